# Optimizing an MI355X kernel written in HIP

```python
import math
import jax, jax.numpy as jnp
from jax import lax
import numpy as np

D_MODEL = 1024
BATCH = 8
SEQ = 2048
DEPTH = 2

N_A = DEPTH // 2
N_B = DEPTH - N_A
HEAD_DIM = 64
CHUNK = 128
N_SG = 12
SG_WIDTH = N_SG * HEAD_DIM
DIL_PAIRS = ((128, 1), (512, 4), (2048, 16))
HEADS_PER_DIL = 4
N_DIL_HEADS = HEADS_PER_DIL * len(DIL_PAIRS)
DIL_Q_WIDTH = N_DIL_HEADS * HEAD_DIM
DIL_OUT_WIDTH = HEADS_PER_DIL * HEAD_DIM
N_MEM = 256
MEM_HEADS = 4
MEM_WIDTH = MEM_HEADS * HEAD_DIM
N_EXPERTS = 16
N_EXPERT_GROUPS = 4
EXPERTS_PER_GROUP = N_EXPERTS // N_EXPERT_GROUPS
TOP_K = 2
D_EXPERT = 1024
MOE_BLOCK = 128
ALPHA = (2 * DEPTH) ** 0.25
BETA = (8 * DEPTH) ** -0.25
LN_EPS = 1e-5
ATT_SCALE = 1.0 / math.sqrt(HEAD_DIM)

kernel_name = "yoco_gmlp_dilated_moe_trunk"


def layer_norm(x, g, b):
    xf = x.astype(jnp.float32)
    mu = jnp.mean(xf, -1, keepdims=True)
    var = jnp.mean(jnp.square(xf - mu), -1, keepdims=True)
    return ((xf - mu) * lax.rsqrt(var + LN_EPS)).astype(x.dtype) * g + b


def alibi_slopes():
    return 2.0 ** (-8.0 * jnp.arange(1, N_DIL_HEADS + 1, dtype=jnp.float32) / N_DIL_HEADS)


def spatial_gating(u, v, w_s, b_s):
    B, S, G, Dh = v.shape
    vc = v.reshape(B, S // CHUNK, CHUNK, G, Dh)
    causal = jnp.tril(jnp.ones((CHUNK, CHUNK), bool))
    w = jnp.where(causal[None], w_s, 0).astype(v.dtype)
    s = jnp.einsum('gpq,bcqgd->bcpgd', w, vc) + b_s.T[None, None, :, :, None].astype(v.dtype)
    return u * s.reshape(B, S, G, Dh)


def dilated_branch(q, k, v, window, dilation, slopes):
    B, S, H, Dh = q.shape
    steps = window // dilation
    L = S // dilation
    N = B * dilation

    def by_residue(t):
        return t.reshape(B, L, dilation, H, Dh).transpose(0, 2, 3, 1, 4).reshape(N, H, L, Dh)

    qr, kr, vr = by_residue(q), by_residue(k), by_residue(v)
    nb = -(-L // CHUNK)
    pad = nb * CHUNK - L
    qr = jnp.pad(qr, ((0, 0), (0, 0), (0, pad), (0, 0)))
    kr = jnp.pad(kr, ((0, 0), (0, 0), (CHUNK, pad), (0, 0)))
    vr = jnp.pad(vr, ((0, 0), (0, 0), (CHUNK, pad), (0, 0)))
    qb = qr.reshape(N, H, nb, CHUNK, Dh)
    kb = kr.reshape(N, H, nb + 1, CHUNK, Dh)
    vb = vr.reshape(N, H, nb + 1, CHUNK, Dh)
    kband = jnp.concatenate([kb[:, :, :-1], kb[:, :, 1:]], axis=3)
    vband = jnp.concatenate([vb[:, :, :-1], vb[:, :, 1:]], axis=3)
    s = jnp.einsum('nhbqd,nhbkd->nhbqk', qb, kband).astype(jnp.float32) * ATT_SCALE
    iq = jnp.arange(CHUNK)[:, None]
    jk = jnp.arange(2 * CHUNK)[None, :]
    rel = CHUNK + iq - jk
    key_pos = (jnp.arange(nb)[:, None, None] - 1) * CHUNK + jk[None]
    valid = (rel >= 0)[None] & (rel <= steps)[None] & (key_pos >= 0)
    bias = -slopes[:, None, None, None] * (dilation * rel).astype(jnp.float32)[None, None]
    s = jnp.where(valid[None, None], s + bias[None], -jnp.inf)
    m = jnp.max(s, -1, keepdims=True)
    p = jnp.exp(s - m)
    l = jnp.sum(p, -1, keepdims=True)
    o = jnp.einsum('nhbqk,nhbkd->nhbqd', (p / l).astype(v.dtype), vband)
    lse = (m + jnp.log(l))[..., 0]
    o = o.reshape(N, H, nb * CHUNK, Dh)[:, :, :L]
    lse = lse.reshape(N, H, nb * CHUNK)[:, :, :L]
    o = o.reshape(B, dilation, H, L, Dh).transpose(0, 3, 1, 2, 4).reshape(B, S, H, Dh)
    lse = lse.reshape(B, dilation, H, L).transpose(0, 3, 1, 2).reshape(B, S, H)
    return o, lse


def dilated_mixture(q, k, v, slopes):
    outs, lses = [], []
    for g, (window, dilation) in enumerate(DIL_PAIRS):
        hs = slice(g * HEADS_PER_DIL, (g + 1) * HEADS_PER_DIL)
        o, lse = dilated_branch(q[:, :, hs], k[:, :, hs], v[:, :, hs], window, dilation, slopes[hs])
        outs.append(o)
        lses.append(lse)
    O = jnp.stack(outs, 0)
    wts = jax.nn.softmax(jnp.stack(lses, 0), 0)
    return jnp.sum(wts[..., None].astype(O.dtype) * O, 0)


def memory_attention(q, mk, mv):
    s = jnp.einsum('bshd,bmhd->bhsm', q, mk).astype(jnp.float32) * ATT_SCALE
    p = jax.nn.softmax(s, -1).astype(mv.dtype)
    return jnp.einsum('bhsm,bmhd->bshd', p, mv)


def route(h, w_router, b_router):
    T = h.shape[0]
    probs = jax.nn.softmax((h @ w_router).astype(jnp.float32), -1)
    sel = probs + b_router.astype(jnp.float32)
    grp = sel.reshape(T, N_EXPERT_GROUPS, EXPERTS_PER_GROUP)
    grp_score = jnp.sum(lax.top_k(grp, TOP_K)[0], -1)
    g_idx = jnp.argmax(grp_score, -1).astype(jnp.int32)
    in_grp = jnp.take_along_axis(grp, g_idx[:, None, None], axis=1)[:, 0]
    _, local = lax.top_k(in_grp, TOP_K)
    expert = g_idx[:, None] * EXPERTS_PER_GROUP + local.astype(jnp.int32)
    gate = jnp.take_along_axis(probs, expert, 1)
    gate = gate / jnp.sum(gate, -1, keepdims=True)
    return expert, gate


def moe_ffn(h, expert, gate, w_gate, w_up, w_down):
    T, D = h.shape
    n_slots = T * TOP_K
    e_flat = expert.reshape(-1)
    g_flat = gate.reshape(-1)
    tok = jnp.arange(n_slots, dtype=jnp.int32) // TOP_K
    order = jnp.argsort(e_flat)
    e_s, tok_s, g_s = e_flat[order], tok[order], g_flat[order]
    counts = jnp.bincount(e_flat, length=N_EXPERTS)
    starts = jnp.cumsum(counts) - counts
    padded = (counts + MOE_BLOCK - 1) // MOE_BLOCK * MOE_BLOCK
    pad_ends = jnp.cumsum(padded)
    pad_starts = pad_ends - padded
    dest = pad_starts[e_s] + (jnp.arange(n_slots) - starts[e_s])
    n_pad = n_slots + N_EXPERTS * MOE_BLOCK
    n_blocks = n_pad // MOE_BLOCK
    slot_tok = jnp.zeros((n_pad,), jnp.int32).at[dest].set(tok_s)
    slot_gate = jnp.zeros((n_pad,), jnp.float32).at[dest].set(g_s)
    block_start = jnp.arange(n_blocks) * MOE_BLOCK
    block_expert = jnp.minimum(jnp.searchsorted(pad_ends, block_start, side='right'), N_EXPERTS - 1)
    xb = h[slot_tok].reshape(n_blocks, MOE_BLOCK, D)

    def expert_block(args):
        xblk, e = args
        return (jax.nn.silu(xblk @ w_gate[e]) * (xblk @ w_up[e])) @ w_down[e]

    yb = lax.map(expert_block, (xb, block_expert))
    y = yb.reshape(n_pad, D) * slot_gate[:, None].astype(h.dtype)
    return jnp.zeros_like(h).at[slot_tok].add(y)


def _normal(k, shape, scale):
    return jax.random.normal(k, shape, jnp.float32) * scale


def setup_inputs(seed: int = 0) -> dict:
    key = jax.random.key(seed)
    ks = jax.random.split(key, 24)
    D = D_MODEL
    return {
        "x": _normal(ks[0], (BATCH, SEQ, D), 1.0),
        "mem": _normal(ks[1], (BATCH, N_MEM, D), 1.0),
        "w_in_a": _normal(ks[2], (N_A, D, 2 * SG_WIDTH + MEM_WIDTH), D ** -0.5),
        "w_out_a": _normal(ks[3], (N_A, SG_WIDTH + MEM_WIDTH, D), (SG_WIDTH + MEM_WIDTH) ** -0.5 * BETA),
        "sg_ln_g": 1.0 + _normal(ks[4], (N_A, SG_WIDTH), 0.02),
        "sg_ln_b": _normal(ks[5], (N_A, SG_WIDTH), 0.02),
        "sg_w": _normal(ks[6], (N_A, N_SG, CHUNK, CHUNK), 0.5 * CHUNK ** -0.5),
        "sg_b": 1.0 + _normal(ks[7], (N_A, N_SG, CHUNK), 0.1),
        "w_in_b": _normal(ks[8], (N_B, D, DIL_Q_WIDTH + MEM_WIDTH), D ** -0.5),
        "w_out_b": _normal(ks[9], (N_B, DIL_OUT_WIDTH + MEM_WIDTH, D), (DIL_OUT_WIDTH + MEM_WIDTH) ** -0.5 * BETA),
        "w_k_shared": _normal(ks[10], (D, DIL_Q_WIDTH), D ** -0.5),
        "w_v_shared": _normal(ks[11], (D, DIL_Q_WIDTH), D ** -0.5 * BETA),
        "w_mem_k": _normal(ks[12], (DEPTH, D, MEM_WIDTH), D ** -0.5),
        "w_mem_v": _normal(ks[13], (DEPTH, D, MEM_WIDTH), D ** -0.5 * BETA),
        "ln1_g": 1.0 + _normal(ks[14], (DEPTH, D), 0.02),
        "ln1_b": _normal(ks[15], (DEPTH, D), 0.02),
        "ln2_g": 1.0 + _normal(ks[16], (DEPTH, D), 0.02),
        "ln2_b": _normal(ks[17], (DEPTH, D), 0.02),
        "w_router": _normal(ks[18], (D, N_EXPERTS), D ** -0.5),
        "b_router": _normal(ks[19], (N_EXPERTS,), 0.01),
        "w_gate": _normal(ks[20], (DEPTH, N_EXPERTS, D, D_EXPERT), D ** -0.5),
        "w_up": _normal(ks[21], (DEPTH, N_EXPERTS, D, D_EXPERT), D ** -0.5),
        "w_down": _normal(ks[22], (DEPTH, N_EXPERTS, D_EXPERT, D), D_EXPERT ** -0.5 * BETA),
    }


def reference(x, mem, w_in_a, w_out_a, sg_ln_g, sg_ln_b, sg_w, sg_b, w_in_b, w_out_b,
              w_k_shared, w_v_shared, w_mem_k, w_mem_v, ln1_g, ln1_b, ln2_g, ln2_b,
              w_router, b_router, w_gate, w_up, w_down):
    B, S, D = x.shape
    M = mem.shape[1]
    slopes = alibi_slopes()
    k_sh = None
    v_sh = None
    for layer in range(DEPTH):
        mk = (mem @ w_mem_k[layer]).reshape(B, M, MEM_HEADS, HEAD_DIM)
        mv = (mem @ w_mem_v[layer]).reshape(B, M, MEM_HEADS, HEAD_DIM)
        if layer < N_A:
            a = layer
            proj = x @ w_in_a[a]
            u = jax.nn.gelu(proj[..., :SG_WIDTH], approximate=False)
            gv = jax.nn.gelu(proj[..., SG_WIDTH:2 * SG_WIDTH], approximate=False)
            qm = proj[..., 2 * SG_WIDTH:].reshape(B, S, MEM_HEADS, HEAD_DIM)
            gv = layer_norm(gv, sg_ln_g[a], sg_ln_b[a])
            mix = spatial_gating(u.reshape(B, S, N_SG, HEAD_DIM), gv.reshape(B, S, N_SG, HEAD_DIM),
                                 sg_w[a], sg_b[a]).reshape(B, S, SG_WIDTH)
            mo = memory_attention(qm, mk, mv).reshape(B, S, MEM_WIDTH)
            att = jnp.concatenate([mix, mo], -1) @ w_out_a[a]
        else:
            bl = layer - N_A
            if bl == 0:
                k_sh = (x @ w_k_shared).reshape(B, S, N_DIL_HEADS, HEAD_DIM)
                v_sh = (x @ w_v_shared).reshape(B, S, N_DIL_HEADS, HEAD_DIM)
            proj = x @ w_in_b[bl]
            q = proj[..., :DIL_Q_WIDTH].reshape(B, S, N_DIL_HEADS, HEAD_DIM)
            qm = proj[..., DIL_Q_WIDTH:].reshape(B, S, MEM_HEADS, HEAD_DIM)
            mix = dilated_mixture(q, k_sh, v_sh, slopes).reshape(B, S, DIL_OUT_WIDTH)
            mo = memory_attention(qm, mk, mv).reshape(B, S, MEM_WIDTH)
            att = jnp.concatenate([mix, mo], -1) @ w_out_b[bl]
        x = layer_norm(ALPHA * x + att, ln1_g[layer], ln1_b[layer])
        h = x.reshape(B * S, D)
        expert, gate = route(h, w_router, b_router)
        ffn = moe_ffn(h, expert, gate, w_gate[layer], w_up[layer], w_down[layer]).reshape(B, S, D)
        x = layer_norm(ALPHA * x + ffn, ln2_g[layer], ln2_b[layer])
    return x
```

```cpp
#include <hip/hip_runtime.h>
#include <cstdio>
#include <cstdint>
namespace pg8 {
#define PG8_LAS __attribute__((address_space(3)))
typedef unsigned short bf16_t;
typedef short bf16x8 __attribute__((ext_vector_type(8)));
typedef float f32x4 __attribute__((ext_vector_type(4)));
typedef unsigned u32x4 __attribute__((ext_vector_type(4)));
constexpr int BM = 256, BK = 64, HALF = 128, HTB = HALF * BK * 2  , STAGE_BYTES = 8 * HTB, NXCD = 8, WGM = 8;

__host__ __device__ __forceinline__ int lds_byte(int r, int c) { const int st = (r >> 4) * 2 + (c >> 5), rr = r & 15, cc = c & 31, ob = rr * 64 + cc * 2; return st * 1024 + (ob ^ (((ob >> 9) & 1) << 5)); }
__host__ __device__ __forceinline__ void stage_rc(int b, int& R, int& C) { const int st = b / 1024, sb = b % 1024, swz = sb ^ (((sb >> 9) & 1) << 5); R = (st >> 1) * 16 + swz / 64; C = (st & 1) * 32 + (swz % 64) / 2; }
__host__ __device__ __forceinline__ int perm32(int rho) { const int n = rho >> 4, i = rho & 15; return 8 * (i >> 2) + 4 * n + (i & 3); }

struct Unit { int pm, pn; };
struct Gemm { const bf16_t* A; const bf16_t* Bt; int M, N, K; };

struct StaticOrder {
    int nM, nN, nwg, G, c;
    __host__ __device__ void init(int M, int N, int G_, int c_) { nM = M / BM; nN = N / BM; nwg = nM * nN; G = G_; c = c_; }
    __host__ __device__ bool next(int i, Unit& u) const {
        const long L = (long)i * G + c; if (L >= nwg) return false;
        int wgid = (int)L; { const int q = nwg / NXCD, r = nwg % NXCD, xcd = wgid % NXCD, off = wgid / NXCD; wgid = (xcd < r ? xcd * (q + 1) : r * (q + 1) + (xcd - r) * q) + off; }
        const int nig = WGM * nN, gid = wgid / nig, fm = gid * WGM, gsz = (nM - fm) < WGM ? (nM - fm) : WGM;
        u.pm = fm + ((wgid % nig) % gsz); u.pn = (wgid % nig) / gsz; return true;
    }
    __device__ __forceinline__ void a_ready(const Unit&) const {}
    __device__ __forceinline__ void done(const Unit&) const {}
};
__device__ __forceinline__ unsigned cvt_pk_bf16(float lo, float hi) { unsigned r; asm volatile("v_cvt_pk_bf16_f32 %0, %1, %2" : "=v"(r) : "v"(lo), "v"(hi)); return r; }
typedef float f32x2 __attribute__((ext_vector_type(2)));
__device__ __forceinline__ f32x2 gelu_pk(f32x2 v) {
    const f32x2 av = __builtin_elementwise_abs(v), d = av * 0.2316418882f + 1.0f;
    f32x2 t; t.x = __builtin_amdgcn_rcpf(d.x); t.y = __builtin_amdgcn_rcpf(d.y);
    f32x2 q = t * 0.5307027145f + (-0.7265760135f); q = q * t + 0.7107068705f; q = q * t + (-0.142248368f); q = q * t + 0.127414796f; q = q * t;
    const f32x2 s = (v * v) * (-0.72134752044f);
    f32x2 e; e.x = __builtin_amdgcn_exp2f(s.x); e.y = __builtin_amdgcn_exp2f(s.y);
    const f32x2 m = v * (q * e), r = v - m;
    f32x2 o; o.x = v.x < 0.f ? m.x : r.x; o.y = v.y < 0.f ? m.y : r.y; return o;
}
template <class Epi, class Sched, bool STAMP = false>
__device__ __forceinline__ void gemm_phase(PG8_LAS unsigned char* lds, const Gemm g, const Sched& S, const Epi& E, unsigned long long* stamps, const int tid) {
    const int wid = __builtin_amdgcn_readfirstlane(tid >> 6), lane = tid & 63, wr = wid >> 2, wc = wid & 3, fr = lane & 15, fq = lane >> 4;
    const int K = g.K, nt = K / BK;
    int ts_lo = 0, ts_hi = 0, nts = 0; const unsigned long long rt_entry = STAMP ? (unsigned long long)wall_clock64() : 0ull;
#define PG8_STAMP() do { if (STAMP && wid == 0 && nts < 64) { const unsigned long long _c = (unsigned long long)clock64(); \
        ts_lo = (lane == nts) ? (int)(unsigned)_c : ts_lo; ts_hi = (lane == nts) ? (int)(unsigned)(_c >> 32) : ts_hi; ++nts; } } while (0)
    PG8_STAMP();
    unsigned voffA[2], voffB[2];
#pragma unroll
    for (int i = 0; i < 2; ++i) { int R, C; stage_rc(tid * 16 + i * 8192, R, C); const int Rb = Epi::PERM ? ((R & ~31) + perm32(R & 31)) : R;
        voffA[i] = (unsigned)(R * K + C) * 2u; voffB[i] = (unsigned)(Rb * K + C) * 2u; }
    const size_t kstep = (size_t)(BK * 2);
    const size_t hstep = (size_t)HALF * K * 2;
    const size_t tstep = 2 * hstep;
    const unsigned ldsw = (unsigned)wid * 1024u;
    const int aoff = lds_byte(wr * 64 + fr, fq * 8), boff = lds_byte(wc * 32 + fr, fq * 8);
#define PG8_SA(b, h) (((b) * 2 + (h)) * HTB)
#define PG8_SB(b, h) ((4 + (b) * 2 + (h)) * HTB)
#define PG8_STAGE(bufoff, gbase, voff) do { _Pragma("unroll") for (int _i = 0; _i < 2; ++_i) \
        __builtin_amdgcn_global_load_lds((const unsigned*)((const char*)(gbase) + (voff)[_i]), (PG8_LAS unsigned*)(lds + (bufoff) + ldsw + _i * 8192), 16, 0, 0); } while (0)
#define PG8_LDA(dst, b, h) do { _Pragma("unroll") for (int m = 0; m < 4; ++m) _Pragma("unroll") for (int k = 0; k < 2; ++k) dst[m][k] = *(const PG8_LAS bf16x8*)(lds + PG8_SA(b, h) + aoff + m * 2048 + k * 1024); } while (0)
#define PG8_LDB(dst, b, h) do { _Pragma("unroll") for (int n = 0; n < 2; ++n) _Pragma("unroll") for (int k = 0; k < 2; ++k) dst[n][k] = *(const PG8_LAS bf16x8*)(lds + PG8_SB(b, h) + boff + n * 2048 + k * 1024); } while (0)
#define PG8_MMA(ai, bj, At, Bt) do { __builtin_amdgcn_s_setprio(1); _Pragma("unroll") for (int m = 0; m < 4; ++m) _Pragma("unroll") for (int n = 0; n < 2; ++n) _Pragma("unroll") for (int k = 0; k < 2; ++k) \
        acc[ai][bj][m][n] = __builtin_amdgcn_mfma_f32_16x16x32_bf16(Bt[n][k], At[m][k], acc[ai][bj][m][n], 0, 0, 0); __builtin_amdgcn_s_setprio(0); } while (0)
#define PG8_WAIT_V(n) asm volatile("s_waitcnt vmcnt(" #n ")" ::: "memory")
#define PG8_WAIT_L(n) asm volatile("s_waitcnt lgkmcnt(" #n ")" ::: "memory")
#define PG8_BAR __builtin_amdgcn_s_barrier()
#define PG8_SCHED __builtin_amdgcn_sched_barrier(0)
    Unit cur, nxt; int ui = 0;
    if (!S.next(0, cur)) return;
    f32x4 acc[2][2][4][2];
#pragma unroll
    for (int a = 0; a < 2; ++a)
#pragma unroll
        for (int b = 0; b < 2; ++b)
#pragma unroll
            for (int m = 0; m < 4; ++m)
#pragma unroll
                for (int n = 0; n < 2; ++n) acc[a][b][m][n] = (f32x4){0.f, 0.f, 0.f, 0.f};
    bf16x8 At[4][2], B0[2][2], B1[2][2];
    const char* cA = (const char*)g.A + (size_t)cur.pm * tstep; const char* cB = (const char*)g.Bt + (size_t)cur.pn * tstep;
    S.a_ready(cur);
    PG8_STAGE(PG8_SB(0, 0), cB, voffB); PG8_STAGE(PG8_SA(0, 0), cA, voffA); PG8_STAGE(PG8_SB(0, 1), cB + hstep, voffB); PG8_STAGE(PG8_SA(0, 1), cA + hstep, voffA);
    if (wr == 1) PG8_BAR;
    PG8_WAIT_V(4); PG8_BAR;
    PG8_STAGE(PG8_SB(1, 0), cB + kstep, voffB); PG8_STAGE(PG8_SA(1, 0), cA + kstep, voffA); PG8_STAGE(PG8_SB(1, 1), cB + hstep + kstep, voffB);
    PG8_WAIT_V(6); PG8_BAR;
    PG8_STAMP();
    for (;;) {
        const bool has_next = S.next(ui + 1, nxt);
        const char* nA = has_next ? (const char*)g.A + (size_t)nxt.pm * tstep : cA; const char* nB = has_next ? (const char*)g.Bt + (size_t)nxt.pn * tstep : cB;
        for (int t = 0; t < nt; t += 2) {
            const bool last = (t == nt - 2);
            const char* a1 = cA + (size_t)(t + 1) * kstep;
            const char* a2 = last ? nA : cA + (size_t)(t + 2) * kstep; const char* b2 = last ? nB : cB + (size_t)(t + 2) * kstep;
            const char* a3 = a2 + kstep; const char* b3 = b2 + kstep;
            if (last && has_next) S.a_ready(nxt);
            PG8_LDB(B0, 0, 0); PG8_SCHED; PG8_LDA(At, 0, 0); PG8_STAGE(PG8_SA(1, 1), a1 + hstep, voffA);
            PG8_WAIT_L(8); PG8_BAR; PG8_WAIT_L(0); PG8_MMA(0, 0, At, B0); PG8_BAR; PG8_SCHED;
            PG8_LDB(B1, 0, 1); PG8_STAGE(PG8_SB(0, 0), b2, voffB);
            PG8_BAR; PG8_WAIT_L(0); PG8_MMA(0, 1, At, B1); PG8_BAR;
            PG8_LDA(At, 0, 1); PG8_STAGE(PG8_SA(0, 0), a2, voffA);
            PG8_BAR; PG8_WAIT_L(0); PG8_MMA(1, 0, At, B0); PG8_BAR; PG8_SCHED;
            PG8_STAGE(PG8_SB(0, 1), b2 + hstep, voffB);
            PG8_WAIT_V(6); PG8_BAR; PG8_MMA(1, 1, At, B1); PG8_BAR;
            PG8_LDB(B0, 1, 0); PG8_SCHED; PG8_LDA(At, 1, 0); PG8_STAGE(PG8_SA(0, 1), a2 + hstep, voffA);
            PG8_WAIT_L(8); PG8_BAR; PG8_WAIT_L(0); PG8_MMA(0, 0, At, B0); PG8_BAR; PG8_SCHED;
            PG8_LDB(B1, 1, 1); PG8_STAGE(PG8_SB(1, 0), b3, voffB);
            PG8_BAR; PG8_WAIT_L(0); PG8_MMA(0, 1, At, B1); PG8_BAR;
            PG8_LDA(At, 1, 1); PG8_STAGE(PG8_SA(1, 0), a3, voffA);
            PG8_BAR; PG8_WAIT_L(0); PG8_MMA(1, 0, At, B0); PG8_BAR; PG8_SCHED;
            PG8_STAGE(PG8_SB(1, 1), b3 + hstep, voffB);
            PG8_WAIT_V(6); PG8_BAR; PG8_MMA(1, 1, At, B1); PG8_BAR;
        }
        PG8_STAMP();
        if constexpr (!Epi::AFTER_DRAIN) { E(acc, cur, wr, wc, fr, fq); S.done(cur); }
        PG8_STAMP();
        if (!has_next) break;
#pragma unroll
        for (int a = 0; a < 2; ++a)
#pragma unroll
            for (int b = 0; b < 2; ++b)
#pragma unroll
                for (int m = 0; m < 4; ++m)
#pragma unroll
                    for (int n = 0; n < 2; ++n) acc[a][b][m][n] = (f32x4){0.f, 0.f, 0.f, 0.f};
        cur = nxt; cA = nA; cB = nB; ++ui;
    }
    PG8_WAIT_V(0);
    if (wr == 0) PG8_BAR;
    PG8_BAR;
    if constexpr (Epi::AFTER_DRAIN) { E.fused(acc, cur, wr, wc, fr, fq, lds, wid, lane); S.done(cur); }
    PG8_STAMP();
    if (STAMP && wid == 0) { stamps[lane] = lane < nts ? (((unsigned long long)(unsigned)ts_hi << 32) | (unsigned)ts_lo) : 0ull;
        if (lane == 62) stamps[62] = rt_entry; if (lane == 63) stamps[63] = (unsigned long long)wall_clock64(); }
#undef PG8_STAMP
#undef PG8_SA
#undef PG8_SB
#undef PG8_STAGE
#undef PG8_LDA
#undef PG8_LDB
#undef PG8_MMA
#undef PG8_WAIT_V
#undef PG8_WAIT_L
#undef PG8_BAR
#undef PG8_SCHED
}
}

namespace mk {
using pg8::bf16_t; using pg8::f32x4; using pg8::u32x4; using pg8::Unit; using pg8::cvt_pk_bf16;
#define LAS __attribute__((address_space(3)))
typedef float f32x2 __attribute__((ext_vector_type(2)));
typedef unsigned u32x2 __attribute__((ext_vector_type(2)));

#ifndef MK_N_LAUNCHES
#define MK_N_LAUNCHES 1
#endif
constexpr int NPHASE = 18;
constexpr int NB = 8, SEQ = 2048, D = 1024, T = NB * SEQ, NMEM = 256, SGW = 768, NSG = 12, HD = 64, CH = 128;
constexpr int NEXP = 16, LISTCAP = 16384;
constexpr float ALPHA = 1.41421356237f;
constexpr float LN_EPS = 1e-5f, ATT_SCALE = 0.125f;
constexpr int NWAVES = 8, NTHREADS = 512;

constexpr size_t MiB = 1u << 20;
constexpr size_t WS_CTL = 0, CTL_ZERO_BYTES = 1 * MiB;
constexpr size_t WS_TOKE = 1 * MiB, WS_TOKP = WS_TOKE + 128 * 1024, WS_TOKG = WS_TOKP + 128 * 1024;
constexpr size_t WS_LIST = 2 * MiB, WS_LSE = 3 * MiB;
constexpr size_t WS_MKV = 8 * MiB, WS_MEMB = 12 * MiB;
constexpr size_t WS_BT_INA = 18 * MiB, WS_BT_OUTA = 22 * MiB, WS_BT_B = 24 * MiB, WS_BT_OUTB = 29 * MiB, WS_BT_MEM = 30 * MiB;
constexpr size_t WS_WGU = 32 * MiB, WS_WD = 160 * MiB;
constexpr size_t WS_A = 224 * MiB;
constexpr size_t WS_U = WS_A, WS_GV = WS_A + 24 * MiB, WS_QM0 = WS_A + 48 * MiB;
constexpr size_t WS_K = WS_A, WS_V = WS_A + 24 * MiB, WS_Q = WS_A + 48 * MiB, WS_QM1 = WS_A + 72 * MiB;
constexpr size_t WS_ACT = WS_A;
constexpr size_t WS_XB = 304 * MiB;
constexpr size_t WS_C = 336 * MiB;
constexpr size_t WS_CAT = WS_C, WS_OG = WS_C, WS_CAT2 = WS_C + 24 * MiB;
constexpr size_t WS_Y = 376 * MiB;
constexpr size_t WS_YD = 336 * MiB;
constexpr size_t WS_X1B = 440 * MiB;
constexpr size_t WS_END = 472 * MiB;
constexpr int CW_TMO = 0, CW_BAR = 4096, CW_CNT = 16384;
constexpr int LDS_MISC = 131072;
constexpr int LDS_BYTES = 147456;

#define LDS_WAIT() asm volatile("s_waitcnt lgkmcnt(0)" ::: "memory")
#define VM_WAIT() asm volatile("s_waitcnt vmcnt(0)" ::: "memory")
__device__ __forceinline__ unsigned f2bf(float f) { unsigned u = __builtin_bit_cast(unsigned, f); return (u + 0x7fffu + ((u >> 16) & 1u)) >> 16; }
__device__ __forceinline__ unsigned pk2(float lo, float hi) { return f2bf(lo) | (f2bf(hi) << 16); }
__device__ __forceinline__ float bflo(unsigned w) { return __uint_as_float(w << 16); }
__device__ __forceinline__ float bfhi(unsigned w) { return __uint_as_float(w & 0xffff0000u); }
__device__ __forceinline__ float bf1(bf16_t v) { return __uint_as_float(((unsigned)v) << 16); }
__device__ __forceinline__ float wave_sum(float v) {
#pragma unroll
    for (int o = 1; o < 64; o <<= 1) v += __shfl_xor(v, o);
    return v;
}
__device__ __forceinline__ float wave_max(float v) {
#pragma unroll
    for (int o = 1; o < 64; o <<= 1) v = fmaxf(v, __shfl_xor(v, o));
    return v;
}

#define XB_TMO      128
#define XB_XCNT(j)  (256  + 64 * (j))
#define XB_XSUB(j)  (1280 + 64 * (j))
#define XB_XGEN(j)  (2304 + 64 * (j))
#define XB_TOP      3328
#define XB_TOPGEN   3392
#define XCD_BAR_WORDS 3456
#define XB_SPIN_CAP (1u << 18)
__device__ __forceinline__ unsigned xb_ld(unsigned* p)              { return __hip_atomic_load(p, __ATOMIC_RELAXED, __HIP_MEMORY_SCOPE_AGENT); }
__device__ __forceinline__ unsigned xb_add(unsigned* p, unsigned v) { return __hip_atomic_fetch_add(p, v, __ATOMIC_RELAXED, __HIP_MEMORY_SCOPE_AGENT); }
__device__ __forceinline__ unsigned xb_xcc_id() { return (unsigned)__builtin_amdgcn_s_getreg((3 << 11) | 20) & 0xFu; }
#define XB_SPIN(cond, bar) do { unsigned _sp = 0; while (cond) { __builtin_amdgcn_s_sleep(1); \
    if ((++_sp & 255u) == 0u) { if (xb_ld(&(bar)[XB_TMO])) break; if (_sp > XB_SPIN_CAP) { atomicAdd(&(bar)[XB_TMO], 1u); break; } } } } while (0)
struct XcdBarrier { unsigned* bar; unsigned x; volatile LAS unsigned* st; };
__device__ __forceinline__ XcdBarrier xcd_barrier_post(unsigned* bar, volatile LAS unsigned* st) {
    XcdBarrier b; b.bar = bar; b.x = xb_xcc_id(); b.st = st;
    if (threadIdx.x == 0) (void)xb_add(&bar[XB_XCNT(b.x)], 1u);
    return b;
}
__device__ __forceinline__ void xcd_barrier_complete(unsigned* bar, unsigned x, unsigned& nloc, unsigned& nx) {
    const unsigned G = gridDim.x * gridDim.y * gridDim.z;
    unsigned sum, cnt, mine, sp = 0u;
    for (;;) {
        sum = 0u; cnt = 0u; mine = 0u;
#pragma unroll
        for (unsigned j = 0; j < 16; ++j) { const unsigned c = xb_ld(&bar[XB_XCNT(j)]); sum += c; cnt += (c > 0u) ? 1u : 0u; mine = (j == x) ? c : mine; }
        if (sum == G) break;
        __builtin_amdgcn_s_sleep(1);
        if ((++sp & 255u) == 0u) { if (xb_ld(&bar[XB_TMO])) break; if (sp > XB_SPIN_CAP) { atomicAdd(&bar[XB_TMO], 1u); break; } }
    }
    nloc = mine > 0u ? mine : 1u; nx = cnt > 0u ? cnt : 1u;
}
__device__ __forceinline__ void xcd_barrier(const XcdBarrier& b) {
    asm volatile("s_waitcnt vmcnt(0)" ::: "memory");
    __syncthreads();
    if (threadIdx.x == 0) {
        unsigned* bar = b.bar;
        __builtin_amdgcn_s_waitcnt(0);
        unsigned nloc = b.st[0], nx = b.st[1];
        if (nloc == 0u) { xcd_barrier_complete(bar, b.x, nloc, nx); b.st[0] = nloc; b.st[1] = nx; }
        const unsigned old = xb_add(&bar[XB_XSUB(b.x)], 1u);
        const unsigned gen = old / nloc;
        if (old + 1u == (gen + 1u) * nloc) {
            __builtin_amdgcn_fence(__ATOMIC_RELEASE, "agent");
            asm volatile("s_waitcnt vmcnt(0)" ::: "memory");
            const unsigned og = xb_add(&bar[XB_TOP], 1u);
            const unsigned tg = og / nx;
            if (og + 1u == (tg + 1u) * nx) xb_add(&bar[XB_TOPGEN], 1u);
            else XB_SPIN(xb_ld(&bar[XB_TOPGEN]) == tg, bar);
            __builtin_amdgcn_fence(__ATOMIC_ACQUIRE, "agent");
            xb_add(&bar[XB_XGEN(b.x)], 1u);
            asm volatile("s_waitcnt vmcnt(0)" ::: "memory");
        } else {
            XB_SPIN(xb_ld(&bar[XB_XGEN(b.x)]) == gen, bar);
            __builtin_amdgcn_fence(__ATOMIC_ACQUIRE, "agent");
            asm volatile("s_waitcnt vmcnt(0)" ::: "memory");
        }
    }
    __syncthreads();
}


struct EpiProjA {
    static constexpr bool PERM = true, AFTER_DRAIN = false;
    bf16_t *u, *gv, *qm;
    __device__ __forceinline__ void operator()(const f32x4 (&acc)[2][2][4][2], const Unit& un, int wr, int wc, int fr, int fq) const {
        const int row0 = un.pm * 256 + wr * 64 + fr;
        bf16_t* base; int ldc, colt; bool act; float sc = 1.f;
        if (un.pn < 3) { base = u; ldc = SGW; colt = un.pn * 256; act = true; }
        else if (un.pn < 6) { base = gv; ldc = SGW; colt = (un.pn - 3) * 256; act = true; }
        else { base = qm; ldc = 256; colt = 0; act = false; sc = ATT_SCALE; }
        const int col0 = colt + wc * 32 + 8 * fq;
#pragma unroll
        for (int ai = 0; ai < 2; ++ai)
#pragma unroll
            for (int m = 0; m < 4; ++m) { bf16_t* rowp = base + (size_t)(row0 + ai * 128 + m * 16) * ldc + col0;
#pragma unroll
                for (int bj = 0; bj < 2; ++bj) { f32x4 v0 = acc[ai][bj][m][0], v1 = acc[ai][bj][m][1];
                    if (act) { pg8::f32x2 a = pg8::gelu_pk((pg8::f32x2){v0[0], v0[1]}), b = pg8::gelu_pk((pg8::f32x2){v0[2], v0[3]}), c = pg8::gelu_pk((pg8::f32x2){v1[0], v1[1]}), d = pg8::gelu_pk((pg8::f32x2){v1[2], v1[3]});
                        v0 = (f32x4){a.x, a.y, b.x, b.y}; v1 = (f32x4){c.x, c.y, d.x, d.y}; }
                    v0 = v0 * sc; v1 = v1 * sc;
                    u32x4 w; w.x = cvt_pk_bf16(v0[0], v0[1]); w.y = cvt_pk_bf16(v0[2], v0[3]); w.z = cvt_pk_bf16(v1[0], v1[1]); w.w = cvt_pk_bf16(v1[2], v1[3]);
                    *(u32x4*)(rowp + bj * 128) = w; } }
    }
};
struct EpiProjB {
    static constexpr bool PERM = true, AFTER_DRAIN = false;
    bf16_t *k, *v, *q, *qm;
    __device__ __forceinline__ void operator()(const f32x4 (&acc)[2][2][4][2], const Unit& un, int wr, int wc, int fr, int fq) const {
        const int row0 = un.pm * 256 + wr * 64 + fr;
        bf16_t* base; int ldc, colt; float sc = 1.f;
        if (un.pn < 3) { base = k; ldc = SGW; colt = un.pn * 256; }
        else if (un.pn < 6) { base = v; ldc = SGW; colt = (un.pn - 3) * 256; }
        else if (un.pn < 9) { base = q; ldc = SGW; colt = (un.pn - 6) * 256; sc = ATT_SCALE; }
        else { base = qm; ldc = 256; colt = 0; sc = ATT_SCALE; }
        const int col0 = colt + wc * 32 + 8 * fq;
#pragma unroll
        for (int ai = 0; ai < 2; ++ai)
#pragma unroll
            for (int m = 0; m < 4; ++m) { bf16_t* rowp = base + (size_t)(row0 + ai * 128 + m * 16) * ldc + col0;
#pragma unroll
                for (int bj = 0; bj < 2; ++bj) { f32x4 v0 = acc[ai][bj][m][0] * sc, v1 = acc[ai][bj][m][1] * sc;
                    u32x4 w; w.x = cvt_pk_bf16(v0[0], v0[1]); w.y = cvt_pk_bf16(v0[2], v0[3]); w.z = cvt_pk_bf16(v1[0], v1[1]); w.w = cvt_pk_bf16(v1[2], v1[3]);
                    *(u32x4*)(rowp + bj * 128) = w; } }
    }
};
struct EpiPlain {
    static constexpr bool PERM = true, AFTER_DRAIN = false;
    bf16_t* O; int ldc, ntn;
    __device__ __forceinline__ void operator()(const f32x4 (&acc)[2][2][4][2], const Unit& un, int wr, int wc, int fr, int fq) const {
        const int row0 = un.pm * 256 + wr * 64 + fr;
        const int col0 = (un.pn % ntn) * 256 + wc * 32 + 8 * fq;
#pragma unroll
        for (int ai = 0; ai < 2; ++ai)
#pragma unroll
            for (int m = 0; m < 4; ++m) { bf16_t* rowp = O + (size_t)(row0 + ai * 128 + m * 16) * ldc + col0;
#pragma unroll
                for (int bj = 0; bj < 2; ++bj) { const f32x4 v0 = acc[ai][bj][m][0], v1 = acc[ai][bj][m][1];
                    u32x4 w; w.x = cvt_pk_bf16(v0[0], v0[1]); w.y = cvt_pk_bf16(v0[2], v0[3]); w.z = cvt_pk_bf16(v1[0], v1[1]); w.w = cvt_pk_bf16(v1[2], v1[3]);
                    *(u32x4*)(rowp + bj * 128) = w; } }
    }
};
struct EpiSwiGLU {
    static constexpr bool PERM = true, AFTER_DRAIN = false;
    bf16_t* O;
    __device__ __forceinline__ void operator()(const f32x4 (&acc)[2][2][4][2], const Unit& un, int wr, int wc, int fr, int fq) const {
        const int row0 = un.pm * 256 + wr * 64 + fr;
        const int col0 = (un.pn & 7) * 128 + wc * 32 + 8 * fq;
#pragma unroll
        for (int ai = 0; ai < 2; ++ai)
#pragma unroll
            for (int m = 0; m < 4; ++m) { bf16_t* rowp = O + (size_t)(row0 + ai * 128 + m * 16) * 1024 + col0;
                float r[8];
#pragma unroll
                for (int n = 0; n < 2; ++n)
#pragma unroll
                    for (int j = 0; j < 4; ++j) { const float g = acc[ai][0][m][n][j], up = acc[ai][1][m][n][j];
                        r[n * 4 + j] = g * __builtin_amdgcn_rcpf(1.0f + __expf(-g)) * up; }
                u32x4 w; w.x = cvt_pk_bf16(r[0], r[1]); w.y = cvt_pk_bf16(r[2], r[3]); w.z = cvt_pk_bf16(r[4], r[5]); w.w = cvt_pk_bf16(r[6], r[7]);
                *(u32x4*)rowp = w; }
    }
};
template <bool RB> struct EpiResid {
    static constexpr bool PERM = false, AFTER_DRAIN = false;
    const void* res; float* Y;
    __device__ __forceinline__ void operator()(const f32x4 (&acc)[2][2][4][2], const Unit& un, int wr, int wc, int fr, int fq) const {
        const int row0 = un.pm * 256 + wr * 64 + fr, col0 = un.pn * 256 + wc * 32 + 4 * fq;
#pragma unroll
        for (int ai = 0; ai < 2; ++ai)
#pragma unroll
            for (int m = 0; m < 4; ++m) { const size_t off = (size_t)(row0 + ai * 128 + m * 16) * D + col0;
#pragma unroll
                for (int bj = 0; bj < 2; ++bj)
#pragma unroll
                    for (int n = 0; n < 2; ++n) { const size_t o = off + bj * 128 + n * 16; f32x4 r;
                        if (RB) { const u32x2 w = *(const u32x2*)((const bf16_t*)res + o); r = (f32x4){bflo(w.x), bfhi(w.x), bflo(w.y), bfhi(w.y)}; }
                        else r = *(const f32x4*)((const float*)res + o);
                        *(f32x4*)(Y + o) = r * ALPHA + acc[ai][bj][m][n]; } }
    }
};
struct SmallOrder {
    int nN, nwg, c;
    __device__ bool next(int i, Unit& u) const { if (i != 0 || c < 0 || c >= nwg) return false; u.pm = c / nN; u.pn = c % nN; return true; }
    __device__ __forceinline__ void a_ready(const Unit&) const {}
    __device__ __forceinline__ void done(const Unit&) const {}
};
struct MoeOrder {
    const LAS int* tb;
    int ntn, G, c;
    __device__ bool next(int i, Unit& u) const {
        const int L = i * G + c; if (L >= tb[16] * ntn) return false;
        int e = 0;
#pragma unroll
        for (int j = 1; j < 16; ++j) e += (L >= tb[j] * ntn) ? 1 : 0;
        const int r = L - tb[e] * ntn, te = tb[e + 1] - tb[e];
        u.pm = tb[e] + r % te; u.pn = e * ntn + r / te; return true;
    }
    __device__ __forceinline__ void a_ready(const Unit&) const {}
    __device__ __forceinline__ void done(const Unit&) const {}
};

struct Args { const float* in[23]; float* out; unsigned char* ws; int ph_lo, ph_hi; };
struct Ctx {
    unsigned char* ws; LAS unsigned char* lds;
    int tid, lane, wave, gw, NGW, G, bid;
};
__device__ __forceinline__ unsigned char* launder(unsigned char* p) { asm volatile("" : "+s"(p)); return p; }
__device__ __forceinline__ int launder_v(int v) { asm volatile("" : "+v"(v)); return v; }

__device__ __forceinline__ void tr_item(const float* W, int K, int N, bf16_t* WT, int grp, int gstride, int roff, LAS float* scr, int item, int lane) {
    const int nblk = N / 32, kb = item / nblk, nb = item % nblk, k0 = 64 * kb, n0 = 32 * nb;
#pragma unroll 8
    for (int i = 0; i < 32; ++i) { const int kk = 2 * i + (lane >> 5); scr[kk * 33 + (lane & 31)] = W[(size_t)(k0 + kk) * N + n0 + (lane & 31)]; }
    LDS_WAIT(); asm volatile("" ::: "memory");
    const int c = lane & 7;
#pragma unroll
    for (int j = 0; j < 4; ++j) { const int n = (lane >> 3) + 8 * j; const LAS float* s = scr + (8 * c) * 33 + n;
        const int nn = n0 + n, drow = (nn / grp) * gstride + (nn % grp) + roff;
        u32x4 o; o.x = pk2(s[0 * 33], s[1 * 33]); o.y = pk2(s[2 * 33], s[3 * 33]); o.z = pk2(s[4 * 33], s[5 * 33]); o.w = pk2(s[6 * 33], s[7 * 33]);
        *(u32x4*)(WT + (size_t)drow * K + k0 + 8 * c) = o; }
    LDS_WAIT(); asm volatile("" ::: "memory");
}
__device__ __forceinline__ void p0_prologue(const Ctx& C, const Args& A) {
    LAS float* scr = (LAS float*)(C.lds + C.wave * 16384);
    unsigned char* ws = C.ws;
    constexpr int I_MOE = 16 * 32;
    constexpr int N_MOE = 32 * I_MOE;
    constexpr int I_INA = 16 * 56, I_SQ = 512, I_KV = 16 * 24, I_OUTB = 8 * 32, I_MEM = 16 * 8;
    constexpr int NITEMS = 3 * N_MOE + I_INA + I_SQ + I_SQ + 2 * I_KV + I_OUTB + 4 * I_MEM;
    for (int it = C.gw; it < NITEMS; it += C.NGW) {
        int r = it;
        if (r < N_MOE) { const int m = r / I_MOE; tr_item(A.in[20] + (size_t)m * 1048576, 1024, 1024, (bf16_t*)(ws + WS_WGU) + (size_t)m * 2097152, 128, 256, 0, scr, r % I_MOE, C.lane); continue; } r -= N_MOE;
        if (r < N_MOE) { const int m = r / I_MOE; tr_item(A.in[21] + (size_t)m * 1048576, 1024, 1024, (bf16_t*)(ws + WS_WGU) + (size_t)m * 2097152, 128, 256, 128, scr, r % I_MOE, C.lane); continue; } r -= N_MOE;
        if (r < N_MOE) { const int m = r / I_MOE; tr_item(A.in[22] + (size_t)m * 1048576, 1024, 1024, (bf16_t*)(ws + WS_WD) + (size_t)m * 1048576, 1024, 1024, 0, scr, r % I_MOE, C.lane); continue; } r -= N_MOE;
        if (r < I_INA) { tr_item(A.in[2], 1024, 1792, (bf16_t*)(ws + WS_BT_INA), 1792, 1792, 0, scr, r, C.lane); continue; } r -= I_INA;
        if (r < I_SQ) { tr_item(A.in[3], 1024, 1024, (bf16_t*)(ws + WS_BT_OUTA), 1024, 1024, 0, scr, r, C.lane); continue; } r -= I_SQ;
        if (r < I_SQ) { tr_item(A.in[8], 1024, 1024, (bf16_t*)(ws + WS_BT_B), 1024, 1024, 1536, scr, r, C.lane); continue; } r -= I_SQ;
        if (r < I_KV) { tr_item(A.in[10], 1024, 768, (bf16_t*)(ws + WS_BT_B), 768, 768, 0, scr, r, C.lane); continue; } r -= I_KV;
        if (r < I_KV) { tr_item(A.in[11], 1024, 768, (bf16_t*)(ws + WS_BT_B), 768, 768, 768, scr, r, C.lane); continue; } r -= I_KV;
        if (r < I_OUTB) { tr_item(A.in[9], 512, 1024, (bf16_t*)(ws + WS_BT_OUTB), 1024, 1024, 0, scr, r, C.lane); continue; } r -= I_OUTB;
        { const int m = r / I_MEM, layer = m & 1, isv = m >> 1;
          tr_item(A.in[isv ? 13 : 12] + (size_t)layer * 262144, 1024, 256, (bf16_t*)(ws + WS_BT_MEM), 256, 256, layer * 512 + isv * 256, scr, r % I_MEM, C.lane); }
    }
    const int gt = C.bid * NTHREADS + C.tid, NT = C.G * NTHREADS;
    for (int i = gt; i < T * D / 8; i += NT) { const f32x4 a = *(const f32x4*)(A.in[0] + (size_t)i * 8), b = *(const f32x4*)(A.in[0] + (size_t)i * 8 + 4);
        u32x4 w; w.x = pk2(a[0], a[1]); w.y = pk2(a[2], a[3]); w.z = pk2(b[0], b[1]); w.w = pk2(b[2], b[3]); *(u32x4*)((bf16_t*)(ws + WS_XB) + (size_t)i * 8) = w; }
    for (int i = gt; i < NB * NMEM * D / 8; i += NT) { const f32x4 a = *(const f32x4*)(A.in[1] + (size_t)i * 8), b = *(const f32x4*)(A.in[1] + (size_t)i * 8 + 4);
        u32x4 w; w.x = pk2(a[0], a[1]); w.y = pk2(a[2], a[3]); w.z = pk2(b[0], b[1]); w.w = pk2(b[2], b[3]); *(u32x4*)((bf16_t*)(ws + WS_MEMB) + (size_t)i * 8) = w; }
}

__device__ __forceinline__ void sg_scalar(const Ctx& C, const Args& A) {
    const bf16_t* U = (const bf16_t*)(C.ws + WS_U); const bf16_t* GV = (const bf16_t*)(C.ws + WS_GV); bf16_t* CAT = (bf16_t*)(C.ws + WS_CAT);
    const float* lng = A.in[4]; const float* lnb = A.in[5]; const float* sgw = A.in[6]; const float* sgb = A.in[7];
    LAS float* stat = (LAS float*)C.lds;
    LAS float* gvn = (LAS float*)(C.lds + 1024);
    LAS float* Wl = (LAS float*)(C.lds + 1024 + 128 * 65 * 4);
    for (int unit = C.bid; unit < NB * 16; unit += C.G) {
        const int tb = unit * 128;
        for (int rr = 0; rr < 16; ++rr) { const int row = C.wave * 16 + rr; const bf16_t* p = GV + (size_t)(tb + row) * SGW + 4 * C.lane;
            float s = 0.f, ss = 0.f;
#pragma unroll
            for (int j = 0; j < 3; ++j) { const u32x2 w = *(const u32x2*)(p + 256 * j); const float a = bflo(w.x), b = bfhi(w.x), c = bflo(w.y), d = bfhi(w.y);
                s += (a + b) + (c + d); ss += (a * a + b * b) + (c * c + d * d); }
            s = wave_sum(s); ss = wave_sum(ss);
            const float mean = s * (1.f / SGW), var = ss * (1.f / SGW) - mean * mean;
            if (C.lane == 0) { stat[row * 2] = mean; stat[row * 2 + 1] = 1.0f / sqrtf(var + LN_EPS); } }
        __syncthreads();
        const int p = C.tid >> 2, d0 = (C.tid & 3) * 16;
        for (int g = 0; g < NSG; ++g) {
            { const bf16_t* src = GV + (size_t)(tb + p) * SGW + g * 64 + d0; const float mean = stat[p * 2], rstd = stat[p * 2 + 1];
#pragma unroll
              for (int h = 0; h < 2; ++h) { const u32x4 w = *(const u32x4*)(src + 8 * h); const unsigned ww[4] = {w.x, w.y, w.z, w.w};
#pragma unroll
                  for (int j = 0; j < 4; ++j) { const int d = d0 + 8 * h + 2 * j; const int cc = g * 64 + d;
                      gvn[p * 65 + d] = (bflo(ww[j]) - mean) * rstd * lng[cc] + lnb[cc];
                      gvn[p * 65 + d + 1] = (bfhi(ww[j]) - mean) * rstd * lng[cc + 1] + lnb[cc + 1]; } } }
            { const int q0 = (C.tid & 3) * 32; const float* src = sgw + ((size_t)g * 128 + p) * 128 + q0;
#pragma unroll
              for (int j = 0; j < 8; ++j) { const f32x4 w = *(const f32x4*)(src + 4 * j);
#pragma unroll
                  for (int t = 0; t < 4; ++t) { const int q = q0 + 4 * j + t; Wl[p * 129 + q] = (q <= p) ? w[t] : 0.f; } } }
            __syncthreads();
            float acc[16];
#pragma unroll
            for (int j = 0; j < 16; ++j) acc[j] = 0.f;
            for (int q = 0; q <= p; ++q) { const float w = Wl[p * 129 + q];
#pragma unroll
                for (int j = 0; j < 16; ++j) acc[j] += w * gvn[q * 65 + d0 + j]; }
            const float bs = sgb[g * 128 + p];
            const bf16_t* us = U + (size_t)(tb + p) * SGW + g * 64 + d0; bf16_t* dst = CAT + (size_t)(tb + p) * D + g * 64 + d0;
#pragma unroll
            for (int h = 0; h < 2; ++h) { const u32x4 w = *(const u32x4*)(us + 8 * h); const unsigned ww[4] = {w.x, w.y, w.z, w.w}; unsigned o[4];
#pragma unroll
                for (int j = 0; j < 4; ++j) o[j] = pk2(bflo(ww[j]) * (acc[8 * h + 2 * j] + bs), bfhi(ww[j]) * (acc[8 * h + 2 * j + 1] + bs));
                *(u32x4*)(dst + 8 * h) = (u32x4){o[0], o[1], o[2], o[3]}; }
            __syncthreads();
        }
    }
}

__device__ __forceinline__ void memattn_scalar(const Ctx& C, const bf16_t* QM, const bf16_t* MKV, int ck, int cv, bf16_t* OUT, int ldo, int coff) {
    for (int it = C.gw; it < T * 4; it += C.NGW) {
        const int tok = it >> 2, h = it & 3, b = tok / SEQ;
        float q[64];
        { const bf16_t* qp = QM + (size_t)tok * 256 + h * 64;
#pragma unroll
          for (int j = 0; j < 8; ++j) { const u32x4 w = *(const u32x4*)(qp + 8 * j);
              q[8 * j] = bflo(w.x); q[8 * j + 1] = bfhi(w.x); q[8 * j + 2] = bflo(w.y); q[8 * j + 3] = bfhi(w.y); q[8 * j + 4] = bflo(w.z); q[8 * j + 5] = bfhi(w.z); q[8 * j + 6] = bflo(w.w); q[8 * j + 7] = bfhi(w.w); } }
        float s[4];
#pragma unroll
        for (int jj = 0; jj < 4; ++jj) { const bf16_t* kp = MKV + (size_t)(b * NMEM + jj * 64 + C.lane) * 1024 + ck + h * 64; float a = 0.f;
#pragma unroll
            for (int j = 0; j < 8; ++j) { const u32x4 w = *(const u32x4*)(kp + 8 * j);
                a += q[8 * j] * bflo(w.x) + q[8 * j + 1] * bfhi(w.x) + q[8 * j + 2] * bflo(w.y) + q[8 * j + 3] * bfhi(w.y) + q[8 * j + 4] * bflo(w.z) + q[8 * j + 5] * bfhi(w.z) + q[8 * j + 6] * bflo(w.w) + q[8 * j + 7] * bfhi(w.w); }
            s[jj] = a; }
        const float mx = wave_max(fmaxf(fmaxf(s[0], s[1]), fmaxf(s[2], s[3])));
        float l = 0.f;
#pragma unroll
        for (int jj = 0; jj < 4; ++jj) { s[jj] = __expf(s[jj] - mx); l += s[jj]; }
        l = wave_sum(l);
        float acc = 0.f;
#pragma unroll
        for (int jj = 0; jj < 4; ++jj) { const bf16_t* vp = MKV + (size_t)(b * NMEM + jj * 64) * 1024 + cv + h * 64 + C.lane;
            for (int mm = 0; mm < 64; ++mm) acc += __shfl(s[jj], mm) * bf1(vp[(size_t)mm * 1024]); }
        OUT[(size_t)tok * ldo + coff + h * 64 + C.lane] = (bf16_t)f2bf(acc / l);
    }
}

__device__ __forceinline__ void dilattn_scalar(const Ctx& C, const Args& A) {
    const bf16_t* Q = (const bf16_t*)(C.ws + WS_Q); const bf16_t* K = (const bf16_t*)(C.ws + WS_K); const bf16_t* V = (const bf16_t*)(C.ws + WS_V);
    bf16_t* OG = (bf16_t*)(C.ws + WS_OG); float* LSE = (float*)(C.ws + WS_LSE);
    for (int it = C.gw; it < T * 12; it += C.NGW) {
        const int tok = it / 12, h = it % 12, g = h >> 2, dl = (g == 0) ? 1 : (g == 1 ? 4 : 16);
        const int t = tok % SEQ, i = t / dl;
        const float slope = exp2f(-(float)(h + 1) * (8.0f / 12.0f));
        float q[64];
        { const bf16_t* qp = Q + (size_t)tok * SGW + h * 64;
#pragma unroll
          for (int j = 0; j < 8; ++j) { const u32x4 w = *(const u32x4*)(qp + 8 * j);
              q[8 * j] = bflo(w.x); q[8 * j + 1] = bfhi(w.x); q[8 * j + 2] = bflo(w.y); q[8 * j + 3] = bfhi(w.y); q[8 * j + 4] = bflo(w.z); q[8 * j + 5] = bfhi(w.z); q[8 * j + 6] = bflo(w.w); q[8 * j + 7] = bfhi(w.w); } }
        float s[3];
#pragma unroll
        for (int jj = 0; jj < 3; ++jj) { const int j0 = jj * 64 + C.lane; const bool valid = (jj < 2 || C.lane == 0) && (j0 <= i);
            const int jc = valid ? j0 : 0;
            const bf16_t* kp = K + (size_t)(tok - jc * dl) * SGW + h * 64; float a = 0.f;
#pragma unroll
            for (int j = 0; j < 8; ++j) { const u32x4 w = *(const u32x4*)(kp + 8 * j);
                a += q[8 * j] * bflo(w.x) + q[8 * j + 1] * bfhi(w.x) + q[8 * j + 2] * bflo(w.y) + q[8 * j + 3] * bfhi(w.y) + q[8 * j + 4] * bflo(w.z) + q[8 * j + 5] * bfhi(w.z) + q[8 * j + 6] * bflo(w.w) + q[8 * j + 7] * bfhi(w.w); }
            s[jj] = valid ? (a - slope * (float)(dl * j0)) : -INFINITY; }
        const float mx = wave_max(fmaxf(fmaxf(s[0], s[1]), s[2]));
        float l = 0.f;
#pragma unroll
        for (int jj = 0; jj < 3; ++jj) { s[jj] = __expf(s[jj] - mx); l += s[jj]; }
        l = wave_sum(l);
        float acc = 0.f;
#pragma unroll
        for (int jj = 0; jj < 3; ++jj) { const int nm = (jj < 2) ? 64 : 1;
            for (int mm = 0; mm < nm; ++mm) { const int j0 = jj * 64 + mm; const int jc = (j0 <= i) ? j0 : 0;
                acc += __shfl(s[jj], mm) * bf1(V[(size_t)(tok - jc * dl) * SGW + h * 64 + C.lane]); } }
        OG[(size_t)tok * SGW + h * 64 + C.lane] = (bf16_t)f2bf(acc / l);
        if (C.lane == 0) LSE[tok * 12 + h] = mx + __logf(l);
    }
}
__device__ __forceinline__ void dil_merge(const Ctx& C, const Args& A) {
    const bf16_t* OG = (const bf16_t*)(C.ws + WS_OG); const float* LSE = (const float*)(C.ws + WS_LSE); bf16_t* CAT2 = (bf16_t*)(C.ws + WS_CAT2);
    const int gt = C.bid * NTHREADS + C.tid, NT = C.G * NTHREADS;
    for (int it = gt; it < T * 32; it += NT) {
        const int tok = it >> 5, j = (it >> 3) & 3, c8 = it & 7;
        const float l0 = LSE[tok * 12 + j], l1 = LSE[tok * 12 + 4 + j], l2 = LSE[tok * 12 + 8 + j];
        const float mx = fmaxf(l0, fmaxf(l1, l2));
        float w0 = __expf(l0 - mx), w1 = __expf(l1 - mx), w2 = __expf(l2 - mx); const float inv = 1.0f / (w0 + w1 + w2); w0 *= inv; w1 *= inv; w2 *= inv;
        const u32x4 a = *(const u32x4*)(OG + (size_t)tok * SGW + j * 64 + c8 * 8), b = *(const u32x4*)(OG + (size_t)tok * SGW + (4 + j) * 64 + c8 * 8), c = *(const u32x4*)(OG + (size_t)tok * SGW + (8 + j) * 64 + c8 * 8);
        u32x4 o;
        o.x = pk2(w0 * bflo(a.x) + w1 * bflo(b.x) + w2 * bflo(c.x), w0 * bfhi(a.x) + w1 * bfhi(b.x) + w2 * bfhi(c.x));
        o.y = pk2(w0 * bflo(a.y) + w1 * bflo(b.y) + w2 * bflo(c.y), w0 * bfhi(a.y) + w1 * bfhi(b.y) + w2 * bfhi(c.y));
        o.z = pk2(w0 * bflo(a.z) + w1 * bflo(b.z) + w2 * bflo(c.z), w0 * bfhi(a.z) + w1 * bfhi(b.z) + w2 * bfhi(c.z));
        o.w = pk2(w0 * bflo(a.w) + w1 * bflo(b.w) + w2 * bflo(c.w), w0 * bfhi(a.w) + w1 * bfhi(b.w) + w2 * bfhi(c.w));
        *(u32x4*)(CAT2 + (size_t)tok * 512 + j * 64 + c8 * 8) = o;
    }
}

__device__ __forceinline__ void ln_route(const Ctx& C, const Args& A, int layer) {
    const float* Y = (const float*)(C.ws + WS_Y); bf16_t* X1B = (bf16_t*)(C.ws + WS_X1B);
    const float* lg = A.in[14] + layer * D; const float* lb = A.in[15] + layer * D; const float* wr = A.in[18]; const float* br = A.in[19];
    unsigned* cnt = (unsigned*)(C.ws + WS_CTL) + CW_CNT + layer * 16 * 64;
    int* tokE = (int*)(C.ws + WS_TOKE); int* tokP = (int*)(C.ws + WS_TOKP); float* tokG = (float*)(C.ws + WS_TOKG); int* list = (int*)(C.ws + WS_LIST);
    LAS float* wl = (LAS float*)C.lds;
    __syncthreads();
    for (int i = C.tid; i < 1024 * 16 / 4; i += NTHREADS) *(LAS f32x4*)(wl + 4 * i) = *(const f32x4*)(wr + 4 * i);
    __syncthreads();
    const LAS float* wlane = wl + C.lane * 64;
    for (int tok = C.gw; tok < T; tok += C.NGW) {
        f32x4 v[4]; float s = 0.f;
#pragma unroll
        for (int j = 0; j < 4; ++j) { v[j] = *(const f32x4*)(Y + (size_t)tok * D + 4 * C.lane + 256 * j); s += (v[j][0] + v[j][1]) + (v[j][2] + v[j][3]); }
        const float mean = wave_sum(s) * (1.f / D); float s2 = 0.f;
#pragma unroll
        for (int j = 0; j < 4; ++j) { v[j] = v[j] - mean; s2 += (v[j][0] * v[j][0] + v[j][1] * v[j][1]) + (v[j][2] * v[j][2] + v[j][3] * v[j][3]); }
        const float rstd = 1.0f / sqrtf(wave_sum(s2) * (1.f / D) + LN_EPS);
        float lgt[16];
#pragma unroll
        for (int e = 0; e < 16; ++e) lgt[e] = 0.f;
#pragma unroll
        for (int j = 0; j < 4; ++j) { const int col = 4 * C.lane + 256 * j; const f32x4 g4 = *(const f32x4*)(lg + col), b4 = *(const f32x4*)(lb + col);
            v[j] = v[j] * rstd * g4 + b4;
            *(u32x2*)(X1B + (size_t)tok * D + col) = (u32x2){pk2(v[j][0], v[j][1]), pk2(v[j][2], v[j][3])};
#pragma unroll
            for (int c = 0; c < 4; ++c) { const float xv = v[j][c];
#pragma unroll
                for (int e4 = 0; e4 < 4; ++e4) { const f32x4 w = *(const LAS f32x4*)(wlane + (256 * j + c) * 16 + 4 * e4);
                    lgt[4 * e4] += xv * w[0]; lgt[4 * e4 + 1] += xv * w[1]; lgt[4 * e4 + 2] += xv * w[2]; lgt[4 * e4 + 3] += xv * w[3]; } } }
        float mx = -INFINITY;
#pragma unroll
        for (int e = 0; e < 16; ++e) { lgt[e] = wave_sum(lgt[e]); mx = fmaxf(mx, lgt[e]); }
        float sum = 0.f;
#pragma unroll
        for (int e = 0; e < 16; ++e) { lgt[e] = __expf(lgt[e] - mx); sum += lgt[e]; }
        const float inv = 1.0f / sum; float sel[16];
#pragma unroll
        for (int e = 0; e < 16; ++e) { lgt[e] *= inv; sel[e] = lgt[e] + br[e]; }
        float gs[4];
#pragma unroll
        for (int g = 0; g < 4; ++g) { const float a = sel[4 * g], b = sel[4 * g + 1], c = sel[4 * g + 2], d = sel[4 * g + 3];
            gs[g] = fmaxf(fmaxf(fmaxf(a + b, a + c), fmaxf(a + d, b + c)), fmaxf(b + d, c + d)); }
        int gi = 0; float bsc = gs[0];
#pragma unroll
        for (int g = 1; g < 4; ++g) if (gs[g] > bsc) { bsc = gs[g]; gi = g; }
        float sg[4], pg[4];
#pragma unroll
        for (int k = 0; k < 4; ++k) { sg[k] = gi == 0 ? sel[k] : (gi == 1 ? sel[4 + k] : (gi == 2 ? sel[8 + k] : sel[12 + k])); pg[k] = gi == 0 ? lgt[k] : (gi == 1 ? lgt[4 + k] : (gi == 2 ? lgt[8 + k] : lgt[12 + k])); }
        int i1 = 0; float b1 = sg[0], p1 = pg[0];
#pragma unroll
        for (int k = 1; k < 4; ++k) if (sg[k] > b1) { b1 = sg[k]; i1 = k; p1 = pg[k]; }
        int i2 = -1; float b2 = -INFINITY, p2 = 0.f;
#pragma unroll
        for (int k = 0; k < 4; ++k) if (k != i1 && sg[k] > b2) { b2 = sg[k]; i2 = k; p2 = pg[k]; }
        if (C.lane == 0) {
            const int e1 = gi * 4 + i1, e2 = gi * 4 + i2; const float gsum = p1 + p2;
            const unsigned pos1 = __hip_atomic_fetch_add(cnt + e1 * 64, 1u, __ATOMIC_RELAXED, __HIP_MEMORY_SCOPE_AGENT);
            const unsigned pos2 = __hip_atomic_fetch_add(cnt + e2 * 64, 1u, __ATOMIC_RELAXED, __HIP_MEMORY_SCOPE_AGENT);
            list[e1 * LISTCAP + pos1] = tok; list[e2 * LISTCAP + pos2] = tok;
            tokE[tok * 2] = e1; tokE[tok * 2 + 1] = e2; tokP[tok * 2] = (int)pos1; tokP[tok * 2 + 1] = (int)pos2; tokG[tok * 2] = p1 / gsum; tokG[tok * 2 + 1] = p2 / gsum;
        }
    }
}
__device__ __forceinline__ void moe_prefix(const Ctx& C, int layer) {
    LAS int* mi = (LAS int*)(C.lds + LDS_MISC);
    unsigned* cnt = (unsigned*)(C.ws + WS_CTL) + CW_CNT + layer * 16 * 64;
    __syncthreads();
    if (C.tid < 16) mi[17 + C.tid] = (int)__hip_atomic_load(cnt + C.tid * 64, __ATOMIC_RELAXED, __HIP_MEMORY_SCOPE_AGENT);
    __syncthreads();
    if (C.tid == 0) { int a = 0; for (int e = 0; e < 16; ++e) { mi[e] = a; a += (mi[17 + e] + 255) >> 8; } mi[16] = a; }
    __syncthreads();
}
__device__ __forceinline__ void moe_gather(const Ctx& C, const Args& A) {
    const LAS int* mi = (const LAS int*)(C.lds + LDS_MISC);
    const bf16_t* X1B = (const bf16_t*)(C.ws + WS_X1B); bf16_t* XG = (bf16_t*)(C.ws + WS_YD); const int* list = (const int*)(C.ws + WS_LIST);
    const int nrows = mi[16] * 256;
    for (int R = C.gw; R < nrows; R += C.NGW) {
        const int tile = R >> 8; int e = 0;
#pragma unroll
        for (int j = 1; j < 16; ++j) e += (tile >= mi[j]) ? 1 : 0;
        int pos = R - mi[e] * 256; const int cn = mi[17 + e]; if (pos >= cn) pos = cn - 1;
        const int tok = list[e * LISTCAP + pos];
        const u32x4* src = (const u32x4*)(X1B + (size_t)tok * D); u32x4* dst = (u32x4*)(XG + (size_t)R * D);
        dst[C.lane] = src[C.lane]; dst[C.lane + 64] = src[C.lane + 64];
    }
}
__device__ __forceinline__ void combine_ln2(const Ctx& C, const Args& A, int layer) {
    const LAS int* mi = (const LAS int*)(C.lds + LDS_MISC);
    const bf16_t* X1B = (const bf16_t*)(C.ws + WS_X1B); const bf16_t* YD = (const bf16_t*)(C.ws + WS_YD); bf16_t* X2B = (bf16_t*)(C.ws + WS_XB);
    const int* tokE = (const int*)(C.ws + WS_TOKE); const int* tokP = (const int*)(C.ws + WS_TOKP); const float* tokG = (const float*)(C.ws + WS_TOKG);
    const float* lg = A.in[16] + layer * D; const float* lb = A.in[17] + layer * D;
    for (int tok = C.gw; tok < T; tok += C.NGW) {
        const int e0 = tokE[tok * 2], e1 = tokE[tok * 2 + 1]; const float g0 = tokG[tok * 2], g1 = tokG[tok * 2 + 1];
        int tb0 = 0, tb1 = 0;
#pragma unroll
        for (int j = 0; j < 16; ++j) { const int t = mi[j]; tb0 = (e0 == j) ? t : tb0; tb1 = (e1 == j) ? t : tb1; }
        const size_t r0 = (size_t)tb0 * 256 + tokP[tok * 2], r1 = (size_t)tb1 * 256 + tokP[tok * 2 + 1];
        f32x4 v[4]; float s = 0.f;
#pragma unroll
        for (int j = 0; j < 4; ++j) { const int col = 4 * C.lane + 256 * j;
            const u32x2 a = *(const u32x2*)(X1B + (size_t)tok * D + col), y0 = *(const u32x2*)(YD + r0 * D + col), y1 = *(const u32x2*)(YD + r1 * D + col);
            v[j][0] = ALPHA * bflo(a.x) + (g0 * bflo(y0.x) + g1 * bflo(y1.x)); v[j][1] = ALPHA * bfhi(a.x) + (g0 * bfhi(y0.x) + g1 * bfhi(y1.x));
            v[j][2] = ALPHA * bflo(a.y) + (g0 * bflo(y0.y) + g1 * bflo(y1.y)); v[j][3] = ALPHA * bfhi(a.y) + (g0 * bfhi(y0.y) + g1 * bfhi(y1.y));
            s += (v[j][0] + v[j][1]) + (v[j][2] + v[j][3]); }
        const float mean = wave_sum(s) * (1.f / D); float s2 = 0.f;
#pragma unroll
        for (int j = 0; j < 4; ++j) { v[j] = v[j] - mean; s2 += (v[j][0] * v[j][0] + v[j][1] * v[j][1]) + (v[j][2] * v[j][2] + v[j][3] * v[j][3]); }
        const float rstd = 1.0f / sqrtf(wave_sum(s2) * (1.f / D) + LN_EPS);
#pragma unroll
        for (int j = 0; j < 4; ++j) { const int col = 4 * C.lane + 256 * j; const f32x4 g4 = *(const f32x4*)(lg + col), b4 = *(const f32x4*)(lb + col);
            const f32x4 o = v[j] * rstd * g4 + b4;
            if (layer == 0) *(u32x2*)(X2B + (size_t)tok * D + col) = (u32x2){pk2(o[0], o[1]), pk2(o[2], o[3])};
            else *(f32x4*)(A.out + (size_t)tok * D + col) = o; }
    }
}

__global__ void __launch_bounds__(NTHREADS, 2) yoco_fwd(Args args) {
    extern __shared__ __attribute__((aligned(16))) unsigned char lds_raw[];
    Ctx C;
    C.ws = args.ws; C.lds = (LAS unsigned char*)lds_raw;
    C.tid = threadIdx.x; C.lane = C.tid & 63; C.wave = __builtin_amdgcn_readfirstlane(C.tid >> 6);
    C.G = gridDim.x; C.bid = blockIdx.x; C.gw = C.bid * NWAVES + C.wave; C.NGW = C.G * NWAVES;
    unsigned char* ws = args.ws;
#define PHASE_WS() do { ws = launder(args.ws); C.ws = ws; C.tid = launder_v((int)threadIdx.x); C.lane = C.tid & 63; } while (0)
    volatile LAS unsigned* misc = (volatile LAS unsigned*)(C.lds + LDS_MISC);
    for (int u = C.tid; u < 64; u += NTHREADS) misc[u] = 0u;
    __syncthreads();
    XcdBarrier bar; bar.bar = (unsigned*)(ws + WS_CTL) + CW_BAR; bar.x = 0; bar.st = misc + 60;
    const int lo = args.ph_lo, hi = args.ph_hi;
    if (hi - lo > 1) bar = xcd_barrier_post((unsigned*)(ws + WS_CTL) + CW_BAR, misc + 60);
#define IN(k) (lo <= (k) && (k) < hi)
#define SEAM(k) do { if (IN(k) && IN((k) + 1)) xcd_barrier(bar); } while (0)

    if (IN(0)) { PHASE_WS(); p0_prologue(C, args); SEAM(0); }

    if (IN(1)) {
        PHASE_WS();
        { pg8::Gemm g{(const bf16_t*)(ws + WS_XB), (const bf16_t*)(ws + WS_BT_INA), T, 1792, D}; pg8::StaticOrder S; S.init(T, 1792, C.G, C.bid);
          EpiProjA E{(bf16_t*)(ws + WS_U), (bf16_t*)(ws + WS_GV), (bf16_t*)(ws + WS_QM0)};
          pg8::gemm_phase<EpiProjA, pg8::StaticOrder>(C.lds, g, S, E, nullptr, C.tid); }
        { pg8::Gemm g{(const bf16_t*)(ws + WS_MEMB), (const bf16_t*)(ws + WS_BT_MEM), NB * NMEM, 1024, D}; SmallOrder S{4, 32, C.bid - (C.G - 32)};
          EpiPlain E{(bf16_t*)(ws + WS_MKV), 1024, 4};
          pg8::gemm_phase<EpiPlain, SmallOrder>(C.lds, g, S, E, nullptr, C.tid); }
        SEAM(1);
    }
    if (IN(2)) {
        PHASE_WS();
        sg_scalar(C, args);
        memattn_scalar(C, (const bf16_t*)(ws + WS_QM0), (const bf16_t*)(ws + WS_MKV), 0, 256, (bf16_t*)(ws + WS_CAT), D, SGW);
        SEAM(2);
    }
    if (IN(3)) {
        PHASE_WS();
        pg8::Gemm g{(const bf16_t*)(ws + WS_CAT), (const bf16_t*)(ws + WS_BT_OUTA), T, D, D}; pg8::StaticOrder S; S.init(T, D, C.G, C.bid);
        EpiResid<false> E{(const void*)args.in[0], (float*)(ws + WS_Y)};
        pg8::gemm_phase<EpiResid<false>, pg8::StaticOrder>(C.lds, g, S, E, nullptr, C.tid);
        SEAM(3);
    }
#pragma unroll 1
    for (int layer = 0; layer < 2; ++layer) {
        const int pb = 4 + 9 * layer;
        if (IN(pb)) { PHASE_WS(); ln_route(C, args, layer); SEAM(pb); }
        if (IN(pb + 1)) { PHASE_WS(); moe_prefix(C, layer); moe_gather(C, args); SEAM(pb + 1); }
        if (IN(pb + 2)) {
            PHASE_WS();
            moe_prefix(C, layer);
            pg8::Gemm g{(const bf16_t*)(ws + WS_YD), (const bf16_t*)(ws + WS_WGU) + (size_t)layer * 16 * 2097152, 0, 0, D};
            MoeOrder S{(const LAS int*)(C.lds + LDS_MISC), 8, C.G, C.bid};
            EpiSwiGLU E{(bf16_t*)(ws + WS_ACT)};
            pg8::gemm_phase<EpiSwiGLU, MoeOrder>(C.lds, g, S, E, nullptr, C.tid);
            SEAM(pb + 2);
        }
        if (IN(pb + 3)) {
            PHASE_WS();
            moe_prefix(C, layer);
            pg8::Gemm g{(const bf16_t*)(ws + WS_ACT), (const bf16_t*)(ws + WS_WD) + (size_t)layer * 16 * 1048576, 0, 0, D};
            MoeOrder S{(const LAS int*)(C.lds + LDS_MISC), 4, C.G, C.bid};
            EpiPlain E{(bf16_t*)(ws + WS_YD), 1024, 4};
            pg8::gemm_phase<EpiPlain, MoeOrder>(C.lds, g, S, E, nullptr, C.tid);
            SEAM(pb + 3);
        }
        if (IN(pb + 4)) { PHASE_WS(); moe_prefix(C, layer); combine_ln2(C, args, layer); if (layer == 0) SEAM(pb + 4); }
        if (layer == 0) {
            if (IN(9)) {
                PHASE_WS();
                pg8::Gemm g{(const bf16_t*)(ws + WS_XB), (const bf16_t*)(ws + WS_BT_B), T, 2560, D}; pg8::StaticOrder S; S.init(T, 2560, C.G, C.bid);
                EpiProjB E{(bf16_t*)(ws + WS_K), (bf16_t*)(ws + WS_V), (bf16_t*)(ws + WS_Q), (bf16_t*)(ws + WS_QM1)};
                pg8::gemm_phase<EpiProjB, pg8::StaticOrder>(C.lds, g, S, E, nullptr, C.tid);
                SEAM(9);
            }
            if (IN(10)) {
                PHASE_WS();
                dilattn_scalar(C, args);
                memattn_scalar(C, (const bf16_t*)(ws + WS_QM1), (const bf16_t*)(ws + WS_MKV), 512, 768, (bf16_t*)(ws + WS_CAT2), 512, 256);
                SEAM(10);
            }
            if (IN(11)) { PHASE_WS(); dil_merge(C, args); SEAM(11); }
            if (IN(12)) {
                PHASE_WS();
                pg8::Gemm g{(const bf16_t*)(ws + WS_CAT2), (const bf16_t*)(ws + WS_BT_OUTB), T, D, 512}; pg8::StaticOrder S; S.init(T, D, C.G, C.bid);
                EpiResid<true> E{(const void*)(ws + WS_XB), (float*)(ws + WS_Y)};
                pg8::gemm_phase<EpiResid<true>, pg8::StaticOrder>(C.lds, g, S, E, nullptr, C.tid);
                SEAM(12);
            }
        }
    }
#undef IN
#undef SEAM
}
}

extern "C" void kernel_launch(void* const* d_in, const int* in_sizes, int n_in, void* d_out, int out_size, void* d_ws, size_t ws_size, hipStream_t stream) {
    using namespace mk;
    static int grid = 0;
    if (grid == 0) {
        if (n_in != 23 || out_size != T * D || ws_size < WS_END) { fprintf(stderr, "kernel_launch: unexpected shapes (n_in %d, out %d, ws %zu)\n", n_in, out_size, ws_size); grid = -1; return; }
        int dev = 0, cus = 0, per_cu = 0;
        if (hipGetDevice(&dev) != hipSuccess || hipDeviceGetAttribute(&cus, hipDeviceAttributeMultiprocessorCount, dev) != hipSuccess) { grid = -1; return; }
        if (hipFuncSetAttribute((const void*)yoco_fwd, hipFuncAttributeMaxDynamicSharedMemorySize, LDS_BYTES) != hipSuccess) { fprintf(stderr, "kernel_launch: hipFuncSetAttribute failed\n"); grid = -1; return; }
        if (hipOccupancyMaxActiveBlocksPerMultiprocessor(&per_cu, (const void*)yoco_fwd, NTHREADS, LDS_BYTES) != hipSuccess || per_cu < 1)
            fprintf(stderr, "kernel_launch: occupancy query reports %d workgroups per CU\n", per_cu);
        (void)hipGetLastError();
        grid = cus;
    }
    if (grid < 0) return;
    (void)hipMemsetAsync((char*)d_ws + WS_CTL, 0, CTL_ZERO_BYTES, stream);
    Args a{};
    for (int i = 0; i < 23; ++i) a.in[i] = (const float*)d_in[i];
    a.out = (float*)d_out; a.ws = (unsigned char*)d_ws;
    constexpr int NL = MK_N_LAUNCHES;
    for (int li = 0; li < NL; ++li) {
        a.ph_lo = (NL == NPHASE) ? li : (li * NPHASE) / NL; a.ph_hi = (NL == NPHASE) ? li + 1 : ((li + 1) * NPHASE) / NL;
        hipLaunchKernelGGL(yoco_fwd, dim3(grid), dim3(NTHREADS), LDS_BYTES, stream, a);
    }
}
```

```cpp
#include <hip/hip_runtime.h>
#include <cstdio>
#include <cstdint>
namespace pg8 {
#define PG8_LAS __attribute__((address_space(3)))
typedef unsigned short bf16_t;
typedef short bf16x8 __attribute__((ext_vector_type(8)));
typedef float f32x4 __attribute__((ext_vector_type(4)));
typedef unsigned u32x4 __attribute__((ext_vector_type(4)));
constexpr int BM = 256, BK = 64, HALF = 128, HTB = HALF * BK * 2  , STAGE_BYTES = 8 * HTB, NXCD = 8, WGM = 8;

__host__ __device__ __forceinline__ int lds_byte(int r, int c) { const int st = (r >> 4) * 2 + (c >> 5), rr = r & 15, cc = c & 31, ob = rr * 64 + cc * 2; return st * 1024 + (ob ^ (((ob >> 9) & 1) << 5)); }
__host__ __device__ __forceinline__ void stage_rc(int b, int& R, int& C) { const int st = b / 1024, sb = b % 1024, swz = sb ^ (((sb >> 9) & 1) << 5); R = (st >> 1) * 16 + swz / 64; C = (st & 1) * 32 + (swz % 64) / 2; }
__host__ __device__ __forceinline__ int perm32(int rho) { const int n = rho >> 4, i = rho & 15; return 8 * (i >> 2) + 4 * n + (i & 3); }

struct Unit { int pm, pn; };
struct Gemm { const bf16_t* A; const bf16_t* Bt; int M, N, K; };

struct StaticOrder {
    int nM, nN, nwg, G, c;
    __host__ __device__ void init(int M, int N, int G_, int c_) { nM = M / BM; nN = N / BM; nwg = nM * nN; G = G_; c = c_; }
    __host__ __device__ bool next(int i, Unit& u) const {
        const long L = (long)i * G + c; if (L >= nwg) return false;
        int wgid = (int)L; { const int q = nwg / NXCD, r = nwg % NXCD, xcd = wgid % NXCD, off = wgid / NXCD; wgid = (xcd < r ? xcd * (q + 1) : r * (q + 1) + (xcd - r) * q) + off; }
        const int nig = WGM * nN, gid = wgid / nig, fm = gid * WGM, gsz = (nM - fm) < WGM ? (nM - fm) : WGM;
        u.pm = fm + ((wgid % nig) % gsz); u.pn = (wgid % nig) / gsz; return true;
    }
    __device__ __forceinline__ void a_ready(const Unit&) const {}
    __device__ __forceinline__ void done(const Unit&) const {}
};
__device__ __forceinline__ unsigned cvt_pk_bf16(float lo, float hi) { unsigned r; asm volatile("v_cvt_pk_bf16_f32 %0, %1, %2" : "=v"(r) : "v"(lo), "v"(hi)); return r; }
typedef float f32x2 __attribute__((ext_vector_type(2)));
__device__ __forceinline__ f32x2 gelu_pk(f32x2 v) {
    const f32x2 av = __builtin_elementwise_abs(v), d = av * 0.2316418882f + 1.0f;
    f32x2 t; t.x = __builtin_amdgcn_rcpf(d.x); t.y = __builtin_amdgcn_rcpf(d.y);
    f32x2 q = t * 0.5307027145f + (-0.7265760135f); q = q * t + 0.7107068705f; q = q * t + (-0.142248368f); q = q * t + 0.127414796f; q = q * t;
    const f32x2 s = (v * v) * (-0.72134752044f);
    f32x2 e; e.x = __builtin_amdgcn_exp2f(s.x); e.y = __builtin_amdgcn_exp2f(s.y);
    const f32x2 m = v * (q * e), r = v - m;
    f32x2 o; o.x = v.x < 0.f ? m.x : r.x; o.y = v.y < 0.f ? m.y : r.y; return o;
}
template <class Epi, class Sched, bool STAMP = false>
__device__ __forceinline__ void gemm_phase(PG8_LAS unsigned char* lds, const Gemm g, const Sched& S, const Epi& E, unsigned long long* stamps, const int tid) {
    const int wid = __builtin_amdgcn_readfirstlane(tid >> 6), lane = tid & 63, wr = wid >> 2, wc = wid & 3, fr = lane & 15, fq = lane >> 4;
    const int K = g.K, nt = K / BK;
    int ts_lo = 0, ts_hi = 0, nts = 0; const unsigned long long rt_entry = STAMP ? (unsigned long long)wall_clock64() : 0ull;
#define PG8_STAMP() do { if (STAMP && wid == 0 && nts < 64) { const unsigned long long _c = (unsigned long long)clock64(); \
        ts_lo = (lane == nts) ? (int)(unsigned)_c : ts_lo; ts_hi = (lane == nts) ? (int)(unsigned)(_c >> 32) : ts_hi; ++nts; } } while (0)
    PG8_STAMP();
    unsigned voffA[2], voffB[2];
#pragma unroll
    for (int i = 0; i < 2; ++i) { int R, C; stage_rc(tid * 16 + i * 8192, R, C); const int Rb = Epi::PERM ? ((R & ~31) + perm32(R & 31)) : R;
        voffA[i] = (unsigned)(R * K + C) * 2u; voffB[i] = (unsigned)(Rb * K + C) * 2u; }
    const size_t kstep = (size_t)(BK * 2);
    const size_t hstep = (size_t)HALF * K * 2;
    const size_t tstep = 2 * hstep;
    const unsigned ldsw = (unsigned)wid * 1024u;
    const int aoff = lds_byte(wr * 64 + fr, fq * 8), boff = lds_byte(wc * 32 + fr, fq * 8);
#define PG8_SA(b, h) (((b) * 2 + (h)) * HTB)
#define PG8_SB(b, h) ((4 + (b) * 2 + (h)) * HTB)
#define PG8_STAGE(bufoff, gbase, voff) do { _Pragma("unroll") for (int _i = 0; _i < 2; ++_i) \
        __builtin_amdgcn_global_load_lds((const unsigned*)((const char*)(gbase) + (voff)[_i]), (PG8_LAS unsigned*)(lds + (bufoff) + ldsw + _i * 8192), 16, 0, 0); } while (0)
#define PG8_LDA(dst, b, h) do { _Pragma("unroll") for (int m = 0; m < 4; ++m) _Pragma("unroll") for (int k = 0; k < 2; ++k) dst[m][k] = *(const PG8_LAS bf16x8*)(lds + PG8_SA(b, h) + aoff + m * 2048 + k * 1024); } while (0)
#define PG8_LDB(dst, b, h) do { _Pragma("unroll") for (int n = 0; n < 2; ++n) _Pragma("unroll") for (int k = 0; k < 2; ++k) dst[n][k] = *(const PG8_LAS bf16x8*)(lds + PG8_SB(b, h) + boff + n * 2048 + k * 1024); } while (0)
#define PG8_MMA(ai, bj, At, Bt) do { __builtin_amdgcn_s_setprio(1); _Pragma("unroll") for (int m = 0; m < 4; ++m) _Pragma("unroll") for (int n = 0; n < 2; ++n) _Pragma("unroll") for (int k = 0; k < 2; ++k) \
        acc[ai][bj][m][n] = __builtin_amdgcn_mfma_f32_16x16x32_bf16(Bt[n][k], At[m][k], acc[ai][bj][m][n], 0, 0, 0); __builtin_amdgcn_s_setprio(0); } while (0)
#define PG8_WAIT_V(n) asm volatile("s_waitcnt vmcnt(" #n ")" ::: "memory")
#define PG8_WAIT_L(n) asm volatile("s_waitcnt lgkmcnt(" #n ")" ::: "memory")
#define PG8_BAR __builtin_amdgcn_s_barrier()
#define PG8_SCHED __builtin_amdgcn_sched_barrier(0)
    Unit cur, nxt; int ui = 0;
    if (!S.next(0, cur)) return;
    f32x4 acc[2][2][4][2];
#pragma unroll
    for (int a = 0; a < 2; ++a)
#pragma unroll
        for (int b = 0; b < 2; ++b)
#pragma unroll
            for (int m = 0; m < 4; ++m)
#pragma unroll
                for (int n = 0; n < 2; ++n) acc[a][b][m][n] = (f32x4){0.f, 0.f, 0.f, 0.f};
    bf16x8 At[4][2], B0[2][2], B1[2][2];
    const char* cA = (const char*)g.A + (size_t)cur.pm * tstep; const char* cB = (const char*)g.Bt + (size_t)cur.pn * tstep;
    S.a_ready(cur);
    PG8_STAGE(PG8_SB(0, 0), cB, voffB); PG8_STAGE(PG8_SA(0, 0), cA, voffA); PG8_STAGE(PG8_SB(0, 1), cB + hstep, voffB); PG8_STAGE(PG8_SA(0, 1), cA + hstep, voffA);
    if (wr == 1) PG8_BAR;
    PG8_WAIT_V(4); PG8_BAR;
    PG8_STAGE(PG8_SB(1, 0), cB + kstep, voffB); PG8_STAGE(PG8_SA(1, 0), cA + kstep, voffA); PG8_STAGE(PG8_SB(1, 1), cB + hstep + kstep, voffB);
    PG8_WAIT_V(6); PG8_BAR;
    PG8_STAMP();
    for (;;) {
        const bool has_next = S.next(ui + 1, nxt);
        const char* nA = has_next ? (const char*)g.A + (size_t)nxt.pm * tstep : cA; const char* nB = has_next ? (const char*)g.Bt + (size_t)nxt.pn * tstep : cB;
        for (int t = 0; t < nt; t += 2) {
            const bool last = (t == nt - 2);
            const char* a1 = cA + (size_t)(t + 1) * kstep;
            const char* a2 = last ? nA : cA + (size_t)(t + 2) * kstep; const char* b2 = last ? nB : cB + (size_t)(t + 2) * kstep;
            const char* a3 = a2 + kstep; const char* b3 = b2 + kstep;
            if (last && has_next) S.a_ready(nxt);
            PG8_LDB(B0, 0, 0); PG8_SCHED; PG8_LDA(At, 0, 0); PG8_STAGE(PG8_SA(1, 1), a1 + hstep, voffA);
            PG8_WAIT_L(8); PG8_BAR; PG8_WAIT_L(0); PG8_MMA(0, 0, At, B0); PG8_BAR; PG8_SCHED;
            PG8_LDB(B1, 0, 1); PG8_STAGE(PG8_SB(0, 0), b2, voffB);
            PG8_BAR; PG8_WAIT_L(0); PG8_MMA(0, 1, At, B1); PG8_BAR;
            PG8_LDA(At, 0, 1); PG8_STAGE(PG8_SA(0, 0), a2, voffA);
            PG8_BAR; PG8_WAIT_L(0); PG8_MMA(1, 0, At, B0); PG8_BAR; PG8_SCHED;
            PG8_STAGE(PG8_SB(0, 1), b2 + hstep, voffB);
            PG8_WAIT_V(6); PG8_BAR; PG8_MMA(1, 1, At, B1); PG8_BAR;
            PG8_LDB(B0, 1, 0); PG8_SCHED; PG8_LDA(At, 1, 0); PG8_STAGE(PG8_SA(0, 1), a2 + hstep, voffA);
            PG8_WAIT_L(8); PG8_BAR; PG8_WAIT_L(0); PG8_MMA(0, 0, At, B0); PG8_BAR; PG8_SCHED;
            PG8_LDB(B1, 1, 1); PG8_STAGE(PG8_SB(1, 0), b3, voffB);
            PG8_BAR; PG8_WAIT_L(0); PG8_MMA(0, 1, At, B1); PG8_BAR;
            PG8_LDA(At, 1, 1); PG8_STAGE(PG8_SA(1, 0), a3, voffA);
            PG8_BAR; PG8_WAIT_L(0); PG8_MMA(1, 0, At, B0); PG8_BAR; PG8_SCHED;
            PG8_STAGE(PG8_SB(1, 1), b3 + hstep, voffB);
            PG8_WAIT_V(6); PG8_BAR; PG8_MMA(1, 1, At, B1); PG8_BAR;
        }
        PG8_STAMP();
        if constexpr (!Epi::AFTER_DRAIN) { E(acc, cur, wr, wc, fr, fq); S.done(cur); }
        PG8_STAMP();
        if (!has_next) break;
#pragma unroll
        for (int a = 0; a < 2; ++a)
#pragma unroll
            for (int b = 0; b < 2; ++b)
#pragma unroll
                for (int m = 0; m < 4; ++m)
#pragma unroll
                    for (int n = 0; n < 2; ++n) acc[a][b][m][n] = (f32x4){0.f, 0.f, 0.f, 0.f};
        cur = nxt; cA = nA; cB = nB; ++ui;
    }
    PG8_WAIT_V(0);
    if (wr == 0) PG8_BAR;
    PG8_BAR;
    if constexpr (Epi::AFTER_DRAIN) { E.fused(acc, cur, wr, wc, fr, fq, lds, wid, lane); S.done(cur); }
    PG8_STAMP();
    if (STAMP && wid == 0) { stamps[lane] = lane < nts ? (((unsigned long long)(unsigned)ts_hi << 32) | (unsigned)ts_lo) : 0ull;
        if (lane == 62) stamps[62] = rt_entry; if (lane == 63) stamps[63] = (unsigned long long)wall_clock64(); }
#undef PG8_STAMP
#undef PG8_SA
#undef PG8_SB
#undef PG8_STAGE
#undef PG8_LDA
#undef PG8_LDB
#undef PG8_MMA
#undef PG8_WAIT_V
#undef PG8_WAIT_L
#undef PG8_BAR
#undef PG8_SCHED
}
}

namespace mk {
using pg8::bf16_t; using pg8::f32x4; using pg8::u32x4; using pg8::Unit; using pg8::cvt_pk_bf16;
#define LAS __attribute__((address_space(3)))
typedef float f32x2 __attribute__((ext_vector_type(2)));
typedef unsigned u32x2 __attribute__((ext_vector_type(2)));

#ifndef MK_N_LAUNCHES
#define MK_N_LAUNCHES 1
#endif
constexpr int NPHASE = 18;
constexpr int NB = 8, SEQ = 2048, D = 1024, T = NB * SEQ, NMEM = 256, SGW = 768, NSG = 12, HD = 64, CH = 128;
constexpr int NEXP = 16, LISTCAP = 16384;
constexpr float ALPHA = 1.41421356237f;
constexpr float LN_EPS = 1e-5f, ATT_SCALE = 0.125f;
constexpr int NWAVES = 8, NTHREADS = 512;

constexpr size_t MiB = 1u << 20;
constexpr size_t WS_CTL = 0, CTL_ZERO_BYTES = 1 * MiB;
constexpr size_t WS_TOKE = 1 * MiB, WS_TOKP = WS_TOKE + 128 * 1024, WS_TOKG = WS_TOKP + 128 * 1024;
constexpr size_t WS_LIST = 2 * MiB, WS_LSE = 3 * MiB;
constexpr size_t WS_MKV = 8 * MiB, WS_MEMB = 12 * MiB;
constexpr size_t WS_BT_INA = 18 * MiB, WS_BT_OUTA = 22 * MiB, WS_BT_B = 24 * MiB, WS_BT_OUTB = 29 * MiB, WS_BT_MEM = 30 * MiB;
constexpr size_t WS_WGU = 32 * MiB, WS_WD = 160 * MiB;
constexpr size_t WS_A = 224 * MiB;
constexpr size_t WS_U = WS_A, WS_GV = WS_A + 24 * MiB, WS_QM0 = WS_A + 48 * MiB;
constexpr size_t WS_K = WS_A, WS_V = WS_A + 24 * MiB, WS_Q = WS_A + 48 * MiB, WS_QM1 = WS_A + 72 * MiB;
constexpr size_t WS_ACT = WS_A;
constexpr size_t WS_XB = 304 * MiB;
constexpr size_t WS_C = 336 * MiB;
constexpr size_t WS_CAT = WS_C, WS_OG = WS_C, WS_CAT2 = WS_C + 24 * MiB;
constexpr size_t WS_Y = 376 * MiB;
constexpr size_t WS_YD = 336 * MiB;
constexpr size_t WS_X1B = 440 * MiB;
constexpr size_t WS_END = 472 * MiB;
constexpr int CW_TMO = 0, CW_BAR = 4096, CW_CNT = 16384;
constexpr int LDS_MISC = 131072;
constexpr int LDS_BYTES = 147456;

#define LDS_WAIT() asm volatile("s_waitcnt lgkmcnt(0)" ::: "memory")
#define VM_WAIT() asm volatile("s_waitcnt vmcnt(0)" ::: "memory")
__device__ __forceinline__ unsigned f2bf(float f) { unsigned u = __builtin_bit_cast(unsigned, f); return (u + 0x7fffu + ((u >> 16) & 1u)) >> 16; }
__device__ __forceinline__ unsigned pk2(float lo, float hi) { return f2bf(lo) | (f2bf(hi) << 16); }
__device__ __forceinline__ float bflo(unsigned w) { return __uint_as_float(w << 16); }
__device__ __forceinline__ float bfhi(unsigned w) { return __uint_as_float(w & 0xffff0000u); }
__device__ __forceinline__ float bf1(bf16_t v) { return __uint_as_float(((unsigned)v) << 16); }
__device__ __forceinline__ float wave_sum(float v) {
#pragma unroll
    for (int o = 1; o < 64; o <<= 1) v += __shfl_xor(v, o);
    return v;
}
__device__ __forceinline__ float wave_max(float v) {
#pragma unroll
    for (int o = 1; o < 64; o <<= 1) v = fmaxf(v, __shfl_xor(v, o));
    return v;
}

#define XB_TMO      128
#define XB_XCNT(j)  (256  + 64 * (j))
#define XB_XSUB(j)  (1280 + 64 * (j))
#define XB_XGEN(j)  (2304 + 64 * (j))
#define XB_TOP      3328
#define XB_TOPGEN   3392
#define XCD_BAR_WORDS 3456
#define XB_SPIN_CAP (1u << 18)
__device__ __forceinline__ unsigned xb_ld(unsigned* p)              { return __hip_atomic_load(p, __ATOMIC_RELAXED, __HIP_MEMORY_SCOPE_AGENT); }
__device__ __forceinline__ unsigned xb_add(unsigned* p, unsigned v) { return __hip_atomic_fetch_add(p, v, __ATOMIC_RELAXED, __HIP_MEMORY_SCOPE_AGENT); }
__device__ __forceinline__ unsigned xb_xcc_id() { return (unsigned)__builtin_amdgcn_s_getreg((3 << 11) | 20) & 0xFu; }
#define XB_SPIN(cond, bar) do { unsigned _sp = 0; while (cond) { __builtin_amdgcn_s_sleep(1); \
    if ((++_sp & 255u) == 0u) { if (xb_ld(&(bar)[XB_TMO])) break; if (_sp > XB_SPIN_CAP) { atomicAdd(&(bar)[XB_TMO], 1u); break; } } } } while (0)
struct XcdBarrier { unsigned* bar; unsigned x; volatile LAS unsigned* st; };
__device__ __forceinline__ XcdBarrier xcd_barrier_post(unsigned* bar, volatile LAS unsigned* st) {
    XcdBarrier b; b.bar = bar; b.x = xb_xcc_id(); b.st = st;
    if (threadIdx.x == 0) (void)xb_add(&bar[XB_XCNT(b.x)], 1u);
    return b;
}
__device__ __forceinline__ void xcd_barrier_complete(unsigned* bar, unsigned x, unsigned& nloc, unsigned& nx) {
    const unsigned G = gridDim.x * gridDim.y * gridDim.z;
    unsigned sum, cnt, mine, sp = 0u;
    for (;;) {
        sum = 0u; cnt = 0u; mine = 0u;
#pragma unroll
        for (unsigned j = 0; j < 16; ++j) { const unsigned c = xb_ld(&bar[XB_XCNT(j)]); sum += c; cnt += (c > 0u) ? 1u : 0u; mine = (j == x) ? c : mine; }
        if (sum == G) break;
        __builtin_amdgcn_s_sleep(1);
        if ((++sp & 255u) == 0u) { if (xb_ld(&bar[XB_TMO])) break; if (sp > XB_SPIN_CAP) { atomicAdd(&bar[XB_TMO], 1u); break; } }
    }
    nloc = mine > 0u ? mine : 1u; nx = cnt > 0u ? cnt : 1u;
}
__device__ __forceinline__ void xcd_barrier(const XcdBarrier& b) {
    asm volatile("s_waitcnt vmcnt(0)" ::: "memory");
    __syncthreads();
    if (threadIdx.x == 0) {
        unsigned* bar = b.bar;
        __builtin_amdgcn_s_waitcnt(0);
        unsigned nloc = b.st[0], nx = b.st[1];
        if (nloc == 0u) { xcd_barrier_complete(bar, b.x, nloc, nx); b.st[0] = nloc; b.st[1] = nx; }
        const unsigned old = xb_add(&bar[XB_XSUB(b.x)], 1u);
        const unsigned gen = old / nloc;
        if (old + 1u == (gen + 1u) * nloc) {
            __builtin_amdgcn_fence(__ATOMIC_RELEASE, "agent");
            asm volatile("s_waitcnt vmcnt(0)" ::: "memory");
            const unsigned og = xb_add(&bar[XB_TOP], 1u);
            const unsigned tg = og / nx;
            if (og + 1u == (tg + 1u) * nx) xb_add(&bar[XB_TOPGEN], 1u);
            else XB_SPIN(xb_ld(&bar[XB_TOPGEN]) == tg, bar);
            __builtin_amdgcn_fence(__ATOMIC_ACQUIRE, "agent");
            xb_add(&bar[XB_XGEN(b.x)], 1u);
            asm volatile("s_waitcnt vmcnt(0)" ::: "memory");
        } else {
            XB_SPIN(xb_ld(&bar[XB_XGEN(b.x)]) == gen, bar);
            __builtin_amdgcn_fence(__ATOMIC_ACQUIRE, "agent");
            asm volatile("s_waitcnt vmcnt(0)" ::: "memory");
        }
    }
    __syncthreads();
}


struct EpiProjA {
    static constexpr bool PERM = true, AFTER_DRAIN = false;
    bf16_t *u, *gv, *qm;
    __device__ __forceinline__ void operator()(const f32x4 (&acc)[2][2][4][2], const Unit& un, int wr, int wc, int fr, int fq) const {
        const int row0 = un.pm * 256 + wr * 64 + fr;
        bf16_t* base; int ldc, colt; bool act; float sc = 1.f;
        if (un.pn < 3) { base = u; ldc = SGW; colt = un.pn * 256; act = true; }
        else if (un.pn < 6) { base = gv; ldc = SGW; colt = (un.pn - 3) * 256; act = true; }
        else { base = qm; ldc = 256; colt = 0; act = false; sc = ATT_SCALE; }
        const int col0 = colt + wc * 32 + 8 * fq;
#pragma unroll
        for (int ai = 0; ai < 2; ++ai)
#pragma unroll
            for (int m = 0; m < 4; ++m) { bf16_t* rowp = base + (size_t)(row0 + ai * 128 + m * 16) * ldc + col0;
#pragma unroll
                for (int bj = 0; bj < 2; ++bj) { f32x4 v0 = acc[ai][bj][m][0], v1 = acc[ai][bj][m][1];
                    if (act) { pg8::f32x2 a = pg8::gelu_pk((pg8::f32x2){v0[0], v0[1]}), b = pg8::gelu_pk((pg8::f32x2){v0[2], v0[3]}), c = pg8::gelu_pk((pg8::f32x2){v1[0], v1[1]}), d = pg8::gelu_pk((pg8::f32x2){v1[2], v1[3]});
                        v0 = (f32x4){a.x, a.y, b.x, b.y}; v1 = (f32x4){c.x, c.y, d.x, d.y}; }
                    v0 = v0 * sc; v1 = v1 * sc;
                    u32x4 w; w.x = cvt_pk_bf16(v0[0], v0[1]); w.y = cvt_pk_bf16(v0[2], v0[3]); w.z = cvt_pk_bf16(v1[0], v1[1]); w.w = cvt_pk_bf16(v1[2], v1[3]);
                    *(u32x4*)(rowp + bj * 128) = w; } }
    }
};
struct EpiProjB {
    static constexpr bool PERM = true, AFTER_DRAIN = false;
    bf16_t *k, *v, *q, *qm;
    __device__ __forceinline__ void operator()(const f32x4 (&acc)[2][2][4][2], const Unit& un, int wr, int wc, int fr, int fq) const {
        const int row0 = un.pm * 256 + wr * 64 + fr;
        bf16_t* base; int ldc, colt; float sc = 1.f;
        if (un.pn < 3) { base = k; ldc = SGW; colt = un.pn * 256; }
        else if (un.pn < 6) { base = v; ldc = SGW; colt = (un.pn - 3) * 256; }
        else if (un.pn < 9) { base = q; ldc = SGW; colt = (un.pn - 6) * 256; sc = ATT_SCALE; }
        else { base = qm; ldc = 256; colt = 0; sc = ATT_SCALE; }
        const int col0 = colt + wc * 32 + 8 * fq;
#pragma unroll
        for (int ai = 0; ai < 2; ++ai)
#pragma unroll
            for (int m = 0; m < 4; ++m) { bf16_t* rowp = base + (size_t)(row0 + ai * 128 + m * 16) * ldc + col0;
#pragma unroll
                for (int bj = 0; bj < 2; ++bj) { f32x4 v0 = acc[ai][bj][m][0] * sc, v1 = acc[ai][bj][m][1] * sc;
                    u32x4 w; w.x = cvt_pk_bf16(v0[0], v0[1]); w.y = cvt_pk_bf16(v0[2], v0[3]); w.z = cvt_pk_bf16(v1[0], v1[1]); w.w = cvt_pk_bf16(v1[2], v1[3]);
                    *(u32x4*)(rowp + bj * 128) = w; } }
    }
};
struct EpiPlain {
    static constexpr bool PERM = true, AFTER_DRAIN = false;
    bf16_t* O; int ldc, ntn;
    __device__ __forceinline__ void operator()(const f32x4 (&acc)[2][2][4][2], const Unit& un, int wr, int wc, int fr, int fq) const {
        const int row0 = un.pm * 256 + wr * 64 + fr;
        const int col0 = (un.pn % ntn) * 256 + wc * 32 + 8 * fq;
#pragma unroll
        for (int ai = 0; ai < 2; ++ai)
#pragma unroll
            for (int m = 0; m < 4; ++m) { bf16_t* rowp = O + (size_t)(row0 + ai * 128 + m * 16) * ldc + col0;
#pragma unroll
                for (int bj = 0; bj < 2; ++bj) { const f32x4 v0 = acc[ai][bj][m][0], v1 = acc[ai][bj][m][1];
                    u32x4 w; w.x = cvt_pk_bf16(v0[0], v0[1]); w.y = cvt_pk_bf16(v0[2], v0[3]); w.z = cvt_pk_bf16(v1[0], v1[1]); w.w = cvt_pk_bf16(v1[2], v1[3]);
                    *(u32x4*)(rowp + bj * 128) = w; } }
    }
};
struct EpiSwiGLU {
    static constexpr bool PERM = true, AFTER_DRAIN = false;
    bf16_t* O;
    __device__ __forceinline__ void operator()(const f32x4 (&acc)[2][2][4][2], const Unit& un, int wr, int wc, int fr, int fq) const {
        const int row0 = un.pm * 256 + wr * 64 + fr;
        const int col0 = (un.pn & 7) * 128 + wc * 32 + 8 * fq;
#pragma unroll
        for (int ai = 0; ai < 2; ++ai)
#pragma unroll
            for (int m = 0; m < 4; ++m) { bf16_t* rowp = O + (size_t)(row0 + ai * 128 + m * 16) * 1024 + col0;
                float r[8];
#pragma unroll
                for (int n = 0; n < 2; ++n)
#pragma unroll
                    for (int j = 0; j < 4; ++j) { const float g = acc[ai][0][m][n][j], up = acc[ai][1][m][n][j];
                        r[n * 4 + j] = g * __builtin_amdgcn_rcpf(1.0f + __expf(-g)) * up; }
                u32x4 w; w.x = cvt_pk_bf16(r[0], r[1]); w.y = cvt_pk_bf16(r[2], r[3]); w.z = cvt_pk_bf16(r[4], r[5]); w.w = cvt_pk_bf16(r[6], r[7]);
                *(u32x4*)rowp = w; }
    }
};
template <bool RB> struct EpiResid {
    static constexpr bool PERM = false, AFTER_DRAIN = false;
    const void* res; float* Y;
    __device__ __forceinline__ void operator()(const f32x4 (&acc)[2][2][4][2], const Unit& un, int wr, int wc, int fr, int fq) const {
        const int row0 = un.pm * 256 + wr * 64 + fr, col0 = un.pn * 256 + wc * 32 + 4 * fq;
#pragma unroll
        for (int ai = 0; ai < 2; ++ai)
#pragma unroll
            for (int m = 0; m < 4; ++m) { const size_t off = (size_t)(row0 + ai * 128 + m * 16) * D + col0;
#pragma unroll
                for (int bj = 0; bj < 2; ++bj)
#pragma unroll
                    for (int n = 0; n < 2; ++n) { const size_t o = off + bj * 128 + n * 16; f32x4 r;
                        if (RB) { const u32x2 w = *(const u32x2*)((const bf16_t*)res + o); r = (f32x4){bflo(w.x), bfhi(w.x), bflo(w.y), bfhi(w.y)}; }
                        else r = *(const f32x4*)((const float*)res + o);
                        *(f32x4*)(Y + o) = r * ALPHA + acc[ai][bj][m][n]; } }
    }
};
struct SmallOrder {
    int nN, nwg, c;
    __device__ bool next(int i, Unit& u) const { if (i != 0 || c < 0 || c >= nwg) return false; u.pm = c / nN; u.pn = c % nN; return true; }
    __device__ __forceinline__ void a_ready(const Unit&) const {}
    __device__ __forceinline__ void done(const Unit&) const {}
};
struct MoeOrder {
    const LAS int* tb;
    int ntn, G, c;
    __device__ bool next(int i, Unit& u) const {
        const int L = i * G + c; if (L >= tb[16] * ntn) return false;
        int e = 0;
#pragma unroll
        for (int j = 1; j < 16; ++j) e += (L >= tb[j] * ntn) ? 1 : 0;
        const int r = L - tb[e] * ntn, te = tb[e + 1] - tb[e];
        u.pm = tb[e] + r % te; u.pn = e * ntn + r / te; return true;
    }
    __device__ __forceinline__ void a_ready(const Unit&) const {}
    __device__ __forceinline__ void done(const Unit&) const {}
};

struct Args { const float* in[23]; float* out; unsigned char* ws; int ph_lo, ph_hi; };
struct Ctx {
    unsigned char* ws; LAS unsigned char* lds;
    int tid, lane, wave, gw, NGW, G, bid;
};
__device__ __forceinline__ unsigned char* launder(unsigned char* p) { asm volatile("" : "+s"(p)); return p; }
__device__ __forceinline__ int launder_v(int v) { asm volatile("" : "+v"(v)); return v; }

__device__ __forceinline__ void tr_item(const float* W, int K, int N, bf16_t* WT, int grp, int gstride, int roff, LAS float* scr, int item, int lane) {
    const int nblk = N / 32, kb = item / nblk, nb = item % nblk, k0 = 64 * kb, n0 = 32 * nb;
#pragma unroll 8
    for (int i = 0; i < 32; ++i) { const int kk = 2 * i + (lane >> 5); scr[kk * 33 + (lane & 31)] = W[(size_t)(k0 + kk) * N + n0 + (lane & 31)]; }
    LDS_WAIT(); asm volatile("" ::: "memory");
    const int c = lane & 7;
#pragma unroll
    for (int j = 0; j < 4; ++j) { const int n = (lane >> 3) + 8 * j; const LAS float* s = scr + (8 * c) * 33 + n;
        const int nn = n0 + n, drow = (nn / grp) * gstride + (nn % grp) + roff;
        u32x4 o; o.x = pk2(s[0 * 33], s[1 * 33]); o.y = pk2(s[2 * 33], s[3 * 33]); o.z = pk2(s[4 * 33], s[5 * 33]); o.w = pk2(s[6 * 33], s[7 * 33]);
        *(u32x4*)(WT + (size_t)drow * K + k0 + 8 * c) = o; }
    LDS_WAIT(); asm volatile("" ::: "memory");
}
__device__ __forceinline__ void p0_prologue(const Ctx& C, const Args& A) {
    LAS float* scr = (LAS float*)(C.lds + C.wave * 16384);
    unsigned char* ws = C.ws;
    constexpr int I_MOE = 16 * 32;
    constexpr int N_MOE = 32 * I_MOE;
    constexpr int I_INA = 16 * 56, I_SQ = 512, I_KV = 16 * 24, I_OUTB = 8 * 32, I_MEM = 16 * 8;
    constexpr int NITEMS = 3 * N_MOE + I_INA + I_SQ + I_SQ + 2 * I_KV + I_OUTB + 4 * I_MEM;
    for (int it = C.gw; it < NITEMS; it += C.NGW) {
        int r = it;
        if (r < N_MOE) { const int m = r / I_MOE; tr_item(A.in[20] + (size_t)m * 1048576, 1024, 1024, (bf16_t*)(ws + WS_WGU) + (size_t)m * 2097152, 128, 256, 0, scr, r % I_MOE, C.lane); continue; } r -= N_MOE;
        if (r < N_MOE) { const int m = r / I_MOE; tr_item(A.in[21] + (size_t)m * 1048576, 1024, 1024, (bf16_t*)(ws + WS_WGU) + (size_t)m * 2097152, 128, 256, 128, scr, r % I_MOE, C.lane); continue; } r -= N_MOE;
        if (r < N_MOE) { const int m = r / I_MOE; tr_item(A.in[22] + (size_t)m * 1048576, 1024, 1024, (bf16_t*)(ws + WS_WD) + (size_t)m * 1048576, 1024, 1024, 0, scr, r % I_MOE, C.lane); continue; } r -= N_MOE;
        if (r < I_INA) { tr_item(A.in[2], 1024, 1792, (bf16_t*)(ws + WS_BT_INA), 1792, 1792, 0, scr, r, C.lane); continue; } r -= I_INA;
        if (r < I_SQ) { tr_item(A.in[3], 1024, 1024, (bf16_t*)(ws + WS_BT_OUTA), 1024, 1024, 0, scr, r, C.lane); continue; } r -= I_SQ;
        if (r < I_SQ) { tr_item(A.in[8], 1024, 1024, (bf16_t*)(ws + WS_BT_B), 1024, 1024, 1536, scr, r, C.lane); continue; } r -= I_SQ;
        if (r < I_KV) { tr_item(A.in[10], 1024, 768, (bf16_t*)(ws + WS_BT_B), 768, 768, 0, scr, r, C.lane); continue; } r -= I_KV;
        if (r < I_KV) { tr_item(A.in[11], 1024, 768, (bf16_t*)(ws + WS_BT_B), 768, 768, 768, scr, r, C.lane); continue; } r -= I_KV;
        if (r < I_OUTB) { tr_item(A.in[9], 512, 1024, (bf16_t*)(ws + WS_BT_OUTB), 1024, 1024, 0, scr, r, C.lane); continue; } r -= I_OUTB;
        { const int m = r / I_MEM, layer = m & 1, isv = m >> 1;
          tr_item(A.in[isv ? 13 : 12] + (size_t)layer * 262144, 1024, 256, (bf16_t*)(ws + WS_BT_MEM), 256, 256, layer * 512 + isv * 256, scr, r % I_MEM, C.lane); }
    }
    const int gt = C.bid * NTHREADS + C.tid, NT = C.G * NTHREADS;
    for (int i = gt; i < T * D / 8; i += NT) { const f32x4 a = *(const f32x4*)(A.in[0] + (size_t)i * 8), b = *(const f32x4*)(A.in[0] + (size_t)i * 8 + 4);
        u32x4 w; w.x = pk2(a[0], a[1]); w.y = pk2(a[2], a[3]); w.z = pk2(b[0], b[1]); w.w = pk2(b[2], b[3]); *(u32x4*)((bf16_t*)(ws + WS_XB) + (size_t)i * 8) = w; }
    for (int i = gt; i < NB * NMEM * D / 8; i += NT) { const f32x4 a = *(const f32x4*)(A.in[1] + (size_t)i * 8), b = *(const f32x4*)(A.in[1] + (size_t)i * 8 + 4);
        u32x4 w; w.x = pk2(a[0], a[1]); w.y = pk2(a[2], a[3]); w.z = pk2(b[0], b[1]); w.w = pk2(b[2], b[3]); *(u32x4*)((bf16_t*)(ws + WS_MEMB) + (size_t)i * 8) = w; }
}

__device__ __forceinline__ void sg_scalar(const Ctx& C, const Args& A) {
    const bf16_t* U = (const bf16_t*)(C.ws + WS_U); const bf16_t* GV = (const bf16_t*)(C.ws + WS_GV); bf16_t* CAT = (bf16_t*)(C.ws + WS_CAT);
    const float* lng = A.in[4]; const float* lnb = A.in[5]; const float* sgw = A.in[6]; const float* sgb = A.in[7];
    LAS float* stat = (LAS float*)C.lds;
    LAS float* gvn = (LAS float*)(C.lds + 1024);
    LAS float* Wl = (LAS float*)(C.lds + 1024 + 128 * 65 * 4);
    for (int unit = C.bid; unit < NB * 16; unit += C.G) {
        const int tb = unit * 128;
        for (int rr = 0; rr < 16; ++rr) { const int row = C.wave * 16 + rr; const bf16_t* p = GV + (size_t)(tb + row) * SGW + 4 * C.lane;
            float s = 0.f, ss = 0.f;
#pragma unroll
            for (int j = 0; j < 3; ++j) { const u32x2 w = *(const u32x2*)(p + 256 * j); const float a = bflo(w.x), b = bfhi(w.x), c = bflo(w.y), d = bfhi(w.y);
                s += (a + b) + (c + d); ss += (a * a + b * b) + (c * c + d * d); }
            s = wave_sum(s); ss = wave_sum(ss);
            const float mean = s * (1.f / SGW), var = ss * (1.f / SGW) - mean * mean;
            if (C.lane == 0) { stat[row * 2] = mean; stat[row * 2 + 1] = 1.0f / sqrtf(var + LN_EPS); } }
        __syncthreads();
        const int p = C.tid >> 2, d0 = (C.tid & 3) * 16;
        for (int g = 0; g < NSG; ++g) {
            { const bf16_t* src = GV + (size_t)(tb + p) * SGW + g * 64 + d0; const float mean = stat[p * 2], rstd = stat[p * 2 + 1];
#pragma unroll
              for (int h = 0; h < 2; ++h) { const u32x4 w = *(const u32x4*)(src + 8 * h); const unsigned ww[4] = {w.x, w.y, w.z, w.w};
#pragma unroll
                  for (int j = 0; j < 4; ++j) { const int d = d0 + 8 * h + 2 * j; const int cc = g * 64 + d;
                      gvn[p * 65 + d] = (bflo(ww[j]) - mean) * rstd * lng[cc] + lnb[cc];
                      gvn[p * 65 + d + 1] = (bfhi(ww[j]) - mean) * rstd * lng[cc + 1] + lnb[cc + 1]; } } }
            { const int q0 = (C.tid & 3) * 32; const float* src = sgw + ((size_t)g * 128 + p) * 128 + q0;
#pragma unroll
              for (int j = 0; j < 8; ++j) { const f32x4 w = *(const f32x4*)(src + 4 * j);
#pragma unroll
                  for (int t = 0; t < 4; ++t) { const int q = q0 + 4 * j + t; Wl[p * 129 + q] = (q <= p) ? w[t] : 0.f; } } }
            __syncthreads();
            float acc[16];
#pragma unroll
            for (int j = 0; j < 16; ++j) acc[j] = 0.f;
            for (int q = 0; q <= p; ++q) { const float w = Wl[p * 129 + q];
#pragma unroll
                for (int j = 0; j < 16; ++j) acc[j] += w * gvn[q * 65 + d0 + j]; }
            const float bs = sgb[g * 128 + p];
            const bf16_t* us = U + (size_t)(tb + p) * SGW + g * 64 + d0; bf16_t* dst = CAT + (size_t)(tb + p) * D + g * 64 + d0;
#pragma unroll
            for (int h = 0; h < 2; ++h) { const u32x4 w = *(const u32x4*)(us + 8 * h); const unsigned ww[4] = {w.x, w.y, w.z, w.w}; unsigned o[4];
#pragma unroll
                for (int j = 0; j < 4; ++j) o[j] = pk2(bflo(ww[j]) * (acc[8 * h + 2 * j] + bs), bfhi(ww[j]) * (acc[8 * h + 2 * j + 1] + bs));
                *(u32x4*)(dst + 8 * h) = (u32x4){o[0], o[1], o[2], o[3]}; }
            __syncthreads();
        }
    }
}

__device__ __forceinline__ void memattn_scalar(const Ctx& C, const bf16_t* QM, const bf16_t* MKV, int ck, int cv, bf16_t* OUT, int ldo, int coff) {
    for (int it = C.gw; it < T * 4; it += C.NGW) {
        const int tok = it >> 2, h = it & 3, b = tok / SEQ;
        float q[64];
        { const bf16_t* qp = QM + (size_t)tok * 256 + h * 64;
#pragma unroll
          for (int j = 0; j < 8; ++j) { const u32x4 w = *(const u32x4*)(qp + 8 * j);
              q[8 * j] = bflo(w.x); q[8 * j + 1] = bfhi(w.x); q[8 * j + 2] = bflo(w.y); q[8 * j + 3] = bfhi(w.y); q[8 * j + 4] = bflo(w.z); q[8 * j + 5] = bfhi(w.z); q[8 * j + 6] = bflo(w.w); q[8 * j + 7] = bfhi(w.w); } }
        float s[4];
#pragma unroll
        for (int jj = 0; jj < 4; ++jj) { const bf16_t* kp = MKV + (size_t)(b * NMEM + jj * 64 + C.lane) * 1024 + ck + h * 64; float a = 0.f;
#pragma unroll
            for (int j = 0; j < 8; ++j) { const u32x4 w = *(const u32x4*)(kp + 8 * j);
                a += q[8 * j] * bflo(w.x) + q[8 * j + 1] * bfhi(w.x) + q[8 * j + 2] * bflo(w.y) + q[8 * j + 3] * bfhi(w.y) + q[8 * j + 4] * bflo(w.z) + q[8 * j + 5] * bfhi(w.z) + q[8 * j + 6] * bflo(w.w) + q[8 * j + 7] * bfhi(w.w); }
            s[jj] = a; }
        const float mx = wave_max(fmaxf(fmaxf(s[0], s[1]), fmaxf(s[2], s[3])));
        float l = 0.f;
#pragma unroll
        for (int jj = 0; jj < 4; ++jj) { s[jj] = __expf(s[jj] - mx); l += s[jj]; }
        l = wave_sum(l);
        float acc = 0.f;
#pragma unroll
        for (int jj = 0; jj < 4; ++jj) { const bf16_t* vp = MKV + (size_t)(b * NMEM + jj * 64) * 1024 + cv + h * 64 + C.lane;
            for (int mm = 0; mm < 64; ++mm) acc += __shfl(s[jj], mm) * bf1(vp[(size_t)mm * 1024]); }
        OUT[(size_t)tok * ldo + coff + h * 64 + C.lane] = (bf16_t)f2bf(acc / l);
    }
}

__device__ __forceinline__ void dilattn_scalar(const Ctx& C, const Args& A) {
    const bf16_t* Q = (const bf16_t*)(C.ws + WS_Q); const bf16_t* K = (const bf16_t*)(C.ws + WS_K); const bf16_t* V = (const bf16_t*)(C.ws + WS_V);
    bf16_t* OG = (bf16_t*)(C.ws + WS_OG); float* LSE = (float*)(C.ws + WS_LSE);
    for (int it = C.gw; it < T * 12; it += C.NGW) {
        const int tok = it / 12, h = it % 12, g = h >> 2, dl = (g == 0) ? 1 : (g == 1 ? 4 : 16);
        const int t = tok % SEQ, i = t / dl;
        const float slope = exp2f(-(float)(h + 1) * (8.0f / 12.0f));
        float q[64];
        { const bf16_t* qp = Q + (size_t)tok * SGW + h * 64;
#pragma unroll
          for (int j = 0; j < 8; ++j) { const u32x4 w = *(const u32x4*)(qp + 8 * j);
              q[8 * j] = bflo(w.x); q[8 * j + 1] = bfhi(w.x); q[8 * j + 2] = bflo(w.y); q[8 * j + 3] = bfhi(w.y); q[8 * j + 4] = bflo(w.z); q[8 * j + 5] = bfhi(w.z); q[8 * j + 6] = bflo(w.w); q[8 * j + 7] = bfhi(w.w); } }
        float s[3];
#pragma unroll
        for (int jj = 0; jj < 3; ++jj) { const int j0 = jj * 64 + C.lane; const bool valid = (jj < 2 || C.lane == 0) && (j0 <= i);
            const int jc = valid ? j0 : 0;
            const bf16_t* kp = K + (size_t)(tok - jc * dl) * SGW + h * 64; float a = 0.f;
#pragma unroll
            for (int j = 0; j < 8; ++j) { const u32x4 w = *(const u32x4*)(kp + 8 * j);
                a += q[8 * j] * bflo(w.x) + q[8 * j + 1] * bfhi(w.x) + q[8 * j + 2] * bflo(w.y) + q[8 * j + 3] * bfhi(w.y) + q[8 * j + 4] * bflo(w.z) + q[8 * j + 5] * bfhi(w.z) + q[8 * j + 6] * bflo(w.w) + q[8 * j + 7] * bfhi(w.w); }
            s[jj] = valid ? (a - slope * (float)(dl * j0)) : -INFINITY; }
        const float mx = wave_max(fmaxf(fmaxf(s[0], s[1]), s[2]));
        float l = 0.f;
#pragma unroll
        for (int jj = 0; jj < 3; ++jj) { s[jj] = __expf(s[jj] - mx); l += s[jj]; }
        l = wave_sum(l);
        float acc = 0.f;
#pragma unroll
        for (int jj = 0; jj < 3; ++jj) { const int nm = (jj < 2) ? 64 : 1;
            for (int mm = 0; mm < nm; ++mm) { const int j0 = jj * 64 + mm; const int jc = (j0 <= i) ? j0 : 0;
                acc += __shfl(s[jj], mm) * bf1(V[(size_t)(tok - jc * dl) * SGW + h * 64 + C.lane]); } }
        OG[(size_t)tok * SGW + h * 64 + C.lane] = (bf16_t)f2bf(acc / l);
        if (C.lane == 0) LSE[tok * 12 + h] = mx + __logf(l);
    }
}
typedef short bf16x8 __attribute__((ext_vector_type(8)));
typedef short s16x4 __attribute__((ext_vector_type(4)));
constexpr int AT_KS = 144, AT_VS = 160, AT_ROWS = 272, AT_K_OFF = 0, AT_V_OFF = AT_ROWS * AT_KS;
static_assert(AT_V_OFF % 16 == 0 && AT_V_OFF + AT_ROWS * AT_VS <= 131072, "attention LDS map");

template <int NKB, bool DIL>
__device__ __forceinline__ void attn_compute(LAS unsigned char* lds, int lane, int krow0, bf16x8 qf0, bf16x8 qf1, float sdl, int ikw, f32x4 (&o)[4], float& mx, float& lsum) {
    const int n = lane & 15, g = lane >> 4;
    const LAS unsigned char* Kb = lds + AT_K_OFF + (krow0 + n) * AT_KS + g * 16;
    f32x4 sc[NKB];
#pragma unroll
    for (int kb = 0; kb < NKB; ++kb) {
        const bf16x8 k0 = *(const LAS bf16x8*)(Kb + kb * 16 * AT_KS), k1 = *(const LAS bf16x8*)(Kb + kb * 16 * AT_KS + 64);
        f32x4 a = (f32x4){0.f, 0.f, 0.f, 0.f};
        a = __builtin_amdgcn_mfma_f32_16x16x32_bf16(k0, qf0, a, 0, 0, 0);
        a = __builtin_amdgcn_mfma_f32_16x16x32_bf16(k1, qf1, a, 0, 0, 0);
        sc[kb] = a;
    }
    float m = -INFINITY;
#pragma unroll
    for (int kb = 0; kb < NKB; ++kb)
#pragma unroll
        for (int r = 0; r < 4; ++r) {
            if (DIL) { const int off = 16 * kb + 4 * g + r, rel = 144 + n - off; const bool valid = (rel >= 0) && (rel <= 128) && (ikw + off >= 0);
                sc[kb][r] = valid ? (sc[kb][r] - sdl * (float)rel) : -INFINITY; }
            m = fmaxf(m, sc[kb][r]); }
    m = fmaxf(m, __shfl_xor(m, 16)); m = fmaxf(m, __shfl_xor(m, 32));
    float l = 0.f;
#pragma unroll
    for (int kb = 0; kb < NKB; ++kb)
#pragma unroll
        for (int r = 0; r < 4; ++r) { sc[kb][r] = __expf(sc[kb][r] - m); l += sc[kb][r]; }
    l += __shfl_xor(l, 16); l += __shfl_xor(l, 32);
    mx = m; lsum = l;
    const LAS unsigned char* Vb = lds + AT_V_OFF + (krow0 + 4 * g + (n >> 2)) * AT_VS + (n & 3) * 8;
#pragma unroll
    for (int db = 0; db < 4; ++db) o[db] = (f32x4){0.f, 0.f, 0.f, 0.f};
#pragma unroll
    for (int kk = 0; kk < NKB / 2; ++kk) {
        union { bf16x8 v; unsigned u[4]; } pf;
        pf.u[0] = cvt_pk_bf16(sc[2 * kk][0], sc[2 * kk][1]); pf.u[1] = cvt_pk_bf16(sc[2 * kk][2], sc[2 * kk][3]);
        pf.u[2] = cvt_pk_bf16(sc[2 * kk + 1][0], sc[2 * kk + 1][1]); pf.u[3] = cvt_pk_bf16(sc[2 * kk + 1][2], sc[2 * kk + 1][3]);
#pragma unroll
        for (int db = 0; db < 4; ++db) {
            const s16x4 v0 = __builtin_amdgcn_ds_read_tr16_b64_v4i16((LAS s16x4*)(Vb + (2 * kk) * 16 * AT_VS + db * 32));
            const s16x4 v1 = __builtin_amdgcn_ds_read_tr16_b64_v4i16((LAS s16x4*)(Vb + (2 * kk + 1) * 16 * AT_VS + db * 32));
            const bf16x8 vf = __builtin_shufflevector(v0, v1, 0, 1, 2, 3, 4, 5, 6, 7);
            o[db] = __builtin_amdgcn_mfma_f32_16x16x32_bf16(vf, pf.v, o[db], 0, 0, 0);
        }
    }
}

__device__ __forceinline__ void memattn_mfma(const Ctx& C, const bf16_t* QM, const bf16_t* MKV, int ck, int cv, bf16_t* OUT, int ldo, int coff) {
    const int n = C.lane & 15, g = C.lane >> 4;
    for (int unit = C.bid; unit < NB * 4 * 16; unit += C.G) {
        const int b = unit >> 6, h = (unit >> 4) & 3, qt = unit & 15;
        __syncthreads();
#pragma unroll
        for (int it = 0; it < 4; ++it) { const int row = it * 64 + (C.tid >> 3), c = C.tid & 7;
            const bf16_t* src = MKV + (size_t)(b * NMEM + row) * 1024 + h * 64 + c * 8;
            const u32x4 kv = *(const u32x4*)(src + ck), vv = *(const u32x4*)(src + cv);
            *(LAS u32x4*)(C.lds + AT_K_OFF + row * AT_KS + c * 16) = kv; *(LAS u32x4*)(C.lds + AT_V_OFF + row * AT_VS + c * 16) = vv; }
        const int tok = b * SEQ + qt * 128 + C.wave * 16 + n;
        const bf16_t* qp = QM + (size_t)tok * 256 + h * 64 + g * 8;
        const bf16x8 qf0 = *(const bf16x8*)qp, qf1 = *(const bf16x8*)(qp + 32);
        __syncthreads();
        f32x4 o[4]; float mx, l;
        attn_compute<16, false>(C.lds, C.lane, 0, qf0, qf1, 0.f, 0, o, mx, l);
        const float inv = 1.0f / l;
#pragma unroll
        for (int db = 0; db < 4; ++db)
            *(u32x2*)(OUT + (size_t)tok * ldo + coff + h * 64 + 16 * db + 4 * g) = (u32x2){cvt_pk_bf16(o[db][0] * inv, o[db][1] * inv), cvt_pk_bf16(o[db][2] * inv, o[db][3] * inv)};
    }
}
__device__ __forceinline__ void dilattn_mfma(const Ctx& C) {
    const bf16_t* Q = (const bf16_t*)(C.ws + WS_Q); const bf16_t* K = (const bf16_t*)(C.ws + WS_K); const bf16_t* V = (const bf16_t*)(C.ws + WS_V);
    bf16_t* OG = (bf16_t*)(C.ws + WS_OG); float* LSE = (float*)(C.ws + WS_LSE);
    const int n = C.lane & 15, g = C.lane >> 4;
    for (int unit = C.bid; unit < 12 * 128; unit += C.G) {
        const int h = unit >> 7, rem = unit & 127, b = rem >> 4, x = rem & 15, grp = h >> 2;
        const int dl = (grp == 0) ? 1 : (grp == 1 ? 4 : 16), ntile = 16 / dl, r = x / ntile, I0 = (x % ntile) * 128;
        const float sdl = exp2f(-(float)(h + 1) * (8.0f / 12.0f)) * (float)dl;
        __syncthreads();
        for (int idx = C.tid; idx < AT_ROWS * 8; idx += NTHREADS) { const int row = idx >> 3, c = idx & 7; const int ik = I0 - 144 + row;
            u32x4 kv = (u32x4){0u, 0u, 0u, 0u}, vv = (u32x4){0u, 0u, 0u, 0u};
            if (ik >= 0) { const size_t off = (size_t)(b * SEQ + ik * dl + r) * SGW + h * 64 + c * 8; kv = *(const u32x4*)(K + off); vv = *(const u32x4*)(V + off); }
            *(LAS u32x4*)(C.lds + AT_K_OFF + row * AT_KS + c * 16) = kv; *(LAS u32x4*)(C.lds + AT_V_OFF + row * AT_VS + c * 16) = vv; }
        const int iq = I0 + C.wave * 16 + n, tok = b * SEQ + iq * dl + r;
        const bf16_t* qp = Q + (size_t)tok * SGW + h * 64 + g * 8;
        const bf16x8 qf0 = *(const bf16x8*)qp, qf1 = *(const bf16x8*)(qp + 32);
        __syncthreads();
        f32x4 o[4]; float mx, l;
        attn_compute<10, true>(C.lds, C.lane, C.wave * 16, qf0, qf1, sdl, I0 + C.wave * 16 - 144, o, mx, l);
        const float inv = 1.0f / l;
#pragma unroll
        for (int db = 0; db < 4; ++db)
            *(u32x2*)(OG + (size_t)tok * SGW + h * 64 + 16 * db + 4 * g) = (u32x2){cvt_pk_bf16(o[db][0] * inv, o[db][1] * inv), cvt_pk_bf16(o[db][2] * inv, o[db][3] * inv)};
        if (g == 0) LSE[tok * 12 + h] = mx + __logf(l);
    }
}
__device__ __forceinline__ void dil_merge(const Ctx& C, const Args& A) {
    const bf16_t* OG = (const bf16_t*)(C.ws + WS_OG); const float* LSE = (const float*)(C.ws + WS_LSE); bf16_t* CAT2 = (bf16_t*)(C.ws + WS_CAT2);
    const int gt = C.bid * NTHREADS + C.tid, NT = C.G * NTHREADS;
    for (int it = gt; it < T * 32; it += NT) {
        const int tok = it >> 5, j = (it >> 3) & 3, c8 = it & 7;
        const float l0 = LSE[tok * 12 + j], l1 = LSE[tok * 12 + 4 + j], l2 = LSE[tok * 12 + 8 + j];
        const float mx = fmaxf(l0, fmaxf(l1, l2));
        float w0 = __expf(l0 - mx), w1 = __expf(l1 - mx), w2 = __expf(l2 - mx); const float inv = 1.0f / (w0 + w1 + w2); w0 *= inv; w1 *= inv; w2 *= inv;
        const u32x4 a = *(const u32x4*)(OG + (size_t)tok * SGW + j * 64 + c8 * 8), b = *(const u32x4*)(OG + (size_t)tok * SGW + (4 + j) * 64 + c8 * 8), c = *(const u32x4*)(OG + (size_t)tok * SGW + (8 + j) * 64 + c8 * 8);
        u32x4 o;
        o.x = pk2(w0 * bflo(a.x) + w1 * bflo(b.x) + w2 * bflo(c.x), w0 * bfhi(a.x) + w1 * bfhi(b.x) + w2 * bfhi(c.x));
        o.y = pk2(w0 * bflo(a.y) + w1 * bflo(b.y) + w2 * bflo(c.y), w0 * bfhi(a.y) + w1 * bfhi(b.y) + w2 * bfhi(c.y));
        o.z = pk2(w0 * bflo(a.z) + w1 * bflo(b.z) + w2 * bflo(c.z), w0 * bfhi(a.z) + w1 * bfhi(b.z) + w2 * bfhi(c.z));
        o.w = pk2(w0 * bflo(a.w) + w1 * bflo(b.w) + w2 * bflo(c.w), w0 * bfhi(a.w) + w1 * bfhi(b.w) + w2 * bfhi(c.w));
        *(u32x4*)(CAT2 + (size_t)tok * 512 + j * 64 + c8 * 8) = o;
    }
}

__device__ __forceinline__ void ln_route(const Ctx& C, const Args& A, int layer) {
    const float* Y = (const float*)(C.ws + WS_Y); bf16_t* X1B = (bf16_t*)(C.ws + WS_X1B);
    const float* lg = A.in[14] + layer * D; const float* lb = A.in[15] + layer * D; const float* wr = A.in[18]; const float* br = A.in[19];
    unsigned* cnt = (unsigned*)(C.ws + WS_CTL) + CW_CNT + layer * 16 * 64;
    int* tokE = (int*)(C.ws + WS_TOKE); int* tokP = (int*)(C.ws + WS_TOKP); float* tokG = (float*)(C.ws + WS_TOKG); int* list = (int*)(C.ws + WS_LIST);
    LAS float* wl = (LAS float*)C.lds;
    __syncthreads();
    for (int i = C.tid; i < 1024 * 16 / 4; i += NTHREADS) *(LAS f32x4*)(wl + 4 * i) = *(const f32x4*)(wr + 4 * i);
    __syncthreads();
    const LAS float* wlane = wl + C.lane * 64;
    for (int tok = C.gw; tok < T; tok += C.NGW) {
        f32x4 v[4]; float s = 0.f;
#pragma unroll
        for (int j = 0; j < 4; ++j) { v[j] = *(const f32x4*)(Y + (size_t)tok * D + 4 * C.lane + 256 * j); s += (v[j][0] + v[j][1]) + (v[j][2] + v[j][3]); }
        const float mean = wave_sum(s) * (1.f / D); float s2 = 0.f;
#pragma unroll
        for (int j = 0; j < 4; ++j) { v[j] = v[j] - mean; s2 += (v[j][0] * v[j][0] + v[j][1] * v[j][1]) + (v[j][2] * v[j][2] + v[j][3] * v[j][3]); }
        const float rstd = 1.0f / sqrtf(wave_sum(s2) * (1.f / D) + LN_EPS);
        float lgt[16];
#pragma unroll
        for (int e = 0; e < 16; ++e) lgt[e] = 0.f;
#pragma unroll
        for (int j = 0; j < 4; ++j) { const int col = 4 * C.lane + 256 * j; const f32x4 g4 = *(const f32x4*)(lg + col), b4 = *(const f32x4*)(lb + col);
            v[j] = v[j] * rstd * g4 + b4;
            *(u32x2*)(X1B + (size_t)tok * D + col) = (u32x2){pk2(v[j][0], v[j][1]), pk2(v[j][2], v[j][3])};
#pragma unroll
            for (int c = 0; c < 4; ++c) { const float xv = v[j][c];
#pragma unroll
                for (int e4 = 0; e4 < 4; ++e4) { const f32x4 w = *(const LAS f32x4*)(wlane + (256 * j + c) * 16 + 4 * e4);
                    lgt[4 * e4] += xv * w[0]; lgt[4 * e4 + 1] += xv * w[1]; lgt[4 * e4 + 2] += xv * w[2]; lgt[4 * e4 + 3] += xv * w[3]; } } }
        float mx = -INFINITY;
#pragma unroll
        for (int e = 0; e < 16; ++e) { lgt[e] = wave_sum(lgt[e]); mx = fmaxf(mx, lgt[e]); }
        float sum = 0.f;
#pragma unroll
        for (int e = 0; e < 16; ++e) { lgt[e] = __expf(lgt[e] - mx); sum += lgt[e]; }
        const float inv = 1.0f / sum; float sel[16];
#pragma unroll
        for (int e = 0; e < 16; ++e) { lgt[e] *= inv; sel[e] = lgt[e] + br[e]; }
        float gs[4];
#pragma unroll
        for (int g = 0; g < 4; ++g) { const float a = sel[4 * g], b = sel[4 * g + 1], c = sel[4 * g + 2], d = sel[4 * g + 3];
            gs[g] = fmaxf(fmaxf(fmaxf(a + b, a + c), fmaxf(a + d, b + c)), fmaxf(b + d, c + d)); }
        int gi = 0; float bsc = gs[0];
#pragma unroll
        for (int g = 1; g < 4; ++g) if (gs[g] > bsc) { bsc = gs[g]; gi = g; }
        float sg[4], pg[4];
#pragma unroll
        for (int k = 0; k < 4; ++k) { sg[k] = gi == 0 ? sel[k] : (gi == 1 ? sel[4 + k] : (gi == 2 ? sel[8 + k] : sel[12 + k])); pg[k] = gi == 0 ? lgt[k] : (gi == 1 ? lgt[4 + k] : (gi == 2 ? lgt[8 + k] : lgt[12 + k])); }
        int i1 = 0; float b1 = sg[0], p1 = pg[0];
#pragma unroll
        for (int k = 1; k < 4; ++k) if (sg[k] > b1) { b1 = sg[k]; i1 = k; p1 = pg[k]; }
        int i2 = -1; float b2 = -INFINITY, p2 = 0.f;
#pragma unroll
        for (int k = 0; k < 4; ++k) if (k != i1 && sg[k] > b2) { b2 = sg[k]; i2 = k; p2 = pg[k]; }
        if (C.lane == 0) {
            const int e1 = gi * 4 + i1, e2 = gi * 4 + i2; const float gsum = p1 + p2;
            const unsigned pos1 = __hip_atomic_fetch_add(cnt + e1 * 64, 1u, __ATOMIC_RELAXED, __HIP_MEMORY_SCOPE_AGENT);
            const unsigned pos2 = __hip_atomic_fetch_add(cnt + e2 * 64, 1u, __ATOMIC_RELAXED, __HIP_MEMORY_SCOPE_AGENT);
            list[e1 * LISTCAP + pos1] = tok; list[e2 * LISTCAP + pos2] = tok;
            tokE[tok * 2] = e1; tokE[tok * 2 + 1] = e2; tokP[tok * 2] = (int)pos1; tokP[tok * 2 + 1] = (int)pos2; tokG[tok * 2] = p1 / gsum; tokG[tok * 2 + 1] = p2 / gsum;
        }
    }
}
__device__ __forceinline__ void moe_prefix(const Ctx& C, int layer) {
    LAS int* mi = (LAS int*)(C.lds + LDS_MISC);
    unsigned* cnt = (unsigned*)(C.ws + WS_CTL) + CW_CNT + layer * 16 * 64;
    __syncthreads();
    if (C.tid < 16) mi[17 + C.tid] = (int)__hip_atomic_load(cnt + C.tid * 64, __ATOMIC_RELAXED, __HIP_MEMORY_SCOPE_AGENT);
    __syncthreads();
    if (C.tid == 0) { int a = 0; for (int e = 0; e < 16; ++e) { mi[e] = a; a += (mi[17 + e] + 255) >> 8; } mi[16] = a; }
    __syncthreads();
}
__device__ __forceinline__ void moe_gather(const Ctx& C, const Args& A) {
    const LAS int* mi = (const LAS int*)(C.lds + LDS_MISC);
    const bf16_t* X1B = (const bf16_t*)(C.ws + WS_X1B); bf16_t* XG = (bf16_t*)(C.ws + WS_YD); const int* list = (const int*)(C.ws + WS_LIST);
    const int nrows = mi[16] * 256;
    for (int R = C.gw; R < nrows; R += C.NGW) {
        const int tile = R >> 8; int e = 0;
#pragma unroll
        for (int j = 1; j < 16; ++j) e += (tile >= mi[j]) ? 1 : 0;
        int pos = R - mi[e] * 256; const int cn = mi[17 + e]; if (pos >= cn) pos = cn - 1;
        const int tok = list[e * LISTCAP + pos];
        const u32x4* src = (const u32x4*)(X1B + (size_t)tok * D); u32x4* dst = (u32x4*)(XG + (size_t)R * D);
        dst[C.lane] = src[C.lane]; dst[C.lane + 64] = src[C.lane + 64];
    }
}
__device__ __forceinline__ void combine_ln2(const Ctx& C, const Args& A, int layer) {
    const LAS int* mi = (const LAS int*)(C.lds + LDS_MISC);
    const bf16_t* X1B = (const bf16_t*)(C.ws + WS_X1B); const bf16_t* YD = (const bf16_t*)(C.ws + WS_YD); bf16_t* X2B = (bf16_t*)(C.ws + WS_XB);
    const int* tokE = (const int*)(C.ws + WS_TOKE); const int* tokP = (const int*)(C.ws + WS_TOKP); const float* tokG = (const float*)(C.ws + WS_TOKG);
    const float* lg = A.in[16] + layer * D; const float* lb = A.in[17] + layer * D;
    for (int tok = C.gw; tok < T; tok += C.NGW) {
        const int e0 = tokE[tok * 2], e1 = tokE[tok * 2 + 1]; const float g0 = tokG[tok * 2], g1 = tokG[tok * 2 + 1];
        int tb0 = 0, tb1 = 0;
#pragma unroll
        for (int j = 0; j < 16; ++j) { const int t = mi[j]; tb0 = (e0 == j) ? t : tb0; tb1 = (e1 == j) ? t : tb1; }
        const size_t r0 = (size_t)tb0 * 256 + tokP[tok * 2], r1 = (size_t)tb1 * 256 + tokP[tok * 2 + 1];
        f32x4 v[4]; float s = 0.f;
#pragma unroll
        for (int j = 0; j < 4; ++j) { const int col = 4 * C.lane + 256 * j;
            const u32x2 a = *(const u32x2*)(X1B + (size_t)tok * D + col), y0 = *(const u32x2*)(YD + r0 * D + col), y1 = *(const u32x2*)(YD + r1 * D + col);
            v[j][0] = ALPHA * bflo(a.x) + (g0 * bflo(y0.x) + g1 * bflo(y1.x)); v[j][1] = ALPHA * bfhi(a.x) + (g0 * bfhi(y0.x) + g1 * bfhi(y1.x));
            v[j][2] = ALPHA * bflo(a.y) + (g0 * bflo(y0.y) + g1 * bflo(y1.y)); v[j][3] = ALPHA * bfhi(a.y) + (g0 * bfhi(y0.y) + g1 * bfhi(y1.y));
            s += (v[j][0] + v[j][1]) + (v[j][2] + v[j][3]); }
        const float mean = wave_sum(s) * (1.f / D); float s2 = 0.f;
#pragma unroll
        for (int j = 0; j < 4; ++j) { v[j] = v[j] - mean; s2 += (v[j][0] * v[j][0] + v[j][1] * v[j][1]) + (v[j][2] * v[j][2] + v[j][3] * v[j][3]); }
        const float rstd = 1.0f / sqrtf(wave_sum(s2) * (1.f / D) + LN_EPS);
#pragma unroll
        for (int j = 0; j < 4; ++j) { const int col = 4 * C.lane + 256 * j; const f32x4 g4 = *(const f32x4*)(lg + col), b4 = *(const f32x4*)(lb + col);
            const f32x4 o = v[j] * rstd * g4 + b4;
            if (layer == 0) *(u32x2*)(X2B + (size_t)tok * D + col) = (u32x2){pk2(o[0], o[1]), pk2(o[2], o[3])};
            else *(f32x4*)(A.out + (size_t)tok * D + col) = o; }
    }
}

__global__ void __launch_bounds__(NTHREADS, 2) yoco_fwd(Args args) {
    extern __shared__ __attribute__((aligned(16))) unsigned char lds_raw[];
    Ctx C;
    C.ws = args.ws; C.lds = (LAS unsigned char*)lds_raw;
    C.tid = threadIdx.x; C.lane = C.tid & 63; C.wave = __builtin_amdgcn_readfirstlane(C.tid >> 6);
    C.G = gridDim.x; C.bid = blockIdx.x; C.gw = C.bid * NWAVES + C.wave; C.NGW = C.G * NWAVES;
    unsigned char* ws = args.ws;
#define PHASE_WS() do { ws = launder(args.ws); C.ws = ws; C.tid = launder_v((int)threadIdx.x); C.lane = C.tid & 63; } while (0)
    volatile LAS unsigned* misc = (volatile LAS unsigned*)(C.lds + LDS_MISC);
    for (int u = C.tid; u < 64; u += NTHREADS) misc[u] = 0u;
    __syncthreads();
    XcdBarrier bar; bar.bar = (unsigned*)(ws + WS_CTL) + CW_BAR; bar.x = 0; bar.st = misc + 60;
    const int lo = args.ph_lo, hi = args.ph_hi;
    if (hi - lo > 1) bar = xcd_barrier_post((unsigned*)(ws + WS_CTL) + CW_BAR, misc + 60);
#define IN(k) (lo <= (k) && (k) < hi)
#define SEAM(k) do { if (IN(k) && IN((k) + 1)) xcd_barrier(bar); } while (0)

    if (IN(0)) { PHASE_WS(); p0_prologue(C, args); SEAM(0); }

    if (IN(1)) {
        PHASE_WS();
        { pg8::Gemm g{(const bf16_t*)(ws + WS_XB), (const bf16_t*)(ws + WS_BT_INA), T, 1792, D}; pg8::StaticOrder S; S.init(T, 1792, C.G, C.bid);
          EpiProjA E{(bf16_t*)(ws + WS_U), (bf16_t*)(ws + WS_GV), (bf16_t*)(ws + WS_QM0)};
          pg8::gemm_phase<EpiProjA, pg8::StaticOrder>(C.lds, g, S, E, nullptr, C.tid); }
        { pg8::Gemm g{(const bf16_t*)(ws + WS_MEMB), (const bf16_t*)(ws + WS_BT_MEM), NB * NMEM, 1024, D}; SmallOrder S{4, 32, C.bid - (C.G - 32)};
          EpiPlain E{(bf16_t*)(ws + WS_MKV), 1024, 4};
          pg8::gemm_phase<EpiPlain, SmallOrder>(C.lds, g, S, E, nullptr, C.tid); }
        SEAM(1);
    }
    if (IN(2)) {
        PHASE_WS();
        sg_scalar(C, args);
        memattn_mfma(C, (const bf16_t*)(ws + WS_QM0), (const bf16_t*)(ws + WS_MKV), 0, 256, (bf16_t*)(ws + WS_CAT), D, SGW);
        SEAM(2);
    }
    if (IN(3)) {
        PHASE_WS();
        pg8::Gemm g{(const bf16_t*)(ws + WS_CAT), (const bf16_t*)(ws + WS_BT_OUTA), T, D, D}; pg8::StaticOrder S; S.init(T, D, C.G, C.bid);
        EpiResid<false> E{(const void*)args.in[0], (float*)(ws + WS_Y)};
        pg8::gemm_phase<EpiResid<false>, pg8::StaticOrder>(C.lds, g, S, E, nullptr, C.tid);
        SEAM(3);
    }
#pragma unroll 1
    for (int layer = 0; layer < 2; ++layer) {
        const int pb = 4 + 9 * layer;
        if (IN(pb)) { PHASE_WS(); ln_route(C, args, layer); SEAM(pb); }
        if (IN(pb + 1)) { PHASE_WS(); moe_prefix(C, layer); moe_gather(C, args); SEAM(pb + 1); }
        if (IN(pb + 2)) {
            PHASE_WS();
            moe_prefix(C, layer);
            pg8::Gemm g{(const bf16_t*)(ws + WS_YD), (const bf16_t*)(ws + WS_WGU) + (size_t)layer * 16 * 2097152, 0, 0, D};
            MoeOrder S{(const LAS int*)(C.lds + LDS_MISC), 8, C.G, C.bid};
            EpiSwiGLU E{(bf16_t*)(ws + WS_ACT)};
            pg8::gemm_phase<EpiSwiGLU, MoeOrder>(C.lds, g, S, E, nullptr, C.tid);
            SEAM(pb + 2);
        }
        if (IN(pb + 3)) {
            PHASE_WS();
            moe_prefix(C, layer);
            pg8::Gemm g{(const bf16_t*)(ws + WS_ACT), (const bf16_t*)(ws + WS_WD) + (size_t)layer * 16 * 1048576, 0, 0, D};
            MoeOrder S{(const LAS int*)(C.lds + LDS_MISC), 4, C.G, C.bid};
            EpiPlain E{(bf16_t*)(ws + WS_YD), 1024, 4};
            pg8::gemm_phase<EpiPlain, MoeOrder>(C.lds, g, S, E, nullptr, C.tid);
            SEAM(pb + 3);
        }
        if (IN(pb + 4)) { PHASE_WS(); moe_prefix(C, layer); combine_ln2(C, args, layer); if (layer == 0) SEAM(pb + 4); }
        if (layer == 0) {
            if (IN(9)) {
                PHASE_WS();
                pg8::Gemm g{(const bf16_t*)(ws + WS_XB), (const bf16_t*)(ws + WS_BT_B), T, 2560, D}; pg8::StaticOrder S; S.init(T, 2560, C.G, C.bid);
                EpiProjB E{(bf16_t*)(ws + WS_K), (bf16_t*)(ws + WS_V), (bf16_t*)(ws + WS_Q), (bf16_t*)(ws + WS_QM1)};
                pg8::gemm_phase<EpiProjB, pg8::StaticOrder>(C.lds, g, S, E, nullptr, C.tid);
                SEAM(9);
            }
            if (IN(10)) {
                PHASE_WS();
                dilattn_mfma(C);
                memattn_mfma(C, (const bf16_t*)(ws + WS_QM1), (const bf16_t*)(ws + WS_MKV), 512, 768, (bf16_t*)(ws + WS_CAT2), 512, 256);
                SEAM(10);
            }
            if (IN(11)) { PHASE_WS(); dil_merge(C, args); SEAM(11); }
            if (IN(12)) {
                PHASE_WS();
                pg8::Gemm g{(const bf16_t*)(ws + WS_CAT2), (const bf16_t*)(ws + WS_BT_OUTB), T, D, 512}; pg8::StaticOrder S; S.init(T, D, C.G, C.bid);
                EpiResid<true> E{(const void*)(ws + WS_XB), (float*)(ws + WS_Y)};
                pg8::gemm_phase<EpiResid<true>, pg8::StaticOrder>(C.lds, g, S, E, nullptr, C.tid);
                SEAM(12);
            }
        }
    }
#undef IN
#undef SEAM
}
}

extern "C" void kernel_launch(void* const* d_in, const int* in_sizes, int n_in, void* d_out, int out_size, void* d_ws, size_t ws_size, hipStream_t stream) {
    using namespace mk;
    static int grid = 0;
    if (grid == 0) {
        if (n_in != 23 || out_size != T * D || ws_size < WS_END) { fprintf(stderr, "kernel_launch: unexpected shapes (n_in %d, out %d, ws %zu)\n", n_in, out_size, ws_size); grid = -1; return; }
        int dev = 0, cus = 0, per_cu = 0;
        if (hipGetDevice(&dev) != hipSuccess || hipDeviceGetAttribute(&cus, hipDeviceAttributeMultiprocessorCount, dev) != hipSuccess) { grid = -1; return; }
        if (hipFuncSetAttribute((const void*)yoco_fwd, hipFuncAttributeMaxDynamicSharedMemorySize, LDS_BYTES) != hipSuccess) { fprintf(stderr, "kernel_launch: hipFuncSetAttribute failed\n"); grid = -1; return; }
        if (hipOccupancyMaxActiveBlocksPerMultiprocessor(&per_cu, (const void*)yoco_fwd, NTHREADS, LDS_BYTES) != hipSuccess || per_cu < 1)
            fprintf(stderr, "kernel_launch: occupancy query reports %d workgroups per CU\n", per_cu);
        (void)hipGetLastError();
        grid = cus;
    }
    if (grid < 0) return;
    (void)hipMemsetAsync((char*)d_ws + WS_CTL, 0, CTL_ZERO_BYTES, stream);
    Args a{};
    for (int i = 0; i < 23; ++i) a.in[i] = (const float*)d_in[i];
    a.out = (float*)d_out; a.ws = (unsigned char*)d_ws;
    constexpr int NL = MK_N_LAUNCHES;
    for (int li = 0; li < NL; ++li) {
        a.ph_lo = (NL == NPHASE) ? li : (li * NPHASE) / NL; a.ph_hi = (NL == NPHASE) ? li + 1 : ((li + 1) * NPHASE) / NL;
        hipLaunchKernelGGL(yoco_fwd, dim3(grid), dim3(NTHREADS), LDS_BYTES, stream, a);
    }
}
```

```cpp
#include <hip/hip_runtime.h>
#include <cstdio>
#include <cstdint>
namespace pg8 {
#define PG8_LAS __attribute__((address_space(3)))
typedef unsigned short bf16_t;
typedef short bf16x8 __attribute__((ext_vector_type(8)));
typedef float f32x4 __attribute__((ext_vector_type(4)));
typedef unsigned u32x4 __attribute__((ext_vector_type(4)));
constexpr int BM = 256, BK = 64, HALF = 128, HTB = HALF * BK * 2  , STAGE_BYTES = 8 * HTB, NXCD = 8, WGM = 8;

__host__ __device__ __forceinline__ int lds_byte(int r, int c) { const int st = (r >> 4) * 2 + (c >> 5), rr = r & 15, cc = c & 31, ob = rr * 64 + cc * 2; return st * 1024 + (ob ^ (((ob >> 9) & 1) << 5)); }
__host__ __device__ __forceinline__ void stage_rc(int b, int& R, int& C) { const int st = b / 1024, sb = b % 1024, swz = sb ^ (((sb >> 9) & 1) << 5); R = (st >> 1) * 16 + swz / 64; C = (st & 1) * 32 + (swz % 64) / 2; }
__host__ __device__ __forceinline__ int perm32(int rho) { const int n = rho >> 4, i = rho & 15; return 8 * (i >> 2) + 4 * n + (i & 3); }

struct Unit { int pm, pn; };
struct Gemm { const bf16_t* A; const bf16_t* Bt; int M, N, K; };

struct StaticOrder {
    int nM, nN, nwg, G, c;
    __host__ __device__ void init(int M, int N, int G_, int c_) { nM = M / BM; nN = N / BM; nwg = nM * nN; G = G_; c = c_; }
    __host__ __device__ bool next(int i, Unit& u) const {
        const long L = (long)i * G + c; if (L >= nwg) return false;
        int wgid = (int)L; { const int q = nwg / NXCD, r = nwg % NXCD, xcd = wgid % NXCD, off = wgid / NXCD; wgid = (xcd < r ? xcd * (q + 1) : r * (q + 1) + (xcd - r) * q) + off; }
        const int nig = WGM * nN, gid = wgid / nig, fm = gid * WGM, gsz = (nM - fm) < WGM ? (nM - fm) : WGM;
        u.pm = fm + ((wgid % nig) % gsz); u.pn = (wgid % nig) / gsz; return true;
    }
    __device__ __forceinline__ void a_ready(const Unit&) const {}
    __device__ __forceinline__ void done(const Unit&) const {}
};
__device__ __forceinline__ unsigned cvt_pk_bf16(float lo, float hi) { unsigned r; asm volatile("v_cvt_pk_bf16_f32 %0, %1, %2" : "=v"(r) : "v"(lo), "v"(hi)); return r; }
typedef float f32x2 __attribute__((ext_vector_type(2)));
__device__ __forceinline__ f32x2 gelu_pk(f32x2 v) {
    const f32x2 av = __builtin_elementwise_abs(v), d = av * 0.2316418882f + 1.0f;
    f32x2 t; t.x = __builtin_amdgcn_rcpf(d.x); t.y = __builtin_amdgcn_rcpf(d.y);
    f32x2 q = t * 0.5307027145f + (-0.7265760135f); q = q * t + 0.7107068705f; q = q * t + (-0.142248368f); q = q * t + 0.127414796f; q = q * t;
    const f32x2 s = (v * v) * (-0.72134752044f);
    f32x2 e; e.x = __builtin_amdgcn_exp2f(s.x); e.y = __builtin_amdgcn_exp2f(s.y);
    const f32x2 m = v * (q * e), r = v - m;
    f32x2 o; o.x = v.x < 0.f ? m.x : r.x; o.y = v.y < 0.f ? m.y : r.y; return o;
}
template <class Epi, class Sched, bool STAMP = false>
__device__ __forceinline__ void gemm_phase(PG8_LAS unsigned char* lds, const Gemm g, const Sched& S, const Epi& E, unsigned long long* stamps, const int tid) {
    const int wid = __builtin_amdgcn_readfirstlane(tid >> 6), lane = tid & 63, wr = wid >> 2, wc = wid & 3, fr = lane & 15, fq = lane >> 4;
    const int K = g.K, nt = K / BK;
    int ts_lo = 0, ts_hi = 0, nts = 0; const unsigned long long rt_entry = STAMP ? (unsigned long long)wall_clock64() : 0ull;
#define PG8_STAMP() do { if (STAMP && wid == 0 && nts < 64) { const unsigned long long _c = (unsigned long long)clock64(); \
        ts_lo = (lane == nts) ? (int)(unsigned)_c : ts_lo; ts_hi = (lane == nts) ? (int)(unsigned)(_c >> 32) : ts_hi; ++nts; } } while (0)
    PG8_STAMP();
    unsigned voffA[2], voffB[2];
#pragma unroll
    for (int i = 0; i < 2; ++i) { int R, C; stage_rc(tid * 16 + i * 8192, R, C); const int Rb = Epi::PERM ? ((R & ~31) + perm32(R & 31)) : R;
        voffA[i] = (unsigned)(R * K + C) * 2u; voffB[i] = (unsigned)(Rb * K + C) * 2u; }
    const size_t kstep = (size_t)(BK * 2);
    const size_t hstep = (size_t)HALF * K * 2;
    const size_t tstep = 2 * hstep;
    const unsigned ldsw = (unsigned)wid * 1024u;
    const int aoff = lds_byte(wr * 64 + fr, fq * 8), boff = lds_byte(wc * 32 + fr, fq * 8);
#define PG8_SA(b, h) (((b) * 2 + (h)) * HTB)
#define PG8_SB(b, h) ((4 + (b) * 2 + (h)) * HTB)
#define PG8_STAGE(bufoff, gbase, voff) do { _Pragma("unroll") for (int _i = 0; _i < 2; ++_i) \
        __builtin_amdgcn_global_load_lds((const unsigned*)((const char*)(gbase) + (voff)[_i]), (PG8_LAS unsigned*)(lds + (bufoff) + ldsw + _i * 8192), 16, 0, 0); } while (0)
#define PG8_LDA(dst, b, h) do { _Pragma("unroll") for (int m = 0; m < 4; ++m) _Pragma("unroll") for (int k = 0; k < 2; ++k) dst[m][k] = *(const PG8_LAS bf16x8*)(lds + PG8_SA(b, h) + aoff + m * 2048 + k * 1024); } while (0)
#define PG8_LDB(dst, b, h) do { _Pragma("unroll") for (int n = 0; n < 2; ++n) _Pragma("unroll") for (int k = 0; k < 2; ++k) dst[n][k] = *(const PG8_LAS bf16x8*)(lds + PG8_SB(b, h) + boff + n * 2048 + k * 1024); } while (0)
#define PG8_MMA(ai, bj, At, Bt) do { __builtin_amdgcn_s_setprio(1); _Pragma("unroll") for (int m = 0; m < 4; ++m) _Pragma("unroll") for (int n = 0; n < 2; ++n) _Pragma("unroll") for (int k = 0; k < 2; ++k) \
        acc[ai][bj][m][n] = __builtin_amdgcn_mfma_f32_16x16x32_bf16(Bt[n][k], At[m][k], acc[ai][bj][m][n], 0, 0, 0); __builtin_amdgcn_s_setprio(0); } while (0)
#define PG8_WAIT_V(n) asm volatile("s_waitcnt vmcnt(" #n ")" ::: "memory")
#define PG8_WAIT_L(n) asm volatile("s_waitcnt lgkmcnt(" #n ")" ::: "memory")
#define PG8_BAR __builtin_amdgcn_s_barrier()
#define PG8_SCHED __builtin_amdgcn_sched_barrier(0)
    Unit cur, nxt; int ui = 0;
    if (!S.next(0, cur)) return;
    f32x4 acc[2][2][4][2];
#pragma unroll
    for (int a = 0; a < 2; ++a)
#pragma unroll
        for (int b = 0; b < 2; ++b)
#pragma unroll
            for (int m = 0; m < 4; ++m)
#pragma unroll
                for (int n = 0; n < 2; ++n) acc[a][b][m][n] = (f32x4){0.f, 0.f, 0.f, 0.f};
    bf16x8 At[4][2], B0[2][2], B1[2][2];
    const char* cA = (const char*)g.A + (size_t)cur.pm * tstep; const char* cB = (const char*)g.Bt + (size_t)cur.pn * tstep;
    S.a_ready(cur);
    PG8_STAGE(PG8_SB(0, 0), cB, voffB); PG8_STAGE(PG8_SA(0, 0), cA, voffA); PG8_STAGE(PG8_SB(0, 1), cB + hstep, voffB); PG8_STAGE(PG8_SA(0, 1), cA + hstep, voffA);
    if (wr == 1) PG8_BAR;
    PG8_WAIT_V(4); PG8_BAR;
    PG8_STAGE(PG8_SB(1, 0), cB + kstep, voffB); PG8_STAGE(PG8_SA(1, 0), cA + kstep, voffA); PG8_STAGE(PG8_SB(1, 1), cB + hstep + kstep, voffB);
    PG8_WAIT_V(6); PG8_BAR;
    PG8_STAMP();
    for (;;) {
        const bool has_next = S.next(ui + 1, nxt);
        const char* nA = has_next ? (const char*)g.A + (size_t)nxt.pm * tstep : cA; const char* nB = has_next ? (const char*)g.Bt + (size_t)nxt.pn * tstep : cB;
        for (int t = 0; t < nt; t += 2) {
            const bool last = (t == nt - 2);
            const char* a1 = cA + (size_t)(t + 1) * kstep;
            const char* a2 = last ? nA : cA + (size_t)(t + 2) * kstep; const char* b2 = last ? nB : cB + (size_t)(t + 2) * kstep;
            const char* a3 = a2 + kstep; const char* b3 = b2 + kstep;
            if (last && has_next) S.a_ready(nxt);
            PG8_LDB(B0, 0, 0); PG8_SCHED; PG8_LDA(At, 0, 0); PG8_STAGE(PG8_SA(1, 1), a1 + hstep, voffA);
            PG8_WAIT_L(8); PG8_BAR; PG8_WAIT_L(0); PG8_MMA(0, 0, At, B0); PG8_BAR; PG8_SCHED;
            PG8_LDB(B1, 0, 1); PG8_STAGE(PG8_SB(0, 0), b2, voffB);
            PG8_BAR; PG8_WAIT_L(0); PG8_MMA(0, 1, At, B1); PG8_BAR;
            PG8_LDA(At, 0, 1); PG8_STAGE(PG8_SA(0, 0), a2, voffA);
            PG8_BAR; PG8_WAIT_L(0); PG8_MMA(1, 0, At, B0); PG8_BAR; PG8_SCHED;
            PG8_STAGE(PG8_SB(0, 1), b2 + hstep, voffB);
            PG8_WAIT_V(6); PG8_BAR; PG8_MMA(1, 1, At, B1); PG8_BAR;
            PG8_LDB(B0, 1, 0); PG8_SCHED; PG8_LDA(At, 1, 0); PG8_STAGE(PG8_SA(0, 1), a2 + hstep, voffA);
            PG8_WAIT_L(8); PG8_BAR; PG8_WAIT_L(0); PG8_MMA(0, 0, At, B0); PG8_BAR; PG8_SCHED;
            PG8_LDB(B1, 1, 1); PG8_STAGE(PG8_SB(1, 0), b3, voffB);
            PG8_BAR; PG8_WAIT_L(0); PG8_MMA(0, 1, At, B1); PG8_BAR;
            PG8_LDA(At, 1, 1); PG8_STAGE(PG8_SA(1, 0), a3, voffA);
            PG8_BAR; PG8_WAIT_L(0); PG8_MMA(1, 0, At, B0); PG8_BAR; PG8_SCHED;
            PG8_STAGE(PG8_SB(1, 1), b3 + hstep, voffB);
            PG8_WAIT_V(6); PG8_BAR; PG8_MMA(1, 1, At, B1); PG8_BAR;
        }
        PG8_STAMP();
        if constexpr (!Epi::AFTER_DRAIN) { E(acc, cur, wr, wc, fr, fq); S.done(cur); }
        PG8_STAMP();
        if (!has_next) break;
#pragma unroll
        for (int a = 0; a < 2; ++a)
#pragma unroll
            for (int b = 0; b < 2; ++b)
#pragma unroll
                for (int m = 0; m < 4; ++m)
#pragma unroll
                    for (int n = 0; n < 2; ++n) acc[a][b][m][n] = (f32x4){0.f, 0.f, 0.f, 0.f};
        cur = nxt; cA = nA; cB = nB; ++ui;
    }
    PG8_WAIT_V(0);
    if (wr == 0) PG8_BAR;
    PG8_BAR;
    if constexpr (Epi::AFTER_DRAIN) { E.fused(acc, cur, wr, wc, fr, fq, lds, wid, lane); S.done(cur); }
    PG8_STAMP();
    if (STAMP && wid == 0) { stamps[lane] = lane < nts ? (((unsigned long long)(unsigned)ts_hi << 32) | (unsigned)ts_lo) : 0ull;
        if (lane == 62) stamps[62] = rt_entry; if (lane == 63) stamps[63] = (unsigned long long)wall_clock64(); }
#undef PG8_STAMP
#undef PG8_SA
#undef PG8_SB
#undef PG8_STAGE
#undef PG8_LDA
#undef PG8_LDB
#undef PG8_MMA
#undef PG8_WAIT_V
#undef PG8_WAIT_L
#undef PG8_BAR
#undef PG8_SCHED
}
}

namespace mk {
using pg8::bf16_t; using pg8::f32x4; using pg8::u32x4; using pg8::Unit; using pg8::cvt_pk_bf16;
#define LAS __attribute__((address_space(3)))
typedef float f32x2 __attribute__((ext_vector_type(2)));
typedef unsigned u32x2 __attribute__((ext_vector_type(2)));

#ifndef MK_N_LAUNCHES
#define MK_N_LAUNCHES 1
#endif
constexpr int NPHASE = 18;
constexpr int NB = 8, SEQ = 2048, D = 1024, T = NB * SEQ, NMEM = 256, SGW = 768, NSG = 12, HD = 64, CH = 128;
constexpr int NEXP = 16, LISTCAP = 16384;
constexpr float ALPHA = 1.41421356237f;
constexpr float LN_EPS = 1e-5f, ATT_SCALE = 0.125f;
constexpr int NWAVES = 8, NTHREADS = 512;

constexpr size_t MiB = 1u << 20;
constexpr size_t WS_CTL = 0, CTL_ZERO_BYTES = 1 * MiB;
constexpr size_t WS_TOKE = 1 * MiB, WS_TOKP = WS_TOKE + 128 * 1024, WS_TOKG = WS_TOKP + 128 * 1024;
constexpr size_t WS_LIST = 2 * MiB, WS_LSE = 3 * MiB, WS_SGWB = 4 * MiB;
constexpr size_t WS_MKV = 8 * MiB, WS_MEMB = 12 * MiB;
constexpr size_t WS_BT_INA = 18 * MiB, WS_BT_OUTA = 22 * MiB, WS_BT_B = 24 * MiB, WS_BT_OUTB = 29 * MiB, WS_BT_MEM = 30 * MiB;
constexpr size_t WS_WGU = 32 * MiB, WS_WD = 160 * MiB;
constexpr size_t WS_A = 224 * MiB;
constexpr size_t WS_U = WS_A, WS_GV = WS_A + 24 * MiB, WS_QM0 = WS_A + 48 * MiB;
constexpr size_t WS_K = WS_A, WS_V = WS_A + 24 * MiB, WS_Q = WS_A + 48 * MiB, WS_QM1 = WS_A + 72 * MiB;
constexpr size_t WS_ACT = WS_A;
constexpr size_t WS_XB = 304 * MiB;
constexpr size_t WS_C = 336 * MiB;
constexpr size_t WS_CAT = WS_C, WS_OG = WS_C, WS_CAT2 = WS_C + 24 * MiB;
constexpr size_t WS_Y = 376 * MiB;
constexpr size_t WS_YD = 336 * MiB;
constexpr size_t WS_X1B = 440 * MiB;
constexpr size_t WS_END = 472 * MiB;
constexpr int CW_TMO = 0, CW_BAR = 4096, CW_CNT = 16384;
constexpr int LDS_MISC = 131072;
constexpr int LDS_BYTES = 147456;

#define LDS_WAIT() asm volatile("s_waitcnt lgkmcnt(0)" ::: "memory")
#define VM_WAIT() asm volatile("s_waitcnt vmcnt(0)" ::: "memory")
__device__ __forceinline__ unsigned f2bf(float f) { unsigned u = __builtin_bit_cast(unsigned, f); return (u + 0x7fffu + ((u >> 16) & 1u)) >> 16; }
__device__ __forceinline__ unsigned pk2(float lo, float hi) { return f2bf(lo) | (f2bf(hi) << 16); }
__device__ __forceinline__ float bflo(unsigned w) { return __uint_as_float(w << 16); }
__device__ __forceinline__ float bfhi(unsigned w) { return __uint_as_float(w & 0xffff0000u); }
__device__ __forceinline__ float bf1(bf16_t v) { return __uint_as_float(((unsigned)v) << 16); }
__device__ __forceinline__ float wave_sum(float v) {
#pragma unroll
    for (int o = 1; o < 64; o <<= 1) v += __shfl_xor(v, o);
    return v;
}
__device__ __forceinline__ float wave_max(float v) {
#pragma unroll
    for (int o = 1; o < 64; o <<= 1) v = fmaxf(v, __shfl_xor(v, o));
    return v;
}

#define XB_TMO      128
#define XB_XCNT(j)  (256  + 64 * (j))
#define XB_XSUB(j)  (1280 + 64 * (j))
#define XB_XGEN(j)  (2304 + 64 * (j))
#define XB_TOP      3328
#define XB_TOPGEN   3392
#define XCD_BAR_WORDS 3456
#define XB_SPIN_CAP (1u << 18)
__device__ __forceinline__ unsigned xb_ld(unsigned* p)              { return __hip_atomic_load(p, __ATOMIC_RELAXED, __HIP_MEMORY_SCOPE_AGENT); }
__device__ __forceinline__ unsigned xb_add(unsigned* p, unsigned v) { return __hip_atomic_fetch_add(p, v, __ATOMIC_RELAXED, __HIP_MEMORY_SCOPE_AGENT); }
__device__ __forceinline__ unsigned xb_xcc_id() { return (unsigned)__builtin_amdgcn_s_getreg((3 << 11) | 20) & 0xFu; }
#define XB_SPIN(cond, bar) do { unsigned _sp = 0; while (cond) { __builtin_amdgcn_s_sleep(1); \
    if ((++_sp & 255u) == 0u) { if (xb_ld(&(bar)[XB_TMO])) break; if (_sp > XB_SPIN_CAP) { atomicAdd(&(bar)[XB_TMO], 1u); break; } } } } while (0)
struct XcdBarrier { unsigned* bar; unsigned x; volatile LAS unsigned* st; };
__device__ __forceinline__ XcdBarrier xcd_barrier_post(unsigned* bar, volatile LAS unsigned* st) {
    XcdBarrier b; b.bar = bar; b.x = xb_xcc_id(); b.st = st;
    if (threadIdx.x == 0) (void)xb_add(&bar[XB_XCNT(b.x)], 1u);
    return b;
}
__device__ __forceinline__ void xcd_barrier_complete(unsigned* bar, unsigned x, unsigned& nloc, unsigned& nx) {
    const unsigned G = gridDim.x * gridDim.y * gridDim.z;
    unsigned sum, cnt, mine, sp = 0u;
    for (;;) {
        sum = 0u; cnt = 0u; mine = 0u;
#pragma unroll
        for (unsigned j = 0; j < 16; ++j) { const unsigned c = xb_ld(&bar[XB_XCNT(j)]); sum += c; cnt += (c > 0u) ? 1u : 0u; mine = (j == x) ? c : mine; }
        if (sum == G) break;
        __builtin_amdgcn_s_sleep(1);
        if ((++sp & 255u) == 0u) { if (xb_ld(&bar[XB_TMO])) break; if (sp > XB_SPIN_CAP) { atomicAdd(&bar[XB_TMO], 1u); break; } }
    }
    nloc = mine > 0u ? mine : 1u; nx = cnt > 0u ? cnt : 1u;
}
__device__ __forceinline__ void xcd_barrier(const XcdBarrier& b) {
    asm volatile("s_waitcnt vmcnt(0)" ::: "memory");
    __syncthreads();
    if (threadIdx.x == 0) {
        unsigned* bar = b.bar;
        __builtin_amdgcn_s_waitcnt(0);
        unsigned nloc = b.st[0], nx = b.st[1];
        if (nloc == 0u) { xcd_barrier_complete(bar, b.x, nloc, nx); b.st[0] = nloc; b.st[1] = nx; }
        const unsigned old = xb_add(&bar[XB_XSUB(b.x)], 1u);
        const unsigned gen = old / nloc;
        if (old + 1u == (gen + 1u) * nloc) {
            __builtin_amdgcn_fence(__ATOMIC_RELEASE, "agent");
            asm volatile("s_waitcnt vmcnt(0)" ::: "memory");
            const unsigned og = xb_add(&bar[XB_TOP], 1u);
            const unsigned tg = og / nx;
            if (og + 1u == (tg + 1u) * nx) xb_add(&bar[XB_TOPGEN], 1u);
            else XB_SPIN(xb_ld(&bar[XB_TOPGEN]) == tg, bar);
            __builtin_amdgcn_fence(__ATOMIC_ACQUIRE, "agent");
            xb_add(&bar[XB_XGEN(b.x)], 1u);
            asm volatile("s_waitcnt vmcnt(0)" ::: "memory");
        } else {
            XB_SPIN(xb_ld(&bar[XB_XGEN(b.x)]) == gen, bar);
            __builtin_amdgcn_fence(__ATOMIC_ACQUIRE, "agent");
            asm volatile("s_waitcnt vmcnt(0)" ::: "memory");
        }
    }
    __syncthreads();
}


struct EpiProjA {
    static constexpr bool PERM = true, AFTER_DRAIN = false;
    bf16_t *u, *gv, *qm;
    __device__ __forceinline__ void operator()(const f32x4 (&acc)[2][2][4][2], const Unit& un, int wr, int wc, int fr, int fq) const {
        const int row0 = un.pm * 256 + wr * 64 + fr;
        bf16_t* base; int ldc, colt; bool act; float sc = 1.f;
        if (un.pn < 3) { base = u; ldc = SGW; colt = un.pn * 256; act = true; }
        else if (un.pn < 6) { base = gv; ldc = SGW; colt = (un.pn - 3) * 256; act = true; }
        else { base = qm; ldc = 256; colt = 0; act = false; sc = ATT_SCALE; }
        const int col0 = colt + wc * 32 + 8 * fq;
#pragma unroll
        for (int ai = 0; ai < 2; ++ai)
#pragma unroll
            for (int m = 0; m < 4; ++m) { bf16_t* rowp = base + (size_t)(row0 + ai * 128 + m * 16) * ldc + col0;
#pragma unroll
                for (int bj = 0; bj < 2; ++bj) { f32x4 v0 = acc[ai][bj][m][0], v1 = acc[ai][bj][m][1];
                    if (act) { pg8::f32x2 a = pg8::gelu_pk((pg8::f32x2){v0[0], v0[1]}), b = pg8::gelu_pk((pg8::f32x2){v0[2], v0[3]}), c = pg8::gelu_pk((pg8::f32x2){v1[0], v1[1]}), d = pg8::gelu_pk((pg8::f32x2){v1[2], v1[3]});
                        v0 = (f32x4){a.x, a.y, b.x, b.y}; v1 = (f32x4){c.x, c.y, d.x, d.y}; }
                    v0 = v0 * sc; v1 = v1 * sc;
                    u32x4 w; w.x = cvt_pk_bf16(v0[0], v0[1]); w.y = cvt_pk_bf16(v0[2], v0[3]); w.z = cvt_pk_bf16(v1[0], v1[1]); w.w = cvt_pk_bf16(v1[2], v1[3]);
                    *(u32x4*)(rowp + bj * 128) = w; } }
    }
};
struct EpiProjB {
    static constexpr bool PERM = true, AFTER_DRAIN = false;
    bf16_t *k, *v, *q, *qm;
    __device__ __forceinline__ void operator()(const f32x4 (&acc)[2][2][4][2], const Unit& un, int wr, int wc, int fr, int fq) const {
        const int row0 = un.pm * 256 + wr * 64 + fr;
        bf16_t* base; int ldc, colt; float sc = 1.f;
        if (un.pn < 3) { base = k; ldc = SGW; colt = un.pn * 256; }
        else if (un.pn < 6) { base = v; ldc = SGW; colt = (un.pn - 3) * 256; }
        else if (un.pn < 9) { base = q; ldc = SGW; colt = (un.pn - 6) * 256; sc = ATT_SCALE; }
        else { base = qm; ldc = 256; colt = 0; sc = ATT_SCALE; }
        const int col0 = colt + wc * 32 + 8 * fq;
#pragma unroll
        for (int ai = 0; ai < 2; ++ai)
#pragma unroll
            for (int m = 0; m < 4; ++m) { bf16_t* rowp = base + (size_t)(row0 + ai * 128 + m * 16) * ldc + col0;
#pragma unroll
                for (int bj = 0; bj < 2; ++bj) { f32x4 v0 = acc[ai][bj][m][0] * sc, v1 = acc[ai][bj][m][1] * sc;
                    u32x4 w; w.x = cvt_pk_bf16(v0[0], v0[1]); w.y = cvt_pk_bf16(v0[2], v0[3]); w.z = cvt_pk_bf16(v1[0], v1[1]); w.w = cvt_pk_bf16(v1[2], v1[3]);
                    *(u32x4*)(rowp + bj * 128) = w; } }
    }
};
struct EpiPlain {
    static constexpr bool PERM = true, AFTER_DRAIN = false;
    bf16_t* O; int ldc, ntn;
    __device__ __forceinline__ void operator()(const f32x4 (&acc)[2][2][4][2], const Unit& un, int wr, int wc, int fr, int fq) const {
        const int row0 = un.pm * 256 + wr * 64 + fr;
        const int col0 = (un.pn % ntn) * 256 + wc * 32 + 8 * fq;
#pragma unroll
        for (int ai = 0; ai < 2; ++ai)
#pragma unroll
            for (int m = 0; m < 4; ++m) { bf16_t* rowp = O + (size_t)(row0 + ai * 128 + m * 16) * ldc + col0;
#pragma unroll
                for (int bj = 0; bj < 2; ++bj) { const f32x4 v0 = acc[ai][bj][m][0], v1 = acc[ai][bj][m][1];
                    u32x4 w; w.x = cvt_pk_bf16(v0[0], v0[1]); w.y = cvt_pk_bf16(v0[2], v0[3]); w.z = cvt_pk_bf16(v1[0], v1[1]); w.w = cvt_pk_bf16(v1[2], v1[3]);
                    *(u32x4*)(rowp + bj * 128) = w; } }
    }
};
struct EpiSwiGLU {
    static constexpr bool PERM = true, AFTER_DRAIN = false;
    bf16_t* O;
    __device__ __forceinline__ void operator()(const f32x4 (&acc)[2][2][4][2], const Unit& un, int wr, int wc, int fr, int fq) const {
        const int row0 = un.pm * 256 + wr * 64 + fr;
        const int col0 = (un.pn & 7) * 128 + wc * 32 + 8 * fq;
#pragma unroll
        for (int ai = 0; ai < 2; ++ai)
#pragma unroll
            for (int m = 0; m < 4; ++m) { bf16_t* rowp = O + (size_t)(row0 + ai * 128 + m * 16) * 1024 + col0;
                float r[8];
#pragma unroll
                for (int n = 0; n < 2; ++n)
#pragma unroll
                    for (int j = 0; j < 4; ++j) { const float g = acc[ai][0][m][n][j], up = acc[ai][1][m][n][j];
                        r[n * 4 + j] = g * __builtin_amdgcn_rcpf(1.0f + __expf(-g)) * up; }
                u32x4 w; w.x = cvt_pk_bf16(r[0], r[1]); w.y = cvt_pk_bf16(r[2], r[3]); w.z = cvt_pk_bf16(r[4], r[5]); w.w = cvt_pk_bf16(r[6], r[7]);
                *(u32x4*)rowp = w; }
    }
};
template <bool RB> struct EpiResid {
    static constexpr bool PERM = false, AFTER_DRAIN = false;
    const void* res; float* Y;
    __device__ __forceinline__ void operator()(const f32x4 (&acc)[2][2][4][2], const Unit& un, int wr, int wc, int fr, int fq) const {
        const int row0 = un.pm * 256 + wr * 64 + fr, col0 = un.pn * 256 + wc * 32 + 4 * fq;
#pragma unroll
        for (int ai = 0; ai < 2; ++ai)
#pragma unroll
            for (int m = 0; m < 4; ++m) { const size_t off = (size_t)(row0 + ai * 128 + m * 16) * D + col0;
#pragma unroll
                for (int bj = 0; bj < 2; ++bj)
#pragma unroll
                    for (int n = 0; n < 2; ++n) { const size_t o = off + bj * 128 + n * 16; f32x4 r;
                        if (RB) { const u32x2 w = *(const u32x2*)((const bf16_t*)res + o); r = (f32x4){bflo(w.x), bfhi(w.x), bflo(w.y), bfhi(w.y)}; }
                        else r = *(const f32x4*)((const float*)res + o);
                        *(f32x4*)(Y + o) = r * ALPHA + acc[ai][bj][m][n]; } }
    }
};
struct SmallOrder {
    int nN, nwg, c;
    __device__ bool next(int i, Unit& u) const { if (i != 0 || c < 0 || c >= nwg) return false; u.pm = c / nN; u.pn = c % nN; return true; }
    __device__ __forceinline__ void a_ready(const Unit&) const {}
    __device__ __forceinline__ void done(const Unit&) const {}
};
struct MoeOrder {
    const LAS int* tb;
    int ntn, G, c;
    __device__ bool next(int i, Unit& u) const {
        const int L = i * G + c; if (L >= tb[16] * ntn) return false;
        int e = 0;
#pragma unroll
        for (int j = 1; j < 16; ++j) e += (L >= tb[j] * ntn) ? 1 : 0;
        const int r = L - tb[e] * ntn, te = tb[e + 1] - tb[e];
        u.pm = tb[e] + r % te; u.pn = e * ntn + r / te; return true;
    }
    __device__ __forceinline__ void a_ready(const Unit&) const {}
    __device__ __forceinline__ void done(const Unit&) const {}
};

struct Args { const float* in[23]; float* out; unsigned char* ws; int ph_lo, ph_hi; };
struct Ctx {
    unsigned char* ws; LAS unsigned char* lds;
    int tid, lane, wave, gw, NGW, G, bid;
};
__device__ __forceinline__ unsigned char* launder(unsigned char* p) { asm volatile("" : "+s"(p)); return p; }
__device__ __forceinline__ int launder_v(int v) { asm volatile("" : "+v"(v)); return v; }

__device__ __forceinline__ void tr_item(const float* W, int K, int N, bf16_t* WT, int grp, int gstride, int roff, LAS float* scr, int item, int lane) {
    const int nblk = N / 32, kb = item / nblk, nb = item % nblk, k0 = 64 * kb, n0 = 32 * nb;
#pragma unroll 8
    for (int i = 0; i < 32; ++i) { const int kk = 2 * i + (lane >> 5); scr[kk * 33 + (lane & 31)] = W[(size_t)(k0 + kk) * N + n0 + (lane & 31)]; }
    LDS_WAIT(); asm volatile("" ::: "memory");
    const int c = lane & 7;
#pragma unroll
    for (int j = 0; j < 4; ++j) { const int n = (lane >> 3) + 8 * j; const LAS float* s = scr + (8 * c) * 33 + n;
        const int nn = n0 + n, drow = (nn / grp) * gstride + (nn % grp) + roff;
        u32x4 o; o.x = pk2(s[0 * 33], s[1 * 33]); o.y = pk2(s[2 * 33], s[3 * 33]); o.z = pk2(s[4 * 33], s[5 * 33]); o.w = pk2(s[6 * 33], s[7 * 33]);
        *(u32x4*)(WT + (size_t)drow * K + k0 + 8 * c) = o; }
    LDS_WAIT(); asm volatile("" ::: "memory");
}
__device__ __forceinline__ void p0_prologue(const Ctx& C, const Args& A) {
    LAS float* scr = (LAS float*)(C.lds + C.wave * 16384);
    unsigned char* ws = C.ws;
    constexpr int I_MOE = 16 * 32;
    constexpr int N_MOE = 32 * I_MOE;
    constexpr int I_INA = 16 * 56, I_SQ = 512, I_KV = 16 * 24, I_OUTB = 8 * 32, I_MEM = 16 * 8;
    constexpr int NITEMS = 3 * N_MOE + I_INA + I_SQ + I_SQ + 2 * I_KV + I_OUTB + 4 * I_MEM;
    for (int it = C.gw; it < NITEMS; it += C.NGW) {
        int r = it;
        if (r < N_MOE) { const int m = r / I_MOE; tr_item(A.in[20] + (size_t)m * 1048576, 1024, 1024, (bf16_t*)(ws + WS_WGU) + (size_t)m * 2097152, 128, 256, 0, scr, r % I_MOE, C.lane); continue; } r -= N_MOE;
        if (r < N_MOE) { const int m = r / I_MOE; tr_item(A.in[21] + (size_t)m * 1048576, 1024, 1024, (bf16_t*)(ws + WS_WGU) + (size_t)m * 2097152, 128, 256, 128, scr, r % I_MOE, C.lane); continue; } r -= N_MOE;
        if (r < N_MOE) { const int m = r / I_MOE; tr_item(A.in[22] + (size_t)m * 1048576, 1024, 1024, (bf16_t*)(ws + WS_WD) + (size_t)m * 1048576, 1024, 1024, 0, scr, r % I_MOE, C.lane); continue; } r -= N_MOE;
        if (r < I_INA) { tr_item(A.in[2], 1024, 1792, (bf16_t*)(ws + WS_BT_INA), 1792, 1792, 0, scr, r, C.lane); continue; } r -= I_INA;
        if (r < I_SQ) { tr_item(A.in[3], 1024, 1024, (bf16_t*)(ws + WS_BT_OUTA), 1024, 1024, 0, scr, r, C.lane); continue; } r -= I_SQ;
        if (r < I_SQ) { tr_item(A.in[8], 1024, 1024, (bf16_t*)(ws + WS_BT_B), 1024, 1024, 1536, scr, r, C.lane); continue; } r -= I_SQ;
        if (r < I_KV) { tr_item(A.in[10], 1024, 768, (bf16_t*)(ws + WS_BT_B), 768, 768, 0, scr, r, C.lane); continue; } r -= I_KV;
        if (r < I_KV) { tr_item(A.in[11], 1024, 768, (bf16_t*)(ws + WS_BT_B), 768, 768, 768, scr, r, C.lane); continue; } r -= I_KV;
        if (r < I_OUTB) { tr_item(A.in[9], 512, 1024, (bf16_t*)(ws + WS_BT_OUTB), 1024, 1024, 0, scr, r, C.lane); continue; } r -= I_OUTB;
        { const int m = r / I_MEM, layer = m & 1, isv = m >> 1;
          tr_item(A.in[isv ? 13 : 12] + (size_t)layer * 262144, 1024, 256, (bf16_t*)(ws + WS_BT_MEM), 256, 256, layer * 512 + isv * 256, scr, r % I_MEM, C.lane); }
    }
    const int gt = C.bid * NTHREADS + C.tid, NT = C.G * NTHREADS;
    for (int i = gt; i < NSG * 128 * 128 / 8; i += NT) { const int q0 = (i & 15) * 8, p = (i >> 4) & 127;
        const f32x4 a = *(const f32x4*)(A.in[6] + (size_t)i * 8), b = *(const f32x4*)(A.in[6] + (size_t)i * 8 + 4); float v[8] = {a[0], a[1], a[2], a[3], b[0], b[1], b[2], b[3]};
#pragma unroll
        for (int j = 0; j < 8; ++j) v[j] = (q0 + j <= p) ? v[j] : 0.f;
        u32x4 w; w.x = pk2(v[0], v[1]); w.y = pk2(v[2], v[3]); w.z = pk2(v[4], v[5]); w.w = pk2(v[6], v[7]); *(u32x4*)((bf16_t*)(ws + WS_SGWB) + (size_t)i * 8) = w; }
    for (int i = gt; i < T * D / 8; i += NT) { const f32x4 a = *(const f32x4*)(A.in[0] + (size_t)i * 8), b = *(const f32x4*)(A.in[0] + (size_t)i * 8 + 4);
        u32x4 w; w.x = pk2(a[0], a[1]); w.y = pk2(a[2], a[3]); w.z = pk2(b[0], b[1]); w.w = pk2(b[2], b[3]); *(u32x4*)((bf16_t*)(ws + WS_XB) + (size_t)i * 8) = w; }
    for (int i = gt; i < NB * NMEM * D / 8; i += NT) { const f32x4 a = *(const f32x4*)(A.in[1] + (size_t)i * 8), b = *(const f32x4*)(A.in[1] + (size_t)i * 8 + 4);
        u32x4 w; w.x = pk2(a[0], a[1]); w.y = pk2(a[2], a[3]); w.z = pk2(b[0], b[1]); w.w = pk2(b[2], b[3]); *(u32x4*)((bf16_t*)(ws + WS_MEMB) + (size_t)i * 8) = w; }
}

__device__ __forceinline__ void sg_scalar(const Ctx& C, const Args& A) {
    const bf16_t* U = (const bf16_t*)(C.ws + WS_U); const bf16_t* GV = (const bf16_t*)(C.ws + WS_GV); bf16_t* CAT = (bf16_t*)(C.ws + WS_CAT);
    const float* lng = A.in[4]; const float* lnb = A.in[5]; const float* sgw = A.in[6]; const float* sgb = A.in[7];
    LAS float* stat = (LAS float*)C.lds;
    LAS float* gvn = (LAS float*)(C.lds + 1024);
    LAS float* Wl = (LAS float*)(C.lds + 1024 + 128 * 65 * 4);
    for (int unit = C.bid; unit < NB * 16; unit += C.G) {
        const int tb = unit * 128;
        for (int rr = 0; rr < 16; ++rr) { const int row = C.wave * 16 + rr; const bf16_t* p = GV + (size_t)(tb + row) * SGW + 4 * C.lane;
            float s = 0.f, ss = 0.f;
#pragma unroll
            for (int j = 0; j < 3; ++j) { const u32x2 w = *(const u32x2*)(p + 256 * j); const float a = bflo(w.x), b = bfhi(w.x), c = bflo(w.y), d = bfhi(w.y);
                s += (a + b) + (c + d); ss += (a * a + b * b) + (c * c + d * d); }
            s = wave_sum(s); ss = wave_sum(ss);
            const float mean = s * (1.f / SGW), var = ss * (1.f / SGW) - mean * mean;
            if (C.lane == 0) { stat[row * 2] = mean; stat[row * 2 + 1] = 1.0f / sqrtf(var + LN_EPS); } }
        __syncthreads();
        const int p = C.tid >> 2, d0 = (C.tid & 3) * 16;
        for (int g = 0; g < NSG; ++g) {
            { const bf16_t* src = GV + (size_t)(tb + p) * SGW + g * 64 + d0; const float mean = stat[p * 2], rstd = stat[p * 2 + 1];
#pragma unroll
              for (int h = 0; h < 2; ++h) { const u32x4 w = *(const u32x4*)(src + 8 * h); const unsigned ww[4] = {w.x, w.y, w.z, w.w};
#pragma unroll
                  for (int j = 0; j < 4; ++j) { const int d = d0 + 8 * h + 2 * j; const int cc = g * 64 + d;
                      gvn[p * 65 + d] = (bflo(ww[j]) - mean) * rstd * lng[cc] + lnb[cc];
                      gvn[p * 65 + d + 1] = (bfhi(ww[j]) - mean) * rstd * lng[cc + 1] + lnb[cc + 1]; } } }
            { const int q0 = (C.tid & 3) * 32; const float* src = sgw + ((size_t)g * 128 + p) * 128 + q0;
#pragma unroll
              for (int j = 0; j < 8; ++j) { const f32x4 w = *(const f32x4*)(src + 4 * j);
#pragma unroll
                  for (int t = 0; t < 4; ++t) { const int q = q0 + 4 * j + t; Wl[p * 129 + q] = (q <= p) ? w[t] : 0.f; } } }
            __syncthreads();
            float acc[16];
#pragma unroll
            for (int j = 0; j < 16; ++j) acc[j] = 0.f;
            for (int q = 0; q <= p; ++q) { const float w = Wl[p * 129 + q];
#pragma unroll
                for (int j = 0; j < 16; ++j) acc[j] += w * gvn[q * 65 + d0 + j]; }
            const float bs = sgb[g * 128 + p];
            const bf16_t* us = U + (size_t)(tb + p) * SGW + g * 64 + d0; bf16_t* dst = CAT + (size_t)(tb + p) * D + g * 64 + d0;
#pragma unroll
            for (int h = 0; h < 2; ++h) { const u32x4 w = *(const u32x4*)(us + 8 * h); const unsigned ww[4] = {w.x, w.y, w.z, w.w}; unsigned o[4];
#pragma unroll
                for (int j = 0; j < 4; ++j) o[j] = pk2(bflo(ww[j]) * (acc[8 * h + 2 * j] + bs), bfhi(ww[j]) * (acc[8 * h + 2 * j + 1] + bs));
                *(u32x4*)(dst + 8 * h) = (u32x4){o[0], o[1], o[2], o[3]}; }
            __syncthreads();
        }
    }
}

__device__ __forceinline__ void memattn_scalar(const Ctx& C, const bf16_t* QM, const bf16_t* MKV, int ck, int cv, bf16_t* OUT, int ldo, int coff) {
    for (int it = C.gw; it < T * 4; it += C.NGW) {
        const int tok = it >> 2, h = it & 3, b = tok / SEQ;
        float q[64];
        { const bf16_t* qp = QM + (size_t)tok * 256 + h * 64;
#pragma unroll
          for (int j = 0; j < 8; ++j) { const u32x4 w = *(const u32x4*)(qp + 8 * j);
              q[8 * j] = bflo(w.x); q[8 * j + 1] = bfhi(w.x); q[8 * j + 2] = bflo(w.y); q[8 * j + 3] = bfhi(w.y); q[8 * j + 4] = bflo(w.z); q[8 * j + 5] = bfhi(w.z); q[8 * j + 6] = bflo(w.w); q[8 * j + 7] = bfhi(w.w); } }
        float s[4];
#pragma unroll
        for (int jj = 0; jj < 4; ++jj) { const bf16_t* kp = MKV + (size_t)(b * NMEM + jj * 64 + C.lane) * 1024 + ck + h * 64; float a = 0.f;
#pragma unroll
            for (int j = 0; j < 8; ++j) { const u32x4 w = *(const u32x4*)(kp + 8 * j);
                a += q[8 * j] * bflo(w.x) + q[8 * j + 1] * bfhi(w.x) + q[8 * j + 2] * bflo(w.y) + q[8 * j + 3] * bfhi(w.y) + q[8 * j + 4] * bflo(w.z) + q[8 * j + 5] * bfhi(w.z) + q[8 * j + 6] * bflo(w.w) + q[8 * j + 7] * bfhi(w.w); }
            s[jj] = a; }
        const float mx = wave_max(fmaxf(fmaxf(s[0], s[1]), fmaxf(s[2], s[3])));
        float l = 0.f;
#pragma unroll
        for (int jj = 0; jj < 4; ++jj) { s[jj] = __expf(s[jj] - mx); l += s[jj]; }
        l = wave_sum(l);
        float acc = 0.f;
#pragma unroll
        for (int jj = 0; jj < 4; ++jj) { const bf16_t* vp = MKV + (size_t)(b * NMEM + jj * 64) * 1024 + cv + h * 64 + C.lane;
            for (int mm = 0; mm < 64; ++mm) acc += __shfl(s[jj], mm) * bf1(vp[(size_t)mm * 1024]); }
        OUT[(size_t)tok * ldo + coff + h * 64 + C.lane] = (bf16_t)f2bf(acc / l);
    }
}

__device__ __forceinline__ void dilattn_scalar(const Ctx& C, const Args& A) {
    const bf16_t* Q = (const bf16_t*)(C.ws + WS_Q); const bf16_t* K = (const bf16_t*)(C.ws + WS_K); const bf16_t* V = (const bf16_t*)(C.ws + WS_V);
    bf16_t* OG = (bf16_t*)(C.ws + WS_OG); float* LSE = (float*)(C.ws + WS_LSE);
    for (int it = C.gw; it < T * 12; it += C.NGW) {
        const int tok = it / 12, h = it % 12, g = h >> 2, dl = (g == 0) ? 1 : (g == 1 ? 4 : 16);
        const int t = tok % SEQ, i = t / dl;
        const float slope = exp2f(-(float)(h + 1) * (8.0f / 12.0f));
        float q[64];
        { const bf16_t* qp = Q + (size_t)tok * SGW + h * 64;
#pragma unroll
          for (int j = 0; j < 8; ++j) { const u32x4 w = *(const u32x4*)(qp + 8 * j);
              q[8 * j] = bflo(w.x); q[8 * j + 1] = bfhi(w.x); q[8 * j + 2] = bflo(w.y); q[8 * j + 3] = bfhi(w.y); q[8 * j + 4] = bflo(w.z); q[8 * j + 5] = bfhi(w.z); q[8 * j + 6] = bflo(w.w); q[8 * j + 7] = bfhi(w.w); } }
        float s[3];
#pragma unroll
        for (int jj = 0; jj < 3; ++jj) { const int j0 = jj * 64 + C.lane; const bool valid = (jj < 2 || C.lane == 0) && (j0 <= i);
            const int jc = valid ? j0 : 0;
            const bf16_t* kp = K + (size_t)(tok - jc * dl) * SGW + h * 64; float a = 0.f;
#pragma unroll
            for (int j = 0; j < 8; ++j) { const u32x4 w = *(const u32x4*)(kp + 8 * j);
                a += q[8 * j] * bflo(w.x) + q[8 * j + 1] * bfhi(w.x) + q[8 * j + 2] * bflo(w.y) + q[8 * j + 3] * bfhi(w.y) + q[8 * j + 4] * bflo(w.z) + q[8 * j + 5] * bfhi(w.z) + q[8 * j + 6] * bflo(w.w) + q[8 * j + 7] * bfhi(w.w); }
            s[jj] = valid ? (a - slope * (float)(dl * j0)) : -INFINITY; }
        const float mx = wave_max(fmaxf(fmaxf(s[0], s[1]), s[2]));
        float l = 0.f;
#pragma unroll
        for (int jj = 0; jj < 3; ++jj) { s[jj] = __expf(s[jj] - mx); l += s[jj]; }
        l = wave_sum(l);
        float acc = 0.f;
#pragma unroll
        for (int jj = 0; jj < 3; ++jj) { const int nm = (jj < 2) ? 64 : 1;
            for (int mm = 0; mm < nm; ++mm) { const int j0 = jj * 64 + mm; const int jc = (j0 <= i) ? j0 : 0;
                acc += __shfl(s[jj], mm) * bf1(V[(size_t)(tok - jc * dl) * SGW + h * 64 + C.lane]); } }
        OG[(size_t)tok * SGW + h * 64 + C.lane] = (bf16_t)f2bf(acc / l);
        if (C.lane == 0) LSE[tok * 12 + h] = mx + __logf(l);
    }
}
typedef short bf16x8 __attribute__((ext_vector_type(8)));
typedef short s16x4 __attribute__((ext_vector_type(4)));
constexpr int AT_KS = 144, AT_VS = 160, AT_ROWS = 272, AT_K_OFF = 0, AT_V_OFF = AT_ROWS * AT_KS;
static_assert(AT_V_OFF % 16 == 0 && AT_V_OFF + AT_ROWS * AT_VS <= 131072, "attention LDS map");

template <int NKB, bool DIL>
__device__ __forceinline__ void attn_compute(LAS unsigned char* lds, int lane, int krow0, bf16x8 qf0, bf16x8 qf1, float sdl, int ikw, f32x4 (&o)[4], float& mx, float& lsum) {
    const int n = lane & 15, g = lane >> 4;
    const LAS unsigned char* Kb = lds + AT_K_OFF + (krow0 + n) * AT_KS + g * 16;
    f32x4 sc[NKB];
#pragma unroll
    for (int kb = 0; kb < NKB; ++kb) {
        const bf16x8 k0 = *(const LAS bf16x8*)(Kb + kb * 16 * AT_KS), k1 = *(const LAS bf16x8*)(Kb + kb * 16 * AT_KS + 64);
        f32x4 a = (f32x4){0.f, 0.f, 0.f, 0.f};
        a = __builtin_amdgcn_mfma_f32_16x16x32_bf16(k0, qf0, a, 0, 0, 0);
        a = __builtin_amdgcn_mfma_f32_16x16x32_bf16(k1, qf1, a, 0, 0, 0);
        sc[kb] = a;
    }
    float m = -INFINITY;
#pragma unroll
    for (int kb = 0; kb < NKB; ++kb)
#pragma unroll
        for (int r = 0; r < 4; ++r) {
            if (DIL) { const int off = 16 * kb + 4 * g + r, rel = 144 + n - off; const bool valid = (rel >= 0) && (rel <= 128) && (ikw + off >= 0);
                sc[kb][r] = valid ? (sc[kb][r] - sdl * (float)rel) : -INFINITY; }
            m = fmaxf(m, sc[kb][r]); }
    m = fmaxf(m, __shfl_xor(m, 16)); m = fmaxf(m, __shfl_xor(m, 32));
    float l = 0.f;
#pragma unroll
    for (int kb = 0; kb < NKB; ++kb)
#pragma unroll
        for (int r = 0; r < 4; ++r) { sc[kb][r] = __expf(sc[kb][r] - m); l += sc[kb][r]; }
    l += __shfl_xor(l, 16); l += __shfl_xor(l, 32);
    mx = m; lsum = l;
    const LAS unsigned char* Vb = lds + AT_V_OFF + (krow0 + 4 * g + (n >> 2)) * AT_VS + (n & 3) * 8;
#pragma unroll
    for (int db = 0; db < 4; ++db) o[db] = (f32x4){0.f, 0.f, 0.f, 0.f};
#pragma unroll
    for (int kk = 0; kk < NKB / 2; ++kk) {
        union { bf16x8 v; unsigned u[4]; } pf;
        pf.u[0] = cvt_pk_bf16(sc[2 * kk][0], sc[2 * kk][1]); pf.u[1] = cvt_pk_bf16(sc[2 * kk][2], sc[2 * kk][3]);
        pf.u[2] = cvt_pk_bf16(sc[2 * kk + 1][0], sc[2 * kk + 1][1]); pf.u[3] = cvt_pk_bf16(sc[2 * kk + 1][2], sc[2 * kk + 1][3]);
#pragma unroll
        for (int db = 0; db < 4; ++db) {
            const s16x4 v0 = __builtin_amdgcn_ds_read_tr16_b64_v4i16((LAS s16x4*)(Vb + (2 * kk) * 16 * AT_VS + db * 32));
            const s16x4 v1 = __builtin_amdgcn_ds_read_tr16_b64_v4i16((LAS s16x4*)(Vb + (2 * kk + 1) * 16 * AT_VS + db * 32));
            const bf16x8 vf = __builtin_shufflevector(v0, v1, 0, 1, 2, 3, 4, 5, 6, 7);
            o[db] = __builtin_amdgcn_mfma_f32_16x16x32_bf16(vf, pf.v, o[db], 0, 0, 0);
        }
    }
}

__device__ __forceinline__ void memattn_mfma(const Ctx& C, const bf16_t* QM, const bf16_t* MKV, int ck, int cv, bf16_t* OUT, int ldo, int coff) {
    const int n = C.lane & 15, g = C.lane >> 4;
    for (int unit = C.bid; unit < NB * 4 * 16; unit += C.G) {
        const int b = unit >> 6, h = (unit >> 4) & 3, qt = unit & 15;
        __syncthreads();
#pragma unroll
        for (int it = 0; it < 4; ++it) { const int row = it * 64 + (C.tid >> 3), c = C.tid & 7;
            const bf16_t* src = MKV + (size_t)(b * NMEM + row) * 1024 + h * 64 + c * 8;
            const u32x4 kv = *(const u32x4*)(src + ck), vv = *(const u32x4*)(src + cv);
            *(LAS u32x4*)(C.lds + AT_K_OFF + row * AT_KS + c * 16) = kv; *(LAS u32x4*)(C.lds + AT_V_OFF + row * AT_VS + c * 16) = vv; }
        const int tok = b * SEQ + qt * 128 + C.wave * 16 + n;
        const bf16_t* qp = QM + (size_t)tok * 256 + h * 64 + g * 8;
        const bf16x8 qf0 = *(const bf16x8*)qp, qf1 = *(const bf16x8*)(qp + 32);
        __syncthreads();
        f32x4 o[4]; float mx, l;
        attn_compute<16, false>(C.lds, C.lane, 0, qf0, qf1, 0.f, 0, o, mx, l);
        const float inv = 1.0f / l;
#pragma unroll
        for (int db = 0; db < 4; ++db)
            *(u32x2*)(OUT + (size_t)tok * ldo + coff + h * 64 + 16 * db + 4 * g) = (u32x2){cvt_pk_bf16(o[db][0] * inv, o[db][1] * inv), cvt_pk_bf16(o[db][2] * inv, o[db][3] * inv)};
    }
}
__device__ __forceinline__ void dilattn_mfma(const Ctx& C) {
    const bf16_t* Q = (const bf16_t*)(C.ws + WS_Q); const bf16_t* K = (const bf16_t*)(C.ws + WS_K); const bf16_t* V = (const bf16_t*)(C.ws + WS_V);
    bf16_t* OG = (bf16_t*)(C.ws + WS_OG); float* LSE = (float*)(C.ws + WS_LSE);
    const int n = C.lane & 15, g = C.lane >> 4;
    for (int unit = C.bid; unit < 12 * 128; unit += C.G) {
        const int h = unit >> 7, rem = unit & 127, b = rem >> 4, x = rem & 15, grp = h >> 2;
        const int dl = (grp == 0) ? 1 : (grp == 1 ? 4 : 16), ntile = 16 / dl, r = x / ntile, I0 = (x % ntile) * 128;
        const float sdl = exp2f(-(float)(h + 1) * (8.0f / 12.0f)) * (float)dl;
        __syncthreads();
        for (int idx = C.tid; idx < AT_ROWS * 8; idx += NTHREADS) { const int row = idx >> 3, c = idx & 7; const int ik = I0 - 144 + row;
            u32x4 kv = (u32x4){0u, 0u, 0u, 0u}, vv = (u32x4){0u, 0u, 0u, 0u};
            if (ik >= 0) { const size_t off = (size_t)(b * SEQ + ik * dl + r) * SGW + h * 64 + c * 8; kv = *(const u32x4*)(K + off); vv = *(const u32x4*)(V + off); }
            *(LAS u32x4*)(C.lds + AT_K_OFF + row * AT_KS + c * 16) = kv; *(LAS u32x4*)(C.lds + AT_V_OFF + row * AT_VS + c * 16) = vv; }
        const int iq = I0 + C.wave * 16 + n, tok = b * SEQ + iq * dl + r;
        const bf16_t* qp = Q + (size_t)tok * SGW + h * 64 + g * 8;
        const bf16x8 qf0 = *(const bf16x8*)qp, qf1 = *(const bf16x8*)(qp + 32);
        __syncthreads();
        f32x4 o[4]; float mx, l;
        attn_compute<10, true>(C.lds, C.lane, C.wave * 16, qf0, qf1, sdl, I0 + C.wave * 16 - 144, o, mx, l);
        const float inv = 1.0f / l;
#pragma unroll
        for (int db = 0; db < 4; ++db)
            *(u32x2*)(OG + (size_t)tok * SGW + h * 64 + 16 * db + 4 * g) = (u32x2){cvt_pk_bf16(o[db][0] * inv, o[db][1] * inv), cvt_pk_bf16(o[db][2] * inv, o[db][3] * inv)};
        if (g == 0) LSE[tok * 12 + h] = mx + __logf(l);
    }
}
constexpr int SG_GVN_OFF = 1024, SG_VS = 160;
__device__ __forceinline__ void sg_mfma(const Ctx& C, const Args& A) {
    const bf16_t* U = (const bf16_t*)(C.ws + WS_U); const bf16_t* GV = (const bf16_t*)(C.ws + WS_GV); bf16_t* CAT = (bf16_t*)(C.ws + WS_CAT);
    const bf16_t* WB = (const bf16_t*)(C.ws + WS_SGWB);
    const float* lng = A.in[4]; const float* lnb = A.in[5]; const float* sgb = A.in[7];
    LAS float* stat = (LAS float*)C.lds;
    const int n = C.lane & 15, gl = C.lane >> 4;
    for (int unit = C.bid; unit < NB * 16 * 4; unit += C.G) {
        const int tb = (unit >> 2) * 128, gq = unit & 3;
        __syncthreads();
        for (int rr = 0; rr < 16; ++rr) { const int row = C.wave * 16 + rr; const bf16_t* p = GV + (size_t)(tb + row) * SGW + 4 * C.lane;
            float s = 0.f, ss = 0.f;
#pragma unroll
            for (int j = 0; j < 3; ++j) { const u32x2 w = *(const u32x2*)(p + 256 * j); const float a = bflo(w.x), b = bfhi(w.x), c = bflo(w.y), d = bfhi(w.y);
                s += (a + b) + (c + d); ss += (a * a + b * b) + (c * c + d * d); }
            s = wave_sum(s); ss = wave_sum(ss);
            const float mean = s * (1.f / SGW), var = ss * (1.f / SGW) - mean * mean;
            if (C.lane == 0) { stat[row * 2] = mean; stat[row * 2 + 1] = 1.0f / sqrtf(var + LN_EPS); } }
        __syncthreads();
        for (int gi = 0; gi < 3; ++gi) {
            const int g = gq * 3 + gi;
#pragma unroll
            for (int it = 0; it < 2; ++it) { const int idx = it * NTHREADS + C.tid, row = idx >> 3, c = idx & 7, cc = g * 64 + c * 8;
                const u32x4 w = *(const u32x4*)(GV + (size_t)(tb + row) * SGW + cc); const float mean = stat[row * 2], rstd = stat[row * 2 + 1];
                const f32x4 ga = *(const f32x4*)(lng + cc), gb = *(const f32x4*)(lng + cc + 4), ba = *(const f32x4*)(lnb + cc), bb = *(const f32x4*)(lnb + cc + 4);
                u32x4 o;
                o.x = pk2((bflo(w.x) - mean) * rstd * ga[0] + ba[0], (bfhi(w.x) - mean) * rstd * ga[1] + ba[1]);
                o.y = pk2((bflo(w.y) - mean) * rstd * ga[2] + ba[2], (bfhi(w.y) - mean) * rstd * ga[3] + ba[3]);
                o.z = pk2((bflo(w.z) - mean) * rstd * gb[0] + bb[0], (bfhi(w.z) - mean) * rstd * gb[1] + bb[1]);
                o.w = pk2((bflo(w.w) - mean) * rstd * gb[2] + bb[2], (bfhi(w.w) - mean) * rstd * gb[3] + bb[3]);
                *(LAS u32x4*)(C.lds + SG_GVN_OFF + row * SG_VS + c * 16) = o; }
            __syncthreads();
            const int p = C.wave * 16 + n, nks = (C.wave >> 1) + 1;
            f32x4 acc[4];
#pragma unroll
            for (int db = 0; db < 4; ++db) acc[db] = (f32x4){0.f, 0.f, 0.f, 0.f};
            const bf16_t* wp = WB + (size_t)(g * 128 + p) * 128 + 8 * gl;
            const LAS unsigned char* vb = C.lds + SG_GVN_OFF + (8 * gl + (n >> 2)) * SG_VS + (n & 3) * 8;
            for (int ks = 0; ks < nks; ++ks) {
                const bf16x8 wf = *(const bf16x8*)(wp + 32 * ks);
#pragma unroll
                for (int db = 0; db < 4; ++db) {
                    const s16x4 v0 = __builtin_amdgcn_ds_read_tr16_b64_v4i16((LAS s16x4*)(vb + ks * 32 * SG_VS + db * 32));
                    const s16x4 v1 = __builtin_amdgcn_ds_read_tr16_b64_v4i16((LAS s16x4*)(vb + ks * 32 * SG_VS + 4 * SG_VS + db * 32));
                    const bf16x8 vf = __builtin_shufflevector(v0, v1, 0, 1, 2, 3, 4, 5, 6, 7);
                    acc[db] = __builtin_amdgcn_mfma_f32_16x16x32_bf16(vf, wf, acc[db], 0, 0, 0);
                }
            }
            const float bs = sgb[g * 128 + p];
#pragma unroll
            for (int db = 0; db < 4; ++db) { const size_t co = (size_t)g * 64 + 16 * db + 4 * gl;
                const u32x2 uw = *(const u32x2*)(U + (size_t)(tb + p) * SGW + co);
                *(u32x2*)(CAT + (size_t)(tb + p) * D + co) = (u32x2){cvt_pk_bf16(bflo(uw.x) * (acc[db][0] + bs), bfhi(uw.x) * (acc[db][1] + bs)), cvt_pk_bf16(bflo(uw.y) * (acc[db][2] + bs), bfhi(uw.y) * (acc[db][3] + bs))}; }
            __syncthreads();
        }
    }
}
__device__ __forceinline__ void dil_merge(const Ctx& C, const Args& A) {
    const bf16_t* OG = (const bf16_t*)(C.ws + WS_OG); const float* LSE = (const float*)(C.ws + WS_LSE); bf16_t* CAT2 = (bf16_t*)(C.ws + WS_CAT2);
    const int gt = C.bid * NTHREADS + C.tid, NT = C.G * NTHREADS;
    for (int it = gt; it < T * 32; it += NT) {
        const int tok = it >> 5, j = (it >> 3) & 3, c8 = it & 7;
        const float l0 = LSE[tok * 12 + j], l1 = LSE[tok * 12 + 4 + j], l2 = LSE[tok * 12 + 8 + j];
        const float mx = fmaxf(l0, fmaxf(l1, l2));
        float w0 = __expf(l0 - mx), w1 = __expf(l1 - mx), w2 = __expf(l2 - mx); const float inv = 1.0f / (w0 + w1 + w2); w0 *= inv; w1 *= inv; w2 *= inv;
        const u32x4 a = *(const u32x4*)(OG + (size_t)tok * SGW + j * 64 + c8 * 8), b = *(const u32x4*)(OG + (size_t)tok * SGW + (4 + j) * 64 + c8 * 8), c = *(const u32x4*)(OG + (size_t)tok * SGW + (8 + j) * 64 + c8 * 8);
        u32x4 o;
        o.x = pk2(w0 * bflo(a.x) + w1 * bflo(b.x) + w2 * bflo(c.x), w0 * bfhi(a.x) + w1 * bfhi(b.x) + w2 * bfhi(c.x));
        o.y = pk2(w0 * bflo(a.y) + w1 * bflo(b.y) + w2 * bflo(c.y), w0 * bfhi(a.y) + w1 * bfhi(b.y) + w2 * bfhi(c.y));
        o.z = pk2(w0 * bflo(a.z) + w1 * bflo(b.z) + w2 * bflo(c.z), w0 * bfhi(a.z) + w1 * bfhi(b.z) + w2 * bfhi(c.z));
        o.w = pk2(w0 * bflo(a.w) + w1 * bflo(b.w) + w2 * bflo(c.w), w0 * bfhi(a.w) + w1 * bfhi(b.w) + w2 * bfhi(c.w));
        *(u32x4*)(CAT2 + (size_t)tok * 512 + j * 64 + c8 * 8) = o;
    }
}

__device__ __forceinline__ void ln_route(const Ctx& C, const Args& A, int layer) {
    const float* Y = (const float*)(C.ws + WS_Y); bf16_t* X1B = (bf16_t*)(C.ws + WS_X1B);
    const float* lg = A.in[14] + layer * D; const float* lb = A.in[15] + layer * D; const float* wr = A.in[18]; const float* br = A.in[19];
    unsigned* cnt = (unsigned*)(C.ws + WS_CTL) + CW_CNT + layer * 16 * 64;
    int* tokE = (int*)(C.ws + WS_TOKE); int* tokP = (int*)(C.ws + WS_TOKP); float* tokG = (float*)(C.ws + WS_TOKG); int* list = (int*)(C.ws + WS_LIST);
    LAS float* wl = (LAS float*)C.lds;
    __syncthreads();
    for (int i = C.tid; i < 1024 * 16 / 4; i += NTHREADS) *(LAS f32x4*)(wl + 4 * i) = *(const f32x4*)(wr + 4 * i);
    __syncthreads();
    const LAS float* wlane = wl + C.lane * 64;
    for (int tok = C.gw; tok < T; tok += C.NGW) {
        f32x4 v[4]; float s = 0.f;
#pragma unroll
        for (int j = 0; j < 4; ++j) { v[j] = *(const f32x4*)(Y + (size_t)tok * D + 4 * C.lane + 256 * j); s += (v[j][0] + v[j][1]) + (v[j][2] + v[j][3]); }
        const float mean = wave_sum(s) * (1.f / D); float s2 = 0.f;
#pragma unroll
        for (int j = 0; j < 4; ++j) { v[j] = v[j] - mean; s2 += (v[j][0] * v[j][0] + v[j][1] * v[j][1]) + (v[j][2] * v[j][2] + v[j][3] * v[j][3]); }
        const float rstd = 1.0f / sqrtf(wave_sum(s2) * (1.f / D) + LN_EPS);
        float lgt[16];
#pragma unroll
        for (int e = 0; e < 16; ++e) lgt[e] = 0.f;
#pragma unroll
        for (int j = 0; j < 4; ++j) { const int col = 4 * C.lane + 256 * j; const f32x4 g4 = *(const f32x4*)(lg + col), b4 = *(const f32x4*)(lb + col);
            v[j] = v[j] * rstd * g4 + b4;
            *(u32x2*)(X1B + (size_t)tok * D + col) = (u32x2){pk2(v[j][0], v[j][1]), pk2(v[j][2], v[j][3])};
#pragma unroll
            for (int c = 0; c < 4; ++c) { const float xv = v[j][c];
#pragma unroll
                for (int e4 = 0; e4 < 4; ++e4) { const f32x4 w = *(const LAS f32x4*)(wlane + (256 * j + c) * 16 + 4 * e4);
                    lgt[4 * e4] += xv * w[0]; lgt[4 * e4 + 1] += xv * w[1]; lgt[4 * e4 + 2] += xv * w[2]; lgt[4 * e4 + 3] += xv * w[3]; } } }
        float mx = -INFINITY;
#pragma unroll
        for (int e = 0; e < 16; ++e) { lgt[e] = wave_sum(lgt[e]); mx = fmaxf(mx, lgt[e]); }
        float sum = 0.f;
#pragma unroll
        for (int e = 0; e < 16; ++e) { lgt[e] = __expf(lgt[e] - mx); sum += lgt[e]; }
        const float inv = 1.0f / sum; float sel[16];
#pragma unroll
        for (int e = 0; e < 16; ++e) { lgt[e] *= inv; sel[e] = lgt[e] + br[e]; }
        float gs[4];
#pragma unroll
        for (int g = 0; g < 4; ++g) { const float a = sel[4 * g], b = sel[4 * g + 1], c = sel[4 * g + 2], d = sel[4 * g + 3];
            gs[g] = fmaxf(fmaxf(fmaxf(a + b, a + c), fmaxf(a + d, b + c)), fmaxf(b + d, c + d)); }
        int gi = 0; float bsc = gs[0];
#pragma unroll
        for (int g = 1; g < 4; ++g) if (gs[g] > bsc) { bsc = gs[g]; gi = g; }
        float sg[4], pg[4];
#pragma unroll
        for (int k = 0; k < 4; ++k) { sg[k] = gi == 0 ? sel[k] : (gi == 1 ? sel[4 + k] : (gi == 2 ? sel[8 + k] : sel[12 + k])); pg[k] = gi == 0 ? lgt[k] : (gi == 1 ? lgt[4 + k] : (gi == 2 ? lgt[8 + k] : lgt[12 + k])); }
        int i1 = 0; float b1 = sg[0], p1 = pg[0];
#pragma unroll
        for (int k = 1; k < 4; ++k) if (sg[k] > b1) { b1 = sg[k]; i1 = k; p1 = pg[k]; }
        int i2 = -1; float b2 = -INFINITY, p2 = 0.f;
#pragma unroll
        for (int k = 0; k < 4; ++k) if (k != i1 && sg[k] > b2) { b2 = sg[k]; i2 = k; p2 = pg[k]; }
        if (C.lane == 0) {
            const int e1 = gi * 4 + i1, e2 = gi * 4 + i2; const float gsum = p1 + p2;
            const unsigned pos1 = __hip_atomic_fetch_add(cnt + e1 * 64, 1u, __ATOMIC_RELAXED, __HIP_MEMORY_SCOPE_AGENT);
            const unsigned pos2 = __hip_atomic_fetch_add(cnt + e2 * 64, 1u, __ATOMIC_RELAXED, __HIP_MEMORY_SCOPE_AGENT);
            list[e1 * LISTCAP + pos1] = tok; list[e2 * LISTCAP + pos2] = tok;
            tokE[tok * 2] = e1; tokE[tok * 2 + 1] = e2; tokP[tok * 2] = (int)pos1; tokP[tok * 2 + 1] = (int)pos2; tokG[tok * 2] = p1 / gsum; tokG[tok * 2 + 1] = p2 / gsum;
        }
    }
}
__device__ __forceinline__ void moe_prefix(const Ctx& C, int layer) {
    LAS int* mi = (LAS int*)(C.lds + LDS_MISC);
    unsigned* cnt = (unsigned*)(C.ws + WS_CTL) + CW_CNT + layer * 16 * 64;
    __syncthreads();
    if (C.tid < 16) mi[17 + C.tid] = (int)__hip_atomic_load(cnt + C.tid * 64, __ATOMIC_RELAXED, __HIP_MEMORY_SCOPE_AGENT);
    __syncthreads();
    if (C.tid == 0) { int a = 0; for (int e = 0; e < 16; ++e) { mi[e] = a; a += (mi[17 + e] + 255) >> 8; } mi[16] = a; }
    __syncthreads();
}
__device__ __forceinline__ void moe_gather(const Ctx& C, const Args& A) {
    const LAS int* mi = (const LAS int*)(C.lds + LDS_MISC);
    const bf16_t* X1B = (const bf16_t*)(C.ws + WS_X1B); bf16_t* XG = (bf16_t*)(C.ws + WS_YD); const int* list = (const int*)(C.ws + WS_LIST);
    const int nrows = mi[16] * 256;
    for (int R = C.gw; R < nrows; R += C.NGW) {
        const int tile = R >> 8; int e = 0;
#pragma unroll
        for (int j = 1; j < 16; ++j) e += (tile >= mi[j]) ? 1 : 0;
        int pos = R - mi[e] * 256; const int cn = mi[17 + e]; if (pos >= cn) pos = cn - 1;
        const int tok = list[e * LISTCAP + pos];
        const u32x4* src = (const u32x4*)(X1B + (size_t)tok * D); u32x4* dst = (u32x4*)(XG + (size_t)R * D);
        dst[C.lane] = src[C.lane]; dst[C.lane + 64] = src[C.lane + 64];
    }
}
__device__ __forceinline__ void combine_ln2(const Ctx& C, const Args& A, int layer) {
    const LAS int* mi = (const LAS int*)(C.lds + LDS_MISC);
    const bf16_t* X1B = (const bf16_t*)(C.ws + WS_X1B); const bf16_t* YD = (const bf16_t*)(C.ws + WS_YD); bf16_t* X2B = (bf16_t*)(C.ws + WS_XB);
    const int* tokE = (const int*)(C.ws + WS_TOKE); const int* tokP = (const int*)(C.ws + WS_TOKP); const float* tokG = (const float*)(C.ws + WS_TOKG);
    const float* lg = A.in[16] + layer * D; const float* lb = A.in[17] + layer * D;
    for (int tok = C.gw; tok < T; tok += C.NGW) {
        const int e0 = tokE[tok * 2], e1 = tokE[tok * 2 + 1]; const float g0 = tokG[tok * 2], g1 = tokG[tok * 2 + 1];
        int tb0 = 0, tb1 = 0;
#pragma unroll
        for (int j = 0; j < 16; ++j) { const int t = mi[j]; tb0 = (e0 == j) ? t : tb0; tb1 = (e1 == j) ? t : tb1; }
        const size_t r0 = (size_t)tb0 * 256 + tokP[tok * 2], r1 = (size_t)tb1 * 256 + tokP[tok * 2 + 1];
        f32x4 v[4]; float s = 0.f;
#pragma unroll
        for (int j = 0; j < 4; ++j) { const int col = 4 * C.lane + 256 * j;
            const u32x2 a = *(const u32x2*)(X1B + (size_t)tok * D + col), y0 = *(const u32x2*)(YD + r0 * D + col), y1 = *(const u32x2*)(YD + r1 * D + col);
            v[j][0] = ALPHA * bflo(a.x) + (g0 * bflo(y0.x) + g1 * bflo(y1.x)); v[j][1] = ALPHA * bfhi(a.x) + (g0 * bfhi(y0.x) + g1 * bfhi(y1.x));
            v[j][2] = ALPHA * bflo(a.y) + (g0 * bflo(y0.y) + g1 * bflo(y1.y)); v[j][3] = ALPHA * bfhi(a.y) + (g0 * bfhi(y0.y) + g1 * bfhi(y1.y));
            s += (v[j][0] + v[j][1]) + (v[j][2] + v[j][3]); }
        const float mean = wave_sum(s) * (1.f / D); float s2 = 0.f;
#pragma unroll
        for (int j = 0; j < 4; ++j) { v[j] = v[j] - mean; s2 += (v[j][0] * v[j][0] + v[j][1] * v[j][1]) + (v[j][2] * v[j][2] + v[j][3] * v[j][3]); }
        const float rstd = 1.0f / sqrtf(wave_sum(s2) * (1.f / D) + LN_EPS);
#pragma unroll
        for (int j = 0; j < 4; ++j) { const int col = 4 * C.lane + 256 * j; const f32x4 g4 = *(const f32x4*)(lg + col), b4 = *(const f32x4*)(lb + col);
            const f32x4 o = v[j] * rstd * g4 + b4;
            if (layer == 0) *(u32x2*)(X2B + (size_t)tok * D + col) = (u32x2){pk2(o[0], o[1]), pk2(o[2], o[3])};
            else *(f32x4*)(A.out + (size_t)tok * D + col) = o; }
    }
}

__global__ void __launch_bounds__(NTHREADS, 2) yoco_fwd(Args args) {
    extern __shared__ __attribute__((aligned(16))) unsigned char lds_raw[];
    Ctx C;
    C.ws = args.ws; C.lds = (LAS unsigned char*)lds_raw;
    C.tid = threadIdx.x; C.lane = C.tid & 63; C.wave = __builtin_amdgcn_readfirstlane(C.tid >> 6);
    C.G = gridDim.x; C.bid = blockIdx.x; C.gw = C.bid * NWAVES + C.wave; C.NGW = C.G * NWAVES;
    unsigned char* ws = args.ws;
#define PHASE_WS() do { ws = launder(args.ws); C.ws = ws; C.tid = launder_v((int)threadIdx.x); C.lane = C.tid & 63; } while (0)
    volatile LAS unsigned* misc = (volatile LAS unsigned*)(C.lds + LDS_MISC);
    for (int u = C.tid; u < 64; u += NTHREADS) misc[u] = 0u;
    __syncthreads();
    XcdBarrier bar; bar.bar = (unsigned*)(ws + WS_CTL) + CW_BAR; bar.x = 0; bar.st = misc + 60;
    const int lo = args.ph_lo, hi = args.ph_hi;
    if (hi - lo > 1) bar = xcd_barrier_post((unsigned*)(ws + WS_CTL) + CW_BAR, misc + 60);
#define IN(k) (lo <= (k) && (k) < hi)
#define SEAM(k) do { if (IN(k) && IN((k) + 1)) xcd_barrier(bar); } while (0)

    if (IN(0)) { PHASE_WS(); p0_prologue(C, args); SEAM(0); }

    if (IN(1)) {
        PHASE_WS();
        { pg8::Gemm g{(const bf16_t*)(ws + WS_XB), (const bf16_t*)(ws + WS_BT_INA), T, 1792, D}; pg8::StaticOrder S; S.init(T, 1792, C.G, C.bid);
          EpiProjA E{(bf16_t*)(ws + WS_U), (bf16_t*)(ws + WS_GV), (bf16_t*)(ws + WS_QM0)};
          pg8::gemm_phase<EpiProjA, pg8::StaticOrder>(C.lds, g, S, E, nullptr, C.tid); }
        { pg8::Gemm g{(const bf16_t*)(ws + WS_MEMB), (const bf16_t*)(ws + WS_BT_MEM), NB * NMEM, 1024, D}; SmallOrder S{4, 32, C.bid - (C.G - 32)};
          EpiPlain E{(bf16_t*)(ws + WS_MKV), 1024, 4};
          pg8::gemm_phase<EpiPlain, SmallOrder>(C.lds, g, S, E, nullptr, C.tid); }
        SEAM(1);
    }
    if (IN(2)) {
        PHASE_WS();
        sg_mfma(C, args);
        memattn_mfma(C, (const bf16_t*)(ws + WS_QM0), (const bf16_t*)(ws + WS_MKV), 0, 256, (bf16_t*)(ws + WS_CAT), D, SGW);
        SEAM(2);
    }
    if (IN(3)) {
        PHASE_WS();
        pg8::Gemm g{(const bf16_t*)(ws + WS_CAT), (const bf16_t*)(ws + WS_BT_OUTA), T, D, D}; pg8::StaticOrder S; S.init(T, D, C.G, C.bid);
        EpiResid<false> E{(const void*)args.in[0], (float*)(ws + WS_Y)};
        pg8::gemm_phase<EpiResid<false>, pg8::StaticOrder>(C.lds, g, S, E, nullptr, C.tid);
        SEAM(3);
    }
#pragma unroll 1
    for (int layer = 0; layer < 2; ++layer) {
        const int pb = 4 + 9 * layer;
        if (IN(pb)) { PHASE_WS(); ln_route(C, args, layer); SEAM(pb); }
        if (IN(pb + 1)) { PHASE_WS(); moe_prefix(C, layer); moe_gather(C, args); SEAM(pb + 1); }
        if (IN(pb + 2)) {
            PHASE_WS();
            moe_prefix(C, layer);
            pg8::Gemm g{(const bf16_t*)(ws + WS_YD), (const bf16_t*)(ws + WS_WGU) + (size_t)layer * 16 * 2097152, 0, 0, D};
            MoeOrder S{(const LAS int*)(C.lds + LDS_MISC), 8, C.G, C.bid};
            EpiSwiGLU E{(bf16_t*)(ws + WS_ACT)};
            pg8::gemm_phase<EpiSwiGLU, MoeOrder>(C.lds, g, S, E, nullptr, C.tid);
            SEAM(pb + 2);
        }
        if (IN(pb + 3)) {
            PHASE_WS();
            moe_prefix(C, layer);
            pg8::Gemm g{(const bf16_t*)(ws + WS_ACT), (const bf16_t*)(ws + WS_WD) + (size_t)layer * 16 * 1048576, 0, 0, D};
            MoeOrder S{(const LAS int*)(C.lds + LDS_MISC), 4, C.G, C.bid};
            EpiPlain E{(bf16_t*)(ws + WS_YD), 1024, 4};
            pg8::gemm_phase<EpiPlain, MoeOrder>(C.lds, g, S, E, nullptr, C.tid);
            SEAM(pb + 3);
        }
        if (IN(pb + 4)) { PHASE_WS(); moe_prefix(C, layer); combine_ln2(C, args, layer); if (layer == 0) SEAM(pb + 4); }
        if (layer == 0) {
            if (IN(9)) {
                PHASE_WS();
                pg8::Gemm g{(const bf16_t*)(ws + WS_XB), (const bf16_t*)(ws + WS_BT_B), T, 2560, D}; pg8::StaticOrder S; S.init(T, 2560, C.G, C.bid);
                EpiProjB E{(bf16_t*)(ws + WS_K), (bf16_t*)(ws + WS_V), (bf16_t*)(ws + WS_Q), (bf16_t*)(ws + WS_QM1)};
                pg8::gemm_phase<EpiProjB, pg8::StaticOrder>(C.lds, g, S, E, nullptr, C.tid);
                SEAM(9);
            }
            if (IN(10)) {
                PHASE_WS();
                dilattn_mfma(C);
                memattn_mfma(C, (const bf16_t*)(ws + WS_QM1), (const bf16_t*)(ws + WS_MKV), 512, 768, (bf16_t*)(ws + WS_CAT2), 512, 256);
                SEAM(10);
            }
            if (IN(11)) { PHASE_WS(); dil_merge(C, args); SEAM(11); }
            if (IN(12)) {
                PHASE_WS();
                pg8::Gemm g{(const bf16_t*)(ws + WS_CAT2), (const bf16_t*)(ws + WS_BT_OUTB), T, D, 512}; pg8::StaticOrder S; S.init(T, D, C.G, C.bid);
                EpiResid<true> E{(const void*)(ws + WS_XB), (float*)(ws + WS_Y)};
                pg8::gemm_phase<EpiResid<true>, pg8::StaticOrder>(C.lds, g, S, E, nullptr, C.tid);
                SEAM(12);
            }
        }
    }
#undef IN
#undef SEAM
}
}

extern "C" void kernel_launch(void* const* d_in, const int* in_sizes, int n_in, void* d_out, int out_size, void* d_ws, size_t ws_size, hipStream_t stream) {
    using namespace mk;
    static int grid = 0;
    if (grid == 0) {
        if (n_in != 23 || out_size != T * D || ws_size < WS_END) { fprintf(stderr, "kernel_launch: unexpected shapes (n_in %d, out %d, ws %zu)\n", n_in, out_size, ws_size); grid = -1; return; }
        int dev = 0, cus = 0, per_cu = 0;
        if (hipGetDevice(&dev) != hipSuccess || hipDeviceGetAttribute(&cus, hipDeviceAttributeMultiprocessorCount, dev) != hipSuccess) { grid = -1; return; }
        if (hipFuncSetAttribute((const void*)yoco_fwd, hipFuncAttributeMaxDynamicSharedMemorySize, LDS_BYTES) != hipSuccess) { fprintf(stderr, "kernel_launch: hipFuncSetAttribute failed\n"); grid = -1; return; }
        if (hipOccupancyMaxActiveBlocksPerMultiprocessor(&per_cu, (const void*)yoco_fwd, NTHREADS, LDS_BYTES) != hipSuccess || per_cu < 1)
            fprintf(stderr, "kernel_launch: occupancy query reports %d workgroups per CU\n", per_cu);
        (void)hipGetLastError();
        grid = cus;
    }
    if (grid < 0) return;
    (void)hipMemsetAsync((char*)d_ws + WS_CTL, 0, CTL_ZERO_BYTES, stream);
    Args a{};
    for (int i = 0; i < 23; ++i) a.in[i] = (const float*)d_in[i];
    a.out = (float*)d_out; a.ws = (unsigned char*)d_ws;
    constexpr int NL = MK_N_LAUNCHES;
    for (int li = 0; li < NL; ++li) {
        a.ph_lo = (NL == NPHASE) ? li : (li * NPHASE) / NL; a.ph_hi = (NL == NPHASE) ? li + 1 : ((li + 1) * NPHASE) / NL;
        hipLaunchKernelGGL(yoco_fwd, dim3(grid), dim3(NTHREADS), LDS_BYTES, stream, a);
    }
}
```

```cpp
#include <hip/hip_runtime.h>
#include <cstdio>
#include <cstdint>
namespace pg8 {
#define PG8_LAS __attribute__((address_space(3)))
typedef unsigned short bf16_t;
typedef short bf16x8 __attribute__((ext_vector_type(8)));
typedef float f32x4 __attribute__((ext_vector_type(4)));
typedef unsigned u32x4 __attribute__((ext_vector_type(4)));
constexpr int BM = 256, BK = 64, HALF = 128, HTB = HALF * BK * 2  , STAGE_BYTES = 8 * HTB, NXCD = 8, WGM = 8;

__host__ __device__ __forceinline__ int lds_byte(int r, int c) { const int st = (r >> 4) * 2 + (c >> 5), rr = r & 15, cc = c & 31, ob = rr * 64 + cc * 2; return st * 1024 + (ob ^ (((ob >> 9) & 1) << 5)); }
__host__ __device__ __forceinline__ void stage_rc(int b, int& R, int& C) { const int st = b / 1024, sb = b % 1024, swz = sb ^ (((sb >> 9) & 1) << 5); R = (st >> 1) * 16 + swz / 64; C = (st & 1) * 32 + (swz % 64) / 2; }
__host__ __device__ __forceinline__ int perm32(int rho) { const int n = rho >> 4, i = rho & 15; return 8 * (i >> 2) + 4 * n + (i & 3); }

struct Unit { int pm, pn; };
struct Gemm { const bf16_t* A; const bf16_t* Bt; int M, N, K; };

struct StaticOrder {
    int nM, nN, nwg, G, c;
    __host__ __device__ void init(int M, int N, int G_, int c_) { nM = M / BM; nN = N / BM; nwg = nM * nN; G = G_; c = c_; }
    __host__ __device__ bool next(int i, Unit& u) const {
        const long L = (long)i * G + c; if (L >= nwg) return false;
        int wgid = (int)L; { const int q = nwg / NXCD, r = nwg % NXCD, xcd = wgid % NXCD, off = wgid / NXCD; wgid = (xcd < r ? xcd * (q + 1) : r * (q + 1) + (xcd - r) * q) + off; }
        const int nig = WGM * nN, gid = wgid / nig, fm = gid * WGM, gsz = (nM - fm) < WGM ? (nM - fm) : WGM;
        u.pm = fm + ((wgid % nig) % gsz); u.pn = (wgid % nig) / gsz; return true;
    }
    __device__ __forceinline__ void a_ready(const Unit&) const {}
    __device__ __forceinline__ void done(const Unit&) const {}
    __device__ __forceinline__ int arow(int, const Unit& u, int r) const { return u.pm * BM + r; }
};
__device__ __forceinline__ unsigned cvt_pk_bf16(float lo, float hi) { unsigned r; asm volatile("v_cvt_pk_bf16_f32 %0, %1, %2" : "=v"(r) : "v"(lo), "v"(hi)); return r; }
typedef float f32x2 __attribute__((ext_vector_type(2)));
__device__ __forceinline__ f32x2 gelu_pk(f32x2 v) {
    const f32x2 av = __builtin_elementwise_abs(v), d = av * 0.2316418882f + 1.0f;
    f32x2 t; t.x = __builtin_amdgcn_rcpf(d.x); t.y = __builtin_amdgcn_rcpf(d.y);
    f32x2 q = t * 0.5307027145f + (-0.7265760135f); q = q * t + 0.7107068705f; q = q * t + (-0.142248368f); q = q * t + 0.127414796f; q = q * t;
    const f32x2 s = (v * v) * (-0.72134752044f);
    f32x2 e; e.x = __builtin_amdgcn_exp2f(s.x); e.y = __builtin_amdgcn_exp2f(s.y);
    const f32x2 m = v * (q * e), r = v - m;
    f32x2 o; o.x = v.x < 0.f ? m.x : r.x; o.y = v.y < 0.f ? m.y : r.y; return o;
}
template <class Epi, class Sched, bool STAMP = false>
__device__ __forceinline__ void gemm_phase(PG8_LAS unsigned char* lds, const Gemm g, const Sched& S, const Epi& E, unsigned long long* stamps, const int tid) {
    const int wid = __builtin_amdgcn_readfirstlane(tid >> 6), lane = tid & 63, wr = wid >> 2, wc = wid & 3, fr = lane & 15, fq = lane >> 4;
    const int K = g.K, nt = K / BK;
    int ts_lo = 0, ts_hi = 0, nts = 0; const unsigned long long rt_entry = STAMP ? (unsigned long long)wall_clock64() : 0ull;
#define PG8_STAMP() do { if (STAMP && wid == 0 && nts < 64) { const unsigned long long _c = (unsigned long long)clock64(); \
        ts_lo = (lane == nts) ? (int)(unsigned)_c : ts_lo; ts_hi = (lane == nts) ? (int)(unsigned)(_c >> 32) : ts_hi; ++nts; } } while (0)
    PG8_STAMP();
    unsigned colA[2], voffB[2]; int rowA[2];
#pragma unroll
    for (int i = 0; i < 2; ++i) { int R, C; stage_rc(tid * 16 + i * 8192, R, C); const int Rb = Epi::PERM ? ((R & ~31) + perm32(R & 31)) : R;
        rowA[i] = R; colA[i] = (unsigned)C * 2u; voffB[i] = (unsigned)(Rb * K + C) * 2u; }
#define PG8_AOFF(dst, uidx, un) do { _Pragma("unroll") for (int _h = 0; _h < 2; ++_h) _Pragma("unroll") for (int _i = 0; _i < 2; ++_i) \
        dst[_h][_i] = (unsigned)S.arow((uidx), (un), _h * HALF + rowA[_i]) * (unsigned)(K * 2) + colA[_i]; } while (0)
    const size_t kstep = (size_t)(BK * 2);
    const size_t hstep = (size_t)HALF * K * 2;
    const size_t tstep = 2 * hstep;
    const unsigned ldsw = (unsigned)wid * 1024u;
    const int aoff = lds_byte(wr * 64 + fr, fq * 8), boff = lds_byte(wc * 32 + fr, fq * 8);
#define PG8_SA(b, h) (((b) * 2 + (h)) * HTB)
#define PG8_SB(b, h) ((4 + (b) * 2 + (h)) * HTB)
#define PG8_STAGE(bufoff, gbase, voff) do { _Pragma("unroll") for (int _i = 0; _i < 2; ++_i) \
        __builtin_amdgcn_global_load_lds((const unsigned*)((const char*)(gbase) + (voff)[_i]), (PG8_LAS unsigned*)(lds + (bufoff) + ldsw + _i * 8192), 16, 0, 0); } while (0)
#define PG8_LDA(dst, b, h) do { _Pragma("unroll") for (int m = 0; m < 4; ++m) _Pragma("unroll") for (int k = 0; k < 2; ++k) dst[m][k] = *(const PG8_LAS bf16x8*)(lds + PG8_SA(b, h) + aoff + m * 2048 + k * 1024); } while (0)
#define PG8_LDB(dst, b, h) do { _Pragma("unroll") for (int n = 0; n < 2; ++n) _Pragma("unroll") for (int k = 0; k < 2; ++k) dst[n][k] = *(const PG8_LAS bf16x8*)(lds + PG8_SB(b, h) + boff + n * 2048 + k * 1024); } while (0)
#define PG8_MMA(ai, bj, At, Bt) do { __builtin_amdgcn_s_setprio(1); _Pragma("unroll") for (int m = 0; m < 4; ++m) _Pragma("unroll") for (int n = 0; n < 2; ++n) _Pragma("unroll") for (int k = 0; k < 2; ++k) \
        acc[ai][bj][m][n] = __builtin_amdgcn_mfma_f32_16x16x32_bf16(Bt[n][k], At[m][k], acc[ai][bj][m][n], 0, 0, 0); __builtin_amdgcn_s_setprio(0); } while (0)
#define PG8_WAIT_V(n) asm volatile("s_waitcnt vmcnt(" #n ")" ::: "memory")
#define PG8_WAIT_L(n) asm volatile("s_waitcnt lgkmcnt(" #n ")" ::: "memory")
#define PG8_BAR __builtin_amdgcn_s_barrier()
#define PG8_SCHED __builtin_amdgcn_sched_barrier(0)
    Unit cur, nxt; int ui = 0;
    if (!S.next(0, cur)) return;
    f32x4 acc[2][2][4][2];
#pragma unroll
    for (int a = 0; a < 2; ++a)
#pragma unroll
        for (int b = 0; b < 2; ++b)
#pragma unroll
            for (int m = 0; m < 4; ++m)
#pragma unroll
                for (int n = 0; n < 2; ++n) acc[a][b][m][n] = (f32x4){0.f, 0.f, 0.f, 0.f};
    bf16x8 At[4][2], B0[2][2], B1[2][2];
    const char* Ab = (const char*)g.A; const char* cB = (const char*)g.Bt + (size_t)cur.pn * tstep;
    unsigned cuA[2][2], nxA[2][2];
    S.a_ready(cur);
    PG8_AOFF(cuA, 0, cur);
    PG8_STAGE(PG8_SB(0, 0), cB, voffB); PG8_STAGE(PG8_SA(0, 0), Ab, cuA[0]); PG8_STAGE(PG8_SB(0, 1), cB + hstep, voffB); PG8_STAGE(PG8_SA(0, 1), Ab, cuA[1]);
    if (wr == 1) PG8_BAR;
    PG8_WAIT_V(4); PG8_BAR;
    PG8_STAGE(PG8_SB(1, 0), cB + kstep, voffB); PG8_STAGE(PG8_SA(1, 0), Ab + kstep, cuA[0]); PG8_STAGE(PG8_SB(1, 1), cB + hstep + kstep, voffB);
    PG8_WAIT_V(6); PG8_BAR;
    PG8_STAMP();
    for (;;) {
        const bool has_next = S.next(ui + 1, nxt);
        const char* nB = has_next ? (const char*)g.Bt + (size_t)nxt.pn * tstep : cB;
        if (has_next) PG8_AOFF(nxA, ui + 1, nxt);
        else { _Pragma("unroll") for (int _h = 0; _h < 2; ++_h) _Pragma("unroll") for (int _i = 0; _i < 2; ++_i) nxA[_h][_i] = cuA[_h][_i]; }
        for (int t = 0; t < nt; t += 2) {
            const bool last = (t == nt - 2);
            const char* a1 = Ab + (size_t)(t + 1) * kstep;
            const char* a2 = last ? Ab : Ab + (size_t)(t + 2) * kstep; const char* b2 = last ? nB : cB + (size_t)(t + 2) * kstep;
            const char* a3 = a2 + kstep; const char* b3 = b2 + kstep;
            unsigned v2A[2][2];
            _Pragma("unroll") for (int _h = 0; _h < 2; ++_h) _Pragma("unroll") for (int _i = 0; _i < 2; ++_i) v2A[_h][_i] = last ? nxA[_h][_i] : cuA[_h][_i];
            if (last && has_next) S.a_ready(nxt);
            PG8_LDB(B0, 0, 0); PG8_SCHED; PG8_LDA(At, 0, 0); PG8_STAGE(PG8_SA(1, 1), a1, cuA[1]);
            PG8_WAIT_L(8); PG8_BAR; PG8_WAIT_L(0); PG8_MMA(0, 0, At, B0); PG8_BAR; PG8_SCHED;
            PG8_LDB(B1, 0, 1); PG8_STAGE(PG8_SB(0, 0), b2, voffB);
            PG8_BAR; PG8_WAIT_L(0); PG8_MMA(0, 1, At, B1); PG8_BAR;
            PG8_LDA(At, 0, 1); PG8_STAGE(PG8_SA(0, 0), a2, v2A[0]);
            PG8_BAR; PG8_WAIT_L(0); PG8_MMA(1, 0, At, B0); PG8_BAR; PG8_SCHED;
            PG8_STAGE(PG8_SB(0, 1), b2 + hstep, voffB);
            PG8_WAIT_V(6); PG8_BAR; PG8_MMA(1, 1, At, B1); PG8_BAR;
            PG8_LDB(B0, 1, 0); PG8_SCHED; PG8_LDA(At, 1, 0); PG8_STAGE(PG8_SA(0, 1), a2, v2A[1]);
            PG8_WAIT_L(8); PG8_BAR; PG8_WAIT_L(0); PG8_MMA(0, 0, At, B0); PG8_BAR; PG8_SCHED;
            PG8_LDB(B1, 1, 1); PG8_STAGE(PG8_SB(1, 0), b3, voffB);
            PG8_BAR; PG8_WAIT_L(0); PG8_MMA(0, 1, At, B1); PG8_BAR;
            PG8_LDA(At, 1, 1); PG8_STAGE(PG8_SA(1, 0), a3, v2A[0]);
            PG8_BAR; PG8_WAIT_L(0); PG8_MMA(1, 0, At, B0); PG8_BAR; PG8_SCHED;
            PG8_STAGE(PG8_SB(1, 1), b3 + hstep, voffB);
            PG8_WAIT_V(6); PG8_BAR; PG8_MMA(1, 1, At, B1); PG8_BAR;
        }
        PG8_STAMP();
        if constexpr (!Epi::AFTER_DRAIN) { E(acc, cur, wr, wc, fr, fq); S.done(cur); }
        PG8_STAMP();
        if (!has_next) break;
#pragma unroll
        for (int a = 0; a < 2; ++a)
#pragma unroll
            for (int b = 0; b < 2; ++b)
#pragma unroll
                for (int m = 0; m < 4; ++m)
#pragma unroll
                    for (int n = 0; n < 2; ++n) acc[a][b][m][n] = (f32x4){0.f, 0.f, 0.f, 0.f};
        cur = nxt; cB = nB; ++ui;
        _Pragma("unroll") for (int _h = 0; _h < 2; ++_h) _Pragma("unroll") for (int _i = 0; _i < 2; ++_i) cuA[_h][_i] = nxA[_h][_i];
    }
    PG8_WAIT_V(0);
    if (wr == 0) PG8_BAR;
    PG8_BAR;
    if constexpr (Epi::AFTER_DRAIN) { E.fused(acc, cur, wr, wc, fr, fq, lds, wid, lane); S.done(cur); }
    PG8_STAMP();
    if (STAMP && wid == 0) { stamps[lane] = lane < nts ? (((unsigned long long)(unsigned)ts_hi << 32) | (unsigned)ts_lo) : 0ull;
        if (lane == 62) stamps[62] = rt_entry; if (lane == 63) stamps[63] = (unsigned long long)wall_clock64(); }
#undef PG8_STAMP
#undef PG8_SA
#undef PG8_SB
#undef PG8_STAGE
#undef PG8_AOFF
#undef PG8_LDA
#undef PG8_LDB
#undef PG8_MMA
#undef PG8_WAIT_V
#undef PG8_WAIT_L
#undef PG8_BAR
#undef PG8_SCHED
}
}

namespace mk {
using pg8::bf16_t; using pg8::f32x4; using pg8::u32x4; using pg8::Unit; using pg8::cvt_pk_bf16;
#define LAS __attribute__((address_space(3)))
typedef float f32x2 __attribute__((ext_vector_type(2)));
typedef unsigned u32x2 __attribute__((ext_vector_type(2)));

#ifndef MK_N_LAUNCHES
#define MK_N_LAUNCHES 1
#endif
constexpr int NPHASE = 16;
constexpr int NB = 8, SEQ = 2048, D = 1024, T = NB * SEQ, NMEM = 256, SGW = 768, NSG = 12, HD = 64, CH = 128;
constexpr int NEXP = 16, LISTCAP = 16384;
constexpr float ALPHA = 1.41421356237f;
constexpr float LN_EPS = 1e-5f, ATT_SCALE = 0.125f;
constexpr int NWAVES = 8, NTHREADS = 512;

constexpr size_t MiB = 1u << 20;
constexpr size_t WS_CTL = 0, CTL_ZERO_BYTES = 1 * MiB;
constexpr size_t WS_TOKE = 1 * MiB, WS_TOKP = WS_TOKE + 128 * 1024, WS_TOKG = WS_TOKP + 128 * 1024;
constexpr size_t WS_LIST = 2 * MiB, WS_LSE = 3 * MiB, WS_SGWB = 4 * MiB;
constexpr size_t WS_MKV = 8 * MiB, WS_MEMB = 12 * MiB;
constexpr size_t WS_BT_INA = 18 * MiB, WS_BT_OUTA = 22 * MiB, WS_BT_B = 24 * MiB, WS_BT_OUTB = 29 * MiB, WS_BT_MEM = 30 * MiB;
constexpr size_t WS_WGU = 32 * MiB, WS_WD = 160 * MiB;
constexpr size_t WS_A = 224 * MiB;
constexpr size_t WS_U = WS_A, WS_GV = WS_A + 24 * MiB, WS_QM0 = WS_A + 48 * MiB;
constexpr size_t WS_K = WS_A, WS_V = WS_A + 24 * MiB, WS_Q = WS_A + 48 * MiB, WS_QM1 = WS_A + 72 * MiB;
constexpr size_t WS_ACT = WS_A;
constexpr size_t WS_XB = 304 * MiB;
constexpr size_t WS_C = 336 * MiB;
constexpr size_t WS_CAT = WS_C, WS_OG = WS_C, WS_CAT2 = WS_C + 24 * MiB;
constexpr size_t WS_Y = 376 * MiB;
constexpr size_t WS_YD = 336 * MiB;
constexpr size_t WS_X1B = 440 * MiB;
constexpr size_t WS_END = 472 * MiB;
constexpr int CW_TMO = 0, CW_BAR = 4096, CW_CNT = 16384;
constexpr int LDS_TOKS = 131072 + 1024, MAX_UNITS = 8;
constexpr int LDS_MISC = 131072;
constexpr int LDS_BYTES = 147456;
static_assert(LDS_TOKS + MAX_UNITS * 1024 <= LDS_BYTES, "LDS map");

#define LDS_WAIT() asm volatile("s_waitcnt lgkmcnt(0)" ::: "memory")
#define VM_WAIT() asm volatile("s_waitcnt vmcnt(0)" ::: "memory")
__device__ __forceinline__ unsigned f2bf(float f) { unsigned u = __builtin_bit_cast(unsigned, f); return (u + 0x7fffu + ((u >> 16) & 1u)) >> 16; }
__device__ __forceinline__ unsigned pk2(float lo, float hi) { return f2bf(lo) | (f2bf(hi) << 16); }
__device__ __forceinline__ float bflo(unsigned w) { return __uint_as_float(w << 16); }
__device__ __forceinline__ float bfhi(unsigned w) { return __uint_as_float(w & 0xffff0000u); }
__device__ __forceinline__ float bf1(bf16_t v) { return __uint_as_float(((unsigned)v) << 16); }
__device__ __forceinline__ float wave_sum(float v) {
#pragma unroll
    for (int o = 1; o < 64; o <<= 1) v += __shfl_xor(v, o);
    return v;
}
__device__ __forceinline__ float wave_max(float v) {
#pragma unroll
    for (int o = 1; o < 64; o <<= 1) v = fmaxf(v, __shfl_xor(v, o));
    return v;
}

#define XB_TMO      128
#define XB_XCNT(j)  (256  + 64 * (j))
#define XB_XSUB(j)  (1280 + 64 * (j))
#define XB_XGEN(j)  (2304 + 64 * (j))
#define XB_TOP      3328
#define XB_TOPGEN   3392
#define XCD_BAR_WORDS 3456
#define XB_SPIN_CAP (1u << 18)
__device__ __forceinline__ unsigned xb_ld(unsigned* p)              { return __hip_atomic_load(p, __ATOMIC_RELAXED, __HIP_MEMORY_SCOPE_AGENT); }
__device__ __forceinline__ unsigned xb_add(unsigned* p, unsigned v) { return __hip_atomic_fetch_add(p, v, __ATOMIC_RELAXED, __HIP_MEMORY_SCOPE_AGENT); }
__device__ __forceinline__ unsigned xb_xcc_id() { return (unsigned)__builtin_amdgcn_s_getreg((3 << 11) | 20) & 0xFu; }
#define XB_SPIN(cond, bar) do { unsigned _sp = 0; while (cond) { __builtin_amdgcn_s_sleep(1); \
    if ((++_sp & 255u) == 0u) { if (xb_ld(&(bar)[XB_TMO])) break; if (_sp > XB_SPIN_CAP) { atomicAdd(&(bar)[XB_TMO], 1u); break; } } } } while (0)
struct XcdBarrier { unsigned* bar; unsigned x; volatile LAS unsigned* st; };
__device__ __forceinline__ XcdBarrier xcd_barrier_post(unsigned* bar, volatile LAS unsigned* st) {
    XcdBarrier b; b.bar = bar; b.x = xb_xcc_id(); b.st = st;
    if (threadIdx.x == 0) (void)xb_add(&bar[XB_XCNT(b.x)], 1u);
    return b;
}
__device__ __forceinline__ void xcd_barrier_complete(unsigned* bar, unsigned x, unsigned& nloc, unsigned& nx) {
    const unsigned G = gridDim.x * gridDim.y * gridDim.z;
    unsigned sum, cnt, mine, sp = 0u;
    for (;;) {
        sum = 0u; cnt = 0u; mine = 0u;
#pragma unroll
        for (unsigned j = 0; j < 16; ++j) { const unsigned c = xb_ld(&bar[XB_XCNT(j)]); sum += c; cnt += (c > 0u) ? 1u : 0u; mine = (j == x) ? c : mine; }
        if (sum == G) break;
        __builtin_amdgcn_s_sleep(1);
        if ((++sp & 255u) == 0u) { if (xb_ld(&bar[XB_TMO])) break; if (sp > XB_SPIN_CAP) { atomicAdd(&bar[XB_TMO], 1u); break; } }
    }
    nloc = mine > 0u ? mine : 1u; nx = cnt > 0u ? cnt : 1u;
}
__device__ __forceinline__ void xcd_barrier(const XcdBarrier& b) {
    asm volatile("s_waitcnt vmcnt(0)" ::: "memory");
    __syncthreads();
    if (threadIdx.x == 0) {
        unsigned* bar = b.bar;
        __builtin_amdgcn_s_waitcnt(0);
        unsigned nloc = b.st[0], nx = b.st[1];
        if (nloc == 0u) { xcd_barrier_complete(bar, b.x, nloc, nx); b.st[0] = nloc; b.st[1] = nx; }
        const unsigned old = xb_add(&bar[XB_XSUB(b.x)], 1u);
        const unsigned gen = old / nloc;
        if (old + 1u == (gen + 1u) * nloc) {
            __builtin_amdgcn_fence(__ATOMIC_RELEASE, "agent");
            asm volatile("s_waitcnt vmcnt(0)" ::: "memory");
            const unsigned og = xb_add(&bar[XB_TOP], 1u);
            const unsigned tg = og / nx;
            if (og + 1u == (tg + 1u) * nx) xb_add(&bar[XB_TOPGEN], 1u);
            else XB_SPIN(xb_ld(&bar[XB_TOPGEN]) == tg, bar);
            __builtin_amdgcn_fence(__ATOMIC_ACQUIRE, "agent");
            xb_add(&bar[XB_XGEN(b.x)], 1u);
            asm volatile("s_waitcnt vmcnt(0)" ::: "memory");
        } else {
            XB_SPIN(xb_ld(&bar[XB_XGEN(b.x)]) == gen, bar);
            __builtin_amdgcn_fence(__ATOMIC_ACQUIRE, "agent");
            asm volatile("s_waitcnt vmcnt(0)" ::: "memory");
        }
    }
    __syncthreads();
}


struct EpiProjA {
    static constexpr bool PERM = true, AFTER_DRAIN = false;
    bf16_t *u, *gv, *qm;
    __device__ __forceinline__ void operator()(const f32x4 (&acc)[2][2][4][2], const Unit& un, int wr, int wc, int fr, int fq) const {
        const int row0 = un.pm * 256 + wr * 64 + fr;
        bf16_t* base; int ldc, colt; bool act; float sc = 1.f;
        if (un.pn < 3) { base = u; ldc = SGW; colt = un.pn * 256; act = true; }
        else if (un.pn < 6) { base = gv; ldc = SGW; colt = (un.pn - 3) * 256; act = true; }
        else { base = qm; ldc = 256; colt = 0; act = false; sc = ATT_SCALE; }
        const int col0 = colt + wc * 32 + 8 * fq;
#pragma unroll
        for (int ai = 0; ai < 2; ++ai)
#pragma unroll
            for (int m = 0; m < 4; ++m) { bf16_t* rowp = base + (size_t)(row0 + ai * 128 + m * 16) * ldc + col0;
#pragma unroll
                for (int bj = 0; bj < 2; ++bj) { f32x4 v0 = acc[ai][bj][m][0], v1 = acc[ai][bj][m][1];
                    if (act) { pg8::f32x2 a = pg8::gelu_pk((pg8::f32x2){v0[0], v0[1]}), b = pg8::gelu_pk((pg8::f32x2){v0[2], v0[3]}), c = pg8::gelu_pk((pg8::f32x2){v1[0], v1[1]}), d = pg8::gelu_pk((pg8::f32x2){v1[2], v1[3]});
                        v0 = (f32x4){a.x, a.y, b.x, b.y}; v1 = (f32x4){c.x, c.y, d.x, d.y}; }
                    v0 = v0 * sc; v1 = v1 * sc;
                    u32x4 w; w.x = cvt_pk_bf16(v0[0], v0[1]); w.y = cvt_pk_bf16(v0[2], v0[3]); w.z = cvt_pk_bf16(v1[0], v1[1]); w.w = cvt_pk_bf16(v1[2], v1[3]);
                    *(u32x4*)(rowp + bj * 128) = w; } }
    }
};
struct EpiProjB {
    static constexpr bool PERM = true, AFTER_DRAIN = false;
    bf16_t *k, *v, *q, *qm;
    __device__ __forceinline__ void operator()(const f32x4 (&acc)[2][2][4][2], const Unit& un, int wr, int wc, int fr, int fq) const {
        const int row0 = un.pm * 256 + wr * 64 + fr;
        bf16_t* base; int ldc, colt; float sc = 1.f;
        if (un.pn < 3) { base = k; ldc = SGW; colt = un.pn * 256; }
        else if (un.pn < 6) { base = v; ldc = SGW; colt = (un.pn - 3) * 256; }
        else if (un.pn < 9) { base = q; ldc = SGW; colt = (un.pn - 6) * 256; sc = ATT_SCALE; }
        else { base = qm; ldc = 256; colt = 0; sc = ATT_SCALE; }
        const int col0 = colt + wc * 32 + 8 * fq;
#pragma unroll
        for (int ai = 0; ai < 2; ++ai)
#pragma unroll
            for (int m = 0; m < 4; ++m) { bf16_t* rowp = base + (size_t)(row0 + ai * 128 + m * 16) * ldc + col0;
#pragma unroll
                for (int bj = 0; bj < 2; ++bj) { f32x4 v0 = acc[ai][bj][m][0] * sc, v1 = acc[ai][bj][m][1] * sc;
                    u32x4 w; w.x = cvt_pk_bf16(v0[0], v0[1]); w.y = cvt_pk_bf16(v0[2], v0[3]); w.z = cvt_pk_bf16(v1[0], v1[1]); w.w = cvt_pk_bf16(v1[2], v1[3]);
                    *(u32x4*)(rowp + bj * 128) = w; } }
    }
};
struct EpiPlain {
    static constexpr bool PERM = true, AFTER_DRAIN = false;
    bf16_t* O; int ldc, ntn;
    __device__ __forceinline__ void operator()(const f32x4 (&acc)[2][2][4][2], const Unit& un, int wr, int wc, int fr, int fq) const {
        const int row0 = un.pm * 256 + wr * 64 + fr;
        const int col0 = (un.pn % ntn) * 256 + wc * 32 + 8 * fq;
#pragma unroll
        for (int ai = 0; ai < 2; ++ai)
#pragma unroll
            for (int m = 0; m < 4; ++m) { bf16_t* rowp = O + (size_t)(row0 + ai * 128 + m * 16) * ldc + col0;
#pragma unroll
                for (int bj = 0; bj < 2; ++bj) { const f32x4 v0 = acc[ai][bj][m][0], v1 = acc[ai][bj][m][1];
                    u32x4 w; w.x = cvt_pk_bf16(v0[0], v0[1]); w.y = cvt_pk_bf16(v0[2], v0[3]); w.z = cvt_pk_bf16(v1[0], v1[1]); w.w = cvt_pk_bf16(v1[2], v1[3]);
                    *(u32x4*)(rowp + bj * 128) = w; } }
    }
};
struct EpiSwiGLU {
    static constexpr bool PERM = true, AFTER_DRAIN = false;
    bf16_t* O;
    __device__ __forceinline__ void operator()(const f32x4 (&acc)[2][2][4][2], const Unit& un, int wr, int wc, int fr, int fq) const {
        const int row0 = un.pm * 256 + wr * 64 + fr;
        const int col0 = (un.pn & 7) * 128 + wc * 32 + 8 * fq;
#pragma unroll
        for (int ai = 0; ai < 2; ++ai)
#pragma unroll
            for (int m = 0; m < 4; ++m) { bf16_t* rowp = O + (size_t)(row0 + ai * 128 + m * 16) * 1024 + col0;
                float r[8];
#pragma unroll
                for (int n = 0; n < 2; ++n)
#pragma unroll
                    for (int j = 0; j < 4; ++j) { const float g = acc[ai][0][m][n][j], up = acc[ai][1][m][n][j];
                        r[n * 4 + j] = g * __builtin_amdgcn_rcpf(1.0f + __expf(-g)) * up; }
                u32x4 w; w.x = cvt_pk_bf16(r[0], r[1]); w.y = cvt_pk_bf16(r[2], r[3]); w.z = cvt_pk_bf16(r[4], r[5]); w.w = cvt_pk_bf16(r[6], r[7]);
                *(u32x4*)rowp = w; }
    }
};
template <bool RB> struct EpiResid {
    static constexpr bool PERM = false, AFTER_DRAIN = false;
    const void* res; float* Y;
    __device__ __forceinline__ void operator()(const f32x4 (&acc)[2][2][4][2], const Unit& un, int wr, int wc, int fr, int fq) const {
        const int row0 = un.pm * 256 + wr * 64 + fr, col0 = un.pn * 256 + wc * 32 + 4 * fq;
#pragma unroll
        for (int ai = 0; ai < 2; ++ai)
#pragma unroll
            for (int m = 0; m < 4; ++m) { const size_t off = (size_t)(row0 + ai * 128 + m * 16) * D + col0;
#pragma unroll
                for (int bj = 0; bj < 2; ++bj)
#pragma unroll
                    for (int n = 0; n < 2; ++n) { const size_t o = off + bj * 128 + n * 16; f32x4 r;
                        if (RB) { const u32x2 w = *(const u32x2*)((const bf16_t*)res + o); r = (f32x4){bflo(w.x), bfhi(w.x), bflo(w.y), bfhi(w.y)}; }
                        else r = *(const f32x4*)((const float*)res + o);
                        *(f32x4*)(Y + o) = r * ALPHA + acc[ai][bj][m][n]; } }
    }
};
struct SmallOrder {
    int nN, nwg, c;
    __device__ bool next(int i, Unit& u) const { if (i != 0 || c < 0 || c >= nwg) return false; u.pm = c / nN; u.pn = c % nN; return true; }
    __device__ __forceinline__ void a_ready(const Unit&) const {}
    __device__ __forceinline__ void done(const Unit&) const {}
    __device__ __forceinline__ int arow(int, const Unit& u, int r) const { return u.pm * 256 + r; }
};
struct MoeOrder {
    const LAS int* tb;
    int ntn, G, c;
    __device__ bool next(int i, Unit& u) const {
        const int L = i * G + c; if (L >= tb[16] * ntn) return false;
        int e = 0;
#pragma unroll
        for (int j = 1; j < 16; ++j) e += (L >= tb[j] * ntn) ? 1 : 0;
        const int r = L - tb[e] * ntn, te = tb[e + 1] - tb[e];
        u.pm = tb[e] + r % te; u.pn = e * ntn + r / te; return true;
    }
    __device__ __forceinline__ void a_ready(const Unit&) const {}
    __device__ __forceinline__ void done(const Unit&) const {}
    __device__ __forceinline__ int arow(int, const Unit& u, int r) const { return u.pm * 256 + r; }
};
struct MoeGatherOrder : MoeOrder {
    const LAS int* toks;
    __device__ __forceinline__ int arow(int ui, const Unit&, int r) const { return toks[ui * 256 + r]; }
};

struct Args { const float* in[23]; float* out; unsigned char* ws; int ph_lo, ph_hi; };
struct Ctx {
    unsigned char* ws; LAS unsigned char* lds;
    int tid, lane, wave, gw, NGW, G, bid;
};
__device__ __forceinline__ unsigned char* launder(unsigned char* p) { asm volatile("" : "+s"(p)); return p; }
__device__ __forceinline__ int launder_v(int v) { asm volatile("" : "+v"(v)); return v; }

__device__ __forceinline__ void tr_item(const float* W, int K, int N, bf16_t* WT, int grp, int gstride, int roff, LAS float* scr, int item, int lane) {
    const int nblk = N / 32, kb = item / nblk, nb = item % nblk, k0 = 64 * kb, n0 = 32 * nb;
    float ld[32];
    { const float* wp = W + (size_t)(k0 + (lane >> 5)) * N + n0 + (lane & 31);
#pragma unroll
      for (int i = 0; i < 32; ++i) ld[i] = __builtin_nontemporal_load(wp + (size_t)(2 * i) * N); }
#pragma unroll
    for (int i = 0; i < 32; ++i) scr[(2 * i + (lane >> 5)) * 33 + (lane & 31)] = ld[i];
    LDS_WAIT(); asm volatile("" ::: "memory");
    const int c = lane & 7;
#pragma unroll
    for (int j = 0; j < 4; ++j) { const int n = (lane >> 3) + 8 * j; const LAS float* s = scr + (8 * c) * 33 + n;
        const int nn = n0 + n, drow = (nn / grp) * gstride + (nn % grp) + roff;
        u32x4 o; o.x = pk2(s[0 * 33], s[1 * 33]); o.y = pk2(s[2 * 33], s[3 * 33]); o.z = pk2(s[4 * 33], s[5 * 33]); o.w = pk2(s[6 * 33], s[7 * 33]);
        *(u32x4*)(WT + (size_t)drow * K + k0 + 8 * c) = o; }
    LDS_WAIT(); asm volatile("" ::: "memory");
}
__device__ __forceinline__ void p0_prologue(const Ctx& C, const Args& A) {
    LAS float* scr = (LAS float*)(C.lds + C.wave * 16384);
    unsigned char* ws = C.ws;
    constexpr int I_MOE = 16 * 32;
    constexpr int N_MOE = 32 * I_MOE;
    constexpr int I_INA = 16 * 56, I_SQ = 512, I_KV = 16 * 24, I_OUTB = 8 * 32, I_MEM = 16 * 8;
    constexpr int NITEMS = 3 * N_MOE + I_INA + I_SQ + I_SQ + 2 * I_KV + I_OUTB + 4 * I_MEM;
    for (int it = C.gw; it < NITEMS; it += C.NGW) {
        int r = it;
        if (r < N_MOE) { const int m = r / I_MOE; tr_item(A.in[20] + (size_t)m * 1048576, 1024, 1024, (bf16_t*)(ws + WS_WGU) + (size_t)m * 2097152, 128, 256, 0, scr, r % I_MOE, C.lane); continue; } r -= N_MOE;
        if (r < N_MOE) { const int m = r / I_MOE; tr_item(A.in[21] + (size_t)m * 1048576, 1024, 1024, (bf16_t*)(ws + WS_WGU) + (size_t)m * 2097152, 128, 256, 128, scr, r % I_MOE, C.lane); continue; } r -= N_MOE;
        if (r < N_MOE) { const int m = r / I_MOE; tr_item(A.in[22] + (size_t)m * 1048576, 1024, 1024, (bf16_t*)(ws + WS_WD) + (size_t)m * 1048576, 1024, 1024, 0, scr, r % I_MOE, C.lane); continue; } r -= N_MOE;
        if (r < I_INA) { tr_item(A.in[2], 1024, 1792, (bf16_t*)(ws + WS_BT_INA), 1792, 1792, 0, scr, r, C.lane); continue; } r -= I_INA;
        if (r < I_SQ) { tr_item(A.in[3], 1024, 1024, (bf16_t*)(ws + WS_BT_OUTA), 1024, 1024, 0, scr, r, C.lane); continue; } r -= I_SQ;
        if (r < I_SQ) { tr_item(A.in[8], 1024, 1024, (bf16_t*)(ws + WS_BT_B), 1024, 1024, 1536, scr, r, C.lane); continue; } r -= I_SQ;
        if (r < I_KV) { tr_item(A.in[10], 1024, 768, (bf16_t*)(ws + WS_BT_B), 768, 768, 0, scr, r, C.lane); continue; } r -= I_KV;
        if (r < I_KV) { tr_item(A.in[11], 1024, 768, (bf16_t*)(ws + WS_BT_B), 768, 768, 768, scr, r, C.lane); continue; } r -= I_KV;
        if (r < I_OUTB) { tr_item(A.in[9], 512, 1024, (bf16_t*)(ws + WS_BT_OUTB), 1024, 1024, 0, scr, r, C.lane); continue; } r -= I_OUTB;
        { const int m = r / I_MEM, layer = m & 1, isv = m >> 1;
          tr_item(A.in[isv ? 13 : 12] + (size_t)layer * 262144, 1024, 256, (bf16_t*)(ws + WS_BT_MEM), 256, 256, layer * 512 + isv * 256, scr, r % I_MEM, C.lane); }
    }
    const int gt = C.bid * NTHREADS + C.tid, NT = C.G * NTHREADS;
    for (int i = gt; i < NSG * 128 * 128 / 8; i += NT) { const int q0 = (i & 15) * 8, p = (i >> 4) & 127;
        const f32x4 a = *(const f32x4*)(A.in[6] + (size_t)i * 8), b = *(const f32x4*)(A.in[6] + (size_t)i * 8 + 4); float v[8] = {a[0], a[1], a[2], a[3], b[0], b[1], b[2], b[3]};
#pragma unroll
        for (int j = 0; j < 8; ++j) v[j] = (q0 + j <= p) ? v[j] : 0.f;
        u32x4 w; w.x = pk2(v[0], v[1]); w.y = pk2(v[2], v[3]); w.z = pk2(v[4], v[5]); w.w = pk2(v[6], v[7]); *(u32x4*)((bf16_t*)(ws + WS_SGWB) + (size_t)i * 8) = w; }
    for (int i = gt; i < T * D / 8; i += NT) { const f32x4 a = *(const f32x4*)(A.in[0] + (size_t)i * 8), b = *(const f32x4*)(A.in[0] + (size_t)i * 8 + 4);
        u32x4 w; w.x = pk2(a[0], a[1]); w.y = pk2(a[2], a[3]); w.z = pk2(b[0], b[1]); w.w = pk2(b[2], b[3]); *(u32x4*)((bf16_t*)(ws + WS_XB) + (size_t)i * 8) = w; }
    for (int i = gt; i < NB * NMEM * D / 8; i += NT) { const f32x4 a = *(const f32x4*)(A.in[1] + (size_t)i * 8), b = *(const f32x4*)(A.in[1] + (size_t)i * 8 + 4);
        u32x4 w; w.x = pk2(a[0], a[1]); w.y = pk2(a[2], a[3]); w.z = pk2(b[0], b[1]); w.w = pk2(b[2], b[3]); *(u32x4*)((bf16_t*)(ws + WS_MEMB) + (size_t)i * 8) = w; }
}

__device__ __forceinline__ void sg_scalar(const Ctx& C, const Args& A) {
    const bf16_t* U = (const bf16_t*)(C.ws + WS_U); const bf16_t* GV = (const bf16_t*)(C.ws + WS_GV); bf16_t* CAT = (bf16_t*)(C.ws + WS_CAT);
    const float* lng = A.in[4]; const float* lnb = A.in[5]; const float* sgw = A.in[6]; const float* sgb = A.in[7];
    LAS float* stat = (LAS float*)C.lds;
    LAS float* gvn = (LAS float*)(C.lds + 1024);
    LAS float* Wl = (LAS float*)(C.lds + 1024 + 128 * 65 * 4);
    for (int unit = C.bid; unit < NB * 16; unit += C.G) {
        const int tb = unit * 128;
        for (int rr = 0; rr < 16; ++rr) { const int row = C.wave * 16 + rr; const bf16_t* p = GV + (size_t)(tb + row) * SGW + 4 * C.lane;
            float s = 0.f, ss = 0.f;
#pragma unroll
            for (int j = 0; j < 3; ++j) { const u32x2 w = *(const u32x2*)(p + 256 * j); const float a = bflo(w.x), b = bfhi(w.x), c = bflo(w.y), d = bfhi(w.y);
                s += (a + b) + (c + d); ss += (a * a + b * b) + (c * c + d * d); }
            s = wave_sum(s); ss = wave_sum(ss);
            const float mean = s * (1.f / SGW), var = ss * (1.f / SGW) - mean * mean;
            if (C.lane == 0) { stat[row * 2] = mean; stat[row * 2 + 1] = 1.0f / sqrtf(var + LN_EPS); } }
        __syncthreads();
        const int p = C.tid >> 2, d0 = (C.tid & 3) * 16;
        for (int g = 0; g < NSG; ++g) {
            { const bf16_t* src = GV + (size_t)(tb + p) * SGW + g * 64 + d0; const float mean = stat[p * 2], rstd = stat[p * 2 + 1];
#pragma unroll
              for (int h = 0; h < 2; ++h) { const u32x4 w = *(const u32x4*)(src + 8 * h); const unsigned ww[4] = {w.x, w.y, w.z, w.w};
#pragma unroll
                  for (int j = 0; j < 4; ++j) { const int d = d0 + 8 * h + 2 * j; const int cc = g * 64 + d;
                      gvn[p * 65 + d] = (bflo(ww[j]) - mean) * rstd * lng[cc] + lnb[cc];
                      gvn[p * 65 + d + 1] = (bfhi(ww[j]) - mean) * rstd * lng[cc + 1] + lnb[cc + 1]; } } }
            { const int q0 = (C.tid & 3) * 32; const float* src = sgw + ((size_t)g * 128 + p) * 128 + q0;
#pragma unroll
              for (int j = 0; j < 8; ++j) { const f32x4 w = *(const f32x4*)(src + 4 * j);
#pragma unroll
                  for (int t = 0; t < 4; ++t) { const int q = q0 + 4 * j + t; Wl[p * 129 + q] = (q <= p) ? w[t] : 0.f; } } }
            __syncthreads();
            float acc[16];
#pragma unroll
            for (int j = 0; j < 16; ++j) acc[j] = 0.f;
            for (int q = 0; q <= p; ++q) { const float w = Wl[p * 129 + q];
#pragma unroll
                for (int j = 0; j < 16; ++j) acc[j] += w * gvn[q * 65 + d0 + j]; }
            const float bs = sgb[g * 128 + p];
            const bf16_t* us = U + (size_t)(tb + p) * SGW + g * 64 + d0; bf16_t* dst = CAT + (size_t)(tb + p) * D + g * 64 + d0;
#pragma unroll
            for (int h = 0; h < 2; ++h) { const u32x4 w = *(const u32x4*)(us + 8 * h); const unsigned ww[4] = {w.x, w.y, w.z, w.w}; unsigned o[4];
#pragma unroll
                for (int j = 0; j < 4; ++j) o[j] = pk2(bflo(ww[j]) * (acc[8 * h + 2 * j] + bs), bfhi(ww[j]) * (acc[8 * h + 2 * j + 1] + bs));
                *(u32x4*)(dst + 8 * h) = (u32x4){o[0], o[1], o[2], o[3]}; }
            __syncthreads();
        }
    }
}

__device__ __forceinline__ void memattn_scalar(const Ctx& C, const bf16_t* QM, const bf16_t* MKV, int ck, int cv, bf16_t* OUT, int ldo, int coff) {
    for (int it = C.gw; it < T * 4; it += C.NGW) {
        const int tok = it >> 2, h = it & 3, b = tok / SEQ;
        float q[64];
        { const bf16_t* qp = QM + (size_t)tok * 256 + h * 64;
#pragma unroll
          for (int j = 0; j < 8; ++j) { const u32x4 w = *(const u32x4*)(qp + 8 * j);
              q[8 * j] = bflo(w.x); q[8 * j + 1] = bfhi(w.x); q[8 * j + 2] = bflo(w.y); q[8 * j + 3] = bfhi(w.y); q[8 * j + 4] = bflo(w.z); q[8 * j + 5] = bfhi(w.z); q[8 * j + 6] = bflo(w.w); q[8 * j + 7] = bfhi(w.w); } }
        float s[4];
#pragma unroll
        for (int jj = 0; jj < 4; ++jj) { const bf16_t* kp = MKV + (size_t)(b * NMEM + jj * 64 + C.lane) * 1024 + ck + h * 64; float a = 0.f;
#pragma unroll
            for (int j = 0; j < 8; ++j) { const u32x4 w = *(const u32x4*)(kp + 8 * j);
                a += q[8 * j] * bflo(w.x) + q[8 * j + 1] * bfhi(w.x) + q[8 * j + 2] * bflo(w.y) + q[8 * j + 3] * bfhi(w.y) + q[8 * j + 4] * bflo(w.z) + q[8 * j + 5] * bfhi(w.z) + q[8 * j + 6] * bflo(w.w) + q[8 * j + 7] * bfhi(w.w); }
            s[jj] = a; }
        const float mx = wave_max(fmaxf(fmaxf(s[0], s[1]), fmaxf(s[2], s[3])));
        float l = 0.f;
#pragma unroll
        for (int jj = 0; jj < 4; ++jj) { s[jj] = __expf(s[jj] - mx); l += s[jj]; }
        l = wave_sum(l);
        float acc = 0.f;
#pragma unroll
        for (int jj = 0; jj < 4; ++jj) { const bf16_t* vp = MKV + (size_t)(b * NMEM + jj * 64) * 1024 + cv + h * 64 + C.lane;
            for (int mm = 0; mm < 64; ++mm) acc += __shfl(s[jj], mm) * bf1(vp[(size_t)mm * 1024]); }
        OUT[(size_t)tok * ldo + coff + h * 64 + C.lane] = (bf16_t)f2bf(acc / l);
    }
}

__device__ __forceinline__ void dilattn_scalar(const Ctx& C, const Args& A) {
    const bf16_t* Q = (const bf16_t*)(C.ws + WS_Q); const bf16_t* K = (const bf16_t*)(C.ws + WS_K); const bf16_t* V = (const bf16_t*)(C.ws + WS_V);
    bf16_t* OG = (bf16_t*)(C.ws + WS_OG); float* LSE = (float*)(C.ws + WS_LSE);
    for (int it = C.gw; it < T * 12; it += C.NGW) {
        const int tok = it / 12, h = it % 12, g = h >> 2, dl = (g == 0) ? 1 : (g == 1 ? 4 : 16);
        const int t = tok % SEQ, i = t / dl;
        const float slope = exp2f(-(float)(h + 1) * (8.0f / 12.0f));
        float q[64];
        { const bf16_t* qp = Q + (size_t)tok * SGW + h * 64;
#pragma unroll
          for (int j = 0; j < 8; ++j) { const u32x4 w = *(const u32x4*)(qp + 8 * j);
              q[8 * j] = bflo(w.x); q[8 * j + 1] = bfhi(w.x); q[8 * j + 2] = bflo(w.y); q[8 * j + 3] = bfhi(w.y); q[8 * j + 4] = bflo(w.z); q[8 * j + 5] = bfhi(w.z); q[8 * j + 6] = bflo(w.w); q[8 * j + 7] = bfhi(w.w); } }
        float s[3];
#pragma unroll
        for (int jj = 0; jj < 3; ++jj) { const int j0 = jj * 64 + C.lane; const bool valid = (jj < 2 || C.lane == 0) && (j0 <= i);
            const int jc = valid ? j0 : 0;
            const bf16_t* kp = K + (size_t)(tok - jc * dl) * SGW + h * 64; float a = 0.f;
#pragma unroll
            for (int j = 0; j < 8; ++j) { const u32x4 w = *(const u32x4*)(kp + 8 * j);
                a += q[8 * j] * bflo(w.x) + q[8 * j + 1] * bfhi(w.x) + q[8 * j + 2] * bflo(w.y) + q[8 * j + 3] * bfhi(w.y) + q[8 * j + 4] * bflo(w.z) + q[8 * j + 5] * bfhi(w.z) + q[8 * j + 6] * bflo(w.w) + q[8 * j + 7] * bfhi(w.w); }
            s[jj] = valid ? (a - slope * (float)(dl * j0)) : -INFINITY; }
        const float mx = wave_max(fmaxf(fmaxf(s[0], s[1]), s[2]));
        float l = 0.f;
#pragma unroll
        for (int jj = 0; jj < 3; ++jj) { s[jj] = __expf(s[jj] - mx); l += s[jj]; }
        l = wave_sum(l);
        float acc = 0.f;
#pragma unroll
        for (int jj = 0; jj < 3; ++jj) { const int nm = (jj < 2) ? 64 : 1;
            for (int mm = 0; mm < nm; ++mm) { const int j0 = jj * 64 + mm; const int jc = (j0 <= i) ? j0 : 0;
                acc += __shfl(s[jj], mm) * bf1(V[(size_t)(tok - jc * dl) * SGW + h * 64 + C.lane]); } }
        OG[(size_t)tok * SGW + h * 64 + C.lane] = (bf16_t)f2bf(acc / l);
        if (C.lane == 0) LSE[tok * 12 + h] = mx + __logf(l);
    }
}
typedef short bf16x8 __attribute__((ext_vector_type(8)));
typedef short s16x4 __attribute__((ext_vector_type(4)));
constexpr int AT_KS = 144, AT_VS = 160, AT_ROWS = 272, AT_K_OFF = 0, AT_V_OFF = AT_ROWS * AT_KS;
static_assert(AT_V_OFF % 16 == 0 && AT_V_OFF + AT_ROWS * AT_VS <= 131072, "attention LDS map");

template <int NKB, bool DIL>
__device__ __forceinline__ void attn_compute(LAS unsigned char* lds, int lane, int krow0, bf16x8 qf0, bf16x8 qf1, float sdl, int ikw, f32x4 (&o)[4], float& mx, float& lsum) {
    const int n = lane & 15, g = lane >> 4;
    const LAS unsigned char* Kb = lds + AT_K_OFF + (krow0 + n) * AT_KS + g * 16;
    f32x4 sc[NKB];
#pragma unroll
    for (int kb = 0; kb < NKB; ++kb) {
        const bf16x8 k0 = *(const LAS bf16x8*)(Kb + kb * 16 * AT_KS), k1 = *(const LAS bf16x8*)(Kb + kb * 16 * AT_KS + 64);
        f32x4 a = (f32x4){0.f, 0.f, 0.f, 0.f};
        a = __builtin_amdgcn_mfma_f32_16x16x32_bf16(k0, qf0, a, 0, 0, 0);
        a = __builtin_amdgcn_mfma_f32_16x16x32_bf16(k1, qf1, a, 0, 0, 0);
        sc[kb] = a;
    }
    float m = -INFINITY;
#pragma unroll
    for (int kb = 0; kb < NKB; ++kb)
#pragma unroll
        for (int r = 0; r < 4; ++r) {
            if (DIL) { const int off = 16 * kb + 4 * g + r, rel = 144 + n - off; const bool valid = (rel >= 0) && (rel <= 128) && (ikw + off >= 0);
                sc[kb][r] = valid ? (sc[kb][r] - sdl * (float)rel) : -INFINITY; }
            m = fmaxf(m, sc[kb][r]); }
    m = fmaxf(m, __shfl_xor(m, 16)); m = fmaxf(m, __shfl_xor(m, 32));
    float l = 0.f;
#pragma unroll
    for (int kb = 0; kb < NKB; ++kb)
#pragma unroll
        for (int r = 0; r < 4; ++r) { sc[kb][r] = __expf(sc[kb][r] - m); l += sc[kb][r]; }
    l += __shfl_xor(l, 16); l += __shfl_xor(l, 32);
    mx = m; lsum = l;
    const LAS unsigned char* Vb = lds + AT_V_OFF + (krow0 + 4 * g + (n >> 2)) * AT_VS + (n & 3) * 8;
#pragma unroll
    for (int db = 0; db < 4; ++db) o[db] = (f32x4){0.f, 0.f, 0.f, 0.f};
#pragma unroll
    for (int kk = 0; kk < NKB / 2; ++kk) {
        union { bf16x8 v; unsigned u[4]; } pf;
        pf.u[0] = cvt_pk_bf16(sc[2 * kk][0], sc[2 * kk][1]); pf.u[1] = cvt_pk_bf16(sc[2 * kk][2], sc[2 * kk][3]);
        pf.u[2] = cvt_pk_bf16(sc[2 * kk + 1][0], sc[2 * kk + 1][1]); pf.u[3] = cvt_pk_bf16(sc[2 * kk + 1][2], sc[2 * kk + 1][3]);
#pragma unroll
        for (int db = 0; db < 4; ++db) {
            const s16x4 v0 = __builtin_amdgcn_ds_read_tr16_b64_v4i16((LAS s16x4*)(Vb + (2 * kk) * 16 * AT_VS + db * 32));
            const s16x4 v1 = __builtin_amdgcn_ds_read_tr16_b64_v4i16((LAS s16x4*)(Vb + (2 * kk + 1) * 16 * AT_VS + db * 32));
            const bf16x8 vf = __builtin_shufflevector(v0, v1, 0, 1, 2, 3, 4, 5, 6, 7);
            o[db] = __builtin_amdgcn_mfma_f32_16x16x32_bf16(vf, pf.v, o[db], 0, 0, 0);
        }
    }
}

__device__ __forceinline__ void memattn_mfma(const Ctx& C, const bf16_t* QM, const bf16_t* MKV, int ck, int cv, bf16_t* OUT, int ldo, int coff) {
    const int n = C.lane & 15, g = C.lane >> 4;
    for (int unit = C.bid; unit < NB * 4 * 16; unit += C.G) {
        const int b = unit >> 6, h = (unit >> 4) & 3, qt = unit & 15;
        __syncthreads();
#pragma unroll
        for (int it = 0; it < 4; ++it) { const int row = it * 64 + (C.tid >> 3), c = C.tid & 7;
            const bf16_t* src = MKV + (size_t)(b * NMEM + row) * 1024 + h * 64 + c * 8;
            const u32x4 kv = *(const u32x4*)(src + ck), vv = *(const u32x4*)(src + cv);
            *(LAS u32x4*)(C.lds + AT_K_OFF + row * AT_KS + c * 16) = kv; *(LAS u32x4*)(C.lds + AT_V_OFF + row * AT_VS + c * 16) = vv; }
        const int tok = b * SEQ + qt * 128 + C.wave * 16 + n;
        const bf16_t* qp = QM + (size_t)tok * 256 + h * 64 + g * 8;
        const bf16x8 qf0 = *(const bf16x8*)qp, qf1 = *(const bf16x8*)(qp + 32);
        __syncthreads();
        f32x4 o[4]; float mx, l;
        attn_compute<16, false>(C.lds, C.lane, 0, qf0, qf1, 0.f, 0, o, mx, l);
        const float inv = 1.0f / l;
#pragma unroll
        for (int db = 0; db < 4; ++db)
            *(u32x2*)(OUT + (size_t)tok * ldo + coff + h * 64 + 16 * db + 4 * g) = (u32x2){cvt_pk_bf16(o[db][0] * inv, o[db][1] * inv), cvt_pk_bf16(o[db][2] * inv, o[db][3] * inv)};
    }
}
__device__ __forceinline__ void dilattn_mfma(const Ctx& C) {
    const bf16_t* Q = (const bf16_t*)(C.ws + WS_Q); const bf16_t* K = (const bf16_t*)(C.ws + WS_K); const bf16_t* V = (const bf16_t*)(C.ws + WS_V);
    bf16_t* OG = (bf16_t*)(C.ws + WS_OG); float* LSE = (float*)(C.ws + WS_LSE);
    const int n = C.lane & 15, g = C.lane >> 4;
    for (int unit = C.bid; unit < 12 * 128; unit += C.G) {
        const int h = unit >> 7, rem = unit & 127, b = rem >> 4, x = rem & 15, grp = h >> 2;
        const int dl = (grp == 0) ? 1 : (grp == 1 ? 4 : 16), ntile = 16 / dl, r = x / ntile, I0 = (x % ntile) * 128;
        const float sdl = exp2f(-(float)(h + 1) * (8.0f / 12.0f)) * (float)dl;
        __syncthreads();
        for (int idx = C.tid; idx < AT_ROWS * 8; idx += NTHREADS) { const int row = idx >> 3, c = idx & 7; const int ik = I0 - 144 + row;
            u32x4 kv = (u32x4){0u, 0u, 0u, 0u}, vv = (u32x4){0u, 0u, 0u, 0u};
            if (ik >= 0) { const size_t off = (size_t)(b * SEQ + ik * dl + r) * SGW + h * 64 + c * 8; kv = *(const u32x4*)(K + off); vv = *(const u32x4*)(V + off); }
            *(LAS u32x4*)(C.lds + AT_K_OFF + row * AT_KS + c * 16) = kv; *(LAS u32x4*)(C.lds + AT_V_OFF + row * AT_VS + c * 16) = vv; }
        const int iq = I0 + C.wave * 16 + n, tok = b * SEQ + iq * dl + r;
        const bf16_t* qp = Q + (size_t)tok * SGW + h * 64 + g * 8;
        const bf16x8 qf0 = *(const bf16x8*)qp, qf1 = *(const bf16x8*)(qp + 32);
        __syncthreads();
        f32x4 o[4]; float mx, l;
        attn_compute<10, true>(C.lds, C.lane, C.wave * 16, qf0, qf1, sdl, I0 + C.wave * 16 - 144, o, mx, l);
        const float inv = 1.0f / l;
#pragma unroll
        for (int db = 0; db < 4; ++db)
            *(u32x2*)(OG + (size_t)tok * SGW + h * 64 + 16 * db + 4 * g) = (u32x2){cvt_pk_bf16(o[db][0] * inv, o[db][1] * inv), cvt_pk_bf16(o[db][2] * inv, o[db][3] * inv)};
        if (g == 0) LSE[tok * 12 + h] = mx + __logf(l);
    }
}
constexpr int SG_GVN_OFF = 1024, SG_VS = 160;
__device__ __forceinline__ void sg_mfma(const Ctx& C, const Args& A) {
    const bf16_t* U = (const bf16_t*)(C.ws + WS_U); const bf16_t* GV = (const bf16_t*)(C.ws + WS_GV); bf16_t* CAT = (bf16_t*)(C.ws + WS_CAT);
    const bf16_t* WB = (const bf16_t*)(C.ws + WS_SGWB);
    const float* lng = A.in[4]; const float* lnb = A.in[5]; const float* sgb = A.in[7];
    LAS float* stat = (LAS float*)C.lds;
    const int n = C.lane & 15, gl = C.lane >> 4;
    for (int unit = C.bid; unit < NB * 16 * 4; unit += C.G) {
        const int tb = (unit >> 2) * 128, gq = unit & 3;
        __syncthreads();
        for (int rr = 0; rr < 16; ++rr) { const int row = C.wave * 16 + rr; const bf16_t* p = GV + (size_t)(tb + row) * SGW + 4 * C.lane;
            float s = 0.f, ss = 0.f;
#pragma unroll
            for (int j = 0; j < 3; ++j) { const u32x2 w = *(const u32x2*)(p + 256 * j); const float a = bflo(w.x), b = bfhi(w.x), c = bflo(w.y), d = bfhi(w.y);
                s += (a + b) + (c + d); ss += (a * a + b * b) + (c * c + d * d); }
            s = wave_sum(s); ss = wave_sum(ss);
            const float mean = s * (1.f / SGW), var = ss * (1.f / SGW) - mean * mean;
            if (C.lane == 0) { stat[row * 2] = mean; stat[row * 2 + 1] = 1.0f / sqrtf(var + LN_EPS); } }
        __syncthreads();
        for (int gi = 0; gi < 3; ++gi) {
            const int g = gq * 3 + gi;
#pragma unroll
            for (int it = 0; it < 2; ++it) { const int idx = it * NTHREADS + C.tid, row = idx >> 3, c = idx & 7, cc = g * 64 + c * 8;
                const u32x4 w = *(const u32x4*)(GV + (size_t)(tb + row) * SGW + cc); const float mean = stat[row * 2], rstd = stat[row * 2 + 1];
                const f32x4 ga = *(const f32x4*)(lng + cc), gb = *(const f32x4*)(lng + cc + 4), ba = *(const f32x4*)(lnb + cc), bb = *(const f32x4*)(lnb + cc + 4);
                u32x4 o;
                o.x = pk2((bflo(w.x) - mean) * rstd * ga[0] + ba[0], (bfhi(w.x) - mean) * rstd * ga[1] + ba[1]);
                o.y = pk2((bflo(w.y) - mean) * rstd * ga[2] + ba[2], (bfhi(w.y) - mean) * rstd * ga[3] + ba[3]);
                o.z = pk2((bflo(w.z) - mean) * rstd * gb[0] + bb[0], (bfhi(w.z) - mean) * rstd * gb[1] + bb[1]);
                o.w = pk2((bflo(w.w) - mean) * rstd * gb[2] + bb[2], (bfhi(w.w) - mean) * rstd * gb[3] + bb[3]);
                *(LAS u32x4*)(C.lds + SG_GVN_OFF + row * SG_VS + c * 16) = o; }
            __syncthreads();
            const int p = C.wave * 16 + n, nks = (C.wave >> 1) + 1;
            f32x4 acc[4];
#pragma unroll
            for (int db = 0; db < 4; ++db) acc[db] = (f32x4){0.f, 0.f, 0.f, 0.f};
            const bf16_t* wp = WB + (size_t)(g * 128 + p) * 128 + 8 * gl;
            const LAS unsigned char* vb = C.lds + SG_GVN_OFF + (8 * gl + (n >> 2)) * SG_VS + (n & 3) * 8;
            for (int ks = 0; ks < nks; ++ks) {
                const bf16x8 wf = *(const bf16x8*)(wp + 32 * ks);
#pragma unroll
                for (int db = 0; db < 4; ++db) {
                    const s16x4 v0 = __builtin_amdgcn_ds_read_tr16_b64_v4i16((LAS s16x4*)(vb + ks * 32 * SG_VS + db * 32));
                    const s16x4 v1 = __builtin_amdgcn_ds_read_tr16_b64_v4i16((LAS s16x4*)(vb + ks * 32 * SG_VS + 4 * SG_VS + db * 32));
                    const bf16x8 vf = __builtin_shufflevector(v0, v1, 0, 1, 2, 3, 4, 5, 6, 7);
                    acc[db] = __builtin_amdgcn_mfma_f32_16x16x32_bf16(vf, wf, acc[db], 0, 0, 0);
                }
            }
            const float bs = sgb[g * 128 + p];
#pragma unroll
            for (int db = 0; db < 4; ++db) { const size_t co = (size_t)g * 64 + 16 * db + 4 * gl;
                const u32x2 uw = *(const u32x2*)(U + (size_t)(tb + p) * SGW + co);
                *(u32x2*)(CAT + (size_t)(tb + p) * D + co) = (u32x2){cvt_pk_bf16(bflo(uw.x) * (acc[db][0] + bs), bfhi(uw.x) * (acc[db][1] + bs)), cvt_pk_bf16(bflo(uw.y) * (acc[db][2] + bs), bfhi(uw.y) * (acc[db][3] + bs))}; }
            __syncthreads();
        }
    }
}
__device__ __forceinline__ void dil_merge(const Ctx& C, const Args& A) {
    const bf16_t* OG = (const bf16_t*)(C.ws + WS_OG); const float* LSE = (const float*)(C.ws + WS_LSE); bf16_t* CAT2 = (bf16_t*)(C.ws + WS_CAT2);
    const int gt = C.bid * NTHREADS + C.tid, NT = C.G * NTHREADS;
    for (int it = gt; it < T * 32; it += NT) {
        const int tok = it >> 5, j = (it >> 3) & 3, c8 = it & 7;
        const float l0 = LSE[tok * 12 + j], l1 = LSE[tok * 12 + 4 + j], l2 = LSE[tok * 12 + 8 + j];
        const float mx = fmaxf(l0, fmaxf(l1, l2));
        float w0 = __expf(l0 - mx), w1 = __expf(l1 - mx), w2 = __expf(l2 - mx); const float inv = 1.0f / (w0 + w1 + w2); w0 *= inv; w1 *= inv; w2 *= inv;
        const u32x4 a = *(const u32x4*)(OG + (size_t)tok * SGW + j * 64 + c8 * 8), b = *(const u32x4*)(OG + (size_t)tok * SGW + (4 + j) * 64 + c8 * 8), c = *(const u32x4*)(OG + (size_t)tok * SGW + (8 + j) * 64 + c8 * 8);
        u32x4 o;
        o.x = pk2(w0 * bflo(a.x) + w1 * bflo(b.x) + w2 * bflo(c.x), w0 * bfhi(a.x) + w1 * bfhi(b.x) + w2 * bfhi(c.x));
        o.y = pk2(w0 * bflo(a.y) + w1 * bflo(b.y) + w2 * bflo(c.y), w0 * bfhi(a.y) + w1 * bfhi(b.y) + w2 * bfhi(c.y));
        o.z = pk2(w0 * bflo(a.z) + w1 * bflo(b.z) + w2 * bflo(c.z), w0 * bfhi(a.z) + w1 * bfhi(b.z) + w2 * bfhi(c.z));
        o.w = pk2(w0 * bflo(a.w) + w1 * bflo(b.w) + w2 * bflo(c.w), w0 * bfhi(a.w) + w1 * bfhi(b.w) + w2 * bfhi(c.w));
        *(u32x4*)(CAT2 + (size_t)tok * 512 + j * 64 + c8 * 8) = o;
    }
}

__device__ __forceinline__ void ln_route(const Ctx& C, const Args& A, int layer) {
    const float* Y = (const float*)(C.ws + WS_Y); bf16_t* X1B = (bf16_t*)(C.ws + WS_X1B);
    const float* lg = A.in[14] + layer * D; const float* lb = A.in[15] + layer * D; const float* wr = A.in[18]; const float* br = A.in[19];
    unsigned* cnt = (unsigned*)(C.ws + WS_CTL) + CW_CNT + layer * 16 * 64;
    int* tokE = (int*)(C.ws + WS_TOKE); int* tokP = (int*)(C.ws + WS_TOKP); float* tokG = (float*)(C.ws + WS_TOKG); int* list = (int*)(C.ws + WS_LIST);
    LAS float* wl = (LAS float*)C.lds;
    LAS int* sE = (LAS int*)(C.lds + 65536); LAS float* sG = (LAS float*)(C.lds + 65536 + 512); LAS int* sPos = (LAS int*)(C.lds + 65536 + 1024);
    LAS int* lcnt = (LAS int*)(C.lds + 65536 + 1536); LAS int* lbase = (LAS int*)(C.lds + 65536 + 1600);
    __syncthreads();
    for (int i = C.tid; i < 1024 * 16 / 4; i += NTHREADS) *(LAS f32x4*)(wl + 4 * i) = *(const f32x4*)(wr + 4 * i);
    const LAS float* wlane = wl + C.lane * 64;
    for (int blk = C.bid; blk < T / 64; blk += C.G) {
        __syncthreads();
        if (C.tid < 16) lcnt[C.tid] = 0;
        for (int ti = 0; ti < 8; ++ti) {
            const int tl = C.wave * 8 + ti, tok = blk * 64 + tl;
            f32x4 v[4]; float s = 0.f;
#pragma unroll
            for (int j = 0; j < 4; ++j) { v[j] = *(const f32x4*)(Y + (size_t)tok * D + 4 * C.lane + 256 * j); s += (v[j][0] + v[j][1]) + (v[j][2] + v[j][3]); }
            const float mean = wave_sum(s) * (1.f / D); float s2 = 0.f;
#pragma unroll
            for (int j = 0; j < 4; ++j) { v[j] = v[j] - mean; s2 += (v[j][0] * v[j][0] + v[j][1] * v[j][1]) + (v[j][2] * v[j][2] + v[j][3] * v[j][3]); }
            const float rstd = 1.0f / sqrtf(wave_sum(s2) * (1.f / D) + LN_EPS);
            float lgt[16];
#pragma unroll
            for (int e = 0; e < 16; ++e) lgt[e] = 0.f;
#pragma unroll
            for (int j = 0; j < 4; ++j) { const int col = 4 * C.lane + 256 * j; const f32x4 g4 = *(const f32x4*)(lg + col), b4 = *(const f32x4*)(lb + col);
                v[j] = v[j] * rstd * g4 + b4;
                *(u32x2*)(X1B + (size_t)tok * D + col) = (u32x2){pk2(v[j][0], v[j][1]), pk2(v[j][2], v[j][3])};
#pragma unroll
                for (int c = 0; c < 4; ++c) { const float xv = v[j][c];
#pragma unroll
                    for (int e4 = 0; e4 < 4; ++e4) { const f32x4 w = *(const LAS f32x4*)(wlane + (256 * j + c) * 16 + 4 * e4);
                        lgt[4 * e4] += xv * w[0]; lgt[4 * e4 + 1] += xv * w[1]; lgt[4 * e4 + 2] += xv * w[2]; lgt[4 * e4 + 3] += xv * w[3]; } } }
            float mx = -INFINITY;
#pragma unroll
            for (int e = 0; e < 16; ++e) { lgt[e] = wave_sum(lgt[e]); mx = fmaxf(mx, lgt[e]); }
            float sum = 0.f;
#pragma unroll
            for (int e = 0; e < 16; ++e) { lgt[e] = __expf(lgt[e] - mx); sum += lgt[e]; }
            const float inv = 1.0f / sum; float sel[16];
#pragma unroll
            for (int e = 0; e < 16; ++e) { lgt[e] *= inv; sel[e] = lgt[e] + br[e]; }
            float gs[4];
#pragma unroll
            for (int g = 0; g < 4; ++g) { const float a = sel[4 * g], b = sel[4 * g + 1], c = sel[4 * g + 2], d = sel[4 * g + 3];
                gs[g] = fmaxf(fmaxf(fmaxf(a + b, a + c), fmaxf(a + d, b + c)), fmaxf(b + d, c + d)); }
            int gi = 0; float bsc = gs[0];
#pragma unroll
            for (int g = 1; g < 4; ++g) if (gs[g] > bsc) { bsc = gs[g]; gi = g; }
            float sg[4], pg[4];
#pragma unroll
            for (int k = 0; k < 4; ++k) { sg[k] = gi == 0 ? sel[k] : (gi == 1 ? sel[4 + k] : (gi == 2 ? sel[8 + k] : sel[12 + k])); pg[k] = gi == 0 ? lgt[k] : (gi == 1 ? lgt[4 + k] : (gi == 2 ? lgt[8 + k] : lgt[12 + k])); }
            int i1 = 0; float b1 = sg[0], p1 = pg[0];
#pragma unroll
            for (int k = 1; k < 4; ++k) if (sg[k] > b1) { b1 = sg[k]; i1 = k; p1 = pg[k]; }
            int i2 = -1; float b2 = -INFINITY, p2 = 0.f;
#pragma unroll
            for (int k = 0; k < 4; ++k) if (k != i1 && sg[k] > b2) { b2 = sg[k]; i2 = k; p2 = pg[k]; }
            if (C.lane == 0) { const float gsum = p1 + p2; sE[tl * 2] = gi * 4 + i1; sE[tl * 2 + 1] = gi * 4 + i2; sG[tl * 2] = p1 / gsum; sG[tl * 2 + 1] = p2 / gsum; }
        }
        __syncthreads();
        if (C.tid < 128) sPos[C.tid] = __hip_atomic_fetch_add(lcnt + sE[C.tid], 1, __ATOMIC_RELAXED, __HIP_MEMORY_SCOPE_WORKGROUP);
        __syncthreads();
        if (C.tid < 16) lbase[C.tid] = (int)__hip_atomic_fetch_add(cnt + C.tid * 64, (unsigned)lcnt[C.tid], __ATOMIC_RELAXED, __HIP_MEMORY_SCOPE_AGENT);
        __syncthreads();
        if (C.tid < 128) { const int e = sE[C.tid], pos = lbase[e] + sPos[C.tid], tok = blk * 64 + (C.tid >> 1);
            list[e * LISTCAP + pos] = tok; tokE[tok * 2 + (C.tid & 1)] = e; tokP[tok * 2 + (C.tid & 1)] = pos; tokG[tok * 2 + (C.tid & 1)] = sG[C.tid]; }
    }
}
__device__ __forceinline__ void moe_prefix(const Ctx& C, int layer) {
    LAS int* mi = (LAS int*)(C.lds + LDS_MISC);
    unsigned* cnt = (unsigned*)(C.ws + WS_CTL) + CW_CNT + layer * 16 * 64;
    __syncthreads();
    if (C.tid < 16) mi[17 + C.tid] = (int)__hip_atomic_load(cnt + C.tid * 64, __ATOMIC_RELAXED, __HIP_MEMORY_SCOPE_AGENT);
    __syncthreads();
    if (C.tid == 0) { int a = 0; for (int e = 0; e < 16; ++e) { mi[e] = a; a += (mi[17 + e] + 255) >> 8; } mi[16] = a; }
    __syncthreads();
}
__device__ __forceinline__ void moe_tokens(const Ctx& C, int ntn) {
    const LAS int* mi = (const LAS int*)(C.lds + LDS_MISC); LAS int* toks = (LAS int*)(C.lds + LDS_TOKS);
    const int* list = (const int*)(C.ws + WS_LIST);
    for (int u = 0; u < MAX_UNITS; ++u) {
        const int L = u * C.G + C.bid; if (L >= mi[16] * ntn) break;
        int e = 0;
#pragma unroll
        for (int j = 1; j < 16; ++j) e += (L >= mi[j] * ntn) ? 1 : 0;
        const int r = L - mi[e] * ntn, te = mi[e + 1] - mi[e], mt = r % te, cn = mi[17 + e];
        if (C.tid < 256) { int pos = mt * 256 + C.tid; pos = pos < cn ? pos : cn - 1; toks[u * 256 + C.tid] = list[e * LISTCAP + pos]; }
    }
    __syncthreads();
}
__device__ __forceinline__ void combine_ln2(const Ctx& C, const Args& A, int layer) {
    const LAS int* mi = (const LAS int*)(C.lds + LDS_MISC);
    const bf16_t* X1B = (const bf16_t*)(C.ws + WS_X1B); const bf16_t* YD = (const bf16_t*)(C.ws + WS_YD); bf16_t* X2B = (bf16_t*)(C.ws + WS_XB);
    const int* tokE = (const int*)(C.ws + WS_TOKE); const int* tokP = (const int*)(C.ws + WS_TOKP); const float* tokG = (const float*)(C.ws + WS_TOKG);
    const float* lg = A.in[16] + layer * D; const float* lb = A.in[17] + layer * D;
    for (int tok = C.gw; tok < T; tok += C.NGW) {
        const int e0 = tokE[tok * 2], e1 = tokE[tok * 2 + 1]; const float g0 = tokG[tok * 2], g1 = tokG[tok * 2 + 1];
        int tb0 = 0, tb1 = 0;
#pragma unroll
        for (int j = 0; j < 16; ++j) { const int t = mi[j]; tb0 = (e0 == j) ? t : tb0; tb1 = (e1 == j) ? t : tb1; }
        const size_t r0 = (size_t)tb0 * 256 + tokP[tok * 2], r1 = (size_t)tb1 * 256 + tokP[tok * 2 + 1];
        f32x4 v[4]; float s = 0.f;
#pragma unroll
        for (int j = 0; j < 4; ++j) { const int col = 4 * C.lane + 256 * j;
            const u32x2 a = *(const u32x2*)(X1B + (size_t)tok * D + col), y0 = *(const u32x2*)(YD + r0 * D + col), y1 = *(const u32x2*)(YD + r1 * D + col);
            v[j][0] = ALPHA * bflo(a.x) + (g0 * bflo(y0.x) + g1 * bflo(y1.x)); v[j][1] = ALPHA * bfhi(a.x) + (g0 * bfhi(y0.x) + g1 * bfhi(y1.x));
            v[j][2] = ALPHA * bflo(a.y) + (g0 * bflo(y0.y) + g1 * bflo(y1.y)); v[j][3] = ALPHA * bfhi(a.y) + (g0 * bfhi(y0.y) + g1 * bfhi(y1.y));
            s += (v[j][0] + v[j][1]) + (v[j][2] + v[j][3]); }
        const float mean = wave_sum(s) * (1.f / D); float s2 = 0.f;
#pragma unroll
        for (int j = 0; j < 4; ++j) { v[j] = v[j] - mean; s2 += (v[j][0] * v[j][0] + v[j][1] * v[j][1]) + (v[j][2] * v[j][2] + v[j][3] * v[j][3]); }
        const float rstd = 1.0f / sqrtf(wave_sum(s2) * (1.f / D) + LN_EPS);
#pragma unroll
        for (int j = 0; j < 4; ++j) { const int col = 4 * C.lane + 256 * j; const f32x4 g4 = *(const f32x4*)(lg + col), b4 = *(const f32x4*)(lb + col);
            const f32x4 o = v[j] * rstd * g4 + b4;
            if (layer == 0) *(u32x2*)(X2B + (size_t)tok * D + col) = (u32x2){pk2(o[0], o[1]), pk2(o[2], o[3])};
            else *(f32x4*)(A.out + (size_t)tok * D + col) = o; }
    }
}

__global__ void __launch_bounds__(NTHREADS, 2) yoco_fwd(Args args) {
    extern __shared__ __attribute__((aligned(16))) unsigned char lds_raw[];
    Ctx C;
    C.ws = args.ws; C.lds = (LAS unsigned char*)lds_raw;
    C.tid = threadIdx.x; C.lane = C.tid & 63; C.wave = __builtin_amdgcn_readfirstlane(C.tid >> 6);
    C.G = gridDim.x; C.bid = blockIdx.x; C.gw = C.bid * NWAVES + C.wave; C.NGW = C.G * NWAVES;
    unsigned char* ws = args.ws;
#define PHASE_WS() do { ws = launder(args.ws); C.ws = ws; C.tid = launder_v((int)threadIdx.x); C.lane = C.tid & 63; } while (0)
    volatile LAS unsigned* misc = (volatile LAS unsigned*)(C.lds + LDS_MISC);
    for (int u = C.tid; u < 64; u += NTHREADS) misc[u] = 0u;
    __syncthreads();
    XcdBarrier bar; bar.bar = (unsigned*)(ws + WS_CTL) + CW_BAR; bar.x = 0; bar.st = misc + 60;
    const int lo = args.ph_lo, hi = args.ph_hi;
    if (hi - lo > 1) bar = xcd_barrier_post((unsigned*)(ws + WS_CTL) + CW_BAR, misc + 60);
#define IN(k) (lo <= (k) && (k) < hi)
#define SEAM(k) do { if (IN(k) && IN((k) + 1)) xcd_barrier(bar); } while (0)
#ifndef MK_DUP
#define MK_DUP 0
#endif
#define REP(k) for (int rep_ = 0; rep_ < 1 + ((MK_DUP >> (k)) & 1); ++rep_)

    if (IN(0)) { REP(0) { PHASE_WS(); p0_prologue(C, args); } SEAM(0); }

    if (IN(1)) {
        REP(1) {
        PHASE_WS();
        { pg8::Gemm g{(const bf16_t*)(ws + WS_XB), (const bf16_t*)(ws + WS_BT_INA), T, 1792, D}; pg8::StaticOrder S; S.init(T, 1792, C.G, C.bid);
          EpiProjA E{(bf16_t*)(ws + WS_U), (bf16_t*)(ws + WS_GV), (bf16_t*)(ws + WS_QM0)};
          pg8::gemm_phase<EpiProjA, pg8::StaticOrder>(C.lds, g, S, E, nullptr, C.tid); }
        { pg8::Gemm g{(const bf16_t*)(ws + WS_MEMB), (const bf16_t*)(ws + WS_BT_MEM), NB * NMEM, 1024, D}; SmallOrder S{4, 32, C.bid - (C.G - 32)};
          EpiPlain E{(bf16_t*)(ws + WS_MKV), 1024, 4};
          pg8::gemm_phase<EpiPlain, SmallOrder>(C.lds, g, S, E, nullptr, C.tid); }
        }
        SEAM(1);
    }
    if (IN(2)) {
        REP(2) { PHASE_WS();
        sg_mfma(C, args);
        memattn_mfma(C, (const bf16_t*)(ws + WS_QM0), (const bf16_t*)(ws + WS_MKV), 0, 256, (bf16_t*)(ws + WS_CAT), D, SGW); }
        SEAM(2);
    }
    if (IN(3)) {
        REP(3) { PHASE_WS();
        pg8::Gemm g{(const bf16_t*)(ws + WS_CAT), (const bf16_t*)(ws + WS_BT_OUTA), T, D, D}; pg8::StaticOrder S; S.init(T, D, C.G, C.bid);
        EpiResid<false> E{(const void*)args.in[0], (float*)(ws + WS_Y)};
        pg8::gemm_phase<EpiResid<false>, pg8::StaticOrder>(C.lds, g, S, E, nullptr, C.tid); }
        SEAM(3);
    }
#pragma unroll 1
    for (int layer = 0; layer < 2; ++layer) {
        const int pb = 4 + 8 * layer;
        if (IN(pb)) { PHASE_WS(); ln_route(C, args, layer); SEAM(pb); }
        if (IN(pb + 1)) {
            REP(5) { PHASE_WS();
            moe_prefix(C, layer); moe_tokens(C, 8);
            pg8::Gemm g{(const bf16_t*)(ws + WS_X1B), (const bf16_t*)(ws + WS_WGU) + (size_t)layer * 16 * 2097152, 0, 0, D};
            MoeGatherOrder S; S.tb = (const LAS int*)(C.lds + LDS_MISC); S.ntn = 8; S.G = C.G; S.c = C.bid; S.toks = (const LAS int*)(C.lds + LDS_TOKS);
            EpiSwiGLU E{(bf16_t*)(ws + WS_ACT)};
            pg8::gemm_phase<EpiSwiGLU, MoeGatherOrder>(C.lds, g, S, E, nullptr, C.tid); }
            SEAM(pb + 1);
        }
        if (IN(pb + 2)) {
            REP(6) { PHASE_WS();
            moe_prefix(C, layer);
            pg8::Gemm g{(const bf16_t*)(ws + WS_ACT), (const bf16_t*)(ws + WS_WD) + (size_t)layer * 16 * 1048576, 0, 0, D};
            MoeOrder S{(const LAS int*)(C.lds + LDS_MISC), 4, C.G, C.bid};
            EpiPlain E{(bf16_t*)(ws + WS_YD), 1024, 4};
            pg8::gemm_phase<EpiPlain, MoeOrder>(C.lds, g, S, E, nullptr, C.tid); }
            SEAM(pb + 2);
        }
        if (IN(pb + 3)) { REP(7) { PHASE_WS(); moe_prefix(C, layer); combine_ln2(C, args, layer); } if (layer == 0) SEAM(pb + 3); }
        if (layer == 0) {
            if (IN(8)) {
                REP(8) { PHASE_WS();
                pg8::Gemm g{(const bf16_t*)(ws + WS_XB), (const bf16_t*)(ws + WS_BT_B), T, 2560, D}; pg8::StaticOrder S; S.init(T, 2560, C.G, C.bid);
                EpiProjB E{(bf16_t*)(ws + WS_K), (bf16_t*)(ws + WS_V), (bf16_t*)(ws + WS_Q), (bf16_t*)(ws + WS_QM1)};
                pg8::gemm_phase<EpiProjB, pg8::StaticOrder>(C.lds, g, S, E, nullptr, C.tid); }
                SEAM(8);
            }
            if (IN(9)) {
                REP(9) { PHASE_WS();
                dilattn_mfma(C);
                memattn_mfma(C, (const bf16_t*)(ws + WS_QM1), (const bf16_t*)(ws + WS_MKV), 512, 768, (bf16_t*)(ws + WS_CAT2), 512, 256); }
                SEAM(9);
            }
            if (IN(10)) { REP(10) { PHASE_WS(); dil_merge(C, args); } SEAM(10); }
            if (IN(11)) {
                REP(11) { PHASE_WS();
                pg8::Gemm g{(const bf16_t*)(ws + WS_CAT2), (const bf16_t*)(ws + WS_BT_OUTB), T, D, 512}; pg8::StaticOrder S; S.init(T, D, C.G, C.bid);
                EpiResid<true> E{(const void*)(ws + WS_XB), (float*)(ws + WS_Y)};
                pg8::gemm_phase<EpiResid<true>, pg8::StaticOrder>(C.lds, g, S, E, nullptr, C.tid); }
                SEAM(11);
            }
        }
    }
#undef IN
#undef SEAM
}
}

extern "C" void kernel_launch(void* const* d_in, const int* in_sizes, int n_in, void* d_out, int out_size, void* d_ws, size_t ws_size, hipStream_t stream) {
    using namespace mk;
    static int grid = 0;
    if (grid == 0) {
        if (n_in != 23 || out_size != T * D || ws_size < WS_END) { fprintf(stderr, "kernel_launch: unexpected shapes (n_in %d, out %d, ws %zu)\n", n_in, out_size, ws_size); grid = -1; return; }
        int dev = 0, cus = 0, per_cu = 0;
        if (hipGetDevice(&dev) != hipSuccess || hipDeviceGetAttribute(&cus, hipDeviceAttributeMultiprocessorCount, dev) != hipSuccess) { grid = -1; return; }
        if (hipFuncSetAttribute((const void*)yoco_fwd, hipFuncAttributeMaxDynamicSharedMemorySize, LDS_BYTES) != hipSuccess) { fprintf(stderr, "kernel_launch: hipFuncSetAttribute failed\n"); grid = -1; return; }
        if (hipOccupancyMaxActiveBlocksPerMultiprocessor(&per_cu, (const void*)yoco_fwd, NTHREADS, LDS_BYTES) != hipSuccess || per_cu < 1)
            fprintf(stderr, "kernel_launch: occupancy query reports %d workgroups per CU\n", per_cu);
        (void)hipGetLastError();
        grid = cus;
    }
    if (grid < 0) return;
    (void)hipMemsetAsync((char*)d_ws + WS_CTL, 0, CTL_ZERO_BYTES, stream);
    Args a{};
    for (int i = 0; i < 23; ++i) a.in[i] = (const float*)d_in[i];
    a.out = (float*)d_out; a.ws = (unsigned char*)d_ws;
    constexpr int NL = MK_N_LAUNCHES;
    for (int li = 0; li < NL; ++li) {
        a.ph_lo = (NL == NPHASE) ? li : (li * NPHASE) / NL; a.ph_hi = (NL == NPHASE) ? li + 1 : ((li + 1) * NPHASE) / NL;
        hipLaunchKernelGGL(yoco_fwd, dim3(grid), dim3(NTHREADS), LDS_BYTES, stream, a);
    }
}
```

```cpp
#include <hip/hip_runtime.h>
#include <cstdio>
#include <cstdint>
namespace pg8 {
#define PG8_LAS __attribute__((address_space(3)))
typedef unsigned short bf16_t;
typedef short bf16x8 __attribute__((ext_vector_type(8)));
typedef float f32x4 __attribute__((ext_vector_type(4)));
typedef unsigned u32x4 __attribute__((ext_vector_type(4)));
constexpr int BM = 256, BK = 64, HALF = 128, HTB = HALF * BK * 2  , STAGE_BYTES = 8 * HTB, NXCD = 8, WGM = 8;

__host__ __device__ __forceinline__ int lds_byte(int r, int c) { const int st = (r >> 4) * 2 + (c >> 5), rr = r & 15, cc = c & 31, ob = rr * 64 + cc * 2; return st * 1024 + (ob ^ (((ob >> 9) & 1) << 5)); }
__host__ __device__ __forceinline__ void stage_rc(int b, int& R, int& C) { const int st = b / 1024, sb = b % 1024, swz = sb ^ (((sb >> 9) & 1) << 5); R = (st >> 1) * 16 + swz / 64; C = (st & 1) * 32 + (swz % 64) / 2; }
__host__ __device__ __forceinline__ int perm32(int rho) { const int n = rho >> 4, i = rho & 15; return 8 * (i >> 2) + 4 * n + (i & 3); }

struct Unit { int pm, pn; };
struct Gemm { const bf16_t* A; const bf16_t* Bt; int M, N, K; int sA, sB; };

struct StaticOrder {
    int nM, nN, nwg, G, c;
    __host__ __device__ void init(int M, int N, int G_, int c_) { nM = M / BM; nN = N / BM; nwg = nM * nN; G = G_; c = c_; }
    __host__ __device__ bool next(int i, Unit& u) const {
        const long L = (long)i * G + c; if (L >= nwg) return false;
        int wgid = (int)L; { const int q = nwg / NXCD, r = nwg % NXCD, xcd = wgid % NXCD, off = wgid / NXCD; wgid = (xcd < r ? xcd * (q + 1) : r * (q + 1) + (xcd - r) * q) + off; }
        const int nig = WGM * nN, gid = wgid / nig, fm = gid * WGM, gsz = (nM - fm) < WGM ? (nM - fm) : WGM;
        u.pm = fm + ((wgid % nig) % gsz); u.pn = (wgid % nig) / gsz; return true;
    }
    __device__ __forceinline__ void a_ready(const Unit&) const {}
    __device__ __forceinline__ void done(const Unit&) const {}
    __device__ __forceinline__ int arow(int, const Unit& u, int r) const { return u.pm * BM + r; }
};
__device__ __forceinline__ unsigned cvt_pk_bf16(float lo, float hi) { unsigned r; asm volatile("v_cvt_pk_bf16_f32 %0, %1, %2" : "=v"(r) : "v"(lo), "v"(hi)); return r; }
typedef float f32x2 __attribute__((ext_vector_type(2)));
__device__ __forceinline__ f32x2 gelu_pk(f32x2 v) {
    const f32x2 av = __builtin_elementwise_abs(v), d = av * 0.2316418882f + 1.0f;
    f32x2 t; t.x = __builtin_amdgcn_rcpf(d.x); t.y = __builtin_amdgcn_rcpf(d.y);
    f32x2 q = t * 0.5307027145f + (-0.7265760135f); q = q * t + 0.7107068705f; q = q * t + (-0.142248368f); q = q * t + 0.127414796f; q = q * t;
    const f32x2 s = (v * v) * (-0.72134752044f);
    f32x2 e; e.x = __builtin_amdgcn_exp2f(s.x); e.y = __builtin_amdgcn_exp2f(s.y);
    const f32x2 m = v * (q * e), r = v - m;
    f32x2 o; o.x = v.x < 0.f ? m.x : r.x; o.y = v.y < 0.f ? m.y : r.y; return o;
}
template <class Epi, class Sched, bool STAMP = false, bool F8 = false>
__device__ __forceinline__ void gemm_phase(PG8_LAS unsigned char* lds, const Gemm g, const Sched& S, const Epi& E, unsigned long long* stamps, const int tid) {
    const int wid = __builtin_amdgcn_readfirstlane(tid >> 6), lane = tid & 63, wr = wid >> 2, wc = wid & 3, fr = lane & 15, fq = lane >> 4;
    const int K = g.K, nt = K / BK;
    int ts_lo = 0, ts_hi = 0, nts = 0; const unsigned long long rt_entry = STAMP ? (unsigned long long)wall_clock64() : 0ull;
#define PG8_STAMP() do { if (STAMP && wid == 0 && nts < 64) { const unsigned long long _c = (unsigned long long)clock64(); \
        ts_lo = (lane == nts) ? (int)(unsigned)_c : ts_lo; ts_hi = (lane == nts) ? (int)(unsigned)(_c >> 32) : ts_hi; ++nts; } } while (0)
    PG8_STAMP();
    unsigned colA[2], voffB[2]; int rowA[2];
#pragma unroll
    for (int i = 0; i < 2; ++i) { int R, C; stage_rc(tid * 16 + i * 8192, R, C); const int Rb = Epi::PERM ? ((R & ~31) + perm32(R & 31)) : R;
        rowA[i] = R; colA[i] = (unsigned)C * 2u; voffB[i] = (unsigned)(Rb * K + C) * 2u; }
#define PG8_AOFF(dst, uidx, un) do { _Pragma("unroll") for (int _h = 0; _h < 2; ++_h) _Pragma("unroll") for (int _i = 0; _i < 2; ++_i) \
        dst[_h][_i] = (unsigned)S.arow((uidx), (un), _h * HALF + rowA[_i]) * (unsigned)(K * 2) + colA[_i]; } while (0)
    const size_t kstep = (size_t)(BK * 2);
    const size_t hstep = (size_t)HALF * K * 2;
    const size_t tstep = 2 * hstep;
    const unsigned ldsw = (unsigned)wid * 1024u;
    const int aoff = F8 ? lds_byte(wr * 64 + fr, fq * 16) : lds_byte(wr * 64 + fr, fq * 8), boff = F8 ? lds_byte(wc * 32 + fr, fq * 16) : lds_byte(wc * 32 + fr, fq * 8);
    constexpr int KOFF = F8 ? 16 : 1024;
#define PG8_SA(b, h) (((b) * 2 + (h)) * HTB)
#define PG8_SB(b, h) ((4 + (b) * 2 + (h)) * HTB)
#define PG8_STAGE(bufoff, gbase, voff) do { _Pragma("unroll") for (int _i = 0; _i < 2; ++_i) \
        __builtin_amdgcn_global_load_lds((const unsigned*)((const char*)(gbase) + (voff)[_i]), (PG8_LAS unsigned*)(lds + (bufoff) + ldsw + _i * 8192), 16, 0, 0); } while (0)
#define PG8_LDA(dst, b, h) do { _Pragma("unroll") for (int m = 0; m < 4; ++m) _Pragma("unroll") for (int k = 0; k < 2; ++k) dst[m][k] = *(const PG8_LAS bf16x8*)(lds + PG8_SA(b, h) + aoff + m * 2048 + k * KOFF); } while (0)
#define PG8_LDB(dst, b, h) do { _Pragma("unroll") for (int n = 0; n < 2; ++n) _Pragma("unroll") for (int k = 0; k < 2; ++k) dst[n][k] = *(const PG8_LAS bf16x8*)(lds + PG8_SB(b, h) + boff + n * 2048 + k * KOFF); } while (0)
#define PG8_MMA(ai, bj, At, Bt) do { __builtin_amdgcn_s_setprio(1); \
        if constexpr (F8) { _Pragma("unroll") for (int m = 0; m < 4; ++m) _Pragma("unroll") for (int n = 0; n < 2; ++n) { \
            typedef int i32x4_ __attribute__((ext_vector_type(4))); typedef int i32x8_ __attribute__((ext_vector_type(8))); \
            const i32x8_ b8_ = __builtin_shufflevector(__builtin_bit_cast(i32x4_, Bt[n][0]), __builtin_bit_cast(i32x4_, Bt[n][1]), 0, 1, 2, 3, 4, 5, 6, 7); \
            const i32x8_ a8_ = __builtin_shufflevector(__builtin_bit_cast(i32x4_, At[m][0]), __builtin_bit_cast(i32x4_, At[m][1]), 0, 1, 2, 3, 4, 5, 6, 7); \
            acc[ai][bj][m][n] = __builtin_amdgcn_mfma_scale_f32_16x16x128_f8f6f4(b8_, a8_, acc[ai][bj][m][n], 0, 0, 0, g.sB, 0, g.sA); } } \
        else { _Pragma("unroll") for (int m = 0; m < 4; ++m) _Pragma("unroll") for (int n = 0; n < 2; ++n) _Pragma("unroll") for (int k = 0; k < 2; ++k) \
            acc[ai][bj][m][n] = __builtin_amdgcn_mfma_f32_16x16x32_bf16(Bt[n][k], At[m][k], acc[ai][bj][m][n], 0, 0, 0); } \
        __builtin_amdgcn_s_setprio(0); } while (0)
#define PG8_WAIT_V(n) asm volatile("s_waitcnt vmcnt(" #n ")" ::: "memory")
#define PG8_WAIT_L(n) asm volatile("s_waitcnt lgkmcnt(" #n ")" ::: "memory")
#define PG8_BAR __builtin_amdgcn_s_barrier()
#define PG8_SCHED __builtin_amdgcn_sched_barrier(0)
    Unit cur, nxt; int ui = 0;
    if (!S.next(0, cur)) return;
    f32x4 acc[2][2][4][2];
#pragma unroll
    for (int a = 0; a < 2; ++a)
#pragma unroll
        for (int b = 0; b < 2; ++b)
#pragma unroll
            for (int m = 0; m < 4; ++m)
#pragma unroll
                for (int n = 0; n < 2; ++n) acc[a][b][m][n] = (f32x4){0.f, 0.f, 0.f, 0.f};
    bf16x8 At[4][2], B0[2][2], B1[2][2];
    const char* Ab = (const char*)g.A; const char* cB = (const char*)g.Bt + (size_t)cur.pn * tstep;
    unsigned cuA[2][2];
    S.a_ready(cur);
    PG8_AOFF(cuA, 0, cur);
    PG8_STAGE(PG8_SB(0, 0), cB, voffB); PG8_STAGE(PG8_SA(0, 0), Ab, cuA[0]); PG8_STAGE(PG8_SB(0, 1), cB + hstep, voffB); PG8_STAGE(PG8_SA(0, 1), Ab, cuA[1]);
    if (wr == 1) PG8_BAR;
    PG8_WAIT_V(4); PG8_BAR;
    PG8_STAGE(PG8_SB(1, 0), cB + kstep, voffB); PG8_STAGE(PG8_SA(1, 0), Ab + kstep, cuA[0]); PG8_STAGE(PG8_SB(1, 1), cB + hstep + kstep, voffB);
    PG8_WAIT_V(6); PG8_BAR;
    PG8_STAMP();
    for (;;) {
        const bool has_next = S.next(ui + 1, nxt);
        const char* nB = has_next ? (const char*)g.Bt + (size_t)nxt.pn * tstep : cB;
        for (int t = 0; t < nt; t += 2) {
            const bool last = (t == nt - 2);
            const char* a1 = Ab + (size_t)(t + 1) * kstep;
            const char* a2 = last ? Ab : Ab + (size_t)(t + 2) * kstep; const char* b2 = last ? nB : cB + (size_t)(t + 2) * kstep;
            const char* a3 = a2 + kstep; const char* b3 = b2 + kstep;

            if (last && has_next) S.a_ready(nxt);
            PG8_LDB(B0, 0, 0); PG8_SCHED; PG8_LDA(At, 0, 0); PG8_STAGE(PG8_SA(1, 1), a1, cuA[1]);
            PG8_WAIT_L(8); PG8_BAR; PG8_WAIT_L(0); PG8_MMA(0, 0, At, B0); PG8_BAR; PG8_SCHED;
            if (last && has_next) PG8_AOFF(cuA, ui + 1, nxt);
            PG8_LDB(B1, 0, 1); PG8_STAGE(PG8_SB(0, 0), b2, voffB);
            PG8_BAR; PG8_WAIT_L(0); PG8_MMA(0, 1, At, B1); PG8_BAR;
            PG8_LDA(At, 0, 1); PG8_STAGE(PG8_SA(0, 0), a2, cuA[0]);
            PG8_BAR; PG8_WAIT_L(0); PG8_MMA(1, 0, At, B0); PG8_BAR; PG8_SCHED;
            PG8_STAGE(PG8_SB(0, 1), b2 + hstep, voffB);
            PG8_WAIT_V(6); PG8_BAR; PG8_MMA(1, 1, At, B1); PG8_BAR;
            PG8_LDB(B0, 1, 0); PG8_SCHED; PG8_LDA(At, 1, 0); PG8_STAGE(PG8_SA(0, 1), a2, cuA[1]);
            PG8_WAIT_L(8); PG8_BAR; PG8_WAIT_L(0); PG8_MMA(0, 0, At, B0); PG8_BAR; PG8_SCHED;
            PG8_LDB(B1, 1, 1); PG8_STAGE(PG8_SB(1, 0), b3, voffB);
            PG8_BAR; PG8_WAIT_L(0); PG8_MMA(0, 1, At, B1); PG8_BAR;
            PG8_LDA(At, 1, 1); PG8_STAGE(PG8_SA(1, 0), a3, cuA[0]);
            PG8_BAR; PG8_WAIT_L(0); PG8_MMA(1, 0, At, B0); PG8_BAR; PG8_SCHED;
            PG8_STAGE(PG8_SB(1, 1), b3 + hstep, voffB);
            PG8_WAIT_V(6); PG8_BAR; PG8_MMA(1, 1, At, B1); PG8_BAR;
        }
        PG8_STAMP();
        if constexpr (!Epi::AFTER_DRAIN) { E(acc, cur, wr, wc, fr, fq); S.done(cur); }
        PG8_STAMP();
        if (!has_next) break;
#pragma unroll
        for (int a = 0; a < 2; ++a)
#pragma unroll
            for (int b = 0; b < 2; ++b)
#pragma unroll
                for (int m = 0; m < 4; ++m)
#pragma unroll
                    for (int n = 0; n < 2; ++n) acc[a][b][m][n] = (f32x4){0.f, 0.f, 0.f, 0.f};
        cur = nxt; cB = nB; ++ui;
    }
    PG8_WAIT_V(0);
    if (wr == 0) PG8_BAR;
    PG8_BAR;
    if constexpr (Epi::AFTER_DRAIN) { E.fused(acc, cur, wr, wc, fr, fq, lds, wid, lane); S.done(cur); }
    PG8_STAMP();
    if (STAMP && wid == 0) { stamps[lane] = lane < nts ? (((unsigned long long)(unsigned)ts_hi << 32) | (unsigned)ts_lo) : 0ull;
        if (lane == 62) stamps[62] = rt_entry; if (lane == 63) stamps[63] = (unsigned long long)wall_clock64(); }
#undef PG8_STAMP
#undef PG8_SA
#undef PG8_SB
#undef PG8_STAGE
#undef PG8_AOFF
#undef PG8_LDA
#undef PG8_LDB
#undef PG8_MMA
#undef PG8_WAIT_V
#undef PG8_WAIT_L
#undef PG8_BAR
#undef PG8_SCHED
}
}

namespace mk {
using pg8::bf16_t; using pg8::f32x4; using pg8::u32x4; using pg8::Unit; using pg8::cvt_pk_bf16;
#define LAS __attribute__((address_space(3)))
typedef float f32x2 __attribute__((ext_vector_type(2)));
typedef unsigned u32x2 __attribute__((ext_vector_type(2)));

#ifndef MK_N_LAUNCHES
#define MK_N_LAUNCHES 1
#endif
constexpr int NPHASE = 16;
constexpr int NB = 8, SEQ = 2048, D = 1024, T = NB * SEQ, NMEM = 256, SGW = 768, NSG = 12, HD = 64, CH = 128;
constexpr int NEXP = 16, LISTCAP = 16384;
constexpr float ALPHA = 1.41421356237f;
constexpr float LN_EPS = 1e-5f, ATT_SCALE = 0.125f;
constexpr int NWAVES = 8, NTHREADS = 512;

constexpr size_t MiB = 1u << 20;
constexpr size_t WS_CTL = 0, CTL_ZERO_BYTES = 1 * MiB;
constexpr size_t WS_TOKE = 1 * MiB, WS_TOKP = WS_TOKE + 128 * 1024, WS_TOKG = WS_TOKP + 128 * 1024;
constexpr size_t WS_LIST = 2 * MiB, WS_LSE = 3 * MiB, WS_SGWB = 4 * MiB;
constexpr size_t WS_MKV = 8 * MiB, WS_MEMB = 12 * MiB;
constexpr size_t WS_BT_INA = 18 * MiB, WS_BT_OUTA = 22 * MiB, WS_BT_B = 24 * MiB, WS_BT_OUTB = 29 * MiB, WS_BT_MEM = 30 * MiB;
constexpr size_t WS_WGU = 32 * MiB, WS_WD = 160 * MiB;
constexpr size_t WS_A = 224 * MiB;
constexpr size_t WS_U = WS_A, WS_GV = WS_A + 24 * MiB, WS_QM0 = WS_A + 48 * MiB;
constexpr size_t WS_K = WS_A, WS_V = WS_A + 24 * MiB, WS_Q = WS_A + 48 * MiB, WS_QM1 = WS_A + 72 * MiB;
constexpr size_t WS_ACT = WS_A;
constexpr size_t WS_XB = 304 * MiB;
constexpr size_t WS_C = 336 * MiB;
constexpr size_t WS_CAT = WS_C, WS_OG = WS_C, WS_CAT2 = WS_C + 24 * MiB;
constexpr size_t WS_Y = 376 * MiB;
constexpr size_t WS_YD = 336 * MiB;
constexpr size_t WS_X1B = 440 * MiB;
constexpr size_t WS_X1F8 = 472 * MiB;
constexpr size_t WS_END = 488 * MiB;
constexpr size_t WS_WGU8 = WS_WGU + 64 * MiB, WS_WD8 = WS_WD + 32 * MiB;
constexpr int CW_TMO = 0, CW_BAR = 4096, CW_CNT = 16384;
constexpr int LDS_TOKS = 131072 + 1024, MAX_UNITS = 8;
constexpr int LDS_MISC = 131072;
constexpr int LDS_BYTES = 147456;
static_assert(LDS_TOKS + MAX_UNITS * 1024 <= LDS_BYTES, "LDS map");

#define LDS_WAIT() asm volatile("s_waitcnt lgkmcnt(0)" ::: "memory")
#define VM_WAIT() asm volatile("s_waitcnt vmcnt(0)" ::: "memory")
__device__ __forceinline__ unsigned f2bf(float f) { unsigned u = __builtin_bit_cast(unsigned, f); return (u + 0x7fffu + ((u >> 16) & 1u)) >> 16; }
__device__ __forceinline__ unsigned pk2(float lo, float hi) { return f2bf(lo) | (f2bf(hi) << 16); }
__device__ __forceinline__ unsigned pk4_fp8_e(float a, float b, float c, float d) { int r = 0; r = __builtin_amdgcn_cvt_pk_fp8_f32(a, b, r, false); r = __builtin_amdgcn_cvt_pk_fp8_f32(c, d, r, true); return (unsigned)r; }
__device__ __forceinline__ float bflo(unsigned w) { return __uint_as_float(w << 16); }
__device__ __forceinline__ float bfhi(unsigned w) { return __uint_as_float(w & 0xffff0000u); }
__device__ __forceinline__ float bf1(bf16_t v) { return __uint_as_float(((unsigned)v) << 16); }
__device__ __forceinline__ float wave_sum(float v) {
#pragma unroll
    for (int o = 1; o < 64; o <<= 1) v += __shfl_xor(v, o);
    return v;
}
__device__ __forceinline__ float wave_max(float v) {
#pragma unroll
    for (int o = 1; o < 64; o <<= 1) v = fmaxf(v, __shfl_xor(v, o));
    return v;
}

#define XB_TMO      128
#define XB_XCNT(j)  (256  + 64 * (j))
#define XB_XSUB(j)  (1280 + 64 * (j))
#define XB_XGEN(j)  (2304 + 64 * (j))
#define XB_TOP      3328
#define XB_TOPGEN   3392
#define XCD_BAR_WORDS 3456
#define XB_SPIN_CAP (1u << 18)
__device__ __forceinline__ unsigned xb_ld(unsigned* p)              { return __hip_atomic_load(p, __ATOMIC_RELAXED, __HIP_MEMORY_SCOPE_AGENT); }
__device__ __forceinline__ unsigned xb_add(unsigned* p, unsigned v) { return __hip_atomic_fetch_add(p, v, __ATOMIC_RELAXED, __HIP_MEMORY_SCOPE_AGENT); }
__device__ __forceinline__ unsigned xb_xcc_id() { return (unsigned)__builtin_amdgcn_s_getreg((3 << 11) | 20) & 0xFu; }
#define XB_SPIN(cond, bar) do { unsigned _sp = 0; while (cond) { __builtin_amdgcn_s_sleep(1); \
    if ((++_sp & 255u) == 0u) { if (xb_ld(&(bar)[XB_TMO])) break; if (_sp > XB_SPIN_CAP) { atomicAdd(&(bar)[XB_TMO], 1u); break; } } } } while (0)
struct XcdBarrier { unsigned* bar; unsigned x; volatile LAS unsigned* st; };
__device__ __forceinline__ XcdBarrier xcd_barrier_post(unsigned* bar, volatile LAS unsigned* st) {
    XcdBarrier b; b.bar = bar; b.x = xb_xcc_id(); b.st = st;
    if (threadIdx.x == 0) (void)xb_add(&bar[XB_XCNT(b.x)], 1u);
    return b;
}
__device__ __forceinline__ void xcd_barrier_complete(unsigned* bar, unsigned x, unsigned& nloc, unsigned& nx) {
    const unsigned G = gridDim.x * gridDim.y * gridDim.z;
    unsigned sum, cnt, mine, sp = 0u;
    for (;;) {
        sum = 0u; cnt = 0u; mine = 0u;
#pragma unroll
        for (unsigned j = 0; j < 16; ++j) { const unsigned c = xb_ld(&bar[XB_XCNT(j)]); sum += c; cnt += (c > 0u) ? 1u : 0u; mine = (j == x) ? c : mine; }
        if (sum == G) break;
        __builtin_amdgcn_s_sleep(1);
        if ((++sp & 255u) == 0u) { if (xb_ld(&bar[XB_TMO])) break; if (sp > XB_SPIN_CAP) { atomicAdd(&bar[XB_TMO], 1u); break; } }
    }
    nloc = mine > 0u ? mine : 1u; nx = cnt > 0u ? cnt : 1u;
}
__device__ __forceinline__ void xcd_barrier(const XcdBarrier& b) {
    asm volatile("s_waitcnt vmcnt(0)" ::: "memory");
    __syncthreads();
    if (threadIdx.x == 0) {
        unsigned* bar = b.bar;
        __builtin_amdgcn_s_waitcnt(0);
        unsigned nloc = b.st[0], nx = b.st[1];
        if (nloc == 0u) { xcd_barrier_complete(bar, b.x, nloc, nx); b.st[0] = nloc; b.st[1] = nx; }
        const unsigned old = xb_add(&bar[XB_XSUB(b.x)], 1u);
        const unsigned gen = old / nloc;
        if (old + 1u == (gen + 1u) * nloc) {
            __builtin_amdgcn_fence(__ATOMIC_RELEASE, "agent");
            asm volatile("s_waitcnt vmcnt(0)" ::: "memory");
            const unsigned og = xb_add(&bar[XB_TOP], 1u);
            const unsigned tg = og / nx;
            if (og + 1u == (tg + 1u) * nx) xb_add(&bar[XB_TOPGEN], 1u);
            else XB_SPIN(xb_ld(&bar[XB_TOPGEN]) == tg, bar);
            __builtin_amdgcn_fence(__ATOMIC_ACQUIRE, "agent");
            xb_add(&bar[XB_XGEN(b.x)], 1u);
            asm volatile("s_waitcnt vmcnt(0)" ::: "memory");
        } else {
            XB_SPIN(xb_ld(&bar[XB_XGEN(b.x)]) == gen, bar);
            __builtin_amdgcn_fence(__ATOMIC_ACQUIRE, "agent");
            asm volatile("s_waitcnt vmcnt(0)" ::: "memory");
        }
    }
    __syncthreads();
}


struct EpiProjA {
    static constexpr bool PERM = true, AFTER_DRAIN = false;
    bf16_t *u, *gv, *qm;
    __device__ __forceinline__ void operator()(const f32x4 (&acc)[2][2][4][2], const Unit& un, int wr, int wc, int fr, int fq) const {
        const int row0 = un.pm * 256 + wr * 64 + fr;
        bf16_t* base; int ldc, colt; bool act; float sc = 1.f;
        if (un.pn < 3) { base = u; ldc = SGW; colt = un.pn * 256; act = true; }
        else if (un.pn < 6) { base = gv; ldc = SGW; colt = (un.pn - 3) * 256; act = true; }
        else { base = qm; ldc = 256; colt = 0; act = false; sc = ATT_SCALE; }
        const int col0 = colt + wc * 32 + 8 * fq;
#pragma unroll
        for (int ai = 0; ai < 2; ++ai)
#pragma unroll
            for (int m = 0; m < 4; ++m) { bf16_t* rowp = base + (size_t)(row0 + ai * 128 + m * 16) * ldc + col0;
#pragma unroll
                for (int bj = 0; bj < 2; ++bj) { f32x4 v0 = acc[ai][bj][m][0], v1 = acc[ai][bj][m][1];
                    if (act) { pg8::f32x2 a = pg8::gelu_pk((pg8::f32x2){v0[0], v0[1]}), b = pg8::gelu_pk((pg8::f32x2){v0[2], v0[3]}), c = pg8::gelu_pk((pg8::f32x2){v1[0], v1[1]}), d = pg8::gelu_pk((pg8::f32x2){v1[2], v1[3]});
                        v0 = (f32x4){a.x, a.y, b.x, b.y}; v1 = (f32x4){c.x, c.y, d.x, d.y}; }
                    v0 = v0 * sc; v1 = v1 * sc;
                    u32x4 w; w.x = cvt_pk_bf16(v0[0], v0[1]); w.y = cvt_pk_bf16(v0[2], v0[3]); w.z = cvt_pk_bf16(v1[0], v1[1]); w.w = cvt_pk_bf16(v1[2], v1[3]);
                    *(u32x4*)(rowp + bj * 128) = w; } }
    }
};
struct EpiProjB {
    static constexpr bool PERM = true, AFTER_DRAIN = false;
    bf16_t *k, *v, *q, *qm;
    __device__ __forceinline__ void operator()(const f32x4 (&acc)[2][2][4][2], const Unit& un, int wr, int wc, int fr, int fq) const {
        const int row0 = un.pm * 256 + wr * 64 + fr;
        bf16_t* base; int ldc, colt; float sc = 1.f;
        if (un.pn < 3) { base = k; ldc = SGW; colt = un.pn * 256; }
        else if (un.pn < 6) { base = v; ldc = SGW; colt = (un.pn - 3) * 256; }
        else if (un.pn < 9) { base = q; ldc = SGW; colt = (un.pn - 6) * 256; sc = ATT_SCALE; }
        else { base = qm; ldc = 256; colt = 0; sc = ATT_SCALE; }
        const int col0 = colt + wc * 32 + 8 * fq;
#pragma unroll
        for (int ai = 0; ai < 2; ++ai)
#pragma unroll
            for (int m = 0; m < 4; ++m) { bf16_t* rowp = base + (size_t)(row0 + ai * 128 + m * 16) * ldc + col0;
#pragma unroll
                for (int bj = 0; bj < 2; ++bj) { f32x4 v0 = acc[ai][bj][m][0] * sc, v1 = acc[ai][bj][m][1] * sc;
                    u32x4 w; w.x = cvt_pk_bf16(v0[0], v0[1]); w.y = cvt_pk_bf16(v0[2], v0[3]); w.z = cvt_pk_bf16(v1[0], v1[1]); w.w = cvt_pk_bf16(v1[2], v1[3]);
                    *(u32x4*)(rowp + bj * 128) = w; } }
    }
};
struct EpiPlain {
    static constexpr bool PERM = true, AFTER_DRAIN = false;
    bf16_t* O; int ldc, ntn;
    __device__ __forceinline__ void operator()(const f32x4 (&acc)[2][2][4][2], const Unit& un, int wr, int wc, int fr, int fq) const {
        const int row0 = un.pm * 256 + wr * 64 + fr;
        const int col0 = (un.pn % ntn) * 256 + wc * 32 + 8 * fq;
#pragma unroll
        for (int ai = 0; ai < 2; ++ai)
#pragma unroll
            for (int m = 0; m < 4; ++m) { bf16_t* rowp = O + (size_t)(row0 + ai * 128 + m * 16) * ldc + col0;
#pragma unroll
                for (int bj = 0; bj < 2; ++bj) { const f32x4 v0 = acc[ai][bj][m][0], v1 = acc[ai][bj][m][1];
                    u32x4 w; w.x = cvt_pk_bf16(v0[0], v0[1]); w.y = cvt_pk_bf16(v0[2], v0[3]); w.z = cvt_pk_bf16(v1[0], v1[1]); w.w = cvt_pk_bf16(v1[2], v1[3]);
                    *(u32x4*)(rowp + bj * 128) = w; } }
    }
};
struct EpiSwiGLU {
    static constexpr bool PERM = true, AFTER_DRAIN = false;
    bf16_t* O;
    __device__ __forceinline__ void operator()(const f32x4 (&acc)[2][2][4][2], const Unit& un, int wr, int wc, int fr, int fq) const {
        const int row0 = un.pm * 256 + wr * 64 + fr;
        const int col0 = (un.pn & 7) * 128 + wc * 32 + 8 * fq;
#pragma unroll
        for (int ai = 0; ai < 2; ++ai)
#pragma unroll
            for (int m = 0; m < 4; ++m) { bf16_t* rowp = O + (size_t)(row0 + ai * 128 + m * 16) * 1024 + col0;
                float r[8];
#pragma unroll
                for (int n = 0; n < 2; ++n)
#pragma unroll
                    for (int j = 0; j < 4; ++j) { const float g = acc[ai][0][m][n][j], up = acc[ai][1][m][n][j];
                        r[n * 4 + j] = g * __builtin_amdgcn_rcpf(1.0f + __expf(-g)) * up; }
                u32x4 w; w.x = cvt_pk_bf16(r[0], r[1]); w.y = cvt_pk_bf16(r[2], r[3]); w.z = cvt_pk_bf16(r[4], r[5]); w.w = cvt_pk_bf16(r[6], r[7]);
                *(u32x4*)rowp = w; }
    }
};
struct EpiSwiGLU8 {
    static constexpr bool PERM = true, AFTER_DRAIN = false;
    unsigned char* O;
    __device__ __forceinline__ void operator()(const f32x4 (&acc)[2][2][4][2], const Unit& un, int wr, int wc, int fr, int fq) const {
        const int row0 = un.pm * 256 + wr * 64 + fr;
        const int col0 = (un.pn & 7) * 128 + wc * 32 + 8 * fq;
#pragma unroll
        for (int ai = 0; ai < 2; ++ai)
#pragma unroll
            for (int m = 0; m < 4; ++m) { unsigned char* rowp = O + (size_t)(row0 + ai * 128 + m * 16) * 1024 + col0;
                float r[8];
#pragma unroll
                for (int n = 0; n < 2; ++n)
#pragma unroll
                    for (int j = 0; j < 4; ++j) { const float g = acc[ai][0][m][n][j], up = acc[ai][1][m][n][j];
                        r[n * 4 + j] = g * __builtin_amdgcn_rcpf(1.0f + __expf(-g)) * up * 8.0f; }
                *(u32x2*)rowp = (u32x2){pk4_fp8_e(r[0], r[1], r[2], r[3]), pk4_fp8_e(r[4], r[5], r[6], r[7])}; }
    }
};
template <bool RB> struct EpiResid {
    static constexpr bool PERM = false, AFTER_DRAIN = false;
    const void* res; float* Y;
    __device__ __forceinline__ void operator()(const f32x4 (&acc)[2][2][4][2], const Unit& un, int wr, int wc, int fr, int fq) const {
        const int row0 = un.pm * 256 + wr * 64 + fr, col0 = un.pn * 256 + wc * 32 + 4 * fq;
#pragma unroll
        for (int ai = 0; ai < 2; ++ai)
#pragma unroll
            for (int m = 0; m < 4; ++m) { const size_t off = (size_t)(row0 + ai * 128 + m * 16) * D + col0;
#pragma unroll
                for (int bj = 0; bj < 2; ++bj)
#pragma unroll
                    for (int n = 0; n < 2; ++n) { const size_t o = off + bj * 128 + n * 16; f32x4 r;
                        if (RB) { const u32x2 w = *(const u32x2*)((const bf16_t*)res + o); r = (f32x4){bflo(w.x), bfhi(w.x), bflo(w.y), bfhi(w.y)}; }
                        else r = *(const f32x4*)((const float*)res + o);
                        *(f32x4*)(Y + o) = r * ALPHA + acc[ai][bj][m][n]; } }
    }
};
struct SmallOrder {
    int nN, nwg, c;
    __device__ bool next(int i, Unit& u) const { if (i != 0 || c < 0 || c >= nwg) return false; u.pm = c / nN; u.pn = c % nN; return true; }
    __device__ __forceinline__ void a_ready(const Unit&) const {}
    __device__ __forceinline__ void done(const Unit&) const {}
    __device__ __forceinline__ int arow(int, const Unit& u, int r) const { return u.pm * 256 + r; }
};
struct MoeOrder {
    const LAS int* tb;
    int ntn, G, c;
    __device__ bool next(int i, Unit& u) const {
        const int L = i * G + c; if (L >= tb[16] * ntn) return false;
        int e = 0;
#pragma unroll
        for (int j = 1; j < 16; ++j) e += (L >= tb[j] * ntn) ? 1 : 0;
        const int r = L - tb[e] * ntn, te = tb[e + 1] - tb[e];
        u.pm = tb[e] + r % te; u.pn = e * ntn + r / te; return true;
    }
    __device__ __forceinline__ void a_ready(const Unit&) const {}
    __device__ __forceinline__ void done(const Unit&) const {}
    __device__ __forceinline__ int arow(int, const Unit& u, int r) const { return u.pm * 256 + r; }
};
struct MoeGatherOrder : MoeOrder {
    const LAS int* toks;
    __device__ __forceinline__ int arow(int ui, const Unit&, int r) const { return toks[ui * 256 + r]; }
};

struct Args { const float* in[23]; float* out; unsigned char* ws; int ph_lo, ph_hi; };
struct Ctx {
    unsigned char* ws; LAS unsigned char* lds;
    int tid, lane, wave, gw, NGW, G, bid;
};
__device__ __forceinline__ unsigned char* launder(unsigned char* p) { asm volatile("" : "+s"(p)); return p; }
__device__ __forceinline__ int launder_v(int v) { asm volatile("" : "+v"(v)); return v; }

__device__ __forceinline__ void tr_item(const float* W, int K, int N, bf16_t* WT, int grp, int gstride, int roff, LAS float* scr, int item, int lane) {
    const int nblk = N / 32, kb = item / nblk, nb = item % nblk, k0 = 64 * kb, n0 = 32 * nb;
    float ld[32];
    { const float* wp = W + (size_t)(k0 + (lane >> 5)) * N + n0 + (lane & 31);
#pragma unroll
      for (int i = 0; i < 32; ++i) ld[i] = __builtin_nontemporal_load(wp + (size_t)(2 * i) * N); }
#pragma unroll
    for (int i = 0; i < 32; ++i) scr[(2 * i + (lane >> 5)) * 33 + (lane & 31)] = ld[i];
    LDS_WAIT(); asm volatile("" ::: "memory");
    const int c = lane & 7;
#pragma unroll
    for (int j = 0; j < 4; ++j) { const int n = (lane >> 3) + 8 * j; const LAS float* s = scr + (8 * c) * 33 + n;
        const int nn = n0 + n, drow = (nn / grp) * gstride + (nn % grp) + roff;
        u32x4 o; o.x = pk2(s[0 * 33], s[1 * 33]); o.y = pk2(s[2 * 33], s[3 * 33]); o.z = pk2(s[4 * 33], s[5 * 33]); o.w = pk2(s[6 * 33], s[7 * 33]);
        *(u32x4*)(WT + (size_t)drow * K + k0 + 8 * c) = o; }
    LDS_WAIT(); asm volatile("" ::: "memory");
}
__device__ __forceinline__ unsigned pk4_fp8(float a, float b, float c, float d) { int r = 0; r = __builtin_amdgcn_cvt_pk_fp8_f32(a, b, r, false); r = __builtin_amdgcn_cvt_pk_fp8_f32(c, d, r, true); return (unsigned)r; }
__device__ __forceinline__ void tr_item8(const float* W, int K, int N, unsigned char* WT, int grp, int gstride, int roff, float sc, LAS float* scr, int item, int lane) {
    const int nblk = N / 32, kb = item / nblk, nb = item % nblk, k0 = 64 * kb, n0 = 32 * nb;
    float ld[32];
    { const float* wp = W + (size_t)(k0 + (lane >> 5)) * N + n0 + (lane & 31);
#pragma unroll
      for (int i = 0; i < 32; ++i) ld[i] = __builtin_nontemporal_load(wp + (size_t)(2 * i) * N); }
#pragma unroll
    for (int i = 0; i < 32; ++i) scr[(2 * i + (lane >> 5)) * 33 + (lane & 31)] = ld[i];
    LDS_WAIT(); asm volatile("" ::: "memory");
    const int c = lane & 7;
#pragma unroll
    for (int j = 0; j < 4; ++j) { const int n = (lane >> 3) + 8 * j; const LAS float* s = scr + (8 * c) * 33 + n;
        const int nn = n0 + n, drow = (nn / grp) * gstride + (nn % grp) + roff;
        u32x2 o; o.x = pk4_fp8(s[0 * 33] * sc, s[1 * 33] * sc, s[2 * 33] * sc, s[3 * 33] * sc); o.y = pk4_fp8(s[4 * 33] * sc, s[5 * 33] * sc, s[6 * 33] * sc, s[7 * 33] * sc);
        *(u32x2*)(WT + (size_t)drow * K + k0 + 8 * c) = o; }
    LDS_WAIT(); asm volatile("" ::: "memory");
}
constexpr float W8_SCALE = 32.0f, ACT8_SCALE = 8.0f;
constexpr int E8_ONE = 0x7f7f7f7f, E8_W = 0x7a7a7a7a, E8_ACT = 0x7c7c7c7c;
__device__ __forceinline__ void p0_prologue(const Ctx& C, const Args& A) {
    LAS float* scr = (LAS float*)(C.lds + C.wave * 16384);
    unsigned char* ws = C.ws;
    constexpr int I_MOE = 16 * 32;
    constexpr int N_MOE = 32 * I_MOE;
    constexpr int I_INA = 16 * 56, I_SQ = 512, I_KV = 16 * 24, I_OUTB = 8 * 32, I_MEM = 16 * 8;
    constexpr int NITEMS = 3 * N_MOE + I_INA + I_SQ + I_SQ + 2 * I_KV + I_OUTB + 4 * I_MEM;
    for (int it = C.gw; it < NITEMS; it += C.NGW) {
        int r = it;
        if (r < N_MOE) { const int m = r / I_MOE;
            if (m < 16) tr_item(A.in[20] + (size_t)m * 1048576, 1024, 1024, (bf16_t*)(ws + WS_WGU) + (size_t)m * 2097152, 128, 256, 0, scr, r % I_MOE, C.lane);
            else tr_item8(A.in[20] + (size_t)m * 1048576, 1024, 1024, ws + WS_WGU8 + (size_t)(m - 16) * 2097152, 128, 256, 0, W8_SCALE, scr, r % I_MOE, C.lane);
            continue; } r -= N_MOE;
        if (r < N_MOE) { const int m = r / I_MOE;
            if (m < 16) tr_item(A.in[21] + (size_t)m * 1048576, 1024, 1024, (bf16_t*)(ws + WS_WGU) + (size_t)m * 2097152, 128, 256, 128, scr, r % I_MOE, C.lane);
            else tr_item8(A.in[21] + (size_t)m * 1048576, 1024, 1024, ws + WS_WGU8 + (size_t)(m - 16) * 2097152, 128, 256, 128, W8_SCALE, scr, r % I_MOE, C.lane);
            continue; } r -= N_MOE;
        if (r < N_MOE) { const int m = r / I_MOE;
            if (m < 16) tr_item(A.in[22] + (size_t)m * 1048576, 1024, 1024, (bf16_t*)(ws + WS_WD) + (size_t)m * 1048576, 1024, 1024, 0, scr, r % I_MOE, C.lane);
            else tr_item8(A.in[22] + (size_t)m * 1048576, 1024, 1024, ws + WS_WD8 + (size_t)(m - 16) * 1048576, 1024, 1024, 0, W8_SCALE, scr, r % I_MOE, C.lane);
            continue; } r -= N_MOE;
        if (r < I_INA) { tr_item(A.in[2], 1024, 1792, (bf16_t*)(ws + WS_BT_INA), 1792, 1792, 0, scr, r, C.lane); continue; } r -= I_INA;
        if (r < I_SQ) { tr_item(A.in[3], 1024, 1024, (bf16_t*)(ws + WS_BT_OUTA), 1024, 1024, 0, scr, r, C.lane); continue; } r -= I_SQ;
        if (r < I_SQ) { tr_item(A.in[8], 1024, 1024, (bf16_t*)(ws + WS_BT_B), 1024, 1024, 1536, scr, r, C.lane); continue; } r -= I_SQ;
        if (r < I_KV) { tr_item(A.in[10], 1024, 768, (bf16_t*)(ws + WS_BT_B), 768, 768, 0, scr, r, C.lane); continue; } r -= I_KV;
        if (r < I_KV) { tr_item(A.in[11], 1024, 768, (bf16_t*)(ws + WS_BT_B), 768, 768, 768, scr, r, C.lane); continue; } r -= I_KV;
        if (r < I_OUTB) { tr_item(A.in[9], 512, 1024, (bf16_t*)(ws + WS_BT_OUTB), 1024, 1024, 0, scr, r, C.lane); continue; } r -= I_OUTB;
        { const int m = r / I_MEM, layer = m & 1, isv = m >> 1;
          tr_item(A.in[isv ? 13 : 12] + (size_t)layer * 262144, 1024, 256, (bf16_t*)(ws + WS_BT_MEM), 256, 256, layer * 512 + isv * 256, scr, r % I_MEM, C.lane); }
    }
    const int gt = C.bid * NTHREADS + C.tid, NT = C.G * NTHREADS;
    for (int i = gt; i < NSG * 128 * 128 / 8; i += NT) { const int q0 = (i & 15) * 8, p = (i >> 4) & 127;
        const f32x4 a = *(const f32x4*)(A.in[6] + (size_t)i * 8), b = *(const f32x4*)(A.in[6] + (size_t)i * 8 + 4); float v[8] = {a[0], a[1], a[2], a[3], b[0], b[1], b[2], b[3]};
#pragma unroll
        for (int j = 0; j < 8; ++j) v[j] = (q0 + j <= p) ? v[j] : 0.f;
        u32x4 w; w.x = pk2(v[0], v[1]); w.y = pk2(v[2], v[3]); w.z = pk2(v[4], v[5]); w.w = pk2(v[6], v[7]); *(u32x4*)((bf16_t*)(ws + WS_SGWB) + (size_t)i * 8) = w; }
    for (int i = gt; i < T * D / 8; i += NT) { const f32x4 a = *(const f32x4*)(A.in[0] + (size_t)i * 8), b = *(const f32x4*)(A.in[0] + (size_t)i * 8 + 4);
        u32x4 w; w.x = pk2(a[0], a[1]); w.y = pk2(a[2], a[3]); w.z = pk2(b[0], b[1]); w.w = pk2(b[2], b[3]); *(u32x4*)((bf16_t*)(ws + WS_XB) + (size_t)i * 8) = w; }
    for (int i = gt; i < NB * NMEM * D / 8; i += NT) { const f32x4 a = *(const f32x4*)(A.in[1] + (size_t)i * 8), b = *(const f32x4*)(A.in[1] + (size_t)i * 8 + 4);
        u32x4 w; w.x = pk2(a[0], a[1]); w.y = pk2(a[2], a[3]); w.z = pk2(b[0], b[1]); w.w = pk2(b[2], b[3]); *(u32x4*)((bf16_t*)(ws + WS_MEMB) + (size_t)i * 8) = w; }
}

__device__ __forceinline__ void sg_scalar(const Ctx& C, const Args& A) {
    const bf16_t* U = (const bf16_t*)(C.ws + WS_U); const bf16_t* GV = (const bf16_t*)(C.ws + WS_GV); bf16_t* CAT = (bf16_t*)(C.ws + WS_CAT);
    const float* lng = A.in[4]; const float* lnb = A.in[5]; const float* sgw = A.in[6]; const float* sgb = A.in[7];
    LAS float* stat = (LAS float*)C.lds;
    LAS float* gvn = (LAS float*)(C.lds + 1024);
    LAS float* Wl = (LAS float*)(C.lds + 1024 + 128 * 65 * 4);
    for (int unit = C.bid; unit < NB * 16; unit += C.G) {
        const int tb = unit * 128;
        for (int rr = 0; rr < 16; ++rr) { const int row = C.wave * 16 + rr; const bf16_t* p = GV + (size_t)(tb + row) * SGW + 4 * C.lane;
            float s = 0.f, ss = 0.f;
#pragma unroll
            for (int j = 0; j < 3; ++j) { const u32x2 w = *(const u32x2*)(p + 256 * j); const float a = bflo(w.x), b = bfhi(w.x), c = bflo(w.y), d = bfhi(w.y);
                s += (a + b) + (c + d); ss += (a * a + b * b) + (c * c + d * d); }
            s = wave_sum(s); ss = wave_sum(ss);
            const float mean = s * (1.f / SGW), var = ss * (1.f / SGW) - mean * mean;
            if (C.lane == 0) { stat[row * 2] = mean; stat[row * 2 + 1] = 1.0f / sqrtf(var + LN_EPS); } }
        __syncthreads();
        const int p = C.tid >> 2, d0 = (C.tid & 3) * 16;
        for (int g = 0; g < NSG; ++g) {
            { const bf16_t* src = GV + (size_t)(tb + p) * SGW + g * 64 + d0; const float mean = stat[p * 2], rstd = stat[p * 2 + 1];
#pragma unroll
              for (int h = 0; h < 2; ++h) { const u32x4 w = *(const u32x4*)(src + 8 * h); const unsigned ww[4] = {w.x, w.y, w.z, w.w};
#pragma unroll
                  for (int j = 0; j < 4; ++j) { const int d = d0 + 8 * h + 2 * j; const int cc = g * 64 + d;
                      gvn[p * 65 + d] = (bflo(ww[j]) - mean) * rstd * lng[cc] + lnb[cc];
                      gvn[p * 65 + d + 1] = (bfhi(ww[j]) - mean) * rstd * lng[cc + 1] + lnb[cc + 1]; } } }
            { const int q0 = (C.tid & 3) * 32; const float* src = sgw + ((size_t)g * 128 + p) * 128 + q0;
#pragma unroll
              for (int j = 0; j < 8; ++j) { const f32x4 w = *(const f32x4*)(src + 4 * j);
#pragma unroll
                  for (int t = 0; t < 4; ++t) { const int q = q0 + 4 * j + t; Wl[p * 129 + q] = (q <= p) ? w[t] : 0.f; } } }
            __syncthreads();
            float acc[16];
#pragma unroll
            for (int j = 0; j < 16; ++j) acc[j] = 0.f;
            for (int q = 0; q <= p; ++q) { const float w = Wl[p * 129 + q];
#pragma unroll
                for (int j = 0; j < 16; ++j) acc[j] += w * gvn[q * 65 + d0 + j]; }
            const float bs = sgb[g * 128 + p];
            const bf16_t* us = U + (size_t)(tb + p) * SGW + g * 64 + d0; bf16_t* dst = CAT + (size_t)(tb + p) * D + g * 64 + d0;
#pragma unroll
            for (int h = 0; h < 2; ++h) { const u32x4 w = *(const u32x4*)(us + 8 * h); const unsigned ww[4] = {w.x, w.y, w.z, w.w}; unsigned o[4];
#pragma unroll
                for (int j = 0; j < 4; ++j) o[j] = pk2(bflo(ww[j]) * (acc[8 * h + 2 * j] + bs), bfhi(ww[j]) * (acc[8 * h + 2 * j + 1] + bs));
                *(u32x4*)(dst + 8 * h) = (u32x4){o[0], o[1], o[2], o[3]}; }
            __syncthreads();
        }
    }
}

__device__ __forceinline__ void memattn_scalar(const Ctx& C, const bf16_t* QM, const bf16_t* MKV, int ck, int cv, bf16_t* OUT, int ldo, int coff) {
    for (int it = C.gw; it < T * 4; it += C.NGW) {
        const int tok = it >> 2, h = it & 3, b = tok / SEQ;
        float q[64];
        { const bf16_t* qp = QM + (size_t)tok * 256 + h * 64;
#pragma unroll
          for (int j = 0; j < 8; ++j) { const u32x4 w = *(const u32x4*)(qp + 8 * j);
              q[8 * j] = bflo(w.x); q[8 * j + 1] = bfhi(w.x); q[8 * j + 2] = bflo(w.y); q[8 * j + 3] = bfhi(w.y); q[8 * j + 4] = bflo(w.z); q[8 * j + 5] = bfhi(w.z); q[8 * j + 6] = bflo(w.w); q[8 * j + 7] = bfhi(w.w); } }
        float s[4];
#pragma unroll
        for (int jj = 0; jj < 4; ++jj) { const bf16_t* kp = MKV + (size_t)(b * NMEM + jj * 64 + C.lane) * 1024 + ck + h * 64; float a = 0.f;
#pragma unroll
            for (int j = 0; j < 8; ++j) { const u32x4 w = *(const u32x4*)(kp + 8 * j);
                a += q[8 * j] * bflo(w.x) + q[8 * j + 1] * bfhi(w.x) + q[8 * j + 2] * bflo(w.y) + q[8 * j + 3] * bfhi(w.y) + q[8 * j + 4] * bflo(w.z) + q[8 * j + 5] * bfhi(w.z) + q[8 * j + 6] * bflo(w.w) + q[8 * j + 7] * bfhi(w.w); }
            s[jj] = a; }
        const float mx = wave_max(fmaxf(fmaxf(s[0], s[1]), fmaxf(s[2], s[3])));
        float l = 0.f;
#pragma unroll
        for (int jj = 0; jj < 4; ++jj) { s[jj] = __expf(s[jj] - mx); l += s[jj]; }
        l = wave_sum(l);
        float acc = 0.f;
#pragma unroll
        for (int jj = 0; jj < 4; ++jj) { const bf16_t* vp = MKV + (size_t)(b * NMEM + jj * 64) * 1024 + cv + h * 64 + C.lane;
            for (int mm = 0; mm < 64; ++mm) acc += __shfl(s[jj], mm) * bf1(vp[(size_t)mm * 1024]); }
        OUT[(size_t)tok * ldo + coff + h * 64 + C.lane] = (bf16_t)f2bf(acc / l);
    }
}

__device__ __forceinline__ void dilattn_scalar(const Ctx& C, const Args& A) {
    const bf16_t* Q = (const bf16_t*)(C.ws + WS_Q); const bf16_t* K = (const bf16_t*)(C.ws + WS_K); const bf16_t* V = (const bf16_t*)(C.ws + WS_V);
    bf16_t* OG = (bf16_t*)(C.ws + WS_OG); float* LSE = (float*)(C.ws + WS_LSE);
    for (int it = C.gw; it < T * 12; it += C.NGW) {
        const int tok = it / 12, h = it % 12, g = h >> 2, dl = (g == 0) ? 1 : (g == 1 ? 4 : 16);
        const int t = tok % SEQ, i = t / dl;
        const float slope = exp2f(-(float)(h + 1) * (8.0f / 12.0f));
        float q[64];
        { const bf16_t* qp = Q + (size_t)tok * SGW + h * 64;
#pragma unroll
          for (int j = 0; j < 8; ++j) { const u32x4 w = *(const u32x4*)(qp + 8 * j);
              q[8 * j] = bflo(w.x); q[8 * j + 1] = bfhi(w.x); q[8 * j + 2] = bflo(w.y); q[8 * j + 3] = bfhi(w.y); q[8 * j + 4] = bflo(w.z); q[8 * j + 5] = bfhi(w.z); q[8 * j + 6] = bflo(w.w); q[8 * j + 7] = bfhi(w.w); } }
        float s[3];
#pragma unroll
        for (int jj = 0; jj < 3; ++jj) { const int j0 = jj * 64 + C.lane; const bool valid = (jj < 2 || C.lane == 0) && (j0 <= i);
            const int jc = valid ? j0 : 0;
            const bf16_t* kp = K + (size_t)(tok - jc * dl) * SGW + h * 64; float a = 0.f;
#pragma unroll
            for (int j = 0; j < 8; ++j) { const u32x4 w = *(const u32x4*)(kp + 8 * j);
                a += q[8 * j] * bflo(w.x) + q[8 * j + 1] * bfhi(w.x) + q[8 * j + 2] * bflo(w.y) + q[8 * j + 3] * bfhi(w.y) + q[8 * j + 4] * bflo(w.z) + q[8 * j + 5] * bfhi(w.z) + q[8 * j + 6] * bflo(w.w) + q[8 * j + 7] * bfhi(w.w); }
            s[jj] = valid ? (a - slope * (float)(dl * j0)) : -INFINITY; }
        const float mx = wave_max(fmaxf(fmaxf(s[0], s[1]), s[2]));
        float l = 0.f;
#pragma unroll
        for (int jj = 0; jj < 3; ++jj) { s[jj] = __expf(s[jj] - mx); l += s[jj]; }
        l = wave_sum(l);
        float acc = 0.f;
#pragma unroll
        for (int jj = 0; jj < 3; ++jj) { const int nm = (jj < 2) ? 64 : 1;
            for (int mm = 0; mm < nm; ++mm) { const int j0 = jj * 64 + mm; const int jc = (j0 <= i) ? j0 : 0;
                acc += __shfl(s[jj], mm) * bf1(V[(size_t)(tok - jc * dl) * SGW + h * 64 + C.lane]); } }
        OG[(size_t)tok * SGW + h * 64 + C.lane] = (bf16_t)f2bf(acc / l);
        if (C.lane == 0) LSE[tok * 12 + h] = mx + __logf(l);
    }
}
typedef short bf16x8 __attribute__((ext_vector_type(8)));
typedef short s16x4 __attribute__((ext_vector_type(4)));
constexpr int AT_KS = 144, AT_VS = 160, AT_ROWS = 272, AT_K_OFF = 0, AT_V_OFF = AT_ROWS * AT_KS;
static_assert(AT_V_OFF % 16 == 0 && AT_V_OFF + AT_ROWS * AT_VS <= 131072, "attention LDS map");

template <int NKB, bool DIL>
__device__ __forceinline__ void attn_compute(LAS unsigned char* lds, int lane, int krow0, bf16x8 qf0, bf16x8 qf1, float sdl, int ikw, f32x4 (&o)[4], float& mx, float& lsum) {
    const int n = lane & 15, g = lane >> 4;
    const LAS unsigned char* Kb = lds + AT_K_OFF + (krow0 + n) * AT_KS + g * 16;
    f32x4 sc[NKB];
#pragma unroll
    for (int kb = 0; kb < NKB; ++kb) {
        const bf16x8 k0 = *(const LAS bf16x8*)(Kb + kb * 16 * AT_KS), k1 = *(const LAS bf16x8*)(Kb + kb * 16 * AT_KS + 64);
        f32x4 a = (f32x4){0.f, 0.f, 0.f, 0.f};
        a = __builtin_amdgcn_mfma_f32_16x16x32_bf16(k0, qf0, a, 0, 0, 0);
        a = __builtin_amdgcn_mfma_f32_16x16x32_bf16(k1, qf1, a, 0, 0, 0);
        sc[kb] = a;
    }
    float m = -INFINITY;
#pragma unroll
    for (int kb = 0; kb < NKB; ++kb)
#pragma unroll
        for (int r = 0; r < 4; ++r) {
            if (DIL) { const int off = 16 * kb + 4 * g + r, rel = 144 + n - off; const bool valid = (rel >= 0) && (rel <= 128) && (ikw + off >= 0);
                sc[kb][r] = valid ? (sc[kb][r] - sdl * (float)rel) : -INFINITY; }
            m = fmaxf(m, sc[kb][r]); }
    m = fmaxf(m, __shfl_xor(m, 16)); m = fmaxf(m, __shfl_xor(m, 32));
    float l = 0.f;
#pragma unroll
    for (int kb = 0; kb < NKB; ++kb)
#pragma unroll
        for (int r = 0; r < 4; ++r) { sc[kb][r] = __expf(sc[kb][r] - m); l += sc[kb][r]; }
    l += __shfl_xor(l, 16); l += __shfl_xor(l, 32);
    mx = m; lsum = l;
    const LAS unsigned char* Vb = lds + AT_V_OFF + (krow0 + 4 * g + (n >> 2)) * AT_VS + (n & 3) * 8;
#pragma unroll
    for (int db = 0; db < 4; ++db) o[db] = (f32x4){0.f, 0.f, 0.f, 0.f};
#pragma unroll
    for (int kk = 0; kk < NKB / 2; ++kk) {
        union { bf16x8 v; unsigned u[4]; } pf;
        pf.u[0] = cvt_pk_bf16(sc[2 * kk][0], sc[2 * kk][1]); pf.u[1] = cvt_pk_bf16(sc[2 * kk][2], sc[2 * kk][3]);
        pf.u[2] = cvt_pk_bf16(sc[2 * kk + 1][0], sc[2 * kk + 1][1]); pf.u[3] = cvt_pk_bf16(sc[2 * kk + 1][2], sc[2 * kk + 1][3]);
#pragma unroll
        for (int db = 0; db < 4; ++db) {
            const s16x4 v0 = __builtin_amdgcn_ds_read_tr16_b64_v4i16((LAS s16x4*)(Vb + (2 * kk) * 16 * AT_VS + db * 32));
            const s16x4 v1 = __builtin_amdgcn_ds_read_tr16_b64_v4i16((LAS s16x4*)(Vb + (2 * kk + 1) * 16 * AT_VS + db * 32));
            const bf16x8 vf = __builtin_shufflevector(v0, v1, 0, 1, 2, 3, 4, 5, 6, 7);
            o[db] = __builtin_amdgcn_mfma_f32_16x16x32_bf16(vf, pf.v, o[db], 0, 0, 0);
        }
    }
}

__device__ __forceinline__ void memattn_mfma(const Ctx& C, const bf16_t* QM, const bf16_t* MKV, int ck, int cv, bf16_t* OUT, int ldo, int coff) {
    const int n = C.lane & 15, g = C.lane >> 4;
    for (int unit = C.bid; unit < NB * 4 * 16; unit += C.G) {
        const int b = unit >> 6, h = (unit >> 4) & 3, qt = unit & 15;
        __syncthreads();
#pragma unroll
        for (int it = 0; it < 4; ++it) { const int row = it * 64 + (C.tid >> 3), c = C.tid & 7;
            const bf16_t* src = MKV + (size_t)(b * NMEM + row) * 1024 + h * 64 + c * 8;
            const u32x4 kv = *(const u32x4*)(src + ck), vv = *(const u32x4*)(src + cv);
            *(LAS u32x4*)(C.lds + AT_K_OFF + row * AT_KS + c * 16) = kv; *(LAS u32x4*)(C.lds + AT_V_OFF + row * AT_VS + c * 16) = vv; }
        const int tok = b * SEQ + qt * 128 + C.wave * 16 + n;
        const bf16_t* qp = QM + (size_t)tok * 256 + h * 64 + g * 8;
        const bf16x8 qf0 = *(const bf16x8*)qp, qf1 = *(const bf16x8*)(qp + 32);
        __syncthreads();
        f32x4 o[4]; float mx, l;
        attn_compute<16, false>(C.lds, C.lane, 0, qf0, qf1, 0.f, 0, o, mx, l);
        const float inv = 1.0f / l;
#pragma unroll
        for (int db = 0; db < 4; ++db)
            *(u32x2*)(OUT + (size_t)tok * ldo + coff + h * 64 + 16 * db + 4 * g) = (u32x2){cvt_pk_bf16(o[db][0] * inv, o[db][1] * inv), cvt_pk_bf16(o[db][2] * inv, o[db][3] * inv)};
    }
}
__device__ __forceinline__ void dilattn_mfma(const Ctx& C) {
    const bf16_t* Q = (const bf16_t*)(C.ws + WS_Q); const bf16_t* K = (const bf16_t*)(C.ws + WS_K); const bf16_t* V = (const bf16_t*)(C.ws + WS_V);
    bf16_t* OG = (bf16_t*)(C.ws + WS_OG); float* LSE = (float*)(C.ws + WS_LSE);
    const int n = C.lane & 15, g = C.lane >> 4;
    for (int unit = C.bid; unit < 12 * 128; unit += C.G) {
        const int h = unit >> 7, rem = unit & 127, b = rem >> 4, x = rem & 15, grp = h >> 2;
        const int dl = (grp == 0) ? 1 : (grp == 1 ? 4 : 16), ntile = 16 / dl, r = x / ntile, I0 = (x % ntile) * 128;
        const float sdl = exp2f(-(float)(h + 1) * (8.0f / 12.0f)) * (float)dl;
        __syncthreads();
        for (int idx = C.tid; idx < AT_ROWS * 8; idx += NTHREADS) { const int row = idx >> 3, c = idx & 7; const int ik = I0 - 144 + row;
            u32x4 kv = (u32x4){0u, 0u, 0u, 0u}, vv = (u32x4){0u, 0u, 0u, 0u};
            if (ik >= 0) { const size_t off = (size_t)(b * SEQ + ik * dl + r) * SGW + h * 64 + c * 8; kv = *(const u32x4*)(K + off); vv = *(const u32x4*)(V + off); }
            *(LAS u32x4*)(C.lds + AT_K_OFF + row * AT_KS + c * 16) = kv; *(LAS u32x4*)(C.lds + AT_V_OFF + row * AT_VS + c * 16) = vv; }
        const int iq = I0 + C.wave * 16 + n, tok = b * SEQ + iq * dl + r;
        const bf16_t* qp = Q + (size_t)tok * SGW + h * 64 + g * 8;
        const bf16x8 qf0 = *(const bf16x8*)qp, qf1 = *(const bf16x8*)(qp + 32);
        __syncthreads();
        f32x4 o[4]; float mx, l;
        attn_compute<10, true>(C.lds, C.lane, C.wave * 16, qf0, qf1, sdl, I0 + C.wave * 16 - 144, o, mx, l);
        const float inv = 1.0f / l;
#pragma unroll
        for (int db = 0; db < 4; ++db)
            *(u32x2*)(OG + (size_t)tok * SGW + h * 64 + 16 * db + 4 * g) = (u32x2){cvt_pk_bf16(o[db][0] * inv, o[db][1] * inv), cvt_pk_bf16(o[db][2] * inv, o[db][3] * inv)};
        if (g == 0) LSE[tok * 12 + h] = mx + __logf(l);
    }
}
constexpr int SG_GVN_OFF = 1024, SG_VS = 160;
__device__ __forceinline__ void sg_mfma(const Ctx& C, const Args& A) {
    const bf16_t* U = (const bf16_t*)(C.ws + WS_U); const bf16_t* GV = (const bf16_t*)(C.ws + WS_GV); bf16_t* CAT = (bf16_t*)(C.ws + WS_CAT);
    const bf16_t* WB = (const bf16_t*)(C.ws + WS_SGWB);
    const float* lng = A.in[4]; const float* lnb = A.in[5]; const float* sgb = A.in[7];
    LAS float* stat = (LAS float*)C.lds;
    const int n = C.lane & 15, gl = C.lane >> 4;
    for (int unit = C.bid; unit < NB * 16 * 4; unit += C.G) {
        const int tb = (unit >> 2) * 128, gq = unit & 3;
        __syncthreads();
        for (int rr = 0; rr < 16; ++rr) { const int row = C.wave * 16 + rr; const bf16_t* p = GV + (size_t)(tb + row) * SGW + 4 * C.lane;
            float s = 0.f, ss = 0.f;
#pragma unroll
            for (int j = 0; j < 3; ++j) { const u32x2 w = *(const u32x2*)(p + 256 * j); const float a = bflo(w.x), b = bfhi(w.x), c = bflo(w.y), d = bfhi(w.y);
                s += (a + b) + (c + d); ss += (a * a + b * b) + (c * c + d * d); }
            s = wave_sum(s); ss = wave_sum(ss);
            const float mean = s * (1.f / SGW), var = ss * (1.f / SGW) - mean * mean;
            if (C.lane == 0) { stat[row * 2] = mean; stat[row * 2 + 1] = 1.0f / sqrtf(var + LN_EPS); } }
        __syncthreads();
        for (int gi = 0; gi < 3; ++gi) {
            const int g = gq * 3 + gi;
#pragma unroll
            for (int it = 0; it < 2; ++it) { const int idx = it * NTHREADS + C.tid, row = idx >> 3, c = idx & 7, cc = g * 64 + c * 8;
                const u32x4 w = *(const u32x4*)(GV + (size_t)(tb + row) * SGW + cc); const float mean = stat[row * 2], rstd = stat[row * 2 + 1];
                const f32x4 ga = *(const f32x4*)(lng + cc), gb = *(const f32x4*)(lng + cc + 4), ba = *(const f32x4*)(lnb + cc), bb = *(const f32x4*)(lnb + cc + 4);
                u32x4 o;
                o.x = pk2((bflo(w.x) - mean) * rstd * ga[0] + ba[0], (bfhi(w.x) - mean) * rstd * ga[1] + ba[1]);
                o.y = pk2((bflo(w.y) - mean) * rstd * ga[2] + ba[2], (bfhi(w.y) - mean) * rstd * ga[3] + ba[3]);
                o.z = pk2((bflo(w.z) - mean) * rstd * gb[0] + bb[0], (bfhi(w.z) - mean) * rstd * gb[1] + bb[1]);
                o.w = pk2((bflo(w.w) - mean) * rstd * gb[2] + bb[2], (bfhi(w.w) - mean) * rstd * gb[3] + bb[3]);
                *(LAS u32x4*)(C.lds + SG_GVN_OFF + row * SG_VS + c * 16) = o; }
            __syncthreads();
            const int p = C.wave * 16 + n, nks = (C.wave >> 1) + 1;
            f32x4 acc[4];
#pragma unroll
            for (int db = 0; db < 4; ++db) acc[db] = (f32x4){0.f, 0.f, 0.f, 0.f};
            const bf16_t* wp = WB + (size_t)(g * 128 + p) * 128 + 8 * gl;
            const LAS unsigned char* vb = C.lds + SG_GVN_OFF + (8 * gl + (n >> 2)) * SG_VS + (n & 3) * 8;
            for (int ks = 0; ks < nks; ++ks) {
                const bf16x8 wf = *(const bf16x8*)(wp + 32 * ks);
#pragma unroll
                for (int db = 0; db < 4; ++db) {
                    const s16x4 v0 = __builtin_amdgcn_ds_read_tr16_b64_v4i16((LAS s16x4*)(vb + ks * 32 * SG_VS + db * 32));
                    const s16x4 v1 = __builtin_amdgcn_ds_read_tr16_b64_v4i16((LAS s16x4*)(vb + ks * 32 * SG_VS + 4 * SG_VS + db * 32));
                    const bf16x8 vf = __builtin_shufflevector(v0, v1, 0, 1, 2, 3, 4, 5, 6, 7);
                    acc[db] = __builtin_amdgcn_mfma_f32_16x16x32_bf16(vf, wf, acc[db], 0, 0, 0);
                }
            }
            const float bs = sgb[g * 128 + p];
#pragma unroll
            for (int db = 0; db < 4; ++db) { const size_t co = (size_t)g * 64 + 16 * db + 4 * gl;
                const u32x2 uw = *(const u32x2*)(U + (size_t)(tb + p) * SGW + co);
                *(u32x2*)(CAT + (size_t)(tb + p) * D + co) = (u32x2){cvt_pk_bf16(bflo(uw.x) * (acc[db][0] + bs), bfhi(uw.x) * (acc[db][1] + bs)), cvt_pk_bf16(bflo(uw.y) * (acc[db][2] + bs), bfhi(uw.y) * (acc[db][3] + bs))}; }
            __syncthreads();
        }
    }
}
__device__ __forceinline__ void dil_merge(const Ctx& C, const Args& A) {
    const bf16_t* OG = (const bf16_t*)(C.ws + WS_OG); const float* LSE = (const float*)(C.ws + WS_LSE); bf16_t* CAT2 = (bf16_t*)(C.ws + WS_CAT2);
    const int gt = C.bid * NTHREADS + C.tid, NT = C.G * NTHREADS;
    for (int it = gt; it < T * 32; it += NT) {
        const int tok = it >> 5, j = (it >> 3) & 3, c8 = it & 7;
        const float l0 = LSE[tok * 12 + j], l1 = LSE[tok * 12 + 4 + j], l2 = LSE[tok * 12 + 8 + j];
        const float mx = fmaxf(l0, fmaxf(l1, l2));
        float w0 = __expf(l0 - mx), w1 = __expf(l1 - mx), w2 = __expf(l2 - mx); const float inv = 1.0f / (w0 + w1 + w2); w0 *= inv; w1 *= inv; w2 *= inv;
        const u32x4 a = *(const u32x4*)(OG + (size_t)tok * SGW + j * 64 + c8 * 8), b = *(const u32x4*)(OG + (size_t)tok * SGW + (4 + j) * 64 + c8 * 8), c = *(const u32x4*)(OG + (size_t)tok * SGW + (8 + j) * 64 + c8 * 8);
        u32x4 o;
        o.x = pk2(w0 * bflo(a.x) + w1 * bflo(b.x) + w2 * bflo(c.x), w0 * bfhi(a.x) + w1 * bfhi(b.x) + w2 * bfhi(c.x));
        o.y = pk2(w0 * bflo(a.y) + w1 * bflo(b.y) + w2 * bflo(c.y), w0 * bfhi(a.y) + w1 * bfhi(b.y) + w2 * bfhi(c.y));
        o.z = pk2(w0 * bflo(a.z) + w1 * bflo(b.z) + w2 * bflo(c.z), w0 * bfhi(a.z) + w1 * bfhi(b.z) + w2 * bfhi(c.z));
        o.w = pk2(w0 * bflo(a.w) + w1 * bflo(b.w) + w2 * bflo(c.w), w0 * bfhi(a.w) + w1 * bfhi(b.w) + w2 * bfhi(c.w));
        *(u32x4*)(CAT2 + (size_t)tok * 512 + j * 64 + c8 * 8) = o;
    }
}

__device__ __forceinline__ void ln_route(const Ctx& C, const Args& A, int layer) {
    const float* Y = (const float*)(C.ws + WS_Y); bf16_t* X1B = (bf16_t*)(C.ws + WS_X1B); unsigned char* X1F8 = C.ws + WS_X1F8;
    const float* lg = A.in[14] + layer * D; const float* lb = A.in[15] + layer * D; const float* wr = A.in[18]; const float* br = A.in[19];
    unsigned* cnt = (unsigned*)(C.ws + WS_CTL) + CW_CNT + layer * 16 * 64;
    int* tokE = (int*)(C.ws + WS_TOKE); int* tokP = (int*)(C.ws + WS_TOKP); float* tokG = (float*)(C.ws + WS_TOKG); int* list = (int*)(C.ws + WS_LIST);
    LAS float* wl = (LAS float*)C.lds;
    LAS int* sE = (LAS int*)(C.lds + 65536); LAS float* sG = (LAS float*)(C.lds + 65536 + 512); LAS int* sPos = (LAS int*)(C.lds + 65536 + 1024);
    LAS int* lcnt = (LAS int*)(C.lds + 65536 + 1536); LAS int* lbase = (LAS int*)(C.lds + 65536 + 1600);
    __syncthreads();
    for (int i = C.tid; i < 1024 * 16 / 4; i += NTHREADS) *(LAS f32x4*)(wl + 4 * i) = *(const f32x4*)(wr + 4 * i);
    const LAS float* wlane = wl + C.lane * 64;
    for (int blk = C.bid; blk < T / 64; blk += C.G) {
        __syncthreads();
        if (C.tid < 16) lcnt[C.tid] = 0;
        for (int ti = 0; ti < 8; ++ti) {
            const int tl = C.wave * 8 + ti, tok = blk * 64 + tl;
            f32x4 v[4]; float s = 0.f;
#pragma unroll
            for (int j = 0; j < 4; ++j) { v[j] = *(const f32x4*)(Y + (size_t)tok * D + 4 * C.lane + 256 * j); s += (v[j][0] + v[j][1]) + (v[j][2] + v[j][3]); }
            const float mean = wave_sum(s) * (1.f / D); float s2 = 0.f;
#pragma unroll
            for (int j = 0; j < 4; ++j) { v[j] = v[j] - mean; s2 += (v[j][0] * v[j][0] + v[j][1] * v[j][1]) + (v[j][2] * v[j][2] + v[j][3] * v[j][3]); }
            const float rstd = 1.0f / sqrtf(wave_sum(s2) * (1.f / D) + LN_EPS);
            float lgt[16];
#pragma unroll
            for (int e = 0; e < 16; ++e) lgt[e] = 0.f;
#pragma unroll
            for (int j = 0; j < 4; ++j) { const int col = 4 * C.lane + 256 * j; const f32x4 g4 = *(const f32x4*)(lg + col), b4 = *(const f32x4*)(lb + col);
                v[j] = v[j] * rstd * g4 + b4;
                *(u32x2*)(X1B + (size_t)tok * D + col) = (u32x2){pk2(v[j][0], v[j][1]), pk2(v[j][2], v[j][3])};
                if (layer == 1) *(unsigned*)(X1F8 + (size_t)tok * D + col) = pk4_fp8(v[j][0], v[j][1], v[j][2], v[j][3]);
#pragma unroll
                for (int c = 0; c < 4; ++c) { const float xv = v[j][c];
#pragma unroll
                    for (int e4 = 0; e4 < 4; ++e4) { const f32x4 w = *(const LAS f32x4*)(wlane + (256 * j + c) * 16 + 4 * e4);
                        lgt[4 * e4] += xv * w[0]; lgt[4 * e4 + 1] += xv * w[1]; lgt[4 * e4 + 2] += xv * w[2]; lgt[4 * e4 + 3] += xv * w[3]; } } }
            float mx = -INFINITY;
#pragma unroll
            for (int e = 0; e < 16; ++e) { lgt[e] = wave_sum(lgt[e]); mx = fmaxf(mx, lgt[e]); }
            float sum = 0.f;
#pragma unroll
            for (int e = 0; e < 16; ++e) { lgt[e] = __expf(lgt[e] - mx); sum += lgt[e]; }
            const float inv = 1.0f / sum; float sel[16];
#pragma unroll
            for (int e = 0; e < 16; ++e) { lgt[e] *= inv; sel[e] = lgt[e] + br[e]; }
            float gs[4];
#pragma unroll
            for (int g = 0; g < 4; ++g) { const float a = sel[4 * g], b = sel[4 * g + 1], c = sel[4 * g + 2], d = sel[4 * g + 3];
                gs[g] = fmaxf(fmaxf(fmaxf(a + b, a + c), fmaxf(a + d, b + c)), fmaxf(b + d, c + d)); }
            int gi = 0; float bsc = gs[0];
#pragma unroll
            for (int g = 1; g < 4; ++g) if (gs[g] > bsc) { bsc = gs[g]; gi = g; }
            float sg[4], pg[4];
#pragma unroll
            for (int k = 0; k < 4; ++k) { sg[k] = gi == 0 ? sel[k] : (gi == 1 ? sel[4 + k] : (gi == 2 ? sel[8 + k] : sel[12 + k])); pg[k] = gi == 0 ? lgt[k] : (gi == 1 ? lgt[4 + k] : (gi == 2 ? lgt[8 + k] : lgt[12 + k])); }
            int i1 = 0; float b1 = sg[0], p1 = pg[0];
#pragma unroll
            for (int k = 1; k < 4; ++k) if (sg[k] > b1) { b1 = sg[k]; i1 = k; p1 = pg[k]; }
            int i2 = -1; float b2 = -INFINITY, p2 = 0.f;
#pragma unroll
            for (int k = 0; k < 4; ++k) if (k != i1 && sg[k] > b2) { b2 = sg[k]; i2 = k; p2 = pg[k]; }
            if (C.lane == 0) { const float gsum = p1 + p2; sE[tl * 2] = gi * 4 + i1; sE[tl * 2 + 1] = gi * 4 + i2; sG[tl * 2] = p1 / gsum; sG[tl * 2 + 1] = p2 / gsum; }
        }
        __syncthreads();
        if (C.tid < 128) sPos[C.tid] = __hip_atomic_fetch_add(lcnt + sE[C.tid], 1, __ATOMIC_RELAXED, __HIP_MEMORY_SCOPE_WORKGROUP);
        __syncthreads();
        if (C.tid < 16) lbase[C.tid] = (int)__hip_atomic_fetch_add(cnt + C.tid * 64, (unsigned)lcnt[C.tid], __ATOMIC_RELAXED, __HIP_MEMORY_SCOPE_AGENT);
        __syncthreads();
        if (C.tid < 128) { const int e = sE[C.tid], pos = lbase[e] + sPos[C.tid], tok = blk * 64 + (C.tid >> 1);
            list[e * LISTCAP + pos] = tok; tokE[tok * 2 + (C.tid & 1)] = e; tokP[tok * 2 + (C.tid & 1)] = pos; tokG[tok * 2 + (C.tid & 1)] = sG[C.tid]; }
    }
}
__device__ __forceinline__ void moe_prefix(const Ctx& C, int layer) {
    LAS int* mi = (LAS int*)(C.lds + LDS_MISC);
    unsigned* cnt = (unsigned*)(C.ws + WS_CTL) + CW_CNT + layer * 16 * 64;
    __syncthreads();
    if (C.tid < 16) mi[17 + C.tid] = (int)__hip_atomic_load(cnt + C.tid * 64, __ATOMIC_RELAXED, __HIP_MEMORY_SCOPE_AGENT);
    __syncthreads();
    if (C.tid == 0) { int a = 0; for (int e = 0; e < 16; ++e) { mi[e] = a; a += (mi[17 + e] + 255) >> 8; } mi[16] = a; }
    __syncthreads();
}
__device__ __forceinline__ void moe_tokens(const Ctx& C, int ntn) {
    const LAS int* mi = (const LAS int*)(C.lds + LDS_MISC); LAS int* toks = (LAS int*)(C.lds + LDS_TOKS);
    const int* list = (const int*)(C.ws + WS_LIST);
    for (int u = 0; u < MAX_UNITS; ++u) {
        const int L = u * C.G + C.bid; if (L >= mi[16] * ntn) break;
        int e = 0;
#pragma unroll
        for (int j = 1; j < 16; ++j) e += (L >= mi[j] * ntn) ? 1 : 0;
        const int r = L - mi[e] * ntn, te = mi[e + 1] - mi[e], mt = r % te, cn = mi[17 + e];
        if (C.tid < 256) { int pos = mt * 256 + C.tid; pos = pos < cn ? pos : cn - 1; toks[u * 256 + C.tid] = list[e * LISTCAP + pos]; }
    }
    __syncthreads();
}
__device__ __forceinline__ void combine_ln2(const Ctx& C, const Args& A, int layer) {
    const LAS int* mi = (const LAS int*)(C.lds + LDS_MISC);
    const bf16_t* X1B = (const bf16_t*)(C.ws + WS_X1B); const bf16_t* YD = (const bf16_t*)(C.ws + WS_YD); bf16_t* X2B = (bf16_t*)(C.ws + WS_XB);
    const int* tokE = (const int*)(C.ws + WS_TOKE); const int* tokP = (const int*)(C.ws + WS_TOKP); const float* tokG = (const float*)(C.ws + WS_TOKG);
    const float* lg = A.in[16] + layer * D; const float* lb = A.in[17] + layer * D;
    for (int tok = C.gw; tok < T; tok += C.NGW) {
        const int e0 = tokE[tok * 2], e1 = tokE[tok * 2 + 1]; const float g0 = tokG[tok * 2], g1 = tokG[tok * 2 + 1];
        int tb0 = 0, tb1 = 0;
#pragma unroll
        for (int j = 0; j < 16; ++j) { const int t = mi[j]; tb0 = (e0 == j) ? t : tb0; tb1 = (e1 == j) ? t : tb1; }
        const size_t r0 = (size_t)tb0 * 256 + tokP[tok * 2], r1 = (size_t)tb1 * 256 + tokP[tok * 2 + 1];
        f32x4 v[4]; float s = 0.f;
#pragma unroll
        for (int j = 0; j < 4; ++j) { const int col = 4 * C.lane + 256 * j;
            const u32x2 a = *(const u32x2*)(X1B + (size_t)tok * D + col), y0 = *(const u32x2*)(YD + r0 * D + col), y1 = *(const u32x2*)(YD + r1 * D + col);
            v[j][0] = ALPHA * bflo(a.x) + (g0 * bflo(y0.x) + g1 * bflo(y1.x)); v[j][1] = ALPHA * bfhi(a.x) + (g0 * bfhi(y0.x) + g1 * bfhi(y1.x));
            v[j][2] = ALPHA * bflo(a.y) + (g0 * bflo(y0.y) + g1 * bflo(y1.y)); v[j][3] = ALPHA * bfhi(a.y) + (g0 * bfhi(y0.y) + g1 * bfhi(y1.y));
            s += (v[j][0] + v[j][1]) + (v[j][2] + v[j][3]); }
        const float mean = wave_sum(s) * (1.f / D); float s2 = 0.f;
#pragma unroll
        for (int j = 0; j < 4; ++j) { v[j] = v[j] - mean; s2 += (v[j][0] * v[j][0] + v[j][1] * v[j][1]) + (v[j][2] * v[j][2] + v[j][3] * v[j][3]); }
        const float rstd = 1.0f / sqrtf(wave_sum(s2) * (1.f / D) + LN_EPS);
#pragma unroll
        for (int j = 0; j < 4; ++j) { const int col = 4 * C.lane + 256 * j; const f32x4 g4 = *(const f32x4*)(lg + col), b4 = *(const f32x4*)(lb + col);
            const f32x4 o = v[j] * rstd * g4 + b4;
            if (layer == 0) *(u32x2*)(X2B + (size_t)tok * D + col) = (u32x2){pk2(o[0], o[1]), pk2(o[2], o[3])};
            else *(f32x4*)(A.out + (size_t)tok * D + col) = o; }
    }
}

__global__ void __launch_bounds__(NTHREADS, 2) yoco_fwd(Args args) {
    extern __shared__ __attribute__((aligned(16))) unsigned char lds_raw[];
    Ctx C;
    C.ws = args.ws; C.lds = (LAS unsigned char*)lds_raw;
    C.tid = threadIdx.x; C.lane = C.tid & 63; C.wave = __builtin_amdgcn_readfirstlane(C.tid >> 6);
    C.G = gridDim.x; C.bid = blockIdx.x; C.gw = C.bid * NWAVES + C.wave; C.NGW = C.G * NWAVES;
    unsigned char* ws = args.ws;
#define PHASE_WS() do { ws = launder(args.ws); C.ws = ws; C.tid = launder_v((int)threadIdx.x); C.lane = C.tid & 63; } while (0)
    volatile LAS unsigned* misc = (volatile LAS unsigned*)(C.lds + LDS_MISC);
    for (int u = C.tid; u < 64; u += NTHREADS) misc[u] = 0u;
    __syncthreads();
    XcdBarrier bar; bar.bar = (unsigned*)(ws + WS_CTL) + CW_BAR; bar.x = 0; bar.st = misc + 60;
    const int lo = args.ph_lo, hi = args.ph_hi;
    if (hi - lo > 1) bar = xcd_barrier_post((unsigned*)(ws + WS_CTL) + CW_BAR, misc + 60);
#define IN(k) (lo <= (k) && (k) < hi)
#define SEAM(k) do { if (IN(k) && IN((k) + 1)) xcd_barrier(bar); } while (0)
#ifndef MK_DUP
#define MK_DUP 0
#endif
#define REP(k) for (int rep_ = 0; rep_ < 1 + ((MK_DUP >> (k)) & 1); ++rep_)

    if (IN(0)) { REP(0) { PHASE_WS(); p0_prologue(C, args); } SEAM(0); }

    if (IN(1)) {
        REP(1) {
        PHASE_WS();
        { pg8::Gemm g{(const bf16_t*)(ws + WS_XB), (const bf16_t*)(ws + WS_BT_INA), T, 1792, D}; pg8::StaticOrder S; S.init(T, 1792, C.G, C.bid);
          EpiProjA E{(bf16_t*)(ws + WS_U), (bf16_t*)(ws + WS_GV), (bf16_t*)(ws + WS_QM0)};
          pg8::gemm_phase<EpiProjA, pg8::StaticOrder>(C.lds, g, S, E, nullptr, C.tid); }
        { pg8::Gemm g{(const bf16_t*)(ws + WS_MEMB), (const bf16_t*)(ws + WS_BT_MEM), NB * NMEM, 1024, D}; SmallOrder S{4, 32, C.bid - (C.G - 32)};
          EpiPlain E{(bf16_t*)(ws + WS_MKV), 1024, 4};
          pg8::gemm_phase<EpiPlain, SmallOrder>(C.lds, g, S, E, nullptr, C.tid); }
        }
        SEAM(1);
    }
    if (IN(2)) {
        REP(2) { PHASE_WS();
        sg_mfma(C, args);
        memattn_mfma(C, (const bf16_t*)(ws + WS_QM0), (const bf16_t*)(ws + WS_MKV), 0, 256, (bf16_t*)(ws + WS_CAT), D, SGW); }
        SEAM(2);
    }
    if (IN(3)) {
        REP(3) { PHASE_WS();
        pg8::Gemm g{(const bf16_t*)(ws + WS_CAT), (const bf16_t*)(ws + WS_BT_OUTA), T, D, D}; pg8::StaticOrder S; S.init(T, D, C.G, C.bid);
        EpiResid<false> E{(const void*)args.in[0], (float*)(ws + WS_Y)};
        pg8::gemm_phase<EpiResid<false>, pg8::StaticOrder>(C.lds, g, S, E, nullptr, C.tid); }
        SEAM(3);
    }
    { constexpr int layer = 0;
        const int pb = 4 + 8 * layer;
        if (IN(pb)) { PHASE_WS(); ln_route(C, args, layer); SEAM(pb); }
        if (IN(pb + 1)) {
            REP(5) { PHASE_WS();
            moe_prefix(C, layer); moe_tokens(C, 8);
            MoeGatherOrder S; S.tb = (const LAS int*)(C.lds + LDS_MISC); S.ntn = 8; S.G = C.G; S.c = C.bid; S.toks = (const LAS int*)(C.lds + LDS_TOKS);
            if (layer == 0) {
                pg8::Gemm g{(const bf16_t*)(ws + WS_X1B), (const bf16_t*)(ws + WS_WGU), 0, 0, D};
                EpiSwiGLU E{(bf16_t*)(ws + WS_ACT)};
                pg8::gemm_phase<EpiSwiGLU, MoeGatherOrder>(C.lds, g, S, E, nullptr, C.tid);
            } else {
                pg8::Gemm g{(const bf16_t*)(ws + WS_X1F8), (const bf16_t*)(ws + WS_WGU8), 0, 0, D / 2, E8_ONE, E8_W};
                EpiSwiGLU8 E{ws + WS_ACT};
                pg8::gemm_phase<EpiSwiGLU8, MoeGatherOrder, false, true>(C.lds, g, S, E, nullptr, C.tid);
            } }
            SEAM(pb + 1);
        }
        if (IN(pb + 2)) {
            REP(6) { PHASE_WS();
            moe_prefix(C, layer);
            MoeOrder S{(const LAS int*)(C.lds + LDS_MISC), 4, C.G, C.bid};
            EpiPlain E{(bf16_t*)(ws + WS_YD), 1024, 4};
            if (layer == 0) {
                pg8::Gemm g{(const bf16_t*)(ws + WS_ACT), (const bf16_t*)(ws + WS_WD), 0, 0, D};
                pg8::gemm_phase<EpiPlain, MoeOrder>(C.lds, g, S, E, nullptr, C.tid);
            } else {
                pg8::Gemm g{(const bf16_t*)(ws + WS_ACT), (const bf16_t*)(ws + WS_WD8), 0, 0, D / 2, E8_ACT, E8_W};
                pg8::gemm_phase<EpiPlain, MoeOrder, false, true>(C.lds, g, S, E, nullptr, C.tid);
            } }
            SEAM(pb + 2);
        }
        if (IN(pb + 3)) { REP(7) { PHASE_WS(); moe_prefix(C, layer); combine_ln2(C, args, layer); } if (layer == 0) SEAM(pb + 3); }
    }
    {
            if (IN(8)) {
                REP(8) { PHASE_WS();
                pg8::Gemm g{(const bf16_t*)(ws + WS_XB), (const bf16_t*)(ws + WS_BT_B), T, 2560, D}; pg8::StaticOrder S; S.init(T, 2560, C.G, C.bid);
                EpiProjB E{(bf16_t*)(ws + WS_K), (bf16_t*)(ws + WS_V), (bf16_t*)(ws + WS_Q), (bf16_t*)(ws + WS_QM1)};
                pg8::gemm_phase<EpiProjB, pg8::StaticOrder>(C.lds, g, S, E, nullptr, C.tid); }
                SEAM(8);
            }
            if (IN(9)) {
                REP(9) { PHASE_WS();
                dilattn_mfma(C);
                memattn_mfma(C, (const bf16_t*)(ws + WS_QM1), (const bf16_t*)(ws + WS_MKV), 512, 768, (bf16_t*)(ws + WS_CAT2), 512, 256); }
                SEAM(9);
            }
            if (IN(10)) { REP(10) { PHASE_WS(); dil_merge(C, args); } SEAM(10); }
            if (IN(11)) {
                REP(11) { PHASE_WS();
                pg8::Gemm g{(const bf16_t*)(ws + WS_CAT2), (const bf16_t*)(ws + WS_BT_OUTB), T, D, 512}; pg8::StaticOrder S; S.init(T, D, C.G, C.bid);
                EpiResid<true> E{(const void*)(ws + WS_XB), (float*)(ws + WS_Y)};
                pg8::gemm_phase<EpiResid<true>, pg8::StaticOrder>(C.lds, g, S, E, nullptr, C.tid); }
                SEAM(11);
            }
    }
    { constexpr int layer = 1;
        const int pb = 4 + 8 * layer;
        if (IN(pb)) { PHASE_WS(); ln_route(C, args, layer); SEAM(pb); }
        if (IN(pb + 1)) {
            REP(5) { PHASE_WS();
            moe_prefix(C, layer); moe_tokens(C, 8);
            MoeGatherOrder S; S.tb = (const LAS int*)(C.lds + LDS_MISC); S.ntn = 8; S.G = C.G; S.c = C.bid; S.toks = (const LAS int*)(C.lds + LDS_TOKS);
            if (layer == 0) {
                pg8::Gemm g{(const bf16_t*)(ws + WS_X1B), (const bf16_t*)(ws + WS_WGU), 0, 0, D};
                EpiSwiGLU E{(bf16_t*)(ws + WS_ACT)};
                pg8::gemm_phase<EpiSwiGLU, MoeGatherOrder>(C.lds, g, S, E, nullptr, C.tid);
            } else {
                pg8::Gemm g{(const bf16_t*)(ws + WS_X1F8), (const bf16_t*)(ws + WS_WGU8), 0, 0, D / 2, E8_ONE, E8_W};
                EpiSwiGLU8 E{ws + WS_ACT};
                pg8::gemm_phase<EpiSwiGLU8, MoeGatherOrder, false, true>(C.lds, g, S, E, nullptr, C.tid);
            } }
            SEAM(pb + 1);
        }
        if (IN(pb + 2)) {
            REP(6) { PHASE_WS();
            moe_prefix(C, layer);
            MoeOrder S{(const LAS int*)(C.lds + LDS_MISC), 4, C.G, C.bid};
            EpiPlain E{(bf16_t*)(ws + WS_YD), 1024, 4};
            if (layer == 0) {
                pg8::Gemm g{(const bf16_t*)(ws + WS_ACT), (const bf16_t*)(ws + WS_WD), 0, 0, D};
                pg8::gemm_phase<EpiPlain, MoeOrder>(C.lds, g, S, E, nullptr, C.tid);
            } else {
                pg8::Gemm g{(const bf16_t*)(ws + WS_ACT), (const bf16_t*)(ws + WS_WD8), 0, 0, D / 2, E8_ACT, E8_W};
                pg8::gemm_phase<EpiPlain, MoeOrder, false, true>(C.lds, g, S, E, nullptr, C.tid);
            } }
            SEAM(pb + 2);
        }
        if (IN(pb + 3)) { REP(7) { PHASE_WS(); moe_prefix(C, layer); combine_ln2(C, args, layer); } if (layer == 0) SEAM(pb + 3); }
    }
#undef IN
#undef SEAM
}
}

extern "C" void kernel_launch(void* const* d_in, const int* in_sizes, int n_in, void* d_out, int out_size, void* d_ws, size_t ws_size, hipStream_t stream) {
    using namespace mk;
    static int grid = 0;
    if (grid == 0) {
        if (n_in != 23 || out_size != T * D || ws_size < WS_END) { fprintf(stderr, "kernel_launch: unexpected shapes (n_in %d, out %d, ws %zu)\n", n_in, out_size, ws_size); grid = -1; return; }
        int dev = 0, cus = 0, per_cu = 0;
        if (hipGetDevice(&dev) != hipSuccess || hipDeviceGetAttribute(&cus, hipDeviceAttributeMultiprocessorCount, dev) != hipSuccess) { grid = -1; return; }
        if (hipFuncSetAttribute((const void*)yoco_fwd, hipFuncAttributeMaxDynamicSharedMemorySize, LDS_BYTES) != hipSuccess) { fprintf(stderr, "kernel_launch: hipFuncSetAttribute failed\n"); grid = -1; return; }
        if (hipOccupancyMaxActiveBlocksPerMultiprocessor(&per_cu, (const void*)yoco_fwd, NTHREADS, LDS_BYTES) != hipSuccess || per_cu < 1)
            fprintf(stderr, "kernel_launch: occupancy query reports %d workgroups per CU\n", per_cu);
        (void)hipGetLastError();
        grid = cus;
    }
    if (grid < 0) return;
    (void)hipMemsetAsync((char*)d_ws + WS_CTL, 0, CTL_ZERO_BYTES, stream);
    Args a{};
    for (int i = 0; i < 23; ++i) a.in[i] = (const float*)d_in[i];
    a.out = (float*)d_out; a.ws = (unsigned char*)d_ws;
    constexpr int NL = MK_N_LAUNCHES;
    for (int li = 0; li < NL; ++li) {
        a.ph_lo = (NL == NPHASE) ? li : (li * NPHASE) / NL; a.ph_hi = (NL == NPHASE) ? li + 1 : ((li + 1) * NPHASE) / NL;
        hipLaunchKernelGGL(yoco_fwd, dim3(grid), dim3(NTHREADS), LDS_BYTES, stream, a);
    }
}
```

```cpp
#include <hip/hip_runtime.h>
#include <cstdio>
#include <cstdint>
namespace pg8 {
#define PG8_LAS __attribute__((address_space(3)))
typedef unsigned short bf16_t;
typedef short bf16x8 __attribute__((ext_vector_type(8)));
typedef float f32x4 __attribute__((ext_vector_type(4)));
typedef unsigned u32x4 __attribute__((ext_vector_type(4)));
constexpr int BM = 256, BK = 64, HALF = 128, HTB = HALF * BK * 2  , STAGE_BYTES = 8 * HTB, NXCD = 8, WGM = 8;

__host__ __device__ __forceinline__ int lds_byte(int r, int c) { const int st = (r >> 4) * 2 + (c >> 5), rr = r & 15, cc = c & 31, ob = rr * 64 + cc * 2; return st * 1024 + (ob ^ (((ob >> 9) & 1) << 5)); }
__host__ __device__ __forceinline__ void stage_rc(int b, int& R, int& C) { const int st = b / 1024, sb = b % 1024, swz = sb ^ (((sb >> 9) & 1) << 5); R = (st >> 1) * 16 + swz / 64; C = (st & 1) * 32 + (swz % 64) / 2; }
__host__ __device__ __forceinline__ int perm32(int rho) { const int n = rho >> 4, i = rho & 15; return 8 * (i >> 2) + 4 * n + (i & 3); }

struct Unit { int pm, pn; };
struct Gemm { const bf16_t* A; const bf16_t* Bt; int M, N, K; int sA, sB; };

struct StaticOrder {
    int nM, nN, nwg, G, c;
    __host__ __device__ void init(int M, int N, int G_, int c_) { nM = M / BM; nN = N / BM; nwg = nM * nN; G = G_; c = c_; }
    __host__ __device__ bool next(int i, Unit& u) const {
        const long L = (long)i * G + c; if (L >= nwg) return false;
        int wgid = (int)L; { const int q = nwg / NXCD, r = nwg % NXCD, xcd = wgid % NXCD, off = wgid / NXCD; wgid = (xcd < r ? xcd * (q + 1) : r * (q + 1) + (xcd - r) * q) + off; }
        const int nig = WGM * nN, gid = wgid / nig, fm = gid * WGM, gsz = (nM - fm) < WGM ? (nM - fm) : WGM;
        u.pm = fm + ((wgid % nig) % gsz); u.pn = (wgid % nig) / gsz; return true;
    }
    __device__ __forceinline__ void a_ready(const Unit&) const {}
    __device__ __forceinline__ void done(const Unit&) const {}
    __device__ __forceinline__ int arow(int, const Unit& u, int r) const { return u.pm * BM + r; }
};
__device__ __forceinline__ unsigned cvt_pk_bf16(float lo, float hi) { unsigned r; asm volatile("v_cvt_pk_bf16_f32 %0, %1, %2" : "=v"(r) : "v"(lo), "v"(hi)); return r; }
typedef float f32x2 __attribute__((ext_vector_type(2)));
__device__ __forceinline__ f32x2 gelu_pk(f32x2 v) {
    const f32x2 av = __builtin_elementwise_abs(v), d = av * 0.2316418882f + 1.0f;
    f32x2 t; t.x = __builtin_amdgcn_rcpf(d.x); t.y = __builtin_amdgcn_rcpf(d.y);
    f32x2 q = t * 0.5307027145f + (-0.7265760135f); q = q * t + 0.7107068705f; q = q * t + (-0.142248368f); q = q * t + 0.127414796f; q = q * t;
    const f32x2 s = (v * v) * (-0.72134752044f);
    f32x2 e; e.x = __builtin_amdgcn_exp2f(s.x); e.y = __builtin_amdgcn_exp2f(s.y);
    const f32x2 m = v * (q * e), r = v - m;
    f32x2 o; o.x = v.x < 0.f ? m.x : r.x; o.y = v.y < 0.f ? m.y : r.y; return o;
}
template <class Epi, class Sched, bool STAMP = false, bool F8 = false>
__device__ __forceinline__ void gemm_phase(PG8_LAS unsigned char* lds, const Gemm g, const Sched& S, const Epi& E, unsigned long long* stamps, const int tid) {
    const int wid = __builtin_amdgcn_readfirstlane(tid >> 6), lane = tid & 63, wr = wid >> 2, wc = wid & 3, fr = lane & 15, fq = lane >> 4;
    const int K = g.K, nt = K / BK;
    int ts_lo = 0, ts_hi = 0, nts = 0; const unsigned long long rt_entry = STAMP ? (unsigned long long)wall_clock64() : 0ull;
#define PG8_STAMP() do { if (STAMP && wid == 0 && nts < 64) { const unsigned long long _c = (unsigned long long)clock64(); \
        ts_lo = (lane == nts) ? (int)(unsigned)_c : ts_lo; ts_hi = (lane == nts) ? (int)(unsigned)(_c >> 32) : ts_hi; ++nts; } } while (0)
    PG8_STAMP();
    unsigned colA[2], voffB[2]; int rowA[2];
#pragma unroll
    for (int i = 0; i < 2; ++i) { int R, C; stage_rc(tid * 16 + i * 8192, R, C); const int Rb = Epi::PERM ? ((R & ~31) + perm32(R & 31)) : R;
        rowA[i] = R; colA[i] = (unsigned)C * 2u; voffB[i] = (unsigned)(Rb * K + C) * 2u; }
#define PG8_AOFF(dst, uidx, un) do { _Pragma("unroll") for (int _h = 0; _h < 2; ++_h) _Pragma("unroll") for (int _i = 0; _i < 2; ++_i) \
        dst[_h][_i] = (unsigned)S.arow((uidx), (un), _h * HALF + rowA[_i]) * (unsigned)(K * 2) + colA[_i]; } while (0)
    const size_t kstep = (size_t)(BK * 2);
    const size_t hstep = (size_t)HALF * K * 2;
    const size_t tstep = 2 * hstep;
    const unsigned ldsw = (unsigned)wid * 1024u;
    const int aoff = F8 ? lds_byte(wr * 64 + fr, fq * 16) : lds_byte(wr * 64 + fr, fq * 8), boff = F8 ? lds_byte(wc * 32 + fr, fq * 16) : lds_byte(wc * 32 + fr, fq * 8);
    constexpr int KOFF = F8 ? 16 : 1024;
#define PG8_SA(b, h) (((b) * 2 + (h)) * HTB)
#define PG8_SB(b, h) ((4 + (b) * 2 + (h)) * HTB)
#define PG8_STAGE(bufoff, gbase, voff) do { _Pragma("unroll") for (int _i = 0; _i < 2; ++_i) \
        __builtin_amdgcn_global_load_lds((const unsigned*)((const char*)(gbase) + (voff)[_i]), (PG8_LAS unsigned*)(lds + (bufoff) + ldsw + _i * 8192), 16, 0, 0); } while (0)
#define PG8_LDA(dst, b, h) do { _Pragma("unroll") for (int m = 0; m < 4; ++m) _Pragma("unroll") for (int k = 0; k < 2; ++k) dst[m][k] = *(const PG8_LAS bf16x8*)(lds + PG8_SA(b, h) + aoff + m * 2048 + k * KOFF); } while (0)
#define PG8_LDB(dst, b, h) do { _Pragma("unroll") for (int n = 0; n < 2; ++n) _Pragma("unroll") for (int k = 0; k < 2; ++k) dst[n][k] = *(const PG8_LAS bf16x8*)(lds + PG8_SB(b, h) + boff + n * 2048 + k * KOFF); } while (0)
#define PG8_MMA(ai, bj, At, Bt) do { __builtin_amdgcn_s_setprio(1); \
        if constexpr (F8) { _Pragma("unroll") for (int m = 0; m < 4; ++m) _Pragma("unroll") for (int n = 0; n < 2; ++n) { \
            typedef int i32x4_ __attribute__((ext_vector_type(4))); typedef int i32x8_ __attribute__((ext_vector_type(8))); \
            const i32x8_ b8_ = __builtin_shufflevector(__builtin_bit_cast(i32x4_, Bt[n][0]), __builtin_bit_cast(i32x4_, Bt[n][1]), 0, 1, 2, 3, 4, 5, 6, 7); \
            const i32x8_ a8_ = __builtin_shufflevector(__builtin_bit_cast(i32x4_, At[m][0]), __builtin_bit_cast(i32x4_, At[m][1]), 0, 1, 2, 3, 4, 5, 6, 7); \
            acc[ai][bj][m][n] = __builtin_amdgcn_mfma_scale_f32_16x16x128_f8f6f4(b8_, a8_, acc[ai][bj][m][n], 0, 0, 0, g.sB, 0, g.sA); } } \
        else { _Pragma("unroll") for (int m = 0; m < 4; ++m) _Pragma("unroll") for (int n = 0; n < 2; ++n) _Pragma("unroll") for (int k = 0; k < 2; ++k) \
            acc[ai][bj][m][n] = __builtin_amdgcn_mfma_f32_16x16x32_bf16(Bt[n][k], At[m][k], acc[ai][bj][m][n], 0, 0, 0); } \
        __builtin_amdgcn_s_setprio(0); } while (0)
#define PG8_WAIT_V(n) asm volatile("s_waitcnt vmcnt(" #n ")" ::: "memory")
#define PG8_WAIT_L(n) asm volatile("s_waitcnt lgkmcnt(" #n ")" ::: "memory")
#define PG8_BAR __builtin_amdgcn_s_barrier()
#define PG8_SCHED __builtin_amdgcn_sched_barrier(0)
    Unit cur, nxt; int ui = 0;
    if (!S.next(0, cur)) return;
    f32x4 acc[2][2][4][2];
#pragma unroll
    for (int a = 0; a < 2; ++a)
#pragma unroll
        for (int b = 0; b < 2; ++b)
#pragma unroll
            for (int m = 0; m < 4; ++m)
#pragma unroll
                for (int n = 0; n < 2; ++n) acc[a][b][m][n] = (f32x4){0.f, 0.f, 0.f, 0.f};
    bf16x8 At[4][2], B0[2][2], B1[2][2];
    const char* Ab = (const char*)g.A; const char* cB = (const char*)g.Bt + (size_t)cur.pn * tstep;
    unsigned cuA[2][2];
    S.a_ready(cur);
    PG8_AOFF(cuA, 0, cur);
    PG8_STAGE(PG8_SB(0, 0), cB, voffB); PG8_STAGE(PG8_SA(0, 0), Ab, cuA[0]); PG8_STAGE(PG8_SB(0, 1), cB + hstep, voffB); PG8_STAGE(PG8_SA(0, 1), Ab, cuA[1]);
    if (wr == 1) PG8_BAR;
    PG8_WAIT_V(4); PG8_BAR;
    PG8_STAGE(PG8_SB(1, 0), cB + kstep, voffB); PG8_STAGE(PG8_SA(1, 0), Ab + kstep, cuA[0]); PG8_STAGE(PG8_SB(1, 1), cB + hstep + kstep, voffB);
    PG8_WAIT_V(6); PG8_BAR;
    PG8_STAMP();
    for (;;) {
        const bool has_next = S.next(ui + 1, nxt);
        const char* nB = has_next ? (const char*)g.Bt + (size_t)nxt.pn * tstep : cB;
        for (int t = 0; t < nt; t += 2) {
            const bool last = (t == nt - 2);
            const char* a1 = Ab + (size_t)(t + 1) * kstep;
            const char* a2 = last ? Ab : Ab + (size_t)(t + 2) * kstep; const char* b2 = last ? nB : cB + (size_t)(t + 2) * kstep;
            const char* a3 = a2 + kstep; const char* b3 = b2 + kstep;

            if (last && has_next) S.a_ready(nxt);
            PG8_LDB(B0, 0, 0); PG8_SCHED; PG8_LDA(At, 0, 0); PG8_STAGE(PG8_SA(1, 1), a1, cuA[1]);
            PG8_WAIT_L(8); PG8_BAR; PG8_WAIT_L(0); PG8_MMA(0, 0, At, B0); PG8_BAR; PG8_SCHED;
            if (last && has_next) PG8_AOFF(cuA, ui + 1, nxt);
            PG8_LDB(B1, 0, 1); PG8_STAGE(PG8_SB(0, 0), b2, voffB);
            PG8_BAR; PG8_WAIT_L(0); PG8_MMA(0, 1, At, B1); PG8_BAR;
            PG8_LDA(At, 0, 1); PG8_STAGE(PG8_SA(0, 0), a2, cuA[0]);
            PG8_BAR; PG8_WAIT_L(0); PG8_MMA(1, 0, At, B0); PG8_BAR; PG8_SCHED;
            PG8_STAGE(PG8_SB(0, 1), b2 + hstep, voffB);
            PG8_WAIT_V(6); PG8_BAR; PG8_MMA(1, 1, At, B1); PG8_BAR;
            PG8_LDB(B0, 1, 0); PG8_SCHED; PG8_LDA(At, 1, 0); PG8_STAGE(PG8_SA(0, 1), a2, cuA[1]);
            PG8_WAIT_L(8); PG8_BAR; PG8_WAIT_L(0); PG8_MMA(0, 0, At, B0); PG8_BAR; PG8_SCHED;
            PG8_LDB(B1, 1, 1); PG8_STAGE(PG8_SB(1, 0), b3, voffB);
            PG8_BAR; PG8_WAIT_L(0); PG8_MMA(0, 1, At, B1); PG8_BAR;
            PG8_LDA(At, 1, 1); PG8_STAGE(PG8_SA(1, 0), a3, cuA[0]);
            PG8_BAR; PG8_WAIT_L(0); PG8_MMA(1, 0, At, B0); PG8_BAR; PG8_SCHED;
            PG8_STAGE(PG8_SB(1, 1), b3 + hstep, voffB);
            PG8_WAIT_V(6); PG8_BAR; PG8_MMA(1, 1, At, B1); PG8_BAR;
        }
        PG8_STAMP();
        if constexpr (!Epi::AFTER_DRAIN) { E(acc, cur, wr, wc, fr, fq); S.done(cur); }
        PG8_STAMP();
        if (!has_next) break;
#pragma unroll
        for (int a = 0; a < 2; ++a)
#pragma unroll
            for (int b = 0; b < 2; ++b)
#pragma unroll
                for (int m = 0; m < 4; ++m)
#pragma unroll
                    for (int n = 0; n < 2; ++n) acc[a][b][m][n] = (f32x4){0.f, 0.f, 0.f, 0.f};
        cur = nxt; cB = nB; ++ui;
    }
    PG8_WAIT_V(0);
    if (wr == 0) PG8_BAR;
    PG8_BAR;
    if constexpr (Epi::AFTER_DRAIN) { E.fused(acc, cur, wr, wc, fr, fq, lds, wid, lane); S.done(cur); }
    PG8_STAMP();
    if (STAMP && wid == 0) { stamps[lane] = lane < nts ? (((unsigned long long)(unsigned)ts_hi << 32) | (unsigned)ts_lo) : 0ull;
        if (lane == 62) stamps[62] = rt_entry; if (lane == 63) stamps[63] = (unsigned long long)wall_clock64(); }
#undef PG8_STAMP
#undef PG8_SA
#undef PG8_SB
#undef PG8_STAGE
#undef PG8_AOFF
#undef PG8_LDA
#undef PG8_LDB
#undef PG8_MMA
#undef PG8_WAIT_V
#undef PG8_WAIT_L
#undef PG8_BAR
#undef PG8_SCHED
}
}

namespace mk {
using pg8::bf16_t; using pg8::f32x4; using pg8::u32x4; using pg8::Unit; using pg8::cvt_pk_bf16;
#define LAS __attribute__((address_space(3)))
typedef float f32x2 __attribute__((ext_vector_type(2)));
typedef unsigned u32x2 __attribute__((ext_vector_type(2)));

#ifndef MK_N_LAUNCHES
#define MK_N_LAUNCHES 1
#endif
constexpr int NPHASE = 16;
constexpr int NB = 8, SEQ = 2048, D = 1024, T = NB * SEQ, NMEM = 256, SGW = 768, NSG = 12, HD = 64, CH = 128;
constexpr int NEXP = 16, LISTCAP = 16384;
constexpr float ALPHA = 1.41421356237f;
constexpr float LN_EPS = 1e-5f, ATT_SCALE = 0.125f;
constexpr int NWAVES = 8, NTHREADS = 512;

constexpr size_t MiB = 1u << 20;
constexpr size_t WS_CTL = 0, CTL_ZERO_BYTES = 1 * MiB;
constexpr size_t WS_TOKE = 1 * MiB, WS_TOKP = WS_TOKE + 128 * 1024, WS_TOKG = WS_TOKP + 128 * 1024;
constexpr size_t WS_LIST = 2 * MiB, WS_LSE = 3 * MiB, WS_SGWB = 4 * MiB;
constexpr size_t WS_MKV = 8 * MiB, WS_MEMB = 12 * MiB;
constexpr size_t WS_BT_INA = 18 * MiB, WS_BT_OUTA = 22 * MiB, WS_BT_B = 24 * MiB, WS_BT_OUTB = 29 * MiB, WS_BT_MEM = 30 * MiB;
constexpr size_t WS_WGU = 32 * MiB, WS_WD = 160 * MiB;
constexpr size_t WS_A = 224 * MiB;
constexpr size_t WS_U = WS_A, WS_GV = WS_A + 24 * MiB, WS_QM0 = WS_A + 48 * MiB;
constexpr size_t WS_K = WS_A, WS_V = WS_A + 24 * MiB, WS_Q = WS_A + 48 * MiB, WS_QM1 = WS_A + 72 * MiB;
constexpr size_t WS_ACT = WS_A;
constexpr size_t WS_XB = 304 * MiB;
constexpr size_t WS_C = 336 * MiB;
constexpr size_t WS_CAT = WS_C, WS_OG = WS_C, WS_CAT2 = WS_C + 24 * MiB;
constexpr size_t WS_Y = 376 * MiB;
constexpr size_t WS_YD = 336 * MiB;
constexpr size_t WS_X1B = 440 * MiB;
constexpr size_t WS_X1F8 = 472 * MiB;
constexpr size_t WS_END = 488 * MiB;
constexpr size_t WS_WGU8 = WS_WGU + 64 * MiB, WS_WD8 = WS_WD + 32 * MiB;
constexpr int CW_TMO = 0, CW_BAR = 4096, CW_CNT = 16384;
constexpr int LDS_TOKS = 131072 + 1024, MAX_UNITS = 8;
constexpr int LDS_MISC = 131072;
constexpr int LDS_BYTES = 147456;
static_assert(LDS_TOKS + MAX_UNITS * 1024 <= LDS_BYTES, "LDS map");

#define LDS_WAIT() asm volatile("s_waitcnt lgkmcnt(0)" ::: "memory")
#define VM_WAIT() asm volatile("s_waitcnt vmcnt(0)" ::: "memory")
__device__ __forceinline__ unsigned f2bf(float f) { unsigned u = __builtin_bit_cast(unsigned, f); return (u + 0x7fffu + ((u >> 16) & 1u)) >> 16; }
__device__ __forceinline__ unsigned pk2(float lo, float hi) { return f2bf(lo) | (f2bf(hi) << 16); }
__device__ __forceinline__ unsigned pk4_fp8_e(float a, float b, float c, float d) { int r = 0; r = __builtin_amdgcn_cvt_pk_fp8_f32(a, b, r, false); r = __builtin_amdgcn_cvt_pk_fp8_f32(c, d, r, true); return (unsigned)r; }
__device__ __forceinline__ float bflo(unsigned w) { return __uint_as_float(w << 16); }
__device__ __forceinline__ float bfhi(unsigned w) { return __uint_as_float(w & 0xffff0000u); }
__device__ __forceinline__ float bf1(bf16_t v) { return __uint_as_float(((unsigned)v) << 16); }
__device__ __forceinline__ float wave_sum(float v) {
#pragma unroll
    for (int o = 1; o < 64; o <<= 1) v += __shfl_xor(v, o);
    return v;
}
__device__ __forceinline__ float wave_max(float v) {
#pragma unroll
    for (int o = 1; o < 64; o <<= 1) v = fmaxf(v, __shfl_xor(v, o));
    return v;
}

#define XB_TMO      128
#define XB_XCNT(j)  (256  + 64 * (j))
#define XB_XSUB(j)  (1280 + 64 * (j))
#define XB_XGEN(j)  (2304 + 64 * (j))
#define XB_TOP      3328
#define XB_TOPGEN   3392
#define XCD_BAR_WORDS 3456
#define XB_SPIN_CAP (1u << 18)
__device__ __forceinline__ unsigned xb_ld(unsigned* p)              { return __hip_atomic_load(p, __ATOMIC_RELAXED, __HIP_MEMORY_SCOPE_AGENT); }
__device__ __forceinline__ unsigned xb_add(unsigned* p, unsigned v) { return __hip_atomic_fetch_add(p, v, __ATOMIC_RELAXED, __HIP_MEMORY_SCOPE_AGENT); }
__device__ __forceinline__ unsigned xb_xcc_id() { return (unsigned)__builtin_amdgcn_s_getreg((3 << 11) | 20) & 0xFu; }
#define XB_SPIN(cond, bar) do { unsigned _sp = 0; while (cond) { __builtin_amdgcn_s_sleep(1); \
    if ((++_sp & 255u) == 0u) { if (xb_ld(&(bar)[XB_TMO])) break; if (_sp > XB_SPIN_CAP) { atomicAdd(&(bar)[XB_TMO], 1u); break; } } } } while (0)
struct XcdBarrier { unsigned* bar; unsigned x; volatile LAS unsigned* st; };
__device__ __forceinline__ XcdBarrier xcd_barrier_post(unsigned* bar, volatile LAS unsigned* st) {
    XcdBarrier b; b.bar = bar; b.x = xb_xcc_id(); b.st = st;
    if (threadIdx.x == 0) (void)xb_add(&bar[XB_XCNT(b.x)], 1u);
    return b;
}
__device__ __forceinline__ void xcd_barrier_complete(unsigned* bar, unsigned x, unsigned& nloc, unsigned& nx) {
    const unsigned G = gridDim.x * gridDim.y * gridDim.z;
    unsigned sum, cnt, mine, sp = 0u;
    for (;;) {
        sum = 0u; cnt = 0u; mine = 0u;
#pragma unroll
        for (unsigned j = 0; j < 16; ++j) { const unsigned c = xb_ld(&bar[XB_XCNT(j)]); sum += c; cnt += (c > 0u) ? 1u : 0u; mine = (j == x) ? c : mine; }
        if (sum == G) break;
        __builtin_amdgcn_s_sleep(1);
        if ((++sp & 255u) == 0u) { if (xb_ld(&bar[XB_TMO])) break; if (sp > XB_SPIN_CAP) { atomicAdd(&bar[XB_TMO], 1u); break; } }
    }
    nloc = mine > 0u ? mine : 1u; nx = cnt > 0u ? cnt : 1u;
}
__device__ __forceinline__ void xcd_barrier(const XcdBarrier& b) {
    asm volatile("s_waitcnt vmcnt(0)" ::: "memory");
    __syncthreads();
    if (threadIdx.x == 0) {
        unsigned* bar = b.bar;
        __builtin_amdgcn_s_waitcnt(0);
        unsigned nloc = b.st[0], nx = b.st[1];
        if (nloc == 0u) { xcd_barrier_complete(bar, b.x, nloc, nx); b.st[0] = nloc; b.st[1] = nx; }
        const unsigned old = xb_add(&bar[XB_XSUB(b.x)], 1u);
        const unsigned gen = old / nloc;
        if (old + 1u == (gen + 1u) * nloc) {
            __builtin_amdgcn_fence(__ATOMIC_RELEASE, "agent");
            asm volatile("s_waitcnt vmcnt(0)" ::: "memory");
            const unsigned og = xb_add(&bar[XB_TOP], 1u);
            const unsigned tg = og / nx;
            if (og + 1u == (tg + 1u) * nx) xb_add(&bar[XB_TOPGEN], 1u);
            else XB_SPIN(xb_ld(&bar[XB_TOPGEN]) == tg, bar);
            __builtin_amdgcn_fence(__ATOMIC_ACQUIRE, "agent");
            xb_add(&bar[XB_XGEN(b.x)], 1u);
            asm volatile("s_waitcnt vmcnt(0)" ::: "memory");
        } else {
            XB_SPIN(xb_ld(&bar[XB_XGEN(b.x)]) == gen, bar);
            __builtin_amdgcn_fence(__ATOMIC_ACQUIRE, "agent");
            asm volatile("s_waitcnt vmcnt(0)" ::: "memory");
        }
    }
    __syncthreads();
}


struct EpiProjA {
    static constexpr bool PERM = true, AFTER_DRAIN = false;
    bf16_t *u, *gv, *qm;
    __device__ __forceinline__ void operator()(const f32x4 (&acc)[2][2][4][2], const Unit& un, int wr, int wc, int fr, int fq) const {
        const int row0 = un.pm * 256 + wr * 64 + fr;
        bf16_t* base; int ldc, colt; bool act; float sc = 1.f;
        if (un.pn < 3) { base = u; ldc = SGW; colt = un.pn * 256; act = true; }
        else if (un.pn < 6) { base = gv; ldc = SGW; colt = (un.pn - 3) * 256; act = true; }
        else { base = qm; ldc = 256; colt = 0; act = false; sc = ATT_SCALE; }
        const int col0 = colt + wc * 32 + 8 * fq;
#pragma unroll
        for (int ai = 0; ai < 2; ++ai)
#pragma unroll
            for (int m = 0; m < 4; ++m) { bf16_t* rowp = base + (size_t)(row0 + ai * 128 + m * 16) * ldc + col0;
#pragma unroll
                for (int bj = 0; bj < 2; ++bj) { f32x4 v0 = acc[ai][bj][m][0], v1 = acc[ai][bj][m][1];
                    if (act) { pg8::f32x2 a = pg8::gelu_pk((pg8::f32x2){v0[0], v0[1]}), b = pg8::gelu_pk((pg8::f32x2){v0[2], v0[3]}), c = pg8::gelu_pk((pg8::f32x2){v1[0], v1[1]}), d = pg8::gelu_pk((pg8::f32x2){v1[2], v1[3]});
                        v0 = (f32x4){a.x, a.y, b.x, b.y}; v1 = (f32x4){c.x, c.y, d.x, d.y}; }
                    v0 = v0 * sc; v1 = v1 * sc;
                    u32x4 w; w.x = cvt_pk_bf16(v0[0], v0[1]); w.y = cvt_pk_bf16(v0[2], v0[3]); w.z = cvt_pk_bf16(v1[0], v1[1]); w.w = cvt_pk_bf16(v1[2], v1[3]);
                    *(u32x4*)(rowp + bj * 128) = w; } }
    }
};
struct EpiProjB {
    static constexpr bool PERM = true, AFTER_DRAIN = false;
    bf16_t *k, *v, *q, *qm;
    __device__ __forceinline__ void operator()(const f32x4 (&acc)[2][2][4][2], const Unit& un, int wr, int wc, int fr, int fq) const {
        const int row0 = un.pm * 256 + wr * 64 + fr;
        bf16_t* base; int ldc, colt; float sc = 1.f;
        if (un.pn < 3) { base = k; ldc = SGW; colt = un.pn * 256; }
        else if (un.pn < 6) { base = v; ldc = SGW; colt = (un.pn - 3) * 256; }
        else if (un.pn < 9) { base = q; ldc = SGW; colt = (un.pn - 6) * 256; sc = ATT_SCALE; }
        else { base = qm; ldc = 256; colt = 0; sc = ATT_SCALE; }
        const int col0 = colt + wc * 32 + 8 * fq;
#pragma unroll
        for (int ai = 0; ai < 2; ++ai)
#pragma unroll
            for (int m = 0; m < 4; ++m) { bf16_t* rowp = base + (size_t)(row0 + ai * 128 + m * 16) * ldc + col0;
#pragma unroll
                for (int bj = 0; bj < 2; ++bj) { f32x4 v0 = acc[ai][bj][m][0] * sc, v1 = acc[ai][bj][m][1] * sc;
                    u32x4 w; w.x = cvt_pk_bf16(v0[0], v0[1]); w.y = cvt_pk_bf16(v0[2], v0[3]); w.z = cvt_pk_bf16(v1[0], v1[1]); w.w = cvt_pk_bf16(v1[2], v1[3]);
                    *(u32x4*)(rowp + bj * 128) = w; } }
    }
};
struct EpiPlain {
    static constexpr bool PERM = true, AFTER_DRAIN = false;
    bf16_t* O; int ldc, ntn;
    __device__ __forceinline__ void operator()(const f32x4 (&acc)[2][2][4][2], const Unit& un, int wr, int wc, int fr, int fq) const {
        const int row0 = un.pm * 256 + wr * 64 + fr;
        const int col0 = (un.pn % ntn) * 256 + wc * 32 + 8 * fq;
#pragma unroll
        for (int ai = 0; ai < 2; ++ai)
#pragma unroll
            for (int m = 0; m < 4; ++m) { bf16_t* rowp = O + (size_t)(row0 + ai * 128 + m * 16) * ldc + col0;
#pragma unroll
                for (int bj = 0; bj < 2; ++bj) { const f32x4 v0 = acc[ai][bj][m][0], v1 = acc[ai][bj][m][1];
                    u32x4 w; w.x = cvt_pk_bf16(v0[0], v0[1]); w.y = cvt_pk_bf16(v0[2], v0[3]); w.z = cvt_pk_bf16(v1[0], v1[1]); w.w = cvt_pk_bf16(v1[2], v1[3]);
                    *(u32x4*)(rowp + bj * 128) = w; } }
    }
};
struct EpiSwiGLU {
    static constexpr bool PERM = true, AFTER_DRAIN = false;
    bf16_t* O;
    __device__ __forceinline__ void operator()(const f32x4 (&acc)[2][2][4][2], const Unit& un, int wr, int wc, int fr, int fq) const {
        const int row0 = un.pm * 256 + wr * 64 + fr;
        const int col0 = (un.pn & 7) * 128 + wc * 32 + 8 * fq;
#pragma unroll
        for (int ai = 0; ai < 2; ++ai)
#pragma unroll
            for (int m = 0; m < 4; ++m) { bf16_t* rowp = O + (size_t)(row0 + ai * 128 + m * 16) * 1024 + col0;
                float r[8];
#pragma unroll
                for (int n = 0; n < 2; ++n)
#pragma unroll
                    for (int j = 0; j < 4; ++j) { const float g = acc[ai][0][m][n][j], up = acc[ai][1][m][n][j];
                        r[n * 4 + j] = g * __builtin_amdgcn_rcpf(1.0f + __expf(-g)) * up; }
                u32x4 w; w.x = cvt_pk_bf16(r[0], r[1]); w.y = cvt_pk_bf16(r[2], r[3]); w.z = cvt_pk_bf16(r[4], r[5]); w.w = cvt_pk_bf16(r[6], r[7]);
                *(u32x4*)rowp = w; }
    }
};
struct EpiSwiGLU8 {
    static constexpr bool PERM = true, AFTER_DRAIN = false;
    unsigned char* O;
    __device__ __forceinline__ void operator()(const f32x4 (&acc)[2][2][4][2], const Unit& un, int wr, int wc, int fr, int fq) const {
        const int row0 = un.pm * 256 + wr * 64 + fr;
        const int col0 = (un.pn & 7) * 128 + wc * 32 + 8 * fq;
#pragma unroll
        for (int ai = 0; ai < 2; ++ai)
#pragma unroll
            for (int m = 0; m < 4; ++m) { unsigned char* rowp = O + (size_t)(row0 + ai * 128 + m * 16) * 1024 + col0;
                float r[8];
#pragma unroll
                for (int n = 0; n < 2; ++n)
#pragma unroll
                    for (int j = 0; j < 4; ++j) { const float g = acc[ai][0][m][n][j], up = acc[ai][1][m][n][j];
                        r[n * 4 + j] = g * __builtin_amdgcn_rcpf(1.0f + __expf(-g)) * up * 8.0f; }
                *(u32x2*)rowp = (u32x2){pk4_fp8_e(r[0], r[1], r[2], r[3]), pk4_fp8_e(r[4], r[5], r[6], r[7])}; }
    }
};
template <bool RB> struct EpiResid {
    static constexpr bool PERM = false, AFTER_DRAIN = false;
    const void* res; float* Y;
    __device__ __forceinline__ void operator()(const f32x4 (&acc)[2][2][4][2], const Unit& un, int wr, int wc, int fr, int fq) const {
        const int row0 = un.pm * 256 + wr * 64 + fr, col0 = un.pn * 256 + wc * 32 + 4 * fq;
#pragma unroll
        for (int ai = 0; ai < 2; ++ai)
#pragma unroll
            for (int m = 0; m < 4; ++m) { const size_t off = (size_t)(row0 + ai * 128 + m * 16) * D + col0;
#pragma unroll
                for (int bj = 0; bj < 2; ++bj)
#pragma unroll
                    for (int n = 0; n < 2; ++n) { const size_t o = off + bj * 128 + n * 16; f32x4 r;
                        if (RB) { const u32x2 w = *(const u32x2*)((const bf16_t*)res + o); r = (f32x4){bflo(w.x), bfhi(w.x), bflo(w.y), bfhi(w.y)}; }
                        else r = *(const f32x4*)((const float*)res + o);
                        *(f32x4*)(Y + o) = r * ALPHA + acc[ai][bj][m][n]; } }
    }
};
struct SmallOrder {
    int nN, nwg, c;
    __device__ bool next(int i, Unit& u) const { if (i != 0 || c < 0 || c >= nwg) return false; u.pm = c / nN; u.pn = c % nN; return true; }
    __device__ __forceinline__ void a_ready(const Unit&) const {}
    __device__ __forceinline__ void done(const Unit&) const {}
    __device__ __forceinline__ int arow(int, const Unit& u, int r) const { return u.pm * 256 + r; }
};
struct MoeOrder {
    const LAS int* tb;
    int ntn, G, c;
    __device__ bool next(int i, Unit& u) const {
        const int L = i * G + c; if (L >= tb[16] * ntn) return false;
        int e = 0;
#pragma unroll
        for (int j = 1; j < 16; ++j) e += (L >= tb[j] * ntn) ? 1 : 0;
        const int r = L - tb[e] * ntn, te = tb[e + 1] - tb[e];
        u.pm = tb[e] + r % te; u.pn = e * ntn + r / te; return true;
    }
    __device__ __forceinline__ void a_ready(const Unit&) const {}
    __device__ __forceinline__ void done(const Unit&) const {}
    __device__ __forceinline__ int arow(int, const Unit& u, int r) const { return u.pm * 256 + r; }
};
struct MoeGatherOrder : MoeOrder {
    const LAS int* toks;
    __device__ __forceinline__ int arow(int ui, const Unit&, int r) const { return toks[ui * 256 + r]; }
};

struct Args { const float* in[23]; float* out; unsigned char* ws; int ph_lo, ph_hi; };
struct Ctx {
    unsigned char* ws; LAS unsigned char* lds;
    int tid, lane, wave, gw, NGW, G, bid;
};
__device__ __forceinline__ unsigned char* launder(unsigned char* p) { asm volatile("" : "+s"(p)); return p; }
__device__ __forceinline__ int launder_v(int v) { asm volatile("" : "+v"(v)); return v; }

__device__ __forceinline__ void tr_item(const float* W, int K, int N, bf16_t* WT, int grp, int gstride, int roff, LAS float* scr, int item, int lane) {
    const int nblk = N / 32, kb = item / nblk, nb = item % nblk, k0 = 64 * kb, n0 = 32 * nb;
    float ld[32];
    { const float* wp = W + (size_t)(k0 + (lane >> 5)) * N + n0 + (lane & 31);
#pragma unroll
      for (int i = 0; i < 32; ++i) ld[i] = __builtin_nontemporal_load(wp + (size_t)(2 * i) * N); }
#pragma unroll
    for (int i = 0; i < 32; ++i) scr[(2 * i + (lane >> 5)) * 33 + (lane & 31)] = ld[i];
    LDS_WAIT(); asm volatile("" ::: "memory");
    const int c = lane & 7;
#pragma unroll
    for (int j = 0; j < 4; ++j) { const int n = (lane >> 3) + 8 * j; const LAS float* s = scr + (8 * c) * 33 + n;
        const int nn = n0 + n, drow = (nn / grp) * gstride + (nn % grp) + roff;
        u32x4 o; o.x = pk2(s[0 * 33], s[1 * 33]); o.y = pk2(s[2 * 33], s[3 * 33]); o.z = pk2(s[4 * 33], s[5 * 33]); o.w = pk2(s[6 * 33], s[7 * 33]);
        *(u32x4*)(WT + (size_t)drow * K + k0 + 8 * c) = o; }
    LDS_WAIT(); asm volatile("" ::: "memory");
}
__device__ __forceinline__ unsigned pk4_fp8(float a, float b, float c, float d) { int r = 0; r = __builtin_amdgcn_cvt_pk_fp8_f32(a, b, r, false); r = __builtin_amdgcn_cvt_pk_fp8_f32(c, d, r, true); return (unsigned)r; }
__device__ __forceinline__ void tr_item8(const float* W, int K, int N, unsigned char* WT, int grp, int gstride, int roff, float sc, LAS float* scr, int item, int lane) {
    const int nblk = N / 32, kb = item / nblk, nb = item % nblk, k0 = 64 * kb, n0 = 32 * nb;
    float ld[32];
    { const float* wp = W + (size_t)(k0 + (lane >> 5)) * N + n0 + (lane & 31);
#pragma unroll
      for (int i = 0; i < 32; ++i) ld[i] = __builtin_nontemporal_load(wp + (size_t)(2 * i) * N); }
#pragma unroll
    for (int i = 0; i < 32; ++i) scr[(2 * i + (lane >> 5)) * 33 + (lane & 31)] = ld[i];
    LDS_WAIT(); asm volatile("" ::: "memory");
    const int c = lane & 7;
#pragma unroll
    for (int j = 0; j < 4; ++j) { const int n = (lane >> 3) + 8 * j; const LAS float* s = scr + (8 * c) * 33 + n;
        const int nn = n0 + n, drow = (nn / grp) * gstride + (nn % grp) + roff;
        u32x2 o; o.x = pk4_fp8(s[0 * 33] * sc, s[1 * 33] * sc, s[2 * 33] * sc, s[3 * 33] * sc); o.y = pk4_fp8(s[4 * 33] * sc, s[5 * 33] * sc, s[6 * 33] * sc, s[7 * 33] * sc);
        *(u32x2*)(WT + (size_t)drow * K + k0 + 8 * c) = o; }
    LDS_WAIT(); asm volatile("" ::: "memory");
}
constexpr float W8_SCALE = 32.0f, ACT8_SCALE = 8.0f;
constexpr int E8_ONE = 0x7f7f7f7f, E8_W = 0x7a7a7a7a, E8_ACT = 0x7c7c7c7c;
__device__ __forceinline__ void p0_prologue(const Ctx& C, const Args& A) {
    LAS float* scr = (LAS float*)(C.lds + C.wave * 16384);
    unsigned char* ws = C.ws;
    constexpr int I_MOE = 16 * 32;
    constexpr int N_MOE = 32 * I_MOE;
    constexpr int I_INA = 16 * 56, I_SQ = 512, I_KV = 16 * 24, I_OUTB = 8 * 32, I_MEM = 16 * 8;
    constexpr int NITEMS = 3 * N_MOE + I_INA + I_SQ + I_SQ + 2 * I_KV + I_OUTB + 4 * I_MEM;
    for (int it = C.gw; it < NITEMS; it += C.NGW) {
        int r = it;
        if (r < N_MOE) { const int m = r / I_MOE;
            tr_item8(A.in[20] + (size_t)m * 1048576, 1024, 1024, ws + WS_WGU + (size_t)(m >> 4) * (64 * MiB) + (size_t)(m & 15) * 2097152, 128, 256, 0, W8_SCALE, scr, r % I_MOE, C.lane);
            continue; } r -= N_MOE;
        if (r < N_MOE) { const int m = r / I_MOE;
            tr_item8(A.in[21] + (size_t)m * 1048576, 1024, 1024, ws + WS_WGU + (size_t)(m >> 4) * (64 * MiB) + (size_t)(m & 15) * 2097152, 128, 256, 128, W8_SCALE, scr, r % I_MOE, C.lane);
            continue; } r -= N_MOE;
        if (r < N_MOE) { const int m = r / I_MOE;
            tr_item8(A.in[22] + (size_t)m * 1048576, 1024, 1024, ws + WS_WD + (size_t)(m >> 4) * (32 * MiB) + (size_t)(m & 15) * 1048576, 1024, 1024, 0, W8_SCALE, scr, r % I_MOE, C.lane);
            continue; } r -= N_MOE;
        if (r < I_INA) { tr_item(A.in[2], 1024, 1792, (bf16_t*)(ws + WS_BT_INA), 1792, 1792, 0, scr, r, C.lane); continue; } r -= I_INA;
        if (r < I_SQ) { tr_item(A.in[3], 1024, 1024, (bf16_t*)(ws + WS_BT_OUTA), 1024, 1024, 0, scr, r, C.lane); continue; } r -= I_SQ;
        if (r < I_SQ) { tr_item(A.in[8], 1024, 1024, (bf16_t*)(ws + WS_BT_B), 1024, 1024, 1536, scr, r, C.lane); continue; } r -= I_SQ;
        if (r < I_KV) { tr_item(A.in[10], 1024, 768, (bf16_t*)(ws + WS_BT_B), 768, 768, 0, scr, r, C.lane); continue; } r -= I_KV;
        if (r < I_KV) { tr_item(A.in[11], 1024, 768, (bf16_t*)(ws + WS_BT_B), 768, 768, 768, scr, r, C.lane); continue; } r -= I_KV;
        if (r < I_OUTB) { tr_item(A.in[9], 512, 1024, (bf16_t*)(ws + WS_BT_OUTB), 1024, 1024, 0, scr, r, C.lane); continue; } r -= I_OUTB;
        { const int m = r / I_MEM, layer = m & 1, isv = m >> 1;
          tr_item(A.in[isv ? 13 : 12] + (size_t)layer * 262144, 1024, 256, (bf16_t*)(ws + WS_BT_MEM), 256, 256, layer * 512 + isv * 256, scr, r % I_MEM, C.lane); }
    }
    const int gt = C.bid * NTHREADS + C.tid, NT = C.G * NTHREADS;
    for (int i = gt; i < NSG * 128 * 128 / 8; i += NT) { const int q0 = (i & 15) * 8, p = (i >> 4) & 127;
        const f32x4 a = *(const f32x4*)(A.in[6] + (size_t)i * 8), b = *(const f32x4*)(A.in[6] + (size_t)i * 8 + 4); float v[8] = {a[0], a[1], a[2], a[3], b[0], b[1], b[2], b[3]};
#pragma unroll
        for (int j = 0; j < 8; ++j) v[j] = (q0 + j <= p) ? v[j] : 0.f;
        u32x4 w; w.x = pk2(v[0], v[1]); w.y = pk2(v[2], v[3]); w.z = pk2(v[4], v[5]); w.w = pk2(v[6], v[7]); *(u32x4*)((bf16_t*)(ws + WS_SGWB) + (size_t)i * 8) = w; }
    for (int i = gt; i < T * D / 8; i += NT) { const f32x4 a = *(const f32x4*)(A.in[0] + (size_t)i * 8), b = *(const f32x4*)(A.in[0] + (size_t)i * 8 + 4);
        u32x4 w; w.x = pk2(a[0], a[1]); w.y = pk2(a[2], a[3]); w.z = pk2(b[0], b[1]); w.w = pk2(b[2], b[3]); *(u32x4*)((bf16_t*)(ws + WS_XB) + (size_t)i * 8) = w; }
    for (int i = gt; i < NB * NMEM * D / 8; i += NT) { const f32x4 a = *(const f32x4*)(A.in[1] + (size_t)i * 8), b = *(const f32x4*)(A.in[1] + (size_t)i * 8 + 4);
        u32x4 w; w.x = pk2(a[0], a[1]); w.y = pk2(a[2], a[3]); w.z = pk2(b[0], b[1]); w.w = pk2(b[2], b[3]); *(u32x4*)((bf16_t*)(ws + WS_MEMB) + (size_t)i * 8) = w; }
}

__device__ __forceinline__ void sg_scalar(const Ctx& C, const Args& A) {
    const bf16_t* U = (const bf16_t*)(C.ws + WS_U); const bf16_t* GV = (const bf16_t*)(C.ws + WS_GV); bf16_t* CAT = (bf16_t*)(C.ws + WS_CAT);
    const float* lng = A.in[4]; const float* lnb = A.in[5]; const float* sgw = A.in[6]; const float* sgb = A.in[7];
    LAS float* stat = (LAS float*)C.lds;
    LAS float* gvn = (LAS float*)(C.lds + 1024);
    LAS float* Wl = (LAS float*)(C.lds + 1024 + 128 * 65 * 4);
    for (int unit = C.bid; unit < NB * 16; unit += C.G) {
        const int tb = unit * 128;
        for (int rr = 0; rr < 16; ++rr) { const int row = C.wave * 16 + rr; const bf16_t* p = GV + (size_t)(tb + row) * SGW + 4 * C.lane;
            float s = 0.f, ss = 0.f;
#pragma unroll
            for (int j = 0; j < 3; ++j) { const u32x2 w = *(const u32x2*)(p + 256 * j); const float a = bflo(w.x), b = bfhi(w.x), c = bflo(w.y), d = bfhi(w.y);
                s += (a + b) + (c + d); ss += (a * a + b * b) + (c * c + d * d); }
            s = wave_sum(s); ss = wave_sum(ss);
            const float mean = s * (1.f / SGW), var = ss * (1.f / SGW) - mean * mean;
            if (C.lane == 0) { stat[row * 2] = mean; stat[row * 2 + 1] = 1.0f / sqrtf(var + LN_EPS); } }
        __syncthreads();
        const int p = C.tid >> 2, d0 = (C.tid & 3) * 16;
        for (int g = 0; g < NSG; ++g) {
            { const bf16_t* src = GV + (size_t)(tb + p) * SGW + g * 64 + d0; const float mean = stat[p * 2], rstd = stat[p * 2 + 1];
#pragma unroll
              for (int h = 0; h < 2; ++h) { const u32x4 w = *(const u32x4*)(src + 8 * h); const unsigned ww[4] = {w.x, w.y, w.z, w.w};
#pragma unroll
                  for (int j = 0; j < 4; ++j) { const int d = d0 + 8 * h + 2 * j; const int cc = g * 64 + d;
                      gvn[p * 65 + d] = (bflo(ww[j]) - mean) * rstd * lng[cc] + lnb[cc];
                      gvn[p * 65 + d + 1] = (bfhi(ww[j]) - mean) * rstd * lng[cc + 1] + lnb[cc + 1]; } } }
            { const int q0 = (C.tid & 3) * 32; const float* src = sgw + ((size_t)g * 128 + p) * 128 + q0;
#pragma unroll
              for (int j = 0; j < 8; ++j) { const f32x4 w = *(const f32x4*)(src + 4 * j);
#pragma unroll
                  for (int t = 0; t < 4; ++t) { const int q = q0 + 4 * j + t; Wl[p * 129 + q] = (q <= p) ? w[t] : 0.f; } } }
            __syncthreads();
            float acc[16];
#pragma unroll
            for (int j = 0; j < 16; ++j) acc[j] = 0.f;
            for (int q = 0; q <= p; ++q) { const float w = Wl[p * 129 + q];
#pragma unroll
                for (int j = 0; j < 16; ++j) acc[j] += w * gvn[q * 65 + d0 + j]; }
            const float bs = sgb[g * 128 + p];
            const bf16_t* us = U + (size_t)(tb + p) * SGW + g * 64 + d0; bf16_t* dst = CAT + (size_t)(tb + p) * D + g * 64 + d0;
#pragma unroll
            for (int h = 0; h < 2; ++h) { const u32x4 w = *(const u32x4*)(us + 8 * h); const unsigned ww[4] = {w.x, w.y, w.z, w.w}; unsigned o[4];
#pragma unroll
                for (int j = 0; j < 4; ++j) o[j] = pk2(bflo(ww[j]) * (acc[8 * h + 2 * j] + bs), bfhi(ww[j]) * (acc[8 * h + 2 * j + 1] + bs));
                *(u32x4*)(dst + 8 * h) = (u32x4){o[0], o[1], o[2], o[3]}; }
            __syncthreads();
        }
    }
}

__device__ __forceinline__ void memattn_scalar(const Ctx& C, const bf16_t* QM, const bf16_t* MKV, int ck, int cv, bf16_t* OUT, int ldo, int coff) {
    for (int it = C.gw; it < T * 4; it += C.NGW) {
        const int tok = it >> 2, h = it & 3, b = tok / SEQ;
        float q[64];
        { const bf16_t* qp = QM + (size_t)tok * 256 + h * 64;
#pragma unroll
          for (int j = 0; j < 8; ++j) { const u32x4 w = *(const u32x4*)(qp + 8 * j);
              q[8 * j] = bflo(w.x); q[8 * j + 1] = bfhi(w.x); q[8 * j + 2] = bflo(w.y); q[8 * j + 3] = bfhi(w.y); q[8 * j + 4] = bflo(w.z); q[8 * j + 5] = bfhi(w.z); q[8 * j + 6] = bflo(w.w); q[8 * j + 7] = bfhi(w.w); } }
        float s[4];
#pragma unroll
        for (int jj = 0; jj < 4; ++jj) { const bf16_t* kp = MKV + (size_t)(b * NMEM + jj * 64 + C.lane) * 1024 + ck + h * 64; float a = 0.f;
#pragma unroll
            for (int j = 0; j < 8; ++j) { const u32x4 w = *(const u32x4*)(kp + 8 * j);
                a += q[8 * j] * bflo(w.x) + q[8 * j + 1] * bfhi(w.x) + q[8 * j + 2] * bflo(w.y) + q[8 * j + 3] * bfhi(w.y) + q[8 * j + 4] * bflo(w.z) + q[8 * j + 5] * bfhi(w.z) + q[8 * j + 6] * bflo(w.w) + q[8 * j + 7] * bfhi(w.w); }
            s[jj] = a; }
        const float mx = wave_max(fmaxf(fmaxf(s[0], s[1]), fmaxf(s[2], s[3])));
        float l = 0.f;
#pragma unroll
        for (int jj = 0; jj < 4; ++jj) { s[jj] = __expf(s[jj] - mx); l += s[jj]; }
        l = wave_sum(l);
        float acc = 0.f;
#pragma unroll
        for (int jj = 0; jj < 4; ++jj) { const bf16_t* vp = MKV + (size_t)(b * NMEM + jj * 64) * 1024 + cv + h * 64 + C.lane;
            for (int mm = 0; mm < 64; ++mm) acc += __shfl(s[jj], mm) * bf1(vp[(size_t)mm * 1024]); }
        OUT[(size_t)tok * ldo + coff + h * 64 + C.lane] = (bf16_t)f2bf(acc / l);
    }
}

__device__ __forceinline__ void dilattn_scalar(const Ctx& C, const Args& A) {
    const bf16_t* Q = (const bf16_t*)(C.ws + WS_Q); const bf16_t* K = (const bf16_t*)(C.ws + WS_K); const bf16_t* V = (const bf16_t*)(C.ws + WS_V);
    bf16_t* OG = (bf16_t*)(C.ws + WS_OG); float* LSE = (float*)(C.ws + WS_LSE);
    for (int it = C.gw; it < T * 12; it += C.NGW) {
        const int tok = it / 12, h = it % 12, g = h >> 2, dl = (g == 0) ? 1 : (g == 1 ? 4 : 16);
        const int t = tok % SEQ, i = t / dl;
        const float slope = exp2f(-(float)(h + 1) * (8.0f / 12.0f));
        float q[64];
        { const bf16_t* qp = Q + (size_t)tok * SGW + h * 64;
#pragma unroll
          for (int j = 0; j < 8; ++j) { const u32x4 w = *(const u32x4*)(qp + 8 * j);
              q[8 * j] = bflo(w.x); q[8 * j + 1] = bfhi(w.x); q[8 * j + 2] = bflo(w.y); q[8 * j + 3] = bfhi(w.y); q[8 * j + 4] = bflo(w.z); q[8 * j + 5] = bfhi(w.z); q[8 * j + 6] = bflo(w.w); q[8 * j + 7] = bfhi(w.w); } }
        float s[3];
#pragma unroll
        for (int jj = 0; jj < 3; ++jj) { const int j0 = jj * 64 + C.lane; const bool valid = (jj < 2 || C.lane == 0) && (j0 <= i);
            const int jc = valid ? j0 : 0;
            const bf16_t* kp = K + (size_t)(tok - jc * dl) * SGW + h * 64; float a = 0.f;
#pragma unroll
            for (int j = 0; j < 8; ++j) { const u32x4 w = *(const u32x4*)(kp + 8 * j);
                a += q[8 * j] * bflo(w.x) + q[8 * j + 1] * bfhi(w.x) + q[8 * j + 2] * bflo(w.y) + q[8 * j + 3] * bfhi(w.y) + q[8 * j + 4] * bflo(w.z) + q[8 * j + 5] * bfhi(w.z) + q[8 * j + 6] * bflo(w.w) + q[8 * j + 7] * bfhi(w.w); }
            s[jj] = valid ? (a - slope * (float)(dl * j0)) : -INFINITY; }
        const float mx = wave_max(fmaxf(fmaxf(s[0], s[1]), s[2]));
        float l = 0.f;
#pragma unroll
        for (int jj = 0; jj < 3; ++jj) { s[jj] = __expf(s[jj] - mx); l += s[jj]; }
        l = wave_sum(l);
        float acc = 0.f;
#pragma unroll
        for (int jj = 0; jj < 3; ++jj) { const int nm = (jj < 2) ? 64 : 1;
            for (int mm = 0; mm < nm; ++mm) { const int j0 = jj * 64 + mm; const int jc = (j0 <= i) ? j0 : 0;
                acc += __shfl(s[jj], mm) * bf1(V[(size_t)(tok - jc * dl) * SGW + h * 64 + C.lane]); } }
        OG[(size_t)tok * SGW + h * 64 + C.lane] = (bf16_t)f2bf(acc / l);
        if (C.lane == 0) LSE[tok * 12 + h] = mx + __logf(l);
    }
}
typedef short bf16x8 __attribute__((ext_vector_type(8)));
typedef short s16x4 __attribute__((ext_vector_type(4)));
constexpr int AT_KS = 144, AT_VS = 160, AT_ROWS = 272, AT_K_OFF = 0, AT_V_OFF = AT_ROWS * AT_KS;
static_assert(AT_V_OFF % 16 == 0 && AT_V_OFF + AT_ROWS * AT_VS <= 131072, "attention LDS map");

template <int NKB, bool DIL>
__device__ __forceinline__ void attn_compute(LAS unsigned char* lds, int lane, int krow0, bf16x8 qf0, bf16x8 qf1, float sdl, int ikw, f32x4 (&o)[4], float& mx, float& lsum) {
    const int n = lane & 15, g = lane >> 4;
    const LAS unsigned char* Kb = lds + AT_K_OFF + (krow0 + n) * AT_KS + g * 16;
    f32x4 sc[NKB];
#pragma unroll
    for (int kb = 0; kb < NKB; ++kb) {
        const bf16x8 k0 = *(const LAS bf16x8*)(Kb + kb * 16 * AT_KS), k1 = *(const LAS bf16x8*)(Kb + kb * 16 * AT_KS + 64);
        f32x4 a = (f32x4){0.f, 0.f, 0.f, 0.f};
        a = __builtin_amdgcn_mfma_f32_16x16x32_bf16(k0, qf0, a, 0, 0, 0);
        a = __builtin_amdgcn_mfma_f32_16x16x32_bf16(k1, qf1, a, 0, 0, 0);
        sc[kb] = a;
    }
    float m = -INFINITY;
#pragma unroll
    for (int kb = 0; kb < NKB; ++kb)
#pragma unroll
        for (int r = 0; r < 4; ++r) {
            if (DIL) { const int off = 16 * kb + 4 * g + r, rel = 144 + n - off; const bool valid = (rel >= 0) && (rel <= 128) && (ikw + off >= 0);
                sc[kb][r] = valid ? (sc[kb][r] - sdl * (float)rel) : -INFINITY; }
            m = fmaxf(m, sc[kb][r]); }
    m = fmaxf(m, __shfl_xor(m, 16)); m = fmaxf(m, __shfl_xor(m, 32));
    float l = 0.f;
#pragma unroll
    for (int kb = 0; kb < NKB; ++kb)
#pragma unroll
        for (int r = 0; r < 4; ++r) { sc[kb][r] = __expf(sc[kb][r] - m); l += sc[kb][r]; }
    l += __shfl_xor(l, 16); l += __shfl_xor(l, 32);
    mx = m; lsum = l;
    const LAS unsigned char* Vb = lds + AT_V_OFF + (krow0 + 4 * g + (n >> 2)) * AT_VS + (n & 3) * 8;
#pragma unroll
    for (int db = 0; db < 4; ++db) o[db] = (f32x4){0.f, 0.f, 0.f, 0.f};
#pragma unroll
    for (int kk = 0; kk < NKB / 2; ++kk) {
        union { bf16x8 v; unsigned u[4]; } pf;
        pf.u[0] = cvt_pk_bf16(sc[2 * kk][0], sc[2 * kk][1]); pf.u[1] = cvt_pk_bf16(sc[2 * kk][2], sc[2 * kk][3]);
        pf.u[2] = cvt_pk_bf16(sc[2 * kk + 1][0], sc[2 * kk + 1][1]); pf.u[3] = cvt_pk_bf16(sc[2 * kk + 1][2], sc[2 * kk + 1][3]);
#pragma unroll
        for (int db = 0; db < 4; ++db) {
            const s16x4 v0 = __builtin_amdgcn_ds_read_tr16_b64_v4i16((LAS s16x4*)(Vb + (2 * kk) * 16 * AT_VS + db * 32));
            const s16x4 v1 = __builtin_amdgcn_ds_read_tr16_b64_v4i16((LAS s16x4*)(Vb + (2 * kk + 1) * 16 * AT_VS + db * 32));
            const bf16x8 vf = __builtin_shufflevector(v0, v1, 0, 1, 2, 3, 4, 5, 6, 7);
            o[db] = __builtin_amdgcn_mfma_f32_16x16x32_bf16(vf, pf.v, o[db], 0, 0, 0);
        }
    }
}

__device__ __forceinline__ void memattn_mfma(const Ctx& C, const bf16_t* QM, const bf16_t* MKV, int ck, int cv, bf16_t* OUT, int ldo, int coff) {
    const int n = C.lane & 15, g = C.lane >> 4;
    for (int unit = C.bid; unit < NB * 4 * 16; unit += C.G) {
        const int b = unit >> 6, h = (unit >> 4) & 3, qt = unit & 15;
        __syncthreads();
#pragma unroll
        for (int it = 0; it < 4; ++it) { const int row = it * 64 + (C.tid >> 3), c = C.tid & 7;
            const bf16_t* src = MKV + (size_t)(b * NMEM + row) * 1024 + h * 64 + c * 8;
            const u32x4 kv = *(const u32x4*)(src + ck), vv = *(const u32x4*)(src + cv);
            *(LAS u32x4*)(C.lds + AT_K_OFF + row * AT_KS + c * 16) = kv; *(LAS u32x4*)(C.lds + AT_V_OFF + row * AT_VS + c * 16) = vv; }
        const int tok = b * SEQ + qt * 128 + C.wave * 16 + n;
        const bf16_t* qp = QM + (size_t)tok * 256 + h * 64 + g * 8;
        const bf16x8 qf0 = *(const bf16x8*)qp, qf1 = *(const bf16x8*)(qp + 32);
        __syncthreads();
        f32x4 o[4]; float mx, l;
        attn_compute<16, false>(C.lds, C.lane, 0, qf0, qf1, 0.f, 0, o, mx, l);
        const float inv = 1.0f / l;
#pragma unroll
        for (int db = 0; db < 4; ++db)
            *(u32x2*)(OUT + (size_t)tok * ldo + coff + h * 64 + 16 * db + 4 * g) = (u32x2){cvt_pk_bf16(o[db][0] * inv, o[db][1] * inv), cvt_pk_bf16(o[db][2] * inv, o[db][3] * inv)};
    }
}
__device__ __forceinline__ void dilattn_mfma(const Ctx& C) {
    const bf16_t* Q = (const bf16_t*)(C.ws + WS_Q); const bf16_t* K = (const bf16_t*)(C.ws + WS_K); const bf16_t* V = (const bf16_t*)(C.ws + WS_V);
    bf16_t* OG = (bf16_t*)(C.ws + WS_OG); float* LSE = (float*)(C.ws + WS_LSE);
    const int n = C.lane & 15, g = C.lane >> 4;
    for (int unit = C.bid; unit < 12 * 128; unit += C.G) {
        const int h = unit >> 7, rem = unit & 127, b = rem >> 4, x = rem & 15, grp = h >> 2;
        const int dl = (grp == 0) ? 1 : (grp == 1 ? 4 : 16), ntile = 16 / dl, r = x / ntile, I0 = (x % ntile) * 128;
        const float sdl = exp2f(-(float)(h + 1) * (8.0f / 12.0f)) * (float)dl;
        __syncthreads();
        for (int idx = C.tid; idx < AT_ROWS * 8; idx += NTHREADS) { const int row = idx >> 3, c = idx & 7; const int ik = I0 - 144 + row;
            u32x4 kv = (u32x4){0u, 0u, 0u, 0u}, vv = (u32x4){0u, 0u, 0u, 0u};
            if (ik >= 0) { const size_t off = (size_t)(b * SEQ + ik * dl + r) * SGW + h * 64 + c * 8; kv = *(const u32x4*)(K + off); vv = *(const u32x4*)(V + off); }
            *(LAS u32x4*)(C.lds + AT_K_OFF + row * AT_KS + c * 16) = kv; *(LAS u32x4*)(C.lds + AT_V_OFF + row * AT_VS + c * 16) = vv; }
        const int iq = I0 + C.wave * 16 + n, tok = b * SEQ + iq * dl + r;
        const bf16_t* qp = Q + (size_t)tok * SGW + h * 64 + g * 8;
        const bf16x8 qf0 = *(const bf16x8*)qp, qf1 = *(const bf16x8*)(qp + 32);
        __syncthreads();
        f32x4 o[4]; float mx, l;
        attn_compute<10, true>(C.lds, C.lane, C.wave * 16, qf0, qf1, sdl, I0 + C.wave * 16 - 144, o, mx, l);
        const float inv = 1.0f / l;
#pragma unroll
        for (int db = 0; db < 4; ++db)
            *(u32x2*)(OG + (size_t)tok * SGW + h * 64 + 16 * db + 4 * g) = (u32x2){cvt_pk_bf16(o[db][0] * inv, o[db][1] * inv), cvt_pk_bf16(o[db][2] * inv, o[db][3] * inv)};
        if (g == 0) LSE[tok * 12 + h] = mx + __logf(l);
    }
}
constexpr int SG_GVN_OFF = 1024, SG_VS = 160;
__device__ __forceinline__ void sg_mfma(const Ctx& C, const Args& A) {
    const bf16_t* U = (const bf16_t*)(C.ws + WS_U); const bf16_t* GV = (const bf16_t*)(C.ws + WS_GV); bf16_t* CAT = (bf16_t*)(C.ws + WS_CAT);
    const bf16_t* WB = (const bf16_t*)(C.ws + WS_SGWB);
    const float* lng = A.in[4]; const float* lnb = A.in[5]; const float* sgb = A.in[7];
    LAS float* stat = (LAS float*)C.lds;
    const int n = C.lane & 15, gl = C.lane >> 4;
    for (int unit = C.bid; unit < NB * 16 * 4; unit += C.G) {
        const int tb = (unit >> 2) * 128, gq = unit & 3;
        __syncthreads();
        for (int rr = 0; rr < 16; ++rr) { const int row = C.wave * 16 + rr; const bf16_t* p = GV + (size_t)(tb + row) * SGW + 4 * C.lane;
            float s = 0.f, ss = 0.f;
#pragma unroll
            for (int j = 0; j < 3; ++j) { const u32x2 w = *(const u32x2*)(p + 256 * j); const float a = bflo(w.x), b = bfhi(w.x), c = bflo(w.y), d = bfhi(w.y);
                s += (a + b) + (c + d); ss += (a * a + b * b) + (c * c + d * d); }
            s = wave_sum(s); ss = wave_sum(ss);
            const float mean = s * (1.f / SGW), var = ss * (1.f / SGW) - mean * mean;
            if (C.lane == 0) { stat[row * 2] = mean; stat[row * 2 + 1] = 1.0f / sqrtf(var + LN_EPS); } }
        __syncthreads();
        for (int gi = 0; gi < 3; ++gi) {
            const int g = gq * 3 + gi;
#pragma unroll
            for (int it = 0; it < 2; ++it) { const int idx = it * NTHREADS + C.tid, row = idx >> 3, c = idx & 7, cc = g * 64 + c * 8;
                const u32x4 w = *(const u32x4*)(GV + (size_t)(tb + row) * SGW + cc); const float mean = stat[row * 2], rstd = stat[row * 2 + 1];
                const f32x4 ga = *(const f32x4*)(lng + cc), gb = *(const f32x4*)(lng + cc + 4), ba = *(const f32x4*)(lnb + cc), bb = *(const f32x4*)(lnb + cc + 4);
                u32x4 o;
                o.x = pk2((bflo(w.x) - mean) * rstd * ga[0] + ba[0], (bfhi(w.x) - mean) * rstd * ga[1] + ba[1]);
                o.y = pk2((bflo(w.y) - mean) * rstd * ga[2] + ba[2], (bfhi(w.y) - mean) * rstd * ga[3] + ba[3]);
                o.z = pk2((bflo(w.z) - mean) * rstd * gb[0] + bb[0], (bfhi(w.z) - mean) * rstd * gb[1] + bb[1]);
                o.w = pk2((bflo(w.w) - mean) * rstd * gb[2] + bb[2], (bfhi(w.w) - mean) * rstd * gb[3] + bb[3]);
                *(LAS u32x4*)(C.lds + SG_GVN_OFF + row * SG_VS + c * 16) = o; }
            __syncthreads();
            const int p = C.wave * 16 + n, nks = (C.wave >> 1) + 1;
            f32x4 acc[4];
#pragma unroll
            for (int db = 0; db < 4; ++db) acc[db] = (f32x4){0.f, 0.f, 0.f, 0.f};
            const bf16_t* wp = WB + (size_t)(g * 128 + p) * 128 + 8 * gl;
            const LAS unsigned char* vb = C.lds + SG_GVN_OFF + (8 * gl + (n >> 2)) * SG_VS + (n & 3) * 8;
            for (int ks = 0; ks < nks; ++ks) {
                const bf16x8 wf = *(const bf16x8*)(wp + 32 * ks);
#pragma unroll
                for (int db = 0; db < 4; ++db) {
                    const s16x4 v0 = __builtin_amdgcn_ds_read_tr16_b64_v4i16((LAS s16x4*)(vb + ks * 32 * SG_VS + db * 32));
                    const s16x4 v1 = __builtin_amdgcn_ds_read_tr16_b64_v4i16((LAS s16x4*)(vb + ks * 32 * SG_VS + 4 * SG_VS + db * 32));
                    const bf16x8 vf = __builtin_shufflevector(v0, v1, 0, 1, 2, 3, 4, 5, 6, 7);
                    acc[db] = __builtin_amdgcn_mfma_f32_16x16x32_bf16(vf, wf, acc[db], 0, 0, 0);
                }
            }
            const float bs = sgb[g * 128 + p];
#pragma unroll
            for (int db = 0; db < 4; ++db) { const size_t co = (size_t)g * 64 + 16 * db + 4 * gl;
                const u32x2 uw = *(const u32x2*)(U + (size_t)(tb + p) * SGW + co);
                *(u32x2*)(CAT + (size_t)(tb + p) * D + co) = (u32x2){cvt_pk_bf16(bflo(uw.x) * (acc[db][0] + bs), bfhi(uw.x) * (acc[db][1] + bs)), cvt_pk_bf16(bflo(uw.y) * (acc[db][2] + bs), bfhi(uw.y) * (acc[db][3] + bs))}; }
            __syncthreads();
        }
    }
}
__device__ __forceinline__ void dil_merge(const Ctx& C, const Args& A) {
    const bf16_t* OG = (const bf16_t*)(C.ws + WS_OG); const float* LSE = (const float*)(C.ws + WS_LSE); bf16_t* CAT2 = (bf16_t*)(C.ws + WS_CAT2);
    const int gt = C.bid * NTHREADS + C.tid, NT = C.G * NTHREADS;
    for (int it = gt; it < T * 32; it += NT) {
        const int tok = it >> 5, j = (it >> 3) & 3, c8 = it & 7;
        const float l0 = LSE[tok * 12 + j], l1 = LSE[tok * 12 + 4 + j], l2 = LSE[tok * 12 + 8 + j];
        const float mx = fmaxf(l0, fmaxf(l1, l2));
        float w0 = __expf(l0 - mx), w1 = __expf(l1 - mx), w2 = __expf(l2 - mx); const float inv = 1.0f / (w0 + w1 + w2); w0 *= inv; w1 *= inv; w2 *= inv;
        const u32x4 a = *(const u32x4*)(OG + (size_t)tok * SGW + j * 64 + c8 * 8), b = *(const u32x4*)(OG + (size_t)tok * SGW + (4 + j) * 64 + c8 * 8), c = *(const u32x4*)(OG + (size_t)tok * SGW + (8 + j) * 64 + c8 * 8);
        u32x4 o;
        o.x = pk2(w0 * bflo(a.x) + w1 * bflo(b.x) + w2 * bflo(c.x), w0 * bfhi(a.x) + w1 * bfhi(b.x) + w2 * bfhi(c.x));
        o.y = pk2(w0 * bflo(a.y) + w1 * bflo(b.y) + w2 * bflo(c.y), w0 * bfhi(a.y) + w1 * bfhi(b.y) + w2 * bfhi(c.y));
        o.z = pk2(w0 * bflo(a.z) + w1 * bflo(b.z) + w2 * bflo(c.z), w0 * bfhi(a.z) + w1 * bfhi(b.z) + w2 * bfhi(c.z));
        o.w = pk2(w0 * bflo(a.w) + w1 * bflo(b.w) + w2 * bflo(c.w), w0 * bfhi(a.w) + w1 * bfhi(b.w) + w2 * bfhi(c.w));
        *(u32x4*)(CAT2 + (size_t)tok * 512 + j * 64 + c8 * 8) = o;
    }
}

__device__ __forceinline__ void ln_route(const Ctx& C, const Args& A, int layer) {
    const float* Y = (const float*)(C.ws + WS_Y); bf16_t* X1B = (bf16_t*)(C.ws + WS_X1B); unsigned char* X1F8 = C.ws + WS_X1F8;
    const float* lg = A.in[14] + layer * D; const float* lb = A.in[15] + layer * D; const float* wr = A.in[18]; const float* br = A.in[19];
    unsigned* cnt = (unsigned*)(C.ws + WS_CTL) + CW_CNT + layer * 16 * 64;
    int* tokE = (int*)(C.ws + WS_TOKE); int* tokP = (int*)(C.ws + WS_TOKP); float* tokG = (float*)(C.ws + WS_TOKG); int* list = (int*)(C.ws + WS_LIST);
    LAS float* wl = (LAS float*)C.lds;
    LAS int* sE = (LAS int*)(C.lds + 65536); LAS float* sG = (LAS float*)(C.lds + 65536 + 512); LAS int* sPos = (LAS int*)(C.lds + 65536 + 1024);
    LAS int* lcnt = (LAS int*)(C.lds + 65536 + 1536); LAS int* lbase = (LAS int*)(C.lds + 65536 + 1600);
    __syncthreads();
    for (int i = C.tid; i < 1024 * 16 / 4; i += NTHREADS) *(LAS f32x4*)(wl + 4 * i) = *(const f32x4*)(wr + 4 * i);
    const LAS float* wlane = wl + C.lane * 64;
    for (int blk = C.bid; blk < T / 64; blk += C.G) {
        __syncthreads();
        if (C.tid < 16) lcnt[C.tid] = 0;
        for (int ti = 0; ti < 8; ++ti) {
            const int tl = C.wave * 8 + ti, tok = blk * 64 + tl;
            f32x4 v[4]; float s = 0.f;
#pragma unroll
            for (int j = 0; j < 4; ++j) { v[j] = *(const f32x4*)(Y + (size_t)tok * D + 4 * C.lane + 256 * j); s += (v[j][0] + v[j][1]) + (v[j][2] + v[j][3]); }
            const float mean = wave_sum(s) * (1.f / D); float s2 = 0.f;
#pragma unroll
            for (int j = 0; j < 4; ++j) { v[j] = v[j] - mean; s2 += (v[j][0] * v[j][0] + v[j][1] * v[j][1]) + (v[j][2] * v[j][2] + v[j][3] * v[j][3]); }
            const float rstd = 1.0f / sqrtf(wave_sum(s2) * (1.f / D) + LN_EPS);
            float lgt[16];
#pragma unroll
            for (int e = 0; e < 16; ++e) lgt[e] = 0.f;
#pragma unroll
            for (int j = 0; j < 4; ++j) { const int col = 4 * C.lane + 256 * j; const f32x4 g4 = *(const f32x4*)(lg + col), b4 = *(const f32x4*)(lb + col);
                v[j] = v[j] * rstd * g4 + b4;
                *(u32x2*)(X1B + (size_t)tok * D + col) = (u32x2){pk2(v[j][0], v[j][1]), pk2(v[j][2], v[j][3])};
                *(unsigned*)(X1F8 + (size_t)tok * D + col) = pk4_fp8(v[j][0], v[j][1], v[j][2], v[j][3]);
#pragma unroll
                for (int c = 0; c < 4; ++c) { const float xv = v[j][c];
#pragma unroll
                    for (int e4 = 0; e4 < 4; ++e4) { const f32x4 w = *(const LAS f32x4*)(wlane + (256 * j + c) * 16 + 4 * e4);
                        lgt[4 * e4] += xv * w[0]; lgt[4 * e4 + 1] += xv * w[1]; lgt[4 * e4 + 2] += xv * w[2]; lgt[4 * e4 + 3] += xv * w[3]; } } }
            float mx = -INFINITY;
#pragma unroll
            for (int e = 0; e < 16; ++e) { lgt[e] = wave_sum(lgt[e]); mx = fmaxf(mx, lgt[e]); }
            float sum = 0.f;
#pragma unroll
            for (int e = 0; e < 16; ++e) { lgt[e] = __expf(lgt[e] - mx); sum += lgt[e]; }
            const float inv = 1.0f / sum; float sel[16];
#pragma unroll
            for (int e = 0; e < 16; ++e) { lgt[e] *= inv; sel[e] = lgt[e] + br[e]; }
            float gs[4];
#pragma unroll
            for (int g = 0; g < 4; ++g) { const float a = sel[4 * g], b = sel[4 * g + 1], c = sel[4 * g + 2], d = sel[4 * g + 3];
                gs[g] = fmaxf(fmaxf(fmaxf(a + b, a + c), fmaxf(a + d, b + c)), fmaxf(b + d, c + d)); }
            int gi = 0; float bsc = gs[0];
#pragma unroll
            for (int g = 1; g < 4; ++g) if (gs[g] > bsc) { bsc = gs[g]; gi = g; }
            float sg[4], pg[4];
#pragma unroll
            for (int k = 0; k < 4; ++k) { sg[k] = gi == 0 ? sel[k] : (gi == 1 ? sel[4 + k] : (gi == 2 ? sel[8 + k] : sel[12 + k])); pg[k] = gi == 0 ? lgt[k] : (gi == 1 ? lgt[4 + k] : (gi == 2 ? lgt[8 + k] : lgt[12 + k])); }
            int i1 = 0; float b1 = sg[0], p1 = pg[0];
#pragma unroll
            for (int k = 1; k < 4; ++k) if (sg[k] > b1) { b1 = sg[k]; i1 = k; p1 = pg[k]; }
            int i2 = -1; float b2 = -INFINITY, p2 = 0.f;
#pragma unroll
            for (int k = 0; k < 4; ++k) if (k != i1 && sg[k] > b2) { b2 = sg[k]; i2 = k; p2 = pg[k]; }
            if (C.lane == 0) { const float gsum = p1 + p2; sE[tl * 2] = gi * 4 + i1; sE[tl * 2 + 1] = gi * 4 + i2; sG[tl * 2] = p1 / gsum; sG[tl * 2 + 1] = p2 / gsum; }
        }
        __syncthreads();
        if (C.tid < 128) sPos[C.tid] = __hip_atomic_fetch_add(lcnt + sE[C.tid], 1, __ATOMIC_RELAXED, __HIP_MEMORY_SCOPE_WORKGROUP);
        __syncthreads();
        if (C.tid < 16) lbase[C.tid] = (int)__hip_atomic_fetch_add(cnt + C.tid * 64, (unsigned)lcnt[C.tid], __ATOMIC_RELAXED, __HIP_MEMORY_SCOPE_AGENT);
        __syncthreads();
        if (C.tid < 128) { const int e = sE[C.tid], pos = lbase[e] + sPos[C.tid], tok = blk * 64 + (C.tid >> 1);
            list[e * LISTCAP + pos] = tok; tokE[tok * 2 + (C.tid & 1)] = e; tokP[tok * 2 + (C.tid & 1)] = pos; tokG[tok * 2 + (C.tid & 1)] = sG[C.tid]; }
    }
}
__device__ __forceinline__ void moe_prefix(const Ctx& C, int layer) {
    LAS int* mi = (LAS int*)(C.lds + LDS_MISC);
    unsigned* cnt = (unsigned*)(C.ws + WS_CTL) + CW_CNT + layer * 16 * 64;
    __syncthreads();
    if (C.tid < 16) mi[17 + C.tid] = (int)__hip_atomic_load(cnt + C.tid * 64, __ATOMIC_RELAXED, __HIP_MEMORY_SCOPE_AGENT);
    __syncthreads();
    if (C.tid == 0) { int a = 0; for (int e = 0; e < 16; ++e) { mi[e] = a; a += (mi[17 + e] + 255) >> 8; } mi[16] = a; }
    __syncthreads();
}
__device__ __forceinline__ void moe_tokens(const Ctx& C, int ntn) {
    const LAS int* mi = (const LAS int*)(C.lds + LDS_MISC); LAS int* toks = (LAS int*)(C.lds + LDS_TOKS);
    const int* list = (const int*)(C.ws + WS_LIST);
    for (int u = 0; u < MAX_UNITS; ++u) {
        const int L = u * C.G + C.bid; if (L >= mi[16] * ntn) break;
        int e = 0;
#pragma unroll
        for (int j = 1; j < 16; ++j) e += (L >= mi[j] * ntn) ? 1 : 0;
        const int r = L - mi[e] * ntn, te = mi[e + 1] - mi[e], mt = r % te, cn = mi[17 + e];
        if (C.tid < 256) { int pos = mt * 256 + C.tid; pos = pos < cn ? pos : cn - 1; toks[u * 256 + C.tid] = list[e * LISTCAP + pos]; }
    }
    __syncthreads();
}
__device__ __forceinline__ void combine_ln2(const Ctx& C, const Args& A, int layer) {
    const LAS int* mi = (const LAS int*)(C.lds + LDS_MISC);
    const bf16_t* X1B = (const bf16_t*)(C.ws + WS_X1B); const bf16_t* YD = (const bf16_t*)(C.ws + WS_YD); bf16_t* X2B = (bf16_t*)(C.ws + WS_XB);
    const int* tokE = (const int*)(C.ws + WS_TOKE); const int* tokP = (const int*)(C.ws + WS_TOKP); const float* tokG = (const float*)(C.ws + WS_TOKG);
    const float* lg = A.in[16] + layer * D; const float* lb = A.in[17] + layer * D;
    for (int tok = C.gw; tok < T; tok += C.NGW) {
        const int e0 = tokE[tok * 2], e1 = tokE[tok * 2 + 1]; const float g0 = tokG[tok * 2], g1 = tokG[tok * 2 + 1];
        int tb0 = 0, tb1 = 0;
#pragma unroll
        for (int j = 0; j < 16; ++j) { const int t = mi[j]; tb0 = (e0 == j) ? t : tb0; tb1 = (e1 == j) ? t : tb1; }
        const size_t r0 = (size_t)tb0 * 256 + tokP[tok * 2], r1 = (size_t)tb1 * 256 + tokP[tok * 2 + 1];
        f32x4 v[4]; float s = 0.f;
#pragma unroll
        for (int j = 0; j < 4; ++j) { const int col = 4 * C.lane + 256 * j;
            const u32x2 a = *(const u32x2*)(X1B + (size_t)tok * D + col), y0 = *(const u32x2*)(YD + r0 * D + col), y1 = *(const u32x2*)(YD + r1 * D + col);
            v[j][0] = ALPHA * bflo(a.x) + (g0 * bflo(y0.x) + g1 * bflo(y1.x)); v[j][1] = ALPHA * bfhi(a.x) + (g0 * bfhi(y0.x) + g1 * bfhi(y1.x));
            v[j][2] = ALPHA * bflo(a.y) + (g0 * bflo(y0.y) + g1 * bflo(y1.y)); v[j][3] = ALPHA * bfhi(a.y) + (g0 * bfhi(y0.y) + g1 * bfhi(y1.y));
            s += (v[j][0] + v[j][1]) + (v[j][2] + v[j][3]); }
        const float mean = wave_sum(s) * (1.f / D); float s2 = 0.f;
#pragma unroll
        for (int j = 0; j < 4; ++j) { v[j] = v[j] - mean; s2 += (v[j][0] * v[j][0] + v[j][1] * v[j][1]) + (v[j][2] * v[j][2] + v[j][3] * v[j][3]); }
        const float rstd = 1.0f / sqrtf(wave_sum(s2) * (1.f / D) + LN_EPS);
#pragma unroll
        for (int j = 0; j < 4; ++j) { const int col = 4 * C.lane + 256 * j; const f32x4 g4 = *(const f32x4*)(lg + col), b4 = *(const f32x4*)(lb + col);
            const f32x4 o = v[j] * rstd * g4 + b4;
            if (layer == 0) *(u32x2*)(X2B + (size_t)tok * D + col) = (u32x2){pk2(o[0], o[1]), pk2(o[2], o[3])};
            else *(f32x4*)(A.out + (size_t)tok * D + col) = o; }
    }
}

__global__ void __launch_bounds__(NTHREADS, 2) yoco_fwd(Args args) {
    extern __shared__ __attribute__((aligned(16))) unsigned char lds_raw[];
    Ctx C;
    C.ws = args.ws; C.lds = (LAS unsigned char*)lds_raw;
    C.tid = threadIdx.x; C.lane = C.tid & 63; C.wave = __builtin_amdgcn_readfirstlane(C.tid >> 6);
    C.G = gridDim.x; C.bid = blockIdx.x; C.gw = C.bid * NWAVES + C.wave; C.NGW = C.G * NWAVES;
    unsigned char* ws = args.ws;
#define PHASE_WS() do { ws = launder(args.ws); C.ws = ws; C.tid = launder_v((int)threadIdx.x); C.lane = C.tid & 63; } while (0)
    volatile LAS unsigned* misc = (volatile LAS unsigned*)(C.lds + LDS_MISC);
    for (int u = C.tid; u < 64; u += NTHREADS) misc[u] = 0u;
    __syncthreads();
    XcdBarrier bar; bar.bar = (unsigned*)(ws + WS_CTL) + CW_BAR; bar.x = 0; bar.st = misc + 60;
    const int lo = args.ph_lo, hi = args.ph_hi;
    if (hi - lo > 1) bar = xcd_barrier_post((unsigned*)(ws + WS_CTL) + CW_BAR, misc + 60);
#define IN(k) (lo <= (k) && (k) < hi)
#define SEAM(k) do { if (IN(k) && IN((k) + 1)) xcd_barrier(bar); } while (0)
#ifndef MK_DUP
#define MK_DUP 0
#endif
#define REP(k) for (int rep_ = 0; rep_ < 1 + ((MK_DUP >> (k)) & 1); ++rep_)

    if (IN(0)) { REP(0) { PHASE_WS(); p0_prologue(C, args); } SEAM(0); }

    if (IN(1)) {
        REP(1) {
        PHASE_WS();
        { pg8::Gemm g{(const bf16_t*)(ws + WS_XB), (const bf16_t*)(ws + WS_BT_INA), T, 1792, D}; pg8::StaticOrder S; S.init(T, 1792, C.G, C.bid);
          EpiProjA E{(bf16_t*)(ws + WS_U), (bf16_t*)(ws + WS_GV), (bf16_t*)(ws + WS_QM0)};
          pg8::gemm_phase<EpiProjA, pg8::StaticOrder>(C.lds, g, S, E, nullptr, C.tid); }
        { pg8::Gemm g{(const bf16_t*)(ws + WS_MEMB), (const bf16_t*)(ws + WS_BT_MEM), NB * NMEM, 1024, D}; SmallOrder S{4, 32, C.bid - (C.G - 32)};
          EpiPlain E{(bf16_t*)(ws + WS_MKV), 1024, 4};
          pg8::gemm_phase<EpiPlain, SmallOrder>(C.lds, g, S, E, nullptr, C.tid); }
        }
        SEAM(1);
    }
    if (IN(2)) {
        REP(2) { PHASE_WS();
        sg_mfma(C, args);
        memattn_mfma(C, (const bf16_t*)(ws + WS_QM0), (const bf16_t*)(ws + WS_MKV), 0, 256, (bf16_t*)(ws + WS_CAT), D, SGW); }
        SEAM(2);
    }
    if (IN(3)) {
        REP(3) { PHASE_WS();
        pg8::Gemm g{(const bf16_t*)(ws + WS_CAT), (const bf16_t*)(ws + WS_BT_OUTA), T, D, D}; pg8::StaticOrder S; S.init(T, D, C.G, C.bid);
        EpiResid<false> E{(const void*)args.in[0], (float*)(ws + WS_Y)};
        pg8::gemm_phase<EpiResid<false>, pg8::StaticOrder>(C.lds, g, S, E, nullptr, C.tid); }
        SEAM(3);
    }
    { constexpr int layer = 0;
        const int pb = 4 + 8 * layer;
        if (IN(pb)) { PHASE_WS(); ln_route(C, args, layer); SEAM(pb); }
        if (IN(pb + 1)) {
            REP(5) { PHASE_WS();
            moe_prefix(C, layer); moe_tokens(C, 8);
            MoeGatherOrder S; S.tb = (const LAS int*)(C.lds + LDS_MISC); S.ntn = 8; S.G = C.G; S.c = C.bid; S.toks = (const LAS int*)(C.lds + LDS_TOKS);
            {
                pg8::Gemm g{(const bf16_t*)(ws + WS_X1F8), (const bf16_t*)(ws + WS_WGU + (size_t)layer * (64 * MiB)), 0, 0, D / 2, E8_ONE, E8_W};
                EpiSwiGLU8 E{ws + WS_ACT};
                pg8::gemm_phase<EpiSwiGLU8, MoeGatherOrder, false, true>(C.lds, g, S, E, nullptr, C.tid);
            } }
            SEAM(pb + 1);
        }
        if (IN(pb + 2)) {
            REP(6) { PHASE_WS();
            moe_prefix(C, layer);
            MoeOrder S{(const LAS int*)(C.lds + LDS_MISC), 4, C.G, C.bid};
            EpiPlain E{(bf16_t*)(ws + WS_YD), 1024, 4};
            {
                pg8::Gemm g{(const bf16_t*)(ws + WS_ACT), (const bf16_t*)(ws + WS_WD + (size_t)layer * (32 * MiB)), 0, 0, D / 2, E8_ACT, E8_W};
                pg8::gemm_phase<EpiPlain, MoeOrder, false, true>(C.lds, g, S, E, nullptr, C.tid);
            } }
            SEAM(pb + 2);
        }
        if (IN(pb + 3)) { REP(7) { PHASE_WS(); moe_prefix(C, layer); combine_ln2(C, args, layer); } if (layer == 0) SEAM(pb + 3); }
    }
    {
            if (IN(8)) {
                REP(8) { PHASE_WS();
                pg8::Gemm g{(const bf16_t*)(ws + WS_XB), (const bf16_t*)(ws + WS_BT_B), T, 2560, D}; pg8::StaticOrder S; S.init(T, 2560, C.G, C.bid);
                EpiProjB E{(bf16_t*)(ws + WS_K), (bf16_t*)(ws + WS_V), (bf16_t*)(ws + WS_Q), (bf16_t*)(ws + WS_QM1)};
                pg8::gemm_phase<EpiProjB, pg8::StaticOrder>(C.lds, g, S, E, nullptr, C.tid); }
                SEAM(8);
            }
            if (IN(9)) {
                REP(9) { PHASE_WS();
                dilattn_mfma(C);
                memattn_mfma(C, (const bf16_t*)(ws + WS_QM1), (const bf16_t*)(ws + WS_MKV), 512, 768, (bf16_t*)(ws + WS_CAT2), 512, 256); }
                SEAM(9);
            }
            if (IN(10)) { REP(10) { PHASE_WS(); dil_merge(C, args); } SEAM(10); }
            if (IN(11)) {
                REP(11) { PHASE_WS();
                pg8::Gemm g{(const bf16_t*)(ws + WS_CAT2), (const bf16_t*)(ws + WS_BT_OUTB), T, D, 512}; pg8::StaticOrder S; S.init(T, D, C.G, C.bid);
                EpiResid<true> E{(const void*)(ws + WS_XB), (float*)(ws + WS_Y)};
                pg8::gemm_phase<EpiResid<true>, pg8::StaticOrder>(C.lds, g, S, E, nullptr, C.tid); }
                SEAM(11);
            }
    }
    { constexpr int layer = 1;
        const int pb = 4 + 8 * layer;
        if (IN(pb)) { PHASE_WS(); ln_route(C, args, layer); SEAM(pb); }
        if (IN(pb + 1)) {
            REP(5) { PHASE_WS();
            moe_prefix(C, layer); moe_tokens(C, 8);
            MoeGatherOrder S; S.tb = (const LAS int*)(C.lds + LDS_MISC); S.ntn = 8; S.G = C.G; S.c = C.bid; S.toks = (const LAS int*)(C.lds + LDS_TOKS);
            {
                pg8::Gemm g{(const bf16_t*)(ws + WS_X1F8), (const bf16_t*)(ws + WS_WGU + (size_t)layer * (64 * MiB)), 0, 0, D / 2, E8_ONE, E8_W};
                EpiSwiGLU8 E{ws + WS_ACT};
                pg8::gemm_phase<EpiSwiGLU8, MoeGatherOrder, false, true>(C.lds, g, S, E, nullptr, C.tid);
            } }
            SEAM(pb + 1);
        }
        if (IN(pb + 2)) {
            REP(6) { PHASE_WS();
            moe_prefix(C, layer);
            MoeOrder S{(const LAS int*)(C.lds + LDS_MISC), 4, C.G, C.bid};
            EpiPlain E{(bf16_t*)(ws + WS_YD), 1024, 4};
            {
                pg8::Gemm g{(const bf16_t*)(ws + WS_ACT), (const bf16_t*)(ws + WS_WD + (size_t)layer * (32 * MiB)), 0, 0, D / 2, E8_ACT, E8_W};
                pg8::gemm_phase<EpiPlain, MoeOrder, false, true>(C.lds, g, S, E, nullptr, C.tid);
            } }
            SEAM(pb + 2);
        }
        if (IN(pb + 3)) { REP(7) { PHASE_WS(); moe_prefix(C, layer); combine_ln2(C, args, layer); } if (layer == 0) SEAM(pb + 3); }
    }
#undef IN
#undef SEAM
}
}

extern "C" void kernel_launch(void* const* d_in, const int* in_sizes, int n_in, void* d_out, int out_size, void* d_ws, size_t ws_size, hipStream_t stream) {
    using namespace mk;
    static int grid = 0;
    if (grid == 0) {
        if (n_in != 23 || out_size != T * D || ws_size < WS_END) { fprintf(stderr, "kernel_launch: unexpected shapes (n_in %d, out %d, ws %zu)\n", n_in, out_size, ws_size); grid = -1; return; }
        int dev = 0, cus = 0, per_cu = 0;
        if (hipGetDevice(&dev) != hipSuccess || hipDeviceGetAttribute(&cus, hipDeviceAttributeMultiprocessorCount, dev) != hipSuccess) { grid = -1; return; }
        if (hipFuncSetAttribute((const void*)yoco_fwd, hipFuncAttributeMaxDynamicSharedMemorySize, LDS_BYTES) != hipSuccess) { fprintf(stderr, "kernel_launch: hipFuncSetAttribute failed\n"); grid = -1; return; }
        if (hipOccupancyMaxActiveBlocksPerMultiprocessor(&per_cu, (const void*)yoco_fwd, NTHREADS, LDS_BYTES) != hipSuccess || per_cu < 1)
            fprintf(stderr, "kernel_launch: occupancy query reports %d workgroups per CU\n", per_cu);
        (void)hipGetLastError();
        grid = cus;
    }
    if (grid < 0) return;
    (void)hipMemsetAsync((char*)d_ws + WS_CTL, 0, CTL_ZERO_BYTES, stream);
    Args a{};
    for (int i = 0; i < 23; ++i) a.in[i] = (const float*)d_in[i];
    a.out = (float*)d_out; a.ws = (unsigned char*)d_ws;
    constexpr int NL = MK_N_LAUNCHES;
    for (int li = 0; li < NL; ++li) {
        a.ph_lo = (NL == NPHASE) ? li : (li * NPHASE) / NL; a.ph_hi = (NL == NPHASE) ? li + 1 : ((li + 1) * NPHASE) / NL;
        hipLaunchKernelGGL(yoco_fwd, dim3(grid), dim3(NTHREADS), LDS_BYTES, stream, a);
    }
}
```

```cpp
#include <hip/hip_runtime.h>
#include <cstdio>
#include <cstdint>
namespace pg8 {
#define PG8_LAS __attribute__((address_space(3)))
typedef unsigned short bf16_t;
typedef short bf16x8 __attribute__((ext_vector_type(8)));
typedef float f32x4 __attribute__((ext_vector_type(4)));
typedef unsigned u32x4 __attribute__((ext_vector_type(4)));
constexpr int BM = 256, BK = 64, HALF = 128, HTB = HALF * BK * 2  , STAGE_BYTES = 8 * HTB, NXCD = 8, WGM = 8;

__host__ __device__ __forceinline__ int lds_byte(int r, int c) { const int st = (r >> 4) * 2 + (c >> 5), rr = r & 15, cc = c & 31, ob = rr * 64 + cc * 2; return st * 1024 + (ob ^ (((ob >> 9) & 1) << 5)); }
__host__ __device__ __forceinline__ void stage_rc(int b, int& R, int& C) { const int st = b / 1024, sb = b % 1024, swz = sb ^ (((sb >> 9) & 1) << 5); R = (st >> 1) * 16 + swz / 64; C = (st & 1) * 32 + (swz % 64) / 2; }
__host__ __device__ __forceinline__ int perm32(int rho) { const int n = rho >> 4, i = rho & 15; return 8 * (i >> 2) + 4 * n + (i & 3); }

struct Unit { int pm, pn; };
struct Gemm { const bf16_t* A; const bf16_t* Bt; int M, N, K; int sA, sB; };

struct StaticOrder {
    int nM, nN, nwg, G, c;
    __host__ __device__ void init(int M, int N, int G_, int c_) { nM = M / BM; nN = N / BM; nwg = nM * nN; G = G_; c = c_; }
    __host__ __device__ bool next(int i, Unit& u) const {
        const long L = (long)i * G + c; if (L >= nwg) return false;
        int wgid = (int)L; { const int q = nwg / NXCD, r = nwg % NXCD, xcd = wgid % NXCD, off = wgid / NXCD; wgid = (xcd < r ? xcd * (q + 1) : r * (q + 1) + (xcd - r) * q) + off; }
        const int nig = WGM * nN, gid = wgid / nig, fm = gid * WGM, gsz = (nM - fm) < WGM ? (nM - fm) : WGM;
        u.pm = fm + ((wgid % nig) % gsz); u.pn = (wgid % nig) / gsz; return true;
    }
    __device__ __forceinline__ void a_ready(const Unit&) const {}
    __device__ __forceinline__ void done(const Unit&) const {}
    __device__ __forceinline__ int arow(int, const Unit& u, int r) const { return u.pm * BM + r; }
};
__device__ __forceinline__ unsigned cvt_pk_bf16(float lo, float hi) { unsigned r; asm volatile("v_cvt_pk_bf16_f32 %0, %1, %2" : "=v"(r) : "v"(lo), "v"(hi)); return r; }
typedef float f32x2 __attribute__((ext_vector_type(2)));
__device__ __forceinline__ f32x2 gelu_pk(f32x2 v) {
    const f32x2 av = __builtin_elementwise_abs(v), d = av * 0.2316418882f + 1.0f;
    f32x2 t; t.x = __builtin_amdgcn_rcpf(d.x); t.y = __builtin_amdgcn_rcpf(d.y);
    f32x2 q = t * 0.5307027145f + (-0.7265760135f); q = q * t + 0.7107068705f; q = q * t + (-0.142248368f); q = q * t + 0.127414796f; q = q * t;
    const f32x2 s = (v * v) * (-0.72134752044f);
    f32x2 e; e.x = __builtin_amdgcn_exp2f(s.x); e.y = __builtin_amdgcn_exp2f(s.y);
    const f32x2 m = v * (q * e), r = v - m;
    f32x2 o; o.x = v.x < 0.f ? m.x : r.x; o.y = v.y < 0.f ? m.y : r.y; return o;
}
template <class Epi, class Sched, bool STAMP = false, bool F8 = false>
__device__ __forceinline__ void gemm_phase(PG8_LAS unsigned char* lds, const Gemm g, const Sched& S, const Epi& E, unsigned long long* stamps, const int tid) {
    const int wid = __builtin_amdgcn_readfirstlane(tid >> 6), lane = tid & 63, wr = wid >> 2, wc = wid & 3, fr = lane & 15, fq = lane >> 4;
    const int K = g.K, nt = K / BK;
    int ts_lo = 0, ts_hi = 0, nts = 0; const unsigned long long rt_entry = STAMP ? (unsigned long long)wall_clock64() : 0ull;
#define PG8_STAMP() do { if (STAMP && wid == 0 && nts < 64) { const unsigned long long _c = (unsigned long long)clock64(); \
        ts_lo = (lane == nts) ? (int)(unsigned)_c : ts_lo; ts_hi = (lane == nts) ? (int)(unsigned)(_c >> 32) : ts_hi; ++nts; } } while (0)
    PG8_STAMP();
    unsigned colA[2], voffB[2]; int rowA[2];
#pragma unroll
    for (int i = 0; i < 2; ++i) { int R, C; stage_rc(tid * 16 + i * 8192, R, C); const int Rb = Epi::PERM ? ((R & ~31) + perm32(R & 31)) : R;
        rowA[i] = R; colA[i] = (unsigned)C * 2u; voffB[i] = (unsigned)(Rb * K + C) * 2u; }
#define PG8_AOFF(dst, uidx, un) do { _Pragma("unroll") for (int _h = 0; _h < 2; ++_h) _Pragma("unroll") for (int _i = 0; _i < 2; ++_i) \
        dst[_h][_i] = (unsigned)S.arow((uidx), (un), _h * HALF + rowA[_i]) * (unsigned)(K * 2) + colA[_i]; } while (0)
    const size_t kstep = (size_t)(BK * 2);
    const size_t hstep = (size_t)HALF * K * 2;
    const size_t tstep = 2 * hstep;
    const unsigned ldsw = (unsigned)wid * 1024u;
    const int aoff = F8 ? lds_byte(wr * 64 + fr, fq * 16) : lds_byte(wr * 64 + fr, fq * 8), boff = F8 ? lds_byte(wc * 32 + fr, fq * 16) : lds_byte(wc * 32 + fr, fq * 8);
    constexpr int KOFF = F8 ? 16 : 1024;
#define PG8_SA(b, h) (((b) * 2 + (h)) * HTB)
#define PG8_SB(b, h) ((4 + (b) * 2 + (h)) * HTB)
#define PG8_STAGE(bufoff, gbase, voff) do { _Pragma("unroll") for (int _i = 0; _i < 2; ++_i) \
        __builtin_amdgcn_global_load_lds((const unsigned*)((const char*)(gbase) + (voff)[_i]), (PG8_LAS unsigned*)(lds + (bufoff) + ldsw + _i * 8192), 16, 0, 0); } while (0)
#define PG8_LDA(dst, b, h) do { _Pragma("unroll") for (int m = 0; m < 4; ++m) _Pragma("unroll") for (int k = 0; k < 2; ++k) dst[m][k] = *(const PG8_LAS bf16x8*)(lds + PG8_SA(b, h) + aoff + m * 2048 + k * KOFF); } while (0)
#define PG8_LDB(dst, b, h) do { _Pragma("unroll") for (int n = 0; n < 2; ++n) _Pragma("unroll") for (int k = 0; k < 2; ++k) dst[n][k] = *(const PG8_LAS bf16x8*)(lds + PG8_SB(b, h) + boff + n * 2048 + k * KOFF); } while (0)
#define PG8_MMA(ai, bj, At, Bt) do { __builtin_amdgcn_s_setprio(1); \
        if constexpr (F8) { _Pragma("unroll") for (int m = 0; m < 4; ++m) _Pragma("unroll") for (int n = 0; n < 2; ++n) { \
            typedef int i32x4_ __attribute__((ext_vector_type(4))); typedef int i32x8_ __attribute__((ext_vector_type(8))); \
            const i32x8_ b8_ = __builtin_shufflevector(__builtin_bit_cast(i32x4_, Bt[n][0]), __builtin_bit_cast(i32x4_, Bt[n][1]), 0, 1, 2, 3, 4, 5, 6, 7); \
            const i32x8_ a8_ = __builtin_shufflevector(__builtin_bit_cast(i32x4_, At[m][0]), __builtin_bit_cast(i32x4_, At[m][1]), 0, 1, 2, 3, 4, 5, 6, 7); \
            acc[ai][bj][m][n] = __builtin_amdgcn_mfma_scale_f32_16x16x128_f8f6f4(b8_, a8_, acc[ai][bj][m][n], 0, 0, 0, g.sB, 0, g.sA); } } \
        else { _Pragma("unroll") for (int m = 0; m < 4; ++m) _Pragma("unroll") for (int n = 0; n < 2; ++n) _Pragma("unroll") for (int k = 0; k < 2; ++k) \
            acc[ai][bj][m][n] = __builtin_amdgcn_mfma_f32_16x16x32_bf16(Bt[n][k], At[m][k], acc[ai][bj][m][n], 0, 0, 0); } \
        __builtin_amdgcn_s_setprio(0); } while (0)
#define PG8_WAIT_V(n) asm volatile("s_waitcnt vmcnt(" #n ")" ::: "memory")
#define PG8_WAIT_L(n) asm volatile("s_waitcnt lgkmcnt(" #n ")" ::: "memory")
#define PG8_BAR __builtin_amdgcn_s_barrier()
#define PG8_SCHED __builtin_amdgcn_sched_barrier(0)
    Unit cur, nxt; int ui = 0;
    if (!S.next(0, cur)) return;
    f32x4 acc[2][2][4][2];
#pragma unroll
    for (int a = 0; a < 2; ++a)
#pragma unroll
        for (int b = 0; b < 2; ++b)
#pragma unroll
            for (int m = 0; m < 4; ++m)
#pragma unroll
                for (int n = 0; n < 2; ++n) acc[a][b][m][n] = (f32x4){0.f, 0.f, 0.f, 0.f};
    bf16x8 At[4][2], B0[2][2], B1[2][2];
    const char* Ab = (const char*)g.A; const char* cB = (const char*)g.Bt + (size_t)cur.pn * tstep;
    unsigned cuA[2][2];
    S.a_ready(cur);
    PG8_AOFF(cuA, 0, cur);
    PG8_STAGE(PG8_SB(0, 0), cB, voffB); PG8_STAGE(PG8_SA(0, 0), Ab, cuA[0]); PG8_STAGE(PG8_SB(0, 1), cB + hstep, voffB); PG8_STAGE(PG8_SA(0, 1), Ab, cuA[1]);
    if (wr == 1) PG8_BAR;
    PG8_WAIT_V(4); PG8_BAR;
    PG8_STAGE(PG8_SB(1, 0), cB + kstep, voffB); PG8_STAGE(PG8_SA(1, 0), Ab + kstep, cuA[0]); PG8_STAGE(PG8_SB(1, 1), cB + hstep + kstep, voffB);
    PG8_WAIT_V(6); PG8_BAR;
    PG8_STAMP();
    for (;;) {
        const bool has_next = S.next(ui + 1, nxt);
        const char* nB = has_next ? (const char*)g.Bt + (size_t)nxt.pn * tstep : cB;
        for (int t = 0; t < nt; t += 2) {
            const bool last = (t == nt - 2);
            const char* a1 = Ab + (size_t)(t + 1) * kstep;
            const char* a2 = last ? Ab : Ab + (size_t)(t + 2) * kstep; const char* b2 = last ? nB : cB + (size_t)(t + 2) * kstep;
            const char* a3 = a2 + kstep; const char* b3 = b2 + kstep;

            if (last && has_next) S.a_ready(nxt);
            PG8_LDB(B0, 0, 0); PG8_SCHED; PG8_LDA(At, 0, 0); PG8_STAGE(PG8_SA(1, 1), a1, cuA[1]);
            PG8_WAIT_L(8); PG8_BAR; PG8_WAIT_L(0); PG8_MMA(0, 0, At, B0); PG8_BAR; PG8_SCHED;
            if (last && has_next) PG8_AOFF(cuA, ui + 1, nxt);
            PG8_LDB(B1, 0, 1); PG8_STAGE(PG8_SB(0, 0), b2, voffB);
            PG8_BAR; PG8_WAIT_L(0); PG8_MMA(0, 1, At, B1); PG8_BAR;
            PG8_LDA(At, 0, 1); PG8_STAGE(PG8_SA(0, 0), a2, cuA[0]);
            PG8_BAR; PG8_WAIT_L(0); PG8_MMA(1, 0, At, B0); PG8_BAR; PG8_SCHED;
            PG8_STAGE(PG8_SB(0, 1), b2 + hstep, voffB);
            PG8_WAIT_V(6); PG8_BAR; PG8_MMA(1, 1, At, B1); PG8_BAR;
            PG8_LDB(B0, 1, 0); PG8_SCHED; PG8_LDA(At, 1, 0); PG8_STAGE(PG8_SA(0, 1), a2, cuA[1]);
            PG8_WAIT_L(8); PG8_BAR; PG8_WAIT_L(0); PG8_MMA(0, 0, At, B0); PG8_BAR; PG8_SCHED;
            PG8_LDB(B1, 1, 1); PG8_STAGE(PG8_SB(1, 0), b3, voffB);
            PG8_BAR; PG8_WAIT_L(0); PG8_MMA(0, 1, At, B1); PG8_BAR;
            PG8_LDA(At, 1, 1); PG8_STAGE(PG8_SA(1, 0), a3, cuA[0]);
            PG8_BAR; PG8_WAIT_L(0); PG8_MMA(1, 0, At, B0); PG8_BAR; PG8_SCHED;
            PG8_STAGE(PG8_SB(1, 1), b3 + hstep, voffB);
            PG8_WAIT_V(6); PG8_BAR; PG8_MMA(1, 1, At, B1); PG8_BAR;
        }
        PG8_STAMP();
        if constexpr (!Epi::AFTER_DRAIN) { E(acc, cur, wr, wc, fr, fq); S.done(cur); }
        PG8_STAMP();
        if (!has_next) break;
#pragma unroll
        for (int a = 0; a < 2; ++a)
#pragma unroll
            for (int b = 0; b < 2; ++b)
#pragma unroll
                for (int m = 0; m < 4; ++m)
#pragma unroll
                    for (int n = 0; n < 2; ++n) acc[a][b][m][n] = (f32x4){0.f, 0.f, 0.f, 0.f};
        cur = nxt; cB = nB; ++ui;
    }
    PG8_WAIT_V(0);
    if (wr == 0) PG8_BAR;
    PG8_BAR;
    if constexpr (Epi::AFTER_DRAIN) { E.fused(acc, cur, wr, wc, fr, fq, lds, wid, lane); S.done(cur); }
    PG8_STAMP();
    if (STAMP && wid == 0) { stamps[lane] = lane < nts ? (((unsigned long long)(unsigned)ts_hi << 32) | (unsigned)ts_lo) : 0ull;
        if (lane == 62) stamps[62] = rt_entry; if (lane == 63) stamps[63] = (unsigned long long)wall_clock64(); }
#undef PG8_STAMP
#undef PG8_SA
#undef PG8_SB
#undef PG8_STAGE
#undef PG8_AOFF
#undef PG8_LDA
#undef PG8_LDB
#undef PG8_MMA
#undef PG8_WAIT_V
#undef PG8_WAIT_L
#undef PG8_BAR
#undef PG8_SCHED
}
}

namespace mk {
using pg8::bf16_t; using pg8::f32x4; using pg8::u32x4; using pg8::Unit; using pg8::cvt_pk_bf16;
#define LAS __attribute__((address_space(3)))
typedef float f32x2 __attribute__((ext_vector_type(2)));
typedef unsigned u32x2 __attribute__((ext_vector_type(2)));

#ifndef MK_N_LAUNCHES
#define MK_N_LAUNCHES 1
#endif
constexpr int NPHASE = 16;
constexpr int NB = 8, SEQ = 2048, D = 1024, T = NB * SEQ, NMEM = 256, SGW = 768, NSG = 12, HD = 64, CH = 128;
constexpr int NEXP = 16, LISTCAP = 16384;
constexpr float ALPHA = 1.41421356237f;
constexpr float LN_EPS = 1e-5f, ATT_SCALE = 0.125f;
constexpr int NWAVES = 8, NTHREADS = 512;

constexpr size_t MiB = 1u << 20;
constexpr size_t WS_CTL = 0, CTL_ZERO_BYTES = 1 * MiB;
constexpr size_t WS_TOKE = 1 * MiB, WS_TOKP = WS_TOKE + 128 * 1024, WS_TOKG = WS_TOKP + 128 * 1024;
constexpr size_t WS_LIST = 2 * MiB, WS_LSE = 3 * MiB, WS_SGWB = 4 * MiB;
constexpr size_t WS_MKV = 8 * MiB, WS_MEMB = 12 * MiB;
constexpr size_t WS_BT_INA = 18 * MiB, WS_BT_OUTA = 22 * MiB, WS_BT_B = 24 * MiB, WS_BT_OUTB = 29 * MiB, WS_BT_MEM = 30 * MiB;
constexpr size_t WS_WGU = 32 * MiB, WS_WD = 160 * MiB;
constexpr size_t WS_A = 224 * MiB;
constexpr size_t WS_U = WS_A, WS_GV = WS_A + 24 * MiB, WS_QM0 = WS_A + 48 * MiB;
constexpr size_t WS_K = WS_A, WS_V = WS_A + 24 * MiB, WS_Q = WS_A + 48 * MiB, WS_QM1 = WS_A + 72 * MiB;
constexpr size_t WS_ACT = WS_A;
constexpr size_t WS_XB = 304 * MiB;
constexpr size_t WS_C = 336 * MiB;
constexpr size_t WS_CAT = WS_C, WS_OG = WS_C, WS_CAT2 = WS_C + 24 * MiB;
constexpr size_t WS_Y = 376 * MiB;
constexpr size_t WS_YD = 336 * MiB;
constexpr size_t WS_X1B = 440 * MiB;
constexpr size_t WS_X1F8 = 472 * MiB;
constexpr size_t WS_END = 488 * MiB;
constexpr size_t WS_WGU8 = WS_WGU + 64 * MiB, WS_WD8 = WS_WD + 32 * MiB;
constexpr int CW_TMO = 0, CW_BAR = 4096, CW_CNT = 16384;
constexpr int LDS_TOKS = 131072 + 1024, MAX_UNITS = 8;
constexpr int LDS_MISC = 131072;
constexpr int LDS_BYTES = 147456;
static_assert(LDS_TOKS + MAX_UNITS * 1024 <= LDS_BYTES, "LDS map");

#define LDS_WAIT() asm volatile("s_waitcnt lgkmcnt(0)" ::: "memory")
#define VM_WAIT() asm volatile("s_waitcnt vmcnt(0)" ::: "memory")
__device__ __forceinline__ unsigned f2bf(float f) { unsigned u = __builtin_bit_cast(unsigned, f); return (u + 0x7fffu + ((u >> 16) & 1u)) >> 16; }
__device__ __forceinline__ unsigned pk2(float lo, float hi) { return f2bf(lo) | (f2bf(hi) << 16); }
__device__ __forceinline__ unsigned pk4_fp8_e(float a, float b, float c, float d) { int r = 0; r = __builtin_amdgcn_cvt_pk_fp8_f32(a, b, r, false); r = __builtin_amdgcn_cvt_pk_fp8_f32(c, d, r, true); return (unsigned)r; }
__device__ __forceinline__ float bflo(unsigned w) { return __uint_as_float(w << 16); }
__device__ __forceinline__ float bfhi(unsigned w) { return __uint_as_float(w & 0xffff0000u); }
__device__ __forceinline__ float bf1(bf16_t v) { return __uint_as_float(((unsigned)v) << 16); }
__device__ __forceinline__ float wave_sum(float v) {
#pragma unroll
    for (int o = 1; o < 64; o <<= 1) v += __shfl_xor(v, o);
    return v;
}
__device__ __forceinline__ float wave_max(float v) {
#pragma unroll
    for (int o = 1; o < 64; o <<= 1) v = fmaxf(v, __shfl_xor(v, o));
    return v;
}

#define XB_TMO      128
#define XB_XCNT(j)  (256  + 64 * (j))
#define XB_XSUB(j)  (1280 + 64 * (j))
#define XB_XGEN(j)  (2304 + 64 * (j))
#define XB_TOP      3328
#define XB_TOPGEN   3392
#define XCD_BAR_WORDS 3456
#define XB_SPIN_CAP (1u << 18)
__device__ __forceinline__ unsigned xb_ld(unsigned* p)              { return __hip_atomic_load(p, __ATOMIC_RELAXED, __HIP_MEMORY_SCOPE_AGENT); }
__device__ __forceinline__ unsigned xb_add(unsigned* p, unsigned v) { return __hip_atomic_fetch_add(p, v, __ATOMIC_RELAXED, __HIP_MEMORY_SCOPE_AGENT); }
__device__ __forceinline__ unsigned xb_xcc_id() { return (unsigned)__builtin_amdgcn_s_getreg((3 << 11) | 20) & 0xFu; }
#define XB_SPIN(cond, bar) do { unsigned _sp = 0; while (cond) { __builtin_amdgcn_s_sleep(1); \
    if ((++_sp & 255u) == 0u) { if (xb_ld(&(bar)[XB_TMO])) break; if (_sp > XB_SPIN_CAP) { atomicAdd(&(bar)[XB_TMO], 1u); break; } } } } while (0)
struct XcdBarrier { unsigned* bar; unsigned x; volatile LAS unsigned* st; };
__device__ __forceinline__ XcdBarrier xcd_barrier_post(unsigned* bar, volatile LAS unsigned* st) {
    XcdBarrier b; b.bar = bar; b.x = xb_xcc_id(); b.st = st;
    if (threadIdx.x == 0) (void)xb_add(&bar[XB_XCNT(b.x)], 1u);
    return b;
}
__device__ __forceinline__ void xcd_barrier_complete(unsigned* bar, unsigned x, unsigned& nloc, unsigned& nx) {
    const unsigned G = gridDim.x * gridDim.y * gridDim.z;
    unsigned sum, cnt, mine, sp = 0u;
    for (;;) {
        sum = 0u; cnt = 0u; mine = 0u;
#pragma unroll
        for (unsigned j = 0; j < 16; ++j) { const unsigned c = xb_ld(&bar[XB_XCNT(j)]); sum += c; cnt += (c > 0u) ? 1u : 0u; mine = (j == x) ? c : mine; }
        if (sum == G) break;
        __builtin_amdgcn_s_sleep(1);
        if ((++sp & 255u) == 0u) { if (xb_ld(&bar[XB_TMO])) break; if (sp > XB_SPIN_CAP) { atomicAdd(&bar[XB_TMO], 1u); break; } }
    }
    nloc = mine > 0u ? mine : 1u; nx = cnt > 0u ? cnt : 1u;
}
__device__ __forceinline__ void xcd_barrier(const XcdBarrier& b) {
    asm volatile("s_waitcnt vmcnt(0)" ::: "memory");
    __syncthreads();
    if (threadIdx.x == 0) {
        unsigned* bar = b.bar;
        __builtin_amdgcn_s_waitcnt(0);
        unsigned nloc = b.st[0], nx = b.st[1];
        if (nloc == 0u) { xcd_barrier_complete(bar, b.x, nloc, nx); b.st[0] = nloc; b.st[1] = nx; }
        const unsigned old = xb_add(&bar[XB_XSUB(b.x)], 1u);
        const unsigned gen = old / nloc;
        if (old + 1u == (gen + 1u) * nloc) {
            __builtin_amdgcn_fence(__ATOMIC_RELEASE, "agent");
            asm volatile("s_waitcnt vmcnt(0)" ::: "memory");
            const unsigned og = xb_add(&bar[XB_TOP], 1u);
            const unsigned tg = og / nx;
            if (og + 1u == (tg + 1u) * nx) xb_add(&bar[XB_TOPGEN], 1u);
            else XB_SPIN(xb_ld(&bar[XB_TOPGEN]) == tg, bar);
            __builtin_amdgcn_fence(__ATOMIC_ACQUIRE, "agent");
            xb_add(&bar[XB_XGEN(b.x)], 1u);
            asm volatile("s_waitcnt vmcnt(0)" ::: "memory");
        } else {
            XB_SPIN(xb_ld(&bar[XB_XGEN(b.x)]) == gen, bar);
            __builtin_amdgcn_fence(__ATOMIC_ACQUIRE, "agent");
            asm volatile("s_waitcnt vmcnt(0)" ::: "memory");
        }
    }
    __syncthreads();
}


struct EpiProjA {
    static constexpr bool PERM = true, AFTER_DRAIN = false;
    bf16_t *u, *gv, *qm;
    __device__ __forceinline__ void operator()(const f32x4 (&acc)[2][2][4][2], const Unit& un, int wr, int wc, int fr, int fq) const {
        const int row0 = un.pm * 256 + wr * 64 + fr;
        bf16_t* base; int ldc, colt; bool act; float sc = 1.f;
        if (un.pn < 3) { base = u; ldc = SGW; colt = un.pn * 256; act = true; }
        else if (un.pn < 6) { base = gv; ldc = SGW; colt = (un.pn - 3) * 256; act = true; }
        else { base = qm; ldc = 256; colt = 0; act = false; sc = ATT_SCALE; }
        const int col0 = colt + wc * 32 + 8 * fq;
#pragma unroll
        for (int ai = 0; ai < 2; ++ai)
#pragma unroll
            for (int m = 0; m < 4; ++m) { bf16_t* rowp = base + (size_t)(row0 + ai * 128 + m * 16) * ldc + col0;
#pragma unroll
                for (int bj = 0; bj < 2; ++bj) { f32x4 v0 = acc[ai][bj][m][0], v1 = acc[ai][bj][m][1];
                    if (act) { pg8::f32x2 a = pg8::gelu_pk((pg8::f32x2){v0[0], v0[1]}), b = pg8::gelu_pk((pg8::f32x2){v0[2], v0[3]}), c = pg8::gelu_pk((pg8::f32x2){v1[0], v1[1]}), d = pg8::gelu_pk((pg8::f32x2){v1[2], v1[3]});
                        v0 = (f32x4){a.x, a.y, b.x, b.y}; v1 = (f32x4){c.x, c.y, d.x, d.y}; }
                    v0 = v0 * sc; v1 = v1 * sc;
                    u32x4 w; w.x = cvt_pk_bf16(v0[0], v0[1]); w.y = cvt_pk_bf16(v0[2], v0[3]); w.z = cvt_pk_bf16(v1[0], v1[1]); w.w = cvt_pk_bf16(v1[2], v1[3]);
                    *(u32x4*)(rowp + bj * 128) = w; } }
    }
};
struct EpiProjB {
    static constexpr bool PERM = true, AFTER_DRAIN = false;
    bf16_t *k, *v, *q, *qm;
    __device__ __forceinline__ void operator()(const f32x4 (&acc)[2][2][4][2], const Unit& un, int wr, int wc, int fr, int fq) const {
        const int row0 = un.pm * 256 + wr * 64 + fr;
        bf16_t* base; int ldc, colt; float sc = 1.f;
        if (un.pn < 3) { base = k; ldc = SGW; colt = un.pn * 256; }
        else if (un.pn < 6) { base = v; ldc = SGW; colt = (un.pn - 3) * 256; }
        else if (un.pn < 9) { base = q; ldc = SGW; colt = (un.pn - 6) * 256; sc = ATT_SCALE; }
        else { base = qm; ldc = 256; colt = 0; sc = ATT_SCALE; }
        const int col0 = colt + wc * 32 + 8 * fq;
#pragma unroll
        for (int ai = 0; ai < 2; ++ai)
#pragma unroll
            for (int m = 0; m < 4; ++m) { bf16_t* rowp = base + (size_t)(row0 + ai * 128 + m * 16) * ldc + col0;
#pragma unroll
                for (int bj = 0; bj < 2; ++bj) { f32x4 v0 = acc[ai][bj][m][0] * sc, v1 = acc[ai][bj][m][1] * sc;
                    u32x4 w; w.x = cvt_pk_bf16(v0[0], v0[1]); w.y = cvt_pk_bf16(v0[2], v0[3]); w.z = cvt_pk_bf16(v1[0], v1[1]); w.w = cvt_pk_bf16(v1[2], v1[3]);
                    *(u32x4*)(rowp + bj * 128) = w; } }
    }
};
struct EpiPlain {
    static constexpr bool PERM = true, AFTER_DRAIN = false;
    bf16_t* O; int ldc, ntn;
    __device__ __forceinline__ void operator()(const f32x4 (&acc)[2][2][4][2], const Unit& un, int wr, int wc, int fr, int fq) const {
        const int row0 = un.pm * 256 + wr * 64 + fr;
        const int col0 = (un.pn % ntn) * 256 + wc * 32 + 8 * fq;
#pragma unroll
        for (int ai = 0; ai < 2; ++ai)
#pragma unroll
            for (int m = 0; m < 4; ++m) { bf16_t* rowp = O + (size_t)(row0 + ai * 128 + m * 16) * ldc + col0;
#pragma unroll
                for (int bj = 0; bj < 2; ++bj) { const f32x4 v0 = acc[ai][bj][m][0], v1 = acc[ai][bj][m][1];
                    u32x4 w; w.x = cvt_pk_bf16(v0[0], v0[1]); w.y = cvt_pk_bf16(v0[2], v0[3]); w.z = cvt_pk_bf16(v1[0], v1[1]); w.w = cvt_pk_bf16(v1[2], v1[3]);
                    *(u32x4*)(rowp + bj * 128) = w; } }
    }
};
struct EpiSwiGLU {
    static constexpr bool PERM = true, AFTER_DRAIN = false;
    bf16_t* O;
    __device__ __forceinline__ void operator()(const f32x4 (&acc)[2][2][4][2], const Unit& un, int wr, int wc, int fr, int fq) const {
        const int row0 = un.pm * 256 + wr * 64 + fr;
        const int col0 = (un.pn & 7) * 128 + wc * 32 + 8 * fq;
#pragma unroll
        for (int ai = 0; ai < 2; ++ai)
#pragma unroll
            for (int m = 0; m < 4; ++m) { bf16_t* rowp = O + (size_t)(row0 + ai * 128 + m * 16) * 1024 + col0;
                float r[8];
#pragma unroll
                for (int n = 0; n < 2; ++n)
#pragma unroll
                    for (int j = 0; j < 4; ++j) { const float g = acc[ai][0][m][n][j], up = acc[ai][1][m][n][j];
                        r[n * 4 + j] = g * __builtin_amdgcn_rcpf(1.0f + __expf(-g)) * up; }
                u32x4 w; w.x = cvt_pk_bf16(r[0], r[1]); w.y = cvt_pk_bf16(r[2], r[3]); w.z = cvt_pk_bf16(r[4], r[5]); w.w = cvt_pk_bf16(r[6], r[7]);
                *(u32x4*)rowp = w; }
    }
};
struct EpiSwiGLU8 {
    static constexpr bool PERM = true, AFTER_DRAIN = false;
    unsigned char* O;
    __device__ __forceinline__ void operator()(const f32x4 (&acc)[2][2][4][2], const Unit& un, int wr, int wc, int fr, int fq) const {
        const int row0 = un.pm * 256 + wr * 64 + fr;
        const int col0 = (un.pn & 7) * 128 + wc * 32 + 8 * fq;
#pragma unroll
        for (int ai = 0; ai < 2; ++ai)
#pragma unroll
            for (int m = 0; m < 4; ++m) { unsigned char* rowp = O + (size_t)(row0 + ai * 128 + m * 16) * 1024 + col0;
                float r[8];
#pragma unroll
                for (int n = 0; n < 2; ++n)
#pragma unroll
                    for (int j = 0; j < 4; ++j) { const float g = acc[ai][0][m][n][j], up = acc[ai][1][m][n][j];
                        r[n * 4 + j] = g * __builtin_amdgcn_rcpf(1.0f + __expf(-g)) * up * 8.0f; }
                *(u32x2*)rowp = (u32x2){pk4_fp8_e(r[0], r[1], r[2], r[3]), pk4_fp8_e(r[4], r[5], r[6], r[7])}; }
    }
};
template <bool RB> struct EpiResid {
    static constexpr bool PERM = false, AFTER_DRAIN = false;
    const void* res; float* Y;
    __device__ __forceinline__ void operator()(const f32x4 (&acc)[2][2][4][2], const Unit& un, int wr, int wc, int fr, int fq) const {
        const int row0 = un.pm * 256 + wr * 64 + fr, col0 = un.pn * 256 + wc * 32 + 4 * fq;
#pragma unroll
        for (int ai = 0; ai < 2; ++ai)
#pragma unroll
            for (int m = 0; m < 4; ++m) { const size_t off = (size_t)(row0 + ai * 128 + m * 16) * D + col0;
#pragma unroll
                for (int bj = 0; bj < 2; ++bj)
#pragma unroll
                    for (int n = 0; n < 2; ++n) { const size_t o = off + bj * 128 + n * 16; f32x4 r;
                        if (RB) { const u32x2 w = *(const u32x2*)((const bf16_t*)res + o); r = (f32x4){bflo(w.x), bfhi(w.x), bflo(w.y), bfhi(w.y)}; }
                        else r = *(const f32x4*)((const float*)res + o);
                        *(f32x4*)(Y + o) = r * ALPHA + acc[ai][bj][m][n]; } }
    }
};
struct SmallOrder {
    int nN, nwg, c;
    __device__ bool next(int i, Unit& u) const { if (i != 0 || c < 0 || c >= nwg) return false; u.pm = c / nN; u.pn = c % nN; return true; }
    __device__ __forceinline__ void a_ready(const Unit&) const {}
    __device__ __forceinline__ void done(const Unit&) const {}
    __device__ __forceinline__ int arow(int, const Unit& u, int r) const { return u.pm * 256 + r; }
};
struct MoeOrder {
    const LAS int* tb;
    int ntn, G, c;
    __device__ bool next(int i, Unit& u) const {
        const int L = i * G + c; if (L >= tb[16] * ntn) return false;
        int e = 0;
#pragma unroll
        for (int j = 1; j < 16; ++j) e += (L >= tb[j] * ntn) ? 1 : 0;
        const int r = L - tb[e] * ntn, te = tb[e + 1] - tb[e];
        u.pm = tb[e] + r % te; u.pn = e * ntn + r / te; return true;
    }
    __device__ __forceinline__ void a_ready(const Unit&) const {}
    __device__ __forceinline__ void done(const Unit&) const {}
    __device__ __forceinline__ int arow(int, const Unit& u, int r) const { return u.pm * 256 + r; }
};
struct MoeGatherOrder : MoeOrder {
    const LAS int* toks;
    __device__ __forceinline__ int arow(int ui, const Unit&, int r) const { return toks[ui * 256 + r]; }
};

struct Args { const float* in[23]; float* out; unsigned char* ws; int ph_lo, ph_hi; };
struct Ctx {
    unsigned char* ws; LAS unsigned char* lds;
    int tid, lane, wave, gw, NGW, G, bid;
};
__device__ __forceinline__ unsigned char* launder(unsigned char* p) { asm volatile("" : "+s"(p)); return p; }
__device__ __forceinline__ int launder_v(int v) { asm volatile("" : "+v"(v)); return v; }

__device__ __forceinline__ void tr_item(const float* W, int K, int N, bf16_t* WT, int grp, int gstride, int roff, LAS float* scr, int item, int lane) {
    const int nblk = N / 32, kb = item / nblk, nb = item % nblk, k0 = 64 * kb, n0 = 32 * nb;
    float ld[32];
    { const float* wp = W + (size_t)(k0 + (lane >> 5)) * N + n0 + (lane & 31);
#pragma unroll
      for (int i = 0; i < 32; ++i) ld[i] = __builtin_nontemporal_load(wp + (size_t)(2 * i) * N); }
#pragma unroll
    for (int i = 0; i < 32; ++i) scr[(2 * i + (lane >> 5)) * 33 + (lane & 31)] = ld[i];
    LDS_WAIT(); asm volatile("" ::: "memory");
    const int c = lane & 7;
#pragma unroll
    for (int j = 0; j < 4; ++j) { const int n = (lane >> 3) + 8 * j; const LAS float* s = scr + (8 * c) * 33 + n;
        const int nn = n0 + n, drow = (nn / grp) * gstride + (nn % grp) + roff;
        u32x4 o; o.x = pk2(s[0 * 33], s[1 * 33]); o.y = pk2(s[2 * 33], s[3 * 33]); o.z = pk2(s[4 * 33], s[5 * 33]); o.w = pk2(s[6 * 33], s[7 * 33]);
        *(u32x4*)(WT + (size_t)drow * K + k0 + 8 * c) = o; }
    LDS_WAIT(); asm volatile("" ::: "memory");
}
__device__ __forceinline__ unsigned pk4_fp8(float a, float b, float c, float d) { int r = 0; r = __builtin_amdgcn_cvt_pk_fp8_f32(a, b, r, false); r = __builtin_amdgcn_cvt_pk_fp8_f32(c, d, r, true); return (unsigned)r; }
__device__ __forceinline__ void tr_item8(const float* W, int K, int N, unsigned char* WT, int grp, int gstride, int roff, float sc, LAS float* scr, int item, int lane) {
    const int nblk = N / 32, kb = item / nblk, nb = item % nblk, k0 = 64 * kb, n0 = 32 * nb;
    float ld[32];
    { const float* wp = W + (size_t)(k0 + (lane >> 5)) * N + n0 + (lane & 31);
#pragma unroll
      for (int i = 0; i < 32; ++i) ld[i] = __builtin_nontemporal_load(wp + (size_t)(2 * i) * N); }
#pragma unroll
    for (int i = 0; i < 32; ++i) scr[(2 * i + (lane >> 5)) * 33 + (lane & 31)] = ld[i];
    LDS_WAIT(); asm volatile("" ::: "memory");
    const int c = lane & 7;
#pragma unroll
    for (int j = 0; j < 4; ++j) { const int n = (lane >> 3) + 8 * j; const LAS float* s = scr + (8 * c) * 33 + n;
        const int nn = n0 + n, drow = (nn / grp) * gstride + (nn % grp) + roff;
        u32x2 o; o.x = pk4_fp8(s[0 * 33] * sc, s[1 * 33] * sc, s[2 * 33] * sc, s[3 * 33] * sc); o.y = pk4_fp8(s[4 * 33] * sc, s[5 * 33] * sc, s[6 * 33] * sc, s[7 * 33] * sc);
        *(u32x2*)(WT + (size_t)drow * K + k0 + 8 * c) = o; }
    LDS_WAIT(); asm volatile("" ::: "memory");
}
constexpr float W8_SCALE = 32.0f, ACT8_SCALE = 8.0f;
constexpr int E8_ONE = 0x7f7f7f7f, E8_W = 0x7a7a7a7a, E8_ACT = 0x7c7c7c7c;
__device__ __forceinline__ void p0_prologue(const Ctx& C, const Args& A) {
    LAS float* scr = (LAS float*)(C.lds + C.wave * 16384);
    unsigned char* ws = C.ws;
    constexpr int I_MOE = 16 * 32;
    constexpr int N_MOE = 32 * I_MOE;
    constexpr int I_INA = 16 * 56, I_SQ = 512, I_KV = 16 * 24, I_OUTB = 8 * 32, I_MEM = 16 * 8;
    constexpr int NITEMS = 3 * N_MOE + I_INA + I_SQ + I_SQ + 2 * I_KV + I_OUTB + 4 * I_MEM;
    for (int it = C.gw; it < NITEMS; it += C.NGW) {
        int r = it;
        if (r < N_MOE) { const int m = r / I_MOE;
            tr_item8(A.in[20] + (size_t)m * 1048576, 1024, 1024, ws + WS_WGU + (size_t)(m >> 4) * (64 * MiB) + (size_t)(m & 15) * 2097152, 128, 256, 0, W8_SCALE, scr, r % I_MOE, C.lane);
            continue; } r -= N_MOE;
        if (r < N_MOE) { const int m = r / I_MOE;
            tr_item8(A.in[21] + (size_t)m * 1048576, 1024, 1024, ws + WS_WGU + (size_t)(m >> 4) * (64 * MiB) + (size_t)(m & 15) * 2097152, 128, 256, 128, W8_SCALE, scr, r % I_MOE, C.lane);
            continue; } r -= N_MOE;
        if (r < N_MOE) { const int m = r / I_MOE;
            tr_item8(A.in[22] + (size_t)m * 1048576, 1024, 1024, ws + WS_WD + (size_t)(m >> 4) * (32 * MiB) + (size_t)(m & 15) * 1048576, 1024, 1024, 0, W8_SCALE, scr, r % I_MOE, C.lane);
            continue; } r -= N_MOE;
        if (r < I_INA) { tr_item(A.in[2], 1024, 1792, (bf16_t*)(ws + WS_BT_INA), 1792, 1792, 0, scr, r, C.lane); continue; } r -= I_INA;
        if (r < I_SQ) { tr_item(A.in[3], 1024, 1024, (bf16_t*)(ws + WS_BT_OUTA), 1024, 1024, 0, scr, r, C.lane); continue; } r -= I_SQ;
        if (r < I_SQ) { tr_item(A.in[8], 1024, 1024, (bf16_t*)(ws + WS_BT_B), 1024, 1024, 1536, scr, r, C.lane); continue; } r -= I_SQ;
        if (r < I_KV) { tr_item(A.in[10], 1024, 768, (bf16_t*)(ws + WS_BT_B), 768, 768, 0, scr, r, C.lane); continue; } r -= I_KV;
        if (r < I_KV) { tr_item(A.in[11], 1024, 768, (bf16_t*)(ws + WS_BT_B), 768, 768, 768, scr, r, C.lane); continue; } r -= I_KV;
        if (r < I_OUTB) { tr_item(A.in[9], 512, 1024, (bf16_t*)(ws + WS_BT_OUTB), 1024, 1024, 0, scr, r, C.lane); continue; } r -= I_OUTB;
        { const int m = r / I_MEM, layer = m & 1, isv = m >> 1;
          tr_item(A.in[isv ? 13 : 12] + (size_t)layer * 262144, 1024, 256, (bf16_t*)(ws + WS_BT_MEM), 256, 256, layer * 512 + isv * 256, scr, r % I_MEM, C.lane); }
    }
    const int gt = C.bid * NTHREADS + C.tid, NT = C.G * NTHREADS;
    for (int i = gt; i < NSG * 128 * 128 / 8; i += NT) { const int q0 = (i & 15) * 8, p = (i >> 4) & 127;
        const f32x4 a = *(const f32x4*)(A.in[6] + (size_t)i * 8), b = *(const f32x4*)(A.in[6] + (size_t)i * 8 + 4); float v[8] = {a[0], a[1], a[2], a[3], b[0], b[1], b[2], b[3]};
#pragma unroll
        for (int j = 0; j < 8; ++j) v[j] = (q0 + j <= p) ? v[j] : 0.f;
        u32x4 w; w.x = pk2(v[0], v[1]); w.y = pk2(v[2], v[3]); w.z = pk2(v[4], v[5]); w.w = pk2(v[6], v[7]); *(u32x4*)((bf16_t*)(ws + WS_SGWB) + (size_t)i * 8) = w; }
    for (int i = gt; i < T * D / 8; i += NT) { const f32x4 a = *(const f32x4*)(A.in[0] + (size_t)i * 8), b = *(const f32x4*)(A.in[0] + (size_t)i * 8 + 4);
        u32x4 w; w.x = pk2(a[0], a[1]); w.y = pk2(a[2], a[3]); w.z = pk2(b[0], b[1]); w.w = pk2(b[2], b[3]); *(u32x4*)((bf16_t*)(ws + WS_XB) + (size_t)i * 8) = w; }
    for (int i = gt; i < NB * NMEM * D / 8; i += NT) { const f32x4 a = *(const f32x4*)(A.in[1] + (size_t)i * 8), b = *(const f32x4*)(A.in[1] + (size_t)i * 8 + 4);
        u32x4 w; w.x = pk2(a[0], a[1]); w.y = pk2(a[2], a[3]); w.z = pk2(b[0], b[1]); w.w = pk2(b[2], b[3]); *(u32x4*)((bf16_t*)(ws + WS_MEMB) + (size_t)i * 8) = w; }
}

__device__ __forceinline__ void sg_scalar(const Ctx& C, const Args& A) {
    const bf16_t* U = (const bf16_t*)(C.ws + WS_U); const bf16_t* GV = (const bf16_t*)(C.ws + WS_GV); bf16_t* CAT = (bf16_t*)(C.ws + WS_CAT);
    const float* lng = A.in[4]; const float* lnb = A.in[5]; const float* sgw = A.in[6]; const float* sgb = A.in[7];
    LAS float* stat = (LAS float*)C.lds;
    LAS float* gvn = (LAS float*)(C.lds + 1024);
    LAS float* Wl = (LAS float*)(C.lds + 1024 + 128 * 65 * 4);
    for (int unit = C.bid; unit < NB * 16; unit += C.G) {
        const int tb = unit * 128;
        for (int rr = 0; rr < 16; ++rr) { const int row = C.wave * 16 + rr; const bf16_t* p = GV + (size_t)(tb + row) * SGW + 4 * C.lane;
            float s = 0.f, ss = 0.f;
#pragma unroll
            for (int j = 0; j < 3; ++j) { const u32x2 w = *(const u32x2*)(p + 256 * j); const float a = bflo(w.x), b = bfhi(w.x), c = bflo(w.y), d = bfhi(w.y);
                s += (a + b) + (c + d); ss += (a * a + b * b) + (c * c + d * d); }
            s = wave_sum(s); ss = wave_sum(ss);
            const float mean = s * (1.f / SGW), var = ss * (1.f / SGW) - mean * mean;
            if (C.lane == 0) { stat[row * 2] = mean; stat[row * 2 + 1] = 1.0f / sqrtf(var + LN_EPS); } }
        __syncthreads();
        const int p = C.tid >> 2, d0 = (C.tid & 3) * 16;
        for (int g = 0; g < NSG; ++g) {
            { const bf16_t* src = GV + (size_t)(tb + p) * SGW + g * 64 + d0; const float mean = stat[p * 2], rstd = stat[p * 2 + 1];
#pragma unroll
              for (int h = 0; h < 2; ++h) { const u32x4 w = *(const u32x4*)(src + 8 * h); const unsigned ww[4] = {w.x, w.y, w.z, w.w};
#pragma unroll
                  for (int j = 0; j < 4; ++j) { const int d = d0 + 8 * h + 2 * j; const int cc = g * 64 + d;
                      gvn[p * 65 + d] = (bflo(ww[j]) - mean) * rstd * lng[cc] + lnb[cc];
                      gvn[p * 65 + d + 1] = (bfhi(ww[j]) - mean) * rstd * lng[cc + 1] + lnb[cc + 1]; } } }
            { const int q0 = (C.tid & 3) * 32; const float* src = sgw + ((size_t)g * 128 + p) * 128 + q0;
#pragma unroll
              for (int j = 0; j < 8; ++j) { const f32x4 w = *(const f32x4*)(src + 4 * j);
#pragma unroll
                  for (int t = 0; t < 4; ++t) { const int q = q0 + 4 * j + t; Wl[p * 129 + q] = (q <= p) ? w[t] : 0.f; } } }
            __syncthreads();
            float acc[16];
#pragma unroll
            for (int j = 0; j < 16; ++j) acc[j] = 0.f;
            for (int q = 0; q <= p; ++q) { const float w = Wl[p * 129 + q];
#pragma unroll
                for (int j = 0; j < 16; ++j) acc[j] += w * gvn[q * 65 + d0 + j]; }
            const float bs = sgb[g * 128 + p];
            const bf16_t* us = U + (size_t)(tb + p) * SGW + g * 64 + d0; bf16_t* dst = CAT + (size_t)(tb + p) * D + g * 64 + d0;
#pragma unroll
            for (int h = 0; h < 2; ++h) { const u32x4 w = *(const u32x4*)(us + 8 * h); const unsigned ww[4] = {w.x, w.y, w.z, w.w}; unsigned o[4];
#pragma unroll
                for (int j = 0; j < 4; ++j) o[j] = pk2(bflo(ww[j]) * (acc[8 * h + 2 * j] + bs), bfhi(ww[j]) * (acc[8 * h + 2 * j + 1] + bs));
                *(u32x4*)(dst + 8 * h) = (u32x4){o[0], o[1], o[2], o[3]}; }
            __syncthreads();
        }
    }
}

__device__ __forceinline__ void memattn_scalar(const Ctx& C, const bf16_t* QM, const bf16_t* MKV, int ck, int cv, bf16_t* OUT, int ldo, int coff) {
    for (int it = C.gw; it < T * 4; it += C.NGW) {
        const int tok = it >> 2, h = it & 3, b = tok / SEQ;
        float q[64];
        { const bf16_t* qp = QM + (size_t)tok * 256 + h * 64;
#pragma unroll
          for (int j = 0; j < 8; ++j) { const u32x4 w = *(const u32x4*)(qp + 8 * j);
              q[8 * j] = bflo(w.x); q[8 * j + 1] = bfhi(w.x); q[8 * j + 2] = bflo(w.y); q[8 * j + 3] = bfhi(w.y); q[8 * j + 4] = bflo(w.z); q[8 * j + 5] = bfhi(w.z); q[8 * j + 6] = bflo(w.w); q[8 * j + 7] = bfhi(w.w); } }
        float s[4];
#pragma unroll
        for (int jj = 0; jj < 4; ++jj) { const bf16_t* kp = MKV + (size_t)(b * NMEM + jj * 64 + C.lane) * 1024 + ck + h * 64; float a = 0.f;
#pragma unroll
            for (int j = 0; j < 8; ++j) { const u32x4 w = *(const u32x4*)(kp + 8 * j);
                a += q[8 * j] * bflo(w.x) + q[8 * j + 1] * bfhi(w.x) + q[8 * j + 2] * bflo(w.y) + q[8 * j + 3] * bfhi(w.y) + q[8 * j + 4] * bflo(w.z) + q[8 * j + 5] * bfhi(w.z) + q[8 * j + 6] * bflo(w.w) + q[8 * j + 7] * bfhi(w.w); }
            s[jj] = a; }
        const float mx = wave_max(fmaxf(fmaxf(s[0], s[1]), fmaxf(s[2], s[3])));
        float l = 0.f;
#pragma unroll
        for (int jj = 0; jj < 4; ++jj) { s[jj] = __expf(s[jj] - mx); l += s[jj]; }
        l = wave_sum(l);
        float acc = 0.f;
#pragma unroll
        for (int jj = 0; jj < 4; ++jj) { const bf16_t* vp = MKV + (size_t)(b * NMEM + jj * 64) * 1024 + cv + h * 64 + C.lane;
            for (int mm = 0; mm < 64; ++mm) acc += __shfl(s[jj], mm) * bf1(vp[(size_t)mm * 1024]); }
        OUT[(size_t)tok * ldo + coff + h * 64 + C.lane] = (bf16_t)f2bf(acc / l);
    }
}

__device__ __forceinline__ void dilattn_scalar(const Ctx& C, const Args& A) {
    const bf16_t* Q = (const bf16_t*)(C.ws + WS_Q); const bf16_t* K = (const bf16_t*)(C.ws + WS_K); const bf16_t* V = (const bf16_t*)(C.ws + WS_V);
    bf16_t* OG = (bf16_t*)(C.ws + WS_OG); float* LSE = (float*)(C.ws + WS_LSE);
    for (int it = C.gw; it < T * 12; it += C.NGW) {
        const int tok = it / 12, h = it % 12, g = h >> 2, dl = (g == 0) ? 1 : (g == 1 ? 4 : 16);
        const int t = tok % SEQ, i = t / dl;
        const float slope = exp2f(-(float)(h + 1) * (8.0f / 12.0f));
        float q[64];
        { const bf16_t* qp = Q + (size_t)tok * SGW + h * 64;
#pragma unroll
          for (int j = 0; j < 8; ++j) { const u32x4 w = *(const u32x4*)(qp + 8 * j);
              q[8 * j] = bflo(w.x); q[8 * j + 1] = bfhi(w.x); q[8 * j + 2] = bflo(w.y); q[8 * j + 3] = bfhi(w.y); q[8 * j + 4] = bflo(w.z); q[8 * j + 5] = bfhi(w.z); q[8 * j + 6] = bflo(w.w); q[8 * j + 7] = bfhi(w.w); } }
        float s[3];
#pragma unroll
        for (int jj = 0; jj < 3; ++jj) { const int j0 = jj * 64 + C.lane; const bool valid = (jj < 2 || C.lane == 0) && (j0 <= i);
            const int jc = valid ? j0 : 0;
            const bf16_t* kp = K + (size_t)(tok - jc * dl) * SGW + h * 64; float a = 0.f;
#pragma unroll
            for (int j = 0; j < 8; ++j) { const u32x4 w = *(const u32x4*)(kp + 8 * j);
                a += q[8 * j] * bflo(w.x) + q[8 * j + 1] * bfhi(w.x) + q[8 * j + 2] * bflo(w.y) + q[8 * j + 3] * bfhi(w.y) + q[8 * j + 4] * bflo(w.z) + q[8 * j + 5] * bfhi(w.z) + q[8 * j + 6] * bflo(w.w) + q[8 * j + 7] * bfhi(w.w); }
            s[jj] = valid ? (a - slope * (float)(dl * j0)) : -INFINITY; }
        const float mx = wave_max(fmaxf(fmaxf(s[0], s[1]), s[2]));
        float l = 0.f;
#pragma unroll
        for (int jj = 0; jj < 3; ++jj) { s[jj] = __expf(s[jj] - mx); l += s[jj]; }
        l = wave_sum(l);
        float acc = 0.f;
#pragma unroll
        for (int jj = 0; jj < 3; ++jj) { const int nm = (jj < 2) ? 64 : 1;
            for (int mm = 0; mm < nm; ++mm) { const int j0 = jj * 64 + mm; const int jc = (j0 <= i) ? j0 : 0;
                acc += __shfl(s[jj], mm) * bf1(V[(size_t)(tok - jc * dl) * SGW + h * 64 + C.lane]); } }
        OG[(size_t)tok * SGW + h * 64 + C.lane] = (bf16_t)f2bf(acc / l);
        if (C.lane == 0) LSE[tok * 12 + h] = mx + __logf(l);
    }
}
typedef short bf16x8 __attribute__((ext_vector_type(8)));
typedef short s16x4 __attribute__((ext_vector_type(4)));
constexpr int AT_KS = 144, AT_VS = 160, AT_ROWS = 272, AT_K_OFF = 0, AT_V_OFF = AT_ROWS * AT_KS;
static_assert(AT_V_OFF % 16 == 0 && AT_V_OFF + AT_ROWS * AT_VS <= 131072, "attention LDS map");

template <int NKB, bool DIL>
__device__ __forceinline__ void attn_compute(LAS unsigned char* lds, int lane, int krow0, bf16x8 qf0, bf16x8 qf1, float sdl, int ikw, f32x4 (&o)[4], float& mx, float& lsum) {
    const int n = lane & 15, g = lane >> 4;
    const LAS unsigned char* Kb = lds + AT_K_OFF + (krow0 + n) * AT_KS + g * 16;
    f32x4 sc[NKB];
#pragma unroll
    for (int kb = 0; kb < NKB; ++kb) {
        const bf16x8 k0 = *(const LAS bf16x8*)(Kb + kb * 16 * AT_KS), k1 = *(const LAS bf16x8*)(Kb + kb * 16 * AT_KS + 64);
        f32x4 a = (f32x4){0.f, 0.f, 0.f, 0.f};
        a = __builtin_amdgcn_mfma_f32_16x16x32_bf16(k0, qf0, a, 0, 0, 0);
        a = __builtin_amdgcn_mfma_f32_16x16x32_bf16(k1, qf1, a, 0, 0, 0);
        sc[kb] = a;
    }
    float m = -INFINITY;
#pragma unroll
    for (int kb = 0; kb < NKB; ++kb)
#pragma unroll
        for (int r = 0; r < 4; ++r) {
            if (DIL) { const int off = 16 * kb + 4 * g + r, rel = 144 + n - off; const bool valid = (rel >= 0) && (rel <= 128) && (ikw + off >= 0);
                sc[kb][r] = valid ? (sc[kb][r] - sdl * (float)rel) : -INFINITY; }
            m = fmaxf(m, sc[kb][r]); }
    m = fmaxf(m, __shfl_xor(m, 16)); m = fmaxf(m, __shfl_xor(m, 32));
    float l = 0.f;
#pragma unroll
    for (int kb = 0; kb < NKB; ++kb)
#pragma unroll
        for (int r = 0; r < 4; ++r) { sc[kb][r] = __expf(sc[kb][r] - m); l += sc[kb][r]; }
    l += __shfl_xor(l, 16); l += __shfl_xor(l, 32);
    mx = m; lsum = l;
    const LAS unsigned char* Vb = lds + AT_V_OFF + (krow0 + 4 * g + (n >> 2)) * AT_VS + (n & 3) * 8;
#pragma unroll
    for (int db = 0; db < 4; ++db) o[db] = (f32x4){0.f, 0.f, 0.f, 0.f};
#pragma unroll
    for (int kk = 0; kk < NKB / 2; ++kk) {
        union { bf16x8 v; unsigned u[4]; } pf;
        pf.u[0] = cvt_pk_bf16(sc[2 * kk][0], sc[2 * kk][1]); pf.u[1] = cvt_pk_bf16(sc[2 * kk][2], sc[2 * kk][3]);
        pf.u[2] = cvt_pk_bf16(sc[2 * kk + 1][0], sc[2 * kk + 1][1]); pf.u[3] = cvt_pk_bf16(sc[2 * kk + 1][2], sc[2 * kk + 1][3]);
#pragma unroll
        for (int db = 0; db < 4; ++db) {
            const s16x4 v0 = __builtin_amdgcn_ds_read_tr16_b64_v4i16((LAS s16x4*)(Vb + (2 * kk) * 16 * AT_VS + db * 32));
            const s16x4 v1 = __builtin_amdgcn_ds_read_tr16_b64_v4i16((LAS s16x4*)(Vb + (2 * kk + 1) * 16 * AT_VS + db * 32));
            const bf16x8 vf = __builtin_shufflevector(v0, v1, 0, 1, 2, 3, 4, 5, 6, 7);
            o[db] = __builtin_amdgcn_mfma_f32_16x16x32_bf16(vf, pf.v, o[db], 0, 0, 0);
        }
    }
}

__device__ __forceinline__ void memattn_mfma(const Ctx& C, const bf16_t* QM, const bf16_t* MKV, int ck, int cv, bf16_t* OUT, int ldo, int coff) {
    const int n = C.lane & 15, g = C.lane >> 4;
    for (int unit = C.bid; unit < NB * 4 * 16; unit += C.G) {
        const int b = unit >> 6, h = (unit >> 4) & 3, qt = unit & 15;
        __syncthreads();
#pragma unroll
        for (int it = 0; it < 4; ++it) { const int row = it * 64 + (C.tid >> 3), c = C.tid & 7;
            const bf16_t* src = MKV + (size_t)(b * NMEM + row) * 1024 + h * 64 + c * 8;
            const u32x4 kv = *(const u32x4*)(src + ck), vv = *(const u32x4*)(src + cv);
            *(LAS u32x4*)(C.lds + AT_K_OFF + row * AT_KS + c * 16) = kv; *(LAS u32x4*)(C.lds + AT_V_OFF + row * AT_VS + c * 16) = vv; }
        const int tok = b * SEQ + qt * 128 + C.wave * 16 + n;
        const bf16_t* qp = QM + (size_t)tok * 256 + h * 64 + g * 8;
        const bf16x8 qf0 = *(const bf16x8*)qp, qf1 = *(const bf16x8*)(qp + 32);
        __syncthreads();
        f32x4 o[4]; float mx, l;
        attn_compute<16, false>(C.lds, C.lane, 0, qf0, qf1, 0.f, 0, o, mx, l);
        const float inv = 1.0f / l;
#pragma unroll
        for (int db = 0; db < 4; ++db)
            *(u32x2*)(OUT + (size_t)tok * ldo + coff + h * 64 + 16 * db + 4 * g) = (u32x2){cvt_pk_bf16(o[db][0] * inv, o[db][1] * inv), cvt_pk_bf16(o[db][2] * inv, o[db][3] * inv)};
    }
}
__device__ __forceinline__ void dilattn_mfma(const Ctx& C) {
    const bf16_t* Q = (const bf16_t*)(C.ws + WS_Q); const bf16_t* K = (const bf16_t*)(C.ws + WS_K); const bf16_t* V = (const bf16_t*)(C.ws + WS_V);
    bf16_t* OG = (bf16_t*)(C.ws + WS_OG); float* LSE = (float*)(C.ws + WS_LSE);
    const int n = C.lane & 15, g = C.lane >> 4;
    for (int unit = C.bid; unit < 12 * 128; unit += C.G) {
        const int h = unit >> 7, rem = unit & 127, b = rem >> 4, x = rem & 15, grp = h >> 2;
        const int dl = (grp == 0) ? 1 : (grp == 1 ? 4 : 16), ntile = 16 / dl, r = x / ntile, I0 = (x % ntile) * 128;
        const float sdl = exp2f(-(float)(h + 1) * (8.0f / 12.0f)) * (float)dl;
        __syncthreads();
        for (int idx = C.tid; idx < AT_ROWS * 8; idx += NTHREADS) { const int row = idx >> 3, c = idx & 7; const int ik = I0 - 144 + row;
            u32x4 kv = (u32x4){0u, 0u, 0u, 0u}, vv = (u32x4){0u, 0u, 0u, 0u};
            if (ik >= 0) { const size_t off = (size_t)(b * SEQ + ik * dl + r) * SGW + h * 64 + c * 8; kv = *(const u32x4*)(K + off); vv = *(const u32x4*)(V + off); }
            *(LAS u32x4*)(C.lds + AT_K_OFF + row * AT_KS + c * 16) = kv; *(LAS u32x4*)(C.lds + AT_V_OFF + row * AT_VS + c * 16) = vv; }
        const int iq = I0 + C.wave * 16 + n, tok = b * SEQ + iq * dl + r;
        const bf16_t* qp = Q + (size_t)tok * SGW + h * 64 + g * 8;
        const bf16x8 qf0 = *(const bf16x8*)qp, qf1 = *(const bf16x8*)(qp + 32);
        __syncthreads();
        f32x4 o[4]; float mx, l;
        attn_compute<10, true>(C.lds, C.lane, C.wave * 16, qf0, qf1, sdl, I0 + C.wave * 16 - 144, o, mx, l);
        const float inv = 1.0f / l;
#pragma unroll
        for (int db = 0; db < 4; ++db)
            *(u32x2*)(OG + (size_t)tok * SGW + h * 64 + 16 * db + 4 * g) = (u32x2){cvt_pk_bf16(o[db][0] * inv, o[db][1] * inv), cvt_pk_bf16(o[db][2] * inv, o[db][3] * inv)};
        if (g == 0) LSE[tok * 12 + h] = mx + __logf(l);
    }
}
constexpr int SG_GVN_OFF = 1024, SG_VS = 160;
__device__ __forceinline__ void sg_mfma(const Ctx& C, const Args& A) {
    const bf16_t* U = (const bf16_t*)(C.ws + WS_U); const bf16_t* GV = (const bf16_t*)(C.ws + WS_GV); bf16_t* CAT = (bf16_t*)(C.ws + WS_CAT);
    const bf16_t* WB = (const bf16_t*)(C.ws + WS_SGWB);
    const float* lng = A.in[4]; const float* lnb = A.in[5]; const float* sgb = A.in[7];
    LAS float* stat = (LAS float*)C.lds;
    const int n = C.lane & 15, gl = C.lane >> 4;
    for (int unit = C.bid; unit < NB * 16 * 4; unit += C.G) {
        const int tb = (unit >> 2) * 128, gq = unit & 3;
        __syncthreads();
        for (int rr = 0; rr < 16; ++rr) { const int row = C.wave * 16 + rr; const bf16_t* p = GV + (size_t)(tb + row) * SGW + 4 * C.lane;
            float s = 0.f, ss = 0.f;
#pragma unroll
            for (int j = 0; j < 3; ++j) { const u32x2 w = *(const u32x2*)(p + 256 * j); const float a = bflo(w.x), b = bfhi(w.x), c = bflo(w.y), d = bfhi(w.y);
                s += (a + b) + (c + d); ss += (a * a + b * b) + (c * c + d * d); }
            s = wave_sum(s); ss = wave_sum(ss);
            const float mean = s * (1.f / SGW), var = ss * (1.f / SGW) - mean * mean;
            if (C.lane == 0) { stat[row * 2] = mean; stat[row * 2 + 1] = 1.0f / sqrtf(var + LN_EPS); } }
        __syncthreads();
        for (int gi = 0; gi < 3; ++gi) {
            const int g = gq * 3 + gi;
#pragma unroll
            for (int it = 0; it < 2; ++it) { const int idx = it * NTHREADS + C.tid, row = idx >> 3, c = idx & 7, cc = g * 64 + c * 8;
                const u32x4 w = *(const u32x4*)(GV + (size_t)(tb + row) * SGW + cc); const float mean = stat[row * 2], rstd = stat[row * 2 + 1];
                const f32x4 ga = *(const f32x4*)(lng + cc), gb = *(const f32x4*)(lng + cc + 4), ba = *(const f32x4*)(lnb + cc), bb = *(const f32x4*)(lnb + cc + 4);
                u32x4 o;
                o.x = pk2((bflo(w.x) - mean) * rstd * ga[0] + ba[0], (bfhi(w.x) - mean) * rstd * ga[1] + ba[1]);
                o.y = pk2((bflo(w.y) - mean) * rstd * ga[2] + ba[2], (bfhi(w.y) - mean) * rstd * ga[3] + ba[3]);
                o.z = pk2((bflo(w.z) - mean) * rstd * gb[0] + bb[0], (bfhi(w.z) - mean) * rstd * gb[1] + bb[1]);
                o.w = pk2((bflo(w.w) - mean) * rstd * gb[2] + bb[2], (bfhi(w.w) - mean) * rstd * gb[3] + bb[3]);
                *(LAS u32x4*)(C.lds + SG_GVN_OFF + row * SG_VS + c * 16) = o; }
            __syncthreads();
            const int p = C.wave * 16 + n, nks = (C.wave >> 1) + 1;
            f32x4 acc[4];
#pragma unroll
            for (int db = 0; db < 4; ++db) acc[db] = (f32x4){0.f, 0.f, 0.f, 0.f};
            const bf16_t* wp = WB + (size_t)(g * 128 + p) * 128 + 8 * gl;
            const LAS unsigned char* vb = C.lds + SG_GVN_OFF + (8 * gl + (n >> 2)) * SG_VS + (n & 3) * 8;
            for (int ks = 0; ks < nks; ++ks) {
                const bf16x8 wf = *(const bf16x8*)(wp + 32 * ks);
#pragma unroll
                for (int db = 0; db < 4; ++db) {
                    const s16x4 v0 = __builtin_amdgcn_ds_read_tr16_b64_v4i16((LAS s16x4*)(vb + ks * 32 * SG_VS + db * 32));
                    const s16x4 v1 = __builtin_amdgcn_ds_read_tr16_b64_v4i16((LAS s16x4*)(vb + ks * 32 * SG_VS + 4 * SG_VS + db * 32));
                    const bf16x8 vf = __builtin_shufflevector(v0, v1, 0, 1, 2, 3, 4, 5, 6, 7);
                    acc[db] = __builtin_amdgcn_mfma_f32_16x16x32_bf16(vf, wf, acc[db], 0, 0, 0);
                }
            }
            const float bs = sgb[g * 128 + p];
#pragma unroll
            for (int db = 0; db < 4; ++db) { const size_t co = (size_t)g * 64 + 16 * db + 4 * gl;
                const u32x2 uw = *(const u32x2*)(U + (size_t)(tb + p) * SGW + co);
                *(u32x2*)(CAT + (size_t)(tb + p) * D + co) = (u32x2){cvt_pk_bf16(bflo(uw.x) * (acc[db][0] + bs), bfhi(uw.x) * (acc[db][1] + bs)), cvt_pk_bf16(bflo(uw.y) * (acc[db][2] + bs), bfhi(uw.y) * (acc[db][3] + bs))}; }
            __syncthreads();
        }
    }
}
__device__ __forceinline__ void dil_merge(const Ctx& C, const Args& A) {
    const bf16_t* OG = (const bf16_t*)(C.ws + WS_OG); const float* LSE = (const float*)(C.ws + WS_LSE); bf16_t* CAT2 = (bf16_t*)(C.ws + WS_CAT2);
    const int gt = C.bid * NTHREADS + C.tid, NT = C.G * NTHREADS;
    for (int it = gt; it < T * 32; it += NT) {
        const int tok = it >> 5, j = (it >> 3) & 3, c8 = it & 7;
        const float l0 = LSE[tok * 12 + j], l1 = LSE[tok * 12 + 4 + j], l2 = LSE[tok * 12 + 8 + j];
        const float mx = fmaxf(l0, fmaxf(l1, l2));
        float w0 = __expf(l0 - mx), w1 = __expf(l1 - mx), w2 = __expf(l2 - mx); const float inv = 1.0f / (w0 + w1 + w2); w0 *= inv; w1 *= inv; w2 *= inv;
        const u32x4 a = *(const u32x4*)(OG + (size_t)tok * SGW + j * 64 + c8 * 8), b = *(const u32x4*)(OG + (size_t)tok * SGW + (4 + j) * 64 + c8 * 8), c = *(const u32x4*)(OG + (size_t)tok * SGW + (8 + j) * 64 + c8 * 8);
        u32x4 o;
        o.x = pk2(w0 * bflo(a.x) + w1 * bflo(b.x) + w2 * bflo(c.x), w0 * bfhi(a.x) + w1 * bfhi(b.x) + w2 * bfhi(c.x));
        o.y = pk2(w0 * bflo(a.y) + w1 * bflo(b.y) + w2 * bflo(c.y), w0 * bfhi(a.y) + w1 * bfhi(b.y) + w2 * bfhi(c.y));
        o.z = pk2(w0 * bflo(a.z) + w1 * bflo(b.z) + w2 * bflo(c.z), w0 * bfhi(a.z) + w1 * bfhi(b.z) + w2 * bfhi(c.z));
        o.w = pk2(w0 * bflo(a.w) + w1 * bflo(b.w) + w2 * bflo(c.w), w0 * bfhi(a.w) + w1 * bfhi(b.w) + w2 * bfhi(c.w));
        *(u32x4*)(CAT2 + (size_t)tok * 512 + j * 64 + c8 * 8) = o;
    }
}

__device__ __forceinline__ void ln_route(const Ctx& C, const Args& A, int layer, int cset) {
    const float* Y = (const float*)(C.ws + WS_Y); bf16_t* X1B = (bf16_t*)(C.ws + WS_X1B); unsigned char* X1F8 = C.ws + WS_X1F8;
    const float* lg = A.in[14] + layer * D; const float* lb = A.in[15] + layer * D; const float* wr = A.in[18]; const float* br = A.in[19];
    unsigned* cnt = (unsigned*)(C.ws + WS_CTL) + CW_CNT + cset * 16 * 64;
    int* tokE = (int*)(C.ws + WS_TOKE); int* tokP = (int*)(C.ws + WS_TOKP); float* tokG = (float*)(C.ws + WS_TOKG); int* list = (int*)(C.ws + WS_LIST);
    LAS float* wl = (LAS float*)C.lds;
    LAS int* sE = (LAS int*)(C.lds + 65536); LAS float* sG = (LAS float*)(C.lds + 65536 + 512); LAS int* sPos = (LAS int*)(C.lds + 65536 + 1024);
    LAS int* lcnt = (LAS int*)(C.lds + 65536 + 1536); LAS int* lbase = (LAS int*)(C.lds + 65536 + 1600);
    __syncthreads();
    for (int i = C.tid; i < 1024 * 16 / 4; i += NTHREADS) { const int row = i >> 2, e4 = i & 3, jj = row >> 8, ln = (row & 255) >> 2, cc = row & 3;
        *(LAS f32x4*)(wl + 4 * ((((jj * 4 + cc) * 4 + e4) << 6) + ln)) = *(const f32x4*)(wr + 4 * i); }
    const LAS float* wlane = wl + C.lane * 4;
    for (int blk = C.bid; blk < T / 64; blk += C.G) {
        __syncthreads();
        if (C.tid < 16) lcnt[C.tid] = 0;
        for (int ti = 0; ti < 8; ++ti) {
            const int tl = C.wave * 8 + ti, tok = blk * 64 + tl;
            f32x4 v[4]; float s = 0.f;
#pragma unroll
            for (int j = 0; j < 4; ++j) { v[j] = *(const f32x4*)(Y + (size_t)tok * D + 4 * C.lane + 256 * j); s += (v[j][0] + v[j][1]) + (v[j][2] + v[j][3]); }
            const float mean = wave_sum(s) * (1.f / D); float s2 = 0.f;
#pragma unroll
            for (int j = 0; j < 4; ++j) { v[j] = v[j] - mean; s2 += (v[j][0] * v[j][0] + v[j][1] * v[j][1]) + (v[j][2] * v[j][2] + v[j][3] * v[j][3]); }
            const float rstd = 1.0f / sqrtf(wave_sum(s2) * (1.f / D) + LN_EPS);
            float lgt[16];
#pragma unroll
            for (int e = 0; e < 16; ++e) lgt[e] = 0.f;
#pragma unroll
            for (int j = 0; j < 4; ++j) { const int col = 4 * C.lane + 256 * j; const f32x4 g4 = *(const f32x4*)(lg + col), b4 = *(const f32x4*)(lb + col);
                v[j] = v[j] * rstd * g4 + b4;
                *(u32x2*)(X1B + (size_t)tok * D + col) = (u32x2){pk2(v[j][0], v[j][1]), pk2(v[j][2], v[j][3])};
                *(unsigned*)(X1F8 + (size_t)tok * D + col) = pk4_fp8(v[j][0], v[j][1], v[j][2], v[j][3]);
#pragma unroll
                for (int c = 0; c < 4; ++c) { const float xv = v[j][c];
#pragma unroll
                    for (int e4 = 0; e4 < 4; ++e4) { const f32x4 w = *(const LAS f32x4*)(wlane + (((j * 4 + c) * 4 + e4) << 8));
                        lgt[4 * e4] += xv * w[0]; lgt[4 * e4 + 1] += xv * w[1]; lgt[4 * e4 + 2] += xv * w[2]; lgt[4 * e4 + 3] += xv * w[3]; } } }
            float mx = -INFINITY;
#pragma unroll
            for (int e = 0; e < 16; ++e) { lgt[e] = wave_sum(lgt[e]); mx = fmaxf(mx, lgt[e]); }
            float sum = 0.f;
#pragma unroll
            for (int e = 0; e < 16; ++e) { lgt[e] = __expf(lgt[e] - mx); sum += lgt[e]; }
            const float inv = 1.0f / sum; float sel[16];
#pragma unroll
            for (int e = 0; e < 16; ++e) { lgt[e] *= inv; sel[e] = lgt[e] + br[e]; }
            float gs[4];
#pragma unroll
            for (int g = 0; g < 4; ++g) { const float a = sel[4 * g], b = sel[4 * g + 1], c = sel[4 * g + 2], d = sel[4 * g + 3];
                gs[g] = fmaxf(fmaxf(fmaxf(a + b, a + c), fmaxf(a + d, b + c)), fmaxf(b + d, c + d)); }
            int gi = 0; float bsc = gs[0];
#pragma unroll
            for (int g = 1; g < 4; ++g) if (gs[g] > bsc) { bsc = gs[g]; gi = g; }
            float sg[4], pg[4];
#pragma unroll
            for (int k = 0; k < 4; ++k) { sg[k] = gi == 0 ? sel[k] : (gi == 1 ? sel[4 + k] : (gi == 2 ? sel[8 + k] : sel[12 + k])); pg[k] = gi == 0 ? lgt[k] : (gi == 1 ? lgt[4 + k] : (gi == 2 ? lgt[8 + k] : lgt[12 + k])); }
            int i1 = 0; float b1 = sg[0], p1 = pg[0];
#pragma unroll
            for (int k = 1; k < 4; ++k) if (sg[k] > b1) { b1 = sg[k]; i1 = k; p1 = pg[k]; }
            int i2 = -1; float b2 = -INFINITY, p2 = 0.f;
#pragma unroll
            for (int k = 0; k < 4; ++k) if (k != i1 && sg[k] > b2) { b2 = sg[k]; i2 = k; p2 = pg[k]; }
            if (C.lane == 0) { const float gsum = p1 + p2; sE[tl * 2] = gi * 4 + i1; sE[tl * 2 + 1] = gi * 4 + i2; sG[tl * 2] = p1 / gsum; sG[tl * 2 + 1] = p2 / gsum; }
        }
        __syncthreads();
        if (C.tid < 128) sPos[C.tid] = __hip_atomic_fetch_add(lcnt + sE[C.tid], 1, __ATOMIC_RELAXED, __HIP_MEMORY_SCOPE_WORKGROUP);
        __syncthreads();
        if (C.tid < 16) lbase[C.tid] = (int)__hip_atomic_fetch_add(cnt + C.tid * 64, (unsigned)lcnt[C.tid], __ATOMIC_RELAXED, __HIP_MEMORY_SCOPE_AGENT);
        __syncthreads();
        if (C.tid < 128) { const int e = sE[C.tid], pos = lbase[e] + sPos[C.tid], tok = blk * 64 + (C.tid >> 1);
            list[e * LISTCAP + pos] = tok; tokE[tok * 2 + (C.tid & 1)] = e; tokP[tok * 2 + (C.tid & 1)] = pos; tokG[tok * 2 + (C.tid & 1)] = sG[C.tid]; }
    }
}
__device__ __forceinline__ void moe_prefix(const Ctx& C, int layer) {
    LAS int* mi = (LAS int*)(C.lds + LDS_MISC);
    unsigned* cnt = (unsigned*)(C.ws + WS_CTL) + CW_CNT + layer * 16 * 64;
    __syncthreads();
    if (C.tid < 16) mi[17 + C.tid] = (int)__hip_atomic_load(cnt + C.tid * 64, __ATOMIC_RELAXED, __HIP_MEMORY_SCOPE_AGENT);
    __syncthreads();
    if (C.tid == 0) { int a = 0; for (int e = 0; e < 16; ++e) { mi[e] = a; a += (mi[17 + e] + 255) >> 8; } mi[16] = a; }
    __syncthreads();
}
__device__ __forceinline__ void moe_tokens(const Ctx& C, int ntn) {
    const LAS int* mi = (const LAS int*)(C.lds + LDS_MISC); LAS int* toks = (LAS int*)(C.lds + LDS_TOKS);
    const int* list = (const int*)(C.ws + WS_LIST);
    for (int u = 0; u < MAX_UNITS; ++u) {
        const int L = u * C.G + C.bid; if (L >= mi[16] * ntn) break;
        int e = 0;
#pragma unroll
        for (int j = 1; j < 16; ++j) e += (L >= mi[j] * ntn) ? 1 : 0;
        const int r = L - mi[e] * ntn, te = mi[e + 1] - mi[e], mt = r % te, cn = mi[17 + e];
        if (C.tid < 256) { int pos = mt * 256 + C.tid; pos = pos < cn ? pos : cn - 1; toks[u * 256 + C.tid] = list[e * LISTCAP + pos]; }
    }
    __syncthreads();
}
__device__ __forceinline__ void combine_ln2(const Ctx& C, const Args& A, int layer) {
    const LAS int* mi = (const LAS int*)(C.lds + LDS_MISC);
    const bf16_t* X1B = (const bf16_t*)(C.ws + WS_X1B); const bf16_t* YD = (const bf16_t*)(C.ws + WS_YD); bf16_t* X2B = (bf16_t*)(C.ws + WS_XB);
    const int* tokE = (const int*)(C.ws + WS_TOKE); const int* tokP = (const int*)(C.ws + WS_TOKP); const float* tokG = (const float*)(C.ws + WS_TOKG);
    const float* lg = A.in[16] + layer * D; const float* lb = A.in[17] + layer * D;
    for (int tok = C.gw; tok < T; tok += C.NGW) {
        const int e0 = tokE[tok * 2], e1 = tokE[tok * 2 + 1]; const float g0 = tokG[tok * 2], g1 = tokG[tok * 2 + 1];
        int tb0 = 0, tb1 = 0;
#pragma unroll
        for (int j = 0; j < 16; ++j) { const int t = mi[j]; tb0 = (e0 == j) ? t : tb0; tb1 = (e1 == j) ? t : tb1; }
        const size_t r0 = (size_t)tb0 * 256 + tokP[tok * 2], r1 = (size_t)tb1 * 256 + tokP[tok * 2 + 1];
        f32x4 v[4]; float s = 0.f;
#pragma unroll
        for (int j = 0; j < 4; ++j) { const int col = 4 * C.lane + 256 * j;
            const u32x2 a = *(const u32x2*)(X1B + (size_t)tok * D + col), y0 = *(const u32x2*)(YD + r0 * D + col), y1 = *(const u32x2*)(YD + r1 * D + col);
            v[j][0] = ALPHA * bflo(a.x) + (g0 * bflo(y0.x) + g1 * bflo(y1.x)); v[j][1] = ALPHA * bfhi(a.x) + (g0 * bfhi(y0.x) + g1 * bfhi(y1.x));
            v[j][2] = ALPHA * bflo(a.y) + (g0 * bflo(y0.y) + g1 * bflo(y1.y)); v[j][3] = ALPHA * bfhi(a.y) + (g0 * bfhi(y0.y) + g1 * bfhi(y1.y));
            s += (v[j][0] + v[j][1]) + (v[j][2] + v[j][3]); }
        const float mean = wave_sum(s) * (1.f / D); float s2 = 0.f;
#pragma unroll
        for (int j = 0; j < 4; ++j) { v[j] = v[j] - mean; s2 += (v[j][0] * v[j][0] + v[j][1] * v[j][1]) + (v[j][2] * v[j][2] + v[j][3] * v[j][3]); }
        const float rstd = 1.0f / sqrtf(wave_sum(s2) * (1.f / D) + LN_EPS);
#pragma unroll
        for (int j = 0; j < 4; ++j) { const int col = 4 * C.lane + 256 * j; const f32x4 g4 = *(const f32x4*)(lg + col), b4 = *(const f32x4*)(lb + col);
            const f32x4 o = v[j] * rstd * g4 + b4;
            if (layer == 0) *(u32x2*)(X2B + (size_t)tok * D + col) = (u32x2){pk2(o[0], o[1]), pk2(o[2], o[3])};
            else *(f32x4*)(A.out + (size_t)tok * D + col) = o; }
    }
}

__global__ void __launch_bounds__(NTHREADS, 2) yoco_fwd(Args args) {
    extern __shared__ __attribute__((aligned(16))) unsigned char lds_raw[];
    Ctx C;
    C.ws = args.ws; C.lds = (LAS unsigned char*)lds_raw;
    C.tid = threadIdx.x; C.lane = C.tid & 63; C.wave = __builtin_amdgcn_readfirstlane(C.tid >> 6);
    C.G = gridDim.x; C.bid = blockIdx.x; C.gw = C.bid * NWAVES + C.wave; C.NGW = C.G * NWAVES;
    unsigned char* ws = args.ws;
#define PHASE_WS() do { ws = launder(args.ws); C.ws = ws; C.tid = launder_v((int)threadIdx.x); C.lane = C.tid & 63; } while (0)
    volatile LAS unsigned* misc = (volatile LAS unsigned*)(C.lds + LDS_MISC);
    for (int u = C.tid; u < 64; u += NTHREADS) misc[u] = 0u;
    __syncthreads();
    XcdBarrier bar; bar.bar = (unsigned*)(ws + WS_CTL) + CW_BAR; bar.x = 0; bar.st = misc + 60;
    const int lo = args.ph_lo, hi = args.ph_hi;
    if (hi - lo > 1) bar = xcd_barrier_post((unsigned*)(ws + WS_CTL) + CW_BAR, misc + 60);
#define IN(k) (lo <= (k) && (k) < hi)
#define SEAM(k) do { if (IN(k) && IN((k) + 1)) xcd_barrier(bar); } while (0)
#ifndef MK_DUP
#define MK_DUP 0
#endif
#define REP(k) for (int rep_ = 0; rep_ < 1 + ((MK_DUP >> (k)) & 1); ++rep_)

    if (IN(0)) { REP(0) { PHASE_WS(); p0_prologue(C, args); } SEAM(0); }

    if (IN(1)) {
        REP(1) {
        PHASE_WS();
        { pg8::Gemm g{(const bf16_t*)(ws + WS_XB), (const bf16_t*)(ws + WS_BT_INA), T, 1792, D}; pg8::StaticOrder S; S.init(T, 1792, C.G, C.bid);
          EpiProjA E{(bf16_t*)(ws + WS_U), (bf16_t*)(ws + WS_GV), (bf16_t*)(ws + WS_QM0)};
          pg8::gemm_phase<EpiProjA, pg8::StaticOrder>(C.lds, g, S, E, nullptr, C.tid); }
        { pg8::Gemm g{(const bf16_t*)(ws + WS_MEMB), (const bf16_t*)(ws + WS_BT_MEM), NB * NMEM, 1024, D}; SmallOrder S{4, 32, C.bid - (C.G - 32)};
          EpiPlain E{(bf16_t*)(ws + WS_MKV), 1024, 4};
          pg8::gemm_phase<EpiPlain, SmallOrder>(C.lds, g, S, E, nullptr, C.tid); }
        }
        SEAM(1);
    }
    if (IN(2)) {
        REP(2) { PHASE_WS();
        sg_mfma(C, args);
        memattn_mfma(C, (const bf16_t*)(ws + WS_QM0), (const bf16_t*)(ws + WS_MKV), 0, 256, (bf16_t*)(ws + WS_CAT), D, SGW); }
        SEAM(2);
    }
    if (IN(3)) {
        REP(3) { PHASE_WS();
        pg8::Gemm g{(const bf16_t*)(ws + WS_CAT), (const bf16_t*)(ws + WS_BT_OUTA), T, D, D}; pg8::StaticOrder S; S.init(T, D, C.G, C.bid);
        EpiResid<false> E{(const void*)args.in[0], (float*)(ws + WS_Y)};
        pg8::gemm_phase<EpiResid<false>, pg8::StaticOrder>(C.lds, g, S, E, nullptr, C.tid); }
        SEAM(3);
    }
    { constexpr int layer = 0;
        const int pb = 4 + 8 * layer;
        if (IN(pb)) { if ((MK_DUP >> 4) & 1) { PHASE_WS(); ln_route(C, args, layer, 2 + layer); __syncthreads(); } PHASE_WS(); ln_route(C, args, layer, layer); SEAM(pb); }
        if (IN(pb + 1)) {
            REP(5) { PHASE_WS();
            moe_prefix(C, layer); moe_tokens(C, 8);
            MoeGatherOrder S; S.tb = (const LAS int*)(C.lds + LDS_MISC); S.ntn = 8; S.G = C.G; S.c = C.bid; S.toks = (const LAS int*)(C.lds + LDS_TOKS);
            {
                pg8::Gemm g{(const bf16_t*)(ws + WS_X1F8), (const bf16_t*)(ws + WS_WGU + (size_t)layer * (64 * MiB)), 0, 0, D / 2, E8_ONE, E8_W};
                EpiSwiGLU8 E{ws + WS_ACT};
                pg8::gemm_phase<EpiSwiGLU8, MoeGatherOrder, false, true>(C.lds, g, S, E, nullptr, C.tid);
            } }
            SEAM(pb + 1);
        }
        if (IN(pb + 2)) {
            REP(6) { PHASE_WS();
            moe_prefix(C, layer);
            MoeOrder S{(const LAS int*)(C.lds + LDS_MISC), 4, C.G, C.bid};
            EpiPlain E{(bf16_t*)(ws + WS_YD), 1024, 4};
            {
                pg8::Gemm g{(const bf16_t*)(ws + WS_ACT), (const bf16_t*)(ws + WS_WD + (size_t)layer * (32 * MiB)), 0, 0, D / 2, E8_ACT, E8_W};
                pg8::gemm_phase<EpiPlain, MoeOrder, false, true>(C.lds, g, S, E, nullptr, C.tid);
            } }
            SEAM(pb + 2);
        }
        if (IN(pb + 3)) { REP(7) { PHASE_WS(); moe_prefix(C, layer); combine_ln2(C, args, layer); } if (layer == 0) SEAM(pb + 3); }
    }
    {
            if (IN(8)) {
                REP(8) { PHASE_WS();
                pg8::Gemm g{(const bf16_t*)(ws + WS_XB), (const bf16_t*)(ws + WS_BT_B), T, 2560, D}; pg8::StaticOrder S; S.init(T, 2560, C.G, C.bid);
                EpiProjB E{(bf16_t*)(ws + WS_K), (bf16_t*)(ws + WS_V), (bf16_t*)(ws + WS_Q), (bf16_t*)(ws + WS_QM1)};
                pg8::gemm_phase<EpiProjB, pg8::StaticOrder>(C.lds, g, S, E, nullptr, C.tid); }
                SEAM(8);
            }
            if (IN(9)) {
                REP(9) { PHASE_WS();
                dilattn_mfma(C);
                memattn_mfma(C, (const bf16_t*)(ws + WS_QM1), (const bf16_t*)(ws + WS_MKV), 512, 768, (bf16_t*)(ws + WS_CAT2), 512, 256); }
                SEAM(9);
            }
            if (IN(10)) { REP(10) { PHASE_WS(); dil_merge(C, args); } SEAM(10); }
            if (IN(11)) {
                REP(11) { PHASE_WS();
                pg8::Gemm g{(const bf16_t*)(ws + WS_CAT2), (const bf16_t*)(ws + WS_BT_OUTB), T, D, 512}; pg8::StaticOrder S; S.init(T, D, C.G, C.bid);
                EpiResid<true> E{(const void*)(ws + WS_XB), (float*)(ws + WS_Y)};
                pg8::gemm_phase<EpiResid<true>, pg8::StaticOrder>(C.lds, g, S, E, nullptr, C.tid); }
                SEAM(11);
            }
    }
    { constexpr int layer = 1;
        const int pb = 4 + 8 * layer;
        if (IN(pb)) { if ((MK_DUP >> 4) & 1) { PHASE_WS(); ln_route(C, args, layer, 2 + layer); __syncthreads(); } PHASE_WS(); ln_route(C, args, layer, layer); SEAM(pb); }
        if (IN(pb + 1)) {
            REP(5) { PHASE_WS();
            moe_prefix(C, layer); moe_tokens(C, 8);
            MoeGatherOrder S; S.tb = (const LAS int*)(C.lds + LDS_MISC); S.ntn = 8; S.G = C.G; S.c = C.bid; S.toks = (const LAS int*)(C.lds + LDS_TOKS);
            {
                pg8::Gemm g{(const bf16_t*)(ws + WS_X1F8), (const bf16_t*)(ws + WS_WGU + (size_t)layer * (64 * MiB)), 0, 0, D / 2, E8_ONE, E8_W};
                EpiSwiGLU8 E{ws + WS_ACT};
                pg8::gemm_phase<EpiSwiGLU8, MoeGatherOrder, false, true>(C.lds, g, S, E, nullptr, C.tid);
            } }
            SEAM(pb + 1);
        }
        if (IN(pb + 2)) {
            REP(6) { PHASE_WS();
            moe_prefix(C, layer);
            MoeOrder S{(const LAS int*)(C.lds + LDS_MISC), 4, C.G, C.bid};
            EpiPlain E{(bf16_t*)(ws + WS_YD), 1024, 4};
            {
                pg8::Gemm g{(const bf16_t*)(ws + WS_ACT), (const bf16_t*)(ws + WS_WD + (size_t)layer * (32 * MiB)), 0, 0, D / 2, E8_ACT, E8_W};
                pg8::gemm_phase<EpiPlain, MoeOrder, false, true>(C.lds, g, S, E, nullptr, C.tid);
            } }
            SEAM(pb + 2);
        }
        if (IN(pb + 3)) { REP(7) { PHASE_WS(); moe_prefix(C, layer); combine_ln2(C, args, layer); } if (layer == 0) SEAM(pb + 3); }
    }
#undef IN
#undef SEAM
}
}

extern "C" void kernel_launch(void* const* d_in, const int* in_sizes, int n_in, void* d_out, int out_size, void* d_ws, size_t ws_size, hipStream_t stream) {
    using namespace mk;
    static int grid = 0;
    if (grid == 0) {
        if (n_in != 23 || out_size != T * D || ws_size < WS_END) { fprintf(stderr, "kernel_launch: unexpected shapes (n_in %d, out %d, ws %zu)\n", n_in, out_size, ws_size); grid = -1; return; }
        int dev = 0, cus = 0, per_cu = 0;
        if (hipGetDevice(&dev) != hipSuccess || hipDeviceGetAttribute(&cus, hipDeviceAttributeMultiprocessorCount, dev) != hipSuccess) { grid = -1; return; }
        if (hipFuncSetAttribute((const void*)yoco_fwd, hipFuncAttributeMaxDynamicSharedMemorySize, LDS_BYTES) != hipSuccess) { fprintf(stderr, "kernel_launch: hipFuncSetAttribute failed\n"); grid = -1; return; }
        if (hipOccupancyMaxActiveBlocksPerMultiprocessor(&per_cu, (const void*)yoco_fwd, NTHREADS, LDS_BYTES) != hipSuccess || per_cu < 1)
            fprintf(stderr, "kernel_launch: occupancy query reports %d workgroups per CU\n", per_cu);
        (void)hipGetLastError();
        grid = cus;
    }
    if (grid < 0) return;
    (void)hipMemsetAsync((char*)d_ws + WS_CTL, 0, CTL_ZERO_BYTES, stream);
    Args a{};
    for (int i = 0; i < 23; ++i) a.in[i] = (const float*)d_in[i];
    a.out = (float*)d_out; a.ws = (unsigned char*)d_ws;
    constexpr int NL = MK_N_LAUNCHES;
    for (int li = 0; li < NL; ++li) {
        a.ph_lo = (NL == NPHASE) ? li : (li * NPHASE) / NL; a.ph_hi = (NL == NPHASE) ? li + 1 : ((li + 1) * NPHASE) / NL;
        hipLaunchKernelGGL(yoco_fwd, dim3(grid), dim3(NTHREADS), LDS_BYTES, stream, a);
    }
}
```

```cpp
#include <hip/hip_runtime.h>
#include <cstdio>
#include <cstdint>
namespace pg8 {
#define PG8_LAS __attribute__((address_space(3)))
typedef unsigned short bf16_t;
typedef short bf16x8 __attribute__((ext_vector_type(8)));
typedef float f32x4 __attribute__((ext_vector_type(4)));
typedef unsigned u32x4 __attribute__((ext_vector_type(4)));
constexpr int BM = 256, BK = 64, HALF = 128, HTB = HALF * BK * 2  , STAGE_BYTES = 8 * HTB, NXCD = 8, WGM = 8;

__host__ __device__ __forceinline__ int lds_byte(int r, int c) { const int st = (r >> 4) * 2 + (c >> 5), rr = r & 15, cc = c & 31, ob = rr * 64 + cc * 2; return st * 1024 + (ob ^ (((ob >> 9) & 1) << 5)); }
__host__ __device__ __forceinline__ void stage_rc(int b, int& R, int& C) { const int st = b / 1024, sb = b % 1024, swz = sb ^ (((sb >> 9) & 1) << 5); R = (st >> 1) * 16 + swz / 64; C = (st & 1) * 32 + (swz % 64) / 2; }
__host__ __device__ __forceinline__ int perm32(int rho) { const int n = rho >> 4, i = rho & 15; return 8 * (i >> 2) + 4 * n + (i & 3); }

struct Unit { int pm, pn; };
struct Gemm { const bf16_t* A; const bf16_t* Bt; int M, N, K; int sA, sB; };

struct StaticOrder {
    int nM, nN, nwg, G, c;
    __host__ __device__ void init(int M, int N, int G_, int c_) { nM = M / BM; nN = N / BM; nwg = nM * nN; G = G_; c = c_; }
    __host__ __device__ bool next(int i, Unit& u) const {
        const long L = (long)i * G + c; if (L >= nwg) return false;
        int wgid = (int)L; { const int q = nwg / NXCD, r = nwg % NXCD, xcd = wgid % NXCD, off = wgid / NXCD; wgid = (xcd < r ? xcd * (q + 1) : r * (q + 1) + (xcd - r) * q) + off; }
        const int nig = WGM * nN, gid = wgid / nig, fm = gid * WGM, gsz = (nM - fm) < WGM ? (nM - fm) : WGM;
        u.pm = fm + ((wgid % nig) % gsz); u.pn = (wgid % nig) / gsz; return true;
    }
    __device__ __forceinline__ void a_ready(const Unit&) const {}
    __device__ __forceinline__ void done(const Unit&) const {}
    __device__ __forceinline__ int arow(int, const Unit& u, int r) const { return u.pm * BM + r; }
};
__device__ __forceinline__ unsigned cvt_pk_bf16(float lo, float hi) { unsigned r; asm volatile("v_cvt_pk_bf16_f32 %0, %1, %2" : "=v"(r) : "v"(lo), "v"(hi)); return r; }
typedef float f32x2 __attribute__((ext_vector_type(2)));
__device__ __forceinline__ f32x2 gelu_pk(f32x2 v) {
    const f32x2 av = __builtin_elementwise_abs(v), d = av * 0.2316418882f + 1.0f;
    f32x2 t; t.x = __builtin_amdgcn_rcpf(d.x); t.y = __builtin_amdgcn_rcpf(d.y);
    f32x2 q = t * 0.5307027145f + (-0.7265760135f); q = q * t + 0.7107068705f; q = q * t + (-0.142248368f); q = q * t + 0.127414796f; q = q * t;
    const f32x2 s = (v * v) * (-0.72134752044f);
    f32x2 e; e.x = __builtin_amdgcn_exp2f(s.x); e.y = __builtin_amdgcn_exp2f(s.y);
    const f32x2 m = v * (q * e), r = v - m;
    f32x2 o; o.x = v.x < 0.f ? m.x : r.x; o.y = v.y < 0.f ? m.y : r.y; return o;
}
template <class Epi, class Sched, bool STAMP = false, bool F8 = false>
__device__ __forceinline__ void gemm_phase(PG8_LAS unsigned char* lds, const Gemm g, const Sched& S, const Epi& E, unsigned long long* stamps, const int tid) {
    const int wid = __builtin_amdgcn_readfirstlane(tid >> 6), lane = tid & 63, wr = wid >> 2, wc = wid & 3, fr = lane & 15, fq = lane >> 4;
    const int K = g.K, nt = K / BK;
    int ts_lo = 0, ts_hi = 0, nts = 0; const unsigned long long rt_entry = STAMP ? (unsigned long long)wall_clock64() : 0ull;
#define PG8_STAMP() do { if (STAMP && wid == 0 && nts < 64) { const unsigned long long _c = (unsigned long long)clock64(); \
        ts_lo = (lane == nts) ? (int)(unsigned)_c : ts_lo; ts_hi = (lane == nts) ? (int)(unsigned)(_c >> 32) : ts_hi; ++nts; } } while (0)
    PG8_STAMP();
    unsigned colA[2], voffB[2]; int rowA[2];
#pragma unroll
    for (int i = 0; i < 2; ++i) { int R, C; stage_rc(tid * 16 + i * 8192, R, C); const int Rb = Epi::PERM ? ((R & ~31) + perm32(R & 31)) : R;
        rowA[i] = R; colA[i] = (unsigned)C * 2u; voffB[i] = (unsigned)(Rb * K + C) * 2u; }
#define PG8_AOFF(dst, uidx, un) do { _Pragma("unroll") for (int _h = 0; _h < 2; ++_h) _Pragma("unroll") for (int _i = 0; _i < 2; ++_i) \
        dst[_h][_i] = (unsigned)S.arow((uidx), (un), _h * HALF + rowA[_i]) * (unsigned)(K * 2) + colA[_i]; } while (0)
    const size_t kstep = (size_t)(BK * 2);
    const size_t hstep = (size_t)HALF * K * 2;
    const size_t tstep = 2 * hstep;
    const unsigned ldsw = (unsigned)wid * 1024u;
    const int aoff = F8 ? lds_byte(wr * 64 + fr, fq * 16) : lds_byte(wr * 64 + fr, fq * 8), boff = F8 ? lds_byte(wc * 32 + fr, fq * 16) : lds_byte(wc * 32 + fr, fq * 8);
    constexpr int KOFF = F8 ? 16 : 1024;
#define PG8_SA(b, h) (((b) * 2 + (h)) * HTB)
#define PG8_SB(b, h) ((4 + (b) * 2 + (h)) * HTB)
#define PG8_STAGE(bufoff, gbase, voff) do { _Pragma("unroll") for (int _i = 0; _i < 2; ++_i) \
        __builtin_amdgcn_global_load_lds((const unsigned*)((const char*)(gbase) + (voff)[_i]), (PG8_LAS unsigned*)(lds + (bufoff) + ldsw + _i * 8192), 16, 0, 0); } while (0)
#define PG8_LDA(dst, b, h) do { _Pragma("unroll") for (int m = 0; m < 4; ++m) _Pragma("unroll") for (int k = 0; k < 2; ++k) dst[m][k] = *(const PG8_LAS bf16x8*)(lds + PG8_SA(b, h) + aoff + m * 2048 + k * KOFF); } while (0)
#define PG8_LDB(dst, b, h) do { _Pragma("unroll") for (int n = 0; n < 2; ++n) _Pragma("unroll") for (int k = 0; k < 2; ++k) dst[n][k] = *(const PG8_LAS bf16x8*)(lds + PG8_SB(b, h) + boff + n * 2048 + k * KOFF); } while (0)
#define PG8_MMA(ai, bj, At, Bt) do { __builtin_amdgcn_s_setprio(1); \
        if constexpr (F8) { _Pragma("unroll") for (int m = 0; m < 4; ++m) _Pragma("unroll") for (int n = 0; n < 2; ++n) { \
            typedef int i32x4_ __attribute__((ext_vector_type(4))); typedef int i32x8_ __attribute__((ext_vector_type(8))); \
            const i32x8_ b8_ = __builtin_shufflevector(__builtin_bit_cast(i32x4_, Bt[n][0]), __builtin_bit_cast(i32x4_, Bt[n][1]), 0, 1, 2, 3, 4, 5, 6, 7); \
            const i32x8_ a8_ = __builtin_shufflevector(__builtin_bit_cast(i32x4_, At[m][0]), __builtin_bit_cast(i32x4_, At[m][1]), 0, 1, 2, 3, 4, 5, 6, 7); \
            acc[ai][bj][m][n] = __builtin_amdgcn_mfma_scale_f32_16x16x128_f8f6f4(b8_, a8_, acc[ai][bj][m][n], 0, 0, 0, g.sB, 0, g.sA); } } \
        else { _Pragma("unroll") for (int m = 0; m < 4; ++m) _Pragma("unroll") for (int n = 0; n < 2; ++n) _Pragma("unroll") for (int k = 0; k < 2; ++k) \
            acc[ai][bj][m][n] = __builtin_amdgcn_mfma_f32_16x16x32_bf16(Bt[n][k], At[m][k], acc[ai][bj][m][n], 0, 0, 0); } \
        __builtin_amdgcn_s_setprio(0); } while (0)
#define PG8_WAIT_V(n) asm volatile("s_waitcnt vmcnt(" #n ")" ::: "memory")
#define PG8_WAIT_L(n) asm volatile("s_waitcnt lgkmcnt(" #n ")" ::: "memory")
#define PG8_BAR __builtin_amdgcn_s_barrier()
#define PG8_SCHED __builtin_amdgcn_sched_barrier(0)
    Unit cur, nxt; int ui = 0;
    if (!S.next(0, cur)) return;
    f32x4 acc[2][2][4][2];
#pragma unroll
    for (int a = 0; a < 2; ++a)
#pragma unroll
        for (int b = 0; b < 2; ++b)
#pragma unroll
            for (int m = 0; m < 4; ++m)
#pragma unroll
                for (int n = 0; n < 2; ++n) acc[a][b][m][n] = (f32x4){0.f, 0.f, 0.f, 0.f};
    bf16x8 At[4][2], B0[2][2], B1[2][2];
    const char* Ab = (const char*)g.A; const char* cB = (const char*)g.Bt + (size_t)cur.pn * tstep;
    unsigned cuA[2][2];
    S.a_ready(cur);
    PG8_AOFF(cuA, 0, cur);
    PG8_STAGE(PG8_SB(0, 0), cB, voffB); PG8_STAGE(PG8_SA(0, 0), Ab, cuA[0]); PG8_STAGE(PG8_SB(0, 1), cB + hstep, voffB); PG8_STAGE(PG8_SA(0, 1), Ab, cuA[1]);
    if (wr == 1) PG8_BAR;
    PG8_WAIT_V(4); PG8_BAR;
    PG8_STAGE(PG8_SB(1, 0), cB + kstep, voffB); PG8_STAGE(PG8_SA(1, 0), Ab + kstep, cuA[0]); PG8_STAGE(PG8_SB(1, 1), cB + hstep + kstep, voffB);
    PG8_WAIT_V(6); PG8_BAR;
    PG8_STAMP();
    for (;;) {
        const bool has_next = S.next(ui + 1, nxt);
        const char* nB = has_next ? (const char*)g.Bt + (size_t)nxt.pn * tstep : cB;
        for (int t = 0; t < nt; t += 2) {
            const bool last = (t == nt - 2);
            const char* a1 = Ab + (size_t)(t + 1) * kstep;
            const char* a2 = last ? Ab : Ab + (size_t)(t + 2) * kstep; const char* b2 = last ? nB : cB + (size_t)(t + 2) * kstep;
            const char* a3 = a2 + kstep; const char* b3 = b2 + kstep;

            if (last && has_next) S.a_ready(nxt);
            PG8_LDB(B0, 0, 0); PG8_SCHED; PG8_LDA(At, 0, 0); PG8_STAGE(PG8_SA(1, 1), a1, cuA[1]);
            PG8_WAIT_L(8); PG8_BAR; PG8_WAIT_L(0); PG8_MMA(0, 0, At, B0); PG8_BAR; PG8_SCHED;
            if (last && has_next) PG8_AOFF(cuA, ui + 1, nxt);
            PG8_LDB(B1, 0, 1); PG8_STAGE(PG8_SB(0, 0), b2, voffB);
            PG8_BAR; PG8_WAIT_L(0); PG8_MMA(0, 1, At, B1); PG8_BAR;
            PG8_LDA(At, 0, 1); PG8_STAGE(PG8_SA(0, 0), a2, cuA[0]);
            PG8_BAR; PG8_WAIT_L(0); PG8_MMA(1, 0, At, B0); PG8_BAR; PG8_SCHED;
            PG8_STAGE(PG8_SB(0, 1), b2 + hstep, voffB);
            PG8_WAIT_V(6); PG8_BAR; PG8_MMA(1, 1, At, B1); PG8_BAR;
            PG8_LDB(B0, 1, 0); PG8_SCHED; PG8_LDA(At, 1, 0); PG8_STAGE(PG8_SA(0, 1), a2, cuA[1]);
            PG8_WAIT_L(8); PG8_BAR; PG8_WAIT_L(0); PG8_MMA(0, 0, At, B0); PG8_BAR; PG8_SCHED;
            PG8_LDB(B1, 1, 1); PG8_STAGE(PG8_SB(1, 0), b3, voffB);
            PG8_BAR; PG8_WAIT_L(0); PG8_MMA(0, 1, At, B1); PG8_BAR;
            PG8_LDA(At, 1, 1); PG8_STAGE(PG8_SA(1, 0), a3, cuA[0]);
            PG8_BAR; PG8_WAIT_L(0); PG8_MMA(1, 0, At, B0); PG8_BAR; PG8_SCHED;
            PG8_STAGE(PG8_SB(1, 1), b3 + hstep, voffB);
            PG8_WAIT_V(6); PG8_BAR; PG8_MMA(1, 1, At, B1); PG8_BAR;
        }
        PG8_STAMP();
        if constexpr (!Epi::AFTER_DRAIN) { E(acc, cur, wr, wc, fr, fq); S.done(cur); }
        PG8_STAMP();
        if (!has_next) break;
#pragma unroll
        for (int a = 0; a < 2; ++a)
#pragma unroll
            for (int b = 0; b < 2; ++b)
#pragma unroll
                for (int m = 0; m < 4; ++m)
#pragma unroll
                    for (int n = 0; n < 2; ++n) acc[a][b][m][n] = (f32x4){0.f, 0.f, 0.f, 0.f};
        cur = nxt; cB = nB; ++ui;
    }
    PG8_WAIT_V(0);
    if (wr == 0) PG8_BAR;
    PG8_BAR;
    if constexpr (Epi::AFTER_DRAIN) { E.fused(acc, cur, wr, wc, fr, fq, lds, wid, lane); S.done(cur); }
    PG8_STAMP();
    if (STAMP && wid == 0) { stamps[lane] = lane < nts ? (((unsigned long long)(unsigned)ts_hi << 32) | (unsigned)ts_lo) : 0ull;
        if (lane == 62) stamps[62] = rt_entry; if (lane == 63) stamps[63] = (unsigned long long)wall_clock64(); }
#undef PG8_STAMP
#undef PG8_SA
#undef PG8_SB
#undef PG8_STAGE
#undef PG8_AOFF
#undef PG8_LDA
#undef PG8_LDB
#undef PG8_MMA
#undef PG8_WAIT_V
#undef PG8_WAIT_L
#undef PG8_BAR
#undef PG8_SCHED
}
}

namespace mk {
using pg8::bf16_t; using pg8::f32x4; using pg8::u32x4; using pg8::Unit; using pg8::cvt_pk_bf16;
#define LAS __attribute__((address_space(3)))
typedef float f32x2 __attribute__((ext_vector_type(2)));
typedef unsigned u32x2 __attribute__((ext_vector_type(2)));

#ifndef MK_DIAG
#define MK_DIAG 0
#endif
#ifndef MK_DIAGMASK
#define MK_DIAGMASK 0xFFFF
#endif
#ifndef MK_N_LAUNCHES
#define MK_N_LAUNCHES 1
#endif
constexpr int NPHASE = 16;
constexpr int NB = 8, SEQ = 2048, D = 1024, T = NB * SEQ, NMEM = 256, SGW = 768, NSG = 12, HD = 64, CH = 128;
constexpr int NEXP = 16, LISTCAP = 16384;
constexpr float ALPHA = 1.41421356237f;
constexpr float LN_EPS = 1e-5f, ATT_SCALE = 0.125f;
constexpr int NWAVES = 8, NTHREADS = 512;

constexpr size_t MiB = 1u << 20;
constexpr size_t WS_CTL = 0, CTL_ZERO_BYTES = 1 * MiB;
constexpr size_t WS_TOKE = 1 * MiB, WS_TOKP = WS_TOKE + 128 * 1024, WS_TOKG = WS_TOKP + 128 * 1024;
constexpr size_t WS_LIST = 2 * MiB, WS_LSE = 3 * MiB, WS_SGWB = 4 * MiB;
constexpr size_t WS_MKV = 8 * MiB, WS_MEMB = 12 * MiB;
constexpr size_t WS_BT_INA = 18 * MiB, WS_BT_OUTA = 22 * MiB, WS_BT_B = 24 * MiB, WS_BT_OUTB = 29 * MiB, WS_BT_MEM = 30 * MiB;
constexpr size_t WS_WGU = 32 * MiB, WS_WD = 160 * MiB;
constexpr size_t WS_A = 224 * MiB;
constexpr size_t WS_U = WS_A, WS_GV = WS_A + 24 * MiB, WS_QM0 = WS_A + 48 * MiB;
constexpr size_t WS_K = WS_A, WS_V = WS_A + 24 * MiB, WS_Q = WS_A + 48 * MiB, WS_QM1 = WS_A + 72 * MiB;
constexpr size_t WS_ACT = WS_A;
constexpr size_t WS_XB = 304 * MiB;
constexpr size_t WS_C = 336 * MiB;
constexpr size_t WS_CAT = WS_C, WS_OG = WS_C, WS_CAT2 = WS_C + 24 * MiB;
constexpr size_t WS_Y = 376 * MiB;
constexpr size_t WS_YD = 336 * MiB;
constexpr size_t WS_X1B = 440 * MiB;
constexpr size_t WS_X1F8 = 472 * MiB;
constexpr size_t WS_END = 488 * MiB;
constexpr size_t WS_WGU8 = WS_WGU + 64 * MiB, WS_WD8 = WS_WD + 32 * MiB;
constexpr int CW_TMO = 0, CW_BAR = 4096, CW_CNT = 16384, CW_CONV = 24576, CW_DONE = 24640;
constexpr int LDS_TOKS = 131072 + 1024, MAX_UNITS = 8;
constexpr int LDS_MISC = 131072;
constexpr int LDS_BYTES = 147456;
static_assert(LDS_TOKS + MAX_UNITS * 1024 <= LDS_BYTES, "LDS map");

#define LDS_WAIT() asm volatile("s_waitcnt lgkmcnt(0)" ::: "memory")
#define VM_WAIT() asm volatile("s_waitcnt vmcnt(0)" ::: "memory")
__device__ __forceinline__ unsigned f2bf(float f) { unsigned u = __builtin_bit_cast(unsigned, f); return (u + 0x7fffu + ((u >> 16) & 1u)) >> 16; }
__device__ __forceinline__ unsigned pk2(float lo, float hi) { return f2bf(lo) | (f2bf(hi) << 16); }
__device__ __forceinline__ unsigned pk4_fp8_e(float a, float b, float c, float d) { int r = 0; r = __builtin_amdgcn_cvt_pk_fp8_f32(a, b, r, false); r = __builtin_amdgcn_cvt_pk_fp8_f32(c, d, r, true); return (unsigned)r; }
__device__ __forceinline__ float bflo(unsigned w) { return __uint_as_float(w << 16); }
__device__ __forceinline__ float bfhi(unsigned w) { return __uint_as_float(w & 0xffff0000u); }
__device__ __forceinline__ float bf1(bf16_t v) { return __uint_as_float(((unsigned)v) << 16); }
__device__ __forceinline__ float wave_sum(float v) {
#pragma unroll
    for (int o = 1; o < 64; o <<= 1) v += __shfl_xor(v, o);
    return v;
}
template <int CTRL> __device__ __forceinline__ float dpp_f(float v) { return __builtin_bit_cast(float, __builtin_amdgcn_update_dpp(0, __builtin_bit_cast(int, v), CTRL, 0xf, 0xf, false)); }
__device__ __forceinline__ float row_sum(float v) { v += dpp_f<0xB1>(v); v += dpp_f<0x4E>(v); v += dpp_f<0x141>(v); v += dpp_f<0x140>(v); return v; }
__device__ __forceinline__ float wave_sum_dpp(float v) { v = row_sum(v); v += __shfl_xor(v, 16); v += __shfl_xor(v, 32); return v; }
__device__ __forceinline__ float wave_max(float v) {
#pragma unroll
    for (int o = 1; o < 64; o <<= 1) v = fmaxf(v, __shfl_xor(v, o));
    return v;
}

#define XB_TMO      128
#define XB_XCNT(j)  (256  + 64 * (j))
#define XB_XSUB(j)  (1280 + 64 * (j))
#define XB_XGEN(j)  (2304 + 64 * (j))
#define XB_TOP      3328
#define XB_TOPGEN   3392
#define XCD_BAR_WORDS 3456
#define XB_SPIN_CAP (1u << 18)
__device__ __forceinline__ unsigned xb_ld(unsigned* p)              { return __hip_atomic_load(p, __ATOMIC_RELAXED, __HIP_MEMORY_SCOPE_AGENT); }
__device__ __forceinline__ unsigned xb_add(unsigned* p, unsigned v) { return __hip_atomic_fetch_add(p, v, __ATOMIC_RELAXED, __HIP_MEMORY_SCOPE_AGENT); }
__device__ __forceinline__ unsigned xb_xcc_id() { return (unsigned)__builtin_amdgcn_s_getreg((3 << 11) | 20) & 0xFu; }
#define XB_SPIN(cond, bar) do { unsigned _sp = 0; while (cond) { __builtin_amdgcn_s_sleep(1); \
    if ((++_sp & 255u) == 0u) { if (xb_ld(&(bar)[XB_TMO])) break; if (_sp > XB_SPIN_CAP) { atomicAdd(&(bar)[XB_TMO], 1u); break; } } } } while (0)
struct XcdBarrier { unsigned* bar; unsigned x; volatile LAS unsigned* st; };
__device__ __forceinline__ XcdBarrier xcd_barrier_post(unsigned* bar, volatile LAS unsigned* st) {
    XcdBarrier b; b.bar = bar; b.x = xb_xcc_id(); b.st = st;
    if (threadIdx.x == 0) (void)xb_add(&bar[XB_XCNT(b.x)], 1u);
    return b;
}
__device__ __forceinline__ void xcd_barrier_complete(unsigned* bar, unsigned x, unsigned& nloc, unsigned& nx) {
    const unsigned G = gridDim.x * gridDim.y * gridDim.z;
    unsigned sum, cnt, mine, sp = 0u;
    for (;;) {
        sum = 0u; cnt = 0u; mine = 0u;
#pragma unroll
        for (unsigned j = 0; j < 16; ++j) { const unsigned c = xb_ld(&bar[XB_XCNT(j)]); sum += c; cnt += (c > 0u) ? 1u : 0u; mine = (j == x) ? c : mine; }
        if (sum == G) break;
        __builtin_amdgcn_s_sleep(1);
        if ((++sp & 255u) == 0u) { if (xb_ld(&bar[XB_TMO])) break; if (sp > XB_SPIN_CAP) { atomicAdd(&bar[XB_TMO], 1u); break; } }
    }
    nloc = mine > 0u ? mine : 1u; nx = cnt > 0u ? cnt : 1u;
}
__device__ __forceinline__ void xcd_barrier(const XcdBarrier& b) {
    asm volatile("s_waitcnt vmcnt(0)" ::: "memory");
    __syncthreads();
    if (threadIdx.x == 0) {
        unsigned* bar = b.bar;
        __builtin_amdgcn_s_waitcnt(0);
        unsigned nloc = b.st[0], nx = b.st[1];
        if (nloc == 0u) { xcd_barrier_complete(bar, b.x, nloc, nx); b.st[0] = nloc; b.st[1] = nx; }
        const unsigned old = xb_add(&bar[XB_XSUB(b.x)], 1u);
        const unsigned gen = old / nloc;
        if (old + 1u == (gen + 1u) * nloc) {
            __builtin_amdgcn_fence(__ATOMIC_RELEASE, "agent");
            asm volatile("s_waitcnt vmcnt(0)" ::: "memory");
            const unsigned og = xb_add(&bar[XB_TOP], 1u);
            const unsigned tg = og / nx;
            if (og + 1u == (tg + 1u) * nx) xb_add(&bar[XB_TOPGEN], 1u);
            else XB_SPIN(xb_ld(&bar[XB_TOPGEN]) == tg, bar);
            __builtin_amdgcn_fence(__ATOMIC_ACQUIRE, "agent");
            xb_add(&bar[XB_XGEN(b.x)], 1u);
            asm volatile("s_waitcnt vmcnt(0)" ::: "memory");
        } else {
            XB_SPIN(xb_ld(&bar[XB_XGEN(b.x)]) == gen, bar);
            __builtin_amdgcn_fence(__ATOMIC_ACQUIRE, "agent");
            asm volatile("s_waitcnt vmcnt(0)" ::: "memory");
        }
    }
    __syncthreads();
}


struct EpiProjA {
    static constexpr bool PERM = true, AFTER_DRAIN = false;
    bf16_t *u, *gv, *qm;
    __device__ __forceinline__ void operator()(const f32x4 (&acc)[2][2][4][2], const Unit& un, int wr, int wc, int fr, int fq) const {
        const int row0 = un.pm * 256 + wr * 64 + fr;
        bf16_t* base; int ldc, colt; bool act; float sc = 1.f;
        if (un.pn < 3) { base = u; ldc = SGW; colt = un.pn * 256; act = true; }
        else if (un.pn < 6) { base = gv; ldc = SGW; colt = (un.pn - 3) * 256; act = true; }
        else { base = qm; ldc = 256; colt = 0; act = false; sc = ATT_SCALE; }
        const int col0 = colt + wc * 32 + 8 * fq;
#pragma unroll
        for (int ai = 0; ai < 2; ++ai)
#pragma unroll
            for (int m = 0; m < 4; ++m) { bf16_t* rowp = base + (size_t)(row0 + ai * 128 + m * 16) * ldc + col0;
#pragma unroll
                for (int bj = 0; bj < 2; ++bj) { f32x4 v0 = acc[ai][bj][m][0], v1 = acc[ai][bj][m][1];
                    if (act) { pg8::f32x2 a = pg8::gelu_pk((pg8::f32x2){v0[0], v0[1]}), b = pg8::gelu_pk((pg8::f32x2){v0[2], v0[3]}), c = pg8::gelu_pk((pg8::f32x2){v1[0], v1[1]}), d = pg8::gelu_pk((pg8::f32x2){v1[2], v1[3]});
                        v0 = (f32x4){a.x, a.y, b.x, b.y}; v1 = (f32x4){c.x, c.y, d.x, d.y}; }
                    v0 = v0 * sc; v1 = v1 * sc;
                    u32x4 w; w.x = cvt_pk_bf16(v0[0], v0[1]); w.y = cvt_pk_bf16(v0[2], v0[3]); w.z = cvt_pk_bf16(v1[0], v1[1]); w.w = cvt_pk_bf16(v1[2], v1[3]);
                    *(u32x4*)(rowp + bj * 128) = w; } }
    }
};
struct EpiProjB {
    static constexpr bool PERM = true, AFTER_DRAIN = false;
    bf16_t *k, *v, *q, *qm;
    __device__ __forceinline__ void operator()(const f32x4 (&acc)[2][2][4][2], const Unit& un, int wr, int wc, int fr, int fq) const {
        const int row0 = un.pm * 256 + wr * 64 + fr;
        bf16_t* base; int ldc, colt; float sc = 1.f;
        if (un.pn < 3) { base = k; ldc = SGW; colt = un.pn * 256; }
        else if (un.pn < 6) { base = v; ldc = SGW; colt = (un.pn - 3) * 256; }
        else if (un.pn < 9) { base = q; ldc = SGW; colt = (un.pn - 6) * 256; sc = ATT_SCALE; }
        else { base = qm; ldc = 256; colt = 0; sc = ATT_SCALE; }
        const int col0 = colt + wc * 32 + 8 * fq;
#pragma unroll
        for (int ai = 0; ai < 2; ++ai)
#pragma unroll
            for (int m = 0; m < 4; ++m) { bf16_t* rowp = base + (size_t)(row0 + ai * 128 + m * 16) * ldc + col0;
#pragma unroll
                for (int bj = 0; bj < 2; ++bj) { f32x4 v0 = acc[ai][bj][m][0] * sc, v1 = acc[ai][bj][m][1] * sc;
                    u32x4 w; w.x = cvt_pk_bf16(v0[0], v0[1]); w.y = cvt_pk_bf16(v0[2], v0[3]); w.z = cvt_pk_bf16(v1[0], v1[1]); w.w = cvt_pk_bf16(v1[2], v1[3]);
                    *(u32x4*)(rowp + bj * 128) = w; } }
    }
};
struct EpiPlain {
    static constexpr bool PERM = true, AFTER_DRAIN = false;
    bf16_t* O; int ldc, ntn;
    __device__ __forceinline__ void operator()(const f32x4 (&acc)[2][2][4][2], const Unit& un, int wr, int wc, int fr, int fq) const {
        const int row0 = un.pm * 256 + wr * 64 + fr;
        const int col0 = (un.pn % ntn) * 256 + wc * 32 + 8 * fq;
#pragma unroll
        for (int ai = 0; ai < 2; ++ai)
#pragma unroll
            for (int m = 0; m < 4; ++m) { bf16_t* rowp = O + (size_t)(row0 + ai * 128 + m * 16) * ldc + col0;
#pragma unroll
                for (int bj = 0; bj < 2; ++bj) { const f32x4 v0 = acc[ai][bj][m][0], v1 = acc[ai][bj][m][1];
                    u32x4 w; w.x = cvt_pk_bf16(v0[0], v0[1]); w.y = cvt_pk_bf16(v0[2], v0[3]); w.z = cvt_pk_bf16(v1[0], v1[1]); w.w = cvt_pk_bf16(v1[2], v1[3]);
                    *(u32x4*)(rowp + bj * 128) = w; } }
    }
};
struct EpiSwiGLU {
    static constexpr bool PERM = true, AFTER_DRAIN = false;
    bf16_t* O;
    __device__ __forceinline__ void operator()(const f32x4 (&acc)[2][2][4][2], const Unit& un, int wr, int wc, int fr, int fq) const {
        const int row0 = un.pm * 256 + wr * 64 + fr;
        const int col0 = (un.pn & 7) * 128 + wc * 32 + 8 * fq;
#pragma unroll
        for (int ai = 0; ai < 2; ++ai)
#pragma unroll
            for (int m = 0; m < 4; ++m) { bf16_t* rowp = O + (size_t)(row0 + ai * 128 + m * 16) * 1024 + col0;
                float r[8];
#pragma unroll
                for (int n = 0; n < 2; ++n)
#pragma unroll
                    for (int j = 0; j < 4; ++j) { const float g = acc[ai][0][m][n][j], up = acc[ai][1][m][n][j];
                        r[n * 4 + j] = g * __builtin_amdgcn_rcpf(1.0f + __expf(-g)) * up; }
                u32x4 w; w.x = cvt_pk_bf16(r[0], r[1]); w.y = cvt_pk_bf16(r[2], r[3]); w.z = cvt_pk_bf16(r[4], r[5]); w.w = cvt_pk_bf16(r[6], r[7]);
                *(u32x4*)rowp = w; }
    }
};
struct EpiSwiGLU8 {
    static constexpr bool PERM = true, AFTER_DRAIN = false;
    unsigned char* O;
    __device__ __forceinline__ void operator()(const f32x4 (&acc)[2][2][4][2], const Unit& un, int wr, int wc, int fr, int fq) const {
        const int row0 = un.pm * 256 + wr * 64 + fr;
        const int col0 = (un.pn & 7) * 128 + wc * 32 + 8 * fq;
#pragma unroll
        for (int ai = 0; ai < 2; ++ai)
#pragma unroll
            for (int m = 0; m < 4; ++m) { unsigned char* rowp = O + (size_t)(row0 + ai * 128 + m * 16) * 1024 + col0;
                float r[8];
#pragma unroll
                for (int n = 0; n < 2; ++n)
#pragma unroll
                    for (int j = 0; j < 4; ++j) { const float g = acc[ai][0][m][n][j], up = acc[ai][1][m][n][j];
                        r[n * 4 + j] = g * __builtin_amdgcn_rcpf(1.0f + __expf(-g)) * up * 8.0f; }
                *(u32x2*)rowp = (u32x2){pk4_fp8_e(r[0], r[1], r[2], r[3]), pk4_fp8_e(r[4], r[5], r[6], r[7])}; }
    }
};
template <bool RB> struct EpiResid {
    static constexpr bool PERM = false, AFTER_DRAIN = false;
    const void* res; float* Y;
    __device__ __forceinline__ void operator()(const f32x4 (&acc)[2][2][4][2], const Unit& un, int wr, int wc, int fr, int fq) const {
        const int row0 = un.pm * 256 + wr * 64 + fr, col0 = un.pn * 256 + wc * 32 + 4 * fq;
#pragma unroll
        for (int ai = 0; ai < 2; ++ai)
#pragma unroll
            for (int m = 0; m < 4; ++m) { const size_t off = (size_t)(row0 + ai * 128 + m * 16) * D + col0;
#pragma unroll
                for (int bj = 0; bj < 2; ++bj)
#pragma unroll
                    for (int n = 0; n < 2; ++n) { const size_t o = off + bj * 128 + n * 16; f32x4 r;
                        if (RB) { const u32x2 w = *(const u32x2*)((const bf16_t*)res + o); r = (f32x4){bflo(w.x), bfhi(w.x), bflo(w.y), bfhi(w.y)}; }
                        else r = *(const f32x4*)((const float*)res + o);
                        *(f32x4*)(Y + o) = r * ALPHA + acc[ai][bj][m][n]; } }
    }
};
struct SmallOrder {
    int nN, nwg, c;
    __device__ bool next(int i, Unit& u) const { if (i != 0 || c < 0 || c >= nwg) return false; u.pm = c / nN; u.pn = c % nN; return true; }
    __device__ __forceinline__ void a_ready(const Unit&) const {}
    __device__ __forceinline__ void done(const Unit&) const {}
    __device__ __forceinline__ int arow(int, const Unit& u, int r) const { return u.pm * 256 + r; }
};
struct MoeOrder {
    const LAS int* tb;
    int ntn, G, c;
    __device__ bool next(int i, Unit& u) const {
        const int L = i * G + c; if (L >= tb[16] * ntn) return false;
        int e = 0;
#pragma unroll
        for (int j = 1; j < 16; ++j) e += (L >= tb[j] * ntn) ? 1 : 0;
        const int r = L - tb[e] * ntn, te = tb[e + 1] - tb[e];
        u.pm = tb[e] + r % te; u.pn = e * ntn + r / te; return true;
    }
    __device__ __forceinline__ void a_ready(const Unit&) const {}
    __device__ __forceinline__ void done(const Unit&) const {}
    __device__ __forceinline__ int arow(int, const Unit& u, int r) const { return u.pm * 256 + r; }
};
struct MoeGatherOrder : MoeOrder {
    const LAS int* toks;
    __device__ __forceinline__ int arow(int ui, const Unit&, int r) const { return toks[ui * 256 + r]; }
};

struct Args { const float* in[23]; float* out; unsigned char* ws; int ph_lo, ph_hi; };
struct Ctx {
    unsigned char* ws; LAS unsigned char* lds;
    int tid, lane, wave, gw, NGW, G, bid;
};
__device__ __forceinline__ unsigned char* launder(unsigned char* p) { asm volatile("" : "+s"(p)); return p; }
__device__ __forceinline__ int launder_v(int v) { asm volatile("" : "+v"(v)); return v; }

__device__ __forceinline__ void tr_item(const float* W, int K, int N, bf16_t* WT, int grp, int gstride, int roff, LAS float* scr, int item, int lane) {
    const int nblk = N / 32, kb = item / nblk, nb = item % nblk, k0 = 64 * kb, n0 = 32 * nb;
    float ld[32];
    { const float* wp = W + (size_t)(k0 + (lane >> 5)) * N + n0 + (lane & 31);
#pragma unroll
      for (int i = 0; i < 32; ++i) ld[i] = __builtin_nontemporal_load(wp + (size_t)(2 * i) * N); }
#pragma unroll
    for (int i = 0; i < 32; ++i) scr[(2 * i + (lane >> 5)) * 33 + (lane & 31)] = ld[i];
    LDS_WAIT(); asm volatile("" ::: "memory");
    const int c = lane & 7;
#pragma unroll
    for (int j = 0; j < 4; ++j) { const int n = (lane >> 3) + 8 * j; const LAS float* s = scr + (8 * c) * 33 + n;
        const int nn = n0 + n, drow = (nn / grp) * gstride + (nn % grp) + roff;
        u32x4 o; o.x = pk2(s[0 * 33], s[1 * 33]); o.y = pk2(s[2 * 33], s[3 * 33]); o.z = pk2(s[4 * 33], s[5 * 33]); o.w = pk2(s[6 * 33], s[7 * 33]);
        *(u32x4*)(WT + (size_t)drow * K + k0 + 8 * c) = o; }
    LDS_WAIT(); asm volatile("" ::: "memory");
}
__device__ __forceinline__ unsigned pk4_fp8(float a, float b, float c, float d) { int r = 0; r = __builtin_amdgcn_cvt_pk_fp8_f32(a, b, r, false); r = __builtin_amdgcn_cvt_pk_fp8_f32(c, d, r, true); return (unsigned)r; }
__device__ __forceinline__ void tr_item8(const float* W, int K, int N, unsigned char* WT, int grp, int gstride, int roff, float sc, LAS float* scr, int item, int lane) {
    const int nblk = N / 32, kb = item / nblk, nb = item % nblk, k0 = 64 * kb, n0 = 32 * nb;
    float ld[32];
    { const float* wp = W + (size_t)(k0 + (lane >> 5)) * N + n0 + (lane & 31);
#pragma unroll
      for (int i = 0; i < 32; ++i) ld[i] = __builtin_nontemporal_load(wp + (size_t)(2 * i) * N); }
#pragma unroll
    for (int i = 0; i < 32; ++i) scr[(2 * i + (lane >> 5)) * 33 + (lane & 31)] = ld[i];
    LDS_WAIT(); asm volatile("" ::: "memory");
    const int c = lane & 7;
#pragma unroll
    for (int j = 0; j < 4; ++j) { const int n = (lane >> 3) + 8 * j; const LAS float* s = scr + (8 * c) * 33 + n;
        const int nn = n0 + n, drow = (nn / grp) * gstride + (nn % grp) + roff;
        u32x2 o; o.x = pk4_fp8(s[0 * 33] * sc, s[1 * 33] * sc, s[2 * 33] * sc, s[3 * 33] * sc); o.y = pk4_fp8(s[4 * 33] * sc, s[5 * 33] * sc, s[6 * 33] * sc, s[7 * 33] * sc);
        *(u32x2*)(WT + (size_t)drow * K + k0 + 8 * c) = o; }
    LDS_WAIT(); asm volatile("" ::: "memory");
}
constexpr float W8_SCALE = 32.0f, ACT8_SCALE = 8.0f;
constexpr int E8_ONE = 0x7f7f7f7f, E8_W = 0x7a7a7a7a, E8_ACT = 0x7c7c7c7c;
__device__ __forceinline__ void moe_conv_item(const Args& A, unsigned char* ws, LAS float* scr, int lane, int layer, int r) {
    const int t = r >> 13, e = (r & 8191) >> 9, m = layer * 16 + e, item = r & 511;
    if (t == 0) tr_item8(A.in[20] + (size_t)m * 1048576, 1024, 1024, ws + WS_WGU + (size_t)layer * (64 * MiB) + (size_t)e * 2097152, 128, 256, 0, W8_SCALE, scr, item, lane);
    else if (t == 1) tr_item8(A.in[21] + (size_t)m * 1048576, 1024, 1024, ws + WS_WGU + (size_t)layer * (64 * MiB) + (size_t)e * 2097152, 128, 256, 128, W8_SCALE, scr, item, lane);
    else tr_item8(A.in[22] + (size_t)m * 1048576, 1024, 1024, ws + WS_WD + (size_t)layer * (32 * MiB) + (size_t)e * 1048576, 1024, 1024, 0, W8_SCALE, scr, item, lane);
}
constexpr int N_CONV1 = 3 * 8192;
__device__ __forceinline__ void fill_tail(const Ctx& C, const Args& A, int ph, bool fin) {
    unsigned* ctl = (unsigned*)(C.ws + WS_CTL);
    volatile LAS int* flag = (volatile LAS int*)(C.lds + LDS_MISC) + 40;
    LAS float* scr = (LAS float*)(C.lds + C.wave * 16384);
    asm volatile("s_waitcnt vmcnt(0)" ::: "memory");
    __syncthreads();
    if (C.tid == 0 && !fin) __hip_atomic_fetch_add(ctl + CW_DONE + 64 * ph, 1u, __ATOMIC_RELAXED, __HIP_MEMORY_SCOPE_AGENT);
    for (;;) {
        if (C.tid == 0) { int v = -1;
            const unsigned d = fin ? 0u : __hip_atomic_fetch_add(ctl + CW_DONE + 64 * ph, 0u, __ATOMIC_RELAXED, __HIP_MEMORY_SCOPE_AGENT);
            if (d + 8u < (unsigned)C.G) { v = (int)__hip_atomic_fetch_add(ctl + CW_CONV, 8u, __ATOMIC_RELAXED, __HIP_MEMORY_SCOPE_AGENT); if (v >= N_CONV1) v = -1; }
#if MK_DIAG == 3
            if (!fin && v >= 0) __hip_atomic_fetch_add(ctl + 30000, 8u, __ATOMIC_RELAXED, __HIP_MEMORY_SCOPE_AGENT);
#endif
            *flag = v; }
        __syncthreads();
        const int v = *flag;
        __syncthreads();
        if (v < 0) break;
        if (v + C.wave < N_CONV1) moe_conv_item(A, C.ws, scr, C.lane, 1, v + C.wave);
    }
}
__device__ __forceinline__ void p0_prologue(const Ctx& C, const Args& A) {
    LAS float* scr = (LAS float*)(C.lds + C.wave * 16384);
    unsigned char* ws = C.ws;
    constexpr int I_MOE = 16 * 32;
    constexpr int N_MOE = 32 * I_MOE;
    constexpr int I_INA = 16 * 56, I_SQ = 512, I_KV = 16 * 24, I_OUTB = 8 * 32, I_MEM = 16 * 8;
    constexpr int N_MOE0 = 3 * 8192;
    constexpr int NITEMS = N_MOE0 + I_INA + I_SQ + I_SQ + 2 * I_KV + I_OUTB + 4 * I_MEM;
    for (int it = C.gw; it < NITEMS; it += C.NGW) {
        int r = it;
        if (r < N_MOE0) { moe_conv_item(A, ws, scr, C.lane, 0, r); continue; } r -= N_MOE0;
        if (r < I_INA) { tr_item(A.in[2], 1024, 1792, (bf16_t*)(ws + WS_BT_INA), 1792, 1792, 0, scr, r, C.lane); continue; } r -= I_INA;
        if (r < I_SQ) { tr_item(A.in[3], 1024, 1024, (bf16_t*)(ws + WS_BT_OUTA), 1024, 1024, 0, scr, r, C.lane); continue; } r -= I_SQ;
        if (r < I_SQ) { tr_item(A.in[8], 1024, 1024, (bf16_t*)(ws + WS_BT_B), 1024, 1024, 1536, scr, r, C.lane); continue; } r -= I_SQ;
        if (r < I_KV) { tr_item(A.in[10], 1024, 768, (bf16_t*)(ws + WS_BT_B), 768, 768, 0, scr, r, C.lane); continue; } r -= I_KV;
        if (r < I_KV) { tr_item(A.in[11], 1024, 768, (bf16_t*)(ws + WS_BT_B), 768, 768, 768, scr, r, C.lane); continue; } r -= I_KV;
        if (r < I_OUTB) { tr_item(A.in[9], 512, 1024, (bf16_t*)(ws + WS_BT_OUTB), 1024, 1024, 0, scr, r, C.lane); continue; } r -= I_OUTB;
        { const int m = r / I_MEM, layer = m & 1, isv = m >> 1;
          tr_item(A.in[isv ? 13 : 12] + (size_t)layer * 262144, 1024, 256, (bf16_t*)(ws + WS_BT_MEM), 256, 256, layer * 512 + isv * 256, scr, r % I_MEM, C.lane); }
    }
    const int gt = C.bid * NTHREADS + C.tid, NT = C.G * NTHREADS;
    for (int i = gt; i < NSG * 128 * 128 / 8; i += NT) { const int q0 = (i & 15) * 8, p = (i >> 4) & 127;
        const f32x4 a = *(const f32x4*)(A.in[6] + (size_t)i * 8), b = *(const f32x4*)(A.in[6] + (size_t)i * 8 + 4); float v[8] = {a[0], a[1], a[2], a[3], b[0], b[1], b[2], b[3]};
#pragma unroll
        for (int j = 0; j < 8; ++j) v[j] = (q0 + j <= p) ? v[j] : 0.f;
        u32x4 w; w.x = pk2(v[0], v[1]); w.y = pk2(v[2], v[3]); w.z = pk2(v[4], v[5]); w.w = pk2(v[6], v[7]); *(u32x4*)((bf16_t*)(ws + WS_SGWB) + (size_t)i * 8) = w; }
    for (int i = gt; i < T * D / 8; i += NT) { const f32x4 a = *(const f32x4*)(A.in[0] + (size_t)i * 8), b = *(const f32x4*)(A.in[0] + (size_t)i * 8 + 4);
        u32x4 w; w.x = pk2(a[0], a[1]); w.y = pk2(a[2], a[3]); w.z = pk2(b[0], b[1]); w.w = pk2(b[2], b[3]); *(u32x4*)((bf16_t*)(ws + WS_XB) + (size_t)i * 8) = w; }
    for (int i = gt; i < NB * NMEM * D / 8; i += NT) { const f32x4 a = *(const f32x4*)(A.in[1] + (size_t)i * 8), b = *(const f32x4*)(A.in[1] + (size_t)i * 8 + 4);
        u32x4 w; w.x = pk2(a[0], a[1]); w.y = pk2(a[2], a[3]); w.z = pk2(b[0], b[1]); w.w = pk2(b[2], b[3]); *(u32x4*)((bf16_t*)(ws + WS_MEMB) + (size_t)i * 8) = w; }
}

__device__ __forceinline__ void sg_scalar(const Ctx& C, const Args& A) {
    const bf16_t* U = (const bf16_t*)(C.ws + WS_U); const bf16_t* GV = (const bf16_t*)(C.ws + WS_GV); bf16_t* CAT = (bf16_t*)(C.ws + WS_CAT);
    const float* lng = A.in[4]; const float* lnb = A.in[5]; const float* sgw = A.in[6]; const float* sgb = A.in[7];
    LAS float* stat = (LAS float*)C.lds;
    LAS float* gvn = (LAS float*)(C.lds + 1024);
    LAS float* Wl = (LAS float*)(C.lds + 1024 + 128 * 65 * 4);
    for (int unit = C.bid; unit < NB * 16; unit += C.G) {
        const int tb = unit * 128;
        for (int rr = 0; rr < 16; ++rr) { const int row = C.wave * 16 + rr; const bf16_t* p = GV + (size_t)(tb + row) * SGW + 4 * C.lane;
            float s = 0.f, ss = 0.f;
#pragma unroll
            for (int j = 0; j < 3; ++j) { const u32x2 w = *(const u32x2*)(p + 256 * j); const float a = bflo(w.x), b = bfhi(w.x), c = bflo(w.y), d = bfhi(w.y);
                s += (a + b) + (c + d); ss += (a * a + b * b) + (c * c + d * d); }
            s = wave_sum(s); ss = wave_sum(ss);
            const float mean = s * (1.f / SGW), var = ss * (1.f / SGW) - mean * mean;
            if (C.lane == 0) { stat[row * 2] = mean; stat[row * 2 + 1] = 1.0f / sqrtf(var + LN_EPS); } }
        __syncthreads();
        const int p = C.tid >> 2, d0 = (C.tid & 3) * 16;
        for (int g = 0; g < NSG; ++g) {
            { const bf16_t* src = GV + (size_t)(tb + p) * SGW + g * 64 + d0; const float mean = stat[p * 2], rstd = stat[p * 2 + 1];
#pragma unroll
              for (int h = 0; h < 2; ++h) { const u32x4 w = *(const u32x4*)(src + 8 * h); const unsigned ww[4] = {w.x, w.y, w.z, w.w};
#pragma unroll
                  for (int j = 0; j < 4; ++j) { const int d = d0 + 8 * h + 2 * j; const int cc = g * 64 + d;
                      gvn[p * 65 + d] = (bflo(ww[j]) - mean) * rstd * lng[cc] + lnb[cc];
                      gvn[p * 65 + d + 1] = (bfhi(ww[j]) - mean) * rstd * lng[cc + 1] + lnb[cc + 1]; } } }
            { const int q0 = (C.tid & 3) * 32; const float* src = sgw + ((size_t)g * 128 + p) * 128 + q0;
#pragma unroll
              for (int j = 0; j < 8; ++j) { const f32x4 w = *(const f32x4*)(src + 4 * j);
#pragma unroll
                  for (int t = 0; t < 4; ++t) { const int q = q0 + 4 * j + t; Wl[p * 129 + q] = (q <= p) ? w[t] : 0.f; } } }
            __syncthreads();
            float acc[16];
#pragma unroll
            for (int j = 0; j < 16; ++j) acc[j] = 0.f;
            for (int q = 0; q <= p; ++q) { const float w = Wl[p * 129 + q];
#pragma unroll
                for (int j = 0; j < 16; ++j) acc[j] += w * gvn[q * 65 + d0 + j]; }
            const float bs = sgb[g * 128 + p];
            const bf16_t* us = U + (size_t)(tb + p) * SGW + g * 64 + d0; bf16_t* dst = CAT + (size_t)(tb + p) * D + g * 64 + d0;
#pragma unroll
            for (int h = 0; h < 2; ++h) { const u32x4 w = *(const u32x4*)(us + 8 * h); const unsigned ww[4] = {w.x, w.y, w.z, w.w}; unsigned o[4];
#pragma unroll
                for (int j = 0; j < 4; ++j) o[j] = pk2(bflo(ww[j]) * (acc[8 * h + 2 * j] + bs), bfhi(ww[j]) * (acc[8 * h + 2 * j + 1] + bs));
                *(u32x4*)(dst + 8 * h) = (u32x4){o[0], o[1], o[2], o[3]}; }
            __syncthreads();
        }
    }
}

__device__ __forceinline__ void memattn_scalar(const Ctx& C, const bf16_t* QM, const bf16_t* MKV, int ck, int cv, bf16_t* OUT, int ldo, int coff) {
    for (int it = C.gw; it < T * 4; it += C.NGW) {
        const int tok = it >> 2, h = it & 3, b = tok / SEQ;
        float q[64];
        { const bf16_t* qp = QM + (size_t)tok * 256 + h * 64;
#pragma unroll
          for (int j = 0; j < 8; ++j) { const u32x4 w = *(const u32x4*)(qp + 8 * j);
              q[8 * j] = bflo(w.x); q[8 * j + 1] = bfhi(w.x); q[8 * j + 2] = bflo(w.y); q[8 * j + 3] = bfhi(w.y); q[8 * j + 4] = bflo(w.z); q[8 * j + 5] = bfhi(w.z); q[8 * j + 6] = bflo(w.w); q[8 * j + 7] = bfhi(w.w); } }
        float s[4];
#pragma unroll
        for (int jj = 0; jj < 4; ++jj) { const bf16_t* kp = MKV + (size_t)(b * NMEM + jj * 64 + C.lane) * 1024 + ck + h * 64; float a = 0.f;
#pragma unroll
            for (int j = 0; j < 8; ++j) { const u32x4 w = *(const u32x4*)(kp + 8 * j);
                a += q[8 * j] * bflo(w.x) + q[8 * j + 1] * bfhi(w.x) + q[8 * j + 2] * bflo(w.y) + q[8 * j + 3] * bfhi(w.y) + q[8 * j + 4] * bflo(w.z) + q[8 * j + 5] * bfhi(w.z) + q[8 * j + 6] * bflo(w.w) + q[8 * j + 7] * bfhi(w.w); }
            s[jj] = a; }
        const float mx = wave_max(fmaxf(fmaxf(s[0], s[1]), fmaxf(s[2], s[3])));
        float l = 0.f;
#pragma unroll
        for (int jj = 0; jj < 4; ++jj) { s[jj] = __expf(s[jj] - mx); l += s[jj]; }
        l = wave_sum(l);
        float acc = 0.f;
#pragma unroll
        for (int jj = 0; jj < 4; ++jj) { const bf16_t* vp = MKV + (size_t)(b * NMEM + jj * 64) * 1024 + cv + h * 64 + C.lane;
            for (int mm = 0; mm < 64; ++mm) acc += __shfl(s[jj], mm) * bf1(vp[(size_t)mm * 1024]); }
        OUT[(size_t)tok * ldo + coff + h * 64 + C.lane] = (bf16_t)f2bf(acc / l);
    }
}

__device__ __forceinline__ void dilattn_scalar(const Ctx& C, const Args& A) {
    const bf16_t* Q = (const bf16_t*)(C.ws + WS_Q); const bf16_t* K = (const bf16_t*)(C.ws + WS_K); const bf16_t* V = (const bf16_t*)(C.ws + WS_V);
    bf16_t* OG = (bf16_t*)(C.ws + WS_OG); float* LSE = (float*)(C.ws + WS_LSE);
    for (int it = C.gw; it < T * 12; it += C.NGW) {
        const int tok = it / 12, h = it % 12, g = h >> 2, dl = (g == 0) ? 1 : (g == 1 ? 4 : 16);
        const int t = tok % SEQ, i = t / dl;
        const float slope = exp2f(-(float)(h + 1) * (8.0f / 12.0f));
        float q[64];
        { const bf16_t* qp = Q + (size_t)tok * SGW + h * 64;
#pragma unroll
          for (int j = 0; j < 8; ++j) { const u32x4 w = *(const u32x4*)(qp + 8 * j);
              q[8 * j] = bflo(w.x); q[8 * j + 1] = bfhi(w.x); q[8 * j + 2] = bflo(w.y); q[8 * j + 3] = bfhi(w.y); q[8 * j + 4] = bflo(w.z); q[8 * j + 5] = bfhi(w.z); q[8 * j + 6] = bflo(w.w); q[8 * j + 7] = bfhi(w.w); } }
        float s[3];
#pragma unroll
        for (int jj = 0; jj < 3; ++jj) { const int j0 = jj * 64 + C.lane; const bool valid = (jj < 2 || C.lane == 0) && (j0 <= i);
            const int jc = valid ? j0 : 0;
            const bf16_t* kp = K + (size_t)(tok - jc * dl) * SGW + h * 64; float a = 0.f;
#pragma unroll
            for (int j = 0; j < 8; ++j) { const u32x4 w = *(const u32x4*)(kp + 8 * j);
                a += q[8 * j] * bflo(w.x) + q[8 * j + 1] * bfhi(w.x) + q[8 * j + 2] * bflo(w.y) + q[8 * j + 3] * bfhi(w.y) + q[8 * j + 4] * bflo(w.z) + q[8 * j + 5] * bfhi(w.z) + q[8 * j + 6] * bflo(w.w) + q[8 * j + 7] * bfhi(w.w); }
            s[jj] = valid ? (a - slope * (float)(dl * j0)) : -INFINITY; }
        const float mx = wave_max(fmaxf(fmaxf(s[0], s[1]), s[2]));
        float l = 0.f;
#pragma unroll
        for (int jj = 0; jj < 3; ++jj) { s[jj] = __expf(s[jj] - mx); l += s[jj]; }
        l = wave_sum(l);
        float acc = 0.f;
#pragma unroll
        for (int jj = 0; jj < 3; ++jj) { const int nm = (jj < 2) ? 64 : 1;
            for (int mm = 0; mm < nm; ++mm) { const int j0 = jj * 64 + mm; const int jc = (j0 <= i) ? j0 : 0;
                acc += __shfl(s[jj], mm) * bf1(V[(size_t)(tok - jc * dl) * SGW + h * 64 + C.lane]); } }
        OG[(size_t)tok * SGW + h * 64 + C.lane] = (bf16_t)f2bf(acc / l);
        if (C.lane == 0) LSE[tok * 12 + h] = mx + __logf(l);
    }
}
typedef short bf16x8 __attribute__((ext_vector_type(8)));
typedef short s16x4 __attribute__((ext_vector_type(4)));
constexpr int AT_KS = 144, AT_VS = 160, AT_ROWS = 272, AT_K_OFF = 0, AT_V_OFF = AT_ROWS * AT_KS;
static_assert(AT_V_OFF % 16 == 0 && AT_V_OFF + AT_ROWS * AT_VS <= 131072, "attention LDS map");

template <int NKB, bool DIL>
__device__ __forceinline__ void attn_compute(LAS unsigned char* lds, int lane, int krow0, bf16x8 qf0, bf16x8 qf1, float sdl, int ikw, f32x4 (&o)[4], float& mx, float& lsum) {
    const int n = lane & 15, g = lane >> 4;
    const LAS unsigned char* Kb = lds + AT_K_OFF + (krow0 + n) * AT_KS + g * 16;
    f32x4 sc[NKB];
#pragma unroll
    for (int kb = 0; kb < NKB; ++kb) {
        const bf16x8 k0 = *(const LAS bf16x8*)(Kb + kb * 16 * AT_KS), k1 = *(const LAS bf16x8*)(Kb + kb * 16 * AT_KS + 64);
        f32x4 a = (f32x4){0.f, 0.f, 0.f, 0.f};
        a = __builtin_amdgcn_mfma_f32_16x16x32_bf16(k0, qf0, a, 0, 0, 0);
        a = __builtin_amdgcn_mfma_f32_16x16x32_bf16(k1, qf1, a, 0, 0, 0);
        sc[kb] = a;
    }
    float m = -INFINITY;
#pragma unroll
    for (int kb = 0; kb < NKB; ++kb)
#pragma unroll
        for (int r = 0; r < 4; ++r) {
            if (DIL) { const int off = 16 * kb + 4 * g + r, rel = 144 + n - off; const bool valid = (rel >= 0) && (rel <= 128) && (ikw + off >= 0);
                sc[kb][r] = valid ? (sc[kb][r] - sdl * (float)rel) : -INFINITY; }
            m = fmaxf(m, sc[kb][r]); }
    m = fmaxf(m, __shfl_xor(m, 16)); m = fmaxf(m, __shfl_xor(m, 32));
    float l = 0.f;
#pragma unroll
    for (int kb = 0; kb < NKB; ++kb)
#pragma unroll
        for (int r = 0; r < 4; ++r) { sc[kb][r] = __expf(sc[kb][r] - m); l += sc[kb][r]; }
    l += __shfl_xor(l, 16); l += __shfl_xor(l, 32);
    mx = m; lsum = l;
    const LAS unsigned char* Vb = lds + AT_V_OFF + (krow0 + 4 * g + (n >> 2)) * AT_VS + (n & 3) * 8;
#pragma unroll
    for (int db = 0; db < 4; ++db) o[db] = (f32x4){0.f, 0.f, 0.f, 0.f};
#pragma unroll
    for (int kk = 0; kk < NKB / 2; ++kk) {
        union { bf16x8 v; unsigned u[4]; } pf;
        pf.u[0] = cvt_pk_bf16(sc[2 * kk][0], sc[2 * kk][1]); pf.u[1] = cvt_pk_bf16(sc[2 * kk][2], sc[2 * kk][3]);
        pf.u[2] = cvt_pk_bf16(sc[2 * kk + 1][0], sc[2 * kk + 1][1]); pf.u[3] = cvt_pk_bf16(sc[2 * kk + 1][2], sc[2 * kk + 1][3]);
#pragma unroll
        for (int db = 0; db < 4; ++db) {
            const s16x4 v0 = __builtin_amdgcn_ds_read_tr16_b64_v4i16((LAS s16x4*)(Vb + (2 * kk) * 16 * AT_VS + db * 32));
            const s16x4 v1 = __builtin_amdgcn_ds_read_tr16_b64_v4i16((LAS s16x4*)(Vb + (2 * kk + 1) * 16 * AT_VS + db * 32));
            const bf16x8 vf = __builtin_shufflevector(v0, v1, 0, 1, 2, 3, 4, 5, 6, 7);
            o[db] = __builtin_amdgcn_mfma_f32_16x16x32_bf16(vf, pf.v, o[db], 0, 0, 0);
        }
    }
}

__device__ __forceinline__ void memattn_mfma(const Ctx& C, const bf16_t* QM, const bf16_t* MKV, int ck, int cv, bf16_t* OUT, int ldo, int coff) {
    const int n = C.lane & 15, g = C.lane >> 4;
    for (int unit = C.bid; unit < NB * 4 * 16; unit += C.G) {
        const int b = unit >> 6, h = (unit >> 4) & 3, qt = unit & 15;
        __syncthreads();
#pragma unroll
        for (int it = 0; it < 4; ++it) { const int row = it * 64 + (C.tid >> 3), c = C.tid & 7;
            const bf16_t* src = MKV + (size_t)(b * NMEM + row) * 1024 + h * 64 + c * 8;
            const u32x4 kv = *(const u32x4*)(src + ck), vv = *(const u32x4*)(src + cv);
            *(LAS u32x4*)(C.lds + AT_K_OFF + row * AT_KS + c * 16) = kv; *(LAS u32x4*)(C.lds + AT_V_OFF + row * AT_VS + c * 16) = vv; }
        const int tok = b * SEQ + qt * 128 + C.wave * 16 + n;
        const bf16_t* qp = QM + (size_t)tok * 256 + h * 64 + g * 8;
        const bf16x8 qf0 = *(const bf16x8*)qp, qf1 = *(const bf16x8*)(qp + 32);
        __syncthreads();
        f32x4 o[4]; float mx, l;
        attn_compute<16, false>(C.lds, C.lane, 0, qf0, qf1, 0.f, 0, o, mx, l);
        const float inv = 1.0f / l;
#pragma unroll
        for (int db = 0; db < 4; ++db)
            *(u32x2*)(OUT + (size_t)tok * ldo + coff + h * 64 + 16 * db + 4 * g) = (u32x2){cvt_pk_bf16(o[db][0] * inv, o[db][1] * inv), cvt_pk_bf16(o[db][2] * inv, o[db][3] * inv)};
    }
}
__device__ __forceinline__ void dilattn_mfma(const Ctx& C) {
    const bf16_t* Q = (const bf16_t*)(C.ws + WS_Q); const bf16_t* K = (const bf16_t*)(C.ws + WS_K); const bf16_t* V = (const bf16_t*)(C.ws + WS_V);
    bf16_t* OG = (bf16_t*)(C.ws + WS_OG); float* LSE = (float*)(C.ws + WS_LSE);
    const int n = C.lane & 15, g = C.lane >> 4;
    for (int unit = C.bid; unit < 12 * 128; unit += C.G) {
        const int h = unit >> 7, rem = unit & 127, b = rem >> 4, x = rem & 15, grp = h >> 2;
        const int dl = (grp == 0) ? 1 : (grp == 1 ? 4 : 16), ntile = 16 / dl, r = x / ntile, I0 = (x % ntile) * 128;
        const float sdl = exp2f(-(float)(h + 1) * (8.0f / 12.0f)) * (float)dl;
        __syncthreads();
        for (int idx = C.tid; idx < AT_ROWS * 8; idx += NTHREADS) { const int row = idx >> 3, c = idx & 7; const int ik = I0 - 144 + row;
            u32x4 kv = (u32x4){0u, 0u, 0u, 0u}, vv = (u32x4){0u, 0u, 0u, 0u};
            if (ik >= 0) { const size_t off = (size_t)(b * SEQ + ik * dl + r) * SGW + h * 64 + c * 8; kv = *(const u32x4*)(K + off); vv = *(const u32x4*)(V + off); }
            *(LAS u32x4*)(C.lds + AT_K_OFF + row * AT_KS + c * 16) = kv; *(LAS u32x4*)(C.lds + AT_V_OFF + row * AT_VS + c * 16) = vv; }
        const int iq = I0 + C.wave * 16 + n, tok = b * SEQ + iq * dl + r;
        const bf16_t* qp = Q + (size_t)tok * SGW + h * 64 + g * 8;
        const bf16x8 qf0 = *(const bf16x8*)qp, qf1 = *(const bf16x8*)(qp + 32);
        __syncthreads();
        f32x4 o[4]; float mx, l;
        attn_compute<10, true>(C.lds, C.lane, C.wave * 16, qf0, qf1, sdl, I0 + C.wave * 16 - 144, o, mx, l);
        const float inv = 1.0f / l;
#pragma unroll
        for (int db = 0; db < 4; ++db)
            *(u32x2*)(OG + (size_t)tok * SGW + h * 64 + 16 * db + 4 * g) = (u32x2){cvt_pk_bf16(o[db][0] * inv, o[db][1] * inv), cvt_pk_bf16(o[db][2] * inv, o[db][3] * inv)};
        if (g == 0) LSE[tok * 12 + h] = mx + __logf(l);
    }
}
constexpr int SG_GVN_OFF = 1024, SG_VS = 160;
__device__ __forceinline__ void sg_mfma(const Ctx& C, const Args& A) {
    const bf16_t* U = (const bf16_t*)(C.ws + WS_U); const bf16_t* GV = (const bf16_t*)(C.ws + WS_GV); bf16_t* CAT = (bf16_t*)(C.ws + WS_CAT);
    const bf16_t* WB = (const bf16_t*)(C.ws + WS_SGWB);
    const float* lng = A.in[4]; const float* lnb = A.in[5]; const float* sgb = A.in[7];
    LAS float* stat = (LAS float*)C.lds;
    const int n = C.lane & 15, gl = C.lane >> 4;
    for (int unit = C.bid; unit < NB * 16 * 4; unit += C.G) {
        const int tb = (unit >> 2) * 128, gq = unit & 3;
        __syncthreads();
        for (int rr = 0; rr < 16; ++rr) { const int row = C.wave * 16 + rr; const bf16_t* p = GV + (size_t)(tb + row) * SGW + 4 * C.lane;
            float s = 0.f, ss = 0.f;
#pragma unroll
            for (int j = 0; j < 3; ++j) { const u32x2 w = *(const u32x2*)(p + 256 * j); const float a = bflo(w.x), b = bfhi(w.x), c = bflo(w.y), d = bfhi(w.y);
                s += (a + b) + (c + d); ss += (a * a + b * b) + (c * c + d * d); }
            s = wave_sum(s); ss = wave_sum(ss);
            const float mean = s * (1.f / SGW), var = ss * (1.f / SGW) - mean * mean;
            if (C.lane == 0) { stat[row * 2] = mean; stat[row * 2 + 1] = 1.0f / sqrtf(var + LN_EPS); } }
        __syncthreads();
        for (int gi = 0; gi < 3; ++gi) {
            const int g = gq * 3 + gi;
#pragma unroll
            for (int it = 0; it < 2; ++it) { const int idx = it * NTHREADS + C.tid, row = idx >> 3, c = idx & 7, cc = g * 64 + c * 8;
                const u32x4 w = *(const u32x4*)(GV + (size_t)(tb + row) * SGW + cc); const float mean = stat[row * 2], rstd = stat[row * 2 + 1];
                const f32x4 ga = *(const f32x4*)(lng + cc), gb = *(const f32x4*)(lng + cc + 4), ba = *(const f32x4*)(lnb + cc), bb = *(const f32x4*)(lnb + cc + 4);
                u32x4 o;
                o.x = pk2((bflo(w.x) - mean) * rstd * ga[0] + ba[0], (bfhi(w.x) - mean) * rstd * ga[1] + ba[1]);
                o.y = pk2((bflo(w.y) - mean) * rstd * ga[2] + ba[2], (bfhi(w.y) - mean) * rstd * ga[3] + ba[3]);
                o.z = pk2((bflo(w.z) - mean) * rstd * gb[0] + bb[0], (bfhi(w.z) - mean) * rstd * gb[1] + bb[1]);
                o.w = pk2((bflo(w.w) - mean) * rstd * gb[2] + bb[2], (bfhi(w.w) - mean) * rstd * gb[3] + bb[3]);
                *(LAS u32x4*)(C.lds + SG_GVN_OFF + row * SG_VS + c * 16) = o; }
            __syncthreads();
            const int p = C.wave * 16 + n, nks = (C.wave >> 1) + 1;
            f32x4 acc[4];
#pragma unroll
            for (int db = 0; db < 4; ++db) acc[db] = (f32x4){0.f, 0.f, 0.f, 0.f};
            const bf16_t* wp = WB + (size_t)(g * 128 + p) * 128 + 8 * gl;
            const LAS unsigned char* vb = C.lds + SG_GVN_OFF + (8 * gl + (n >> 2)) * SG_VS + (n & 3) * 8;
            for (int ks = 0; ks < nks; ++ks) {
                const bf16x8 wf = *(const bf16x8*)(wp + 32 * ks);
#pragma unroll
                for (int db = 0; db < 4; ++db) {
                    const s16x4 v0 = __builtin_amdgcn_ds_read_tr16_b64_v4i16((LAS s16x4*)(vb + ks * 32 * SG_VS + db * 32));
                    const s16x4 v1 = __builtin_amdgcn_ds_read_tr16_b64_v4i16((LAS s16x4*)(vb + ks * 32 * SG_VS + 4 * SG_VS + db * 32));
                    const bf16x8 vf = __builtin_shufflevector(v0, v1, 0, 1, 2, 3, 4, 5, 6, 7);
                    acc[db] = __builtin_amdgcn_mfma_f32_16x16x32_bf16(vf, wf, acc[db], 0, 0, 0);
                }
            }
            const float bs = sgb[g * 128 + p];
#pragma unroll
            for (int db = 0; db < 4; ++db) { const size_t co = (size_t)g * 64 + 16 * db + 4 * gl;
                const u32x2 uw = *(const u32x2*)(U + (size_t)(tb + p) * SGW + co);
                *(u32x2*)(CAT + (size_t)(tb + p) * D + co) = (u32x2){cvt_pk_bf16(bflo(uw.x) * (acc[db][0] + bs), bfhi(uw.x) * (acc[db][1] + bs)), cvt_pk_bf16(bflo(uw.y) * (acc[db][2] + bs), bfhi(uw.y) * (acc[db][3] + bs))}; }
            __syncthreads();
        }
    }
}
__device__ __forceinline__ void dil_merge(const Ctx& C, const Args& A) {
    const bf16_t* OG = (const bf16_t*)(C.ws + WS_OG); const float* LSE = (const float*)(C.ws + WS_LSE); bf16_t* CAT2 = (bf16_t*)(C.ws + WS_CAT2);
    const int gt = C.bid * NTHREADS + C.tid, NT = C.G * NTHREADS;
    for (int it = gt; it < T * 32; it += NT) {
        const int tok = it >> 5, j = (it >> 3) & 3, c8 = it & 7;
        const float l0 = LSE[tok * 12 + j], l1 = LSE[tok * 12 + 4 + j], l2 = LSE[tok * 12 + 8 + j];
        const float mx = fmaxf(l0, fmaxf(l1, l2));
        float w0 = __expf(l0 - mx), w1 = __expf(l1 - mx), w2 = __expf(l2 - mx); const float inv = 1.0f / (w0 + w1 + w2); w0 *= inv; w1 *= inv; w2 *= inv;
        const u32x4 a = *(const u32x4*)(OG + (size_t)tok * SGW + j * 64 + c8 * 8), b = *(const u32x4*)(OG + (size_t)tok * SGW + (4 + j) * 64 + c8 * 8), c = *(const u32x4*)(OG + (size_t)tok * SGW + (8 + j) * 64 + c8 * 8);
        u32x4 o;
        o.x = pk2(w0 * bflo(a.x) + w1 * bflo(b.x) + w2 * bflo(c.x), w0 * bfhi(a.x) + w1 * bfhi(b.x) + w2 * bfhi(c.x));
        o.y = pk2(w0 * bflo(a.y) + w1 * bflo(b.y) + w2 * bflo(c.y), w0 * bfhi(a.y) + w1 * bfhi(b.y) + w2 * bfhi(c.y));
        o.z = pk2(w0 * bflo(a.z) + w1 * bflo(b.z) + w2 * bflo(c.z), w0 * bfhi(a.z) + w1 * bfhi(b.z) + w2 * bfhi(c.z));
        o.w = pk2(w0 * bflo(a.w) + w1 * bflo(b.w) + w2 * bflo(c.w), w0 * bfhi(a.w) + w1 * bfhi(b.w) + w2 * bfhi(c.w));
        *(u32x4*)(CAT2 + (size_t)tok * 512 + j * 64 + c8 * 8) = o;
    }
}

__device__ __forceinline__ void ln_route(const Ctx& C, const Args& A, int layer, int cset) {
    const float* Y = (const float*)(C.ws + WS_Y); bf16_t* X1B = (bf16_t*)(C.ws + WS_X1B); unsigned char* X1F8 = C.ws + WS_X1F8;
    const float* lg = A.in[14] + layer * D; const float* lb = A.in[15] + layer * D; const float* wr = A.in[18]; const float* br = A.in[19];
    unsigned* cnt = (unsigned*)(C.ws + WS_CTL) + CW_CNT + cset * 16 * 64;
    int* tokE = (int*)(C.ws + WS_TOKE); int* tokP = (int*)(C.ws + WS_TOKP); float* tokG = (float*)(C.ws + WS_TOKG); int* list = (int*)(C.ws + WS_LIST);
    LAS float* wl = (LAS float*)C.lds;
    LAS int* sE = (LAS int*)(C.lds + 65536); LAS float* sG = (LAS float*)(C.lds + 65536 + 512); LAS int* sPos = (LAS int*)(C.lds + 65536 + 1024);
    LAS int* lcnt = (LAS int*)(C.lds + 65536 + 1536); LAS int* lbase = (LAS int*)(C.lds + 65536 + 1600);
    __syncthreads();
    for (int i = C.tid; i < 1024 * 16 / 4; i += NTHREADS) { const int row = i >> 2, e4 = i & 3, jj = row >> 8, ln = (row & 255) >> 2, cc = row & 3;
        *(LAS f32x4*)(wl + 4 * ((((jj * 4 + cc) * 4 + e4) << 6) + ln)) = *(const f32x4*)(wr + 4 * i); }
    const LAS float* wlane = wl + C.lane * 4;
    for (int blk = C.bid; blk < T / 64; blk += C.G) {
        __syncthreads();
        if (C.tid < 16) lcnt[C.tid] = 0;
        f32x4 nv[4];
#pragma unroll
        for (int j = 0; j < 4; ++j) nv[j] = *(const f32x4*)(Y + (size_t)(blk * 64 + C.wave * 8) * D + 4 * C.lane + 256 * j);
#pragma unroll 1
        for (int ti = 0; ti < 8; ++ti) {
            const int tl = C.wave * 8 + ti, tok = blk * 64 + tl;
            f32x4 v[4]; float s = 0.f;
#pragma unroll
            for (int j = 0; j < 4; ++j) { v[j] = nv[j]; s += (v[j][0] + v[j][1]) + (v[j][2] + v[j][3]); }
            { const int tn = (ti < 7) ? tok + 1 : tok;
#pragma unroll
              for (int j = 0; j < 4; ++j) nv[j] = *(const f32x4*)(Y + (size_t)tn * D + 4 * C.lane + 256 * j); }
            const float mean = wave_sum_dpp(s) * (1.f / D); float s2 = 0.f;
#pragma unroll
            for (int j = 0; j < 4; ++j) { v[j] = v[j] - mean; s2 += (v[j][0] * v[j][0] + v[j][1] * v[j][1]) + (v[j][2] * v[j][2] + v[j][3] * v[j][3]); }
            const float rstd = 1.0f / sqrtf(wave_sum_dpp(s2) * (1.f / D) + LN_EPS);
            float lgt[16];
#pragma unroll
            for (int e = 0; e < 16; ++e) lgt[e] = 0.f;
#pragma unroll
            for (int j = 0; j < 4; ++j) { const int col = 4 * C.lane + 256 * j; const f32x4 g4 = *(const f32x4*)(lg + col), b4 = *(const f32x4*)(lb + col);
                v[j] = v[j] * rstd * g4 + b4;
                *(u32x2*)(X1B + (size_t)tok * D + col) = (u32x2){pk2(v[j][0], v[j][1]), pk2(v[j][2], v[j][3])};
                *(unsigned*)(X1F8 + (size_t)tok * D + col) = pk4_fp8(v[j][0], v[j][1], v[j][2], v[j][3]);
#pragma unroll
                for (int c = 0; c < 4; ++c) { const float xv = v[j][c];
#pragma unroll
                    for (int e4 = 0; e4 < 4; ++e4) { const f32x4 w = *(const LAS f32x4*)(wlane + (((j * 4 + c) * 4 + e4) << 8));
                        lgt[4 * e4] += xv * w[0]; lgt[4 * e4 + 1] += xv * w[1]; lgt[4 * e4 + 2] += xv * w[2]; lgt[4 * e4 + 3] += xv * w[3]; } } }
            float tsel = 0.f;
#pragma unroll
            for (int e = 0; e < 16; ++e) { const float r = row_sum(lgt[e]); tsel = ((C.lane & 15) == e) ? r : tsel; }
            tsel += __shfl_xor(tsel, 16); tsel += __shfl_xor(tsel, 32);
            float mx = -INFINITY;
#pragma unroll
            for (int e = 0; e < 16; ++e) { lgt[e] = __builtin_bit_cast(float, __builtin_amdgcn_readlane(__builtin_bit_cast(int, tsel), e)); mx = fmaxf(mx, lgt[e]); }
            float sum = 0.f;
#pragma unroll
            for (int e = 0; e < 16; ++e) { lgt[e] = __expf(lgt[e] - mx); sum += lgt[e]; }
            const float inv = 1.0f / sum; float sel[16];
#pragma unroll
            for (int e = 0; e < 16; ++e) { lgt[e] *= inv; sel[e] = lgt[e] + br[e]; }
            float gs[4];
#pragma unroll
            for (int g = 0; g < 4; ++g) { const float a = sel[4 * g], b = sel[4 * g + 1], c = sel[4 * g + 2], d = sel[4 * g + 3];
                gs[g] = fmaxf(fmaxf(fmaxf(a + b, a + c), fmaxf(a + d, b + c)), fmaxf(b + d, c + d)); }
            int gi = 0; float bsc = gs[0];
#pragma unroll
            for (int g = 1; g < 4; ++g) if (gs[g] > bsc) { bsc = gs[g]; gi = g; }
            float sg[4], pg[4];
#pragma unroll
            for (int k = 0; k < 4; ++k) { sg[k] = gi == 0 ? sel[k] : (gi == 1 ? sel[4 + k] : (gi == 2 ? sel[8 + k] : sel[12 + k])); pg[k] = gi == 0 ? lgt[k] : (gi == 1 ? lgt[4 + k] : (gi == 2 ? lgt[8 + k] : lgt[12 + k])); }
            int i1 = 0; float b1 = sg[0], p1 = pg[0];
#pragma unroll
            for (int k = 1; k < 4; ++k) if (sg[k] > b1) { b1 = sg[k]; i1 = k; p1 = pg[k]; }
            int i2 = -1; float b2 = -INFINITY, p2 = 0.f;
#pragma unroll
            for (int k = 0; k < 4; ++k) if (k != i1 && sg[k] > b2) { b2 = sg[k]; i2 = k; p2 = pg[k]; }
            if (C.lane == 0) { const float gsum = p1 + p2; sE[tl * 2] = gi * 4 + i1; sE[tl * 2 + 1] = gi * 4 + i2; sG[tl * 2] = p1 / gsum; sG[tl * 2 + 1] = p2 / gsum; }
        }
        __syncthreads();
        if (C.tid < 128) sPos[C.tid] = __hip_atomic_fetch_add(lcnt + sE[C.tid], 1, __ATOMIC_RELAXED, __HIP_MEMORY_SCOPE_WORKGROUP);
        __syncthreads();
        if (C.tid < 16) lbase[C.tid] = (int)__hip_atomic_fetch_add(cnt + C.tid * 64, (unsigned)lcnt[C.tid], __ATOMIC_RELAXED, __HIP_MEMORY_SCOPE_AGENT);
        __syncthreads();
        if (C.tid < 128) { const int e = sE[C.tid], pos = lbase[e] + sPos[C.tid], tok = blk * 64 + (C.tid >> 1);
            list[e * LISTCAP + pos] = tok; tokE[tok * 2 + (C.tid & 1)] = e; tokP[tok * 2 + (C.tid & 1)] = pos; tokG[tok * 2 + (C.tid & 1)] = sG[C.tid]; }
    }
}
__device__ __forceinline__ void moe_prefix(const Ctx& C, int layer) {
    LAS int* mi = (LAS int*)(C.lds + LDS_MISC);
    unsigned* cnt = (unsigned*)(C.ws + WS_CTL) + CW_CNT + layer * 16 * 64;
    __syncthreads();
    if (C.tid < 16) mi[17 + C.tid] = (int)__hip_atomic_load(cnt + C.tid * 64, __ATOMIC_RELAXED, __HIP_MEMORY_SCOPE_AGENT);
    __syncthreads();
    if (C.tid == 0) { int a = 0; for (int e = 0; e < 16; ++e) { mi[e] = a; a += (mi[17 + e] + 255) >> 8; } mi[16] = a; }
    __syncthreads();
}
__device__ __forceinline__ void moe_tokens(const Ctx& C, int ntn) {
    const LAS int* mi = (const LAS int*)(C.lds + LDS_MISC); LAS int* toks = (LAS int*)(C.lds + LDS_TOKS);
    const int* list = (const int*)(C.ws + WS_LIST);
    for (int u = 0; u < MAX_UNITS; ++u) {
        const int L = u * C.G + C.bid; if (L >= mi[16] * ntn) break;
        int e = 0;
#pragma unroll
        for (int j = 1; j < 16; ++j) e += (L >= mi[j] * ntn) ? 1 : 0;
        const int r = L - mi[e] * ntn, te = mi[e + 1] - mi[e], mt = r % te, cn = mi[17 + e];
        if (C.tid < 256) { int pos = mt * 256 + C.tid; pos = pos < cn ? pos : cn - 1; toks[u * 256 + C.tid] = list[e * LISTCAP + pos]; }
    }
    __syncthreads();
}
__device__ __forceinline__ void combine_ln2(const Ctx& C, const Args& A, int layer) {
    const LAS int* mi = (const LAS int*)(C.lds + LDS_MISC);
    const bf16_t* X1B = (const bf16_t*)(C.ws + WS_X1B); const bf16_t* YD = (const bf16_t*)(C.ws + WS_YD); bf16_t* X2B = (bf16_t*)(C.ws + WS_XB);
    const int* tokE = (const int*)(C.ws + WS_TOKE); const int* tokP = (const int*)(C.ws + WS_TOKP); const float* tokG = (const float*)(C.ws + WS_TOKG);
    const float* lg = A.in[16] + layer * D; const float* lb = A.in[17] + layer * D;
    for (int tok = C.gw; tok < T; tok += C.NGW) {
        const int e0 = tokE[tok * 2], e1 = tokE[tok * 2 + 1]; const float g0 = tokG[tok * 2], g1 = tokG[tok * 2 + 1];
        int tb0 = 0, tb1 = 0;
#pragma unroll
        for (int j = 0; j < 16; ++j) { const int t = mi[j]; tb0 = (e0 == j) ? t : tb0; tb1 = (e1 == j) ? t : tb1; }
        const size_t r0 = (size_t)tb0 * 256 + tokP[tok * 2], r1 = (size_t)tb1 * 256 + tokP[tok * 2 + 1];
        f32x4 v[4]; float s = 0.f;
#pragma unroll
        for (int j = 0; j < 4; ++j) { const int col = 4 * C.lane + 256 * j;
            const u32x2 a = *(const u32x2*)(X1B + (size_t)tok * D + col), y0 = *(const u32x2*)(YD + r0 * D + col), y1 = *(const u32x2*)(YD + r1 * D + col);
            v[j][0] = ALPHA * bflo(a.x) + (g0 * bflo(y0.x) + g1 * bflo(y1.x)); v[j][1] = ALPHA * bfhi(a.x) + (g0 * bfhi(y0.x) + g1 * bfhi(y1.x));
            v[j][2] = ALPHA * bflo(a.y) + (g0 * bflo(y0.y) + g1 * bflo(y1.y)); v[j][3] = ALPHA * bfhi(a.y) + (g0 * bfhi(y0.y) + g1 * bfhi(y1.y));
            s += (v[j][0] + v[j][1]) + (v[j][2] + v[j][3]); }
        const float mean = wave_sum(s) * (1.f / D); float s2 = 0.f;
#pragma unroll
        for (int j = 0; j < 4; ++j) { v[j] = v[j] - mean; s2 += (v[j][0] * v[j][0] + v[j][1] * v[j][1]) + (v[j][2] * v[j][2] + v[j][3] * v[j][3]); }
        const float rstd = 1.0f / sqrtf(wave_sum(s2) * (1.f / D) + LN_EPS);
#pragma unroll
        for (int j = 0; j < 4; ++j) { const int col = 4 * C.lane + 256 * j; const f32x4 g4 = *(const f32x4*)(lg + col), b4 = *(const f32x4*)(lb + col);
            const f32x4 o = v[j] * rstd * g4 + b4;
            if (layer == 0) *(u32x2*)(X2B + (size_t)tok * D + col) = (u32x2){pk2(o[0], o[1]), pk2(o[2], o[3])};
            else *(f32x4*)(A.out + (size_t)tok * D + col) = o; }
    }
}

__global__ void __launch_bounds__(NTHREADS, 2) yoco_fwd(Args args) {
    extern __shared__ __attribute__((aligned(16))) unsigned char lds_raw[];
    Ctx C;
    C.ws = args.ws; C.lds = (LAS unsigned char*)lds_raw;
    C.tid = threadIdx.x; C.lane = C.tid & 63; C.wave = __builtin_amdgcn_readfirstlane(C.tid >> 6);
    C.G = gridDim.x; C.bid = blockIdx.x; C.gw = C.bid * NWAVES + C.wave; C.NGW = C.G * NWAVES;
    unsigned char* ws = args.ws;
#define PHASE_WS() do { ws = launder(args.ws); C.ws = ws; C.tid = launder_v((int)threadIdx.x); C.lane = C.tid & 63; } while (0)
    volatile LAS unsigned* misc = (volatile LAS unsigned*)(C.lds + LDS_MISC);
    for (int u = C.tid; u < 64; u += NTHREADS) misc[u] = 0u;
    __syncthreads();
    XcdBarrier bar; bar.bar = (unsigned*)(ws + WS_CTL) + CW_BAR; bar.x = 0; bar.st = misc + 60;
    const int lo = args.ph_lo, hi = args.ph_hi;
    if (hi - lo > 1) bar = xcd_barrier_post((unsigned*)(ws + WS_CTL) + CW_BAR, misc + 60);
#define IN(k) (lo <= (k) && (k) < hi)
#define SEAMF(k) do { if (IN(k) && IN((k) + 1)) { PHASE_WS(); fill_tail(C, args, (k), false); xcd_barrier(bar); } } while (0)
#if MK_DIAG == 9
#define SEAM(k) do { if (IN(k) && IN((k) + 1)) { const unsigned long long t0_ = __builtin_amdgcn_s_memrealtime(); xcd_barrier(bar); if (((MK_DIAGMASK >> (k)) & 1) && threadIdx.x == 0) diag_acc += (unsigned)(__builtin_amdgcn_s_memrealtime() - t0_); } } while (0)
#else
#define SEAM(k) do { if (IN(k) && IN((k) + 1)) xcd_barrier(bar); } while (0)
#endif
#ifndef MK_DUP
#define MK_DUP 0
#endif
    unsigned diag_acc = 0;
#define REP(k) for (int rep_ = 0; rep_ < 1 + ((MK_DUP >> (k)) & 1); ++rep_)

    if (IN(0)) { REP(0) { PHASE_WS(); p0_prologue(C, args); } SEAM(0); }

    if (IN(1)) {
        REP(1) {
        PHASE_WS();
        { pg8::Gemm g{(const bf16_t*)(ws + WS_XB), (const bf16_t*)(ws + WS_BT_INA), T, 1792, D}; pg8::StaticOrder S; S.init(T, 1792, C.G, C.bid);
          EpiProjA E{(bf16_t*)(ws + WS_U), (bf16_t*)(ws + WS_GV), (bf16_t*)(ws + WS_QM0)};
          pg8::gemm_phase<EpiProjA, pg8::StaticOrder>(C.lds, g, S, E, nullptr, C.tid); }
        { pg8::Gemm g{(const bf16_t*)(ws + WS_MEMB), (const bf16_t*)(ws + WS_BT_MEM), NB * NMEM, 1024, D}; SmallOrder S{4, 32, C.bid - (C.G - 32)};
          EpiPlain E{(bf16_t*)(ws + WS_MKV), 1024, 4};
          pg8::gemm_phase<EpiPlain, SmallOrder>(C.lds, g, S, E, nullptr, C.tid); }
        }
        SEAMF(1);
    }
    if (IN(2)) {
        REP(2) { PHASE_WS();
        sg_mfma(C, args);
        memattn_mfma(C, (const bf16_t*)(ws + WS_QM0), (const bf16_t*)(ws + WS_MKV), 0, 256, (bf16_t*)(ws + WS_CAT), D, SGW); }
        SEAM(2);
    }
    if (IN(3)) {
        REP(3) { PHASE_WS();
        pg8::Gemm g{(const bf16_t*)(ws + WS_CAT), (const bf16_t*)(ws + WS_BT_OUTA), T, D, D}; pg8::StaticOrder S; S.init(T, D, C.G, C.bid);
        EpiResid<false> E{(const void*)args.in[0], (float*)(ws + WS_Y)};
        pg8::gemm_phase<EpiResid<false>, pg8::StaticOrder>(C.lds, g, S, E, nullptr, C.tid); }
        SEAM(3);
    }
    { constexpr int layer = 0;
        const int pb = 4 + 8 * layer;
        if (IN(pb)) { if ((MK_DUP >> 4) & 1) { PHASE_WS(); ln_route(C, args, layer, 2 + layer); __syncthreads(); } PHASE_WS(); ln_route(C, args, layer, layer); SEAM(pb); }
        if (IN(pb + 1)) {
            REP(5) { PHASE_WS();
            moe_prefix(C, layer); moe_tokens(C, 8);
            MoeGatherOrder S; S.tb = (const LAS int*)(C.lds + LDS_MISC); S.ntn = 8; S.G = C.G; S.c = C.bid; S.toks = (const LAS int*)(C.lds + LDS_TOKS);
            {
                pg8::Gemm g{(const bf16_t*)(ws + WS_X1F8), (const bf16_t*)(ws + WS_WGU + (size_t)layer * (64 * MiB)), 0, 0, D / 2, E8_ONE, E8_W};
                EpiSwiGLU8 E{ws + WS_ACT};
                pg8::gemm_phase<EpiSwiGLU8, MoeGatherOrder, false, true>(C.lds, g, S, E, nullptr, C.tid);
            } }
            SEAMF(pb + 1);
        }
        if (IN(pb + 2)) {
            REP(6) { PHASE_WS();
            moe_prefix(C, layer);
            MoeOrder S{(const LAS int*)(C.lds + LDS_MISC), 4, C.G, C.bid};
            EpiPlain E{(bf16_t*)(ws + WS_YD), 1024, 4};
            {
                pg8::Gemm g{(const bf16_t*)(ws + WS_ACT), (const bf16_t*)(ws + WS_WD + (size_t)layer * (32 * MiB)), 0, 0, D / 2, E8_ACT, E8_W};
                pg8::gemm_phase<EpiPlain, MoeOrder, false, true>(C.lds, g, S, E, nullptr, C.tid);
            } }
            SEAMF(pb + 2);
        }
        if (IN(pb + 3)) { REP(7) { PHASE_WS(); moe_prefix(C, layer); combine_ln2(C, args, layer); } if (layer == 0) SEAM(pb + 3); }
    }
    {
            if (IN(8)) {
                REP(8) { PHASE_WS();
                pg8::Gemm g{(const bf16_t*)(ws + WS_XB), (const bf16_t*)(ws + WS_BT_B), T, 2560, D}; pg8::StaticOrder S; S.init(T, 2560, C.G, C.bid);
                EpiProjB E{(bf16_t*)(ws + WS_K), (bf16_t*)(ws + WS_V), (bf16_t*)(ws + WS_Q), (bf16_t*)(ws + WS_QM1)};
                pg8::gemm_phase<EpiProjB, pg8::StaticOrder>(C.lds, g, S, E, nullptr, C.tid); }
                SEAMF(8);
            }
            if (IN(9)) {
                REP(9) { PHASE_WS();
                dilattn_mfma(C);
                memattn_mfma(C, (const bf16_t*)(ws + WS_QM1), (const bf16_t*)(ws + WS_MKV), 512, 768, (bf16_t*)(ws + WS_CAT2), 512, 256); }
                SEAM(9);
            }
            if (IN(10)) { REP(10) { PHASE_WS(); dil_merge(C, args); } SEAM(10); }
            if (IN(11)) {
                REP(11) { PHASE_WS();
                pg8::Gemm g{(const bf16_t*)(ws + WS_CAT2), (const bf16_t*)(ws + WS_BT_OUTB), T, D, 512}; pg8::StaticOrder S; S.init(T, D, C.G, C.bid);
                EpiResid<true> E{(const void*)(ws + WS_XB), (float*)(ws + WS_Y)};
                pg8::gemm_phase<EpiResid<true>, pg8::StaticOrder>(C.lds, g, S, E, nullptr, C.tid); }
                if (IN(11)) { PHASE_WS(); fill_tail(C, args, 11, true); }
                SEAM(11);
            }
    }
    { constexpr int layer = 1;
        const int pb = 4 + 8 * layer;
        if (IN(pb)) { if ((MK_DUP >> 4) & 1) { PHASE_WS(); ln_route(C, args, layer, 2 + layer); __syncthreads(); } PHASE_WS(); ln_route(C, args, layer, layer); SEAM(pb); }
        if (IN(pb + 1)) {
            REP(5) { PHASE_WS();
            moe_prefix(C, layer); moe_tokens(C, 8);
            MoeGatherOrder S; S.tb = (const LAS int*)(C.lds + LDS_MISC); S.ntn = 8; S.G = C.G; S.c = C.bid; S.toks = (const LAS int*)(C.lds + LDS_TOKS);
            {
                pg8::Gemm g{(const bf16_t*)(ws + WS_X1F8), (const bf16_t*)(ws + WS_WGU + (size_t)layer * (64 * MiB)), 0, 0, D / 2, E8_ONE, E8_W};
                EpiSwiGLU8 E{ws + WS_ACT};
                pg8::gemm_phase<EpiSwiGLU8, MoeGatherOrder, false, true>(C.lds, g, S, E, nullptr, C.tid);
            } }
            SEAM(pb + 1);
        }
        if (IN(pb + 2)) {
            REP(6) { PHASE_WS();
            moe_prefix(C, layer);
            MoeOrder S{(const LAS int*)(C.lds + LDS_MISC), 4, C.G, C.bid};
            EpiPlain E{(bf16_t*)(ws + WS_YD), 1024, 4};
            {
                pg8::Gemm g{(const bf16_t*)(ws + WS_ACT), (const bf16_t*)(ws + WS_WD + (size_t)layer * (32 * MiB)), 0, 0, D / 2, E8_ACT, E8_W};
                pg8::gemm_phase<EpiPlain, MoeOrder, false, true>(C.lds, g, S, E, nullptr, C.tid);
            } }
            SEAM(pb + 2);
        }
        if (IN(pb + 3)) { REP(7) { PHASE_WS(); moe_prefix(C, layer); combine_ln2(C, args, layer); } if (layer == 0) SEAM(pb + 3); }
    }
#if MK_DIAG == 3
    xcd_barrier(bar);
    if (blockIdx.x == 0 && threadIdx.x == 0) { const unsigned got = __hip_atomic_fetch_add((unsigned*)(args.ws + WS_CTL) + 30000, 0u, __ATOMIC_RELAXED, __HIP_MEMORY_SCOPE_AGENT); const unsigned long long t0 = __builtin_amdgcn_s_memrealtime();
        const unsigned long long dur = (unsigned long long)got * 4ull;
        while (__builtin_amdgcn_s_memrealtime() - t0 < dur) __builtin_amdgcn_s_sleep(8); }
#endif
#if MK_DIAG == 9
    if (threadIdx.x == 0) __hip_atomic_fetch_add((unsigned*)(args.ws + WS_CTL) + 30000, diag_acc, __ATOMIC_RELAXED, __HIP_MEMORY_SCOPE_AGENT);
    xcd_barrier(bar);
    if (blockIdx.x == 0 && threadIdx.x == 0) { const unsigned got = __hip_atomic_fetch_add((unsigned*)(args.ws + WS_CTL) + 30000, 0u, __ATOMIC_RELAXED, __HIP_MEMORY_SCOPE_AGENT); const unsigned long long t0 = __builtin_amdgcn_s_memrealtime();
        const unsigned long long dur = (unsigned long long)got / 256ull;
        while (__builtin_amdgcn_s_memrealtime() - t0 < dur) __builtin_amdgcn_s_sleep(8); }
#endif
#undef IN
#undef SEAM
}
}

extern "C" void kernel_launch(void* const* d_in, const int* in_sizes, int n_in, void* d_out, int out_size, void* d_ws, size_t ws_size, hipStream_t stream) {
    using namespace mk;
    static int grid = 0;
    if (grid == 0) {
        if (n_in != 23 || out_size != T * D || ws_size < WS_END) { fprintf(stderr, "kernel_launch: unexpected shapes (n_in %d, out %d, ws %zu)\n", n_in, out_size, ws_size); grid = -1; return; }
        int dev = 0, cus = 0, per_cu = 0;
        if (hipGetDevice(&dev) != hipSuccess || hipDeviceGetAttribute(&cus, hipDeviceAttributeMultiprocessorCount, dev) != hipSuccess) { grid = -1; return; }
        if (hipFuncSetAttribute((const void*)yoco_fwd, hipFuncAttributeMaxDynamicSharedMemorySize, LDS_BYTES) != hipSuccess) { fprintf(stderr, "kernel_launch: hipFuncSetAttribute failed\n"); grid = -1; return; }
        if (hipOccupancyMaxActiveBlocksPerMultiprocessor(&per_cu, (const void*)yoco_fwd, NTHREADS, LDS_BYTES) != hipSuccess || per_cu < 1)
            fprintf(stderr, "kernel_launch: occupancy query reports %d workgroups per CU\n", per_cu);
        (void)hipGetLastError();
        grid = cus;
    }
    if (grid < 0) return;
    (void)hipMemsetAsync((char*)d_ws + WS_CTL, 0, CTL_ZERO_BYTES, stream);
    Args a{};
    for (int i = 0; i < 23; ++i) a.in[i] = (const float*)d_in[i];
    a.out = (float*)d_out; a.ws = (unsigned char*)d_ws;
    constexpr int NL = MK_N_LAUNCHES;
    for (int li = 0; li < NL; ++li) {
        a.ph_lo = (NL == NPHASE) ? li : (li * NPHASE) / NL; a.ph_hi = (NL == NPHASE) ? li + 1 : ((li + 1) * NPHASE) / NL;
        hipLaunchKernelGGL(yoco_fwd, dim3(grid), dim3(NTHREADS), LDS_BYTES, stream, a);
    }
}
```

```cpp
#include <hip/hip_runtime.h>
#include <cstdio>
#include <cstdint>
namespace pg8 {
#define PG8_LAS __attribute__((address_space(3)))
typedef unsigned short bf16_t;
typedef short bf16x8 __attribute__((ext_vector_type(8)));
typedef float f32x4 __attribute__((ext_vector_type(4)));
typedef unsigned u32x4 __attribute__((ext_vector_type(4)));
constexpr int BM = 256, BK = 64, HALF = 128, HTB = HALF * BK * 2  , STAGE_BYTES = 8 * HTB, NXCD = 8, WGM = 8;

__host__ __device__ __forceinline__ int lds_byte(int r, int c) { const int st = (r >> 4) * 2 + (c >> 5), rr = r & 15, cc = c & 31, ob = rr * 64 + cc * 2; return st * 1024 + (ob ^ (((ob >> 9) & 1) << 5)); }
__host__ __device__ __forceinline__ void stage_rc(int b, int& R, int& C) { const int st = b / 1024, sb = b % 1024, swz = sb ^ (((sb >> 9) & 1) << 5); R = (st >> 1) * 16 + swz / 64; C = (st & 1) * 32 + (swz % 64) / 2; }
__host__ __device__ __forceinline__ int perm32(int rho) { const int n = rho >> 4, i = rho & 15; return 8 * (i >> 2) + 4 * n + (i & 3); }

struct Unit { int pm, pn; };
struct Gemm { const bf16_t* A; const bf16_t* Bt; int M, N, K; int sA, sB; };

struct StaticOrder {
    int nM, nN, nwg, G, c;
    __host__ __device__ void init(int M, int N, int G_, int c_) { nM = M / BM; nN = N / BM; nwg = nM * nN; G = G_; c = c_; }
    __host__ __device__ bool next(int i, Unit& u) const {
        const long L = (long)i * G + c; if (L >= nwg) return false;
        int wgid = (int)L; { const int q = nwg / NXCD, r = nwg % NXCD, xcd = wgid % NXCD, off = wgid / NXCD; wgid = (xcd < r ? xcd * (q + 1) : r * (q + 1) + (xcd - r) * q) + off; }
        const int nig = WGM * nN, gid = wgid / nig, fm = gid * WGM, gsz = (nM - fm) < WGM ? (nM - fm) : WGM;
        u.pm = fm + ((wgid % nig) % gsz); u.pn = (wgid % nig) / gsz; return true;
    }
    __device__ __forceinline__ void a_ready(const Unit&) const {}
    __device__ __forceinline__ void done(const Unit&) const {}
    __device__ __forceinline__ int arow(int, const Unit& u, int r) const { return u.pm * BM + r; }
};
__device__ __forceinline__ unsigned cvt_pk_bf16(float lo, float hi) { unsigned r; asm volatile("v_cvt_pk_bf16_f32 %0, %1, %2" : "=v"(r) : "v"(lo), "v"(hi)); return r; }
typedef float f32x2 __attribute__((ext_vector_type(2)));
__device__ __forceinline__ f32x2 gelu_pk(f32x2 v) {
    const f32x2 av = __builtin_elementwise_abs(v), d = av * 0.2316418882f + 1.0f;
    f32x2 t; t.x = __builtin_amdgcn_rcpf(d.x); t.y = __builtin_amdgcn_rcpf(d.y);
    f32x2 q = t * 0.5307027145f + (-0.7265760135f); q = q * t + 0.7107068705f; q = q * t + (-0.142248368f); q = q * t + 0.127414796f; q = q * t;
    const f32x2 s = (v * v) * (-0.72134752044f);
    f32x2 e; e.x = __builtin_amdgcn_exp2f(s.x); e.y = __builtin_amdgcn_exp2f(s.y);
    const f32x2 m = v * (q * e), r = v - m;
    f32x2 o; o.x = v.x < 0.f ? m.x : r.x; o.y = v.y < 0.f ? m.y : r.y; return o;
}
template <class Epi, class Sched, bool STAMP = false, bool F8 = false>
__device__ __forceinline__ void gemm_phase(PG8_LAS unsigned char* lds, const Gemm g, const Sched& S, const Epi& E, unsigned long long* stamps, const int tid) {
    const int wid = __builtin_amdgcn_readfirstlane(tid >> 6), lane = tid & 63, wr = wid >> 2, wc = wid & 3, fr = lane & 15, fq = lane >> 4;
    const int K = g.K, nt = K / BK;
    int ts_lo = 0, ts_hi = 0, nts = 0; const unsigned long long rt_entry = STAMP ? (unsigned long long)wall_clock64() : 0ull;
#define PG8_STAMP() do { if (STAMP && wid == 0 && nts < 64) { const unsigned long long _c = (unsigned long long)clock64(); \
        ts_lo = (lane == nts) ? (int)(unsigned)_c : ts_lo; ts_hi = (lane == nts) ? (int)(unsigned)(_c >> 32) : ts_hi; ++nts; } } while (0)
    PG8_STAMP();
    unsigned colA[2], voffB[2]; int rowA[2];
#pragma unroll
    for (int i = 0; i < 2; ++i) { int R, C; stage_rc(tid * 16 + i * 8192, R, C); const int Rb = Epi::PERM ? ((R & ~31) + perm32(R & 31)) : R;
        rowA[i] = R; colA[i] = (unsigned)C * 2u; voffB[i] = (unsigned)(Rb * K + C) * 2u; }
#define PG8_AOFF(dst, uidx, un) do { _Pragma("unroll") for (int _h = 0; _h < 2; ++_h) _Pragma("unroll") for (int _i = 0; _i < 2; ++_i) \
        dst[_h][_i] = (unsigned)S.arow((uidx), (un), _h * HALF + rowA[_i]) * (unsigned)(K * 2) + colA[_i]; } while (0)
    const size_t kstep = (size_t)(BK * 2);
    const size_t hstep = (size_t)HALF * K * 2;
    const size_t tstep = 2 * hstep;
    const unsigned ldsw = (unsigned)wid * 1024u;
    const int aoff = F8 ? lds_byte(wr * 64 + fr, fq * 16) : lds_byte(wr * 64 + fr, fq * 8), boff = F8 ? lds_byte(wc * 32 + fr, fq * 16) : lds_byte(wc * 32 + fr, fq * 8);
    constexpr int KOFF = F8 ? 16 : 1024;
#define PG8_SA(b, h) (((b) * 2 + (h)) * HTB)
#define PG8_SB(b, h) ((4 + (b) * 2 + (h)) * HTB)
#define PG8_STAGE(bufoff, gbase, voff) do { _Pragma("unroll") for (int _i = 0; _i < 2; ++_i) \
        __builtin_amdgcn_global_load_lds((const unsigned*)((const char*)(gbase) + (voff)[_i]), (PG8_LAS unsigned*)(lds + (bufoff) + ldsw + _i * 8192), 16, 0, 0); } while (0)
#define PG8_LDA(dst, b, h) do { _Pragma("unroll") for (int m = 0; m < 4; ++m) _Pragma("unroll") for (int k = 0; k < 2; ++k) dst[m][k] = *(const PG8_LAS bf16x8*)(lds + PG8_SA(b, h) + aoff + m * 2048 + k * KOFF); } while (0)
#define PG8_LDB(dst, b, h) do { _Pragma("unroll") for (int n = 0; n < 2; ++n) _Pragma("unroll") for (int k = 0; k < 2; ++k) dst[n][k] = *(const PG8_LAS bf16x8*)(lds + PG8_SB(b, h) + boff + n * 2048 + k * KOFF); } while (0)
#define PG8_MMA(ai, bj, At, Bt) do { __builtin_amdgcn_s_setprio(1); \
        if constexpr (F8) { _Pragma("unroll") for (int m = 0; m < 4; ++m) _Pragma("unroll") for (int n = 0; n < 2; ++n) { \
            typedef int i32x4_ __attribute__((ext_vector_type(4))); typedef int i32x8_ __attribute__((ext_vector_type(8))); \
            const i32x8_ b8_ = __builtin_shufflevector(__builtin_bit_cast(i32x4_, Bt[n][0]), __builtin_bit_cast(i32x4_, Bt[n][1]), 0, 1, 2, 3, 4, 5, 6, 7); \
            const i32x8_ a8_ = __builtin_shufflevector(__builtin_bit_cast(i32x4_, At[m][0]), __builtin_bit_cast(i32x4_, At[m][1]), 0, 1, 2, 3, 4, 5, 6, 7); \
            acc[ai][bj][m][n] = __builtin_amdgcn_mfma_scale_f32_16x16x128_f8f6f4(b8_, a8_, acc[ai][bj][m][n], 0, 0, 0, g.sB, 0, g.sA); } } \
        else { _Pragma("unroll") for (int m = 0; m < 4; ++m) _Pragma("unroll") for (int n = 0; n < 2; ++n) _Pragma("unroll") for (int k = 0; k < 2; ++k) \
            acc[ai][bj][m][n] = __builtin_amdgcn_mfma_f32_16x16x32_bf16(Bt[n][k], At[m][k], acc[ai][bj][m][n], 0, 0, 0); } \
        __builtin_amdgcn_s_setprio(0); } while (0)
#define PG8_WAIT_V(n) asm volatile("s_waitcnt vmcnt(" #n ")" ::: "memory")
#define PG8_WAIT_L(n) asm volatile("s_waitcnt lgkmcnt(" #n ")" ::: "memory")
#define PG8_BAR __builtin_amdgcn_s_barrier()
#define PG8_SCHED __builtin_amdgcn_sched_barrier(0)
    Unit cur, nxt; int ui = 0;
    if (!S.next(0, cur)) return;
    f32x4 acc[2][2][4][2];
#pragma unroll
    for (int a = 0; a < 2; ++a)
#pragma unroll
        for (int b = 0; b < 2; ++b)
#pragma unroll
            for (int m = 0; m < 4; ++m)
#pragma unroll
                for (int n = 0; n < 2; ++n) acc[a][b][m][n] = (f32x4){0.f, 0.f, 0.f, 0.f};
    bf16x8 At[4][2], B0[2][2], B1[2][2];
    const char* Ab = (const char*)g.A; const char* cB = (const char*)g.Bt + (size_t)cur.pn * tstep;
    unsigned cuA[2][2];
    S.a_ready(cur);
    PG8_AOFF(cuA, 0, cur);
    PG8_STAGE(PG8_SB(0, 0), cB, voffB); PG8_STAGE(PG8_SA(0, 0), Ab, cuA[0]); PG8_STAGE(PG8_SB(0, 1), cB + hstep, voffB); PG8_STAGE(PG8_SA(0, 1), Ab, cuA[1]);
    if (wr == 1) PG8_BAR;
    PG8_WAIT_V(4); PG8_BAR;
    PG8_STAGE(PG8_SB(1, 0), cB + kstep, voffB); PG8_STAGE(PG8_SA(1, 0), Ab + kstep, cuA[0]); PG8_STAGE(PG8_SB(1, 1), cB + hstep + kstep, voffB);
    PG8_WAIT_V(6); PG8_BAR;
    PG8_STAMP();
    for (;;) {
        const bool has_next = S.next(ui + 1, nxt);
        const char* nB = has_next ? (const char*)g.Bt + (size_t)nxt.pn * tstep : cB;
        for (int t = 0; t < nt; t += 2) {
            const bool last = (t == nt - 2);
            const char* a1 = Ab + (size_t)(t + 1) * kstep;
            const char* a2 = last ? Ab : Ab + (size_t)(t + 2) * kstep; const char* b2 = last ? nB : cB + (size_t)(t + 2) * kstep;
            const char* a3 = a2 + kstep; const char* b3 = b2 + kstep;

            if (last && has_next) S.a_ready(nxt);
            PG8_LDB(B0, 0, 0); PG8_SCHED; PG8_LDA(At, 0, 0); PG8_STAGE(PG8_SA(1, 1), a1, cuA[1]);
            PG8_WAIT_L(8); PG8_BAR; PG8_WAIT_L(0); PG8_MMA(0, 0, At, B0); PG8_BAR; PG8_SCHED;
            if (last && has_next) PG8_AOFF(cuA, ui + 1, nxt);
            PG8_LDB(B1, 0, 1); PG8_STAGE(PG8_SB(0, 0), b2, voffB);
            PG8_BAR; PG8_WAIT_L(0); PG8_MMA(0, 1, At, B1); PG8_BAR;
            PG8_LDA(At, 0, 1); PG8_STAGE(PG8_SA(0, 0), a2, cuA[0]);
            PG8_BAR; PG8_WAIT_L(0); PG8_MMA(1, 0, At, B0); PG8_BAR; PG8_SCHED;
            PG8_STAGE(PG8_SB(0, 1), b2 + hstep, voffB);
            PG8_WAIT_V(6); PG8_BAR; PG8_MMA(1, 1, At, B1); PG8_BAR;
            PG8_LDB(B0, 1, 0); PG8_SCHED; PG8_LDA(At, 1, 0); PG8_STAGE(PG8_SA(0, 1), a2, cuA[1]);
            PG8_WAIT_L(8); PG8_BAR; PG8_WAIT_L(0); PG8_MMA(0, 0, At, B0); PG8_BAR; PG8_SCHED;
            PG8_LDB(B1, 1, 1); PG8_STAGE(PG8_SB(1, 0), b3, voffB);
            PG8_BAR; PG8_WAIT_L(0); PG8_MMA(0, 1, At, B1); PG8_BAR;
            PG8_LDA(At, 1, 1); PG8_STAGE(PG8_SA(1, 0), a3, cuA[0]);
            PG8_BAR; PG8_WAIT_L(0); PG8_MMA(1, 0, At, B0); PG8_BAR; PG8_SCHED;
            PG8_STAGE(PG8_SB(1, 1), b3 + hstep, voffB);
            PG8_WAIT_V(6); PG8_BAR; PG8_MMA(1, 1, At, B1); PG8_BAR;
        }
        PG8_STAMP();
        if constexpr (!Epi::AFTER_DRAIN) { E(acc, cur, wr, wc, fr, fq); S.done(cur); }
        PG8_STAMP();
        if (!has_next) break;
#pragma unroll
        for (int a = 0; a < 2; ++a)
#pragma unroll
            for (int b = 0; b < 2; ++b)
#pragma unroll
                for (int m = 0; m < 4; ++m)
#pragma unroll
                    for (int n = 0; n < 2; ++n) acc[a][b][m][n] = (f32x4){0.f, 0.f, 0.f, 0.f};
        cur = nxt; cB = nB; ++ui;
    }
    PG8_WAIT_V(0);
    if (wr == 0) PG8_BAR;
    PG8_BAR;
    if constexpr (Epi::AFTER_DRAIN) { E.fused(acc, cur, wr, wc, fr, fq, lds, wid, lane); S.done(cur); }
    PG8_STAMP();
    if (STAMP && wid == 0) { stamps[lane] = lane < nts ? (((unsigned long long)(unsigned)ts_hi << 32) | (unsigned)ts_lo) : 0ull;
        if (lane == 62) stamps[62] = rt_entry; if (lane == 63) stamps[63] = (unsigned long long)wall_clock64(); }
#undef PG8_STAMP
#undef PG8_SA
#undef PG8_SB
#undef PG8_STAGE
#undef PG8_AOFF
#undef PG8_LDA
#undef PG8_LDB
#undef PG8_MMA
#undef PG8_WAIT_V
#undef PG8_WAIT_L
#undef PG8_BAR
#undef PG8_SCHED
}
}

namespace mk {
using pg8::bf16_t; using pg8::f32x4; using pg8::u32x4; using pg8::Unit; using pg8::cvt_pk_bf16;
#define LAS __attribute__((address_space(3)))
typedef float f32x2 __attribute__((ext_vector_type(2)));
typedef unsigned u32x2 __attribute__((ext_vector_type(2)));

#ifndef MK_DIAG
#define MK_DIAG 0
#endif
#ifndef MK_DIAGSEL
#define MK_DIAGSEL 0
#endif
#ifndef MK_DIAGMASK
#define MK_DIAGMASK 0xFFFF
#endif
#ifndef MK_N_LAUNCHES
#define MK_N_LAUNCHES 1
#endif
constexpr int NPHASE = 16;
constexpr int NB = 8, SEQ = 2048, D = 1024, T = NB * SEQ, NMEM = 256, SGW = 768, NSG = 12, HD = 64, CH = 128;
constexpr int NEXP = 16, LISTCAP = 16384;
constexpr float ALPHA = 1.41421356237f;
constexpr float LN_EPS = 1e-5f, ATT_SCALE = 0.125f;
constexpr int NWAVES = 8, NTHREADS = 512;

constexpr size_t MiB = 1u << 20;
constexpr size_t WS_CTL = 0, CTL_ZERO_BYTES = 1 * MiB;
constexpr size_t WS_TOKE = 1 * MiB, WS_TOKP = WS_TOKE + 128 * 1024, WS_TOKG = WS_TOKP + 128 * 1024;
constexpr size_t WS_LIST = 2 * MiB, WS_LSE = 3 * MiB, WS_SGWB = 4 * MiB, WS_SGRS = 4 * MiB + 512 * 1024;
constexpr size_t WS_MKV = 8 * MiB, WS_MEMB = 12 * MiB;
constexpr size_t WS_BT_INA = 18 * MiB, WS_BT_OUTA = 22 * MiB, WS_BT_B = 24 * MiB, WS_BT_OUTB = 29 * MiB, WS_BT_MEM = 30 * MiB;
constexpr size_t WS_WGU = 32 * MiB, WS_WD = 160 * MiB;
constexpr size_t WS_A = 224 * MiB;
constexpr size_t WS_U = WS_A, WS_GV = WS_A + 24 * MiB, WS_QM0 = WS_A + 48 * MiB;
constexpr size_t WS_K = WS_A, WS_V = WS_A + 24 * MiB, WS_Q = WS_A + 48 * MiB, WS_QM1 = WS_A + 72 * MiB;
constexpr size_t WS_ACT = WS_A;
constexpr size_t WS_XB = 304 * MiB;
constexpr size_t WS_C = 336 * MiB;
constexpr size_t WS_CAT = WS_C, WS_OG = WS_C, WS_CAT2 = WS_C + 24 * MiB;
constexpr size_t WS_Y = 376 * MiB;
constexpr size_t WS_YD = 336 * MiB;
constexpr size_t WS_X1B = 440 * MiB;
constexpr size_t WS_X1F8 = 472 * MiB;
constexpr size_t WS_END = 488 * MiB;
constexpr size_t WS_WGU8 = WS_WGU + 64 * MiB, WS_WD8 = WS_WD + 32 * MiB;
constexpr int CW_TMO = 0, CW_BAR = 4096, CW_CNT = 16384, CW_CONV = 24576, CW_DONE = 24640, CW_CONV0 = 26000;
constexpr int LDS_TOKS = 131072 + 1024, MAX_UNITS = 8;
constexpr int LDS_MISC = 131072;
constexpr int LDS_BYTES = 147456;
static_assert(LDS_TOKS + MAX_UNITS * 1024 <= LDS_BYTES, "LDS map");

#define LDS_WAIT() asm volatile("s_waitcnt lgkmcnt(0)" ::: "memory")
#define VM_WAIT() asm volatile("s_waitcnt vmcnt(0)" ::: "memory")
__device__ __forceinline__ unsigned f2bf(float f) { unsigned u = __builtin_bit_cast(unsigned, f); return (u + 0x7fffu + ((u >> 16) & 1u)) >> 16; }
__device__ __forceinline__ unsigned pk2(float lo, float hi) { return f2bf(lo) | (f2bf(hi) << 16); }
__device__ __forceinline__ unsigned pk4_fp8_e(float a, float b, float c, float d) { int r = 0; r = __builtin_amdgcn_cvt_pk_fp8_f32(a, b, r, false); r = __builtin_amdgcn_cvt_pk_fp8_f32(c, d, r, true); return (unsigned)r; }
__device__ __forceinline__ float bflo(unsigned w) { return __uint_as_float(w << 16); }
__device__ __forceinline__ float bfhi(unsigned w) { return __uint_as_float(w & 0xffff0000u); }
__device__ __forceinline__ float bf1(bf16_t v) { return __uint_as_float(((unsigned)v) << 16); }
__device__ __forceinline__ float wave_sum(float v) {
#pragma unroll
    for (int o = 1; o < 64; o <<= 1) v += __shfl_xor(v, o);
    return v;
}
template <int CTRL> __device__ __forceinline__ float dpp_f(float v) { return __builtin_bit_cast(float, __builtin_amdgcn_update_dpp(0, __builtin_bit_cast(int, v), CTRL, 0xf, 0xf, false)); }
__device__ __forceinline__ float row_sum(float v) { v += dpp_f<0xB1>(v); v += dpp_f<0x4E>(v); v += dpp_f<0x141>(v); v += dpp_f<0x140>(v); return v; }
__device__ __forceinline__ float wave_sum_dpp(float v) { v = row_sum(v); v += __shfl_xor(v, 16); v += __shfl_xor(v, 32); return v; }
__device__ __forceinline__ float wave_max(float v) {
#pragma unroll
    for (int o = 1; o < 64; o <<= 1) v = fmaxf(v, __shfl_xor(v, o));
    return v;
}

#define XB_TMO      128
#define XB_XCNT(j)  (256  + 64 * (j))
#define XB_XSUB(j)  (1280 + 64 * (j))
#define XB_XGEN(j)  (2304 + 64 * (j))
#define XB_TOP      3328
#define XB_TOPGEN   3392
#define XCD_BAR_WORDS 3456
#define XB_SPIN_CAP (1u << 18)
__device__ __forceinline__ unsigned xb_ld(unsigned* p)              { return __hip_atomic_load(p, __ATOMIC_RELAXED, __HIP_MEMORY_SCOPE_AGENT); }
__device__ __forceinline__ unsigned xb_add(unsigned* p, unsigned v) { return __hip_atomic_fetch_add(p, v, __ATOMIC_RELAXED, __HIP_MEMORY_SCOPE_AGENT); }
__device__ __forceinline__ unsigned xb_xcc_id() { return (unsigned)__builtin_amdgcn_s_getreg((3 << 11) | 20) & 0xFu; }
#define XB_SPIN(cond, bar) do { unsigned _sp = 0; while (cond) { __builtin_amdgcn_s_sleep(1); \
    if ((++_sp & 255u) == 0u) { if (xb_ld(&(bar)[XB_TMO])) break; if (_sp > XB_SPIN_CAP) { atomicAdd(&(bar)[XB_TMO], 1u); break; } } } } while (0)
struct XcdBarrier { unsigned* bar; unsigned x; volatile LAS unsigned* st; };
__device__ __forceinline__ XcdBarrier xcd_barrier_post(unsigned* bar, volatile LAS unsigned* st) {
    XcdBarrier b; b.bar = bar; b.x = xb_xcc_id(); b.st = st;
    if (threadIdx.x == 0) (void)xb_add(&bar[XB_XCNT(b.x)], 1u);
    return b;
}
__device__ __forceinline__ void xcd_barrier_complete(unsigned* bar, unsigned x, unsigned& nloc, unsigned& nx) {
    const unsigned G = gridDim.x * gridDim.y * gridDim.z;
    unsigned sum, cnt, mine, sp = 0u;
    for (;;) {
        sum = 0u; cnt = 0u; mine = 0u;
#pragma unroll
        for (unsigned j = 0; j < 16; ++j) { const unsigned c = xb_ld(&bar[XB_XCNT(j)]); sum += c; cnt += (c > 0u) ? 1u : 0u; mine = (j == x) ? c : mine; }
        if (sum == G) break;
        __builtin_amdgcn_s_sleep(1);
        if ((++sp & 255u) == 0u) { if (xb_ld(&bar[XB_TMO])) break; if (sp > XB_SPIN_CAP) { atomicAdd(&bar[XB_TMO], 1u); break; } }
    }
    nloc = mine > 0u ? mine : 1u; nx = cnt > 0u ? cnt : 1u;
}
__device__ __forceinline__ void xcd_barrier(const XcdBarrier& b) {
    asm volatile("s_waitcnt vmcnt(0)" ::: "memory");
    __syncthreads();
    if (threadIdx.x == 0) {
        unsigned* bar = b.bar;
        __builtin_amdgcn_s_waitcnt(0);
        unsigned nloc = b.st[0], nx = b.st[1];
        if (nloc == 0u) { xcd_barrier_complete(bar, b.x, nloc, nx); b.st[0] = nloc; b.st[1] = nx; }
        const unsigned old = xb_add(&bar[XB_XSUB(b.x)], 1u);
        const unsigned gen = old / nloc;
        if (old + 1u == (gen + 1u) * nloc) {
            __builtin_amdgcn_fence(__ATOMIC_RELEASE, "agent");
            asm volatile("s_waitcnt vmcnt(0)" ::: "memory");
            const unsigned og = xb_add(&bar[XB_TOP], 1u);
            const unsigned tg = og / nx;
            if (og + 1u == (tg + 1u) * nx) xb_add(&bar[XB_TOPGEN], 1u);
            else XB_SPIN(xb_ld(&bar[XB_TOPGEN]) == tg, bar);
            __builtin_amdgcn_fence(__ATOMIC_ACQUIRE, "agent");
            xb_add(&bar[XB_XGEN(b.x)], 1u);
            asm volatile("s_waitcnt vmcnt(0)" ::: "memory");
        } else {
            XB_SPIN(xb_ld(&bar[XB_XGEN(b.x)]) == gen, bar);
            __builtin_amdgcn_fence(__ATOMIC_ACQUIRE, "agent");
            asm volatile("s_waitcnt vmcnt(0)" ::: "memory");
        }
    }
    __syncthreads();
}


struct EpiProjA {
    static constexpr bool PERM = true, AFTER_DRAIN = false;
    bf16_t *u, *gv, *qm;
    __device__ __forceinline__ void operator()(const f32x4 (&acc)[2][2][4][2], const Unit& un, int wr, int wc, int fr, int fq) const {
        const int row0 = un.pm * 256 + wr * 64 + fr;
        bf16_t* base; int ldc, colt; bool act; float sc = 1.f;
        if (un.pn < 3) { base = u; ldc = SGW; colt = un.pn * 256; act = true; }
        else if (un.pn < 6) { base = gv; ldc = SGW; colt = (un.pn - 3) * 256; act = true; }
        else { base = qm; ldc = 256; colt = 0; act = false; sc = ATT_SCALE; }
        const int col0 = colt + wc * 32 + 8 * fq;
#pragma unroll
        for (int ai = 0; ai < 2; ++ai)
#pragma unroll
            for (int m = 0; m < 4; ++m) { bf16_t* rowp = base + (size_t)(row0 + ai * 128 + m * 16) * ldc + col0;
#pragma unroll
                for (int bj = 0; bj < 2; ++bj) { f32x4 v0 = acc[ai][bj][m][0], v1 = acc[ai][bj][m][1];
                    if (act) { pg8::f32x2 a = pg8::gelu_pk((pg8::f32x2){v0[0], v0[1]}), b = pg8::gelu_pk((pg8::f32x2){v0[2], v0[3]}), c = pg8::gelu_pk((pg8::f32x2){v1[0], v1[1]}), d = pg8::gelu_pk((pg8::f32x2){v1[2], v1[3]});
                        v0 = (f32x4){a.x, a.y, b.x, b.y}; v1 = (f32x4){c.x, c.y, d.x, d.y}; }
                    v0 = v0 * sc; v1 = v1 * sc;
                    u32x4 w; w.x = cvt_pk_bf16(v0[0], v0[1]); w.y = cvt_pk_bf16(v0[2], v0[3]); w.z = cvt_pk_bf16(v1[0], v1[1]); w.w = cvt_pk_bf16(v1[2], v1[3]);
                    *(u32x4*)(rowp + bj * 128) = w; } }
    }
};
struct EpiProjB {
    static constexpr bool PERM = true, AFTER_DRAIN = false;
    bf16_t *k, *v, *q, *qm;
    __device__ __forceinline__ void operator()(const f32x4 (&acc)[2][2][4][2], const Unit& un, int wr, int wc, int fr, int fq) const {
        const int row0 = un.pm * 256 + wr * 64 + fr;
        bf16_t* base; int ldc, colt; float sc = 1.f;
        if (un.pn < 3) { base = k; ldc = SGW; colt = un.pn * 256; }
        else if (un.pn < 6) { base = v; ldc = SGW; colt = (un.pn - 3) * 256; }
        else if (un.pn < 9) { base = q; ldc = SGW; colt = (un.pn - 6) * 256; sc = ATT_SCALE; }
        else { base = qm; ldc = 256; colt = 0; sc = ATT_SCALE; }
        const int col0 = colt + wc * 32 + 8 * fq;
#pragma unroll
        for (int ai = 0; ai < 2; ++ai)
#pragma unroll
            for (int m = 0; m < 4; ++m) { bf16_t* rowp = base + (size_t)(row0 + ai * 128 + m * 16) * ldc + col0;
#pragma unroll
                for (int bj = 0; bj < 2; ++bj) { f32x4 v0 = acc[ai][bj][m][0] * sc, v1 = acc[ai][bj][m][1] * sc;
                    u32x4 w; w.x = cvt_pk_bf16(v0[0], v0[1]); w.y = cvt_pk_bf16(v0[2], v0[3]); w.z = cvt_pk_bf16(v1[0], v1[1]); w.w = cvt_pk_bf16(v1[2], v1[3]);
                    *(u32x4*)(rowp + bj * 128) = w; } }
    }
};
struct EpiPlain {
    static constexpr bool PERM = true, AFTER_DRAIN = false;
    bf16_t* O; int ldc, ntn;
    __device__ __forceinline__ void operator()(const f32x4 (&acc)[2][2][4][2], const Unit& un, int wr, int wc, int fr, int fq) const {
        const int row0 = un.pm * 256 + wr * 64 + fr;
        const int col0 = (un.pn % ntn) * 256 + wc * 32 + 8 * fq;
#pragma unroll
        for (int ai = 0; ai < 2; ++ai)
#pragma unroll
            for (int m = 0; m < 4; ++m) { bf16_t* rowp = O + (size_t)(row0 + ai * 128 + m * 16) * ldc + col0;
#pragma unroll
                for (int bj = 0; bj < 2; ++bj) { const f32x4 v0 = acc[ai][bj][m][0], v1 = acc[ai][bj][m][1];
                    u32x4 w; w.x = cvt_pk_bf16(v0[0], v0[1]); w.y = cvt_pk_bf16(v0[2], v0[3]); w.z = cvt_pk_bf16(v1[0], v1[1]); w.w = cvt_pk_bf16(v1[2], v1[3]);
                    *(u32x4*)(rowp + bj * 128) = w; } }
    }
};
struct EpiSwiGLU {
    static constexpr bool PERM = true, AFTER_DRAIN = false;
    bf16_t* O;
    __device__ __forceinline__ void operator()(const f32x4 (&acc)[2][2][4][2], const Unit& un, int wr, int wc, int fr, int fq) const {
        const int row0 = un.pm * 256 + wr * 64 + fr;
        const int col0 = (un.pn & 7) * 128 + wc * 32 + 8 * fq;
#pragma unroll
        for (int ai = 0; ai < 2; ++ai)
#pragma unroll
            for (int m = 0; m < 4; ++m) { bf16_t* rowp = O + (size_t)(row0 + ai * 128 + m * 16) * 1024 + col0;
                float r[8];
#pragma unroll
                for (int n = 0; n < 2; ++n)
#pragma unroll
                    for (int j = 0; j < 4; ++j) { const float g = acc[ai][0][m][n][j], up = acc[ai][1][m][n][j];
                        r[n * 4 + j] = g * __builtin_amdgcn_rcpf(1.0f + __expf(-g)) * up; }
                u32x4 w; w.x = cvt_pk_bf16(r[0], r[1]); w.y = cvt_pk_bf16(r[2], r[3]); w.z = cvt_pk_bf16(r[4], r[5]); w.w = cvt_pk_bf16(r[6], r[7]);
                *(u32x4*)rowp = w; }
    }
};
struct EpiSwiGLU8 {
    static constexpr bool PERM = true, AFTER_DRAIN = false;
    unsigned char* O;
    __device__ __forceinline__ void operator()(const f32x4 (&acc)[2][2][4][2], const Unit& un, int wr, int wc, int fr, int fq) const {
        const int row0 = un.pm * 256 + wr * 64 + fr;
        const int col0 = (un.pn & 7) * 128 + wc * 32 + 8 * fq;
#pragma unroll
        for (int ai = 0; ai < 2; ++ai)
#pragma unroll
            for (int m = 0; m < 4; ++m) { unsigned char* rowp = O + (size_t)(row0 + ai * 128 + m * 16) * 1024 + col0;
                float r[8];
#pragma unroll
                for (int n = 0; n < 2; ++n)
#pragma unroll
                    for (int j = 0; j < 4; ++j) { const float g = acc[ai][0][m][n][j], up = acc[ai][1][m][n][j];
                        r[n * 4 + j] = g * __builtin_amdgcn_rcpf(1.0f + __expf(-g)) * up * 8.0f; }
                *(u32x2*)rowp = (u32x2){pk4_fp8_e(r[0], r[1], r[2], r[3]), pk4_fp8_e(r[4], r[5], r[6], r[7])}; }
    }
};
template <bool RB> struct EpiResid {
    static constexpr bool PERM = false, AFTER_DRAIN = false;
    const void* res; float* Y;
    __device__ __forceinline__ void operator()(const f32x4 (&acc)[2][2][4][2], const Unit& un, int wr, int wc, int fr, int fq) const {
        const int row0 = un.pm * 256 + wr * 64 + fr, col0 = un.pn * 256 + wc * 32 + 4 * fq;
#pragma unroll
        for (int ai = 0; ai < 2; ++ai)
#pragma unroll
            for (int m = 0; m < 4; ++m) { const size_t off = (size_t)(row0 + ai * 128 + m * 16) * D + col0;
#pragma unroll
                for (int bj = 0; bj < 2; ++bj)
#pragma unroll
                    for (int n = 0; n < 2; ++n) { const size_t o = off + bj * 128 + n * 16; f32x4 r;
                        if (RB) { const u32x2 w = *(const u32x2*)((const bf16_t*)res + o); r = (f32x4){bflo(w.x), bfhi(w.x), bflo(w.y), bfhi(w.y)}; }
                        else r = *(const f32x4*)((const float*)res + o);
                        *(f32x4*)(Y + o) = r * ALPHA + acc[ai][bj][m][n]; } }
    }
};
struct SmallOrder {
    int nN, nwg, c;
    __device__ bool next(int i, Unit& u) const { if (i != 0 || c < 0 || c >= nwg) return false; u.pm = c / nN; u.pn = c % nN; return true; }
    __device__ __forceinline__ void a_ready(const Unit&) const {}
    __device__ __forceinline__ void done(const Unit&) const {}
    __device__ __forceinline__ int arow(int, const Unit& u, int r) const { return u.pm * 256 + r; }
};
struct MoeOrder {
    const LAS int* tb;
    int ntn, G, c;
    __device__ bool next(int i, Unit& u) const {
        const int L = i * G + c; if (L >= tb[16] * ntn) return false;
        int e = 0;
#pragma unroll
        for (int j = 1; j < 16; ++j) e += (L >= tb[j] * ntn) ? 1 : 0;
        const int r = L - tb[e] * ntn, te = tb[e + 1] - tb[e];
        u.pm = tb[e] + r % te; u.pn = e * ntn + r / te; return true;
    }
    __device__ __forceinline__ void a_ready(const Unit&) const {}
    __device__ __forceinline__ void done(const Unit&) const {}
    __device__ __forceinline__ int arow(int, const Unit& u, int r) const { return u.pm * 256 + r; }
};
struct MoeGatherOrder : MoeOrder {
    const LAS int* toks;
    __device__ __forceinline__ int arow(int ui, const Unit&, int r) const { return toks[ui * 256 + r]; }
};

struct Args { const float* in[23]; float* out; unsigned char* ws; int ph_lo, ph_hi; };
struct Ctx {
    unsigned char* ws; LAS unsigned char* lds;
    int tid, lane, wave, gw, NGW, G, bid;
};
__device__ __forceinline__ unsigned char* launder(unsigned char* p) { asm volatile("" : "+s"(p)); return p; }
__device__ __forceinline__ int launder_v(int v) { asm volatile("" : "+v"(v)); return v; }

__device__ __forceinline__ void tr_item(const float* W, int K, int N, bf16_t* WT, int grp, int gstride, int roff, LAS float* scr, int item, int lane) {
    const int nblk = N / 32, kb = item / nblk, nb = item % nblk, k0 = 64 * kb, n0 = 32 * nb;
    float ld[32];
    { const float* wp = W + (size_t)(k0 + (lane >> 5)) * N + n0 + (lane & 31);
#pragma unroll
      for (int i = 0; i < 32; ++i) ld[i] = __builtin_nontemporal_load(wp + (size_t)(2 * i) * N); }
#pragma unroll
    for (int i = 0; i < 32; ++i) scr[(2 * i + (lane >> 5)) * 33 + (lane & 31)] = ld[i];
    LDS_WAIT(); asm volatile("" ::: "memory");
    const int c = lane & 7;
#pragma unroll
    for (int j = 0; j < 4; ++j) { const int n = (lane >> 3) + 8 * j; const LAS float* s = scr + (8 * c) * 33 + n;
        const int nn = n0 + n, drow = (nn / grp) * gstride + (nn % grp) + roff;
        u32x4 o; o.x = pk2(s[0 * 33], s[1 * 33]); o.y = pk2(s[2 * 33], s[3 * 33]); o.z = pk2(s[4 * 33], s[5 * 33]); o.w = pk2(s[6 * 33], s[7 * 33]);
        *(u32x4*)(WT + (size_t)drow * K + k0 + 8 * c) = o; }
    LDS_WAIT(); asm volatile("" ::: "memory");
}
__device__ __forceinline__ unsigned pk4_fp8(float a, float b, float c, float d) { int r = 0; r = __builtin_amdgcn_cvt_pk_fp8_f32(a, b, r, false); r = __builtin_amdgcn_cvt_pk_fp8_f32(c, d, r, true); return (unsigned)r; }
__device__ __forceinline__ void tr_item8(const float* W, int K, int N, unsigned char* WT, int grp, int gstride, int roff, float sc, LAS float* scr, int item, int lane) {
    const int nblk = N / 32, kb = item / nblk, nb = item % nblk, k0 = 64 * kb, n0 = 32 * nb;
    float ld[32];
    { const float* wp = W + (size_t)(k0 + (lane >> 5)) * N + n0 + (lane & 31);
#pragma unroll
      for (int i = 0; i < 32; ++i) ld[i] = __builtin_nontemporal_load(wp + (size_t)(2 * i) * N); }
#pragma unroll
    for (int i = 0; i < 32; ++i) scr[(2 * i + (lane >> 5)) * 33 + (lane & 31)] = ld[i];
    LDS_WAIT(); asm volatile("" ::: "memory");
    const int c = lane & 7;
#pragma unroll
    for (int j = 0; j < 4; ++j) { const int n = (lane >> 3) + 8 * j; const LAS float* s = scr + (8 * c) * 33 + n;
        const int nn = n0 + n, drow = (nn / grp) * gstride + (nn % grp) + roff;
        u32x2 o; o.x = pk4_fp8(s[0 * 33] * sc, s[1 * 33] * sc, s[2 * 33] * sc, s[3 * 33] * sc); o.y = pk4_fp8(s[4 * 33] * sc, s[5 * 33] * sc, s[6 * 33] * sc, s[7 * 33] * sc);
        *(u32x2*)(WT + (size_t)drow * K + k0 + 8 * c) = o; }
    LDS_WAIT(); asm volatile("" ::: "memory");
}
constexpr float W8_SCALE = 32.0f, ACT8_SCALE = 8.0f;
constexpr int E8_ONE = 0x7f7f7f7f, E8_W = 0x7a7a7a7a, E8_ACT = 0x7c7c7c7c;
__device__ __forceinline__ void moe_conv_item(const Args& A, unsigned char* ws, LAS float* scr, int lane, int layer, int r) {
    const int t = r >> 13, e = (r & 8191) >> 9, m = layer * 16 + e, item = r & 511;
    if (t == 0) tr_item8(A.in[20] + (size_t)m * 1048576, 1024, 1024, ws + WS_WGU + (size_t)layer * (64 * MiB) + (size_t)e * 2097152, 128, 256, 0, W8_SCALE, scr, item, lane);
    else if (t == 1) tr_item8(A.in[21] + (size_t)m * 1048576, 1024, 1024, ws + WS_WGU + (size_t)layer * (64 * MiB) + (size_t)e * 2097152, 128, 256, 128, W8_SCALE, scr, item, lane);
    else tr_item8(A.in[22] + (size_t)m * 1048576, 1024, 1024, ws + WS_WD + (size_t)layer * (32 * MiB) + (size_t)e * 1048576, 1024, 1024, 0, W8_SCALE, scr, item, lane);
}
constexpr int N_CONV1 = 3 * 8192;
__device__ __forceinline__ void fill_tail(const Ctx& C, const Args& A, int ph, bool fin) {
    unsigned* ctl = (unsigned*)(C.ws + WS_CTL);
    volatile LAS int* flag = (volatile LAS int*)(C.lds + LDS_MISC) + 40;
    LAS float* scr = (LAS float*)(C.lds + C.wave * 16384);
    asm volatile("s_waitcnt vmcnt(0)" ::: "memory");
    __syncthreads();
    if (C.tid == 0 && !fin) __hip_atomic_fetch_add(ctl + CW_DONE + 64 * ph, 1u, __ATOMIC_RELAXED, __HIP_MEMORY_SCOPE_AGENT);
    for (;;) {
        if (C.tid == 0) { int v = -1;
            const unsigned d = fin ? 0u : __hip_atomic_fetch_add(ctl + CW_DONE + 64 * ph, 0u, __ATOMIC_RELAXED, __HIP_MEMORY_SCOPE_AGENT);
            if (d + 8u < (unsigned)C.G) { v = (int)__hip_atomic_fetch_add(ctl + CW_CONV, 8u, __ATOMIC_RELAXED, __HIP_MEMORY_SCOPE_AGENT); if (v >= N_CONV1) v = -1; }
#if MK_DIAG == 3
            if (!fin && v >= 0) __hip_atomic_fetch_add(ctl + 30000, 8u, __ATOMIC_RELAXED, __HIP_MEMORY_SCOPE_AGENT);
#endif
            *flag = v; }
        __syncthreads();
        const int v = *flag;
        __syncthreads();
        if (v < 0) break;
        if (v + C.wave < N_CONV1) moe_conv_item(A, C.ws, scr, C.lane, 1, v + C.wave);
    }
}
__device__ __forceinline__ void p0_prologue(const Ctx& C, const Args& A) {
    LAS float* scr = (LAS float*)(C.lds + C.wave * 16384);
    unsigned char* ws = C.ws;
    constexpr int I_MOE = 16 * 32;
    constexpr int N_MOE = 32 * I_MOE;
    constexpr int I_INA = 16 * 56, I_SQ = 512, I_KV = 16 * 24, I_OUTB = 8 * 32, I_MEM = 16 * 8;
    constexpr int N_MOE0 = 3 * 8192;
    constexpr int NITEMS = I_INA + I_SQ + I_SQ + 2 * I_KV + I_OUTB + 4 * I_MEM;
    for (int it = C.gw; it < NITEMS; it += C.NGW) {
        int r = it;
        if (r < I_INA) { tr_item(A.in[2], 1024, 1792, (bf16_t*)(ws + WS_BT_INA), 1792, 1792, 0, scr, r, C.lane); continue; } r -= I_INA;
        if (r < I_SQ) { tr_item(A.in[3], 1024, 1024, (bf16_t*)(ws + WS_BT_OUTA), 1024, 1024, 0, scr, r, C.lane); continue; } r -= I_SQ;
        if (r < I_SQ) { tr_item(A.in[8], 1024, 1024, (bf16_t*)(ws + WS_BT_B), 1024, 1024, 1536, scr, r, C.lane); continue; } r -= I_SQ;
        if (r < I_KV) { tr_item(A.in[10], 1024, 768, (bf16_t*)(ws + WS_BT_B), 768, 768, 0, scr, r, C.lane); continue; } r -= I_KV;
        if (r < I_KV) { tr_item(A.in[11], 1024, 768, (bf16_t*)(ws + WS_BT_B), 768, 768, 768, scr, r, C.lane); continue; } r -= I_KV;
        if (r < I_OUTB) { tr_item(A.in[9], 512, 1024, (bf16_t*)(ws + WS_BT_OUTB), 1024, 1024, 0, scr, r, C.lane); continue; } r -= I_OUTB;
        { const int m = r / I_MEM, layer = m & 1, isv = m >> 1;
          tr_item(A.in[isv ? 13 : 12] + (size_t)layer * 262144, 1024, 256, (bf16_t*)(ws + WS_BT_MEM), 256, 256, layer * 512 + isv * 256, scr, r % I_MEM, C.lane); }
    }
    const int gt = C.bid * NTHREADS + C.tid, NT = C.G * NTHREADS;
    for (int i = gt; i < NSG * 128 * 128 / 8; i += NT) { const int q0 = (i & 15) * 8, p = (i >> 4) & 127;
        const f32x4 a = *(const f32x4*)(A.in[6] + (size_t)i * 8), b = *(const f32x4*)(A.in[6] + (size_t)i * 8 + 4); float v[8] = {a[0], a[1], a[2], a[3], b[0], b[1], b[2], b[3]};
#pragma unroll
        for (int j = 0; j < 8; ++j) v[j] = (q0 + j <= p) ? v[j] : 0.f;
        u32x4 w; w.x = pk2(v[0], v[1]); w.y = pk2(v[2], v[3]); w.z = pk2(v[4], v[5]); w.w = pk2(v[6], v[7]); *(u32x4*)((bf16_t*)(ws + WS_SGWB) + (size_t)i * 8) = w; }
    for (int i = gt; i < NSG * 128; i += NT) { const int p = i & 127; float acc = 0.f;
        for (int q = 0; q <= p; ++q) acc += bflo(f2bf(A.in[6][(size_t)i * 128 + q]));
        ((float*)(ws + WS_SGRS))[i] = acc; }
    for (int i = gt; i < T * D / 8; i += NT) { const f32x4 a = *(const f32x4*)(A.in[0] + (size_t)i * 8), b = *(const f32x4*)(A.in[0] + (size_t)i * 8 + 4);
        u32x4 w; w.x = pk2(a[0], a[1]); w.y = pk2(a[2], a[3]); w.z = pk2(b[0], b[1]); w.w = pk2(b[2], b[3]); *(u32x4*)((bf16_t*)(ws + WS_XB) + (size_t)i * 8) = w; }
    for (int i = gt; i < NB * NMEM * D / 8; i += NT) { const f32x4 a = *(const f32x4*)(A.in[1] + (size_t)i * 8), b = *(const f32x4*)(A.in[1] + (size_t)i * 8 + 4);
        u32x4 w; w.x = pk2(a[0], a[1]); w.y = pk2(a[2], a[3]); w.z = pk2(b[0], b[1]); w.w = pk2(b[2], b[3]); *(u32x4*)((bf16_t*)(ws + WS_MEMB) + (size_t)i * 8) = w; }
    { unsigned* ctr = (unsigned*)(ws + WS_CTL) + CW_CONV0; volatile LAS int* flag = (volatile LAS int*)(C.lds + LDS_MISC) + 40;
      if (C.tid == 0) *flag = (int)__hip_atomic_fetch_add(ctr, 8u, __ATOMIC_RELAXED, __HIP_MEMORY_SCOPE_AGENT);
      __syncthreads();
      int cur = *flag;
      __syncthreads();
      while (cur < N_MOE0) {
          int nxt = 0;
          if (C.tid == 0) nxt = (int)__hip_atomic_fetch_add(ctr, 8u, __ATOMIC_RELAXED, __HIP_MEMORY_SCOPE_AGENT);
          if (cur + C.wave < N_MOE0) moe_conv_item(A, ws, scr, C.lane, 0, cur + C.wave);
          if (C.tid == 0) *flag = nxt;
          __syncthreads();
          cur = *flag;
          __syncthreads();
      } }
}

__device__ __forceinline__ void sg_scalar(const Ctx& C, const Args& A) {
    const bf16_t* U = (const bf16_t*)(C.ws + WS_U); const bf16_t* GV = (const bf16_t*)(C.ws + WS_GV); bf16_t* CAT = (bf16_t*)(C.ws + WS_CAT);
    const float* lng = A.in[4]; const float* lnb = A.in[5]; const float* sgw = A.in[6]; const float* sgb = A.in[7];
    LAS float* stat = (LAS float*)C.lds;
    LAS float* gvn = (LAS float*)(C.lds + 1024);
    LAS float* Wl = (LAS float*)(C.lds + 1024 + 128 * 65 * 4);
    for (int unit = C.bid; unit < NB * 16; unit += C.G) {
        const int tb = unit * 128;
        for (int rr = 0; rr < 16; ++rr) { const int row = C.wave * 16 + rr; const bf16_t* p = GV + (size_t)(tb + row) * SGW + 4 * C.lane;
            float s = 0.f, ss = 0.f;
#pragma unroll
            for (int j = 0; j < 3; ++j) { const u32x2 w = *(const u32x2*)(p + 256 * j); const float a = bflo(w.x), b = bfhi(w.x), c = bflo(w.y), d = bfhi(w.y);
                s += (a + b) + (c + d); ss += (a * a + b * b) + (c * c + d * d); }
            s = wave_sum(s); ss = wave_sum(ss);
            const float mean = s * (1.f / SGW), var = ss * (1.f / SGW) - mean * mean;
            if (C.lane == 0) { stat[row * 2] = mean; stat[row * 2 + 1] = 1.0f / sqrtf(var + LN_EPS); } }
        __syncthreads();
        const int p = C.tid >> 2, d0 = (C.tid & 3) * 16;
        for (int g = 0; g < NSG; ++g) {
            { const bf16_t* src = GV + (size_t)(tb + p) * SGW + g * 64 + d0; const float mean = stat[p * 2], rstd = stat[p * 2 + 1];
#pragma unroll
              for (int h = 0; h < 2; ++h) { const u32x4 w = *(const u32x4*)(src + 8 * h); const unsigned ww[4] = {w.x, w.y, w.z, w.w};
#pragma unroll
                  for (int j = 0; j < 4; ++j) { const int d = d0 + 8 * h + 2 * j; const int cc = g * 64 + d;
                      gvn[p * 65 + d] = (bflo(ww[j]) - mean) * rstd * lng[cc] + lnb[cc];
                      gvn[p * 65 + d + 1] = (bfhi(ww[j]) - mean) * rstd * lng[cc + 1] + lnb[cc + 1]; } } }
            { const int q0 = (C.tid & 3) * 32; const float* src = sgw + ((size_t)g * 128 + p) * 128 + q0;
#pragma unroll
              for (int j = 0; j < 8; ++j) { const f32x4 w = *(const f32x4*)(src + 4 * j);
#pragma unroll
                  for (int t = 0; t < 4; ++t) { const int q = q0 + 4 * j + t; Wl[p * 129 + q] = (q <= p) ? w[t] : 0.f; } } }
            __syncthreads();
            float acc[16];
#pragma unroll
            for (int j = 0; j < 16; ++j) acc[j] = 0.f;
            for (int q = 0; q <= p; ++q) { const float w = Wl[p * 129 + q];
#pragma unroll
                for (int j = 0; j < 16; ++j) acc[j] += w * gvn[q * 65 + d0 + j]; }
            const float bs = sgb[g * 128 + p];
            const bf16_t* us = U + (size_t)(tb + p) * SGW + g * 64 + d0; bf16_t* dst = CAT + (size_t)(tb + p) * D + g * 64 + d0;
#pragma unroll
            for (int h = 0; h < 2; ++h) { const u32x4 w = *(const u32x4*)(us + 8 * h); const unsigned ww[4] = {w.x, w.y, w.z, w.w}; unsigned o[4];
#pragma unroll
                for (int j = 0; j < 4; ++j) o[j] = pk2(bflo(ww[j]) * (acc[8 * h + 2 * j] + bs), bfhi(ww[j]) * (acc[8 * h + 2 * j + 1] + bs));
                *(u32x4*)(dst + 8 * h) = (u32x4){o[0], o[1], o[2], o[3]}; }
            __syncthreads();
        }
    }
}

__device__ __forceinline__ void memattn_scalar(const Ctx& C, const bf16_t* QM, const bf16_t* MKV, int ck, int cv, bf16_t* OUT, int ldo, int coff) {
    for (int it = C.gw; it < T * 4; it += C.NGW) {
        const int tok = it >> 2, h = it & 3, b = tok / SEQ;
        float q[64];
        { const bf16_t* qp = QM + (size_t)tok * 256 + h * 64;
#pragma unroll
          for (int j = 0; j < 8; ++j) { const u32x4 w = *(const u32x4*)(qp + 8 * j);
              q[8 * j] = bflo(w.x); q[8 * j + 1] = bfhi(w.x); q[8 * j + 2] = bflo(w.y); q[8 * j + 3] = bfhi(w.y); q[8 * j + 4] = bflo(w.z); q[8 * j + 5] = bfhi(w.z); q[8 * j + 6] = bflo(w.w); q[8 * j + 7] = bfhi(w.w); } }
        float s[4];
#pragma unroll
        for (int jj = 0; jj < 4; ++jj) { const bf16_t* kp = MKV + (size_t)(b * NMEM + jj * 64 + C.lane) * 1024 + ck + h * 64; float a = 0.f;
#pragma unroll
            for (int j = 0; j < 8; ++j) { const u32x4 w = *(const u32x4*)(kp + 8 * j);
                a += q[8 * j] * bflo(w.x) + q[8 * j + 1] * bfhi(w.x) + q[8 * j + 2] * bflo(w.y) + q[8 * j + 3] * bfhi(w.y) + q[8 * j + 4] * bflo(w.z) + q[8 * j + 5] * bfhi(w.z) + q[8 * j + 6] * bflo(w.w) + q[8 * j + 7] * bfhi(w.w); }
            s[jj] = a; }
        const float mx = wave_max(fmaxf(fmaxf(s[0], s[1]), fmaxf(s[2], s[3])));
        float l = 0.f;
#pragma unroll
        for (int jj = 0; jj < 4; ++jj) { s[jj] = __expf(s[jj] - mx); l += s[jj]; }
        l = wave_sum(l);
        float acc = 0.f;
#pragma unroll
        for (int jj = 0; jj < 4; ++jj) { const bf16_t* vp = MKV + (size_t)(b * NMEM + jj * 64) * 1024 + cv + h * 64 + C.lane;
            for (int mm = 0; mm < 64; ++mm) acc += __shfl(s[jj], mm) * bf1(vp[(size_t)mm * 1024]); }
        OUT[(size_t)tok * ldo + coff + h * 64 + C.lane] = (bf16_t)f2bf(acc / l);
    }
}

__device__ __forceinline__ void dilattn_scalar(const Ctx& C, const Args& A) {
    const bf16_t* Q = (const bf16_t*)(C.ws + WS_Q); const bf16_t* K = (const bf16_t*)(C.ws + WS_K); const bf16_t* V = (const bf16_t*)(C.ws + WS_V);
    bf16_t* OG = (bf16_t*)(C.ws + WS_OG); float* LSE = (float*)(C.ws + WS_LSE);
    for (int it = C.gw; it < T * 12; it += C.NGW) {
        const int tok = it / 12, h = it % 12, g = h >> 2, dl = (g == 0) ? 1 : (g == 1 ? 4 : 16);
        const int t = tok % SEQ, i = t / dl;
        const float slope = exp2f(-(float)(h + 1) * (8.0f / 12.0f));
        float q[64];
        { const bf16_t* qp = Q + (size_t)tok * SGW + h * 64;
#pragma unroll
          for (int j = 0; j < 8; ++j) { const u32x4 w = *(const u32x4*)(qp + 8 * j);
              q[8 * j] = bflo(w.x); q[8 * j + 1] = bfhi(w.x); q[8 * j + 2] = bflo(w.y); q[8 * j + 3] = bfhi(w.y); q[8 * j + 4] = bflo(w.z); q[8 * j + 5] = bfhi(w.z); q[8 * j + 6] = bflo(w.w); q[8 * j + 7] = bfhi(w.w); } }
        float s[3];
#pragma unroll
        for (int jj = 0; jj < 3; ++jj) { const int j0 = jj * 64 + C.lane; const bool valid = (jj < 2 || C.lane == 0) && (j0 <= i);
            const int jc = valid ? j0 : 0;
            const bf16_t* kp = K + (size_t)(tok - jc * dl) * SGW + h * 64; float a = 0.f;
#pragma unroll
            for (int j = 0; j < 8; ++j) { const u32x4 w = *(const u32x4*)(kp + 8 * j);
                a += q[8 * j] * bflo(w.x) + q[8 * j + 1] * bfhi(w.x) + q[8 * j + 2] * bflo(w.y) + q[8 * j + 3] * bfhi(w.y) + q[8 * j + 4] * bflo(w.z) + q[8 * j + 5] * bfhi(w.z) + q[8 * j + 6] * bflo(w.w) + q[8 * j + 7] * bfhi(w.w); }
            s[jj] = valid ? (a - slope * (float)(dl * j0)) : -INFINITY; }
        const float mx = wave_max(fmaxf(fmaxf(s[0], s[1]), s[2]));
        float l = 0.f;
#pragma unroll
        for (int jj = 0; jj < 3; ++jj) { s[jj] = __expf(s[jj] - mx); l += s[jj]; }
        l = wave_sum(l);
        float acc = 0.f;
#pragma unroll
        for (int jj = 0; jj < 3; ++jj) { const int nm = (jj < 2) ? 64 : 1;
            for (int mm = 0; mm < nm; ++mm) { const int j0 = jj * 64 + mm; const int jc = (j0 <= i) ? j0 : 0;
                acc += __shfl(s[jj], mm) * bf1(V[(size_t)(tok - jc * dl) * SGW + h * 64 + C.lane]); } }
        OG[(size_t)tok * SGW + h * 64 + C.lane] = (bf16_t)f2bf(acc / l);
        if (C.lane == 0) LSE[tok * 12 + h] = mx + __logf(l);
    }
}
typedef short bf16x8 __attribute__((ext_vector_type(8)));
typedef short s16x4 __attribute__((ext_vector_type(4)));
constexpr int AT_KS = 144, AT_VS = 160, AT_ROWS = 272, AT_K_OFF = 0, AT_V_OFF = AT_ROWS * AT_KS;
static_assert(AT_V_OFF % 16 == 0 && AT_V_OFF + AT_ROWS * AT_VS <= 131072, "attention LDS map");

template <int NKB, bool DIL>
__device__ __forceinline__ void attn_compute(LAS unsigned char* lds, int lane, int krow0, bf16x8 qf0, bf16x8 qf1, float sdl, int ikw, f32x4 (&o)[4], float& mx, float& lsum) {
    const int n = lane & 15, g = lane >> 4;
    const LAS unsigned char* Kb = lds + AT_K_OFF + (krow0 + n) * AT_KS + g * 16;
    f32x4 sc[NKB];
#pragma unroll
    for (int kb = 0; kb < NKB; ++kb) {
        const bf16x8 k0 = *(const LAS bf16x8*)(Kb + kb * 16 * AT_KS), k1 = *(const LAS bf16x8*)(Kb + kb * 16 * AT_KS + 64);
        f32x4 a = (f32x4){0.f, 0.f, 0.f, 0.f};
        a = __builtin_amdgcn_mfma_f32_16x16x32_bf16(k0, qf0, a, 0, 0, 0);
        a = __builtin_amdgcn_mfma_f32_16x16x32_bf16(k1, qf1, a, 0, 0, 0);
        sc[kb] = a;
    }
    float m = -INFINITY;
#pragma unroll
    for (int kb = 0; kb < NKB; ++kb)
#pragma unroll
        for (int r = 0; r < 4; ++r) {
            if (DIL) { const int off = 16 * kb + 4 * g + r, rel = 144 + n - off; const bool valid = (rel >= 0) && (rel <= 128) && (ikw + off >= 0);
                sc[kb][r] = valid ? (sc[kb][r] - sdl * (float)rel) : -INFINITY; }
            m = fmaxf(m, sc[kb][r]); }
    m = fmaxf(m, __shfl_xor(m, 16)); m = fmaxf(m, __shfl_xor(m, 32));
    float l = 0.f;
#pragma unroll
    for (int kb = 0; kb < NKB; ++kb)
#pragma unroll
        for (int r = 0; r < 4; ++r) { sc[kb][r] = __expf(sc[kb][r] - m); l += sc[kb][r]; }
    l += __shfl_xor(l, 16); l += __shfl_xor(l, 32);
    mx = m; lsum = l;
    const LAS unsigned char* Vb = lds + AT_V_OFF + (krow0 + 4 * g + (n >> 2)) * AT_VS + (n & 3) * 8;
#pragma unroll
    for (int db = 0; db < 4; ++db) o[db] = (f32x4){0.f, 0.f, 0.f, 0.f};
#pragma unroll
    for (int kk = 0; kk < NKB / 2; ++kk) {
        union { bf16x8 v; unsigned u[4]; } pf;
        pf.u[0] = cvt_pk_bf16(sc[2 * kk][0], sc[2 * kk][1]); pf.u[1] = cvt_pk_bf16(sc[2 * kk][2], sc[2 * kk][3]);
        pf.u[2] = cvt_pk_bf16(sc[2 * kk + 1][0], sc[2 * kk + 1][1]); pf.u[3] = cvt_pk_bf16(sc[2 * kk + 1][2], sc[2 * kk + 1][3]);
#pragma unroll
        for (int db = 0; db < 4; ++db) {
            const s16x4 v0 = __builtin_amdgcn_ds_read_tr16_b64_v4i16((LAS s16x4*)(Vb + (2 * kk) * 16 * AT_VS + db * 32));
            const s16x4 v1 = __builtin_amdgcn_ds_read_tr16_b64_v4i16((LAS s16x4*)(Vb + (2 * kk + 1) * 16 * AT_VS + db * 32));
            const bf16x8 vf = __builtin_shufflevector(v0, v1, 0, 1, 2, 3, 4, 5, 6, 7);
            o[db] = __builtin_amdgcn_mfma_f32_16x16x32_bf16(vf, pf.v, o[db], 0, 0, 0);
        }
    }
}

__device__ __forceinline__ void memattn_mfma(const Ctx& C, const bf16_t* QM, const bf16_t* MKV, int ck, int cv, bf16_t* OUT, int ldo, int coff) {
    const int n = C.lane & 15, g = C.lane >> 4;
    for (int unit = C.bid; unit < NB * 4 * 16; unit += C.G) {
        const int b = unit >> 6, h = (unit >> 4) & 3, qt = unit & 15;
        __syncthreads();
#pragma unroll
        for (int it = 0; it < 4; ++it) { const int row = it * 64 + (C.tid >> 3), c = C.tid & 7;
            const bf16_t* src = MKV + (size_t)(b * NMEM + row) * 1024 + h * 64 + c * 8;
            const u32x4 kv = *(const u32x4*)(src + ck), vv = *(const u32x4*)(src + cv);
            *(LAS u32x4*)(C.lds + AT_K_OFF + row * AT_KS + c * 16) = kv; *(LAS u32x4*)(C.lds + AT_V_OFF + row * AT_VS + c * 16) = vv; }
        const int tok = b * SEQ + qt * 128 + C.wave * 16 + n;
        const bf16_t* qp = QM + (size_t)tok * 256 + h * 64 + g * 8;
        const bf16x8 qf0 = *(const bf16x8*)qp, qf1 = *(const bf16x8*)(qp + 32);
        __syncthreads();
        f32x4 o[4]; float mx, l;
        attn_compute<16, false>(C.lds, C.lane, 0, qf0, qf1, 0.f, 0, o, mx, l);
        const float inv = 1.0f / l;
#pragma unroll
        for (int db = 0; db < 4; ++db)
            *(u32x2*)(OUT + (size_t)tok * ldo + coff + h * 64 + 16 * db + 4 * g) = (u32x2){cvt_pk_bf16(o[db][0] * inv, o[db][1] * inv), cvt_pk_bf16(o[db][2] * inv, o[db][3] * inv)};
    }
}
__device__ __forceinline__ void dilattn_mfma(const Ctx& C) {
    const bf16_t* Q = (const bf16_t*)(C.ws + WS_Q); const bf16_t* K = (const bf16_t*)(C.ws + WS_K); const bf16_t* V = (const bf16_t*)(C.ws + WS_V);
    bf16_t* OG = (bf16_t*)(C.ws + WS_OG); float* LSE = (float*)(C.ws + WS_LSE);
    const int n = C.lane & 15, g = C.lane >> 4;
    for (int unit = C.bid; unit < 12 * 128; unit += C.G) {
        const int h = unit >> 7, rem = unit & 127, b = rem >> 4, x = rem & 15, grp = h >> 2;
        const int dl = (grp == 0) ? 1 : (grp == 1 ? 4 : 16), ntile = 16 / dl, r = x / ntile, I0 = (x % ntile) * 128;
        const float sdl = exp2f(-(float)(h + 1) * (8.0f / 12.0f)) * (float)dl;
        __syncthreads();
        { u32x4 kv[5], vv[5];
#pragma unroll
          for (int it = 0; it < 5; ++it) { const int idx = it * NTHREADS + C.tid, row = idx >> 3, c = idx & 7, ik = I0 - 144 + row;
              kv[it] = (u32x4){0u, 0u, 0u, 0u}; vv[it] = (u32x4){0u, 0u, 0u, 0u};
              if (idx < AT_ROWS * 8 && ik >= 0) { const size_t off = (size_t)(b * SEQ + ik * dl + r) * SGW + h * 64 + c * 8; kv[it] = *(const u32x4*)(K + off); vv[it] = *(const u32x4*)(V + off); } }
#pragma unroll
          for (int it = 0; it < 5; ++it) { const int idx = it * NTHREADS + C.tid, row = idx >> 3, c = idx & 7;
              if (idx < AT_ROWS * 8) { *(LAS u32x4*)(C.lds + AT_K_OFF + row * AT_KS + c * 16) = kv[it]; *(LAS u32x4*)(C.lds + AT_V_OFF + row * AT_VS + c * 16) = vv[it]; } } }
        const int iq = I0 + C.wave * 16 + n, tok = b * SEQ + iq * dl + r;
        const bf16_t* qp = Q + (size_t)tok * SGW + h * 64 + g * 8;
        const bf16x8 qf0 = *(const bf16x8*)qp, qf1 = *(const bf16x8*)(qp + 32);
        __syncthreads();
        f32x4 o[4]; float mx, l;
        attn_compute<10, true>(C.lds, C.lane, C.wave * 16, qf0, qf1, sdl, I0 + C.wave * 16 - 144, o, mx, l);
        const float inv = 1.0f / l;
#pragma unroll
        for (int db = 0; db < 4; ++db)
            *(u32x2*)(OG + (size_t)tok * SGW + h * 64 + 16 * db + 4 * g) = (u32x2){cvt_pk_bf16(o[db][0] * inv, o[db][1] * inv), cvt_pk_bf16(o[db][2] * inv, o[db][3] * inv)};
        if (g == 0) LSE[tok * 12 + h] = mx + __logf(l);
    }
}
constexpr int SG_GVN_OFF = 1024, SG_VS = 160, SG_TILE = 128 * SG_VS;
static_assert(SG_GVN_OFF + 6 * SG_TILE <= 131072, "spatial-gating LDS map");
__device__ __forceinline__ void sg_mfma(const Ctx& C, const Args& A) {
    const bf16_t* U = (const bf16_t*)(C.ws + WS_U); const bf16_t* GV = (const bf16_t*)(C.ws + WS_GV); bf16_t* CAT = (bf16_t*)(C.ws + WS_CAT);
    const bf16_t* WB = (const bf16_t*)(C.ws + WS_SGWB); const float* RS = (const float*)(C.ws + WS_SGRS);
    const float* lng = A.in[4]; const float* lnb = A.in[5]; const float* sgb = A.in[7];
    LAS float* stat = (LAS float*)C.lds;
    const int n = C.lane & 15, gl = C.lane >> 4;
    for (int unit = C.bid; unit < NB * 16 * 2; unit += C.G) {
        const int tb = (unit >> 1) * 128, g0 = (unit & 1) * 6;
        __syncthreads();
        for (int r4 = 0; r4 < 16; r4 += 4) {
            u32x2 w[4][3];
#pragma unroll
            for (int q = 0; q < 4; ++q)
#pragma unroll
                for (int j = 0; j < 3; ++j) w[q][j] = *(const u32x2*)(GV + (size_t)(tb + C.wave * 16 + r4 + q) * SGW + 4 * C.lane + 256 * j);
#pragma unroll
            for (int q = 0; q < 4; ++q) { float s = 0.f, ss = 0.f;
#pragma unroll
                for (int j = 0; j < 3; ++j) { const float a = bflo(w[q][j].x), b = bfhi(w[q][j].x), c = bflo(w[q][j].y), d = bfhi(w[q][j].y);
                    s += (a + b) + (c + d); ss += (a * a + b * b) + (c * c + d * d); }
                s = wave_sum_dpp(s); ss = wave_sum_dpp(ss);
                const float mean = s * (1.f / SGW), var = ss * (1.f / SGW) - mean * mean; const int row = C.wave * 16 + r4 + q;
                if (C.lane == 0) { stat[row * 2] = mean; stat[row * 2 + 1] = 1.0f / sqrtf(var + LN_EPS); } } }
        __syncthreads();
#pragma unroll
        for (int hf = 0; hf < 2; ++hf) {
            u32x4 w[6];
#pragma unroll
            for (int k = 0; k < 6; ++k) { const int rg = (hf * 6 + k) * 64 + (C.tid >> 3), gi = rg >> 7, row = rg & 127, c = C.tid & 7;
                w[k] = *(const u32x4*)(GV + (size_t)(tb + row) * SGW + (g0 + gi) * 64 + c * 8); }
#pragma unroll
            for (int k = 0; k < 6; ++k) { const int rg = (hf * 6 + k) * 64 + (C.tid >> 3), gi = rg >> 7, row = rg & 127, c = C.tid & 7;
                const float mean = stat[row * 2], rstd = stat[row * 2 + 1]; u32x4 o;
                o.x = cvt_pk_bf16((bflo(w[k].x) - mean) * rstd, (bfhi(w[k].x) - mean) * rstd); o.y = cvt_pk_bf16((bflo(w[k].y) - mean) * rstd, (bfhi(w[k].y) - mean) * rstd);
                o.z = cvt_pk_bf16((bflo(w[k].z) - mean) * rstd, (bfhi(w[k].z) - mean) * rstd); o.w = cvt_pk_bf16((bflo(w[k].w) - mean) * rstd, (bfhi(w[k].w) - mean) * rstd);
                *(LAS u32x4*)(C.lds + SG_GVN_OFF + gi * SG_TILE + row * SG_VS + c * 16) = o; }
        }
        __syncthreads();
        const int p = C.wave * 16 + n;
#pragma unroll 2
        for (int gi = 0; gi < 6; ++gi) {
            const int g = g0 + gi;
            const bf16_t* wp = WB + (size_t)(g * 128 + p) * 128 + 8 * gl;
            bf16x8 wf[4];
#pragma unroll
            for (int ks = 0; ks < 4; ++ks) wf[ks] = *(const bf16x8*)(wp + 32 * ks);
            u32x2 uw[4]; f32x4 ga[4], be[4];
#pragma unroll
            for (int db = 0; db < 4; ++db) { const size_t co = (size_t)g * 64 + 16 * db + 4 * gl;
                uw[db] = *(const u32x2*)(U + (size_t)(tb + p) * SGW + co); ga[db] = *(const f32x4*)(lng + co); be[db] = *(const f32x4*)(lnb + co); }
            const float bs = sgb[g * 128 + p], rsw = RS[g * 128 + p];
            f32x4 acc[4];
#pragma unroll
            for (int db = 0; db < 4; ++db) acc[db] = (f32x4){0.f, 0.f, 0.f, 0.f};
            const LAS unsigned char* vb = C.lds + SG_GVN_OFF + gi * SG_TILE + (8 * gl + (n >> 2)) * SG_VS + (n & 3) * 8;
#pragma unroll
            for (int ks = 0; ks < 4; ++ks)
#pragma unroll
                for (int db = 0; db < 4; ++db) {
                    const s16x4 v0 = __builtin_amdgcn_ds_read_tr16_b64_v4i16((LAS s16x4*)(vb + ks * 32 * SG_VS + db * 32));
                    const s16x4 v1 = __builtin_amdgcn_ds_read_tr16_b64_v4i16((LAS s16x4*)(vb + ks * 32 * SG_VS + 4 * SG_VS + db * 32));
                    const bf16x8 vf = __builtin_shufflevector(v0, v1, 0, 1, 2, 3, 4, 5, 6, 7);
                    acc[db] = __builtin_amdgcn_mfma_f32_16x16x32_bf16(vf, wf[ks], acc[db], 0, 0, 0);
                }
#pragma unroll
            for (int db = 0; db < 4; ++db) { const size_t co = (size_t)g * 64 + 16 * db + 4 * gl; const float cb = bs;
                const float s0 = ga[db][0] * acc[db][0] + (be[db][0] * rsw + cb), s1 = ga[db][1] * acc[db][1] + (be[db][1] * rsw + cb);
                const float s2 = ga[db][2] * acc[db][2] + (be[db][2] * rsw + cb), s3 = ga[db][3] * acc[db][3] + (be[db][3] * rsw + cb);
                *(u32x2*)(CAT + (size_t)(tb + p) * D + co) = (u32x2){cvt_pk_bf16(bflo(uw[db].x) * s0, bfhi(uw[db].x) * s1), cvt_pk_bf16(bflo(uw[db].y) * s2, bfhi(uw[db].y) * s3)}; }
        }
    }
}
__device__ __forceinline__ void dil_merge(const Ctx& C, const Args& A) {
    const bf16_t* OG = (const bf16_t*)(C.ws + WS_OG); const float* LSE = (const float*)(C.ws + WS_LSE); bf16_t* CAT2 = (bf16_t*)(C.ws + WS_CAT2);
    const int gt = C.bid * NTHREADS + C.tid, NT = C.G * NTHREADS;
    for (int it = gt; it < T * 32; it += NT) {
        const int tok = it >> 5, j = (it >> 3) & 3, c8 = it & 7;
        const float l0 = LSE[tok * 12 + j], l1 = LSE[tok * 12 + 4 + j], l2 = LSE[tok * 12 + 8 + j];
        const float mx = fmaxf(l0, fmaxf(l1, l2));
        float w0 = __expf(l0 - mx), w1 = __expf(l1 - mx), w2 = __expf(l2 - mx); const float inv = 1.0f / (w0 + w1 + w2); w0 *= inv; w1 *= inv; w2 *= inv;
        const u32x4 a = *(const u32x4*)(OG + (size_t)tok * SGW + j * 64 + c8 * 8), b = *(const u32x4*)(OG + (size_t)tok * SGW + (4 + j) * 64 + c8 * 8), c = *(const u32x4*)(OG + (size_t)tok * SGW + (8 + j) * 64 + c8 * 8);
        u32x4 o;
        o.x = pk2(w0 * bflo(a.x) + w1 * bflo(b.x) + w2 * bflo(c.x), w0 * bfhi(a.x) + w1 * bfhi(b.x) + w2 * bfhi(c.x));
        o.y = pk2(w0 * bflo(a.y) + w1 * bflo(b.y) + w2 * bflo(c.y), w0 * bfhi(a.y) + w1 * bfhi(b.y) + w2 * bfhi(c.y));
        o.z = pk2(w0 * bflo(a.z) + w1 * bflo(b.z) + w2 * bflo(c.z), w0 * bfhi(a.z) + w1 * bfhi(b.z) + w2 * bfhi(c.z));
        o.w = pk2(w0 * bflo(a.w) + w1 * bflo(b.w) + w2 * bflo(c.w), w0 * bfhi(a.w) + w1 * bfhi(b.w) + w2 * bfhi(c.w));
        *(u32x4*)(CAT2 + (size_t)tok * 512 + j * 64 + c8 * 8) = o;
    }
}

constexpr int LR_NT = 1;
__device__ __forceinline__ void ln_route(const Ctx& C, const Args& A, int layer, int cset) {
    const float* Y = (const float*)(C.ws + WS_Y); bf16_t* X1B = (bf16_t*)(C.ws + WS_X1B); unsigned char* X1F8 = C.ws + WS_X1F8;
    const float* lg = A.in[14] + layer * D; const float* lb = A.in[15] + layer * D; const float* wr = A.in[18]; const float* br = A.in[19];
    unsigned* cnt = (unsigned*)(C.ws + WS_CTL) + CW_CNT + cset * 16 * 64;
    int* tokE = (int*)(C.ws + WS_TOKE); int* tokP = (int*)(C.ws + WS_TOKP); float* tokG = (float*)(C.ws + WS_TOKG); int* list = (int*)(C.ws + WS_LIST);
    LAS float* wl = (LAS float*)C.lds;
    LAS int* sE = (LAS int*)(C.lds + 65536); LAS float* sG = (LAS float*)(C.lds + 65536 + 512); LAS int* sPos = (LAS int*)(C.lds + 65536 + 1024);
    LAS int* lcnt = (LAS int*)(C.lds + 65536 + 1536); LAS int* lbase = (LAS int*)(C.lds + 65536 + 1600); LAS float* slog = (LAS float*)(C.lds + 65536 + 2048);
    __syncthreads();
    for (int i = C.tid; i < 1024 * 16 / 4; i += NTHREADS) { const int row = i >> 2, e4 = i & 3, jj = row >> 8, ln = (row & 255) >> 2, cc = row & 3;
        *(LAS f32x4*)(wl + 4 * ((((jj * 4 + cc) * 4 + e4) << 6) + ln)) = *(const f32x4*)(wr + 4 * i); }
    const LAS float* wlane = wl + C.lane * 4;
    for (int blk = C.bid; blk < T / 64; blk += C.G) {
        __syncthreads();
        if (C.tid < 16) lcnt[C.tid] = 0;
#pragma unroll 1
        for (int tq = 0; tq < 8; tq += LR_NT) {
            const int tok0 = blk * 64 + C.wave * 8 + tq;
            f32x4 v[LR_NT][4];
#pragma unroll
            for (int t = 0; t < LR_NT; ++t) { const f32x4* yb = (const f32x4*)(Y + (size_t)(tok0 + t) * D) + C.lane;
#pragma unroll
                for (int j = 0; j < 4; ++j) v[t][j] = yb[64 * j]; }
            f32x4 g4[4], b4[4];
#pragma unroll
            for (int j = 0; j < 4; ++j) { g4[j] = *(const f32x4*)(lg + 4 * C.lane + 256 * j); b4[j] = *(const f32x4*)(lb + 4 * C.lane + 256 * j); }
            float lgt[LR_NT][16];
#pragma unroll
            for (int t = 0; t < LR_NT; ++t) {
                float s = 0.f;
#pragma unroll
                for (int j = 0; j < 4; ++j) s += (v[t][j][0] + v[t][j][1]) + (v[t][j][2] + v[t][j][3]);
                const float mean = wave_sum_dpp(s) * (1.f / D); float s2 = 0.f;
#pragma unroll
                for (int j = 0; j < 4; ++j) { v[t][j] = v[t][j] - mean; s2 += (v[t][j][0] * v[t][j][0] + v[t][j][1] * v[t][j][1]) + (v[t][j][2] * v[t][j][2] + v[t][j][3] * v[t][j][3]); }
                const float rstd = 1.0f / sqrtf(wave_sum_dpp(s2) * (1.f / D) + LN_EPS);
                u32x2* xb = (u32x2*)(X1B + (size_t)(tok0 + t) * D) + C.lane; unsigned* x8 = (unsigned*)(X1F8 + (size_t)(tok0 + t) * D) + C.lane;
#pragma unroll
                for (int j = 0; j < 4; ++j) {
                    v[t][j] = v[t][j] * rstd * g4[j] + b4[j];
                    xb[64 * j] = (u32x2){pk2(v[t][j][0], v[t][j][1]), pk2(v[t][j][2], v[t][j][3])};
                    x8[64 * j] = pk4_fp8(v[t][j][0], v[t][j][1], v[t][j][2], v[t][j][3]); }
#pragma unroll
                for (int e = 0; e < 16; ++e) lgt[t][e] = 0.f;
            }
#pragma unroll
            for (int j = 0; j < 4; ++j) {
#pragma unroll
                for (int c = 0; c < 4; ++c) {
                    if ((c & 1) == 0) asm volatile("" ::: "memory");
#pragma unroll
                    for (int e4 = 0; e4 < 4; ++e4) { const f32x4 w = *(const LAS f32x4*)(wlane + (((j * 4 + c) * 4 + e4) << 8));
#pragma unroll
                        for (int t = 0; t < LR_NT; ++t) { const float xv = v[t][j][c];
                            lgt[t][4 * e4] += xv * w[0]; lgt[t][4 * e4 + 1] += xv * w[1]; lgt[t][4 * e4 + 2] += xv * w[2]; lgt[t][4 * e4 + 3] += xv * w[3]; } } }
            }
#pragma unroll
            for (int t = 0; t < LR_NT; ++t) {
                const int tl = C.wave * 8 + tq + t;
                float tsel = 0.f;
#pragma unroll
                for (int e = 0; e < 16; ++e) { const float r = row_sum(lgt[t][e]); tsel = ((C.lane & 15) == e) ? r : tsel; }
                tsel += __shfl_xor(tsel, 16); tsel += __shfl_xor(tsel, 32);
                if (C.lane < 16) slog[tl * 17 + C.lane] = tsel;
            }
        }
        __syncthreads();
        if (C.tid < 64) {
            const int tl = C.tid;
            float pr[16]; float mx = -INFINITY;
#pragma unroll
            for (int e = 0; e < 16; ++e) { pr[e] = slog[tl * 17 + e]; mx = fmaxf(mx, pr[e]); }
            float sum = 0.f;
#pragma unroll
            for (int e = 0; e < 16; ++e) { pr[e] = __expf(pr[e] - mx); sum += pr[e]; }
            const float inv = 1.0f / sum; float sel[16];
#pragma unroll
            for (int e = 0; e < 16; ++e) { pr[e] *= inv; sel[e] = pr[e] + br[e]; }
            float gs[4];
#pragma unroll
            for (int g = 0; g < 4; ++g) { const float a = sel[4 * g], b = sel[4 * g + 1], c = sel[4 * g + 2], d = sel[4 * g + 3];
                gs[g] = fmaxf(fmaxf(fmaxf(a + b, a + c), fmaxf(a + d, b + c)), fmaxf(b + d, c + d)); }
            int gi = 0; float bsc = gs[0];
#pragma unroll
            for (int g = 1; g < 4; ++g) if (gs[g] > bsc) { bsc = gs[g]; gi = g; }
            float sg[4], pg[4];
#pragma unroll
            for (int k = 0; k < 4; ++k) { sg[k] = gi == 0 ? sel[k] : (gi == 1 ? sel[4 + k] : (gi == 2 ? sel[8 + k] : sel[12 + k])); pg[k] = gi == 0 ? pr[k] : (gi == 1 ? pr[4 + k] : (gi == 2 ? pr[8 + k] : pr[12 + k])); }
            int i1 = 0; float b1 = sg[0], p1 = pg[0];
#pragma unroll
            for (int k = 1; k < 4; ++k) if (sg[k] > b1) { b1 = sg[k]; i1 = k; p1 = pg[k]; }
            int i2 = -1; float b2 = -INFINITY, p2 = 0.f;
#pragma unroll
            for (int k = 0; k < 4; ++k) if (k != i1 && sg[k] > b2) { b2 = sg[k]; i2 = k; p2 = pg[k]; }
            const float gsum = p1 + p2; sE[tl * 2] = gi * 4 + i1; sE[tl * 2 + 1] = gi * 4 + i2; sG[tl * 2] = p1 / gsum; sG[tl * 2 + 1] = p2 / gsum;
        }
        __syncthreads();
        if (C.tid < 128) sPos[C.tid] = __hip_atomic_fetch_add(lcnt + sE[C.tid], 1, __ATOMIC_RELAXED, __HIP_MEMORY_SCOPE_WORKGROUP);
        __syncthreads();
        if (C.tid < 16) lbase[C.tid] = (int)__hip_atomic_fetch_add(cnt + C.tid * 64, (unsigned)lcnt[C.tid], __ATOMIC_RELAXED, __HIP_MEMORY_SCOPE_AGENT);
        __syncthreads();
        if (C.tid < 128) { const int e = sE[C.tid], pos = lbase[e] + sPos[C.tid], tok = blk * 64 + (C.tid >> 1);
            list[e * LISTCAP + pos] = tok; tokE[tok * 2 + (C.tid & 1)] = e; tokP[tok * 2 + (C.tid & 1)] = pos; tokG[tok * 2 + (C.tid & 1)] = sG[C.tid]; }
    }
}
__device__ __forceinline__ void moe_prefix(const Ctx& C, int layer) {
    LAS int* mi = (LAS int*)(C.lds + LDS_MISC);
    unsigned* cnt = (unsigned*)(C.ws + WS_CTL) + CW_CNT + layer * 16 * 64;
    __syncthreads();
    if (C.tid < 16) mi[17 + C.tid] = (int)__hip_atomic_load(cnt + C.tid * 64, __ATOMIC_RELAXED, __HIP_MEMORY_SCOPE_AGENT);
    __syncthreads();
    if (C.tid == 0) { int a = 0; for (int e = 0; e < 16; ++e) { mi[e] = a; a += (mi[17 + e] + 255) >> 8; } mi[16] = a; }
    __syncthreads();
}
__device__ __forceinline__ void moe_tokens(const Ctx& C, int ntn) {
    const LAS int* mi = (const LAS int*)(C.lds + LDS_MISC); LAS int* toks = (LAS int*)(C.lds + LDS_TOKS);
    const int* list = (const int*)(C.ws + WS_LIST);
    for (int u = 0; u < MAX_UNITS; ++u) {
        const int L = u * C.G + C.bid; if (L >= mi[16] * ntn) break;
        int e = 0;
#pragma unroll
        for (int j = 1; j < 16; ++j) e += (L >= mi[j] * ntn) ? 1 : 0;
        const int r = L - mi[e] * ntn, te = mi[e + 1] - mi[e], mt = r % te, cn = mi[17 + e];
        if (C.tid < 256) { int pos = mt * 256 + C.tid; pos = pos < cn ? pos : cn - 1; toks[u * 256 + C.tid] = list[e * LISTCAP + pos]; }
    }
    __syncthreads();
}
__device__ __forceinline__ void combine_ln2(const Ctx& C, const Args& A, int layer) {
    const LAS int* mi = (const LAS int*)(C.lds + LDS_MISC);
    const bf16_t* X1B = (const bf16_t*)(C.ws + WS_X1B); const bf16_t* YD = (const bf16_t*)(C.ws + WS_YD); bf16_t* X2B = (bf16_t*)(C.ws + WS_XB);
    const int* tokE = (const int*)(C.ws + WS_TOKE); const int* tokP = (const int*)(C.ws + WS_TOKP); const float* tokG = (const float*)(C.ws + WS_TOKG);
    const float* lg = A.in[16] + layer * D; const float* lb = A.in[17] + layer * D;
    for (int tok0 = C.gw * 8; tok0 < T; tok0 += C.NGW * 8) {
        int rowv = 0; float gv = 0.f;
        if (C.lane < 16) { const int e = tokE[tok0 * 2 + C.lane]; rowv = mi[e] * 256 + tokP[tok0 * 2 + C.lane]; gv = tokG[tok0 * 2 + C.lane]; }
#pragma unroll 1
        for (int tq = 0; tq < 8; tq += 2) {
            u32x2 xa[2][4], y0[2][4], y1[2][4]; float g0[2], g1[2];
#pragma unroll
            for (int t = 0; t < 2; ++t) {
                const int r0 = __builtin_amdgcn_readlane(rowv, 0), dummy = 0; (void)dummy; (void)r0;
                const int ra = __shfl(rowv, 2 * (tq + t)), rb = __shfl(rowv, 2 * (tq + t) + 1);
                g0[t] = __shfl(gv, 2 * (tq + t)); g1[t] = __shfl(gv, 2 * (tq + t) + 1);
                const u32x2* xp = (const u32x2*)(X1B + (size_t)(tok0 + tq + t) * D) + C.lane; const u32x2* pa = (const u32x2*)(YD + (size_t)ra * D) + C.lane; const u32x2* pb = (const u32x2*)(YD + (size_t)rb * D) + C.lane;
#pragma unroll
                for (int j = 0; j < 4; ++j) { xa[t][j] = xp[64 * j]; y0[t][j] = pa[64 * j]; y1[t][j] = pb[64 * j]; }
            }
#pragma unroll
            for (int t = 0; t < 2; ++t) {
                f32x4 v[4]; float s = 0.f;
#pragma unroll
                for (int j = 0; j < 4; ++j) {
                    v[j][0] = ALPHA * bflo(xa[t][j].x) + (g0[t] * bflo(y0[t][j].x) + g1[t] * bflo(y1[t][j].x)); v[j][1] = ALPHA * bfhi(xa[t][j].x) + (g0[t] * bfhi(y0[t][j].x) + g1[t] * bfhi(y1[t][j].x));
                    v[j][2] = ALPHA * bflo(xa[t][j].y) + (g0[t] * bflo(y0[t][j].y) + g1[t] * bflo(y1[t][j].y)); v[j][3] = ALPHA * bfhi(xa[t][j].y) + (g0[t] * bfhi(y0[t][j].y) + g1[t] * bfhi(y1[t][j].y));
                    s += (v[j][0] + v[j][1]) + (v[j][2] + v[j][3]); }
                const float mean = wave_sum_dpp(s) * (1.f / D); float s2 = 0.f;
#pragma unroll
                for (int j = 0; j < 4; ++j) { v[j] = v[j] - mean; s2 += (v[j][0] * v[j][0] + v[j][1] * v[j][1]) + (v[j][2] * v[j][2] + v[j][3] * v[j][3]); }
                const float rstd = 1.0f / sqrtf(wave_sum_dpp(s2) * (1.f / D) + LN_EPS);
                const int tok = tok0 + tq + t;
#pragma unroll
                for (int j = 0; j < 4; ++j) { const int col = 4 * C.lane + 256 * j; const f32x4 g4 = *(const f32x4*)(lg + col), b4 = *(const f32x4*)(lb + col);
                    const f32x4 o = v[j] * rstd * g4 + b4;
                    if (layer == 0) *(u32x2*)(X2B + (size_t)tok * D + col) = (u32x2){pk2(o[0], o[1]), pk2(o[2], o[3])};
                    else *(f32x4*)(A.out + (size_t)tok * D + col) = o; }
            }
        }
    }
}

__global__ void __launch_bounds__(NTHREADS, 2) yoco_fwd(Args args) {
    extern __shared__ __attribute__((aligned(16))) unsigned char lds_raw[];
    Ctx C;
    C.ws = args.ws; C.lds = (LAS unsigned char*)lds_raw;
    C.tid = threadIdx.x; C.lane = C.tid & 63; C.wave = __builtin_amdgcn_readfirstlane(C.tid >> 6);
    C.G = gridDim.x; C.bid = blockIdx.x; C.gw = C.bid * NWAVES + C.wave; C.NGW = C.G * NWAVES;
    unsigned char* ws = args.ws;
#define PHASE_WS() do { ws = launder(args.ws); C.ws = ws; C.tid = launder_v((int)threadIdx.x); C.lane = C.tid & 63; } while (0)
    volatile LAS unsigned* misc = (volatile LAS unsigned*)(C.lds + LDS_MISC);
    for (int u = C.tid; u < 64; u += NTHREADS) misc[u] = 0u;
    __syncthreads();
    XcdBarrier bar; bar.bar = (unsigned*)(ws + WS_CTL) + CW_BAR; bar.x = 0; bar.st = misc + 60;
    const int lo = args.ph_lo, hi = args.ph_hi;
    if (hi - lo > 1) bar = xcd_barrier_post((unsigned*)(ws + WS_CTL) + CW_BAR, misc + 60);
#define IN(k) (lo <= (k) && (k) < hi)
#define SEAMF(k) do { if (IN(k) && IN((k) + 1)) { PHASE_WS(); fill_tail(C, args, (k), false); xcd_barrier(bar); } } while (0)
#if MK_DIAG == 9
#define SEAM(k) do { if (IN(k) && IN((k) + 1)) { const unsigned long long t0_ = __builtin_amdgcn_s_memrealtime(); xcd_barrier(bar); if (((MK_DIAGMASK >> (k)) & 1) && threadIdx.x == 0) diag_acc += (unsigned)(__builtin_amdgcn_s_memrealtime() - t0_); } } while (0)
#else
#define SEAM(k) do { if (IN(k) && IN((k) + 1)) xcd_barrier(bar); } while (0)
#endif
#ifndef MK_DUP
#define MK_DUP 0
#endif
    unsigned diag_acc = 0;
#if MK_DIAG == 10
#define TREG(id, ...) do { __syncthreads(); const unsigned long long t0_ = __builtin_amdgcn_s_memrealtime(); __VA_ARGS__; __syncthreads(); if ((id) == MK_DIAGSEL) diag_acc += (unsigned)(__builtin_amdgcn_s_memrealtime() - t0_); } while (0)
#else
#define TREG(id, ...) do { __VA_ARGS__; } while (0)
#endif
#define REP(k) for (int rep_ = 0; rep_ < 1 + ((MK_DUP >> (k)) & 1); ++rep_)

    if (IN(0)) { REP(0) { PHASE_WS(); TREG(10, p0_prologue(C, args)); } SEAM(0); }

    if (IN(1)) {
        REP(1) {
        PHASE_WS();
        { pg8::Gemm g{(const bf16_t*)(ws + WS_XB), (const bf16_t*)(ws + WS_BT_INA), T, 1792, D}; pg8::StaticOrder S; S.init(T, 1792, C.G, C.bid);
          EpiProjA E{(bf16_t*)(ws + WS_U), (bf16_t*)(ws + WS_GV), (bf16_t*)(ws + WS_QM0)};
          pg8::gemm_phase<EpiProjA, pg8::StaticOrder>(C.lds, g, S, E, nullptr, C.tid); }
        { pg8::Gemm g{(const bf16_t*)(ws + WS_MEMB), (const bf16_t*)(ws + WS_BT_MEM), NB * NMEM, 1024, D}; SmallOrder S{4, 32, C.bid - (C.G - 32)};
          EpiPlain E{(bf16_t*)(ws + WS_MKV), 1024, 4};
          pg8::gemm_phase<EpiPlain, SmallOrder>(C.lds, g, S, E, nullptr, C.tid); }
        }
        SEAMF(1);
    }
    if (IN(2)) {
        REP(2) { PHASE_WS();
        TREG(1, sg_mfma(C, args));
        TREG(2, memattn_mfma(C, (const bf16_t*)(ws + WS_QM0), (const bf16_t*)(ws + WS_MKV), 0, 256, (bf16_t*)(ws + WS_CAT), D, SGW)); }
        SEAM(2);
    }
    if (IN(3)) {
        REP(3) { PHASE_WS();
        pg8::Gemm g{(const bf16_t*)(ws + WS_CAT), (const bf16_t*)(ws + WS_BT_OUTA), T, D, D}; pg8::StaticOrder S; S.init(T, D, C.G, C.bid);
        EpiResid<false> E{(const void*)args.in[0], (float*)(ws + WS_Y)};
        pg8::gemm_phase<EpiResid<false>, pg8::StaticOrder>(C.lds, g, S, E, nullptr, C.tid); }
        SEAM(3);
    }
    { constexpr int layer = 0;
        const int pb = 4 + 8 * layer;
        if (IN(pb)) { if ((MK_DUP >> 4) & 1) { PHASE_WS(); ln_route(C, args, layer, 2 + layer); __syncthreads(); } PHASE_WS(); TREG(6 + layer, ln_route(C, args, layer, layer)); SEAM(pb); }
        if (IN(pb + 1)) {
            REP(5) { PHASE_WS();
            moe_prefix(C, layer); moe_tokens(C, 8);
            MoeGatherOrder S; S.tb = (const LAS int*)(C.lds + LDS_MISC); S.ntn = 8; S.G = C.G; S.c = C.bid; S.toks = (const LAS int*)(C.lds + LDS_TOKS);
            {
                pg8::Gemm g{(const bf16_t*)(ws + WS_X1F8), (const bf16_t*)(ws + WS_WGU + (size_t)layer * (64 * MiB)), 0, 0, D / 2, E8_ONE, E8_W};
                EpiSwiGLU8 E{ws + WS_ACT};
                pg8::gemm_phase<EpiSwiGLU8, MoeGatherOrder, false, true>(C.lds, g, S, E, nullptr, C.tid);
            } }
            SEAMF(pb + 1);
        }
        if (IN(pb + 2)) {
            REP(6) { PHASE_WS();
            moe_prefix(C, layer);
            MoeOrder S{(const LAS int*)(C.lds + LDS_MISC), 4, C.G, C.bid};
            EpiPlain E{(bf16_t*)(ws + WS_YD), 1024, 4};
            {
                pg8::Gemm g{(const bf16_t*)(ws + WS_ACT), (const bf16_t*)(ws + WS_WD + (size_t)layer * (32 * MiB)), 0, 0, D / 2, E8_ACT, E8_W};
                pg8::gemm_phase<EpiPlain, MoeOrder, false, true>(C.lds, g, S, E, nullptr, C.tid);
            } }
            SEAMF(pb + 2);
        }
        if (IN(pb + 3)) { REP(7) { PHASE_WS(); moe_prefix(C, layer); TREG(8 + layer, combine_ln2(C, args, layer)); } if (layer == 0) SEAM(pb + 3); }
    }
    {
            if (IN(8)) {
                REP(8) { PHASE_WS();
                pg8::Gemm g{(const bf16_t*)(ws + WS_XB), (const bf16_t*)(ws + WS_BT_B), T, 2560, D}; pg8::StaticOrder S; S.init(T, 2560, C.G, C.bid);
                EpiProjB E{(bf16_t*)(ws + WS_K), (bf16_t*)(ws + WS_V), (bf16_t*)(ws + WS_Q), (bf16_t*)(ws + WS_QM1)};
                pg8::gemm_phase<EpiProjB, pg8::StaticOrder>(C.lds, g, S, E, nullptr, C.tid); }
                SEAMF(8);
            }
            if (IN(9)) {
                REP(9) { PHASE_WS();
                TREG(3, dilattn_mfma(C));
                TREG(4, memattn_mfma(C, (const bf16_t*)(ws + WS_QM1), (const bf16_t*)(ws + WS_MKV), 512, 768, (bf16_t*)(ws + WS_CAT2), 512, 256)); }
                SEAM(9);
            }
            if (IN(10)) { REP(10) { PHASE_WS(); TREG(5, dil_merge(C, args)); } SEAM(10); }
            if (IN(11)) {
                REP(11) { PHASE_WS();
                pg8::Gemm g{(const bf16_t*)(ws + WS_CAT2), (const bf16_t*)(ws + WS_BT_OUTB), T, D, 512}; pg8::StaticOrder S; S.init(T, D, C.G, C.bid);
                EpiResid<true> E{(const void*)(ws + WS_XB), (float*)(ws + WS_Y)};
                pg8::gemm_phase<EpiResid<true>, pg8::StaticOrder>(C.lds, g, S, E, nullptr, C.tid); }
                if (IN(11)) { PHASE_WS(); fill_tail(C, args, 11, true); }
                SEAM(11);
            }
    }
    { constexpr int layer = 1;
        const int pb = 4 + 8 * layer;
        if (IN(pb)) { if ((MK_DUP >> 4) & 1) { PHASE_WS(); ln_route(C, args, layer, 2 + layer); __syncthreads(); } PHASE_WS(); TREG(6 + layer, ln_route(C, args, layer, layer)); SEAM(pb); }
        if (IN(pb + 1)) {
            REP(5) { PHASE_WS();
            moe_prefix(C, layer); moe_tokens(C, 8);
            MoeGatherOrder S; S.tb = (const LAS int*)(C.lds + LDS_MISC); S.ntn = 8; S.G = C.G; S.c = C.bid; S.toks = (const LAS int*)(C.lds + LDS_TOKS);
            {
                pg8::Gemm g{(const bf16_t*)(ws + WS_X1F8), (const bf16_t*)(ws + WS_WGU + (size_t)layer * (64 * MiB)), 0, 0, D / 2, E8_ONE, E8_W};
                EpiSwiGLU8 E{ws + WS_ACT};
                pg8::gemm_phase<EpiSwiGLU8, MoeGatherOrder, false, true>(C.lds, g, S, E, nullptr, C.tid);
            } }
            SEAM(pb + 1);
        }
        if (IN(pb + 2)) {
            REP(6) { PHASE_WS();
            moe_prefix(C, layer);
            MoeOrder S{(const LAS int*)(C.lds + LDS_MISC), 4, C.G, C.bid};
            EpiPlain E{(bf16_t*)(ws + WS_YD), 1024, 4};
            {
                pg8::Gemm g{(const bf16_t*)(ws + WS_ACT), (const bf16_t*)(ws + WS_WD + (size_t)layer * (32 * MiB)), 0, 0, D / 2, E8_ACT, E8_W};
                pg8::gemm_phase<EpiPlain, MoeOrder, false, true>(C.lds, g, S, E, nullptr, C.tid);
            } }
            SEAM(pb + 2);
        }
        if (IN(pb + 3)) { REP(7) { PHASE_WS(); moe_prefix(C, layer); TREG(8 + layer, combine_ln2(C, args, layer)); } if (layer == 0) SEAM(pb + 3); }
    }
#if MK_DIAG == 3
    xcd_barrier(bar);
    if (blockIdx.x == 0 && threadIdx.x == 0) { const unsigned got = __hip_atomic_fetch_add((unsigned*)(args.ws + WS_CTL) + 30000, 0u, __ATOMIC_RELAXED, __HIP_MEMORY_SCOPE_AGENT); const unsigned long long t0 = __builtin_amdgcn_s_memrealtime();
        const unsigned long long dur = (unsigned long long)got * 4ull;
        while (__builtin_amdgcn_s_memrealtime() - t0 < dur) __builtin_amdgcn_s_sleep(8); }
#endif
#if MK_DIAG == 11
    if (blockIdx.x == 0 && threadIdx.x == 0) { const unsigned long long t0 = __builtin_amdgcn_s_memrealtime(); const unsigned long long dur = (unsigned long long)misc[42] * 4ull;
        while (__builtin_amdgcn_s_memrealtime() - t0 < dur) __builtin_amdgcn_s_sleep(8); }
#endif
#if MK_DIAG == 10
    if (blockIdx.x == 0 && threadIdx.x == 0) { const unsigned long long t0 = __builtin_amdgcn_s_memrealtime(); const unsigned long long dur = (unsigned long long)diag_acc * 4ull;
        while (__builtin_amdgcn_s_memrealtime() - t0 < dur) __builtin_amdgcn_s_sleep(8); }
#endif
#if MK_DIAG == 9
    if (threadIdx.x == 0) __hip_atomic_fetch_add((unsigned*)(args.ws + WS_CTL) + 30000, diag_acc, __ATOMIC_RELAXED, __HIP_MEMORY_SCOPE_AGENT);
    xcd_barrier(bar);
    if (blockIdx.x == 0 && threadIdx.x == 0) { const unsigned got = __hip_atomic_fetch_add((unsigned*)(args.ws + WS_CTL) + 30000, 0u, __ATOMIC_RELAXED, __HIP_MEMORY_SCOPE_AGENT); const unsigned long long t0 = __builtin_amdgcn_s_memrealtime();
        const unsigned long long dur = (unsigned long long)got / 256ull;
        while (__builtin_amdgcn_s_memrealtime() - t0 < dur) __builtin_amdgcn_s_sleep(8); }
#endif
#undef IN
#undef SEAM
}
}

extern "C" void kernel_launch(void* const* d_in, const int* in_sizes, int n_in, void* d_out, int out_size, void* d_ws, size_t ws_size, hipStream_t stream) {
    using namespace mk;
    static int grid = 0;
    if (grid == 0) {
        if (n_in != 23 || out_size != T * D || ws_size < WS_END) { fprintf(stderr, "kernel_launch: unexpected shapes (n_in %d, out %d, ws %zu)\n", n_in, out_size, ws_size); grid = -1; return; }
        int dev = 0, cus = 0, per_cu = 0;
        if (hipGetDevice(&dev) != hipSuccess || hipDeviceGetAttribute(&cus, hipDeviceAttributeMultiprocessorCount, dev) != hipSuccess) { grid = -1; return; }
        if (hipFuncSetAttribute((const void*)yoco_fwd, hipFuncAttributeMaxDynamicSharedMemorySize, LDS_BYTES) != hipSuccess) { fprintf(stderr, "kernel_launch: hipFuncSetAttribute failed\n"); grid = -1; return; }
        if (hipOccupancyMaxActiveBlocksPerMultiprocessor(&per_cu, (const void*)yoco_fwd, NTHREADS, LDS_BYTES) != hipSuccess || per_cu < 1)
            fprintf(stderr, "kernel_launch: occupancy query reports %d workgroups per CU\n", per_cu);
        (void)hipGetLastError();
        grid = cus;
    }
    if (grid < 0) return;
    (void)hipMemsetAsync((char*)d_ws + WS_CTL, 0, CTL_ZERO_BYTES, stream);
    Args a{};
    for (int i = 0; i < 23; ++i) a.in[i] = (const float*)d_in[i];
    a.out = (float*)d_out; a.ws = (unsigned char*)d_ws;
    constexpr int NL = MK_N_LAUNCHES;
    for (int li = 0; li < NL; ++li) {
        a.ph_lo = (NL == NPHASE) ? li : (li * NPHASE) / NL; a.ph_hi = (NL == NPHASE) ? li + 1 : ((li + 1) * NPHASE) / NL;
        hipLaunchKernelGGL(yoco_fwd, dim3(grid), dim3(NTHREADS), LDS_BYTES, stream, a);
    }
}
```

```cpp
#include <hip/hip_runtime.h>
#include <cstdio>
#include <cstdint>
namespace pg8 {
#define PG8_LAS __attribute__((address_space(3)))
typedef unsigned short bf16_t;
typedef short bf16x8 __attribute__((ext_vector_type(8)));
typedef float f32x4 __attribute__((ext_vector_type(4)));
typedef unsigned u32x4 __attribute__((ext_vector_type(4)));
constexpr int BM = 256, BK = 64, HALF = 128, HTB = HALF * BK * 2  , STAGE_BYTES = 8 * HTB, NXCD = 8, WGM = 8;

__host__ __device__ __forceinline__ int lds_byte(int r, int c) { const int st = (r >> 4) * 2 + (c >> 5), rr = r & 15, cc = c & 31, ob = rr * 64 + cc * 2; return st * 1024 + (ob ^ (((ob >> 9) & 1) << 5)); }
__host__ __device__ __forceinline__ void stage_rc(int b, int& R, int& C) { const int st = b / 1024, sb = b % 1024, swz = sb ^ (((sb >> 9) & 1) << 5); R = (st >> 1) * 16 + swz / 64; C = (st & 1) * 32 + (swz % 64) / 2; }
__host__ __device__ __forceinline__ int perm32(int rho) { const int n = rho >> 4, i = rho & 15; return 8 * (i >> 2) + 4 * n + (i & 3); }

struct Unit { int pm, pn; };
struct Gemm { const bf16_t* A; const bf16_t* Bt; int M, N, K; int sA, sB; };

struct StaticOrder {
    int nM, nN, nwg, G, c;
    __host__ __device__ void init(int M, int N, int G_, int c_) { nM = M / BM; nN = N / BM; nwg = nM * nN; G = G_; c = c_; }
    __host__ __device__ bool next(int i, Unit& u) const {
        const long L = (long)i * G + c; if (L >= nwg) return false;
        int wgid = (int)L; { const int q = nwg / NXCD, r = nwg % NXCD, xcd = wgid % NXCD, off = wgid / NXCD; wgid = (xcd < r ? xcd * (q + 1) : r * (q + 1) + (xcd - r) * q) + off; }
        const int nig = WGM * nN, gid = wgid / nig, fm = gid * WGM, gsz = (nM - fm) < WGM ? (nM - fm) : WGM;
        u.pm = fm + ((wgid % nig) % gsz); u.pn = (wgid % nig) / gsz; return true;
    }
    __device__ __forceinline__ void a_ready(const Unit&) const {}
    __device__ __forceinline__ void done(const Unit&) const {}
    __device__ __forceinline__ int arow(int, const Unit& u, int r) const { return u.pm * BM + r; }
};
__device__ __forceinline__ unsigned cvt_pk_bf16(float lo, float hi) { unsigned r; asm volatile("v_cvt_pk_bf16_f32 %0, %1, %2" : "=v"(r) : "v"(lo), "v"(hi)); return r; }
typedef float f32x2 __attribute__((ext_vector_type(2)));
__device__ __forceinline__ f32x2 gelu_pk(f32x2 v) {
    const f32x2 av = __builtin_elementwise_abs(v), d = av * 0.2316418882f + 1.0f;
    f32x2 t; t.x = __builtin_amdgcn_rcpf(d.x); t.y = __builtin_amdgcn_rcpf(d.y);
    f32x2 q = t * 0.5307027145f + (-0.7265760135f); q = q * t + 0.7107068705f; q = q * t + (-0.142248368f); q = q * t + 0.127414796f; q = q * t;
    const f32x2 s = (v * v) * (-0.72134752044f);
    f32x2 e; e.x = __builtin_amdgcn_exp2f(s.x); e.y = __builtin_amdgcn_exp2f(s.y);
    const f32x2 m = v * (q * e), r = v - m;
    f32x2 o; o.x = v.x < 0.f ? m.x : r.x; o.y = v.y < 0.f ? m.y : r.y; return o;
}
template <class Epi, class Sched, bool STAMP = false, bool F8 = false>
__device__ __forceinline__ void gemm_phase(PG8_LAS unsigned char* lds, const Gemm g, const Sched& S, const Epi& E, unsigned long long* stamps, const int tid) {
    const int wid = __builtin_amdgcn_readfirstlane(tid >> 6), lane = tid & 63, wr = wid >> 2, wc = wid & 3, fr = lane & 15, fq = lane >> 4;
    const int K = g.K, nt = K / BK;
    int ts_lo = 0, ts_hi = 0, nts = 0; const unsigned long long rt_entry = STAMP ? (unsigned long long)wall_clock64() : 0ull;
#define PG8_STAMP() do { if (STAMP && wid == 0 && nts < 64) { const unsigned long long _c = (unsigned long long)clock64(); \
        ts_lo = (lane == nts) ? (int)(unsigned)_c : ts_lo; ts_hi = (lane == nts) ? (int)(unsigned)(_c >> 32) : ts_hi; ++nts; } } while (0)
    PG8_STAMP();
    unsigned colA[2], voffB[2]; int rowA[2];
#pragma unroll
    for (int i = 0; i < 2; ++i) { int R, C; stage_rc(tid * 16 + i * 8192, R, C); const int Rb = Epi::PERM ? ((R & ~31) + perm32(R & 31)) : R;
        rowA[i] = R; colA[i] = (unsigned)C * 2u; voffB[i] = (unsigned)(Rb * K + C) * 2u; }
#define PG8_AOFF(dst, uidx, un) do { _Pragma("unroll") for (int _h = 0; _h < 2; ++_h) _Pragma("unroll") for (int _i = 0; _i < 2; ++_i) \
        dst[_h][_i] = (unsigned)S.arow((uidx), (un), _h * HALF + rowA[_i]) * (unsigned)(K * 2) + colA[_i]; } while (0)
    const size_t kstep = (size_t)(BK * 2);
    const size_t hstep = (size_t)HALF * K * 2;
    const size_t tstep = 2 * hstep;
    const unsigned ldsw = (unsigned)wid * 1024u;
    const int aoff = F8 ? lds_byte(wr * 64 + fr, fq * 16) : lds_byte(wr * 64 + fr, fq * 8), boff = F8 ? lds_byte(wc * 32 + fr, fq * 16) : lds_byte(wc * 32 + fr, fq * 8);
    constexpr int KOFF = F8 ? 16 : 1024;
#define PG8_SA(b, h) (((b) * 2 + (h)) * HTB)
#define PG8_SB(b, h) ((4 + (b) * 2 + (h)) * HTB)
#define PG8_STAGE(bufoff, gbase, voff) do { _Pragma("unroll") for (int _i = 0; _i < 2; ++_i) \
        __builtin_amdgcn_global_load_lds((const unsigned*)((const char*)(gbase) + (voff)[_i]), (PG8_LAS unsigned*)(lds + (bufoff) + ldsw + _i * 8192), 16, 0, 0); } while (0)
#define PG8_LDA(dst, b, h) do { _Pragma("unroll") for (int m = 0; m < 4; ++m) _Pragma("unroll") for (int k = 0; k < 2; ++k) dst[m][k] = *(const PG8_LAS bf16x8*)(lds + PG8_SA(b, h) + aoff + m * 2048 + k * KOFF); } while (0)
#define PG8_LDB(dst, b, h) do { _Pragma("unroll") for (int n = 0; n < 2; ++n) _Pragma("unroll") for (int k = 0; k < 2; ++k) dst[n][k] = *(const PG8_LAS bf16x8*)(lds + PG8_SB(b, h) + boff + n * 2048 + k * KOFF); } while (0)
#define PG8_MMA(ai, bj, At, Bt) do { __builtin_amdgcn_s_setprio(1); \
        if constexpr (F8) { _Pragma("unroll") for (int m = 0; m < 4; ++m) _Pragma("unroll") for (int n = 0; n < 2; ++n) { \
            typedef int i32x4_ __attribute__((ext_vector_type(4))); typedef int i32x8_ __attribute__((ext_vector_type(8))); \
            const i32x8_ b8_ = __builtin_shufflevector(__builtin_bit_cast(i32x4_, Bt[n][0]), __builtin_bit_cast(i32x4_, Bt[n][1]), 0, 1, 2, 3, 4, 5, 6, 7); \
            const i32x8_ a8_ = __builtin_shufflevector(__builtin_bit_cast(i32x4_, At[m][0]), __builtin_bit_cast(i32x4_, At[m][1]), 0, 1, 2, 3, 4, 5, 6, 7); \
            acc[ai][bj][m][n] = __builtin_amdgcn_mfma_scale_f32_16x16x128_f8f6f4(b8_, a8_, acc[ai][bj][m][n], 0, 0, 0, g.sB, 0, g.sA); } } \
        else { _Pragma("unroll") for (int m = 0; m < 4; ++m) _Pragma("unroll") for (int n = 0; n < 2; ++n) _Pragma("unroll") for (int k = 0; k < 2; ++k) \
            acc[ai][bj][m][n] = __builtin_amdgcn_mfma_f32_16x16x32_bf16(Bt[n][k], At[m][k], acc[ai][bj][m][n], 0, 0, 0); } \
        __builtin_amdgcn_s_setprio(0); } while (0)
#define PG8_WAIT_V(n) asm volatile("s_waitcnt vmcnt(" #n ")" ::: "memory")
#define PG8_WAIT_L(n) asm volatile("s_waitcnt lgkmcnt(" #n ")" ::: "memory")
#define PG8_BAR __builtin_amdgcn_s_barrier()
#define PG8_SCHED __builtin_amdgcn_sched_barrier(0)
    Unit cur, nxt; int ui = 0;
    if (!S.next(0, cur)) return;
    f32x4 acc[2][2][4][2];
#pragma unroll
    for (int a = 0; a < 2; ++a)
#pragma unroll
        for (int b = 0; b < 2; ++b)
#pragma unroll
            for (int m = 0; m < 4; ++m)
#pragma unroll
                for (int n = 0; n < 2; ++n) acc[a][b][m][n] = (f32x4){0.f, 0.f, 0.f, 0.f};
    bf16x8 At[4][2], B0[2][2], B1[2][2];
    const char* Ab = (const char*)g.A; const char* cB = (const char*)g.Bt + (size_t)cur.pn * tstep;
    unsigned cuA[2][2];
    S.a_ready(cur);
    PG8_AOFF(cuA, 0, cur);
    PG8_STAGE(PG8_SB(0, 0), cB, voffB); PG8_STAGE(PG8_SA(0, 0), Ab, cuA[0]); PG8_STAGE(PG8_SB(0, 1), cB + hstep, voffB); PG8_STAGE(PG8_SA(0, 1), Ab, cuA[1]);
    if (wr == 1) PG8_BAR;
    PG8_WAIT_V(4); PG8_BAR;
    PG8_STAGE(PG8_SB(1, 0), cB + kstep, voffB); PG8_STAGE(PG8_SA(1, 0), Ab + kstep, cuA[0]); PG8_STAGE(PG8_SB(1, 1), cB + hstep + kstep, voffB);
    PG8_WAIT_V(6); PG8_BAR;
    PG8_STAMP();
    for (;;) {
        const bool has_next = S.next(ui + 1, nxt);
        const char* nB = has_next ? (const char*)g.Bt + (size_t)nxt.pn * tstep : cB;
        for (int t = 0; t < nt; t += 2) {
            const bool last = (t == nt - 2);
            const char* a1 = Ab + (size_t)(t + 1) * kstep;
            const char* a2 = last ? Ab : Ab + (size_t)(t + 2) * kstep; const char* b2 = last ? nB : cB + (size_t)(t + 2) * kstep;
            const char* a3 = a2 + kstep; const char* b3 = b2 + kstep;

            if (last && has_next) S.a_ready(nxt);
            PG8_LDB(B0, 0, 0); PG8_SCHED; PG8_LDA(At, 0, 0); PG8_STAGE(PG8_SA(1, 1), a1, cuA[1]);
            PG8_WAIT_L(8); PG8_BAR; PG8_WAIT_L(0); PG8_MMA(0, 0, At, B0); PG8_BAR; PG8_SCHED;
            if (last && has_next) PG8_AOFF(cuA, ui + 1, nxt);
            PG8_LDB(B1, 0, 1); PG8_STAGE(PG8_SB(0, 0), b2, voffB);
            PG8_BAR; PG8_WAIT_L(0); PG8_MMA(0, 1, At, B1); PG8_BAR;
            PG8_LDA(At, 0, 1); PG8_STAGE(PG8_SA(0, 0), a2, cuA[0]);
            PG8_BAR; PG8_WAIT_L(0); PG8_MMA(1, 0, At, B0); PG8_BAR; PG8_SCHED;
            PG8_STAGE(PG8_SB(0, 1), b2 + hstep, voffB);
            PG8_WAIT_V(6); PG8_BAR; PG8_MMA(1, 1, At, B1); PG8_BAR;
            PG8_LDB(B0, 1, 0); PG8_SCHED; PG8_LDA(At, 1, 0); PG8_STAGE(PG8_SA(0, 1), a2, cuA[1]);
            PG8_WAIT_L(8); PG8_BAR; PG8_WAIT_L(0); PG8_MMA(0, 0, At, B0); PG8_BAR; PG8_SCHED;
            PG8_LDB(B1, 1, 1); PG8_STAGE(PG8_SB(1, 0), b3, voffB);
            PG8_BAR; PG8_WAIT_L(0); PG8_MMA(0, 1, At, B1); PG8_BAR;
            PG8_LDA(At, 1, 1); PG8_STAGE(PG8_SA(1, 0), a3, cuA[0]);
            PG8_BAR; PG8_WAIT_L(0); PG8_MMA(1, 0, At, B0); PG8_BAR; PG8_SCHED;
            PG8_STAGE(PG8_SB(1, 1), b3 + hstep, voffB);
            PG8_WAIT_V(6); PG8_BAR; PG8_MMA(1, 1, At, B1); PG8_BAR;
        }
        PG8_STAMP();
        if constexpr (!Epi::AFTER_DRAIN) { E(acc, cur, wr, wc, fr, fq); S.done(cur); }
        PG8_STAMP();
        if (!has_next) break;
#pragma unroll
        for (int a = 0; a < 2; ++a)
#pragma unroll
            for (int b = 0; b < 2; ++b)
#pragma unroll
                for (int m = 0; m < 4; ++m)
#pragma unroll
                    for (int n = 0; n < 2; ++n) acc[a][b][m][n] = (f32x4){0.f, 0.f, 0.f, 0.f};
        cur = nxt; cB = nB; ++ui;
    }
    PG8_WAIT_V(0);
    if (wr == 0) PG8_BAR;
    PG8_BAR;
    if constexpr (Epi::AFTER_DRAIN) { E.fused(acc, cur, wr, wc, fr, fq, lds, wid, lane); S.done(cur); }
    PG8_STAMP();
    if (STAMP && wid == 0) { stamps[lane] = lane < nts ? (((unsigned long long)(unsigned)ts_hi << 32) | (unsigned)ts_lo) : 0ull;
        if (lane == 62) stamps[62] = rt_entry; if (lane == 63) stamps[63] = (unsigned long long)wall_clock64(); }
#undef PG8_STAMP
#undef PG8_SA
#undef PG8_SB
#undef PG8_STAGE
#undef PG8_AOFF
#undef PG8_LDA
#undef PG8_LDB
#undef PG8_MMA
#undef PG8_WAIT_V
#undef PG8_WAIT_L
#undef PG8_BAR
#undef PG8_SCHED
}
}

namespace mk {
using pg8::bf16_t; using pg8::f32x4; using pg8::u32x4; using pg8::Unit; using pg8::cvt_pk_bf16;
#define LAS __attribute__((address_space(3)))
typedef float f32x2 __attribute__((ext_vector_type(2)));
typedef unsigned u32x2 __attribute__((ext_vector_type(2)));

#ifndef MK_DIAG
#define MK_DIAG 0
#endif
#ifndef MK_DIAGSEL
#define MK_DIAGSEL 0
#endif
#ifndef MK_DIAGMASK
#define MK_DIAGMASK 0xFFFF
#endif
#ifndef MK_N_LAUNCHES
#define MK_N_LAUNCHES 1
#endif
constexpr int NPHASE = 16;
constexpr int NB = 8, SEQ = 2048, D = 1024, T = NB * SEQ, NMEM = 256, SGW = 768, NSG = 12, HD = 64, CH = 128;
constexpr int NEXP = 16, LISTCAP = 16384;
constexpr float ALPHA = 1.41421356237f;
constexpr float LN_EPS = 1e-5f, ATT_SCALE = 0.125f;
constexpr int NWAVES = 8, NTHREADS = 512;

constexpr size_t MiB = 1u << 20;
constexpr size_t WS_CTL = 0, CTL_ZERO_BYTES = 1 * MiB;
constexpr size_t WS_TOKE = 1 * MiB, WS_TOKP = WS_TOKE + 128 * 1024, WS_TOKG = WS_TOKP + 128 * 1024;
constexpr size_t WS_LIST = 2 * MiB, WS_LSE = 3 * MiB, WS_SGWB = 4 * MiB, WS_SGRS = 4 * MiB + 512 * 1024, WS_WRT = 4 * MiB + 768 * 1024;
constexpr size_t WS_MKV = 8 * MiB, WS_MEMB = 12 * MiB;
constexpr size_t WS_BT_INA = 18 * MiB, WS_BT_OUTA = 22 * MiB, WS_BT_B = 24 * MiB, WS_BT_OUTB = 29 * MiB, WS_BT_MEM = 30 * MiB;
constexpr size_t WS_WGU = 32 * MiB, WS_WD = 160 * MiB;
constexpr size_t WS_A = 224 * MiB;
constexpr size_t WS_U = WS_A, WS_GV = WS_A + 24 * MiB, WS_QM0 = WS_A + 48 * MiB;
constexpr size_t WS_K = WS_A, WS_V = WS_A + 24 * MiB, WS_Q = WS_A + 48 * MiB, WS_QM1 = WS_A + 72 * MiB;
constexpr size_t WS_ACT = WS_A;
constexpr size_t WS_XB = 304 * MiB;
constexpr size_t WS_C = 336 * MiB;
constexpr size_t WS_CAT = WS_C, WS_OG = WS_C, WS_CAT2 = WS_C + 24 * MiB;
constexpr size_t WS_Y = 376 * MiB;
constexpr size_t WS_YD = 336 * MiB;
constexpr size_t WS_X1B = 440 * MiB;
constexpr size_t WS_X1F8 = 472 * MiB;
constexpr size_t WS_END = 488 * MiB;
constexpr size_t WS_WGU8 = WS_WGU + 64 * MiB, WS_WD8 = WS_WD + 32 * MiB;
constexpr int CW_TMO = 0, CW_BAR = 4096, CW_CNT = 16384, CW_CONV = 24576, CW_DONE = 24640, CW_CONV0 = 26000;
constexpr int LDS_TOKS = 131072 + 1024, MAX_UNITS = 8;
constexpr int LDS_MISC = 131072;
constexpr int LDS_BYTES = 147456;
static_assert(LDS_TOKS + MAX_UNITS * 1024 <= LDS_BYTES, "LDS map");

#define LDS_WAIT() asm volatile("s_waitcnt lgkmcnt(0)" ::: "memory")
#define VM_WAIT() asm volatile("s_waitcnt vmcnt(0)" ::: "memory")
__device__ __forceinline__ unsigned f2bf(float f) { unsigned u = __builtin_bit_cast(unsigned, f); return (u + 0x7fffu + ((u >> 16) & 1u)) >> 16; }
__device__ __forceinline__ unsigned pk2(float lo, float hi) { return f2bf(lo) | (f2bf(hi) << 16); }
__device__ __forceinline__ unsigned pk4_fp8_e(float a, float b, float c, float d) { int r = 0; r = __builtin_amdgcn_cvt_pk_fp8_f32(a, b, r, false); r = __builtin_amdgcn_cvt_pk_fp8_f32(c, d, r, true); return (unsigned)r; }
__device__ __forceinline__ float bflo(unsigned w) { return __uint_as_float(w << 16); }
__device__ __forceinline__ float bfhi(unsigned w) { return __uint_as_float(w & 0xffff0000u); }
__device__ __forceinline__ float bf1(bf16_t v) { return __uint_as_float(((unsigned)v) << 16); }
__device__ __forceinline__ float wave_sum(float v) {
#pragma unroll
    for (int o = 1; o < 64; o <<= 1) v += __shfl_xor(v, o);
    return v;
}
template <int CTRL> __device__ __forceinline__ float dpp_f(float v) { return __builtin_bit_cast(float, __builtin_amdgcn_update_dpp(0, __builtin_bit_cast(int, v), CTRL, 0xf, 0xf, false)); }
__device__ __forceinline__ float row_sum(float v) { v += dpp_f<0xB1>(v); v += dpp_f<0x4E>(v); v += dpp_f<0x141>(v); v += dpp_f<0x140>(v); return v; }
__device__ __forceinline__ float wave_sum_dpp(float v) { v = row_sum(v); v += __shfl_xor(v, 16); v += __shfl_xor(v, 32); return v; }
__device__ __forceinline__ float wave_max(float v) {
#pragma unroll
    for (int o = 1; o < 64; o <<= 1) v = fmaxf(v, __shfl_xor(v, o));
    return v;
}

#define XB_TMO      128
#define XB_XCNT(j)  (256  + 64 * (j))
#define XB_XSUB(j)  (1280 + 64 * (j))
#define XB_XGEN(j)  (2304 + 64 * (j))
#define XB_TOP      3328
#define XB_TOPGEN   3392
#define XCD_BAR_WORDS 3456
#define XB_SPIN_CAP (1u << 18)
__device__ __forceinline__ unsigned xb_ld(unsigned* p)              { return __hip_atomic_load(p, __ATOMIC_RELAXED, __HIP_MEMORY_SCOPE_AGENT); }
__device__ __forceinline__ unsigned xb_add(unsigned* p, unsigned v) { return __hip_atomic_fetch_add(p, v, __ATOMIC_RELAXED, __HIP_MEMORY_SCOPE_AGENT); }
__device__ __forceinline__ unsigned xb_xcc_id() { return (unsigned)__builtin_amdgcn_s_getreg((3 << 11) | 20) & 0xFu; }
#define XB_SPIN(cond, bar) do { unsigned _sp = 0; while (cond) { __builtin_amdgcn_s_sleep(1); \
    if ((++_sp & 255u) == 0u) { if (xb_ld(&(bar)[XB_TMO])) break; if (_sp > XB_SPIN_CAP) { atomicAdd(&(bar)[XB_TMO], 1u); break; } } } } while (0)
struct XcdBarrier { unsigned* bar; unsigned x; volatile LAS unsigned* st; };
__device__ __forceinline__ XcdBarrier xcd_barrier_post(unsigned* bar, volatile LAS unsigned* st) {
    XcdBarrier b; b.bar = bar; b.x = xb_xcc_id(); b.st = st;
    if (threadIdx.x == 0) (void)xb_add(&bar[XB_XCNT(b.x)], 1u);
    return b;
}
__device__ __forceinline__ void xcd_barrier_complete(unsigned* bar, unsigned x, unsigned& nloc, unsigned& nx) {
    const unsigned G = gridDim.x * gridDim.y * gridDim.z;
    unsigned sum, cnt, mine, sp = 0u;
    for (;;) {
        sum = 0u; cnt = 0u; mine = 0u;
#pragma unroll
        for (unsigned j = 0; j < 16; ++j) { const unsigned c = xb_ld(&bar[XB_XCNT(j)]); sum += c; cnt += (c > 0u) ? 1u : 0u; mine = (j == x) ? c : mine; }
        if (sum == G) break;
        __builtin_amdgcn_s_sleep(1);
        if ((++sp & 255u) == 0u) { if (xb_ld(&bar[XB_TMO])) break; if (sp > XB_SPIN_CAP) { atomicAdd(&bar[XB_TMO], 1u); break; } }
    }
    nloc = mine > 0u ? mine : 1u; nx = cnt > 0u ? cnt : 1u;
}
__device__ __forceinline__ void xcd_barrier(const XcdBarrier& b) {
    asm volatile("s_waitcnt vmcnt(0)" ::: "memory");
    __syncthreads();
    if (threadIdx.x == 0) {
        unsigned* bar = b.bar;
        __builtin_amdgcn_s_waitcnt(0);
        unsigned nloc = b.st[0], nx = b.st[1];
        if (nloc == 0u) { xcd_barrier_complete(bar, b.x, nloc, nx); b.st[0] = nloc; b.st[1] = nx; }
        const unsigned old = xb_add(&bar[XB_XSUB(b.x)], 1u);
        const unsigned gen = old / nloc;
        if (old + 1u == (gen + 1u) * nloc) {
            __builtin_amdgcn_fence(__ATOMIC_RELEASE, "agent");
            asm volatile("s_waitcnt vmcnt(0)" ::: "memory");
            const unsigned og = xb_add(&bar[XB_TOP], 1u);
            const unsigned tg = og / nx;
            if (og + 1u == (tg + 1u) * nx) xb_add(&bar[XB_TOPGEN], 1u);
            else XB_SPIN(xb_ld(&bar[XB_TOPGEN]) == tg, bar);
            __builtin_amdgcn_fence(__ATOMIC_ACQUIRE, "agent");
            xb_add(&bar[XB_XGEN(b.x)], 1u);
            asm volatile("s_waitcnt vmcnt(0)" ::: "memory");
        } else {
            XB_SPIN(xb_ld(&bar[XB_XGEN(b.x)]) == gen, bar);
            __builtin_amdgcn_fence(__ATOMIC_ACQUIRE, "agent");
            asm volatile("s_waitcnt vmcnt(0)" ::: "memory");
        }
    }
    __syncthreads();
}


struct EpiProjA {
    static constexpr bool PERM = true, AFTER_DRAIN = false;
    bf16_t *u, *gv, *qm;
    __device__ __forceinline__ void operator()(const f32x4 (&acc)[2][2][4][2], const Unit& un, int wr, int wc, int fr, int fq) const {
        const int row0 = un.pm * 256 + wr * 64 + fr;
        bf16_t* base; int ldc, colt; bool act; float sc = 1.f;
        if (un.pn < 3) { base = u; ldc = SGW; colt = un.pn * 256; act = true; }
        else if (un.pn < 6) { base = gv; ldc = SGW; colt = (un.pn - 3) * 256; act = true; }
        else { base = qm; ldc = 256; colt = 0; act = false; sc = ATT_SCALE; }
        const int col0 = colt + wc * 32 + 8 * fq;
#pragma unroll
        for (int ai = 0; ai < 2; ++ai)
#pragma unroll
            for (int m = 0; m < 4; ++m) { bf16_t* rowp = base + (size_t)(row0 + ai * 128 + m * 16) * ldc + col0;
#pragma unroll
                for (int bj = 0; bj < 2; ++bj) { f32x4 v0 = acc[ai][bj][m][0], v1 = acc[ai][bj][m][1];
                    if (act) { pg8::f32x2 a = pg8::gelu_pk((pg8::f32x2){v0[0], v0[1]}), b = pg8::gelu_pk((pg8::f32x2){v0[2], v0[3]}), c = pg8::gelu_pk((pg8::f32x2){v1[0], v1[1]}), d = pg8::gelu_pk((pg8::f32x2){v1[2], v1[3]});
                        v0 = (f32x4){a.x, a.y, b.x, b.y}; v1 = (f32x4){c.x, c.y, d.x, d.y}; }
                    v0 = v0 * sc; v1 = v1 * sc;
                    u32x4 w; w.x = cvt_pk_bf16(v0[0], v0[1]); w.y = cvt_pk_bf16(v0[2], v0[3]); w.z = cvt_pk_bf16(v1[0], v1[1]); w.w = cvt_pk_bf16(v1[2], v1[3]);
                    *(u32x4*)(rowp + bj * 128) = w; } }
    }
};
struct EpiProjB {
    static constexpr bool PERM = true, AFTER_DRAIN = false;
    bf16_t *k, *v, *q, *qm;
    __device__ __forceinline__ void operator()(const f32x4 (&acc)[2][2][4][2], const Unit& un, int wr, int wc, int fr, int fq) const {
        const int row0 = un.pm * 256 + wr * 64 + fr;
        bf16_t* base; int ldc, colt; float sc = 1.f;
        if (un.pn < 3) { base = k; ldc = SGW; colt = un.pn * 256; }
        else if (un.pn < 6) { base = v; ldc = SGW; colt = (un.pn - 3) * 256; }
        else if (un.pn < 9) { base = q; ldc = SGW; colt = (un.pn - 6) * 256; sc = ATT_SCALE; }
        else { base = qm; ldc = 256; colt = 0; sc = ATT_SCALE; }
        const int col0 = colt + wc * 32 + 8 * fq;
#pragma unroll
        for (int ai = 0; ai < 2; ++ai)
#pragma unroll
            for (int m = 0; m < 4; ++m) { bf16_t* rowp = base + (size_t)(row0 + ai * 128 + m * 16) * ldc + col0;
#pragma unroll
                for (int bj = 0; bj < 2; ++bj) { f32x4 v0 = acc[ai][bj][m][0] * sc, v1 = acc[ai][bj][m][1] * sc;
                    u32x4 w; w.x = cvt_pk_bf16(v0[0], v0[1]); w.y = cvt_pk_bf16(v0[2], v0[3]); w.z = cvt_pk_bf16(v1[0], v1[1]); w.w = cvt_pk_bf16(v1[2], v1[3]);
                    *(u32x4*)(rowp + bj * 128) = w; } }
    }
};
struct EpiPlain {
    static constexpr bool PERM = true, AFTER_DRAIN = false;
    bf16_t* O; int ldc, ntn;
    __device__ __forceinline__ void operator()(const f32x4 (&acc)[2][2][4][2], const Unit& un, int wr, int wc, int fr, int fq) const {
        const int row0 = un.pm * 256 + wr * 64 + fr;
        const int col0 = (un.pn % ntn) * 256 + wc * 32 + 8 * fq;
#pragma unroll
        for (int ai = 0; ai < 2; ++ai)
#pragma unroll
            for (int m = 0; m < 4; ++m) { bf16_t* rowp = O + (size_t)(row0 + ai * 128 + m * 16) * ldc + col0;
#pragma unroll
                for (int bj = 0; bj < 2; ++bj) { const f32x4 v0 = acc[ai][bj][m][0], v1 = acc[ai][bj][m][1];
                    u32x4 w; w.x = cvt_pk_bf16(v0[0], v0[1]); w.y = cvt_pk_bf16(v0[2], v0[3]); w.z = cvt_pk_bf16(v1[0], v1[1]); w.w = cvt_pk_bf16(v1[2], v1[3]);
                    *(u32x4*)(rowp + bj * 128) = w; } }
    }
};
struct EpiSwiGLU {
    static constexpr bool PERM = true, AFTER_DRAIN = false;
    bf16_t* O;
    __device__ __forceinline__ void operator()(const f32x4 (&acc)[2][2][4][2], const Unit& un, int wr, int wc, int fr, int fq) const {
        const int row0 = un.pm * 256 + wr * 64 + fr;
        const int col0 = (un.pn & 7) * 128 + wc * 32 + 8 * fq;
#pragma unroll
        for (int ai = 0; ai < 2; ++ai)
#pragma unroll
            for (int m = 0; m < 4; ++m) { bf16_t* rowp = O + (size_t)(row0 + ai * 128 + m * 16) * 1024 + col0;
                float r[8];
#pragma unroll
                for (int n = 0; n < 2; ++n)
#pragma unroll
                    for (int j = 0; j < 4; ++j) { const float g = acc[ai][0][m][n][j], up = acc[ai][1][m][n][j];
                        r[n * 4 + j] = g * __builtin_amdgcn_rcpf(1.0f + __expf(-g)) * up; }
                u32x4 w; w.x = cvt_pk_bf16(r[0], r[1]); w.y = cvt_pk_bf16(r[2], r[3]); w.z = cvt_pk_bf16(r[4], r[5]); w.w = cvt_pk_bf16(r[6], r[7]);
                *(u32x4*)rowp = w; }
    }
};
struct EpiSwiGLU8 {
    static constexpr bool PERM = true, AFTER_DRAIN = false;
    unsigned char* O;
    __device__ __forceinline__ void operator()(const f32x4 (&acc)[2][2][4][2], const Unit& un, int wr, int wc, int fr, int fq) const {
        const int row0 = un.pm * 256 + wr * 64 + fr;
        const int col0 = (un.pn & 7) * 128 + wc * 32 + 8 * fq;
#pragma unroll
        for (int ai = 0; ai < 2; ++ai)
#pragma unroll
            for (int m = 0; m < 4; ++m) { unsigned char* rowp = O + (size_t)(row0 + ai * 128 + m * 16) * 1024 + col0;
                float r[8];
#pragma unroll
                for (int n = 0; n < 2; ++n)
#pragma unroll
                    for (int j = 0; j < 4; ++j) { const float g = acc[ai][0][m][n][j], up = acc[ai][1][m][n][j];
                        r[n * 4 + j] = g * __builtin_amdgcn_rcpf(1.0f + __expf(-g)) * up * 8.0f; }
                *(u32x2*)rowp = (u32x2){pk4_fp8_e(r[0], r[1], r[2], r[3]), pk4_fp8_e(r[4], r[5], r[6], r[7])}; }
    }
};
template <bool RB> struct EpiResid {
    static constexpr bool PERM = false, AFTER_DRAIN = false;
    const void* res; float* Y;
    __device__ __forceinline__ void operator()(const f32x4 (&acc)[2][2][4][2], const Unit& un, int wr, int wc, int fr, int fq) const {
        const int row0 = un.pm * 256 + wr * 64 + fr, col0 = un.pn * 256 + wc * 32 + 4 * fq;
#pragma unroll
        for (int ai = 0; ai < 2; ++ai)
#pragma unroll
            for (int m = 0; m < 4; ++m) { const size_t off = (size_t)(row0 + ai * 128 + m * 16) * D + col0;
#pragma unroll
                for (int bj = 0; bj < 2; ++bj)
#pragma unroll
                    for (int n = 0; n < 2; ++n) { const size_t o = off + bj * 128 + n * 16; f32x4 r;
                        if (RB) { const u32x2 w = *(const u32x2*)((const bf16_t*)res + o); r = (f32x4){bflo(w.x), bfhi(w.x), bflo(w.y), bfhi(w.y)}; }
                        else r = *(const f32x4*)((const float*)res + o);
                        *(f32x4*)(Y + o) = r * ALPHA + acc[ai][bj][m][n]; } }
    }
};
struct SmallOrder {
    int nN, nwg, c;
    __device__ bool next(int i, Unit& u) const { if (i != 0 || c < 0 || c >= nwg) return false; u.pm = c / nN; u.pn = c % nN; return true; }
    __device__ __forceinline__ void a_ready(const Unit&) const {}
    __device__ __forceinline__ void done(const Unit&) const {}
    __device__ __forceinline__ int arow(int, const Unit& u, int r) const { return u.pm * 256 + r; }
};
struct MoeOrder {
    const LAS int* tb;
    int ntn, G, c;
    __device__ bool next(int i, Unit& u) const {
        const int L = i * G + c; if (L >= tb[16] * ntn) return false;
        int e = 0;
#pragma unroll
        for (int j = 1; j < 16; ++j) e += (L >= tb[j] * ntn) ? 1 : 0;
        const int r = L - tb[e] * ntn, te = tb[e + 1] - tb[e];
        u.pm = tb[e] + r % te; u.pn = e * ntn + r / te; return true;
    }
    __device__ __forceinline__ void a_ready(const Unit&) const {}
    __device__ __forceinline__ void done(const Unit&) const {}
    __device__ __forceinline__ int arow(int, const Unit& u, int r) const { return u.pm * 256 + r; }
};
struct MoeGatherOrder : MoeOrder {
    const LAS int* toks;
    __device__ __forceinline__ int arow(int ui, const Unit&, int r) const { return toks[ui * 256 + r]; }
};

struct Args { const float* in[23]; float* out; unsigned char* ws; int ph_lo, ph_hi; };
struct Ctx {
    unsigned char* ws; LAS unsigned char* lds;
    int tid, lane, wave, gw, NGW, G, bid;
};
__device__ __forceinline__ unsigned char* launder(unsigned char* p) { asm volatile("" : "+s"(p)); return p; }
__device__ __forceinline__ int launder_v(int v) { asm volatile("" : "+v"(v)); return v; }

__device__ __forceinline__ void tr_item(const float* W, int K, int N, bf16_t* WT, int grp, int gstride, int roff, LAS float* scr, int item, int lane) {
    const int nblk = N / 32, kb = item / nblk, nb = item % nblk, k0 = 64 * kb, n0 = 32 * nb;
    float ld[32];
    { const float* wp = W + (size_t)(k0 + (lane >> 5)) * N + n0 + (lane & 31);
#pragma unroll
      for (int i = 0; i < 32; ++i) ld[i] = __builtin_nontemporal_load(wp + (size_t)(2 * i) * N); }
#pragma unroll
    for (int i = 0; i < 32; ++i) scr[(2 * i + (lane >> 5)) * 33 + (lane & 31)] = ld[i];
    LDS_WAIT(); asm volatile("" ::: "memory");
    const int c = lane & 7;
#pragma unroll
    for (int j = 0; j < 4; ++j) { const int n = (lane >> 3) + 8 * j; const LAS float* s = scr + (8 * c) * 33 + n;
        const int nn = n0 + n, drow = (nn / grp) * gstride + (nn % grp) + roff;
        u32x4 o; o.x = pk2(s[0 * 33], s[1 * 33]); o.y = pk2(s[2 * 33], s[3 * 33]); o.z = pk2(s[4 * 33], s[5 * 33]); o.w = pk2(s[6 * 33], s[7 * 33]);
        *(u32x4*)(WT + (size_t)drow * K + k0 + 8 * c) = o; }
    LDS_WAIT(); asm volatile("" ::: "memory");
}
__device__ __forceinline__ unsigned pk4_fp8(float a, float b, float c, float d) { int r = 0; r = __builtin_amdgcn_cvt_pk_fp8_f32(a, b, r, false); r = __builtin_amdgcn_cvt_pk_fp8_f32(c, d, r, true); return (unsigned)r; }
__device__ __forceinline__ void tr_item8(const float* W, int K, int N, unsigned char* WT, int grp, int gstride, int roff, float sc, LAS float* scr, int item, int lane) {
    const int nblk = N / 32, kb = item / nblk, nb = item % nblk, k0 = 64 * kb, n0 = 32 * nb;
    float ld[32];
    { const float* wp = W + (size_t)(k0 + (lane >> 5)) * N + n0 + (lane & 31);
#pragma unroll
      for (int i = 0; i < 32; ++i) ld[i] = __builtin_nontemporal_load(wp + (size_t)(2 * i) * N); }
#pragma unroll
    for (int i = 0; i < 32; ++i) scr[(2 * i + (lane >> 5)) * 33 + (lane & 31)] = ld[i];
    LDS_WAIT(); asm volatile("" ::: "memory");
    const int c = lane & 7;
#pragma unroll
    for (int j = 0; j < 4; ++j) { const int n = (lane >> 3) + 8 * j; const LAS float* s = scr + (8 * c) * 33 + n;
        const int nn = n0 + n, drow = (nn / grp) * gstride + (nn % grp) + roff;
        u32x2 o; o.x = pk4_fp8(s[0 * 33] * sc, s[1 * 33] * sc, s[2 * 33] * sc, s[3 * 33] * sc); o.y = pk4_fp8(s[4 * 33] * sc, s[5 * 33] * sc, s[6 * 33] * sc, s[7 * 33] * sc);
        *(u32x2*)(WT + (size_t)drow * K + k0 + 8 * c) = o; }
    LDS_WAIT(); asm volatile("" ::: "memory");
}
constexpr float W8_SCALE = 32.0f, ACT8_SCALE = 8.0f;
constexpr int E8_ONE = 0x7f7f7f7f, E8_W = 0x7a7a7a7a, E8_ACT = 0x7c7c7c7c;
__device__ __forceinline__ void moe_conv_item(const Args& A, unsigned char* ws, LAS float* scr, int lane, int layer, int r) {
    const int t = r >> 13, e = (r & 8191) >> 9, m = layer * 16 + e, item = r & 511;
    if (t == 0) tr_item8(A.in[20] + (size_t)m * 1048576, 1024, 1024, ws + WS_WGU + (size_t)layer * (64 * MiB) + (size_t)e * 2097152, 128, 256, 0, W8_SCALE, scr, item, lane);
    else if (t == 1) tr_item8(A.in[21] + (size_t)m * 1048576, 1024, 1024, ws + WS_WGU + (size_t)layer * (64 * MiB) + (size_t)e * 2097152, 128, 256, 128, W8_SCALE, scr, item, lane);
    else tr_item8(A.in[22] + (size_t)m * 1048576, 1024, 1024, ws + WS_WD + (size_t)layer * (32 * MiB) + (size_t)e * 1048576, 1024, 1024, 0, W8_SCALE, scr, item, lane);
}
constexpr int N_CONV1 = 3 * 8192;
__device__ __forceinline__ void fill_tail(const Ctx& C, const Args& A, int ph, bool fin) {
    unsigned* ctl = (unsigned*)(C.ws + WS_CTL);
    volatile LAS int* flag = (volatile LAS int*)(C.lds + LDS_MISC) + 40;
    LAS float* scr = (LAS float*)(C.lds + C.wave * 16384);
    asm volatile("s_waitcnt vmcnt(0)" ::: "memory");
    __syncthreads();
    if (C.tid == 0 && !fin) __hip_atomic_fetch_add(ctl + CW_DONE + 64 * ph, 1u, __ATOMIC_RELAXED, __HIP_MEMORY_SCOPE_AGENT);
    for (;;) {
        if (C.tid == 0) { int v = -1;
            const unsigned d = fin ? 0u : __hip_atomic_fetch_add(ctl + CW_DONE + 64 * ph, 0u, __ATOMIC_RELAXED, __HIP_MEMORY_SCOPE_AGENT);
            if (d + 8u < (unsigned)C.G) { v = (int)__hip_atomic_fetch_add(ctl + CW_CONV, 8u, __ATOMIC_RELAXED, __HIP_MEMORY_SCOPE_AGENT); if (v >= N_CONV1) v = -1; }
#if MK_DIAG == 3
            if (!fin && v >= 0) __hip_atomic_fetch_add(ctl + 30000, 8u, __ATOMIC_RELAXED, __HIP_MEMORY_SCOPE_AGENT);
#endif
            *flag = v; }
        __syncthreads();
        const int v = *flag;
        __syncthreads();
        if (v < 0) break;
        if (v + C.wave < N_CONV1) moe_conv_item(A, C.ws, scr, C.lane, 1, v + C.wave);
    }
}
__device__ __forceinline__ void p0_prologue(const Ctx& C, const Args& A) {
    LAS float* scr = (LAS float*)(C.lds + C.wave * 16384);
    unsigned char* ws = C.ws;
    constexpr int I_MOE = 16 * 32;
    constexpr int N_MOE = 32 * I_MOE;
    constexpr int I_INA = 16 * 56, I_SQ = 512, I_KV = 16 * 24, I_OUTB = 8 * 32, I_MEM = 16 * 8;
    constexpr int N_MOE0 = 3 * 8192;
    constexpr int NITEMS = I_INA + I_SQ + I_SQ + 2 * I_KV + I_OUTB + 4 * I_MEM;
    for (int it = C.gw; it < NITEMS; it += C.NGW) {
        int r = it;
        if (r < I_INA) { tr_item(A.in[2], 1024, 1792, (bf16_t*)(ws + WS_BT_INA), 1792, 1792, 0, scr, r, C.lane); continue; } r -= I_INA;
        if (r < I_SQ) { tr_item(A.in[3], 1024, 1024, (bf16_t*)(ws + WS_BT_OUTA), 1024, 1024, 0, scr, r, C.lane); continue; } r -= I_SQ;
        if (r < I_SQ) { tr_item(A.in[8], 1024, 1024, (bf16_t*)(ws + WS_BT_B), 1024, 1024, 1536, scr, r, C.lane); continue; } r -= I_SQ;
        if (r < I_KV) { tr_item(A.in[10], 1024, 768, (bf16_t*)(ws + WS_BT_B), 768, 768, 0, scr, r, C.lane); continue; } r -= I_KV;
        if (r < I_KV) { tr_item(A.in[11], 1024, 768, (bf16_t*)(ws + WS_BT_B), 768, 768, 768, scr, r, C.lane); continue; } r -= I_KV;
        if (r < I_OUTB) { tr_item(A.in[9], 512, 1024, (bf16_t*)(ws + WS_BT_OUTB), 1024, 1024, 0, scr, r, C.lane); continue; } r -= I_OUTB;
        { const int m = r / I_MEM, layer = m & 1, isv = m >> 1;
          tr_item(A.in[isv ? 13 : 12] + (size_t)layer * 262144, 1024, 256, (bf16_t*)(ws + WS_BT_MEM), 256, 256, layer * 512 + isv * 256, scr, r % I_MEM, C.lane); }
    }
    const int gt = C.bid * NTHREADS + C.tid, NT = C.G * NTHREADS;
    for (int i = gt; i < NSG * 128 * 128 / 8; i += NT) { const int q0 = (i & 15) * 8, p = (i >> 4) & 127;
        const f32x4 a = *(const f32x4*)(A.in[6] + (size_t)i * 8), b = *(const f32x4*)(A.in[6] + (size_t)i * 8 + 4); float v[8] = {a[0], a[1], a[2], a[3], b[0], b[1], b[2], b[3]};
#pragma unroll
        for (int j = 0; j < 8; ++j) v[j] = (q0 + j <= p) ? v[j] : 0.f;
        u32x4 w; w.x = pk2(v[0], v[1]); w.y = pk2(v[2], v[3]); w.z = pk2(v[4], v[5]); w.w = pk2(v[6], v[7]); *(u32x4*)((bf16_t*)(ws + WS_SGWB) + (size_t)i * 8) = w; }
    for (int i = gt; i < 16 * 1024; i += NT) { const int e = i >> 10, k = i & 1023; ((bf16_t*)(ws + WS_WRT))[i] = (bf16_t)f2bf(A.in[18][(size_t)k * 16 + e]); }
    for (int i = gt; i < NSG * 128; i += NT) { const int p = i & 127; float acc = 0.f;
        for (int q = 0; q <= p; ++q) acc += bflo(f2bf(A.in[6][(size_t)i * 128 + q]));
        ((float*)(ws + WS_SGRS))[i] = acc; }
    for (int i = gt; i < T * D / 8; i += NT) { const f32x4 a = *(const f32x4*)(A.in[0] + (size_t)i * 8), b = *(const f32x4*)(A.in[0] + (size_t)i * 8 + 4);
        u32x4 w; w.x = pk2(a[0], a[1]); w.y = pk2(a[2], a[3]); w.z = pk2(b[0], b[1]); w.w = pk2(b[2], b[3]); *(u32x4*)((bf16_t*)(ws + WS_XB) + (size_t)i * 8) = w; }
    for (int i = gt; i < NB * NMEM * D / 8; i += NT) { const f32x4 a = *(const f32x4*)(A.in[1] + (size_t)i * 8), b = *(const f32x4*)(A.in[1] + (size_t)i * 8 + 4);
        u32x4 w; w.x = pk2(a[0], a[1]); w.y = pk2(a[2], a[3]); w.z = pk2(b[0], b[1]); w.w = pk2(b[2], b[3]); *(u32x4*)((bf16_t*)(ws + WS_MEMB) + (size_t)i * 8) = w; }
    { unsigned* ctr = (unsigned*)(ws + WS_CTL) + CW_CONV0; volatile LAS int* flag = (volatile LAS int*)(C.lds + LDS_MISC) + 40;
      if (C.tid == 0) *flag = (int)__hip_atomic_fetch_add(ctr, 8u, __ATOMIC_RELAXED, __HIP_MEMORY_SCOPE_AGENT);
      __syncthreads();
      int cur = *flag;
      __syncthreads();
      while (cur < N_MOE0) {
          int nxt = 0;
          if (C.tid == 0) nxt = (int)__hip_atomic_fetch_add(ctr, 8u, __ATOMIC_RELAXED, __HIP_MEMORY_SCOPE_AGENT);
          if (cur + C.wave < N_MOE0) moe_conv_item(A, ws, scr, C.lane, 0, cur + C.wave);
          if (C.tid == 0) *flag = nxt;
          __syncthreads();
          cur = *flag;
          __syncthreads();
      } }
}

__device__ __forceinline__ void sg_scalar(const Ctx& C, const Args& A) {
    const bf16_t* U = (const bf16_t*)(C.ws + WS_U); const bf16_t* GV = (const bf16_t*)(C.ws + WS_GV); bf16_t* CAT = (bf16_t*)(C.ws + WS_CAT);
    const float* lng = A.in[4]; const float* lnb = A.in[5]; const float* sgw = A.in[6]; const float* sgb = A.in[7];
    LAS float* stat = (LAS float*)C.lds;
    LAS float* gvn = (LAS float*)(C.lds + 1024);
    LAS float* Wl = (LAS float*)(C.lds + 1024 + 128 * 65 * 4);
    for (int unit = C.bid; unit < NB * 16; unit += C.G) {
        const int tb = unit * 128;
        for (int rr = 0; rr < 16; ++rr) { const int row = C.wave * 16 + rr; const bf16_t* p = GV + (size_t)(tb + row) * SGW + 4 * C.lane;
            float s = 0.f, ss = 0.f;
#pragma unroll
            for (int j = 0; j < 3; ++j) { const u32x2 w = *(const u32x2*)(p + 256 * j); const float a = bflo(w.x), b = bfhi(w.x), c = bflo(w.y), d = bfhi(w.y);
                s += (a + b) + (c + d); ss += (a * a + b * b) + (c * c + d * d); }
            s = wave_sum(s); ss = wave_sum(ss);
            const float mean = s * (1.f / SGW), var = ss * (1.f / SGW) - mean * mean;
            if (C.lane == 0) { stat[row * 2] = mean; stat[row * 2 + 1] = 1.0f / sqrtf(var + LN_EPS); } }
        __syncthreads();
        const int p = C.tid >> 2, d0 = (C.tid & 3) * 16;
        for (int g = 0; g < NSG; ++g) {
            { const bf16_t* src = GV + (size_t)(tb + p) * SGW + g * 64 + d0; const float mean = stat[p * 2], rstd = stat[p * 2 + 1];
#pragma unroll
              for (int h = 0; h < 2; ++h) { const u32x4 w = *(const u32x4*)(src + 8 * h); const unsigned ww[4] = {w.x, w.y, w.z, w.w};
#pragma unroll
                  for (int j = 0; j < 4; ++j) { const int d = d0 + 8 * h + 2 * j; const int cc = g * 64 + d;
                      gvn[p * 65 + d] = (bflo(ww[j]) - mean) * rstd * lng[cc] + lnb[cc];
                      gvn[p * 65 + d + 1] = (bfhi(ww[j]) - mean) * rstd * lng[cc + 1] + lnb[cc + 1]; } } }
            { const int q0 = (C.tid & 3) * 32; const float* src = sgw + ((size_t)g * 128 + p) * 128 + q0;
#pragma unroll
              for (int j = 0; j < 8; ++j) { const f32x4 w = *(const f32x4*)(src + 4 * j);
#pragma unroll
                  for (int t = 0; t < 4; ++t) { const int q = q0 + 4 * j + t; Wl[p * 129 + q] = (q <= p) ? w[t] : 0.f; } } }
            __syncthreads();
            float acc[16];
#pragma unroll
            for (int j = 0; j < 16; ++j) acc[j] = 0.f;
            for (int q = 0; q <= p; ++q) { const float w = Wl[p * 129 + q];
#pragma unroll
                for (int j = 0; j < 16; ++j) acc[j] += w * gvn[q * 65 + d0 + j]; }
            const float bs = sgb[g * 128 + p];
            const bf16_t* us = U + (size_t)(tb + p) * SGW + g * 64 + d0; bf16_t* dst = CAT + (size_t)(tb + p) * D + g * 64 + d0;
#pragma unroll
            for (int h = 0; h < 2; ++h) { const u32x4 w = *(const u32x4*)(us + 8 * h); const unsigned ww[4] = {w.x, w.y, w.z, w.w}; unsigned o[4];
#pragma unroll
                for (int j = 0; j < 4; ++j) o[j] = pk2(bflo(ww[j]) * (acc[8 * h + 2 * j] + bs), bfhi(ww[j]) * (acc[8 * h + 2 * j + 1] + bs));
                *(u32x4*)(dst + 8 * h) = (u32x4){o[0], o[1], o[2], o[3]}; }
            __syncthreads();
        }
    }
}

__device__ __forceinline__ void memattn_scalar(const Ctx& C, const bf16_t* QM, const bf16_t* MKV, int ck, int cv, bf16_t* OUT, int ldo, int coff) {
    for (int it = C.gw; it < T * 4; it += C.NGW) {
        const int tok = it >> 2, h = it & 3, b = tok / SEQ;
        float q[64];
        { const bf16_t* qp = QM + (size_t)tok * 256 + h * 64;
#pragma unroll
          for (int j = 0; j < 8; ++j) { const u32x4 w = *(const u32x4*)(qp + 8 * j);
              q[8 * j] = bflo(w.x); q[8 * j + 1] = bfhi(w.x); q[8 * j + 2] = bflo(w.y); q[8 * j + 3] = bfhi(w.y); q[8 * j + 4] = bflo(w.z); q[8 * j + 5] = bfhi(w.z); q[8 * j + 6] = bflo(w.w); q[8 * j + 7] = bfhi(w.w); } }
        float s[4];
#pragma unroll
        for (int jj = 0; jj < 4; ++jj) { const bf16_t* kp = MKV + (size_t)(b * NMEM + jj * 64 + C.lane) * 1024 + ck + h * 64; float a = 0.f;
#pragma unroll
            for (int j = 0; j < 8; ++j) { const u32x4 w = *(const u32x4*)(kp + 8 * j);
                a += q[8 * j] * bflo(w.x) + q[8 * j + 1] * bfhi(w.x) + q[8 * j + 2] * bflo(w.y) + q[8 * j + 3] * bfhi(w.y) + q[8 * j + 4] * bflo(w.z) + q[8 * j + 5] * bfhi(w.z) + q[8 * j + 6] * bflo(w.w) + q[8 * j + 7] * bfhi(w.w); }
            s[jj] = a; }
        const float mx = wave_max(fmaxf(fmaxf(s[0], s[1]), fmaxf(s[2], s[3])));
        float l = 0.f;
#pragma unroll
        for (int jj = 0; jj < 4; ++jj) { s[jj] = __expf(s[jj] - mx); l += s[jj]; }
        l = wave_sum(l);
        float acc = 0.f;
#pragma unroll
        for (int jj = 0; jj < 4; ++jj) { const bf16_t* vp = MKV + (size_t)(b * NMEM + jj * 64) * 1024 + cv + h * 64 + C.lane;
            for (int mm = 0; mm < 64; ++mm) acc += __shfl(s[jj], mm) * bf1(vp[(size_t)mm * 1024]); }
        OUT[(size_t)tok * ldo + coff + h * 64 + C.lane] = (bf16_t)f2bf(acc / l);
    }
}

__device__ __forceinline__ void dilattn_scalar(const Ctx& C, const Args& A) {
    const bf16_t* Q = (const bf16_t*)(C.ws + WS_Q); const bf16_t* K = (const bf16_t*)(C.ws + WS_K); const bf16_t* V = (const bf16_t*)(C.ws + WS_V);
    bf16_t* OG = (bf16_t*)(C.ws + WS_OG); float* LSE = (float*)(C.ws + WS_LSE);
    for (int it = C.gw; it < T * 12; it += C.NGW) {
        const int tok = it / 12, h = it % 12, g = h >> 2, dl = (g == 0) ? 1 : (g == 1 ? 4 : 16);
        const int t = tok % SEQ, i = t / dl;
        const float slope = exp2f(-(float)(h + 1) * (8.0f / 12.0f));
        float q[64];
        { const bf16_t* qp = Q + (size_t)tok * SGW + h * 64;
#pragma unroll
          for (int j = 0; j < 8; ++j) { const u32x4 w = *(const u32x4*)(qp + 8 * j);
              q[8 * j] = bflo(w.x); q[8 * j + 1] = bfhi(w.x); q[8 * j + 2] = bflo(w.y); q[8 * j + 3] = bfhi(w.y); q[8 * j + 4] = bflo(w.z); q[8 * j + 5] = bfhi(w.z); q[8 * j + 6] = bflo(w.w); q[8 * j + 7] = bfhi(w.w); } }
        float s[3];
#pragma unroll
        for (int jj = 0; jj < 3; ++jj) { const int j0 = jj * 64 + C.lane; const bool valid = (jj < 2 || C.lane == 0) && (j0 <= i);
            const int jc = valid ? j0 : 0;
            const bf16_t* kp = K + (size_t)(tok - jc * dl) * SGW + h * 64; float a = 0.f;
#pragma unroll
            for (int j = 0; j < 8; ++j) { const u32x4 w = *(const u32x4*)(kp + 8 * j);
                a += q[8 * j] * bflo(w.x) + q[8 * j + 1] * bfhi(w.x) + q[8 * j + 2] * bflo(w.y) + q[8 * j + 3] * bfhi(w.y) + q[8 * j + 4] * bflo(w.z) + q[8 * j + 5] * bfhi(w.z) + q[8 * j + 6] * bflo(w.w) + q[8 * j + 7] * bfhi(w.w); }
            s[jj] = valid ? (a - slope * (float)(dl * j0)) : -INFINITY; }
        const float mx = wave_max(fmaxf(fmaxf(s[0], s[1]), s[2]));
        float l = 0.f;
#pragma unroll
        for (int jj = 0; jj < 3; ++jj) { s[jj] = __expf(s[jj] - mx); l += s[jj]; }
        l = wave_sum(l);
        float acc = 0.f;
#pragma unroll
        for (int jj = 0; jj < 3; ++jj) { const int nm = (jj < 2) ? 64 : 1;
            for (int mm = 0; mm < nm; ++mm) { const int j0 = jj * 64 + mm; const int jc = (j0 <= i) ? j0 : 0;
                acc += __shfl(s[jj], mm) * bf1(V[(size_t)(tok - jc * dl) * SGW + h * 64 + C.lane]); } }
        OG[(size_t)tok * SGW + h * 64 + C.lane] = (bf16_t)f2bf(acc / l);
        if (C.lane == 0) LSE[tok * 12 + h] = mx + __logf(l);
    }
}
typedef short bf16x8 __attribute__((ext_vector_type(8)));
typedef short s16x4 __attribute__((ext_vector_type(4)));
constexpr int AT_KS = 144, AT_VS = 160, AT_ROWS = 272, AT_K_OFF = 0, AT_V_OFF = AT_ROWS * AT_KS;
static_assert(AT_V_OFF % 16 == 0 && AT_V_OFF + AT_ROWS * AT_VS <= 131072, "attention LDS map");

template <int NKB, bool DIL>
__device__ __forceinline__ void attn_compute(LAS unsigned char* lds, int lane, int krow0, bf16x8 qf0, bf16x8 qf1, float sdl, int ikw, f32x4 (&o)[4], float& mx, float& lsum) {
    const int n = lane & 15, g = lane >> 4;
    const LAS unsigned char* Kb = lds + AT_K_OFF + (krow0 + n) * AT_KS + g * 16;
    f32x4 sc[NKB];
#pragma unroll
    for (int kb = 0; kb < NKB; ++kb) {
        const bf16x8 k0 = *(const LAS bf16x8*)(Kb + kb * 16 * AT_KS), k1 = *(const LAS bf16x8*)(Kb + kb * 16 * AT_KS + 64);
        f32x4 a = (f32x4){0.f, 0.f, 0.f, 0.f};
        a = __builtin_amdgcn_mfma_f32_16x16x32_bf16(k0, qf0, a, 0, 0, 0);
        a = __builtin_amdgcn_mfma_f32_16x16x32_bf16(k1, qf1, a, 0, 0, 0);
        sc[kb] = a;
    }
    float m = -INFINITY;
#pragma unroll
    for (int kb = 0; kb < NKB; ++kb)
#pragma unroll
        for (int r = 0; r < 4; ++r) {
            if (DIL) { const int off = 16 * kb + 4 * g + r, rel = 144 + n - off; const bool valid = (rel >= 0) && (rel <= 128) && (ikw + off >= 0);
                sc[kb][r] = valid ? (sc[kb][r] - sdl * (float)rel) : -INFINITY; }
            m = fmaxf(m, sc[kb][r]); }
    m = fmaxf(m, __shfl_xor(m, 16)); m = fmaxf(m, __shfl_xor(m, 32));
    float l = 0.f;
#pragma unroll
    for (int kb = 0; kb < NKB; ++kb)
#pragma unroll
        for (int r = 0; r < 4; ++r) { sc[kb][r] = __expf(sc[kb][r] - m); l += sc[kb][r]; }
    l += __shfl_xor(l, 16); l += __shfl_xor(l, 32);
    mx = m; lsum = l;
    const LAS unsigned char* Vb = lds + AT_V_OFF + (krow0 + 4 * g + (n >> 2)) * AT_VS + (n & 3) * 8;
#pragma unroll
    for (int db = 0; db < 4; ++db) o[db] = (f32x4){0.f, 0.f, 0.f, 0.f};
#pragma unroll
    for (int kk = 0; kk < NKB / 2; ++kk) {
        union { bf16x8 v; unsigned u[4]; } pf;
        pf.u[0] = cvt_pk_bf16(sc[2 * kk][0], sc[2 * kk][1]); pf.u[1] = cvt_pk_bf16(sc[2 * kk][2], sc[2 * kk][3]);
        pf.u[2] = cvt_pk_bf16(sc[2 * kk + 1][0], sc[2 * kk + 1][1]); pf.u[3] = cvt_pk_bf16(sc[2 * kk + 1][2], sc[2 * kk + 1][3]);
#pragma unroll
        for (int db = 0; db < 4; ++db) {
            const s16x4 v0 = __builtin_amdgcn_ds_read_tr16_b64_v4i16((LAS s16x4*)(Vb + (2 * kk) * 16 * AT_VS + db * 32));
            const s16x4 v1 = __builtin_amdgcn_ds_read_tr16_b64_v4i16((LAS s16x4*)(Vb + (2 * kk + 1) * 16 * AT_VS + db * 32));
            const bf16x8 vf = __builtin_shufflevector(v0, v1, 0, 1, 2, 3, 4, 5, 6, 7);
            o[db] = __builtin_amdgcn_mfma_f32_16x16x32_bf16(vf, pf.v, o[db], 0, 0, 0);
        }
    }
}

__device__ __forceinline__ void memattn_mfma(const Ctx& C, const bf16_t* QM, const bf16_t* MKV, int ck, int cv, bf16_t* OUT, int ldo, int coff) {
    const int n = C.lane & 15, g = C.lane >> 4;
    for (int unit = C.bid; unit < NB * 4 * 16; unit += C.G) {
        const int b = unit >> 6, h = (unit >> 4) & 3, qt = unit & 15;
        __syncthreads();
#pragma unroll
        for (int it = 0; it < 4; ++it) { const int row = it * 64 + (C.tid >> 3), c = C.tid & 7;
            const bf16_t* src = MKV + (size_t)(b * NMEM + row) * 1024 + h * 64 + c * 8;
            const u32x4 kv = *(const u32x4*)(src + ck), vv = *(const u32x4*)(src + cv);
            *(LAS u32x4*)(C.lds + AT_K_OFF + row * AT_KS + c * 16) = kv; *(LAS u32x4*)(C.lds + AT_V_OFF + row * AT_VS + c * 16) = vv; }
        const int tok = b * SEQ + qt * 128 + C.wave * 16 + n;
        const bf16_t* qp = QM + (size_t)tok * 256 + h * 64 + g * 8;
        const bf16x8 qf0 = *(const bf16x8*)qp, qf1 = *(const bf16x8*)(qp + 32);
        __syncthreads();
        f32x4 o[4]; float mx, l;
        attn_compute<16, false>(C.lds, C.lane, 0, qf0, qf1, 0.f, 0, o, mx, l);
        const float inv = 1.0f / l;
#pragma unroll
        for (int db = 0; db < 4; ++db)
            *(u32x2*)(OUT + (size_t)tok * ldo + coff + h * 64 + 16 * db + 4 * g) = (u32x2){cvt_pk_bf16(o[db][0] * inv, o[db][1] * inv), cvt_pk_bf16(o[db][2] * inv, o[db][3] * inv)};
    }
}
__device__ __forceinline__ void dilattn_mfma(const Ctx& C) {
    const bf16_t* Q = (const bf16_t*)(C.ws + WS_Q); const bf16_t* K = (const bf16_t*)(C.ws + WS_K); const bf16_t* V = (const bf16_t*)(C.ws + WS_V);
    bf16_t* OG = (bf16_t*)(C.ws + WS_OG); float* LSE = (float*)(C.ws + WS_LSE);
    const int n = C.lane & 15, g = C.lane >> 4;
    for (int unit = C.bid; unit < 12 * 128; unit += C.G) {
        const int h = unit >> 7, rem = unit & 127, b = rem >> 4, x = rem & 15, grp = h >> 2;
        const int dl = (grp == 0) ? 1 : (grp == 1 ? 4 : 16), ntile = 16 / dl, r = x / ntile, I0 = (x % ntile) * 128;
        const float sdl = exp2f(-(float)(h + 1) * (8.0f / 12.0f)) * (float)dl;
        __syncthreads();
        { u32x4 kv[5], vv[5];
#pragma unroll
          for (int it = 0; it < 5; ++it) { const int idx = it * NTHREADS + C.tid, row = idx >> 3, c = idx & 7, ik = I0 - 144 + row;
              kv[it] = (u32x4){0u, 0u, 0u, 0u}; vv[it] = (u32x4){0u, 0u, 0u, 0u};
              if (idx < AT_ROWS * 8 && ik >= 0) { const size_t off = (size_t)(b * SEQ + ik * dl + r) * SGW + h * 64 + c * 8; kv[it] = *(const u32x4*)(K + off); vv[it] = *(const u32x4*)(V + off); } }
#pragma unroll
          for (int it = 0; it < 5; ++it) { const int idx = it * NTHREADS + C.tid, row = idx >> 3, c = idx & 7;
              if (idx < AT_ROWS * 8) { *(LAS u32x4*)(C.lds + AT_K_OFF + row * AT_KS + c * 16) = kv[it]; *(LAS u32x4*)(C.lds + AT_V_OFF + row * AT_VS + c * 16) = vv[it]; } } }
        const int iq = I0 + C.wave * 16 + n, tok = b * SEQ + iq * dl + r;
        const bf16_t* qp = Q + (size_t)tok * SGW + h * 64 + g * 8;
        const bf16x8 qf0 = *(const bf16x8*)qp, qf1 = *(const bf16x8*)(qp + 32);
        __syncthreads();
        f32x4 o[4]; float mx, l;
        attn_compute<10, true>(C.lds, C.lane, C.wave * 16, qf0, qf1, sdl, I0 + C.wave * 16 - 144, o, mx, l);
        const float inv = 1.0f / l;
#pragma unroll
        for (int db = 0; db < 4; ++db)
            *(u32x2*)(OG + (size_t)tok * SGW + h * 64 + 16 * db + 4 * g) = (u32x2){cvt_pk_bf16(o[db][0] * inv, o[db][1] * inv), cvt_pk_bf16(o[db][2] * inv, o[db][3] * inv)};
        if (g == 0) LSE[tok * 12 + h] = mx + __logf(l);
    }
}
constexpr int SG_GVN_OFF = 1024, SG_VS = 160, SG_TILE = 128 * SG_VS, SG_GB_OFF = SG_GVN_OFF + 6 * SG_TILE;
static_assert(SG_GB_OFF + 2 * 384 * 4 <= 131072, "spatial-gating LDS map");
__device__ __forceinline__ void sg_mfma(const Ctx& C, const Args& A) {
    const bf16_t* U = (const bf16_t*)(C.ws + WS_U); const bf16_t* GV = (const bf16_t*)(C.ws + WS_GV); bf16_t* CAT = (bf16_t*)(C.ws + WS_CAT);
    const bf16_t* WB = (const bf16_t*)(C.ws + WS_SGWB); const float* RS = (const float*)(C.ws + WS_SGRS);
    const float* lng = A.in[4]; const float* lnb = A.in[5]; const float* sgb = A.in[7];
    LAS float* stat = (LAS float*)C.lds; LAS float* gbl = (LAS float*)(C.lds + SG_GB_OFF);
    const int n = C.lane & 15, gl = C.lane >> 4;
    for (int unit = C.bid; unit < NB * 16 * 2; unit += C.G) {
        const int tb = (unit >> 1) * 128, g0 = (unit & 1) * 6;
        __syncthreads();
        u32x4 wt[12];
#pragma unroll
        for (int k = 0; k < 12; ++k) { const int rg = k * 64 + (C.tid >> 3), gi = rg >> 7, row = rg & 127, c = C.tid & 7;
            wt[k] = *(const u32x4*)(GV + (size_t)(tb + row) * SGW + (g0 + gi) * 64 + c * 8); }
        if (C.tid < 192) { const int half = C.tid / 96, i4 = C.tid % 96; *(LAS f32x4*)(gbl + half * 384 + 4 * i4) = *(const f32x4*)((half ? lnb : lng) + g0 * 64 + 4 * i4); }
        for (int r8 = 0; r8 < 16; r8 += 8) {
            u32x2 w[8][3];
#pragma unroll
            for (int q = 0; q < 8; ++q)
#pragma unroll
                for (int j = 0; j < 3; ++j) w[q][j] = *(const u32x2*)(GV + (size_t)(tb + C.wave * 16 + r8 + q) * SGW + 4 * C.lane + 256 * j);
#pragma unroll
            for (int q = 0; q < 8; ++q) { float s = 0.f, ss = 0.f;
#pragma unroll
                for (int j = 0; j < 3; ++j) { const float a = bflo(w[q][j].x), b = bfhi(w[q][j].x), c = bflo(w[q][j].y), d = bfhi(w[q][j].y);
                    s += (a + b) + (c + d); ss += (a * a + b * b) + (c * c + d * d); }
                s = wave_sum_dpp(s); ss = wave_sum_dpp(ss);
                const float mean = s * (1.f / SGW), var = ss * (1.f / SGW) - mean * mean; const int row = C.wave * 16 + r8 + q;
                if (C.lane == 0) { stat[row * 2] = mean; stat[row * 2 + 1] = 1.0f / sqrtf(var + LN_EPS); } } }
        __syncthreads();
#pragma unroll
        for (int k = 0; k < 12; ++k) { const int rg = k * 64 + (C.tid >> 3), gi = rg >> 7, row = rg & 127, c = C.tid & 7;
            const float mean = stat[row * 2], rstd = stat[row * 2 + 1]; u32x4 o;
            o.x = cvt_pk_bf16((bflo(wt[k].x) - mean) * rstd, (bfhi(wt[k].x) - mean) * rstd); o.y = cvt_pk_bf16((bflo(wt[k].y) - mean) * rstd, (bfhi(wt[k].y) - mean) * rstd);
            o.z = cvt_pk_bf16((bflo(wt[k].z) - mean) * rstd, (bfhi(wt[k].z) - mean) * rstd); o.w = cvt_pk_bf16((bflo(wt[k].w) - mean) * rstd, (bfhi(wt[k].w) - mean) * rstd);
            *(LAS u32x4*)(C.lds + SG_GVN_OFF + gi * SG_TILE + row * SG_VS + c * 16) = o; }
        __syncthreads();
        const int p = C.wave * 16 + n;
#pragma unroll 3
        for (int gi = 0; gi < 6; ++gi) {
            const int g = g0 + gi;
            const bf16_t* wp = WB + (size_t)(g * 128 + p) * 128 + 8 * gl;
            bf16x8 wf[4];
#pragma unroll
            for (int ks = 0; ks < 4; ++ks) wf[ks] = *(const bf16x8*)(wp + 32 * ks);
            u32x2 uw[4];
#pragma unroll
            for (int db = 0; db < 4; ++db) uw[db] = *(const u32x2*)(U + (size_t)(tb + p) * SGW + (size_t)g * 64 + 16 * db + 4 * gl);
            const float bs = sgb[g * 128 + p], rsw = RS[g * 128 + p];
            f32x4 acc[4];
#pragma unroll
            for (int db = 0; db < 4; ++db) acc[db] = (f32x4){0.f, 0.f, 0.f, 0.f};
            const LAS unsigned char* vb = C.lds + SG_GVN_OFF + gi * SG_TILE + (8 * gl + (n >> 2)) * SG_VS + (n & 3) * 8;
#pragma unroll
            for (int ks = 0; ks < 4; ++ks)
#pragma unroll
                for (int db = 0; db < 4; ++db) {
                    const s16x4 v0 = __builtin_amdgcn_ds_read_tr16_b64_v4i16((LAS s16x4*)(vb + ks * 32 * SG_VS + db * 32));
                    const s16x4 v1 = __builtin_amdgcn_ds_read_tr16_b64_v4i16((LAS s16x4*)(vb + ks * 32 * SG_VS + 4 * SG_VS + db * 32));
                    const bf16x8 vf = __builtin_shufflevector(v0, v1, 0, 1, 2, 3, 4, 5, 6, 7);
                    acc[db] = __builtin_amdgcn_mfma_f32_16x16x32_bf16(vf, wf[ks], acc[db], 0, 0, 0);
                }
#pragma unroll
            for (int db = 0; db < 4; ++db) { const int cl = gi * 64 + 16 * db + 4 * gl; const size_t co = (size_t)g * 64 + 16 * db + 4 * gl;
                const f32x4 ga = *(const LAS f32x4*)(gbl + cl), be = *(const LAS f32x4*)(gbl + 384 + cl);
                const float s0 = ga[0] * acc[db][0] + (be[0] * rsw + bs), s1 = ga[1] * acc[db][1] + (be[1] * rsw + bs);
                const float s2 = ga[2] * acc[db][2] + (be[2] * rsw + bs), s3 = ga[3] * acc[db][3] + (be[3] * rsw + bs);
                *(u32x2*)(CAT + (size_t)(tb + p) * D + co) = (u32x2){cvt_pk_bf16(bflo(uw[db].x) * s0, bfhi(uw[db].x) * s1), cvt_pk_bf16(bflo(uw[db].y) * s2, bfhi(uw[db].y) * s3)}; }
        }
    }
}
__device__ __forceinline__ void dil_merge(const Ctx& C, const Args& A) {
    const bf16_t* OG = (const bf16_t*)(C.ws + WS_OG); const float* LSE = (const float*)(C.ws + WS_LSE); bf16_t* CAT2 = (bf16_t*)(C.ws + WS_CAT2);
    const int gt = C.bid * NTHREADS + C.tid, NT = C.G * NTHREADS;
    for (int it = gt; it < T * 32; it += NT) {
        const int tok = it >> 5, j = (it >> 3) & 3, c8 = it & 7;
        const float l0 = LSE[tok * 12 + j], l1 = LSE[tok * 12 + 4 + j], l2 = LSE[tok * 12 + 8 + j];
        const float mx = fmaxf(l0, fmaxf(l1, l2));
        float w0 = __expf(l0 - mx), w1 = __expf(l1 - mx), w2 = __expf(l2 - mx); const float inv = 1.0f / (w0 + w1 + w2); w0 *= inv; w1 *= inv; w2 *= inv;
        const u32x4 a = *(const u32x4*)(OG + (size_t)tok * SGW + j * 64 + c8 * 8), b = *(const u32x4*)(OG + (size_t)tok * SGW + (4 + j) * 64 + c8 * 8), c = *(const u32x4*)(OG + (size_t)tok * SGW + (8 + j) * 64 + c8 * 8);
        u32x4 o;
        o.x = pk2(w0 * bflo(a.x) + w1 * bflo(b.x) + w2 * bflo(c.x), w0 * bfhi(a.x) + w1 * bfhi(b.x) + w2 * bfhi(c.x));
        o.y = pk2(w0 * bflo(a.y) + w1 * bflo(b.y) + w2 * bflo(c.y), w0 * bfhi(a.y) + w1 * bfhi(b.y) + w2 * bfhi(c.y));
        o.z = pk2(w0 * bflo(a.z) + w1 * bflo(b.z) + w2 * bflo(c.z), w0 * bfhi(a.z) + w1 * bfhi(b.z) + w2 * bfhi(c.z));
        o.w = pk2(w0 * bflo(a.w) + w1 * bflo(b.w) + w2 * bflo(c.w), w0 * bfhi(a.w) + w1 * bfhi(b.w) + w2 * bfhi(c.w));
        *(u32x4*)(CAT2 + (size_t)tok * 512 + j * 64 + c8 * 8) = o;
    }
}

constexpr int LR_WS = 2064;
__device__ __forceinline__ void ln_route(const Ctx& C, const Args& A, int layer, int cset) {
    const float* Y = (const float*)(C.ws + WS_Y); bf16_t* X1B = (bf16_t*)(C.ws + WS_X1B); unsigned char* X1F8 = C.ws + WS_X1F8;
    const float* lg = A.in[14] + layer * D; const float* lb = A.in[15] + layer * D; const float* br = A.in[19];
    unsigned* cnt = (unsigned*)(C.ws + WS_CTL) + CW_CNT + cset * 16 * 64;
    int* tokE = (int*)(C.ws + WS_TOKE); int* tokP = (int*)(C.ws + WS_TOKP); float* tokG = (float*)(C.ws + WS_TOKG); int* list = (int*)(C.ws + WS_LIST);
    LAS unsigned char* wl = C.lds;
    LAS int* sE = (LAS int*)(C.lds + 65536); LAS float* sG = (LAS float*)(C.lds + 65536 + 512); LAS int* sPos = (LAS int*)(C.lds + 65536 + 1024);
    LAS int* lcnt = (LAS int*)(C.lds + 65536 + 1536); LAS int* lbase = (LAS int*)(C.lds + 65536 + 1600); LAS float* slog = (LAS float*)(C.lds + 65536 + 2048);
    __syncthreads();
#pragma unroll
    for (int it = 0; it < 4; ++it) { const int i = it * NTHREADS + C.tid, e = i >> 7, c = i & 127;
        *(LAS u32x4*)(wl + e * LR_WS + c * 16) = *(const u32x4*)((const bf16_t*)(C.ws + WS_WRT) + (size_t)e * 1024 + c * 8); }
    f32x4 g4[4], b4[4];
#pragma unroll
    for (int j = 0; j < 4; ++j) { g4[j] = *(const f32x4*)(lg + 4 * C.lane + 256 * j); b4[j] = *(const f32x4*)(lb + 4 * C.lane + 256 * j); }
    const int n = C.lane & 15, q = C.lane >> 4;
    for (int blk = C.bid; blk < T / 64; blk += C.G) {
        __syncthreads();
        if (C.tid < 16) lcnt[C.tid] = 0;
        f32x4 nv[4];
        { const f32x4* yb = (const f32x4*)(Y + (size_t)(blk * 64 + C.wave * 8) * D) + C.lane;
#pragma unroll
          for (int j = 0; j < 4; ++j) nv[j] = yb[64 * j]; }
#pragma unroll 1
        for (int tq = 0; tq < 8; ++tq) {
            const int tok = blk * 64 + C.wave * 8 + tq;
            f32x4 v[4]; float s = 0.f;
#pragma unroll
            for (int j = 0; j < 4; ++j) { v[j] = nv[j]; s += (v[j][0] + v[j][1]) + (v[j][2] + v[j][3]); }
            { const f32x4* yb = (const f32x4*)(Y + (size_t)(tok + (tq < 7 ? 1 : 0)) * D) + C.lane;
#pragma unroll
              for (int j = 0; j < 4; ++j) nv[j] = yb[64 * j]; }
            const float mean = wave_sum_dpp(s) * (1.f / D); float s2 = 0.f;
#pragma unroll
            for (int j = 0; j < 4; ++j) { v[j] = v[j] - mean; s2 += (v[j][0] * v[j][0] + v[j][1] * v[j][1]) + (v[j][2] * v[j][2] + v[j][3] * v[j][3]); }
            const float rstd = 1.0f / sqrtf(wave_sum_dpp(s2) * (1.f / D) + LN_EPS);
            u32x2* xb = (u32x2*)(X1B + (size_t)tok * D) + C.lane; unsigned* x8 = (unsigned*)(X1F8 + (size_t)tok * D) + C.lane;
#pragma unroll
            for (int j = 0; j < 4; ++j) { v[j] = v[j] * rstd * g4[j] + b4[j];
                xb[64 * j] = (u32x2){pk2(v[j][0], v[j][1]), pk2(v[j][2], v[j][3])};
                x8[64 * j] = pk4_fp8(v[j][0], v[j][1], v[j][2], v[j][3]); }
        }
        asm volatile("s_waitcnt vmcnt(0)" ::: "memory");
        __syncthreads();
        {
            const int tile = C.wave & 3, kh = C.wave >> 2;
            const bf16_t* ap = X1B + (size_t)(blk * 64 + tile * 16 + n) * D + kh * 512 + 8 * q;
            const LAS unsigned char* bp = wl + n * LR_WS + (kh * 512 + 8 * q) * 2;
            bf16x8 af[16];
#pragma unroll
            for (int ks = 0; ks < 16; ++ks) af[ks] = *(const bf16x8*)(ap + 32 * ks);
            f32x4 acc = (f32x4){0.f, 0.f, 0.f, 0.f};
#pragma unroll
            for (int ks = 0; ks < 16; ++ks) { const bf16x8 bf = *(const LAS bf16x8*)(bp + 64 * ks); acc = __builtin_amdgcn_mfma_f32_16x16x32_bf16(af[ks], bf, acc, 0, 0, 0); }
#pragma unroll
            for (int r = 0; r < 4; ++r) slog[(kh * 64 + tile * 16 + 4 * q + r) * 17 + n] = acc[r];
        }
        __syncthreads();
        if (C.tid < 64) {
            const int tl = C.tid;
            float pr[16]; float mx = -INFINITY;
#pragma unroll
            for (int e = 0; e < 16; ++e) { pr[e] = slog[tl * 17 + e] + slog[(64 + tl) * 17 + e]; mx = fmaxf(mx, pr[e]); }
            float sum = 0.f;
#pragma unroll
            for (int e = 0; e < 16; ++e) { pr[e] = __expf(pr[e] - mx); sum += pr[e]; }
            const float inv = 1.0f / sum; float sel[16];
#pragma unroll
            for (int e = 0; e < 16; ++e) { pr[e] *= inv; sel[e] = pr[e] + br[e]; }
            float gs[4];
#pragma unroll
            for (int g = 0; g < 4; ++g) { const float a = sel[4 * g], b = sel[4 * g + 1], c = sel[4 * g + 2], d = sel[4 * g + 3];
                gs[g] = fmaxf(fmaxf(fmaxf(a + b, a + c), fmaxf(a + d, b + c)), fmaxf(b + d, c + d)); }
            int gi = 0; float bsc = gs[0];
#pragma unroll
            for (int g = 1; g < 4; ++g) if (gs[g] > bsc) { bsc = gs[g]; gi = g; }
            float sg[4], pg[4];
#pragma unroll
            for (int k = 0; k < 4; ++k) { sg[k] = gi == 0 ? sel[k] : (gi == 1 ? sel[4 + k] : (gi == 2 ? sel[8 + k] : sel[12 + k])); pg[k] = gi == 0 ? pr[k] : (gi == 1 ? pr[4 + k] : (gi == 2 ? pr[8 + k] : pr[12 + k])); }
            int i1 = 0; float b1 = sg[0], p1 = pg[0];
#pragma unroll
            for (int k = 1; k < 4; ++k) if (sg[k] > b1) { b1 = sg[k]; i1 = k; p1 = pg[k]; }
            int i2 = -1; float b2 = -INFINITY, p2 = 0.f;
#pragma unroll
            for (int k = 0; k < 4; ++k) if (k != i1 && sg[k] > b2) { b2 = sg[k]; i2 = k; p2 = pg[k]; }
            const float gsum = p1 + p2; sE[tl * 2] = gi * 4 + i1; sE[tl * 2 + 1] = gi * 4 + i2; sG[tl * 2] = p1 / gsum; sG[tl * 2 + 1] = p2 / gsum;
        }
        __syncthreads();
        if (C.tid < 128) sPos[C.tid] = __hip_atomic_fetch_add(lcnt + sE[C.tid], 1, __ATOMIC_RELAXED, __HIP_MEMORY_SCOPE_WORKGROUP);
        __syncthreads();
        if (C.tid < 16) lbase[C.tid] = (int)__hip_atomic_fetch_add(cnt + C.tid * 64, (unsigned)lcnt[C.tid], __ATOMIC_RELAXED, __HIP_MEMORY_SCOPE_AGENT);
        __syncthreads();
        if (C.tid < 128) { const int e = sE[C.tid], pos = lbase[e] + sPos[C.tid], tok = blk * 64 + (C.tid >> 1);
            list[e * LISTCAP + pos] = tok; tokE[tok * 2 + (C.tid & 1)] = e; tokP[tok * 2 + (C.tid & 1)] = pos; tokG[tok * 2 + (C.tid & 1)] = sG[C.tid]; }
    }
}
__device__ __forceinline__ void moe_prefix(const Ctx& C, int layer) {
    LAS int* mi = (LAS int*)(C.lds + LDS_MISC);
    unsigned* cnt = (unsigned*)(C.ws + WS_CTL) + CW_CNT + layer * 16 * 64;
    __syncthreads();
    if (C.tid < 16) mi[17 + C.tid] = (int)__hip_atomic_load(cnt + C.tid * 64, __ATOMIC_RELAXED, __HIP_MEMORY_SCOPE_AGENT);
    __syncthreads();
    if (C.tid == 0) { int a = 0; for (int e = 0; e < 16; ++e) { mi[e] = a; a += (mi[17 + e] + 255) >> 8; } mi[16] = a; }
    __syncthreads();
}
__device__ __forceinline__ void moe_tokens(const Ctx& C, int ntn) {
    const LAS int* mi = (const LAS int*)(C.lds + LDS_MISC); LAS int* toks = (LAS int*)(C.lds + LDS_TOKS);
    const int* list = (const int*)(C.ws + WS_LIST);
    for (int u = 0; u < MAX_UNITS; ++u) {
        const int L = u * C.G + C.bid; if (L >= mi[16] * ntn) break;
        int e = 0;
#pragma unroll
        for (int j = 1; j < 16; ++j) e += (L >= mi[j] * ntn) ? 1 : 0;
        const int r = L - mi[e] * ntn, te = mi[e + 1] - mi[e], mt = r % te, cn = mi[17 + e];
        if (C.tid < 256) { int pos = mt * 256 + C.tid; pos = pos < cn ? pos : cn - 1; toks[u * 256 + C.tid] = list[e * LISTCAP + pos]; }
    }
    __syncthreads();
}
__device__ __forceinline__ void combine_ln2(const Ctx& C, const Args& A, int layer) {
    const LAS int* mi = (const LAS int*)(C.lds + LDS_MISC);
    const bf16_t* X1B = (const bf16_t*)(C.ws + WS_X1B); const bf16_t* YD = (const bf16_t*)(C.ws + WS_YD); bf16_t* X2B = (bf16_t*)(C.ws + WS_XB);
    const int* tokE = (const int*)(C.ws + WS_TOKE); const int* tokP = (const int*)(C.ws + WS_TOKP); const float* tokG = (const float*)(C.ws + WS_TOKG);
    const float* lg = A.in[16] + layer * D; const float* lb = A.in[17] + layer * D;
    for (int tok0 = C.gw * 8; tok0 < T; tok0 += C.NGW * 8) {
        int rowv = 0; float gv = 0.f;
        if (C.lane < 16) { const int e = tokE[tok0 * 2 + C.lane]; rowv = mi[e] * 256 + tokP[tok0 * 2 + C.lane]; gv = tokG[tok0 * 2 + C.lane]; }
#pragma unroll 1
        for (int tq = 0; tq < 8; tq += 2) {
            u32x2 xa[2][4], y0[2][4], y1[2][4]; float g0[2], g1[2];
#pragma unroll
            for (int t = 0; t < 2; ++t) {
                const int r0 = __builtin_amdgcn_readlane(rowv, 0), dummy = 0; (void)dummy; (void)r0;
                const int ra = __shfl(rowv, 2 * (tq + t)), rb = __shfl(rowv, 2 * (tq + t) + 1);
                g0[t] = __shfl(gv, 2 * (tq + t)); g1[t] = __shfl(gv, 2 * (tq + t) + 1);
                const u32x2* xp = (const u32x2*)(X1B + (size_t)(tok0 + tq + t) * D) + C.lane; const u32x2* pa = (const u32x2*)(YD + (size_t)ra * D) + C.lane; const u32x2* pb = (const u32x2*)(YD + (size_t)rb * D) + C.lane;
#pragma unroll
                for (int j = 0; j < 4; ++j) { xa[t][j] = xp[64 * j]; y0[t][j] = pa[64 * j]; y1[t][j] = pb[64 * j]; }
            }
#pragma unroll
            for (int t = 0; t < 2; ++t) {
                f32x4 v[4]; float s = 0.f;
#pragma unroll
                for (int j = 0; j < 4; ++j) {
                    v[j][0] = ALPHA * bflo(xa[t][j].x) + (g0[t] * bflo(y0[t][j].x) + g1[t] * bflo(y1[t][j].x)); v[j][1] = ALPHA * bfhi(xa[t][j].x) + (g0[t] * bfhi(y0[t][j].x) + g1[t] * bfhi(y1[t][j].x));
                    v[j][2] = ALPHA * bflo(xa[t][j].y) + (g0[t] * bflo(y0[t][j].y) + g1[t] * bflo(y1[t][j].y)); v[j][3] = ALPHA * bfhi(xa[t][j].y) + (g0[t] * bfhi(y0[t][j].y) + g1[t] * bfhi(y1[t][j].y));
                    s += (v[j][0] + v[j][1]) + (v[j][2] + v[j][3]); }
                const float mean = wave_sum_dpp(s) * (1.f / D); float s2 = 0.f;
#pragma unroll
                for (int j = 0; j < 4; ++j) { v[j] = v[j] - mean; s2 += (v[j][0] * v[j][0] + v[j][1] * v[j][1]) + (v[j][2] * v[j][2] + v[j][3] * v[j][3]); }
                const float rstd = 1.0f / sqrtf(wave_sum_dpp(s2) * (1.f / D) + LN_EPS);
                const int tok = tok0 + tq + t;
#pragma unroll
                for (int j = 0; j < 4; ++j) { const int col = 4 * C.lane + 256 * j; const f32x4 g4 = *(const f32x4*)(lg + col), b4 = *(const f32x4*)(lb + col);
                    const f32x4 o = v[j] * rstd * g4 + b4;
                    if (layer == 0) *(u32x2*)(X2B + (size_t)tok * D + col) = (u32x2){pk2(o[0], o[1]), pk2(o[2], o[3])};
                    else *(f32x4*)(A.out + (size_t)tok * D + col) = o; }
            }
        }
    }
}

__global__ void __launch_bounds__(NTHREADS, 2) yoco_fwd(Args args) {
    extern __shared__ __attribute__((aligned(16))) unsigned char lds_raw[];
    Ctx C;
    C.ws = args.ws; C.lds = (LAS unsigned char*)lds_raw;
    C.tid = threadIdx.x; C.lane = C.tid & 63; C.wave = __builtin_amdgcn_readfirstlane(C.tid >> 6);
    C.G = gridDim.x; C.bid = blockIdx.x; C.gw = C.bid * NWAVES + C.wave; C.NGW = C.G * NWAVES;
    unsigned char* ws = args.ws;
#define PHASE_WS() do { ws = launder(args.ws); C.ws = ws; C.tid = launder_v((int)threadIdx.x); C.lane = C.tid & 63; } while (0)
    volatile LAS unsigned* misc = (volatile LAS unsigned*)(C.lds + LDS_MISC);
    for (int u = C.tid; u < 64; u += NTHREADS) misc[u] = 0u;
    __syncthreads();
    XcdBarrier bar; bar.bar = (unsigned*)(ws + WS_CTL) + CW_BAR; bar.x = 0; bar.st = misc + 60;
    const int lo = args.ph_lo, hi = args.ph_hi;
    if (hi - lo > 1) bar = xcd_barrier_post((unsigned*)(ws + WS_CTL) + CW_BAR, misc + 60);
#define IN(k) (lo <= (k) && (k) < hi)
#define SEAMF(k) do { if (IN(k) && IN((k) + 1)) { PHASE_WS(); fill_tail(C, args, (k), false); xcd_barrier(bar); } } while (0)
#if MK_DIAG == 9
#define SEAM(k) do { if (IN(k) && IN((k) + 1)) { const unsigned long long t0_ = __builtin_amdgcn_s_memrealtime(); xcd_barrier(bar); if (((MK_DIAGMASK >> (k)) & 1) && threadIdx.x == 0) diag_acc += (unsigned)(__builtin_amdgcn_s_memrealtime() - t0_); } } while (0)
#else
#define SEAM(k) do { if (IN(k) && IN((k) + 1)) xcd_barrier(bar); } while (0)
#endif
#ifndef MK_DUP
#define MK_DUP 0
#endif
    unsigned diag_acc = 0;
#if MK_DIAG == 10
#define TREG(id, ...) do { __syncthreads(); const unsigned long long t0_ = __builtin_amdgcn_s_memrealtime(); __VA_ARGS__; __syncthreads(); if ((id) == MK_DIAGSEL) diag_acc += (unsigned)(__builtin_amdgcn_s_memrealtime() - t0_); } while (0)
#else
#define TREG(id, ...) do { __VA_ARGS__; } while (0)
#endif
#define REP(k) for (int rep_ = 0; rep_ < 1 + ((MK_DUP >> (k)) & 1); ++rep_)

    if (IN(0)) { REP(0) { PHASE_WS(); TREG(10, p0_prologue(C, args)); } SEAM(0); }

    if (IN(1)) {
        REP(1) {
        PHASE_WS();
        { pg8::Gemm g{(const bf16_t*)(ws + WS_XB), (const bf16_t*)(ws + WS_BT_INA), T, 1792, D}; pg8::StaticOrder S; S.init(T, 1792, C.G, C.bid);
          EpiProjA E{(bf16_t*)(ws + WS_U), (bf16_t*)(ws + WS_GV), (bf16_t*)(ws + WS_QM0)};
          pg8::gemm_phase<EpiProjA, pg8::StaticOrder>(C.lds, g, S, E, nullptr, C.tid); }
        { pg8::Gemm g{(const bf16_t*)(ws + WS_MEMB), (const bf16_t*)(ws + WS_BT_MEM), NB * NMEM, 1024, D}; SmallOrder S{4, 32, C.bid - (C.G - 32)};
          EpiPlain E{(bf16_t*)(ws + WS_MKV), 1024, 4};
          pg8::gemm_phase<EpiPlain, SmallOrder>(C.lds, g, S, E, nullptr, C.tid); }
        }
        SEAMF(1);
    }
    if (IN(2)) {
        REP(2) { PHASE_WS();
        TREG(1, sg_mfma(C, args));
        TREG(2, memattn_mfma(C, (const bf16_t*)(ws + WS_QM0), (const bf16_t*)(ws + WS_MKV), 0, 256, (bf16_t*)(ws + WS_CAT), D, SGW)); }
        SEAM(2);
    }
    if (IN(3)) {
        REP(3) { PHASE_WS();
        pg8::Gemm g{(const bf16_t*)(ws + WS_CAT), (const bf16_t*)(ws + WS_BT_OUTA), T, D, D}; pg8::StaticOrder S; S.init(T, D, C.G, C.bid);
        EpiResid<false> E{(const void*)args.in[0], (float*)(ws + WS_Y)};
        pg8::gemm_phase<EpiResid<false>, pg8::StaticOrder>(C.lds, g, S, E, nullptr, C.tid); }
        SEAM(3);
    }
    { constexpr int layer = 0;
        const int pb = 4 + 8 * layer;
        if (IN(pb)) { if ((MK_DUP >> 4) & 1) { PHASE_WS(); ln_route(C, args, layer, 2 + layer); __syncthreads(); } PHASE_WS(); TREG(6 + layer, ln_route(C, args, layer, layer)); SEAM(pb); }
        if (IN(pb + 1)) {
            REP(5) { PHASE_WS();
            moe_prefix(C, layer); moe_tokens(C, 8);
            MoeGatherOrder S; S.tb = (const LAS int*)(C.lds + LDS_MISC); S.ntn = 8; S.G = C.G; S.c = C.bid; S.toks = (const LAS int*)(C.lds + LDS_TOKS);
            {
                pg8::Gemm g{(const bf16_t*)(ws + WS_X1F8), (const bf16_t*)(ws + WS_WGU + (size_t)layer * (64 * MiB)), 0, 0, D / 2, E8_ONE, E8_W};
                EpiSwiGLU8 E{ws + WS_ACT};
                pg8::gemm_phase<EpiSwiGLU8, MoeGatherOrder, false, true>(C.lds, g, S, E, nullptr, C.tid);
            } }
            SEAMF(pb + 1);
        }
        if (IN(pb + 2)) {
            REP(6) { PHASE_WS();
            moe_prefix(C, layer);
            MoeOrder S{(const LAS int*)(C.lds + LDS_MISC), 4, C.G, C.bid};
            EpiPlain E{(bf16_t*)(ws + WS_YD), 1024, 4};
            {
                pg8::Gemm g{(const bf16_t*)(ws + WS_ACT), (const bf16_t*)(ws + WS_WD + (size_t)layer * (32 * MiB)), 0, 0, D / 2, E8_ACT, E8_W};
                pg8::gemm_phase<EpiPlain, MoeOrder, false, true>(C.lds, g, S, E, nullptr, C.tid);
            } }
            SEAMF(pb + 2);
        }
        if (IN(pb + 3)) { REP(7) { PHASE_WS(); moe_prefix(C, layer); TREG(8 + layer, combine_ln2(C, args, layer)); } if (layer == 0) SEAM(pb + 3); }
    }
    {
            if (IN(8)) {
                REP(8) { PHASE_WS();
                pg8::Gemm g{(const bf16_t*)(ws + WS_XB), (const bf16_t*)(ws + WS_BT_B), T, 2560, D}; pg8::StaticOrder S; S.init(T, 2560, C.G, C.bid);
                EpiProjB E{(bf16_t*)(ws + WS_K), (bf16_t*)(ws + WS_V), (bf16_t*)(ws + WS_Q), (bf16_t*)(ws + WS_QM1)};
                pg8::gemm_phase<EpiProjB, pg8::StaticOrder>(C.lds, g, S, E, nullptr, C.tid); }
                SEAMF(8);
            }
            if (IN(9)) {
                REP(9) { PHASE_WS();
                TREG(3, dilattn_mfma(C));
                TREG(4, memattn_mfma(C, (const bf16_t*)(ws + WS_QM1), (const bf16_t*)(ws + WS_MKV), 512, 768, (bf16_t*)(ws + WS_CAT2), 512, 256)); }
                SEAM(9);
            }
            if (IN(10)) { REP(10) { PHASE_WS(); TREG(5, dil_merge(C, args)); } SEAM(10); }
            if (IN(11)) {
                REP(11) { PHASE_WS();
                pg8::Gemm g{(const bf16_t*)(ws + WS_CAT2), (const bf16_t*)(ws + WS_BT_OUTB), T, D, 512}; pg8::StaticOrder S; S.init(T, D, C.G, C.bid);
                EpiResid<true> E{(const void*)(ws + WS_XB), (float*)(ws + WS_Y)};
                pg8::gemm_phase<EpiResid<true>, pg8::StaticOrder>(C.lds, g, S, E, nullptr, C.tid); }
                if (IN(11)) { PHASE_WS(); fill_tail(C, args, 11, true); }
                SEAM(11);
            }
    }
    { constexpr int layer = 1;
        const int pb = 4 + 8 * layer;
        if (IN(pb)) { if ((MK_DUP >> 4) & 1) { PHASE_WS(); ln_route(C, args, layer, 2 + layer); __syncthreads(); } PHASE_WS(); TREG(6 + layer, ln_route(C, args, layer, layer)); SEAM(pb); }
        if (IN(pb + 1)) {
            REP(5) { PHASE_WS();
            moe_prefix(C, layer); moe_tokens(C, 8);
            MoeGatherOrder S; S.tb = (const LAS int*)(C.lds + LDS_MISC); S.ntn = 8; S.G = C.G; S.c = C.bid; S.toks = (const LAS int*)(C.lds + LDS_TOKS);
            {
                pg8::Gemm g{(const bf16_t*)(ws + WS_X1F8), (const bf16_t*)(ws + WS_WGU + (size_t)layer * (64 * MiB)), 0, 0, D / 2, E8_ONE, E8_W};
                EpiSwiGLU8 E{ws + WS_ACT};
                pg8::gemm_phase<EpiSwiGLU8, MoeGatherOrder, false, true>(C.lds, g, S, E, nullptr, C.tid);
            } }
            SEAM(pb + 1);
        }
        if (IN(pb + 2)) {
            REP(6) { PHASE_WS();
            moe_prefix(C, layer);
            MoeOrder S{(const LAS int*)(C.lds + LDS_MISC), 4, C.G, C.bid};
            EpiPlain E{(bf16_t*)(ws + WS_YD), 1024, 4};
            {
                pg8::Gemm g{(const bf16_t*)(ws + WS_ACT), (const bf16_t*)(ws + WS_WD + (size_t)layer * (32 * MiB)), 0, 0, D / 2, E8_ACT, E8_W};
                pg8::gemm_phase<EpiPlain, MoeOrder, false, true>(C.lds, g, S, E, nullptr, C.tid);
            } }
            SEAM(pb + 2);
        }
        if (IN(pb + 3)) { REP(7) { PHASE_WS(); moe_prefix(C, layer); TREG(8 + layer, combine_ln2(C, args, layer)); } if (layer == 0) SEAM(pb + 3); }
    }
#if MK_DIAG == 3
    xcd_barrier(bar);
    if (blockIdx.x == 0 && threadIdx.x == 0) { const unsigned got = __hip_atomic_fetch_add((unsigned*)(args.ws + WS_CTL) + 30000, 0u, __ATOMIC_RELAXED, __HIP_MEMORY_SCOPE_AGENT); const unsigned long long t0 = __builtin_amdgcn_s_memrealtime();
        const unsigned long long dur = (unsigned long long)got * 4ull;
        while (__builtin_amdgcn_s_memrealtime() - t0 < dur) __builtin_amdgcn_s_sleep(8); }
#endif
#if MK_DIAG == 11
    if (blockIdx.x == 0 && threadIdx.x == 0) { const unsigned long long t0 = __builtin_amdgcn_s_memrealtime(); const unsigned long long dur = (unsigned long long)misc[42] * 4ull;
        while (__builtin_amdgcn_s_memrealtime() - t0 < dur) __builtin_amdgcn_s_sleep(8); }
#endif
#if MK_DIAG == 10
    if (blockIdx.x == 0 && threadIdx.x == 0) { const unsigned long long t0 = __builtin_amdgcn_s_memrealtime(); const unsigned long long dur = (unsigned long long)diag_acc * 4ull;
        while (__builtin_amdgcn_s_memrealtime() - t0 < dur) __builtin_amdgcn_s_sleep(8); }
#endif
#if MK_DIAG == 9
    if (threadIdx.x == 0) __hip_atomic_fetch_add((unsigned*)(args.ws + WS_CTL) + 30000, diag_acc, __ATOMIC_RELAXED, __HIP_MEMORY_SCOPE_AGENT);
    xcd_barrier(bar);
    if (blockIdx.x == 0 && threadIdx.x == 0) { const unsigned got = __hip_atomic_fetch_add((unsigned*)(args.ws + WS_CTL) + 30000, 0u, __ATOMIC_RELAXED, __HIP_MEMORY_SCOPE_AGENT); const unsigned long long t0 = __builtin_amdgcn_s_memrealtime();
        const unsigned long long dur = (unsigned long long)got / 256ull;
        while (__builtin_amdgcn_s_memrealtime() - t0 < dur) __builtin_amdgcn_s_sleep(8); }
#endif
#undef IN
#undef SEAM
}
}

extern "C" void kernel_launch(void* const* d_in, const int* in_sizes, int n_in, void* d_out, int out_size, void* d_ws, size_t ws_size, hipStream_t stream) {
    using namespace mk;
    static int grid = 0;
    if (grid == 0) {
        if (n_in != 23 || out_size != T * D || ws_size < WS_END) { fprintf(stderr, "kernel_launch: unexpected shapes (n_in %d, out %d, ws %zu)\n", n_in, out_size, ws_size); grid = -1; return; }
        int dev = 0, cus = 0, per_cu = 0;
        if (hipGetDevice(&dev) != hipSuccess || hipDeviceGetAttribute(&cus, hipDeviceAttributeMultiprocessorCount, dev) != hipSuccess) { grid = -1; return; }
        if (hipFuncSetAttribute((const void*)yoco_fwd, hipFuncAttributeMaxDynamicSharedMemorySize, LDS_BYTES) != hipSuccess) { fprintf(stderr, "kernel_launch: hipFuncSetAttribute failed\n"); grid = -1; return; }
        if (hipOccupancyMaxActiveBlocksPerMultiprocessor(&per_cu, (const void*)yoco_fwd, NTHREADS, LDS_BYTES) != hipSuccess || per_cu < 1)
            fprintf(stderr, "kernel_launch: occupancy query reports %d workgroups per CU\n", per_cu);
        (void)hipGetLastError();
        grid = cus;
    }
    if (grid < 0) return;
    (void)hipMemsetAsync((char*)d_ws + WS_CTL, 0, CTL_ZERO_BYTES, stream);
    Args a{};
    for (int i = 0; i < 23; ++i) a.in[i] = (const float*)d_in[i];
    a.out = (float*)d_out; a.ws = (unsigned char*)d_ws;
    constexpr int NL = MK_N_LAUNCHES;
    for (int li = 0; li < NL; ++li) {
        a.ph_lo = (NL == NPHASE) ? li : (li * NPHASE) / NL; a.ph_hi = (NL == NPHASE) ? li + 1 : ((li + 1) * NPHASE) / NL;
        hipLaunchKernelGGL(yoco_fwd, dim3(grid), dim3(NTHREADS), LDS_BYTES, stream, a);
    }
}
```

```cpp
#include <hip/hip_runtime.h>
#include <cstdio>
#include <cstdint>
namespace pg8 {
#define PG8_LAS __attribute__((address_space(3)))
typedef unsigned short bf16_t;
typedef short bf16x8 __attribute__((ext_vector_type(8)));
typedef float f32x4 __attribute__((ext_vector_type(4)));
typedef unsigned u32x4 __attribute__((ext_vector_type(4)));
constexpr int BM = 256, BK = 64, HALF = 128, HTB = HALF * BK * 2  , STAGE_BYTES = 8 * HTB, NXCD = 8, WGM = 8;

__host__ __device__ __forceinline__ int lds_byte(int r, int c) { const int st = (r >> 4) * 2 + (c >> 5), rr = r & 15, cc = c & 31, ob = rr * 64 + cc * 2; return st * 1024 + (ob ^ (((ob >> 9) & 1) << 5)); }
__host__ __device__ __forceinline__ void stage_rc(int b, int& R, int& C) { const int st = b / 1024, sb = b % 1024, swz = sb ^ (((sb >> 9) & 1) << 5); R = (st >> 1) * 16 + swz / 64; C = (st & 1) * 32 + (swz % 64) / 2; }
__host__ __device__ __forceinline__ int perm32(int rho) { const int n = rho >> 4, i = rho & 15; return 8 * (i >> 2) + 4 * n + (i & 3); }

struct Unit { int pm, pn; };
struct Gemm { const bf16_t* A; const bf16_t* Bt; int M, N, K; int sA, sB; };

struct StaticOrder {
    int nM, nN, nwg, G, c;
    __host__ __device__ void init(int M, int N, int G_, int c_) { nM = M / BM; nN = N / BM; nwg = nM * nN; G = G_; c = c_; }
    __host__ __device__ bool next(int i, Unit& u) const {
        const long L = (long)i * G + c; if (L >= nwg) return false;
        int wgid = (int)L; { const int q = nwg / NXCD, r = nwg % NXCD, xcd = wgid % NXCD, off = wgid / NXCD; wgid = (xcd < r ? xcd * (q + 1) : r * (q + 1) + (xcd - r) * q) + off; }
        const int nig = WGM * nN, gid = wgid / nig, fm = gid * WGM, gsz = (nM - fm) < WGM ? (nM - fm) : WGM;
        u.pm = fm + ((wgid % nig) % gsz); u.pn = (wgid % nig) / gsz; return true;
    }
    __device__ __forceinline__ void a_ready(const Unit&) const {}
    __device__ __forceinline__ void done(const Unit&) const {}
    __device__ __forceinline__ int arow(int, const Unit& u, int r) const { return u.pm * BM + r; }
};
__device__ __forceinline__ unsigned cvt_pk_bf16(float lo, float hi) { unsigned r; asm volatile("v_cvt_pk_bf16_f32 %0, %1, %2" : "=v"(r) : "v"(lo), "v"(hi)); return r; }
typedef float f32x2 __attribute__((ext_vector_type(2)));
__device__ __forceinline__ f32x2 gelu_pk(f32x2 v) {
    const f32x2 av = __builtin_elementwise_abs(v), d = av * 0.2316418882f + 1.0f;
    f32x2 t; t.x = __builtin_amdgcn_rcpf(d.x); t.y = __builtin_amdgcn_rcpf(d.y);
    f32x2 q = t * 0.5307027145f + (-0.7265760135f); q = q * t + 0.7107068705f; q = q * t + (-0.142248368f); q = q * t + 0.127414796f; q = q * t;
    const f32x2 s = (v * v) * (-0.72134752044f);
    f32x2 e; e.x = __builtin_amdgcn_exp2f(s.x); e.y = __builtin_amdgcn_exp2f(s.y);
    const f32x2 m = v * (q * e), r = v - m;
    f32x2 o; o.x = v.x < 0.f ? m.x : r.x; o.y = v.y < 0.f ? m.y : r.y; return o;
}
template <class Epi, class Sched, bool STAMP = false, bool F8 = false>
__device__ __forceinline__ void gemm_phase(PG8_LAS unsigned char* lds, const Gemm g, const Sched& S, const Epi& E, unsigned long long* stamps, const int tid) {
    const int wid = __builtin_amdgcn_readfirstlane(tid >> 6), lane = tid & 63, wr = wid >> 2, wc = wid & 3, fr = lane & 15, fq = lane >> 4;
    const int K = g.K, nt = K / BK;
    int ts_lo = 0, ts_hi = 0, nts = 0; const unsigned long long rt_entry = STAMP ? (unsigned long long)wall_clock64() : 0ull;
#define PG8_STAMP() do { if (STAMP && wid == 0 && nts < 64) { const unsigned long long _c = (unsigned long long)clock64(); \
        ts_lo = (lane == nts) ? (int)(unsigned)_c : ts_lo; ts_hi = (lane == nts) ? (int)(unsigned)(_c >> 32) : ts_hi; ++nts; } } while (0)
    PG8_STAMP();
    unsigned colA[2], voffB[2]; int rowA[2];
#pragma unroll
    for (int i = 0; i < 2; ++i) { int R, C; stage_rc(tid * 16 + i * 8192, R, C); const int Rb = Epi::PERM ? ((R & ~31) + perm32(R & 31)) : R;
        rowA[i] = R; colA[i] = (unsigned)C * 2u; voffB[i] = (unsigned)(Rb * K + C) * 2u; }
#define PG8_AOFF(dst, uidx, un) do { _Pragma("unroll") for (int _h = 0; _h < 2; ++_h) _Pragma("unroll") for (int _i = 0; _i < 2; ++_i) \
        dst[_h][_i] = (unsigned)S.arow((uidx), (un), _h * HALF + rowA[_i]) * (unsigned)(K * 2) + colA[_i]; } while (0)
    const size_t kstep = (size_t)(BK * 2);
    const size_t hstep = (size_t)HALF * K * 2;
    const size_t tstep = 2 * hstep;
    const unsigned ldsw = (unsigned)wid * 1024u;
    const int aoff = F8 ? lds_byte(wr * 64 + fr, fq * 16) : lds_byte(wr * 64 + fr, fq * 8), boff = F8 ? lds_byte(wc * 32 + fr, fq * 16) : lds_byte(wc * 32 + fr, fq * 8);
    constexpr int KOFF = F8 ? 16 : 1024;
#define PG8_SA(b, h) (((b) * 2 + (h)) * HTB)
#define PG8_SB(b, h) ((4 + (b) * 2 + (h)) * HTB)
#define PG8_STAGE(bufoff, gbase, voff) do { _Pragma("unroll") for (int _i = 0; _i < 2; ++_i) \
        __builtin_amdgcn_global_load_lds((const unsigned*)((const char*)(gbase) + (voff)[_i]), (PG8_LAS unsigned*)(lds + (bufoff) + ldsw + _i * 8192), 16, 0, 0); } while (0)
#define PG8_LDA(dst, b, h) do { _Pragma("unroll") for (int m = 0; m < 4; ++m) _Pragma("unroll") for (int k = 0; k < 2; ++k) dst[m][k] = *(const PG8_LAS bf16x8*)(lds + PG8_SA(b, h) + aoff + m * 2048 + k * KOFF); } while (0)
#define PG8_LDB(dst, b, h) do { _Pragma("unroll") for (int n = 0; n < 2; ++n) _Pragma("unroll") for (int k = 0; k < 2; ++k) dst[n][k] = *(const PG8_LAS bf16x8*)(lds + PG8_SB(b, h) + boff + n * 2048 + k * KOFF); } while (0)
#define PG8_MMA(ai, bj, At, Bt) do { __builtin_amdgcn_s_setprio(1); \
        if constexpr (F8) { _Pragma("unroll") for (int m = 0; m < 4; ++m) _Pragma("unroll") for (int n = 0; n < 2; ++n) { \
            typedef int i32x4_ __attribute__((ext_vector_type(4))); typedef int i32x8_ __attribute__((ext_vector_type(8))); \
            const i32x8_ b8_ = __builtin_shufflevector(__builtin_bit_cast(i32x4_, Bt[n][0]), __builtin_bit_cast(i32x4_, Bt[n][1]), 0, 1, 2, 3, 4, 5, 6, 7); \
            const i32x8_ a8_ = __builtin_shufflevector(__builtin_bit_cast(i32x4_, At[m][0]), __builtin_bit_cast(i32x4_, At[m][1]), 0, 1, 2, 3, 4, 5, 6, 7); \
            acc[ai][bj][m][n] = __builtin_amdgcn_mfma_scale_f32_16x16x128_f8f6f4(b8_, a8_, acc[ai][bj][m][n], 0, 0, 0, g.sB, 0, g.sA); } } \
        else { _Pragma("unroll") for (int m = 0; m < 4; ++m) _Pragma("unroll") for (int n = 0; n < 2; ++n) _Pragma("unroll") for (int k = 0; k < 2; ++k) \
            acc[ai][bj][m][n] = __builtin_amdgcn_mfma_f32_16x16x32_bf16(Bt[n][k], At[m][k], acc[ai][bj][m][n], 0, 0, 0); } \
        __builtin_amdgcn_s_setprio(0); } while (0)
#define PG8_WAIT_V(n) asm volatile("s_waitcnt vmcnt(" #n ")" ::: "memory")
#define PG8_WAIT_L(n) asm volatile("s_waitcnt lgkmcnt(" #n ")" ::: "memory")
#define PG8_BAR __builtin_amdgcn_s_barrier()
#define PG8_SCHED __builtin_amdgcn_sched_barrier(0)
    Unit cur, nxt; int ui = 0;
    if (!S.next(0, cur)) return;
    f32x4 acc[2][2][4][2];
#pragma unroll
    for (int a = 0; a < 2; ++a)
#pragma unroll
        for (int b = 0; b < 2; ++b)
#pragma unroll
            for (int m = 0; m < 4; ++m)
#pragma unroll
                for (int n = 0; n < 2; ++n) acc[a][b][m][n] = (f32x4){0.f, 0.f, 0.f, 0.f};
    bf16x8 At[4][2], B0[2][2], B1[2][2];
    const char* Ab = (const char*)g.A; const char* cB = (const char*)g.Bt + (size_t)cur.pn * tstep;
    unsigned cuA[2][2];
    S.a_ready(cur);
    PG8_AOFF(cuA, 0, cur);
    PG8_STAGE(PG8_SB(0, 0), cB, voffB); PG8_STAGE(PG8_SA(0, 0), Ab, cuA[0]); PG8_STAGE(PG8_SB(0, 1), cB + hstep, voffB); PG8_STAGE(PG8_SA(0, 1), Ab, cuA[1]);
    if (wr == 1) PG8_BAR;
    PG8_WAIT_V(4); PG8_BAR;
    PG8_STAGE(PG8_SB(1, 0), cB + kstep, voffB); PG8_STAGE(PG8_SA(1, 0), Ab + kstep, cuA[0]); PG8_STAGE(PG8_SB(1, 1), cB + hstep + kstep, voffB);
    PG8_WAIT_V(6); PG8_BAR;
    PG8_STAMP();
    for (;;) {
        const bool has_next = S.next(ui + 1, nxt);
        const char* nB = has_next ? (const char*)g.Bt + (size_t)nxt.pn * tstep : cB;
        for (int t = 0; t < nt; t += 2) {
            const bool last = (t == nt - 2);
            const char* a1 = Ab + (size_t)(t + 1) * kstep;
            const char* a2 = last ? Ab : Ab + (size_t)(t + 2) * kstep; const char* b2 = last ? nB : cB + (size_t)(t + 2) * kstep;
            const char* a3 = a2 + kstep; const char* b3 = b2 + kstep;

            if (last && has_next) S.a_ready(nxt);
            PG8_LDB(B0, 0, 0); PG8_SCHED; PG8_LDA(At, 0, 0); PG8_STAGE(PG8_SA(1, 1), a1, cuA[1]);
            PG8_WAIT_L(8); PG8_BAR; PG8_WAIT_L(0); PG8_MMA(0, 0, At, B0); PG8_BAR; PG8_SCHED;
            if (last && has_next) PG8_AOFF(cuA, ui + 1, nxt);
            PG8_LDB(B1, 0, 1); PG8_STAGE(PG8_SB(0, 0), b2, voffB);
            PG8_BAR; PG8_WAIT_L(0); PG8_MMA(0, 1, At, B1); PG8_BAR;
            PG8_LDA(At, 0, 1); PG8_STAGE(PG8_SA(0, 0), a2, cuA[0]);
            PG8_BAR; PG8_WAIT_L(0); PG8_MMA(1, 0, At, B0); PG8_BAR; PG8_SCHED;
            PG8_STAGE(PG8_SB(0, 1), b2 + hstep, voffB);
            PG8_WAIT_V(6); PG8_BAR; PG8_MMA(1, 1, At, B1); PG8_BAR;
            PG8_LDB(B0, 1, 0); PG8_SCHED; PG8_LDA(At, 1, 0); PG8_STAGE(PG8_SA(0, 1), a2, cuA[1]);
            PG8_WAIT_L(8); PG8_BAR; PG8_WAIT_L(0); PG8_MMA(0, 0, At, B0); PG8_BAR; PG8_SCHED;
            PG8_LDB(B1, 1, 1); PG8_STAGE(PG8_SB(1, 0), b3, voffB);
            PG8_BAR; PG8_WAIT_L(0); PG8_MMA(0, 1, At, B1); PG8_BAR;
            PG8_LDA(At, 1, 1); PG8_STAGE(PG8_SA(1, 0), a3, cuA[0]);
            PG8_BAR; PG8_WAIT_L(0); PG8_MMA(1, 0, At, B0); PG8_BAR; PG8_SCHED;
            PG8_STAGE(PG8_SB(1, 1), b3 + hstep, voffB);
            PG8_WAIT_V(6); PG8_BAR; PG8_MMA(1, 1, At, B1); PG8_BAR;
        }
        PG8_STAMP();
        if constexpr (!Epi::AFTER_DRAIN) { E(acc, cur, wr, wc, fr, fq); S.done(cur); }
        PG8_STAMP();
        if (!has_next) break;
#pragma unroll
        for (int a = 0; a < 2; ++a)
#pragma unroll
            for (int b = 0; b < 2; ++b)
#pragma unroll
                for (int m = 0; m < 4; ++m)
#pragma unroll
                    for (int n = 0; n < 2; ++n) acc[a][b][m][n] = (f32x4){0.f, 0.f, 0.f, 0.f};
        cur = nxt; cB = nB; ++ui;
    }
    PG8_WAIT_V(0);
    if (wr == 0) PG8_BAR;
    PG8_BAR;
    if constexpr (Epi::AFTER_DRAIN) { E.fused(acc, cur, wr, wc, fr, fq, lds, wid, lane); S.done(cur); }
    PG8_STAMP();
    if (STAMP && wid == 0) { stamps[lane] = lane < nts ? (((unsigned long long)(unsigned)ts_hi << 32) | (unsigned)ts_lo) : 0ull;
        if (lane == 62) stamps[62] = rt_entry; if (lane == 63) stamps[63] = (unsigned long long)wall_clock64(); }
#undef PG8_STAMP
#undef PG8_SA
#undef PG8_SB
#undef PG8_STAGE
#undef PG8_AOFF
#undef PG8_LDA
#undef PG8_LDB
#undef PG8_MMA
#undef PG8_WAIT_V
#undef PG8_WAIT_L
#undef PG8_BAR
#undef PG8_SCHED
}
}

namespace mk {
using pg8::bf16_t; using pg8::f32x4; using pg8::u32x4; using pg8::Unit; using pg8::cvt_pk_bf16;
#define LAS __attribute__((address_space(3)))
typedef float f32x2 __attribute__((ext_vector_type(2)));
typedef unsigned u32x2 __attribute__((ext_vector_type(2)));

#ifndef MK_DIAG
#define MK_DIAG 0
#endif
#ifndef MK_DIAGSEL
#define MK_DIAGSEL 0
#endif
#ifndef MK_DIAGMASK
#define MK_DIAGMASK 0xFFFF
#endif
#ifndef MK_N_LAUNCHES
#define MK_N_LAUNCHES 1
#endif
constexpr int NPHASE = 16;
constexpr int NB = 8, SEQ = 2048, D = 1024, T = NB * SEQ, NMEM = 256, SGW = 768, NSG = 12, HD = 64, CH = 128;
constexpr int NEXP = 16, LISTCAP = 16384;
constexpr float ALPHA = 1.41421356237f;
constexpr float LN_EPS = 1e-5f, ATT_SCALE = 0.125f;
constexpr int NWAVES = 8, NTHREADS = 512;

constexpr size_t MiB = 1u << 20;
constexpr size_t WS_CTL = 0, CTL_ZERO_BYTES = 128 * 1024;
constexpr size_t WS_TOKE = 1 * MiB, WS_TOKP = WS_TOKE + 128 * 1024, WS_TOKG = WS_TOKP + 128 * 1024;
constexpr size_t WS_LIST = 2 * MiB, WS_LSE = 3 * MiB, WS_SGWB = 4 * MiB, WS_SGRS = 4 * MiB + 512 * 1024, WS_WRT = 4 * MiB + 768 * 1024;
constexpr size_t WS_MKV = 8 * MiB, WS_MEMB = 12 * MiB;
constexpr size_t WS_BT_INA = 18 * MiB, WS_BT_OUTA = 22 * MiB, WS_BT_B = 24 * MiB, WS_BT_OUTB = 29 * MiB, WS_BT_MEM = 30 * MiB;
constexpr size_t WS_WGU = 32 * MiB, WS_WD = 160 * MiB;
constexpr size_t WS_A = 224 * MiB;
constexpr size_t WS_U = WS_A, WS_GV = WS_A + 24 * MiB, WS_QM0 = WS_A + 48 * MiB;
constexpr size_t WS_K = WS_A, WS_V = WS_A + 24 * MiB, WS_Q = WS_A + 48 * MiB, WS_QM1 = WS_A + 72 * MiB;
constexpr size_t WS_ACT = WS_A;
constexpr size_t WS_XB = 304 * MiB;
constexpr size_t WS_C = 336 * MiB;
constexpr size_t WS_CAT = WS_C, WS_OG = WS_C, WS_CAT2 = WS_C + 24 * MiB;
constexpr size_t WS_Y = 376 * MiB;
constexpr size_t WS_YD = 336 * MiB;
constexpr size_t WS_X1B = 440 * MiB;
constexpr size_t WS_X1F8 = 472 * MiB;
constexpr size_t WS_END = 488 * MiB;
constexpr size_t WS_WGU8 = WS_WGU + 64 * MiB, WS_WD8 = WS_WD + 32 * MiB;
constexpr int CW_TMO = 0, CW_BAR = 4096, CW_CNT = 16384, CW_CONV = 24576, CW_DONE = 24640, CW_CONV0 = 26000;
constexpr int LDS_TOKS = 131072 + 1024, MAX_UNITS = 8;
constexpr int LDS_MISC = 131072;
constexpr int LDS_BYTES = 147456;
static_assert(LDS_TOKS + MAX_UNITS * 1024 <= LDS_BYTES, "LDS map");

#define LDS_WAIT() asm volatile("s_waitcnt lgkmcnt(0)" ::: "memory")
#define VM_WAIT() asm volatile("s_waitcnt vmcnt(0)" ::: "memory")
__device__ __forceinline__ unsigned f2bf(float f) { unsigned u = __builtin_bit_cast(unsigned, f); return (u + 0x7fffu + ((u >> 16) & 1u)) >> 16; }
__device__ __forceinline__ unsigned pk2(float lo, float hi) { return f2bf(lo) | (f2bf(hi) << 16); }
__device__ __forceinline__ unsigned pk4_fp8_e(float a, float b, float c, float d) { int r = 0; r = __builtin_amdgcn_cvt_pk_fp8_f32(a, b, r, false); r = __builtin_amdgcn_cvt_pk_fp8_f32(c, d, r, true); return (unsigned)r; }
__device__ __forceinline__ float bflo(unsigned w) { return __uint_as_float(w << 16); }
__device__ __forceinline__ float bfhi(unsigned w) { return __uint_as_float(w & 0xffff0000u); }
__device__ __forceinline__ float bf1(bf16_t v) { return __uint_as_float(((unsigned)v) << 16); }
__device__ __forceinline__ float wave_sum(float v) {
#pragma unroll
    for (int o = 1; o < 64; o <<= 1) v += __shfl_xor(v, o);
    return v;
}
template <int CTRL> __device__ __forceinline__ float dpp_f(float v) { return __builtin_bit_cast(float, __builtin_amdgcn_update_dpp(0, __builtin_bit_cast(int, v), CTRL, 0xf, 0xf, false)); }
__device__ __forceinline__ float row_sum(float v) { v += dpp_f<0xB1>(v); v += dpp_f<0x4E>(v); v += dpp_f<0x141>(v); v += dpp_f<0x140>(v); return v; }
__device__ __forceinline__ float wave_sum_dpp(float v) { v = row_sum(v); v += __shfl_xor(v, 16); v += __shfl_xor(v, 32); return v; }
__device__ __forceinline__ float wave_max(float v) {
#pragma unroll
    for (int o = 1; o < 64; o <<= 1) v = fmaxf(v, __shfl_xor(v, o));
    return v;
}

#define XB_TMO      128
#define XB_XCNT(j)  (256  + 64 * (j))
#define XB_XSUB(j)  (1280 + 64 * (j))
#define XB_XGEN(j)  (2304 + 64 * (j))
#define XB_TOP      3328
#define XB_TOPGEN   3392
#define XCD_BAR_WORDS 3456
#define XB_SPIN_CAP (1u << 18)
__device__ __forceinline__ unsigned xb_ld(unsigned* p)              { return __hip_atomic_load(p, __ATOMIC_RELAXED, __HIP_MEMORY_SCOPE_AGENT); }
__device__ __forceinline__ unsigned xb_add(unsigned* p, unsigned v) { return __hip_atomic_fetch_add(p, v, __ATOMIC_RELAXED, __HIP_MEMORY_SCOPE_AGENT); }
__device__ __forceinline__ unsigned xb_xcc_id() { return (unsigned)__builtin_amdgcn_s_getreg((3 << 11) | 20) & 0xFu; }
#define XB_SPIN(cond, bar) do { unsigned _sp = 0; while (cond) { __builtin_amdgcn_s_sleep(1); \
    if ((++_sp & 255u) == 0u) { if (xb_ld(&(bar)[XB_TMO])) break; if (_sp > XB_SPIN_CAP) { atomicAdd(&(bar)[XB_TMO], 1u); break; } } } } while (0)
struct XcdBarrier { unsigned* bar; unsigned x; volatile LAS unsigned* st; };
__device__ __forceinline__ XcdBarrier xcd_barrier_post(unsigned* bar, volatile LAS unsigned* st) {
    XcdBarrier b; b.bar = bar; b.x = xb_xcc_id(); b.st = st;
    if (threadIdx.x == 0) (void)xb_add(&bar[XB_XCNT(b.x)], 1u);
    return b;
}
__device__ __forceinline__ void xcd_barrier_complete(unsigned* bar, unsigned x, unsigned& nloc, unsigned& nx) {
    const unsigned G = gridDim.x * gridDim.y * gridDim.z;
    unsigned sum, cnt, mine, sp = 0u;
    for (;;) {
        sum = 0u; cnt = 0u; mine = 0u;
#pragma unroll
        for (unsigned j = 0; j < 16; ++j) { const unsigned c = xb_ld(&bar[XB_XCNT(j)]); sum += c; cnt += (c > 0u) ? 1u : 0u; mine = (j == x) ? c : mine; }
        if (sum == G) break;
        __builtin_amdgcn_s_sleep(1);
        if ((++sp & 255u) == 0u) { if (xb_ld(&bar[XB_TMO])) break; if (sp > XB_SPIN_CAP) { atomicAdd(&bar[XB_TMO], 1u); break; } }
    }
    nloc = mine > 0u ? mine : 1u; nx = cnt > 0u ? cnt : 1u;
}
__device__ __forceinline__ void xcd_barrier(const XcdBarrier& b) {
    asm volatile("s_waitcnt vmcnt(0)" ::: "memory");
    __syncthreads();
    if (threadIdx.x == 0) {
        unsigned* bar = b.bar;
        __builtin_amdgcn_s_waitcnt(0);
        unsigned nloc = b.st[0], nx = b.st[1];
        if (nloc == 0u) { xcd_barrier_complete(bar, b.x, nloc, nx); b.st[0] = nloc; b.st[1] = nx; }
        const unsigned old = xb_add(&bar[XB_XSUB(b.x)], 1u);
        const unsigned gen = old / nloc;
        if (old + 1u == (gen + 1u) * nloc) {
            __builtin_amdgcn_fence(__ATOMIC_RELEASE, "agent");
            asm volatile("s_waitcnt vmcnt(0)" ::: "memory");
            const unsigned og = xb_add(&bar[XB_TOP], 1u);
            const unsigned tg = og / nx;
            if (og + 1u == (tg + 1u) * nx) xb_add(&bar[XB_TOPGEN], 1u);
            else XB_SPIN(xb_ld(&bar[XB_TOPGEN]) == tg, bar);
            __builtin_amdgcn_fence(__ATOMIC_ACQUIRE, "agent");
            xb_add(&bar[XB_XGEN(b.x)], 1u);
            asm volatile("s_waitcnt vmcnt(0)" ::: "memory");
        } else {
            XB_SPIN(xb_ld(&bar[XB_XGEN(b.x)]) == gen, bar);
            __builtin_amdgcn_fence(__ATOMIC_ACQUIRE, "agent");
            asm volatile("s_waitcnt vmcnt(0)" ::: "memory");
        }
    }
    __syncthreads();
}


struct EpiProjA {
    static constexpr bool PERM = true, AFTER_DRAIN = false;
    bf16_t *u, *gv, *qm;
    __device__ __forceinline__ void operator()(const f32x4 (&acc)[2][2][4][2], const Unit& un, int wr, int wc, int fr, int fq) const {
        const int row0 = un.pm * 256 + wr * 64 + fr;
        bf16_t* base; int ldc, colt; bool act; float sc = 1.f;
        if (un.pn < 3) { base = u; ldc = SGW; colt = un.pn * 256; act = true; }
        else if (un.pn < 6) { base = gv; ldc = SGW; colt = (un.pn - 3) * 256; act = true; }
        else { base = qm; ldc = 256; colt = 0; act = false; sc = ATT_SCALE; }
        const int col0 = colt + wc * 32 + 8 * fq;
#pragma unroll
        for (int ai = 0; ai < 2; ++ai)
#pragma unroll
            for (int m = 0; m < 4; ++m) { bf16_t* rowp = base + (size_t)(row0 + ai * 128 + m * 16) * ldc + col0;
#pragma unroll
                for (int bj = 0; bj < 2; ++bj) { f32x4 v0 = acc[ai][bj][m][0], v1 = acc[ai][bj][m][1];
                    if (act) { pg8::f32x2 a = pg8::gelu_pk((pg8::f32x2){v0[0], v0[1]}), b = pg8::gelu_pk((pg8::f32x2){v0[2], v0[3]}), c = pg8::gelu_pk((pg8::f32x2){v1[0], v1[1]}), d = pg8::gelu_pk((pg8::f32x2){v1[2], v1[3]});
                        v0 = (f32x4){a.x, a.y, b.x, b.y}; v1 = (f32x4){c.x, c.y, d.x, d.y}; }
                    v0 = v0 * sc; v1 = v1 * sc;
                    u32x4 w; w.x = cvt_pk_bf16(v0[0], v0[1]); w.y = cvt_pk_bf16(v0[2], v0[3]); w.z = cvt_pk_bf16(v1[0], v1[1]); w.w = cvt_pk_bf16(v1[2], v1[3]);
                    *(u32x4*)(rowp + bj * 128) = w; } }
    }
};
struct EpiProjB {
    static constexpr bool PERM = true, AFTER_DRAIN = false;
    bf16_t *k, *v, *q, *qm;
    __device__ __forceinline__ void operator()(const f32x4 (&acc)[2][2][4][2], const Unit& un, int wr, int wc, int fr, int fq) const {
        const int row0 = un.pm * 256 + wr * 64 + fr;
        bf16_t* base; int ldc, colt; float sc = 1.f;
        if (un.pn < 3) { base = k; ldc = SGW; colt = un.pn * 256; }
        else if (un.pn < 6) { base = v; ldc = SGW; colt = (un.pn - 3) * 256; }
        else if (un.pn < 9) { base = q; ldc = SGW; colt = (un.pn - 6) * 256; sc = ATT_SCALE; }
        else { base = qm; ldc = 256; colt = 0; sc = ATT_SCALE; }
        const int col0 = colt + wc * 32 + 8 * fq;
#pragma unroll
        for (int ai = 0; ai < 2; ++ai)
#pragma unroll
            for (int m = 0; m < 4; ++m) { bf16_t* rowp = base + (size_t)(row0 + ai * 128 + m * 16) * ldc + col0;
#pragma unroll
                for (int bj = 0; bj < 2; ++bj) { f32x4 v0 = acc[ai][bj][m][0] * sc, v1 = acc[ai][bj][m][1] * sc;
                    u32x4 w; w.x = cvt_pk_bf16(v0[0], v0[1]); w.y = cvt_pk_bf16(v0[2], v0[3]); w.z = cvt_pk_bf16(v1[0], v1[1]); w.w = cvt_pk_bf16(v1[2], v1[3]);
                    *(u32x4*)(rowp + bj * 128) = w; } }
    }
};
struct EpiPlain {
    static constexpr bool PERM = true, AFTER_DRAIN = false;
    bf16_t* O; int ldc, ntn;
    __device__ __forceinline__ void operator()(const f32x4 (&acc)[2][2][4][2], const Unit& un, int wr, int wc, int fr, int fq) const {
        const int row0 = un.pm * 256 + wr * 64 + fr;
        const int col0 = (un.pn % ntn) * 256 + wc * 32 + 8 * fq;
#pragma unroll
        for (int ai = 0; ai < 2; ++ai)
#pragma unroll
            for (int m = 0; m < 4; ++m) { bf16_t* rowp = O + (size_t)(row0 + ai * 128 + m * 16) * ldc + col0;
#pragma unroll
                for (int bj = 0; bj < 2; ++bj) { const f32x4 v0 = acc[ai][bj][m][0], v1 = acc[ai][bj][m][1];
                    u32x4 w; w.x = cvt_pk_bf16(v0[0], v0[1]); w.y = cvt_pk_bf16(v0[2], v0[3]); w.z = cvt_pk_bf16(v1[0], v1[1]); w.w = cvt_pk_bf16(v1[2], v1[3]);
                    *(u32x4*)(rowp + bj * 128) = w; } }
    }
};
struct EpiSwiGLU {
    static constexpr bool PERM = true, AFTER_DRAIN = false;
    bf16_t* O;
    __device__ __forceinline__ void operator()(const f32x4 (&acc)[2][2][4][2], const Unit& un, int wr, int wc, int fr, int fq) const {
        const int row0 = un.pm * 256 + wr * 64 + fr;
        const int col0 = (un.pn & 7) * 128 + wc * 32 + 8 * fq;
#pragma unroll
        for (int ai = 0; ai < 2; ++ai)
#pragma unroll
            for (int m = 0; m < 4; ++m) { bf16_t* rowp = O + (size_t)(row0 + ai * 128 + m * 16) * 1024 + col0;
                float r[8];
#pragma unroll
                for (int n = 0; n < 2; ++n)
#pragma unroll
                    for (int j = 0; j < 4; ++j) { const float g = acc[ai][0][m][n][j], up = acc[ai][1][m][n][j];
                        r[n * 4 + j] = g * __builtin_amdgcn_rcpf(1.0f + __expf(-g)) * up; }
                u32x4 w; w.x = cvt_pk_bf16(r[0], r[1]); w.y = cvt_pk_bf16(r[2], r[3]); w.z = cvt_pk_bf16(r[4], r[5]); w.w = cvt_pk_bf16(r[6], r[7]);
                *(u32x4*)rowp = w; }
    }
};
struct EpiSwiGLU8 {
    static constexpr bool PERM = true, AFTER_DRAIN = false;
    unsigned char* O;
    __device__ __forceinline__ void operator()(const f32x4 (&acc)[2][2][4][2], const Unit& un, int wr, int wc, int fr, int fq) const {
        const int row0 = un.pm * 256 + wr * 64 + fr;
        const int col0 = (un.pn & 7) * 128 + wc * 32 + 8 * fq;
#pragma unroll
        for (int ai = 0; ai < 2; ++ai)
#pragma unroll
            for (int m = 0; m < 4; ++m) { unsigned char* rowp = O + (size_t)(row0 + ai * 128 + m * 16) * 1024 + col0;
                float r[8];
#pragma unroll
                for (int n = 0; n < 2; ++n)
#pragma unroll
                    for (int j = 0; j < 4; ++j) { const float g = acc[ai][0][m][n][j], up = acc[ai][1][m][n][j];
                        r[n * 4 + j] = g * __builtin_amdgcn_rcpf(1.0f + __expf(-g)) * up * 8.0f; }
                *(u32x2*)rowp = (u32x2){pk4_fp8_e(r[0], r[1], r[2], r[3]), pk4_fp8_e(r[4], r[5], r[6], r[7])}; }
    }
};
template <bool RB> struct EpiResid {
    static constexpr bool PERM = false, AFTER_DRAIN = false;
    const void* res; bf16_t* Y;
    __device__ __forceinline__ void operator()(const f32x4 (&acc)[2][2][4][2], const Unit& un, int wr, int wc, int fr, int fq) const {
        const int row0 = un.pm * 256 + wr * 64 + fr, col0 = un.pn * 256 + wc * 32 + 4 * fq;
#pragma unroll
        for (int ai = 0; ai < 2; ++ai)
#pragma unroll
            for (int m = 0; m < 4; ++m) { const size_t off = (size_t)(row0 + ai * 128 + m * 16) * D + col0;
#pragma unroll
                for (int bj = 0; bj < 2; ++bj)
#pragma unroll
                    for (int n = 0; n < 2; ++n) { const size_t o = off + bj * 128 + n * 16; f32x4 r;
                        if (RB) { const u32x2 w = *(const u32x2*)((const bf16_t*)res + o); r = (f32x4){bflo(w.x), bfhi(w.x), bflo(w.y), bfhi(w.y)}; }
                        else r = *(const f32x4*)((const float*)res + o);
                        const f32x4 yv = r * ALPHA + acc[ai][bj][m][n]; *(u32x2*)(Y + o) = (u32x2){cvt_pk_bf16(yv[0], yv[1]), cvt_pk_bf16(yv[2], yv[3])}; } }
    }
};
struct SmallOrder {
    int nN, nwg, c;
    __device__ bool next(int i, Unit& u) const { if (i != 0 || c < 0 || c >= nwg) return false; u.pm = c / nN; u.pn = c % nN; return true; }
    __device__ __forceinline__ void a_ready(const Unit&) const {}
    __device__ __forceinline__ void done(const Unit&) const {}
    __device__ __forceinline__ int arow(int, const Unit& u, int r) const { return u.pm * 256 + r; }
};
struct MoeOrder {
    const LAS int* tb;
    int ntn, G, c;
    __device__ bool next(int i, Unit& u) const {
        const int L = i * G + c; if (L >= tb[16] * ntn) return false;
        int e = 0;
#pragma unroll
        for (int j = 1; j < 16; ++j) e += (L >= tb[j] * ntn) ? 1 : 0;
        const int r = L - tb[e] * ntn, te = tb[e + 1] - tb[e];
        u.pm = tb[e] + r % te; u.pn = e * ntn + r / te; return true;
    }
    __device__ __forceinline__ void a_ready(const Unit&) const {}
    __device__ __forceinline__ void done(const Unit&) const {}
    __device__ __forceinline__ int arow(int, const Unit& u, int r) const { return u.pm * 256 + r; }
};
struct MoeGatherOrder : MoeOrder {
    const LAS int* toks;
    __device__ __forceinline__ int arow(int ui, const Unit&, int r) const { return toks[ui * 256 + r]; }
};

struct Args { const float* in[23]; float* out; unsigned char* ws; int ph_lo, ph_hi; };
struct Ctx {
    unsigned char* ws; LAS unsigned char* lds;
    int tid, lane, wave, gw, NGW, G, bid;
};
__device__ __forceinline__ unsigned char* launder(unsigned char* p) { asm volatile("" : "+s"(p)); return p; }
__device__ __forceinline__ int launder_v(int v) { asm volatile("" : "+v"(v)); return v; }

__device__ __forceinline__ void tr_item(const float* W, int K, int N, bf16_t* WT, int grp, int gstride, int roff, LAS float* scr, int item, int lane) {
    const int nblk = N / 32, kb = item / nblk, nb = item % nblk, k0 = 64 * kb, n0 = 32 * nb;
    float ld[32];
    { const float* wp = W + (size_t)(k0 + (lane >> 5)) * N + n0 + (lane & 31);
#pragma unroll
      for (int i = 0; i < 32; ++i) ld[i] = __builtin_nontemporal_load(wp + (size_t)(2 * i) * N); }
#pragma unroll
    for (int i = 0; i < 32; ++i) scr[(2 * i + (lane >> 5)) * 33 + (lane & 31)] = ld[i];
    LDS_WAIT(); asm volatile("" ::: "memory");
    const int c = lane & 7;
#pragma unroll
    for (int j = 0; j < 4; ++j) { const int n = (lane >> 3) + 8 * j; const LAS float* s = scr + (8 * c) * 33 + n;
        const int nn = n0 + n, drow = (nn / grp) * gstride + (nn % grp) + roff;
        u32x4 o; o.x = pk2(s[0 * 33], s[1 * 33]); o.y = pk2(s[2 * 33], s[3 * 33]); o.z = pk2(s[4 * 33], s[5 * 33]); o.w = pk2(s[6 * 33], s[7 * 33]);
        *(u32x4*)(WT + (size_t)drow * K + k0 + 8 * c) = o; }
    LDS_WAIT(); asm volatile("" ::: "memory");
}
__device__ __forceinline__ unsigned pk4_fp8(float a, float b, float c, float d) { int r = 0; r = __builtin_amdgcn_cvt_pk_fp8_f32(a, b, r, false); r = __builtin_amdgcn_cvt_pk_fp8_f32(c, d, r, true); return (unsigned)r; }
__device__ __forceinline__ void tr_item8(const float* W, int K, int N, unsigned char* WT, int grp, int gstride, int roff, float sc, LAS float* scr, int item, int lane) {
    const int nblk = N / 32, kb = item / nblk, nb = item % nblk, k0 = 64 * kb, n0 = 32 * nb;
    float ld[32];
    { const float* wp = W + (size_t)(k0 + (lane >> 5)) * N + n0 + (lane & 31);
#pragma unroll
      for (int i = 0; i < 32; ++i) ld[i] = __builtin_nontemporal_load(wp + (size_t)(2 * i) * N); }
#pragma unroll
    for (int i = 0; i < 32; ++i) scr[(2 * i + (lane >> 5)) * 33 + (lane & 31)] = ld[i];
    LDS_WAIT(); asm volatile("" ::: "memory");
    const int c = lane & 7;
#pragma unroll
    for (int j = 0; j < 4; ++j) { const int n = (lane >> 3) + 8 * j; const LAS float* s = scr + (8 * c) * 33 + n;
        const int nn = n0 + n, drow = (nn / grp) * gstride + (nn % grp) + roff;
        u32x2 o; o.x = pk4_fp8(s[0 * 33] * sc, s[1 * 33] * sc, s[2 * 33] * sc, s[3 * 33] * sc); o.y = pk4_fp8(s[4 * 33] * sc, s[5 * 33] * sc, s[6 * 33] * sc, s[7 * 33] * sc);
        *(u32x2*)(WT + (size_t)drow * K + k0 + 8 * c) = o; }
    LDS_WAIT(); asm volatile("" ::: "memory");
}
constexpr float W8_SCALE = 32.0f, ACT8_SCALE = 8.0f;
constexpr int E8_ONE = 0x7f7f7f7f, E8_W = 0x7a7a7a7a, E8_ACT = 0x7c7c7c7c;
__device__ __forceinline__ void moe_conv_item(const Args& A, unsigned char* ws, LAS float* scr, int lane, int layer, int r) {
    const int t = r >> 13, e = (r & 8191) >> 9, m = layer * 16 + e, item = r & 511;
    if (t == 0) tr_item8(A.in[20] + (size_t)m * 1048576, 1024, 1024, ws + WS_WGU + (size_t)layer * (64 * MiB) + (size_t)e * 2097152, 128, 256, 0, W8_SCALE, scr, item, lane);
    else if (t == 1) tr_item8(A.in[21] + (size_t)m * 1048576, 1024, 1024, ws + WS_WGU + (size_t)layer * (64 * MiB) + (size_t)e * 2097152, 128, 256, 128, W8_SCALE, scr, item, lane);
    else tr_item8(A.in[22] + (size_t)m * 1048576, 1024, 1024, ws + WS_WD + (size_t)layer * (32 * MiB) + (size_t)e * 1048576, 1024, 1024, 0, W8_SCALE, scr, item, lane);
}
constexpr int N_CONV1 = 3 * 8192;
__device__ __forceinline__ void fill_tail(const Ctx& C, const Args& A, int ph, bool fin) {
    unsigned* ctl = (unsigned*)(C.ws + WS_CTL);
    volatile LAS int* flag = (volatile LAS int*)(C.lds + LDS_MISC) + 40;
    LAS float* scr = (LAS float*)(C.lds + C.wave * 16384);
    asm volatile("s_waitcnt vmcnt(0)" ::: "memory");
    __syncthreads();
    if (C.tid == 0 && !fin) __hip_atomic_fetch_add(ctl + CW_DONE + 64 * ph, 1u, __ATOMIC_RELAXED, __HIP_MEMORY_SCOPE_AGENT);
    for (;;) {
        if (C.tid == 0) { int v = -1;
            const unsigned d = fin ? 0u : __hip_atomic_fetch_add(ctl + CW_DONE + 64 * ph, 0u, __ATOMIC_RELAXED, __HIP_MEMORY_SCOPE_AGENT);
            if (d + 8u < (unsigned)C.G) { v = (int)__hip_atomic_fetch_add(ctl + CW_CONV, 8u, __ATOMIC_RELAXED, __HIP_MEMORY_SCOPE_AGENT); if (v >= N_CONV1) v = -1; }
#if MK_DIAG == 3
            if (!fin && v >= 0) __hip_atomic_fetch_add(ctl + 30000, 8u, __ATOMIC_RELAXED, __HIP_MEMORY_SCOPE_AGENT);
#endif
            *flag = v; }
        __syncthreads();
        const int v = *flag;
        __syncthreads();
        if (v < 0) break;
        if (v + C.wave < N_CONV1) moe_conv_item(A, C.ws, scr, C.lane, 1, v + C.wave);
    }
}
__device__ __forceinline__ void p0_prologue(const Ctx& C, const Args& A) {
    LAS float* scr = (LAS float*)(C.lds + C.wave * 16384);
    unsigned char* ws = C.ws;
    constexpr int I_MOE = 16 * 32;
    constexpr int N_MOE = 32 * I_MOE;
    constexpr int I_INA = 16 * 56, I_SQ = 512, I_KV = 16 * 24, I_OUTB = 8 * 32, I_MEM = 16 * 8;
    constexpr int N_MOE0 = 3 * 8192;
    constexpr int NITEMS = I_INA + I_SQ + I_SQ + 2 * I_KV + I_OUTB + 4 * I_MEM;
    for (int it = C.gw; it < NITEMS; it += C.NGW) {
        int r = it;
        if (r < I_INA) { tr_item(A.in[2], 1024, 1792, (bf16_t*)(ws + WS_BT_INA), 1792, 1792, 0, scr, r, C.lane); continue; } r -= I_INA;
        if (r < I_SQ) { tr_item(A.in[3], 1024, 1024, (bf16_t*)(ws + WS_BT_OUTA), 1024, 1024, 0, scr, r, C.lane); continue; } r -= I_SQ;
        if (r < I_SQ) { tr_item(A.in[8], 1024, 1024, (bf16_t*)(ws + WS_BT_B), 1024, 1024, 1536, scr, r, C.lane); continue; } r -= I_SQ;
        if (r < I_KV) { tr_item(A.in[10], 1024, 768, (bf16_t*)(ws + WS_BT_B), 768, 768, 0, scr, r, C.lane); continue; } r -= I_KV;
        if (r < I_KV) { tr_item(A.in[11], 1024, 768, (bf16_t*)(ws + WS_BT_B), 768, 768, 768, scr, r, C.lane); continue; } r -= I_KV;
        if (r < I_OUTB) { tr_item(A.in[9], 512, 1024, (bf16_t*)(ws + WS_BT_OUTB), 1024, 1024, 0, scr, r, C.lane); continue; } r -= I_OUTB;
        { const int m = r / I_MEM, layer = m & 1, isv = m >> 1;
          tr_item(A.in[isv ? 13 : 12] + (size_t)layer * 262144, 1024, 256, (bf16_t*)(ws + WS_BT_MEM), 256, 256, layer * 512 + isv * 256, scr, r % I_MEM, C.lane); }
    }
    const int gt = C.bid * NTHREADS + C.tid, NT = C.G * NTHREADS;
    for (int i = gt; i < NSG * 128 * 128 / 8; i += NT) { const int q0 = (i & 15) * 8, p = (i >> 4) & 127;
        const f32x4 a = *(const f32x4*)(A.in[6] + (size_t)i * 8), b = *(const f32x4*)(A.in[6] + (size_t)i * 8 + 4); float v[8] = {a[0], a[1], a[2], a[3], b[0], b[1], b[2], b[3]};
#pragma unroll
        for (int j = 0; j < 8; ++j) v[j] = (q0 + j <= p) ? v[j] : 0.f;
        u32x4 w; w.x = pk2(v[0], v[1]); w.y = pk2(v[2], v[3]); w.z = pk2(v[4], v[5]); w.w = pk2(v[6], v[7]); *(u32x4*)((bf16_t*)(ws + WS_SGWB) + (size_t)i * 8) = w; }
    for (int i = gt; i < 16 * 1024; i += NT) { const int e = i >> 10, k = i & 1023; ((bf16_t*)(ws + WS_WRT))[i] = (bf16_t)f2bf(A.in[18][(size_t)k * 16 + e]); }
    for (int i = gt; i < NSG * 128; i += NT) { const int p = i & 127; float acc = 0.f;
        for (int q = 0; q <= p; ++q) acc += bflo(f2bf(A.in[6][(size_t)i * 128 + q]));
        ((float*)(ws + WS_SGRS))[i] = acc; }
    for (int i = gt; i < T * D / 8; i += NT) { const f32x4 a = *(const f32x4*)(A.in[0] + (size_t)i * 8), b = *(const f32x4*)(A.in[0] + (size_t)i * 8 + 4);
        u32x4 w; w.x = pk2(a[0], a[1]); w.y = pk2(a[2], a[3]); w.z = pk2(b[0], b[1]); w.w = pk2(b[2], b[3]); *(u32x4*)((bf16_t*)(ws + WS_XB) + (size_t)i * 8) = w; }
    for (int i = gt; i < NB * NMEM * D / 8; i += NT) { const f32x4 a = *(const f32x4*)(A.in[1] + (size_t)i * 8), b = *(const f32x4*)(A.in[1] + (size_t)i * 8 + 4);
        u32x4 w; w.x = pk2(a[0], a[1]); w.y = pk2(a[2], a[3]); w.z = pk2(b[0], b[1]); w.w = pk2(b[2], b[3]); *(u32x4*)((bf16_t*)(ws + WS_MEMB) + (size_t)i * 8) = w; }
    { unsigned* ctr = (unsigned*)(ws + WS_CTL) + CW_CONV0; volatile LAS int* flag = (volatile LAS int*)(C.lds + LDS_MISC) + 40;
      if (C.tid == 0) *flag = (int)__hip_atomic_fetch_add(ctr, 8u, __ATOMIC_RELAXED, __HIP_MEMORY_SCOPE_AGENT);
      __syncthreads();
      int cur = *flag;
      __syncthreads();
      while (cur < N_MOE0) {
          int nxt = 0;
          if (C.tid == 0) nxt = (int)__hip_atomic_fetch_add(ctr, 8u, __ATOMIC_RELAXED, __HIP_MEMORY_SCOPE_AGENT);
          if (cur + C.wave < N_MOE0) moe_conv_item(A, ws, scr, C.lane, 0, cur + C.wave);
          if (C.tid == 0) *flag = nxt;
          __syncthreads();
          cur = *flag;
          __syncthreads();
      } }
}

__device__ __forceinline__ void sg_scalar(const Ctx& C, const Args& A) {
    const bf16_t* U = (const bf16_t*)(C.ws + WS_U); const bf16_t* GV = (const bf16_t*)(C.ws + WS_GV); bf16_t* CAT = (bf16_t*)(C.ws + WS_CAT);
    const float* lng = A.in[4]; const float* lnb = A.in[5]; const float* sgw = A.in[6]; const float* sgb = A.in[7];
    LAS float* stat = (LAS float*)C.lds;
    LAS float* gvn = (LAS float*)(C.lds + 1024);
    LAS float* Wl = (LAS float*)(C.lds + 1024 + 128 * 65 * 4);
    for (int unit = C.bid; unit < NB * 16; unit += C.G) {
        const int tb = unit * 128;
        for (int rr = 0; rr < 16; ++rr) { const int row = C.wave * 16 + rr; const bf16_t* p = GV + (size_t)(tb + row) * SGW + 4 * C.lane;
            float s = 0.f, ss = 0.f;
#pragma unroll
            for (int j = 0; j < 3; ++j) { const u32x2 w = *(const u32x2*)(p + 256 * j); const float a = bflo(w.x), b = bfhi(w.x), c = bflo(w.y), d = bfhi(w.y);
                s += (a + b) + (c + d); ss += (a * a + b * b) + (c * c + d * d); }
            s = wave_sum(s); ss = wave_sum(ss);
            const float mean = s * (1.f / SGW), var = ss * (1.f / SGW) - mean * mean;
            if (C.lane == 0) { stat[row * 2] = mean; stat[row * 2 + 1] = 1.0f / sqrtf(var + LN_EPS); } }
        __syncthreads();
        const int p = C.tid >> 2, d0 = (C.tid & 3) * 16;
        for (int g = 0; g < NSG; ++g) {
            { const bf16_t* src = GV + (size_t)(tb + p) * SGW + g * 64 + d0; const float mean = stat[p * 2], rstd = stat[p * 2 + 1];
#pragma unroll
              for (int h = 0; h < 2; ++h) { const u32x4 w = *(const u32x4*)(src + 8 * h); const unsigned ww[4] = {w.x, w.y, w.z, w.w};
#pragma unroll
                  for (int j = 0; j < 4; ++j) { const int d = d0 + 8 * h + 2 * j; const int cc = g * 64 + d;
                      gvn[p * 65 + d] = (bflo(ww[j]) - mean) * rstd * lng[cc] + lnb[cc];
                      gvn[p * 65 + d + 1] = (bfhi(ww[j]) - mean) * rstd * lng[cc + 1] + lnb[cc + 1]; } } }
            { const int q0 = (C.tid & 3) * 32; const float* src = sgw + ((size_t)g * 128 + p) * 128 + q0;
#pragma unroll
              for (int j = 0; j < 8; ++j) { const f32x4 w = *(const f32x4*)(src + 4 * j);
#pragma unroll
                  for (int t = 0; t < 4; ++t) { const int q = q0 + 4 * j + t; Wl[p * 129 + q] = (q <= p) ? w[t] : 0.f; } } }
            __syncthreads();
            float acc[16];
#pragma unroll
            for (int j = 0; j < 16; ++j) acc[j] = 0.f;
            for (int q = 0; q <= p; ++q) { const float w = Wl[p * 129 + q];
#pragma unroll
                for (int j = 0; j < 16; ++j) acc[j] += w * gvn[q * 65 + d0 + j]; }
            const float bs = sgb[g * 128 + p];
            const bf16_t* us = U + (size_t)(tb + p) * SGW + g * 64 + d0; bf16_t* dst = CAT + (size_t)(tb + p) * D + g * 64 + d0;
#pragma unroll
            for (int h = 0; h < 2; ++h) { const u32x4 w = *(const u32x4*)(us + 8 * h); const unsigned ww[4] = {w.x, w.y, w.z, w.w}; unsigned o[4];
#pragma unroll
                for (int j = 0; j < 4; ++j) o[j] = pk2(bflo(ww[j]) * (acc[8 * h + 2 * j] + bs), bfhi(ww[j]) * (acc[8 * h + 2 * j + 1] + bs));
                *(u32x4*)(dst + 8 * h) = (u32x4){o[0], o[1], o[2], o[3]}; }
            __syncthreads();
        }
    }
}

__device__ __forceinline__ void memattn_scalar(const Ctx& C, const bf16_t* QM, const bf16_t* MKV, int ck, int cv, bf16_t* OUT, int ldo, int coff) {
    for (int it = C.gw; it < T * 4; it += C.NGW) {
        const int tok = it >> 2, h = it & 3, b = tok / SEQ;
        float q[64];
        { const bf16_t* qp = QM + (size_t)tok * 256 + h * 64;
#pragma unroll
          for (int j = 0; j < 8; ++j) { const u32x4 w = *(const u32x4*)(qp + 8 * j);
              q[8 * j] = bflo(w.x); q[8 * j + 1] = bfhi(w.x); q[8 * j + 2] = bflo(w.y); q[8 * j + 3] = bfhi(w.y); q[8 * j + 4] = bflo(w.z); q[8 * j + 5] = bfhi(w.z); q[8 * j + 6] = bflo(w.w); q[8 * j + 7] = bfhi(w.w); } }
        float s[4];
#pragma unroll
        for (int jj = 0; jj < 4; ++jj) { const bf16_t* kp = MKV + (size_t)(b * NMEM + jj * 64 + C.lane) * 1024 + ck + h * 64; float a = 0.f;
#pragma unroll
            for (int j = 0; j < 8; ++j) { const u32x4 w = *(const u32x4*)(kp + 8 * j);
                a += q[8 * j] * bflo(w.x) + q[8 * j + 1] * bfhi(w.x) + q[8 * j + 2] * bflo(w.y) + q[8 * j + 3] * bfhi(w.y) + q[8 * j + 4] * bflo(w.z) + q[8 * j + 5] * bfhi(w.z) + q[8 * j + 6] * bflo(w.w) + q[8 * j + 7] * bfhi(w.w); }
            s[jj] = a; }
        const float mx = wave_max(fmaxf(fmaxf(s[0], s[1]), fmaxf(s[2], s[3])));
        float l = 0.f;
#pragma unroll
        for (int jj = 0; jj < 4; ++jj) { s[jj] = __expf(s[jj] - mx); l += s[jj]; }
        l = wave_sum(l);
        float acc = 0.f;
#pragma unroll
        for (int jj = 0; jj < 4; ++jj) { const bf16_t* vp = MKV + (size_t)(b * NMEM + jj * 64) * 1024 + cv + h * 64 + C.lane;
            for (int mm = 0; mm < 64; ++mm) acc += __shfl(s[jj], mm) * bf1(vp[(size_t)mm * 1024]); }
        OUT[(size_t)tok * ldo + coff + h * 64 + C.lane] = (bf16_t)f2bf(acc / l);
    }
}

__device__ __forceinline__ void dilattn_scalar(const Ctx& C, const Args& A) {
    const bf16_t* Q = (const bf16_t*)(C.ws + WS_Q); const bf16_t* K = (const bf16_t*)(C.ws + WS_K); const bf16_t* V = (const bf16_t*)(C.ws + WS_V);
    bf16_t* OG = (bf16_t*)(C.ws + WS_OG); float* LSE = (float*)(C.ws + WS_LSE);
    for (int it = C.gw; it < T * 12; it += C.NGW) {
        const int tok = it / 12, h = it % 12, g = h >> 2, dl = (g == 0) ? 1 : (g == 1 ? 4 : 16);
        const int t = tok % SEQ, i = t / dl;
        const float slope = exp2f(-(float)(h + 1) * (8.0f / 12.0f));
        float q[64];
        { const bf16_t* qp = Q + (size_t)tok * SGW + h * 64;
#pragma unroll
          for (int j = 0; j < 8; ++j) { const u32x4 w = *(const u32x4*)(qp + 8 * j);
              q[8 * j] = bflo(w.x); q[8 * j + 1] = bfhi(w.x); q[8 * j + 2] = bflo(w.y); q[8 * j + 3] = bfhi(w.y); q[8 * j + 4] = bflo(w.z); q[8 * j + 5] = bfhi(w.z); q[8 * j + 6] = bflo(w.w); q[8 * j + 7] = bfhi(w.w); } }
        float s[3];
#pragma unroll
        for (int jj = 0; jj < 3; ++jj) { const int j0 = jj * 64 + C.lane; const bool valid = (jj < 2 || C.lane == 0) && (j0 <= i);
            const int jc = valid ? j0 : 0;
            const bf16_t* kp = K + (size_t)(tok - jc * dl) * SGW + h * 64; float a = 0.f;
#pragma unroll
            for (int j = 0; j < 8; ++j) { const u32x4 w = *(const u32x4*)(kp + 8 * j);
                a += q[8 * j] * bflo(w.x) + q[8 * j + 1] * bfhi(w.x) + q[8 * j + 2] * bflo(w.y) + q[8 * j + 3] * bfhi(w.y) + q[8 * j + 4] * bflo(w.z) + q[8 * j + 5] * bfhi(w.z) + q[8 * j + 6] * bflo(w.w) + q[8 * j + 7] * bfhi(w.w); }
            s[jj] = valid ? (a - slope * (float)(dl * j0)) : -INFINITY; }
        const float mx = wave_max(fmaxf(fmaxf(s[0], s[1]), s[2]));
        float l = 0.f;
#pragma unroll
        for (int jj = 0; jj < 3; ++jj) { s[jj] = __expf(s[jj] - mx); l += s[jj]; }
        l = wave_sum(l);
        float acc = 0.f;
#pragma unroll
        for (int jj = 0; jj < 3; ++jj) { const int nm = (jj < 2) ? 64 : 1;
            for (int mm = 0; mm < nm; ++mm) { const int j0 = jj * 64 + mm; const int jc = (j0 <= i) ? j0 : 0;
                acc += __shfl(s[jj], mm) * bf1(V[(size_t)(tok - jc * dl) * SGW + h * 64 + C.lane]); } }
        OG[(size_t)tok * SGW + h * 64 + C.lane] = (bf16_t)f2bf(acc / l);
        if (C.lane == 0) LSE[tok * 12 + h] = mx + __logf(l);
    }
}
typedef short bf16x8 __attribute__((ext_vector_type(8)));
typedef short s16x4 __attribute__((ext_vector_type(4)));
constexpr int AT_KS = 144, AT_VS = 160, AT_ROWS = 272, AT_K_OFF = 0, AT_V_OFF = AT_ROWS * AT_KS;
static_assert(AT_V_OFF % 16 == 0 && AT_V_OFF + AT_ROWS * AT_VS <= 131072, "attention LDS map");

template <int NKB, bool DIL>
__device__ __forceinline__ void attn_compute(LAS unsigned char* lds, int lane, int krow0, bf16x8 qf0, bf16x8 qf1, float sdl, int ikw, f32x4 (&o)[4], float& mx, float& lsum) {
    const int n = lane & 15, g = lane >> 4;
    const LAS unsigned char* Kb = lds + AT_K_OFF + (krow0 + n) * AT_KS + g * 16;
    f32x4 sc[NKB];
#pragma unroll
    for (int kb = 0; kb < NKB; ++kb) {
        const bf16x8 k0 = *(const LAS bf16x8*)(Kb + kb * 16 * AT_KS), k1 = *(const LAS bf16x8*)(Kb + kb * 16 * AT_KS + 64);
        f32x4 a = (f32x4){0.f, 0.f, 0.f, 0.f};
        a = __builtin_amdgcn_mfma_f32_16x16x32_bf16(k0, qf0, a, 0, 0, 0);
        a = __builtin_amdgcn_mfma_f32_16x16x32_bf16(k1, qf1, a, 0, 0, 0);
        sc[kb] = a;
    }
    float m = -INFINITY;
#pragma unroll
    for (int kb = 0; kb < NKB; ++kb)
#pragma unroll
        for (int r = 0; r < 4; ++r) {
            if (DIL) { const int off = 16 * kb + 4 * g + r, rel = 144 + n - off; const bool valid = (rel >= 0) && (rel <= 128) && (ikw + off >= 0);
                sc[kb][r] = valid ? (sc[kb][r] - sdl * (float)rel) : -INFINITY; }
            m = fmaxf(m, sc[kb][r]); }
    m = fmaxf(m, __shfl_xor(m, 16)); m = fmaxf(m, __shfl_xor(m, 32));
    float l = 0.f;
#pragma unroll
    for (int kb = 0; kb < NKB; ++kb)
#pragma unroll
        for (int r = 0; r < 4; ++r) { sc[kb][r] = __expf(sc[kb][r] - m); l += sc[kb][r]; }
    l += __shfl_xor(l, 16); l += __shfl_xor(l, 32);
    mx = m; lsum = l;
    const LAS unsigned char* Vb = lds + AT_V_OFF + (krow0 + 4 * g + (n >> 2)) * AT_VS + (n & 3) * 8;
#pragma unroll
    for (int db = 0; db < 4; ++db) o[db] = (f32x4){0.f, 0.f, 0.f, 0.f};
#pragma unroll
    for (int kk = 0; kk < NKB / 2; ++kk) {
        union { bf16x8 v; unsigned u[4]; } pf;
        pf.u[0] = cvt_pk_bf16(sc[2 * kk][0], sc[2 * kk][1]); pf.u[1] = cvt_pk_bf16(sc[2 * kk][2], sc[2 * kk][3]);
        pf.u[2] = cvt_pk_bf16(sc[2 * kk + 1][0], sc[2 * kk + 1][1]); pf.u[3] = cvt_pk_bf16(sc[2 * kk + 1][2], sc[2 * kk + 1][3]);
#pragma unroll
        for (int db = 0; db < 4; ++db) {
            const s16x4 v0 = __builtin_amdgcn_ds_read_tr16_b64_v4i16((LAS s16x4*)(Vb + (2 * kk) * 16 * AT_VS + db * 32));
            const s16x4 v1 = __builtin_amdgcn_ds_read_tr16_b64_v4i16((LAS s16x4*)(Vb + (2 * kk + 1) * 16 * AT_VS + db * 32));
            const bf16x8 vf = __builtin_shufflevector(v0, v1, 0, 1, 2, 3, 4, 5, 6, 7);
            o[db] = __builtin_amdgcn_mfma_f32_16x16x32_bf16(vf, pf.v, o[db], 0, 0, 0);
        }
    }
}

__device__ __forceinline__ void memattn_mfma(const Ctx& C, const bf16_t* QM, const bf16_t* MKV, int ck, int cv, bf16_t* OUT, int ldo, int coff) {
    const int n = C.lane & 15, g = C.lane >> 4;
    for (int unit = C.bid; unit < NB * 4 * 16; unit += C.G) {
        const int b = unit >> 6, h = (unit >> 4) & 3, qt = unit & 15;
        __syncthreads();
#pragma unroll
        for (int it = 0; it < 4; ++it) { const int row = it * 64 + (C.tid >> 3), c = C.tid & 7;
            const bf16_t* src = MKV + (size_t)(b * NMEM + row) * 1024 + h * 64 + c * 8;
            const u32x4 kv = *(const u32x4*)(src + ck), vv = *(const u32x4*)(src + cv);
            *(LAS u32x4*)(C.lds + AT_K_OFF + row * AT_KS + c * 16) = kv; *(LAS u32x4*)(C.lds + AT_V_OFF + row * AT_VS + c * 16) = vv; }
        const int tok = b * SEQ + qt * 128 + C.wave * 16 + n;
        const bf16_t* qp = QM + (size_t)tok * 256 + h * 64 + g * 8;
        const bf16x8 qf0 = *(const bf16x8*)qp, qf1 = *(const bf16x8*)(qp + 32);
        __syncthreads();
        f32x4 o[4]; float mx, l;
        attn_compute<16, false>(C.lds, C.lane, 0, qf0, qf1, 0.f, 0, o, mx, l);
        const float inv = 1.0f / l;
#pragma unroll
        for (int db = 0; db < 4; ++db)
            *(u32x2*)(OUT + (size_t)tok * ldo + coff + h * 64 + 16 * db + 4 * g) = (u32x2){cvt_pk_bf16(o[db][0] * inv, o[db][1] * inv), cvt_pk_bf16(o[db][2] * inv, o[db][3] * inv)};
    }
}
__device__ __forceinline__ void dilattn_mfma(const Ctx& C) {
    const bf16_t* Q = (const bf16_t*)(C.ws + WS_Q); const bf16_t* K = (const bf16_t*)(C.ws + WS_K); const bf16_t* V = (const bf16_t*)(C.ws + WS_V);
    bf16_t* OG = (bf16_t*)(C.ws + WS_OG); float* LSE = (float*)(C.ws + WS_LSE);
    const int n = C.lane & 15, g = C.lane >> 4;
    for (int unit = C.bid; unit < 12 * 128; unit += C.G) {
        const int h = unit >> 7, rem = unit & 127, b = rem >> 4, x = rem & 15, grp = h >> 2;
        const int dl = (grp == 0) ? 1 : (grp == 1 ? 4 : 16), ntile = 16 / dl, r = x / ntile, I0 = (x % ntile) * 128;
        const float sdl = exp2f(-(float)(h + 1) * (8.0f / 12.0f)) * (float)dl;
        __syncthreads();
        { u32x4 kv[5], vv[5];
#pragma unroll
          for (int it = 0; it < 5; ++it) { const int idx = it * NTHREADS + C.tid, row = idx >> 3, c = idx & 7, ik = I0 - 144 + row;
              kv[it] = (u32x4){0u, 0u, 0u, 0u}; vv[it] = (u32x4){0u, 0u, 0u, 0u};
              if (idx < AT_ROWS * 8 && ik >= 0) { const size_t off = (size_t)(b * SEQ + ik * dl + r) * SGW + h * 64 + c * 8; kv[it] = *(const u32x4*)(K + off); vv[it] = *(const u32x4*)(V + off); } }
#pragma unroll
          for (int it = 0; it < 5; ++it) { const int idx = it * NTHREADS + C.tid, row = idx >> 3, c = idx & 7;
              if (idx < AT_ROWS * 8) { *(LAS u32x4*)(C.lds + AT_K_OFF + row * AT_KS + c * 16) = kv[it]; *(LAS u32x4*)(C.lds + AT_V_OFF + row * AT_VS + c * 16) = vv[it]; } } }
        const int iq = I0 + C.wave * 16 + n, tok = b * SEQ + iq * dl + r;
        const bf16_t* qp = Q + (size_t)tok * SGW + h * 64 + g * 8;
        const bf16x8 qf0 = *(const bf16x8*)qp, qf1 = *(const bf16x8*)(qp + 32);
        __syncthreads();
        f32x4 o[4]; float mx, l;
        attn_compute<10, true>(C.lds, C.lane, C.wave * 16, qf0, qf1, sdl, I0 + C.wave * 16 - 144, o, mx, l);
        const float inv = 1.0f / l;
#pragma unroll
        for (int db = 0; db < 4; ++db)
            *(u32x2*)(OG + (size_t)tok * SGW + h * 64 + 16 * db + 4 * g) = (u32x2){cvt_pk_bf16(o[db][0] * inv, o[db][1] * inv), cvt_pk_bf16(o[db][2] * inv, o[db][3] * inv)};
        if (g == 0) LSE[tok * 12 + h] = mx + __logf(l);
    }
}
constexpr int SG_GVN_OFF = 1024, SG_VS = 160, SG_TILE = 128 * SG_VS, SG_GB_OFF = SG_GVN_OFF + 6 * SG_TILE;
static_assert(SG_GB_OFF + 2 * 384 * 4 <= 131072, "spatial-gating LDS map");
__device__ __forceinline__ void sg_mfma(const Ctx& C, const Args& A) {
    const bf16_t* U = (const bf16_t*)(C.ws + WS_U); const bf16_t* GV = (const bf16_t*)(C.ws + WS_GV); bf16_t* CAT = (bf16_t*)(C.ws + WS_CAT);
    const bf16_t* WB = (const bf16_t*)(C.ws + WS_SGWB); const float* RS = (const float*)(C.ws + WS_SGRS);
    const float* lng = A.in[4]; const float* lnb = A.in[5]; const float* sgb = A.in[7];
    LAS float* stat = (LAS float*)C.lds; LAS float* gbl = (LAS float*)(C.lds + SG_GB_OFF);
    const int n = C.lane & 15, gl = C.lane >> 4;
    for (int unit = C.bid; unit < NB * 16 * 2; unit += C.G) {
        const int tb = (unit >> 1) * 128, g0 = (unit & 1) * 6;
        __syncthreads();
        u32x4 wt[12];
#pragma unroll
        for (int k = 0; k < 12; ++k) { const int rg = k * 64 + (C.tid >> 3), gi = rg >> 7, row = rg & 127, c = C.tid & 7;
            wt[k] = *(const u32x4*)(GV + (size_t)(tb + row) * SGW + (g0 + gi) * 64 + c * 8); }
        if (C.tid < 192) { const int half = C.tid / 96, i4 = C.tid % 96; *(LAS f32x4*)(gbl + half * 384 + 4 * i4) = *(const f32x4*)((half ? lnb : lng) + g0 * 64 + 4 * i4); }
        for (int r8 = 0; r8 < 16; r8 += 8) {
            u32x2 w[8][3];
#pragma unroll
            for (int q = 0; q < 8; ++q)
#pragma unroll
                for (int j = 0; j < 3; ++j) w[q][j] = *(const u32x2*)(GV + (size_t)(tb + C.wave * 16 + r8 + q) * SGW + 4 * C.lane + 256 * j);
#pragma unroll
            for (int q = 0; q < 8; ++q) { float s = 0.f, ss = 0.f;
#pragma unroll
                for (int j = 0; j < 3; ++j) { const float a = bflo(w[q][j].x), b = bfhi(w[q][j].x), c = bflo(w[q][j].y), d = bfhi(w[q][j].y);
                    s += (a + b) + (c + d); ss += (a * a + b * b) + (c * c + d * d); }
                s = wave_sum_dpp(s); ss = wave_sum_dpp(ss);
                const float mean = s * (1.f / SGW), var = ss * (1.f / SGW) - mean * mean; const int row = C.wave * 16 + r8 + q;
                if (C.lane == 0) { stat[row * 2] = mean; stat[row * 2 + 1] = 1.0f / sqrtf(var + LN_EPS); } } }
        __syncthreads();
#pragma unroll
        for (int k = 0; k < 12; ++k) { const int rg = k * 64 + (C.tid >> 3), gi = rg >> 7, row = rg & 127, c = C.tid & 7;
            const float mean = stat[row * 2], rstd = stat[row * 2 + 1]; u32x4 o;
            o.x = cvt_pk_bf16((bflo(wt[k].x) - mean) * rstd, (bfhi(wt[k].x) - mean) * rstd); o.y = cvt_pk_bf16((bflo(wt[k].y) - mean) * rstd, (bfhi(wt[k].y) - mean) * rstd);
            o.z = cvt_pk_bf16((bflo(wt[k].z) - mean) * rstd, (bfhi(wt[k].z) - mean) * rstd); o.w = cvt_pk_bf16((bflo(wt[k].w) - mean) * rstd, (bfhi(wt[k].w) - mean) * rstd);
            *(LAS u32x4*)(C.lds + SG_GVN_OFF + gi * SG_TILE + row * SG_VS + c * 16) = o; }
        __syncthreads();
        const int p = C.wave * 16 + n;
#pragma unroll 3
        for (int gi = 0; gi < 6; ++gi) {
            const int g = g0 + gi;
            const bf16_t* wp = WB + (size_t)(g * 128 + p) * 128 + 8 * gl;
            bf16x8 wf[4];
#pragma unroll
            for (int ks = 0; ks < 4; ++ks) wf[ks] = *(const bf16x8*)(wp + 32 * ks);
            u32x2 uw[4];
#pragma unroll
            for (int db = 0; db < 4; ++db) uw[db] = *(const u32x2*)(U + (size_t)(tb + p) * SGW + (size_t)g * 64 + 16 * db + 4 * gl);
            const float bs = sgb[g * 128 + p], rsw = RS[g * 128 + p];
            f32x4 acc[4];
#pragma unroll
            for (int db = 0; db < 4; ++db) acc[db] = (f32x4){0.f, 0.f, 0.f, 0.f};
            const LAS unsigned char* vb = C.lds + SG_GVN_OFF + gi * SG_TILE + (8 * gl + (n >> 2)) * SG_VS + (n & 3) * 8;
#pragma unroll
            for (int ks = 0; ks < 4; ++ks)
#pragma unroll
                for (int db = 0; db < 4; ++db) {
                    const s16x4 v0 = __builtin_amdgcn_ds_read_tr16_b64_v4i16((LAS s16x4*)(vb + ks * 32 * SG_VS + db * 32));
                    const s16x4 v1 = __builtin_amdgcn_ds_read_tr16_b64_v4i16((LAS s16x4*)(vb + ks * 32 * SG_VS + 4 * SG_VS + db * 32));
                    const bf16x8 vf = __builtin_shufflevector(v0, v1, 0, 1, 2, 3, 4, 5, 6, 7);
                    acc[db] = __builtin_amdgcn_mfma_f32_16x16x32_bf16(vf, wf[ks], acc[db], 0, 0, 0);
                }
#pragma unroll
            for (int db = 0; db < 4; ++db) { const int cl = gi * 64 + 16 * db + 4 * gl; const size_t co = (size_t)g * 64 + 16 * db + 4 * gl;
                const f32x4 ga = *(const LAS f32x4*)(gbl + cl), be = *(const LAS f32x4*)(gbl + 384 + cl);
                const float s0 = ga[0] * acc[db][0] + (be[0] * rsw + bs), s1 = ga[1] * acc[db][1] + (be[1] * rsw + bs);
                const float s2 = ga[2] * acc[db][2] + (be[2] * rsw + bs), s3 = ga[3] * acc[db][3] + (be[3] * rsw + bs);
                *(u32x2*)(CAT + (size_t)(tb + p) * D + co) = (u32x2){cvt_pk_bf16(bflo(uw[db].x) * s0, bfhi(uw[db].x) * s1), cvt_pk_bf16(bflo(uw[db].y) * s2, bfhi(uw[db].y) * s3)}; }
        }
    }
}
__device__ __forceinline__ void dil_merge(const Ctx& C, const Args& A) {
    const bf16_t* OG = (const bf16_t*)(C.ws + WS_OG); const float* LSE = (const float*)(C.ws + WS_LSE); bf16_t* CAT2 = (bf16_t*)(C.ws + WS_CAT2);
    const int gt = C.bid * NTHREADS + C.tid, NT = C.G * NTHREADS;
    for (int it = gt; it < T * 32; it += NT) {
        const int tok = it >> 5, j = (it >> 3) & 3, c8 = it & 7;
        const float l0 = LSE[tok * 12 + j], l1 = LSE[tok * 12 + 4 + j], l2 = LSE[tok * 12 + 8 + j];
        const float mx = fmaxf(l0, fmaxf(l1, l2));
        float w0 = __expf(l0 - mx), w1 = __expf(l1 - mx), w2 = __expf(l2 - mx); const float inv = 1.0f / (w0 + w1 + w2); w0 *= inv; w1 *= inv; w2 *= inv;
        const u32x4 a = *(const u32x4*)(OG + (size_t)tok * SGW + j * 64 + c8 * 8), b = *(const u32x4*)(OG + (size_t)tok * SGW + (4 + j) * 64 + c8 * 8), c = *(const u32x4*)(OG + (size_t)tok * SGW + (8 + j) * 64 + c8 * 8);
        u32x4 o;
        o.x = pk2(w0 * bflo(a.x) + w1 * bflo(b.x) + w2 * bflo(c.x), w0 * bfhi(a.x) + w1 * bfhi(b.x) + w2 * bfhi(c.x));
        o.y = pk2(w0 * bflo(a.y) + w1 * bflo(b.y) + w2 * bflo(c.y), w0 * bfhi(a.y) + w1 * bfhi(b.y) + w2 * bfhi(c.y));
        o.z = pk2(w0 * bflo(a.z) + w1 * bflo(b.z) + w2 * bflo(c.z), w0 * bfhi(a.z) + w1 * bfhi(b.z) + w2 * bfhi(c.z));
        o.w = pk2(w0 * bflo(a.w) + w1 * bflo(b.w) + w2 * bflo(c.w), w0 * bfhi(a.w) + w1 * bfhi(b.w) + w2 * bfhi(c.w));
        *(u32x4*)(CAT2 + (size_t)tok * 512 + j * 64 + c8 * 8) = o;
    }
}

constexpr int LR_WS = 2064;
__device__ __forceinline__ void ln_route(const Ctx& C, const Args& A, int layer, int cset) {
    const bf16_t* Y = (const bf16_t*)(C.ws + WS_Y); bf16_t* X1B = (bf16_t*)(C.ws + WS_X1B); unsigned char* X1F8 = C.ws + WS_X1F8;
    const float* lg = A.in[14] + layer * D; const float* lb = A.in[15] + layer * D; const float* br = A.in[19];
    unsigned* cnt = (unsigned*)(C.ws + WS_CTL) + CW_CNT + cset * 16 * 64;
    int* tokE = (int*)(C.ws + WS_TOKE); int* tokP = (int*)(C.ws + WS_TOKP); float* tokG = (float*)(C.ws + WS_TOKG); int* list = (int*)(C.ws + WS_LIST);
    LAS unsigned char* wl = C.lds;
    LAS int* sE = (LAS int*)(C.lds + 65536); LAS float* sG = (LAS float*)(C.lds + 65536 + 512); LAS int* sPos = (LAS int*)(C.lds + 65536 + 1024);
    LAS int* lcnt = (LAS int*)(C.lds + 65536 + 1536); LAS int* lbase = (LAS int*)(C.lds + 65536 + 1600); LAS float* slog = (LAS float*)(C.lds + 65536 + 2048);
    __syncthreads();
#pragma unroll
    for (int it = 0; it < 4; ++it) { const int i = it * NTHREADS + C.tid, e = i >> 7, c = i & 127;
        *(LAS u32x4*)(wl + e * LR_WS + c * 16) = *(const u32x4*)((const bf16_t*)(C.ws + WS_WRT) + (size_t)e * 1024 + c * 8); }
    f32x4 g4[4], b4[4];
#pragma unroll
    for (int j = 0; j < 4; ++j) { g4[j] = *(const f32x4*)(lg + 4 * C.lane + 256 * j); b4[j] = *(const f32x4*)(lb + 4 * C.lane + 256 * j); }
    const int n = C.lane & 15, q = C.lane >> 4;
    for (int blk = C.bid; blk < T / 64; blk += C.G) {
        __syncthreads();
        if (C.tid < 16) lcnt[C.tid] = 0;
        u32x2 nv[4];
        { const u32x2* yb = (const u32x2*)(Y + (size_t)(blk * 64 + C.wave * 8) * D) + C.lane;
#pragma unroll
          for (int j = 0; j < 4; ++j) nv[j] = yb[64 * j]; }
#pragma unroll 1
        for (int tq = 0; tq < 8; ++tq) {
            const int tok = blk * 64 + C.wave * 8 + tq;
            f32x4 v[4]; float s = 0.f;
#pragma unroll
            for (int j = 0; j < 4; ++j) { v[j] = (f32x4){bflo(nv[j].x), bfhi(nv[j].x), bflo(nv[j].y), bfhi(nv[j].y)}; s += (v[j][0] + v[j][1]) + (v[j][2] + v[j][3]); }
            { const u32x2* yb = (const u32x2*)(Y + (size_t)(tok + (tq < 7 ? 1 : 0)) * D) + C.lane;
#pragma unroll
              for (int j = 0; j < 4; ++j) nv[j] = yb[64 * j]; }
            const float mean = wave_sum_dpp(s) * (1.f / D); float s2 = 0.f;
#pragma unroll
            for (int j = 0; j < 4; ++j) { v[j] = v[j] - mean; s2 += (v[j][0] * v[j][0] + v[j][1] * v[j][1]) + (v[j][2] * v[j][2] + v[j][3] * v[j][3]); }
            const float rstd = 1.0f / sqrtf(wave_sum_dpp(s2) * (1.f / D) + LN_EPS);
            u32x2* xb = (u32x2*)(X1B + (size_t)tok * D) + C.lane; unsigned* x8 = (unsigned*)(X1F8 + (size_t)tok * D) + C.lane;
#pragma unroll
            for (int j = 0; j < 4; ++j) { v[j] = v[j] * rstd * g4[j] + b4[j];
                xb[64 * j] = (u32x2){pk2(v[j][0], v[j][1]), pk2(v[j][2], v[j][3])};
                x8[64 * j] = pk4_fp8(v[j][0], v[j][1], v[j][2], v[j][3]); }
        }
        asm volatile("s_waitcnt vmcnt(0)" ::: "memory");
        __syncthreads();
        {
            const int tile = C.wave & 3, kh = C.wave >> 2;
            const bf16_t* ap = X1B + (size_t)(blk * 64 + tile * 16 + n) * D + kh * 512 + 8 * q;
            const LAS unsigned char* bp = wl + n * LR_WS + (kh * 512 + 8 * q) * 2;
            bf16x8 af[16];
#pragma unroll
            for (int ks = 0; ks < 16; ++ks) af[ks] = *(const bf16x8*)(ap + 32 * ks);
            f32x4 acc = (f32x4){0.f, 0.f, 0.f, 0.f};
#pragma unroll
            for (int ks = 0; ks < 16; ++ks) { const bf16x8 bf = *(const LAS bf16x8*)(bp + 64 * ks); acc = __builtin_amdgcn_mfma_f32_16x16x32_bf16(af[ks], bf, acc, 0, 0, 0); }
#pragma unroll
            for (int r = 0; r < 4; ++r) slog[(kh * 64 + tile * 16 + 4 * q + r) * 17 + n] = acc[r];
        }
        __syncthreads();
        if (C.tid < 64) {
            const int tl = C.tid;
            float pr[16]; float mx = -INFINITY;
#pragma unroll
            for (int e = 0; e < 16; ++e) { pr[e] = slog[tl * 17 + e] + slog[(64 + tl) * 17 + e]; mx = fmaxf(mx, pr[e]); }
            float sum = 0.f;
#pragma unroll
            for (int e = 0; e < 16; ++e) { pr[e] = __expf(pr[e] - mx); sum += pr[e]; }
            const float inv = 1.0f / sum; float sel[16];
#pragma unroll
            for (int e = 0; e < 16; ++e) { pr[e] *= inv; sel[e] = pr[e] + br[e]; }
            float gs[4];
#pragma unroll
            for (int g = 0; g < 4; ++g) { const float a = sel[4 * g], b = sel[4 * g + 1], c = sel[4 * g + 2], d = sel[4 * g + 3];
                gs[g] = fmaxf(fmaxf(fmaxf(a + b, a + c), fmaxf(a + d, b + c)), fmaxf(b + d, c + d)); }
            int gi = 0; float bsc = gs[0];
#pragma unroll
            for (int g = 1; g < 4; ++g) if (gs[g] > bsc) { bsc = gs[g]; gi = g; }
            float sg[4], pg[4];
#pragma unroll
            for (int k = 0; k < 4; ++k) { sg[k] = gi == 0 ? sel[k] : (gi == 1 ? sel[4 + k] : (gi == 2 ? sel[8 + k] : sel[12 + k])); pg[k] = gi == 0 ? pr[k] : (gi == 1 ? pr[4 + k] : (gi == 2 ? pr[8 + k] : pr[12 + k])); }
            int i1 = 0; float b1 = sg[0], p1 = pg[0];
#pragma unroll
            for (int k = 1; k < 4; ++k) if (sg[k] > b1) { b1 = sg[k]; i1 = k; p1 = pg[k]; }
            int i2 = -1; float b2 = -INFINITY, p2 = 0.f;
#pragma unroll
            for (int k = 0; k < 4; ++k) if (k != i1 && sg[k] > b2) { b2 = sg[k]; i2 = k; p2 = pg[k]; }
            const float gsum = p1 + p2; sE[tl * 2] = gi * 4 + i1; sE[tl * 2 + 1] = gi * 4 + i2; sG[tl * 2] = p1 / gsum; sG[tl * 2 + 1] = p2 / gsum;
        }
        __syncthreads();
        if (C.tid < 128) sPos[C.tid] = __hip_atomic_fetch_add(lcnt + sE[C.tid], 1, __ATOMIC_RELAXED, __HIP_MEMORY_SCOPE_WORKGROUP);
        __syncthreads();
        if (C.tid < 16) lbase[C.tid] = (int)__hip_atomic_fetch_add(cnt + C.tid * 64, (unsigned)lcnt[C.tid], __ATOMIC_RELAXED, __HIP_MEMORY_SCOPE_AGENT);
        __syncthreads();
        if (C.tid < 128) { const int e = sE[C.tid], pos = lbase[e] + sPos[C.tid], tok = blk * 64 + (C.tid >> 1);
            list[e * LISTCAP + pos] = tok; tokE[tok * 2 + (C.tid & 1)] = e; tokP[tok * 2 + (C.tid & 1)] = pos; tokG[tok * 2 + (C.tid & 1)] = sG[C.tid]; }
    }
}
__device__ __forceinline__ void moe_prefix(const Ctx& C, int layer) {
    LAS int* mi = (LAS int*)(C.lds + LDS_MISC);
    unsigned* cnt = (unsigned*)(C.ws + WS_CTL) + CW_CNT + layer * 16 * 64;
    __syncthreads();
    if (C.tid < 16) mi[17 + C.tid] = (int)__hip_atomic_load(cnt + C.tid * 64, __ATOMIC_RELAXED, __HIP_MEMORY_SCOPE_AGENT);
    __syncthreads();
    if (C.tid == 0) { int a = 0; for (int e = 0; e < 16; ++e) { mi[e] = a; a += (mi[17 + e] + 255) >> 8; } mi[16] = a; }
    __syncthreads();
}
__device__ __forceinline__ void moe_tokens(const Ctx& C, int ntn) {
    const LAS int* mi = (const LAS int*)(C.lds + LDS_MISC); LAS int* toks = (LAS int*)(C.lds + LDS_TOKS);
    const int* list = (const int*)(C.ws + WS_LIST);
    for (int u = 0; u < MAX_UNITS; ++u) {
        const int L = u * C.G + C.bid; if (L >= mi[16] * ntn) break;
        int e = 0;
#pragma unroll
        for (int j = 1; j < 16; ++j) e += (L >= mi[j] * ntn) ? 1 : 0;
        const int r = L - mi[e] * ntn, te = mi[e + 1] - mi[e], mt = r % te, cn = mi[17 + e];
        if (C.tid < 256) { int pos = mt * 256 + C.tid; pos = pos < cn ? pos : cn - 1; toks[u * 256 + C.tid] = list[e * LISTCAP + pos]; }
    }
    __syncthreads();
}
__device__ __forceinline__ void combine_ln2(const Ctx& C, const Args& A, int layer) {
    const LAS int* mi = (const LAS int*)(C.lds + LDS_MISC);
    const bf16_t* X1B = (const bf16_t*)(C.ws + WS_X1B); const bf16_t* YD = (const bf16_t*)(C.ws + WS_YD); bf16_t* X2B = (bf16_t*)(C.ws + WS_XB);
    const int* tokE = (const int*)(C.ws + WS_TOKE); const int* tokP = (const int*)(C.ws + WS_TOKP); const float* tokG = (const float*)(C.ws + WS_TOKG);
    const float* lg = A.in[16] + layer * D; const float* lb = A.in[17] + layer * D;
    for (int tok0 = C.gw * 8; tok0 < T; tok0 += C.NGW * 8) {
        int rowv = 0; float gv = 0.f;
        if (C.lane < 16) { const int e = tokE[tok0 * 2 + C.lane]; rowv = mi[e] * 256 + tokP[tok0 * 2 + C.lane]; gv = tokG[tok0 * 2 + C.lane]; }
#pragma unroll 1
        for (int tq = 0; tq < 8; tq += 4) {
            u32x2 xa[4][4], y0[4][4], y1[4][4]; float g0[4], g1[4];
#pragma unroll
            for (int t = 0; t < 4; ++t) {
                const int ra = __shfl(rowv, 2 * (tq + t)), rb = __shfl(rowv, 2 * (tq + t) + 1);
                g0[t] = __shfl(gv, 2 * (tq + t)); g1[t] = __shfl(gv, 2 * (tq + t) + 1);
                const u32x2* xp = (const u32x2*)(X1B + (size_t)(tok0 + tq + t) * D) + C.lane; const u32x2* pa = (const u32x2*)(YD + (size_t)ra * D) + C.lane; const u32x2* pb = (const u32x2*)(YD + (size_t)rb * D) + C.lane;
#pragma unroll
                for (int j = 0; j < 4; ++j) { xa[t][j] = xp[64 * j]; y0[t][j] = pa[64 * j]; y1[t][j] = pb[64 * j]; }
            }
#pragma unroll
            for (int t = 0; t < 4; ++t) {
                f32x4 v[4]; float s = 0.f;
#pragma unroll
                for (int j = 0; j < 4; ++j) {
                    v[j][0] = ALPHA * bflo(xa[t][j].x) + (g0[t] * bflo(y0[t][j].x) + g1[t] * bflo(y1[t][j].x)); v[j][1] = ALPHA * bfhi(xa[t][j].x) + (g0[t] * bfhi(y0[t][j].x) + g1[t] * bfhi(y1[t][j].x));
                    v[j][2] = ALPHA * bflo(xa[t][j].y) + (g0[t] * bflo(y0[t][j].y) + g1[t] * bflo(y1[t][j].y)); v[j][3] = ALPHA * bfhi(xa[t][j].y) + (g0[t] * bfhi(y0[t][j].y) + g1[t] * bfhi(y1[t][j].y));
                    s += (v[j][0] + v[j][1]) + (v[j][2] + v[j][3]); }
                const float mean = wave_sum_dpp(s) * (1.f / D); float s2 = 0.f;
#pragma unroll
                for (int j = 0; j < 4; ++j) { v[j] = v[j] - mean; s2 += (v[j][0] * v[j][0] + v[j][1] * v[j][1]) + (v[j][2] * v[j][2] + v[j][3] * v[j][3]); }
                const float rstd = 1.0f / sqrtf(wave_sum_dpp(s2) * (1.f / D) + LN_EPS);
                const int tok = tok0 + tq + t;
#pragma unroll
                for (int j = 0; j < 4; ++j) { const int col = 4 * C.lane + 256 * j; const f32x4 g4 = *(const f32x4*)(lg + col), b4 = *(const f32x4*)(lb + col);
                    const f32x4 o = v[j] * rstd * g4 + b4;
                    if (layer == 0) *(u32x2*)(X2B + (size_t)tok * D + col) = (u32x2){pk2(o[0], o[1]), pk2(o[2], o[3])};
                    else *(f32x4*)(A.out + (size_t)tok * D + col) = o; }
            }
        }
    }
}

__global__ void __launch_bounds__(NTHREADS, 2) yoco_fwd(Args args) {
    extern __shared__ __attribute__((aligned(16))) unsigned char lds_raw[];
    Ctx C;
    C.ws = args.ws; C.lds = (LAS unsigned char*)lds_raw;
    C.tid = threadIdx.x; C.lane = C.tid & 63; C.wave = __builtin_amdgcn_readfirstlane(C.tid >> 6);
    C.G = gridDim.x; C.bid = blockIdx.x; C.gw = C.bid * NWAVES + C.wave; C.NGW = C.G * NWAVES;
    unsigned char* ws = args.ws;
#define PHASE_WS() do { ws = launder(args.ws); C.ws = ws; C.tid = launder_v((int)threadIdx.x); C.lane = C.tid & 63; } while (0)
    volatile LAS unsigned* misc = (volatile LAS unsigned*)(C.lds + LDS_MISC);
    for (int u = C.tid; u < 64; u += NTHREADS) misc[u] = 0u;
    __syncthreads();
    XcdBarrier bar; bar.bar = (unsigned*)(ws + WS_CTL) + CW_BAR; bar.x = 0; bar.st = misc + 60;
    const int lo = args.ph_lo, hi = args.ph_hi;
    if (hi - lo > 1) bar = xcd_barrier_post((unsigned*)(ws + WS_CTL) + CW_BAR, misc + 60);
#define IN(k) (lo <= (k) && (k) < hi)
#define SEAMF(k) do { if (IN(k) && IN((k) + 1)) { PHASE_WS(); fill_tail(C, args, (k), false); xcd_barrier(bar); } } while (0)
#if MK_DIAG == 9
#define SEAM(k) do { if (IN(k) && IN((k) + 1)) { const unsigned long long t0_ = __builtin_amdgcn_s_memrealtime(); xcd_barrier(bar); if (((MK_DIAGMASK >> (k)) & 1) && threadIdx.x == 0) diag_acc += (unsigned)(__builtin_amdgcn_s_memrealtime() - t0_); } } while (0)
#else
#define SEAM(k) do { if (IN(k) && IN((k) + 1)) xcd_barrier(bar); } while (0)
#endif
#ifndef MK_DUP
#define MK_DUP 0
#endif
    unsigned diag_acc = 0;
#if MK_DIAG == 10
#define TREG(id, ...) do { __syncthreads(); const unsigned long long t0_ = __builtin_amdgcn_s_memrealtime(); __VA_ARGS__; __syncthreads(); if ((id) == MK_DIAGSEL) diag_acc += (unsigned)(__builtin_amdgcn_s_memrealtime() - t0_); } while (0)
#else
#define TREG(id, ...) do { __VA_ARGS__; } while (0)
#endif
#define REP(k) for (int rep_ = 0; rep_ < 1 + ((MK_DUP >> (k)) & 1); ++rep_)

    if (IN(0)) { REP(0) { PHASE_WS(); TREG(10, p0_prologue(C, args)); } SEAM(0); }

    if (IN(1)) {
        REP(1) {
        PHASE_WS();
        { pg8::Gemm g{(const bf16_t*)(ws + WS_XB), (const bf16_t*)(ws + WS_BT_INA), T, 1792, D}; pg8::StaticOrder S; S.init(T, 1792, C.G, C.bid);
          EpiProjA E{(bf16_t*)(ws + WS_U), (bf16_t*)(ws + WS_GV), (bf16_t*)(ws + WS_QM0)};
          pg8::gemm_phase<EpiProjA, pg8::StaticOrder>(C.lds, g, S, E, nullptr, C.tid); }
        { pg8::Gemm g{(const bf16_t*)(ws + WS_MEMB), (const bf16_t*)(ws + WS_BT_MEM), NB * NMEM, 1024, D}; SmallOrder S{4, 32, C.bid - (C.G - 32)};
          EpiPlain E{(bf16_t*)(ws + WS_MKV), 1024, 4};
          pg8::gemm_phase<EpiPlain, SmallOrder>(C.lds, g, S, E, nullptr, C.tid); }
        }
        SEAMF(1);
    }
    if (IN(2)) {
        REP(2) { PHASE_WS();
        TREG(1, sg_mfma(C, args));
        TREG(2, memattn_mfma(C, (const bf16_t*)(ws + WS_QM0), (const bf16_t*)(ws + WS_MKV), 0, 256, (bf16_t*)(ws + WS_CAT), D, SGW)); }
        SEAM(2);
    }
    if (IN(3)) {
        REP(3) { PHASE_WS();
        pg8::Gemm g{(const bf16_t*)(ws + WS_CAT), (const bf16_t*)(ws + WS_BT_OUTA), T, D, D}; pg8::StaticOrder S; S.init(T, D, C.G, C.bid);
        EpiResid<false> E{(const void*)args.in[0], (bf16_t*)(ws + WS_Y)};
        pg8::gemm_phase<EpiResid<false>, pg8::StaticOrder>(C.lds, g, S, E, nullptr, C.tid); }
        SEAM(3);
    }
    { constexpr int layer = 0;
        const int pb = 4 + 8 * layer;
        if (IN(pb)) { if ((MK_DUP >> 4) & 1) { PHASE_WS(); ln_route(C, args, layer, 2 + layer); __syncthreads(); } PHASE_WS(); TREG(6 + layer, ln_route(C, args, layer, layer)); SEAM(pb); }
        if (IN(pb + 1)) {
            REP(5) { PHASE_WS();
            moe_prefix(C, layer); moe_tokens(C, 8);
            MoeGatherOrder S; S.tb = (const LAS int*)(C.lds + LDS_MISC); S.ntn = 8; S.G = C.G; S.c = C.bid; S.toks = (const LAS int*)(C.lds + LDS_TOKS);
            {
                pg8::Gemm g{(const bf16_t*)(ws + WS_X1F8), (const bf16_t*)(ws + WS_WGU + (size_t)layer * (64 * MiB)), 0, 0, D / 2, E8_ONE, E8_W};
                EpiSwiGLU8 E{ws + WS_ACT};
                pg8::gemm_phase<EpiSwiGLU8, MoeGatherOrder, false, true>(C.lds, g, S, E, nullptr, C.tid);
            } }
            SEAMF(pb + 1);
        }
        if (IN(pb + 2)) {
            REP(6) { PHASE_WS();
            moe_prefix(C, layer);
            MoeOrder S{(const LAS int*)(C.lds + LDS_MISC), 4, C.G, C.bid};
            EpiPlain E{(bf16_t*)(ws + WS_YD), 1024, 4};
            {
                pg8::Gemm g{(const bf16_t*)(ws + WS_ACT), (const bf16_t*)(ws + WS_WD + (size_t)layer * (32 * MiB)), 0, 0, D / 2, E8_ACT, E8_W};
                pg8::gemm_phase<EpiPlain, MoeOrder, false, true>(C.lds, g, S, E, nullptr, C.tid);
            } }
            SEAMF(pb + 2);
        }
        if (IN(pb + 3)) { REP(7) { PHASE_WS(); moe_prefix(C, layer); TREG(8 + layer, combine_ln2(C, args, layer)); } if (layer == 0) SEAM(pb + 3); }
    }
    {
            if (IN(8)) {
                REP(8) { PHASE_WS();
                pg8::Gemm g{(const bf16_t*)(ws + WS_XB), (const bf16_t*)(ws + WS_BT_B), T, 2560, D}; pg8::StaticOrder S; S.init(T, 2560, C.G, C.bid);
                EpiProjB E{(bf16_t*)(ws + WS_K), (bf16_t*)(ws + WS_V), (bf16_t*)(ws + WS_Q), (bf16_t*)(ws + WS_QM1)};
                pg8::gemm_phase<EpiProjB, pg8::StaticOrder>(C.lds, g, S, E, nullptr, C.tid); }
                SEAMF(8);
            }
            if (IN(9)) {
                REP(9) { PHASE_WS();
                TREG(3, dilattn_mfma(C));
                TREG(4, memattn_mfma(C, (const bf16_t*)(ws + WS_QM1), (const bf16_t*)(ws + WS_MKV), 512, 768, (bf16_t*)(ws + WS_CAT2), 512, 256)); }
                SEAM(9);
            }
            if (IN(10)) { REP(10) { PHASE_WS(); TREG(5, dil_merge(C, args)); } SEAM(10); }
            if (IN(11)) {
                REP(11) { PHASE_WS();
                pg8::Gemm g{(const bf16_t*)(ws + WS_CAT2), (const bf16_t*)(ws + WS_BT_OUTB), T, D, 512}; pg8::StaticOrder S; S.init(T, D, C.G, C.bid);
                EpiResid<true> E{(const void*)(ws + WS_XB), (bf16_t*)(ws + WS_Y)};
                pg8::gemm_phase<EpiResid<true>, pg8::StaticOrder>(C.lds, g, S, E, nullptr, C.tid); }
                if (IN(11)) { PHASE_WS(); fill_tail(C, args, 11, true); }
                SEAM(11);
            }
    }
    { constexpr int layer = 1;
        const int pb = 4 + 8 * layer;
        if (IN(pb)) { if ((MK_DUP >> 4) & 1) { PHASE_WS(); ln_route(C, args, layer, 2 + layer); __syncthreads(); } PHASE_WS(); TREG(6 + layer, ln_route(C, args, layer, layer)); SEAM(pb); }
        if (IN(pb + 1)) {
            REP(5) { PHASE_WS();
            moe_prefix(C, layer); moe_tokens(C, 8);
            MoeGatherOrder S; S.tb = (const LAS int*)(C.lds + LDS_MISC); S.ntn = 8; S.G = C.G; S.c = C.bid; S.toks = (const LAS int*)(C.lds + LDS_TOKS);
            {
                pg8::Gemm g{(const bf16_t*)(ws + WS_X1F8), (const bf16_t*)(ws + WS_WGU + (size_t)layer * (64 * MiB)), 0, 0, D / 2, E8_ONE, E8_W};
                EpiSwiGLU8 E{ws + WS_ACT};
                pg8::gemm_phase<EpiSwiGLU8, MoeGatherOrder, false, true>(C.lds, g, S, E, nullptr, C.tid);
            } }
            SEAM(pb + 1);
        }
        if (IN(pb + 2)) {
            REP(6) { PHASE_WS();
            moe_prefix(C, layer);
            MoeOrder S{(const LAS int*)(C.lds + LDS_MISC), 4, C.G, C.bid};
            EpiPlain E{(bf16_t*)(ws + WS_YD), 1024, 4};
            {
                pg8::Gemm g{(const bf16_t*)(ws + WS_ACT), (const bf16_t*)(ws + WS_WD + (size_t)layer * (32 * MiB)), 0, 0, D / 2, E8_ACT, E8_W};
                pg8::gemm_phase<EpiPlain, MoeOrder, false, true>(C.lds, g, S, E, nullptr, C.tid);
            } }
            SEAM(pb + 2);
        }
        if (IN(pb + 3)) { REP(7) { PHASE_WS(); moe_prefix(C, layer); TREG(8 + layer, combine_ln2(C, args, layer)); } if (layer == 0) SEAM(pb + 3); }
    }
#if MK_DIAG == 3
    xcd_barrier(bar);
    if (blockIdx.x == 0 && threadIdx.x == 0) { const unsigned got = __hip_atomic_fetch_add((unsigned*)(args.ws + WS_CTL) + 30000, 0u, __ATOMIC_RELAXED, __HIP_MEMORY_SCOPE_AGENT); const unsigned long long t0 = __builtin_amdgcn_s_memrealtime();
        const unsigned long long dur = (unsigned long long)got * 4ull;
        while (__builtin_amdgcn_s_memrealtime() - t0 < dur) __builtin_amdgcn_s_sleep(8); }
#endif
#if MK_DIAG == 11
    if (blockIdx.x == 0 && threadIdx.x == 0) { const unsigned long long t0 = __builtin_amdgcn_s_memrealtime(); const unsigned long long dur = (unsigned long long)misc[42] * 4ull;
        while (__builtin_amdgcn_s_memrealtime() - t0 < dur) __builtin_amdgcn_s_sleep(8); }
#endif
#if MK_DIAG == 10
    if (blockIdx.x == 0 && threadIdx.x == 0) { const unsigned long long t0 = __builtin_amdgcn_s_memrealtime(); const unsigned long long dur = (unsigned long long)diag_acc * 4ull;
        while (__builtin_amdgcn_s_memrealtime() - t0 < dur) __builtin_amdgcn_s_sleep(8); }
#endif
#if MK_DIAG == 9
    if (threadIdx.x == 0) __hip_atomic_fetch_add((unsigned*)(args.ws + WS_CTL) + 30000, diag_acc, __ATOMIC_RELAXED, __HIP_MEMORY_SCOPE_AGENT);
    xcd_barrier(bar);
    if (blockIdx.x == 0 && threadIdx.x == 0) { const unsigned got = __hip_atomic_fetch_add((unsigned*)(args.ws + WS_CTL) + 30000, 0u, __ATOMIC_RELAXED, __HIP_MEMORY_SCOPE_AGENT); const unsigned long long t0 = __builtin_amdgcn_s_memrealtime();
        const unsigned long long dur = (unsigned long long)got / 256ull;
        while (__builtin_amdgcn_s_memrealtime() - t0 < dur) __builtin_amdgcn_s_sleep(8); }
#endif
#undef IN
#undef SEAM
}
}

extern "C" void kernel_launch(void* const* d_in, const int* in_sizes, int n_in, void* d_out, int out_size, void* d_ws, size_t ws_size, hipStream_t stream) {
    using namespace mk;
    static int grid = 0;
    if (grid == 0) {
        if (n_in != 23 || out_size != T * D || ws_size < WS_END) { fprintf(stderr, "kernel_launch: unexpected shapes (n_in %d, out %d, ws %zu)\n", n_in, out_size, ws_size); grid = -1; return; }
        int dev = 0, cus = 0, per_cu = 0;
        if (hipGetDevice(&dev) != hipSuccess || hipDeviceGetAttribute(&cus, hipDeviceAttributeMultiprocessorCount, dev) != hipSuccess) { grid = -1; return; }
        if (hipFuncSetAttribute((const void*)yoco_fwd, hipFuncAttributeMaxDynamicSharedMemorySize, LDS_BYTES) != hipSuccess) { fprintf(stderr, "kernel_launch: hipFuncSetAttribute failed\n"); grid = -1; return; }
        if (hipOccupancyMaxActiveBlocksPerMultiprocessor(&per_cu, (const void*)yoco_fwd, NTHREADS, LDS_BYTES) != hipSuccess || per_cu < 1)
            fprintf(stderr, "kernel_launch: occupancy query reports %d workgroups per CU\n", per_cu);
        (void)hipGetLastError();
        grid = cus;
    }
    if (grid < 0) return;
    (void)hipMemsetAsync((char*)d_ws + WS_CTL, 0, CTL_ZERO_BYTES, stream);
    Args a{};
    for (int i = 0; i < 23; ++i) a.in[i] = (const float*)d_in[i];
    a.out = (float*)d_out; a.ws = (unsigned char*)d_ws;
    constexpr int NL = MK_N_LAUNCHES;
    for (int li = 0; li < NL; ++li) {
        a.ph_lo = (NL == NPHASE) ? li : (li * NPHASE) / NL; a.ph_hi = (NL == NPHASE) ? li + 1 : ((li + 1) * NPHASE) / NL;
        hipLaunchKernelGGL(yoco_fwd, dim3(grid), dim3(NTHREADS), LDS_BYTES, stream, a);
    }
}
```

```cpp
#include <hip/hip_runtime.h>
#include <cstdio>
#include <cstdint>
namespace pg8 {
#define PG8_LAS __attribute__((address_space(3)))
typedef unsigned short bf16_t;
typedef short bf16x8 __attribute__((ext_vector_type(8)));
typedef float f32x4 __attribute__((ext_vector_type(4)));
typedef unsigned u32x4 __attribute__((ext_vector_type(4)));
constexpr int BM = 256, BK = 64, HALF = 128, HTB = HALF * BK * 2  , STAGE_BYTES = 8 * HTB, NXCD = 8, WGM = 8;

__host__ __device__ __forceinline__ int lds_byte(int r, int c) { const int st = (r >> 4) * 2 + (c >> 5), rr = r & 15, cc = c & 31, ob = rr * 64 + cc * 2; return st * 1024 + (ob ^ (((ob >> 9) & 1) << 5)); }
__host__ __device__ __forceinline__ void stage_rc(int b, int& R, int& C) { const int st = b / 1024, sb = b % 1024, swz = sb ^ (((sb >> 9) & 1) << 5); R = (st >> 1) * 16 + swz / 64; C = (st & 1) * 32 + (swz % 64) / 2; }
__host__ __device__ __forceinline__ int perm32(int rho) { const int n = rho >> 4, i = rho & 15; return 8 * (i >> 2) + 4 * n + (i & 3); }

struct Unit { int pm, pn; };
struct Gemm { const bf16_t* A; const bf16_t* Bt; int M, N, K; int sA, sB; };

struct StaticOrder {
    int nM, nN, nwg, G, c;
    __host__ __device__ void init(int M, int N, int G_, int c_) { nM = M / BM; nN = N / BM; nwg = nM * nN; G = G_; c = c_; }
    __host__ __device__ bool next(int i, Unit& u) const {
        const long L = (long)i * G + c; if (L >= nwg) return false;
        int wgid = (int)L; { const int q = nwg / NXCD, r = nwg % NXCD, xcd = wgid % NXCD, off = wgid / NXCD; wgid = (xcd < r ? xcd * (q + 1) : r * (q + 1) + (xcd - r) * q) + off; }
        const int nig = WGM * nN, gid = wgid / nig, fm = gid * WGM, gsz = (nM - fm) < WGM ? (nM - fm) : WGM;
        u.pm = fm + ((wgid % nig) % gsz); u.pn = (wgid % nig) / gsz; return true;
    }
    __device__ __forceinline__ void a_ready(const Unit&) const {}
    __device__ __forceinline__ void done(const Unit&) const {}
    __device__ __forceinline__ int arow(int, const Unit& u, int r) const { return u.pm * BM + r; }
};
__device__ __forceinline__ unsigned cvt_pk_bf16(float lo, float hi) { unsigned r; asm volatile("v_cvt_pk_bf16_f32 %0, %1, %2" : "=v"(r) : "v"(lo), "v"(hi)); return r; }
typedef float f32x2 __attribute__((ext_vector_type(2)));
__device__ __forceinline__ f32x2 gelu_pk(f32x2 v) {
    const f32x2 av = __builtin_elementwise_abs(v), d = av * 0.2316418882f + 1.0f;
    f32x2 t; t.x = __builtin_amdgcn_rcpf(d.x); t.y = __builtin_amdgcn_rcpf(d.y);
    f32x2 q = t * 0.5307027145f + (-0.7265760135f); q = q * t + 0.7107068705f; q = q * t + (-0.142248368f); q = q * t + 0.127414796f; q = q * t;
    const f32x2 s = (v * v) * (-0.72134752044f);
    f32x2 e; e.x = __builtin_amdgcn_exp2f(s.x); e.y = __builtin_amdgcn_exp2f(s.y);
    const f32x2 m = v * (q * e), r = v - m;
    f32x2 o; o.x = v.x < 0.f ? m.x : r.x; o.y = v.y < 0.f ? m.y : r.y; return o;
}
template <class Epi, class Sched, bool STAMP = false, bool F8 = false>
__device__ __forceinline__ void gemm_phase(PG8_LAS unsigned char* lds, const Gemm g, const Sched& S, const Epi& E, unsigned long long* stamps, const int tid) {
    const int wid = __builtin_amdgcn_readfirstlane(tid >> 6), lane = tid & 63, wr = wid >> 2, wc = wid & 3, fr = lane & 15, fq = lane >> 4;
    const int K = g.K, nt = K / BK;
    int ts_lo = 0, ts_hi = 0, nts = 0; const unsigned long long rt_entry = STAMP ? (unsigned long long)wall_clock64() : 0ull;
#define PG8_STAMP() do { if (STAMP && wid == 0 && nts < 64) { const unsigned long long _c = (unsigned long long)clock64(); \
        ts_lo = (lane == nts) ? (int)(unsigned)_c : ts_lo; ts_hi = (lane == nts) ? (int)(unsigned)(_c >> 32) : ts_hi; ++nts; } } while (0)
    PG8_STAMP();
    unsigned colA[2], voffB[2]; int rowA[2];
#pragma unroll
    for (int i = 0; i < 2; ++i) { int R, C; stage_rc(tid * 16 + i * 8192, R, C); const int Rb = Epi::PERM ? ((R & ~31) + perm32(R & 31)) : R;
        rowA[i] = R; colA[i] = (unsigned)C * 2u; voffB[i] = (unsigned)(Rb * K + C) * 2u; }
#define PG8_AOFF(dst, uidx, un) do { _Pragma("unroll") for (int _h = 0; _h < 2; ++_h) _Pragma("unroll") for (int _i = 0; _i < 2; ++_i) \
        dst[_h][_i] = (unsigned)S.arow((uidx), (un), _h * HALF + rowA[_i]) * (unsigned)(K * 2) + colA[_i]; } while (0)
    const size_t kstep = (size_t)(BK * 2);
    const size_t hstep = (size_t)HALF * K * 2;
    const size_t tstep = 2 * hstep;
    const unsigned ldsw = (unsigned)wid * 1024u;
    const int aoff = lds_byte(wr * 64 + fr, fq * 8), boff = lds_byte(wc * 32 + fr, fq * 8);
    constexpr int KOFF = 1024;
#define PG8_SA(b, h) (((b) * 2 + (h)) * HTB)
#define PG8_SB(b, h) ((4 + (b) * 2 + (h)) * HTB)
#define PG8_STAGE(bufoff, gbase, voff) do { _Pragma("unroll") for (int _i = 0; _i < 2; ++_i) \
        __builtin_amdgcn_global_load_lds((const unsigned*)((const char*)(gbase) + (voff)[_i]), (PG8_LAS unsigned*)(lds + (bufoff) + ldsw + _i * 8192), 16, 0, 0); } while (0)
#define PG8_LDA(dst, b, h) do { _Pragma("unroll") for (int m = 0; m < 4; ++m) _Pragma("unroll") for (int k = 0; k < 2; ++k) dst[m][k] = *(const PG8_LAS bf16x8*)(lds + PG8_SA(b, h) + aoff + m * 2048 + k * KOFF); } while (0)
#define PG8_LDB(dst, b, h) do { _Pragma("unroll") for (int n = 0; n < 2; ++n) _Pragma("unroll") for (int k = 0; k < 2; ++k) dst[n][k] = *(const PG8_LAS bf16x8*)(lds + PG8_SB(b, h) + boff + n * 2048 + k * KOFF); } while (0)
#define PG8_MMA(ai, bj, At, Bt) do { __builtin_amdgcn_s_setprio(1); \
        if constexpr (F8) { _Pragma("unroll") for (int m = 0; m < 4; ++m) _Pragma("unroll") for (int n = 0; n < 2; ++n) { \
            typedef int i32x4_ __attribute__((ext_vector_type(4))); typedef int i32x8_ __attribute__((ext_vector_type(8))); \
            const i32x8_ b8_ = __builtin_shufflevector(__builtin_bit_cast(i32x4_, Bt[n][0]), __builtin_bit_cast(i32x4_, Bt[n][1]), 0, 1, 2, 3, 4, 5, 6, 7); \
            const i32x8_ a8_ = __builtin_shufflevector(__builtin_bit_cast(i32x4_, At[m][0]), __builtin_bit_cast(i32x4_, At[m][1]), 0, 1, 2, 3, 4, 5, 6, 7); \
            acc[ai][bj][m][n] = __builtin_amdgcn_mfma_scale_f32_16x16x128_f8f6f4(b8_, a8_, acc[ai][bj][m][n], 0, 0, 0, g.sB, 0, g.sA); } } \
        else { _Pragma("unroll") for (int m = 0; m < 4; ++m) _Pragma("unroll") for (int n = 0; n < 2; ++n) _Pragma("unroll") for (int k = 0; k < 2; ++k) \
            acc[ai][bj][m][n] = __builtin_amdgcn_mfma_f32_16x16x32_bf16(Bt[n][k], At[m][k], acc[ai][bj][m][n], 0, 0, 0); } \
        __builtin_amdgcn_s_setprio(0); } while (0)
#define PG8_WAIT_V(n) asm volatile("s_waitcnt vmcnt(" #n ")" ::: "memory")
#define PG8_WAIT_L(n) asm volatile("s_waitcnt lgkmcnt(" #n ")" ::: "memory")
#define PG8_BAR __builtin_amdgcn_s_barrier()
#define PG8_SCHED __builtin_amdgcn_sched_barrier(0)
    Unit cur, nxt; int ui = 0;
    if (!S.next(0, cur)) return;
    f32x4 acc[2][2][4][2];
#pragma unroll
    for (int a = 0; a < 2; ++a)
#pragma unroll
        for (int b = 0; b < 2; ++b)
#pragma unroll
            for (int m = 0; m < 4; ++m)
#pragma unroll
                for (int n = 0; n < 2; ++n) acc[a][b][m][n] = (f32x4){0.f, 0.f, 0.f, 0.f};
    bf16x8 At[4][2], B0[2][2], B1[2][2];
    const char* Ab = (const char*)g.A; const char* cB = (const char*)g.Bt + (size_t)cur.pn * tstep;
    unsigned cuA[2][2];
    S.a_ready(cur);
    PG8_AOFF(cuA, 0, cur);
    PG8_STAGE(PG8_SB(0, 0), cB, voffB); PG8_STAGE(PG8_SA(0, 0), Ab, cuA[0]); PG8_STAGE(PG8_SB(0, 1), cB + hstep, voffB); PG8_STAGE(PG8_SA(0, 1), Ab, cuA[1]);
    if (wr == 1) PG8_BAR;
    PG8_WAIT_V(4); PG8_BAR;
    PG8_STAGE(PG8_SB(1, 0), cB + kstep, voffB); PG8_STAGE(PG8_SA(1, 0), Ab + kstep, cuA[0]); PG8_STAGE(PG8_SB(1, 1), cB + hstep + kstep, voffB);
    PG8_WAIT_V(6); PG8_BAR;
    PG8_STAMP();
    for (;;) {
        const bool has_next = S.next(ui + 1, nxt);
        const char* nB = has_next ? (const char*)g.Bt + (size_t)nxt.pn * tstep : cB;
        for (int t = 0; t < nt; t += 2) {
            const bool last = (t == nt - 2);
            const char* a1 = Ab + (size_t)(t + 1) * kstep;
            const char* a2 = last ? Ab : Ab + (size_t)(t + 2) * kstep; const char* b2 = last ? nB : cB + (size_t)(t + 2) * kstep;
            const char* a3 = a2 + kstep; const char* b3 = b2 + kstep;

            if (last && has_next) S.a_ready(nxt);
            PG8_LDB(B0, 0, 0); PG8_SCHED; PG8_LDA(At, 0, 0); PG8_STAGE(PG8_SA(1, 1), a1, cuA[1]);
            PG8_WAIT_L(8); PG8_BAR; PG8_WAIT_L(0); PG8_MMA(0, 0, At, B0); PG8_BAR; PG8_SCHED;
            if (last && has_next) PG8_AOFF(cuA, ui + 1, nxt);
            PG8_LDB(B1, 0, 1); PG8_STAGE(PG8_SB(0, 0), b2, voffB);
            PG8_BAR; PG8_WAIT_L(0); PG8_MMA(0, 1, At, B1); PG8_BAR;
            PG8_LDA(At, 0, 1); PG8_STAGE(PG8_SA(0, 0), a2, cuA[0]);
            PG8_BAR; PG8_WAIT_L(0); PG8_MMA(1, 0, At, B0); PG8_BAR; PG8_SCHED;
            PG8_STAGE(PG8_SB(0, 1), b2 + hstep, voffB);
            PG8_WAIT_V(6); PG8_BAR; PG8_MMA(1, 1, At, B1); PG8_BAR;
            PG8_LDB(B0, 1, 0); PG8_SCHED; PG8_LDA(At, 1, 0); PG8_STAGE(PG8_SA(0, 1), a2, cuA[1]);
            PG8_WAIT_L(8); PG8_BAR; PG8_WAIT_L(0); PG8_MMA(0, 0, At, B0); PG8_BAR; PG8_SCHED;
            PG8_LDB(B1, 1, 1); PG8_STAGE(PG8_SB(1, 0), b3, voffB);
            PG8_BAR; PG8_WAIT_L(0); PG8_MMA(0, 1, At, B1); PG8_BAR;
            PG8_LDA(At, 1, 1); PG8_STAGE(PG8_SA(1, 0), a3, cuA[0]);
            PG8_BAR; PG8_WAIT_L(0); PG8_MMA(1, 0, At, B0); PG8_BAR; PG8_SCHED;
            PG8_STAGE(PG8_SB(1, 1), b3 + hstep, voffB);
            PG8_WAIT_V(6); PG8_BAR; PG8_MMA(1, 1, At, B1); PG8_BAR;
        }
        PG8_STAMP();
        if constexpr (!Epi::AFTER_DRAIN) { E(acc, cur, wr, wc, fr, fq); S.done(cur); }
        PG8_STAMP();
        if (!has_next) break;
#pragma unroll
        for (int a = 0; a < 2; ++a)
#pragma unroll
            for (int b = 0; b < 2; ++b)
#pragma unroll
                for (int m = 0; m < 4; ++m)
#pragma unroll
                    for (int n = 0; n < 2; ++n) acc[a][b][m][n] = (f32x4){0.f, 0.f, 0.f, 0.f};
        cur = nxt; cB = nB; ++ui;
    }
    PG8_WAIT_V(0);
    if (wr == 0) PG8_BAR;
    PG8_BAR;
    if constexpr (Epi::AFTER_DRAIN) { E.fused(acc, cur, wr, wc, fr, fq, lds, wid, lane); S.done(cur); }
    PG8_STAMP();
    if (STAMP && wid == 0) { stamps[lane] = lane < nts ? (((unsigned long long)(unsigned)ts_hi << 32) | (unsigned)ts_lo) : 0ull;
        if (lane == 62) stamps[62] = rt_entry; if (lane == 63) stamps[63] = (unsigned long long)wall_clock64(); }
#undef PG8_STAMP
#undef PG8_SA
#undef PG8_SB
#undef PG8_STAGE
#undef PG8_AOFF
#undef PG8_LDA
#undef PG8_LDB
#undef PG8_MMA
#undef PG8_WAIT_V
#undef PG8_WAIT_L
#undef PG8_BAR
#undef PG8_SCHED
}
}

namespace mk {
using pg8::bf16_t; using pg8::f32x4; using pg8::u32x4; using pg8::Unit; using pg8::cvt_pk_bf16;
#define LAS __attribute__((address_space(3)))
typedef float f32x2 __attribute__((ext_vector_type(2)));
typedef unsigned u32x2 __attribute__((ext_vector_type(2)));

#ifndef MK_DIAG
#define MK_DIAG 0
#endif
#ifndef MK_DUPNULL
#define MK_DUPNULL 0
#endif
#ifndef MK_DIAGSEL
#define MK_DIAGSEL 0
#endif
#ifndef MK_DIAGMASK
#define MK_DIAGMASK 0xFFFF
#endif
#ifndef MK_N_LAUNCHES
#define MK_N_LAUNCHES 1
#endif
constexpr int NPHASE = 16;
constexpr int NB = 8, SEQ = 2048, D = 1024, T = NB * SEQ, NMEM = 256, SGW = 768, NSG = 12, HD = 64, CH = 128;
constexpr int NEXP = 16, LISTCAP = 16384;
constexpr float ALPHA = 1.41421356237f;
constexpr float LN_EPS = 1e-5f, ATT_SCALE = 0.125f;
constexpr int NWAVES = 8, NTHREADS = 512;

constexpr size_t MiB = 1u << 20;
constexpr size_t WS_CTL = 0, CTL_ZERO_BYTES = 128 * 1024;
constexpr size_t WS_TOKE = 1 * MiB, WS_TOKP = WS_TOKE + 128 * 1024, WS_TOKG = WS_TOKP + 128 * 1024;
constexpr size_t WS_LIST = 2 * MiB, WS_LSE = 3 * MiB, WS_SGWB = 4 * MiB, WS_SGRS = 4 * MiB + 512 * 1024, WS_WRT = 4 * MiB + 768 * 1024;
constexpr size_t WS_MKV = 8 * MiB, WS_MEMB = 12 * MiB;
constexpr size_t WS_BT_INA = 18 * MiB, WS_BT_OUTA = 22 * MiB, WS_BT_B = 24 * MiB, WS_BT_OUTB = 29 * MiB, WS_BT_MEM = 30 * MiB;
constexpr size_t WS_WGU = 32 * MiB, WS_WD = 160 * MiB;
constexpr size_t WS_A = 224 * MiB;
constexpr size_t WS_U = WS_A, WS_GV = WS_A + 24 * MiB, WS_QM0 = WS_A + 48 * MiB;
constexpr size_t WS_K = WS_A, WS_V = WS_A + 24 * MiB, WS_Q = WS_A + 48 * MiB, WS_QM1 = WS_A + 72 * MiB;
constexpr size_t WS_ACT = WS_A;
constexpr size_t WS_XB = 304 * MiB;
constexpr size_t WS_C = 336 * MiB;
constexpr size_t WS_CAT = WS_C, WS_OG = WS_C, WS_CAT2 = WS_C + 24 * MiB;
constexpr size_t WS_Y = 376 * MiB;
constexpr size_t WS_YD = 336 * MiB;
constexpr size_t WS_X1B = 440 * MiB;
constexpr size_t WS_X1F8 = 472 * MiB;
constexpr size_t WS_END = 488 * MiB;
constexpr size_t WS_WGU8 = WS_WGU + 64 * MiB, WS_WD8 = WS_WD + 32 * MiB;
constexpr int CW_TMO = 0, CW_BAR = 4096, CW_CNT = 16384, CW_CONV = 24576, CW_DONE = 24640, CW_CONV0 = 26000;
constexpr int LDS_TOKS = 131072 + 1024, MAX_UNITS = 8;
constexpr int LDS_MISC = 131072;
constexpr int LDS_BYTES = 147456;
static_assert(LDS_TOKS + MAX_UNITS * 1024 <= LDS_BYTES, "LDS map");

#define LDS_WAIT() asm volatile("s_waitcnt lgkmcnt(0)" ::: "memory")
#define VM_WAIT() asm volatile("s_waitcnt vmcnt(0)" ::: "memory")
__device__ __forceinline__ unsigned f2bf(float f) { unsigned u = __builtin_bit_cast(unsigned, f); return (u + 0x7fffu + ((u >> 16) & 1u)) >> 16; }
__device__ __forceinline__ unsigned pk2(float lo, float hi) { return f2bf(lo) | (f2bf(hi) << 16); }
__device__ __forceinline__ unsigned pk4_fp8_e(float a, float b, float c, float d) { int r = 0; r = __builtin_amdgcn_cvt_pk_fp8_f32(a, b, r, false); r = __builtin_amdgcn_cvt_pk_fp8_f32(c, d, r, true); return (unsigned)r; }
__device__ __forceinline__ float bflo(unsigned w) { return __uint_as_float(w << 16); }
__device__ __forceinline__ float bfhi(unsigned w) { return __uint_as_float(w & 0xffff0000u); }
__device__ __forceinline__ float bf1(bf16_t v) { return __uint_as_float(((unsigned)v) << 16); }
__device__ __forceinline__ float wave_sum(float v) {
#pragma unroll
    for (int o = 1; o < 64; o <<= 1) v += __shfl_xor(v, o);
    return v;
}
template <int CTRL> __device__ __forceinline__ float dpp_f(float v) { return __builtin_bit_cast(float, __builtin_amdgcn_update_dpp(0, __builtin_bit_cast(int, v), CTRL, 0xf, 0xf, false)); }
__device__ __forceinline__ float row_sum(float v) { v += dpp_f<0xB1>(v); v += dpp_f<0x4E>(v); v += dpp_f<0x141>(v); v += dpp_f<0x140>(v); return v; }
__device__ __forceinline__ float wave_sum_dpp(float v) { v = row_sum(v); v += __shfl_xor(v, 16); v += __shfl_xor(v, 32); return v; }
__device__ __forceinline__ float wave_max(float v) {
#pragma unroll
    for (int o = 1; o < 64; o <<= 1) v = fmaxf(v, __shfl_xor(v, o));
    return v;
}

#define XB_TMO      128
#define XB_XCNT(j)  (256  + 64 * (j))
#define XB_XSUB(j)  (1280 + 64 * (j))
#define XB_XGEN(j)  (2304 + 64 * (j))
#define XB_TOP      3328
#define XB_TOPGEN   3392
#define XCD_BAR_WORDS 3456
#define XB_SPIN_CAP (1u << 18)
__device__ __forceinline__ unsigned xb_ld(unsigned* p)              { return __hip_atomic_load(p, __ATOMIC_RELAXED, __HIP_MEMORY_SCOPE_AGENT); }
__device__ __forceinline__ unsigned xb_add(unsigned* p, unsigned v) { return __hip_atomic_fetch_add(p, v, __ATOMIC_RELAXED, __HIP_MEMORY_SCOPE_AGENT); }
__device__ __forceinline__ unsigned xb_xcc_id() { return (unsigned)__builtin_amdgcn_s_getreg((3 << 11) | 20) & 0xFu; }
#define XB_SPIN(cond, bar) do { unsigned _sp = 0; while (cond) { __builtin_amdgcn_s_sleep(1); \
    if ((++_sp & 255u) == 0u) { if (xb_ld(&(bar)[XB_TMO])) break; if (_sp > XB_SPIN_CAP) { atomicAdd(&(bar)[XB_TMO], 1u); break; } } } } while (0)
struct XcdBarrier { unsigned* bar; unsigned x; volatile LAS unsigned* st; };
__device__ __forceinline__ XcdBarrier xcd_barrier_post(unsigned* bar, volatile LAS unsigned* st) {
    XcdBarrier b; b.bar = bar; b.x = xb_xcc_id(); b.st = st;
    if (threadIdx.x == 0) (void)xb_add(&bar[XB_XCNT(b.x)], 1u);
    return b;
}
__device__ __forceinline__ void xcd_barrier_complete(unsigned* bar, unsigned x, unsigned& nloc, unsigned& nx) {
    const unsigned G = gridDim.x * gridDim.y * gridDim.z;
    unsigned sum, cnt, mine, sp = 0u;
    for (;;) {
        sum = 0u; cnt = 0u; mine = 0u;
#pragma unroll
        for (unsigned j = 0; j < 16; ++j) { const unsigned c = xb_ld(&bar[XB_XCNT(j)]); sum += c; cnt += (c > 0u) ? 1u : 0u; mine = (j == x) ? c : mine; }
        if (sum == G) break;
        __builtin_amdgcn_s_sleep(1);
        if ((++sp & 255u) == 0u) { if (xb_ld(&bar[XB_TMO])) break; if (sp > XB_SPIN_CAP) { atomicAdd(&bar[XB_TMO], 1u); break; } }
    }
    nloc = mine > 0u ? mine : 1u; nx = cnt > 0u ? cnt : 1u;
}
__device__ __forceinline__ void xcd_barrier(const XcdBarrier& b) {
    asm volatile("s_waitcnt vmcnt(0)" ::: "memory");
    __syncthreads();
    if (threadIdx.x == 0) {
        unsigned* bar = b.bar;
        __builtin_amdgcn_s_waitcnt(0);
        unsigned nloc = b.st[0], nx = b.st[1];
        if (nloc == 0u) { xcd_barrier_complete(bar, b.x, nloc, nx); b.st[0] = nloc; b.st[1] = nx; }
        const unsigned old = xb_add(&bar[XB_XSUB(b.x)], 1u);
        const unsigned gen = old / nloc;
        if (old + 1u == (gen + 1u) * nloc) {
            __builtin_amdgcn_fence(__ATOMIC_RELEASE, "agent");
            asm volatile("s_waitcnt vmcnt(0)" ::: "memory");
            const unsigned og = xb_add(&bar[XB_TOP], 1u);
            const unsigned tg = og / nx;
            if (og + 1u == (tg + 1u) * nx) xb_add(&bar[XB_TOPGEN], 1u);
            else XB_SPIN(xb_ld(&bar[XB_TOPGEN]) == tg, bar);
            __builtin_amdgcn_fence(__ATOMIC_ACQUIRE, "agent");
            xb_add(&bar[XB_XGEN(b.x)], 1u);
            asm volatile("s_waitcnt vmcnt(0)" ::: "memory");
        } else {
            XB_SPIN(xb_ld(&bar[XB_XGEN(b.x)]) == gen, bar);
            __builtin_amdgcn_fence(__ATOMIC_ACQUIRE, "agent");
            asm volatile("s_waitcnt vmcnt(0)" ::: "memory");
        }
    }
    __syncthreads();
}


struct EpiProjA {
    static constexpr bool PERM = true, AFTER_DRAIN = false;
    bf16_t *u, *gv, *qm;
    __device__ __forceinline__ void operator()(const f32x4 (&acc)[2][2][4][2], const Unit& un, int wr, int wc, int fr, int fq) const {
        const int row0 = un.pm * 256 + wr * 64 + fr;
        bf16_t* base; int ldc, colt; bool act; float sc = 1.f;
        if (un.pn < 3) { base = u; ldc = SGW; colt = un.pn * 256; act = true; }
        else if (un.pn < 6) { base = gv; ldc = SGW; colt = (un.pn - 3) * 256; act = true; }
        else { base = qm; ldc = 256; colt = 0; act = false; sc = ATT_SCALE; }
        const int col0 = colt + wc * 32 + 8 * fq;
#pragma unroll
        for (int ai = 0; ai < 2; ++ai)
#pragma unroll
            for (int m = 0; m < 4; ++m) { bf16_t* rowp = base + (size_t)(row0 + ai * 128 + m * 16) * ldc + col0;
#pragma unroll
                for (int bj = 0; bj < 2; ++bj) { f32x4 v0 = acc[ai][bj][m][0], v1 = acc[ai][bj][m][1];
                    if (act) { pg8::f32x2 a = pg8::gelu_pk((pg8::f32x2){v0[0], v0[1]}), b = pg8::gelu_pk((pg8::f32x2){v0[2], v0[3]}), c = pg8::gelu_pk((pg8::f32x2){v1[0], v1[1]}), d = pg8::gelu_pk((pg8::f32x2){v1[2], v1[3]});
                        v0 = (f32x4){a.x, a.y, b.x, b.y}; v1 = (f32x4){c.x, c.y, d.x, d.y}; }
                    v0 = v0 * sc; v1 = v1 * sc;
                    u32x4 w; w.x = cvt_pk_bf16(v0[0], v0[1]); w.y = cvt_pk_bf16(v0[2], v0[3]); w.z = cvt_pk_bf16(v1[0], v1[1]); w.w = cvt_pk_bf16(v1[2], v1[3]);
                    *(u32x4*)(rowp + bj * 128) = w; } }
    }
};
struct EpiProjB {
    static constexpr bool PERM = true, AFTER_DRAIN = false;
    bf16_t *k, *v, *q, *qm;
    __device__ __forceinline__ void operator()(const f32x4 (&acc)[2][2][4][2], const Unit& un, int wr, int wc, int fr, int fq) const {
        const int row0 = un.pm * 256 + wr * 64 + fr;
        bf16_t* base; int ldc, colt; float sc = 1.f;
        if (un.pn < 3) { base = k; ldc = SGW; colt = un.pn * 256; }
        else if (un.pn < 6) { base = v; ldc = SGW; colt = (un.pn - 3) * 256; }
        else if (un.pn < 9) { base = q; ldc = SGW; colt = (un.pn - 6) * 256; sc = ATT_SCALE; }
        else { base = qm; ldc = 256; colt = 0; sc = ATT_SCALE; }
        const int col0 = colt + wc * 32 + 8 * fq;
#pragma unroll
        for (int ai = 0; ai < 2; ++ai)
#pragma unroll
            for (int m = 0; m < 4; ++m) { bf16_t* rowp = base + (size_t)(row0 + ai * 128 + m * 16) * ldc + col0;
#pragma unroll
                for (int bj = 0; bj < 2; ++bj) { f32x4 v0 = acc[ai][bj][m][0] * sc, v1 = acc[ai][bj][m][1] * sc;
                    u32x4 w; w.x = cvt_pk_bf16(v0[0], v0[1]); w.y = cvt_pk_bf16(v0[2], v0[3]); w.z = cvt_pk_bf16(v1[0], v1[1]); w.w = cvt_pk_bf16(v1[2], v1[3]);
                    *(u32x4*)(rowp + bj * 128) = w; } }
    }
};
struct EpiPlain {
    static constexpr bool PERM = true, AFTER_DRAIN = false;
    bf16_t* O; int ldc, ntn;
    __device__ __forceinline__ void operator()(const f32x4 (&acc)[2][2][4][2], const Unit& un, int wr, int wc, int fr, int fq) const {
        const int row0 = un.pm * 256 + wr * 64 + fr;
        const int col0 = (un.pn % ntn) * 256 + wc * 32 + 8 * fq;
#pragma unroll
        for (int ai = 0; ai < 2; ++ai)
#pragma unroll
            for (int m = 0; m < 4; ++m) { bf16_t* rowp = O + (size_t)(row0 + ai * 128 + m * 16) * ldc + col0;
#pragma unroll
                for (int bj = 0; bj < 2; ++bj) { const f32x4 v0 = acc[ai][bj][m][0], v1 = acc[ai][bj][m][1];
                    u32x4 w; w.x = cvt_pk_bf16(v0[0], v0[1]); w.y = cvt_pk_bf16(v0[2], v0[3]); w.z = cvt_pk_bf16(v1[0], v1[1]); w.w = cvt_pk_bf16(v1[2], v1[3]);
                    *(u32x4*)(rowp + bj * 128) = w; } }
    }
};
struct EpiSwiGLU {
    static constexpr bool PERM = true, AFTER_DRAIN = false;
    bf16_t* O;
    __device__ __forceinline__ void operator()(const f32x4 (&acc)[2][2][4][2], const Unit& un, int wr, int wc, int fr, int fq) const {
        const int row0 = un.pm * 256 + wr * 64 + fr;
        const int col0 = (un.pn & 7) * 128 + wc * 32 + 8 * fq;
#pragma unroll
        for (int ai = 0; ai < 2; ++ai)
#pragma unroll
            for (int m = 0; m < 4; ++m) { bf16_t* rowp = O + (size_t)(row0 + ai * 128 + m * 16) * 1024 + col0;
                float r[8];
#pragma unroll
                for (int n = 0; n < 2; ++n)
#pragma unroll
                    for (int j = 0; j < 4; ++j) { const float g = acc[ai][0][m][n][j], up = acc[ai][1][m][n][j];
                        r[n * 4 + j] = g * __builtin_amdgcn_rcpf(1.0f + __expf(-g)) * up; }
                u32x4 w; w.x = cvt_pk_bf16(r[0], r[1]); w.y = cvt_pk_bf16(r[2], r[3]); w.z = cvt_pk_bf16(r[4], r[5]); w.w = cvt_pk_bf16(r[6], r[7]);
                *(u32x4*)rowp = w; }
    }
};
struct EpiSwiGLU8 {
    static constexpr bool PERM = true, AFTER_DRAIN = false;
    unsigned char* O;
    __device__ __forceinline__ void operator()(const f32x4 (&acc)[2][2][4][2], const Unit& un, int wr, int wc, int fr, int fq) const {
        const int row0 = un.pm * 256 + wr * 64 + fr;
        const int col0 = (un.pn & 7) * 128 + wc * 32 + 8 * fq;
#pragma unroll
        for (int ai = 0; ai < 2; ++ai)
#pragma unroll
            for (int m = 0; m < 4; ++m) { unsigned char* rowp = O + (size_t)(row0 + ai * 128 + m * 16) * 1024 + col0;
                float r[8];
#pragma unroll
                for (int n = 0; n < 2; ++n)
#pragma unroll
                    for (int j = 0; j < 4; ++j) { const float g = acc[ai][0][m][n][j], up = acc[ai][1][m][n][j];
                        r[n * 4 + j] = g * __builtin_amdgcn_rcpf(1.0f + __expf(-g)) * up * 8.0f; }
                *(u32x2*)rowp = (u32x2){pk4_fp8_e(r[0], r[1], r[2], r[3]), pk4_fp8_e(r[4], r[5], r[6], r[7])}; }
    }
};
template <bool RB> struct EpiResid {
    static constexpr bool PERM = false, AFTER_DRAIN = false;
    const void* res; bf16_t* Y;
    __device__ __forceinline__ void operator()(const f32x4 (&acc)[2][2][4][2], const Unit& un, int wr, int wc, int fr, int fq) const {
        const int row0 = un.pm * 256 + wr * 64 + fr, col0 = un.pn * 256 + wc * 32 + 4 * fq;
#pragma unroll
        for (int ai = 0; ai < 2; ++ai)
#pragma unroll
            for (int m = 0; m < 4; ++m) { const size_t off = (size_t)(row0 + ai * 128 + m * 16) * D + col0;
#pragma unroll
                for (int bj = 0; bj < 2; ++bj)
#pragma unroll
                    for (int n = 0; n < 2; ++n) { const size_t o = off + bj * 128 + n * 16; f32x4 r;
                        if (RB) { const u32x2 w = *(const u32x2*)((const bf16_t*)res + o); r = (f32x4){bflo(w.x), bfhi(w.x), bflo(w.y), bfhi(w.y)}; }
                        else r = *(const f32x4*)((const float*)res + o);
                        const f32x4 yv = r * ALPHA + acc[ai][bj][m][n]; *(u32x2*)(Y + o) = (u32x2){cvt_pk_bf16(yv[0], yv[1]), cvt_pk_bf16(yv[2], yv[3])}; } }
    }
};
struct EpiNull {
    static constexpr bool PERM = true, AFTER_DRAIN = false;
    __device__ __forceinline__ void operator()(const f32x4 (&acc)[2][2][4][2], const Unit&, int, int, int, int) const {
#pragma unroll
        for (int a = 0; a < 2; ++a)
#pragma unroll
            for (int b = 0; b < 2; ++b)
#pragma unroll
                for (int m = 0; m < 4; ++m)
#pragma unroll
                    for (int n = 0; n < 2; ++n) asm volatile("" :: "v"(acc[a][b][m][n]));
    }
};
struct SmallOrder {
    int nN, nwg, c;
    __device__ bool next(int i, Unit& u) const { if (i != 0 || c < 0 || c >= nwg) return false; u.pm = c / nN; u.pn = c % nN; return true; }
    __device__ __forceinline__ void a_ready(const Unit&) const {}
    __device__ __forceinline__ void done(const Unit&) const {}
    __device__ __forceinline__ int arow(int, const Unit& u, int r) const { return u.pm * 256 + r; }
};
struct MoeOrder {
    const LAS int* tb;
    int ntn, G, c;
    __device__ bool next(int i, Unit& u) const {
        const int L = i * G + c; if (L >= tb[16] * ntn) return false;
        int e = 0;
#pragma unroll
        for (int j = 1; j < 16; ++j) e += (L >= tb[j] * ntn) ? 1 : 0;
        const int r = L - tb[e] * ntn, te = tb[e + 1] - tb[e];
        u.pm = tb[e] + r % te; u.pn = e * ntn + r / te; return true;
    }
    __device__ __forceinline__ void a_ready(const Unit&) const {}
    __device__ __forceinline__ void done(const Unit&) const {}
    __device__ __forceinline__ int arow(int, const Unit& u, int r) const { return u.pm * 256 + r; }
};
struct MoeGatherOrder : MoeOrder {
    const LAS int* toks;
    __device__ __forceinline__ int arow(int ui, const Unit&, int r) const { return toks[ui * 256 + r]; }
};

struct Args { const float* in[23]; float* out; unsigned char* ws; int ph_lo, ph_hi; };
struct Ctx {
    unsigned char* ws; LAS unsigned char* lds;
    int tid, lane, wave, gw, NGW, G, bid;
};
__device__ __forceinline__ unsigned char* launder(unsigned char* p) { asm volatile("" : "+s"(p)); return p; }
__device__ __forceinline__ int launder_v(int v) { asm volatile("" : "+v"(v)); return v; }

__device__ __forceinline__ void tr_item(const float* W, int K, int N, bf16_t* WT, int grp, int gstride, int roff, LAS float* scr, int item, int lane) {
    const int nblk = N / 32, kb = item / nblk, nb = item % nblk, k0 = 64 * kb, n0 = 32 * nb;
    float ld[32];
    { const float* wp = W + (size_t)(k0 + (lane >> 5)) * N + n0 + (lane & 31);
#pragma unroll
      for (int i = 0; i < 32; ++i) ld[i] = __builtin_nontemporal_load(wp + (size_t)(2 * i) * N); }
#pragma unroll
    for (int i = 0; i < 32; ++i) scr[(2 * i + (lane >> 5)) * 33 + (lane & 31)] = ld[i];
    LDS_WAIT(); asm volatile("" ::: "memory");
    const int c = lane & 7;
#pragma unroll
    for (int j = 0; j < 4; ++j) { const int n = (lane >> 3) + 8 * j; const LAS float* s = scr + (8 * c) * 33 + n;
        const int nn = n0 + n, drow = (nn / grp) * gstride + (nn % grp) + roff;
        u32x4 o; o.x = pk2(s[0 * 33], s[1 * 33]); o.y = pk2(s[2 * 33], s[3 * 33]); o.z = pk2(s[4 * 33], s[5 * 33]); o.w = pk2(s[6 * 33], s[7 * 33]);
        *(u32x4*)(WT + (size_t)drow * K + k0 + 8 * c) = o; }
    LDS_WAIT(); asm volatile("" ::: "memory");
}
__device__ __forceinline__ unsigned pk4_fp8(float a, float b, float c, float d) { int r = 0; r = __builtin_amdgcn_cvt_pk_fp8_f32(a, b, r, false); r = __builtin_amdgcn_cvt_pk_fp8_f32(c, d, r, true); return (unsigned)r; }
__device__ __forceinline__ void tr_item8(const float* W, int K, int N, unsigned char* WT, int grp, int gstride, int roff, float sc, LAS float* scr, int item, int lane) {
    const int nblk = N / 32, kb = item / nblk, nb = item % nblk, k0 = 64 * kb, n0 = 32 * nb;
    float ld[32];
    { const float* wp = W + (size_t)(k0 + (lane >> 5)) * N + n0 + (lane & 31);
#pragma unroll
      for (int i = 0; i < 32; ++i) ld[i] = __builtin_nontemporal_load(wp + (size_t)(2 * i) * N); }
#pragma unroll
    for (int i = 0; i < 32; ++i) scr[(2 * i + (lane >> 5)) * 33 + (lane & 31)] = ld[i];
    LDS_WAIT(); asm volatile("" ::: "memory");
    const int c = lane & 7;
#pragma unroll
    for (int j = 0; j < 4; ++j) { const int n = (lane >> 3) + 8 * j; const LAS float* s = scr + (8 * c) * 33 + n;
        const int nn = n0 + n, drow = (nn / grp) * gstride + (nn % grp) + roff;
        u32x2 o; o.x = pk4_fp8(s[0 * 33] * sc, s[1 * 33] * sc, s[2 * 33] * sc, s[3 * 33] * sc); o.y = pk4_fp8(s[4 * 33] * sc, s[5 * 33] * sc, s[6 * 33] * sc, s[7 * 33] * sc);
        *(u32x2*)(WT + (size_t)drow * K + k0 + 8 * c) = o; }
    LDS_WAIT(); asm volatile("" ::: "memory");
}
constexpr float W8_SCALE = 32.0f, ACT8_SCALE = 8.0f;
constexpr int E8_ONE = 0x7f7f7f7f, E8_W = 0x7a7a7a7a, E8_ACT = 0x7c7c7c7c;
__device__ __forceinline__ void moe_conv_item(const Args& A, unsigned char* ws, LAS float* scr, int lane, int layer, int r) {
    const int t = r >> 13, e = (r & 8191) >> 9, m = layer * 16 + e, item = r & 511;
    if (t == 0) tr_item8(A.in[20] + (size_t)m * 1048576, 1024, 1024, ws + WS_WGU + (size_t)layer * (64 * MiB) + (size_t)e * 2097152, 128, 256, 0, W8_SCALE, scr, item, lane);
    else if (t == 1) tr_item8(A.in[21] + (size_t)m * 1048576, 1024, 1024, ws + WS_WGU + (size_t)layer * (64 * MiB) + (size_t)e * 2097152, 128, 256, 128, W8_SCALE, scr, item, lane);
    else tr_item8(A.in[22] + (size_t)m * 1048576, 1024, 1024, ws + WS_WD + (size_t)layer * (32 * MiB) + (size_t)e * 1048576, 1024, 1024, 0, W8_SCALE, scr, item, lane);
}
constexpr int N_CONV1 = 3 * 8192;
__device__ __forceinline__ void fill_tail(const Ctx& C, const Args& A, int ph, bool fin) {
    unsigned* ctl = (unsigned*)(C.ws + WS_CTL);
    volatile LAS int* flag = (volatile LAS int*)(C.lds + LDS_MISC) + 40;
    LAS float* scr = (LAS float*)(C.lds + C.wave * 16384);
    asm volatile("s_waitcnt vmcnt(0)" ::: "memory");
    __syncthreads();
    if (C.tid == 0 && !fin) __hip_atomic_fetch_add(ctl + CW_DONE + 64 * ph, 1u, __ATOMIC_RELAXED, __HIP_MEMORY_SCOPE_AGENT);
    for (;;) {
        if (C.tid == 0) { int v = -1;
            const unsigned d = fin ? 0u : __hip_atomic_fetch_add(ctl + CW_DONE + 64 * ph, 0u, __ATOMIC_RELAXED, __HIP_MEMORY_SCOPE_AGENT);
            if (d + 8u < (unsigned)C.G) { v = (int)__hip_atomic_fetch_add(ctl + CW_CONV, 8u, __ATOMIC_RELAXED, __HIP_MEMORY_SCOPE_AGENT); if (v >= N_CONV1) v = -1; }
#if MK_DIAG == 3
            if (!fin && v >= 0) __hip_atomic_fetch_add(ctl + 30000, 8u, __ATOMIC_RELAXED, __HIP_MEMORY_SCOPE_AGENT);
#endif
            *flag = v; }
        __syncthreads();
        const int v = *flag;
        __syncthreads();
        if (v < 0) break;
        if (v + C.wave < N_CONV1) moe_conv_item(A, C.ws, scr, C.lane, 1, v + C.wave);
    }
}
__device__ __forceinline__ void p0_prologue(const Ctx& C, const Args& A) {
    LAS float* scr = (LAS float*)(C.lds + C.wave * 16384);
    unsigned char* ws = C.ws;
    constexpr int I_MOE = 16 * 32;
    constexpr int N_MOE = 32 * I_MOE;
    constexpr int I_INA = 16 * 56, I_SQ = 512, I_KV = 16 * 24, I_OUTB = 8 * 32, I_MEM = 16 * 8;
    constexpr int N_MOE0 = 3 * 8192;
    constexpr int NITEMS = I_INA + I_SQ + I_SQ + 2 * I_KV + I_OUTB + 4 * I_MEM;
    for (int it = C.gw; it < NITEMS; it += C.NGW) {
        int r = it;
        if (r < I_INA) { tr_item(A.in[2], 1024, 1792, (bf16_t*)(ws + WS_BT_INA), 1792, 1792, 0, scr, r, C.lane); continue; } r -= I_INA;
        if (r < I_SQ) { tr_item(A.in[3], 1024, 1024, (bf16_t*)(ws + WS_BT_OUTA), 1024, 1024, 0, scr, r, C.lane); continue; } r -= I_SQ;
        if (r < I_SQ) { tr_item(A.in[8], 1024, 1024, (bf16_t*)(ws + WS_BT_B), 1024, 1024, 1536, scr, r, C.lane); continue; } r -= I_SQ;
        if (r < I_KV) { tr_item(A.in[10], 1024, 768, (bf16_t*)(ws + WS_BT_B), 768, 768, 0, scr, r, C.lane); continue; } r -= I_KV;
        if (r < I_KV) { tr_item(A.in[11], 1024, 768, (bf16_t*)(ws + WS_BT_B), 768, 768, 768, scr, r, C.lane); continue; } r -= I_KV;
        if (r < I_OUTB) { tr_item(A.in[9], 512, 1024, (bf16_t*)(ws + WS_BT_OUTB), 1024, 1024, 0, scr, r, C.lane); continue; } r -= I_OUTB;
        { const int m = r / I_MEM, layer = m & 1, isv = m >> 1;
          tr_item(A.in[isv ? 13 : 12] + (size_t)layer * 262144, 1024, 256, (bf16_t*)(ws + WS_BT_MEM), 256, 256, layer * 512 + isv * 256, scr, r % I_MEM, C.lane); }
    }
    const int gt = C.bid * NTHREADS + C.tid, NT = C.G * NTHREADS;
    for (int i = gt; i < NSG * 128 * 128 / 8; i += NT) { const int q0 = (i & 15) * 8, p = (i >> 4) & 127;
        const f32x4 a = *(const f32x4*)(A.in[6] + (size_t)i * 8), b = *(const f32x4*)(A.in[6] + (size_t)i * 8 + 4); float v[8] = {a[0], a[1], a[2], a[3], b[0], b[1], b[2], b[3]};
#pragma unroll
        for (int j = 0; j < 8; ++j) v[j] = (q0 + j <= p) ? v[j] : 0.f;
        u32x4 w; w.x = pk2(v[0], v[1]); w.y = pk2(v[2], v[3]); w.z = pk2(v[4], v[5]); w.w = pk2(v[6], v[7]); *(u32x4*)((bf16_t*)(ws + WS_SGWB) + (size_t)i * 8) = w; }
    for (int i = gt; i < 16 * 1024; i += NT) { const int e = i >> 10, k = i & 1023; ((bf16_t*)(ws + WS_WRT))[i] = (bf16_t)f2bf(A.in[18][(size_t)k * 16 + e]); }
    for (int i = gt; i < NSG * 128; i += NT) { const int p = i & 127; float acc = 0.f;
        for (int q = 0; q <= p; ++q) acc += bflo(f2bf(A.in[6][(size_t)i * 128 + q]));
        ((float*)(ws + WS_SGRS))[i] = acc; }
    for (int i = gt; i < T * D / 8; i += NT) { const f32x4 a = *(const f32x4*)(A.in[0] + (size_t)i * 8), b = *(const f32x4*)(A.in[0] + (size_t)i * 8 + 4);
        u32x4 w; w.x = pk2(a[0], a[1]); w.y = pk2(a[2], a[3]); w.z = pk2(b[0], b[1]); w.w = pk2(b[2], b[3]); *(u32x4*)((bf16_t*)(ws + WS_XB) + (size_t)i * 8) = w; }
    for (int i = gt; i < NB * NMEM * D / 8; i += NT) { const f32x4 a = *(const f32x4*)(A.in[1] + (size_t)i * 8), b = *(const f32x4*)(A.in[1] + (size_t)i * 8 + 4);
        u32x4 w; w.x = pk2(a[0], a[1]); w.y = pk2(a[2], a[3]); w.z = pk2(b[0], b[1]); w.w = pk2(b[2], b[3]); *(u32x4*)((bf16_t*)(ws + WS_MEMB) + (size_t)i * 8) = w; }
    { unsigned* ctr = (unsigned*)(ws + WS_CTL) + CW_CONV0; volatile LAS int* flag = (volatile LAS int*)(C.lds + LDS_MISC) + 40;
      if (C.tid == 0) *flag = (int)__hip_atomic_fetch_add(ctr, 8u, __ATOMIC_RELAXED, __HIP_MEMORY_SCOPE_AGENT);
      __syncthreads();
      int cur = *flag;
      __syncthreads();
      while (cur < N_MOE0) {
          int nxt = 0;
          if (C.tid == 0) nxt = (int)__hip_atomic_fetch_add(ctr, 8u, __ATOMIC_RELAXED, __HIP_MEMORY_SCOPE_AGENT);
          if (cur + C.wave < N_MOE0) moe_conv_item(A, ws, scr, C.lane, 0, cur + C.wave);
          if (C.tid == 0) *flag = nxt;
          __syncthreads();
          cur = *flag;
          __syncthreads();
      } }
}

__device__ __forceinline__ void sg_scalar(const Ctx& C, const Args& A) {
    const bf16_t* U = (const bf16_t*)(C.ws + WS_U); const bf16_t* GV = (const bf16_t*)(C.ws + WS_GV); bf16_t* CAT = (bf16_t*)(C.ws + WS_CAT);
    const float* lng = A.in[4]; const float* lnb = A.in[5]; const float* sgw = A.in[6]; const float* sgb = A.in[7];
    LAS float* stat = (LAS float*)C.lds;
    LAS float* gvn = (LAS float*)(C.lds + 1024);
    LAS float* Wl = (LAS float*)(C.lds + 1024 + 128 * 65 * 4);
    for (int unit = C.bid; unit < NB * 16; unit += C.G) {
        const int tb = unit * 128;
        for (int rr = 0; rr < 16; ++rr) { const int row = C.wave * 16 + rr; const bf16_t* p = GV + (size_t)(tb + row) * SGW + 4 * C.lane;
            float s = 0.f, ss = 0.f;
#pragma unroll
            for (int j = 0; j < 3; ++j) { const u32x2 w = *(const u32x2*)(p + 256 * j); const float a = bflo(w.x), b = bfhi(w.x), c = bflo(w.y), d = bfhi(w.y);
                s += (a + b) + (c + d); ss += (a * a + b * b) + (c * c + d * d); }
            s = wave_sum(s); ss = wave_sum(ss);
            const float mean = s * (1.f / SGW), var = ss * (1.f / SGW) - mean * mean;
            if (C.lane == 0) { stat[row * 2] = mean; stat[row * 2 + 1] = 1.0f / sqrtf(var + LN_EPS); } }
        __syncthreads();
        const int p = C.tid >> 2, d0 = (C.tid & 3) * 16;
        for (int g = 0; g < NSG; ++g) {
            { const bf16_t* src = GV + (size_t)(tb + p) * SGW + g * 64 + d0; const float mean = stat[p * 2], rstd = stat[p * 2 + 1];
#pragma unroll
              for (int h = 0; h < 2; ++h) { const u32x4 w = *(const u32x4*)(src + 8 * h); const unsigned ww[4] = {w.x, w.y, w.z, w.w};
#pragma unroll
                  for (int j = 0; j < 4; ++j) { const int d = d0 + 8 * h + 2 * j; const int cc = g * 64 + d;
                      gvn[p * 65 + d] = (bflo(ww[j]) - mean) * rstd * lng[cc] + lnb[cc];
                      gvn[p * 65 + d + 1] = (bfhi(ww[j]) - mean) * rstd * lng[cc + 1] + lnb[cc + 1]; } } }
            { const int q0 = (C.tid & 3) * 32; const float* src = sgw + ((size_t)g * 128 + p) * 128 + q0;
#pragma unroll
              for (int j = 0; j < 8; ++j) { const f32x4 w = *(const f32x4*)(src + 4 * j);
#pragma unroll
                  for (int t = 0; t < 4; ++t) { const int q = q0 + 4 * j + t; Wl[p * 129 + q] = (q <= p) ? w[t] : 0.f; } } }
            __syncthreads();
            float acc[16];
#pragma unroll
            for (int j = 0; j < 16; ++j) acc[j] = 0.f;
            for (int q = 0; q <= p; ++q) { const float w = Wl[p * 129 + q];
#pragma unroll
                for (int j = 0; j < 16; ++j) acc[j] += w * gvn[q * 65 + d0 + j]; }
            const float bs = sgb[g * 128 + p];
            const bf16_t* us = U + (size_t)(tb + p) * SGW + g * 64 + d0; bf16_t* dst = CAT + (size_t)(tb + p) * D + g * 64 + d0;
#pragma unroll
            for (int h = 0; h < 2; ++h) { const u32x4 w = *(const u32x4*)(us + 8 * h); const unsigned ww[4] = {w.x, w.y, w.z, w.w}; unsigned o[4];
#pragma unroll
                for (int j = 0; j < 4; ++j) o[j] = pk2(bflo(ww[j]) * (acc[8 * h + 2 * j] + bs), bfhi(ww[j]) * (acc[8 * h + 2 * j + 1] + bs));
                *(u32x4*)(dst + 8 * h) = (u32x4){o[0], o[1], o[2], o[3]}; }
            __syncthreads();
        }
    }
}

__device__ __forceinline__ void memattn_scalar(const Ctx& C, const bf16_t* QM, const bf16_t* MKV, int ck, int cv, bf16_t* OUT, int ldo, int coff) {
    for (int it = C.gw; it < T * 4; it += C.NGW) {
        const int tok = it >> 2, h = it & 3, b = tok / SEQ;
        float q[64];
        { const bf16_t* qp = QM + (size_t)tok * 256 + h * 64;
#pragma unroll
          for (int j = 0; j < 8; ++j) { const u32x4 w = *(const u32x4*)(qp + 8 * j);
              q[8 * j] = bflo(w.x); q[8 * j + 1] = bfhi(w.x); q[8 * j + 2] = bflo(w.y); q[8 * j + 3] = bfhi(w.y); q[8 * j + 4] = bflo(w.z); q[8 * j + 5] = bfhi(w.z); q[8 * j + 6] = bflo(w.w); q[8 * j + 7] = bfhi(w.w); } }
        float s[4];
#pragma unroll
        for (int jj = 0; jj < 4; ++jj) { const bf16_t* kp = MKV + (size_t)(b * NMEM + jj * 64 + C.lane) * 1024 + ck + h * 64; float a = 0.f;
#pragma unroll
            for (int j = 0; j < 8; ++j) { const u32x4 w = *(const u32x4*)(kp + 8 * j);
                a += q[8 * j] * bflo(w.x) + q[8 * j + 1] * bfhi(w.x) + q[8 * j + 2] * bflo(w.y) + q[8 * j + 3] * bfhi(w.y) + q[8 * j + 4] * bflo(w.z) + q[8 * j + 5] * bfhi(w.z) + q[8 * j + 6] * bflo(w.w) + q[8 * j + 7] * bfhi(w.w); }
            s[jj] = a; }
        const float mx = wave_max(fmaxf(fmaxf(s[0], s[1]), fmaxf(s[2], s[3])));
        float l = 0.f;
#pragma unroll
        for (int jj = 0; jj < 4; ++jj) { s[jj] = __expf(s[jj] - mx); l += s[jj]; }
        l = wave_sum(l);
        float acc = 0.f;
#pragma unroll
        for (int jj = 0; jj < 4; ++jj) { const bf16_t* vp = MKV + (size_t)(b * NMEM + jj * 64) * 1024 + cv + h * 64 + C.lane;
            for (int mm = 0; mm < 64; ++mm) acc += __shfl(s[jj], mm) * bf1(vp[(size_t)mm * 1024]); }
        OUT[(size_t)tok * ldo + coff + h * 64 + C.lane] = (bf16_t)f2bf(acc / l);
    }
}

__device__ __forceinline__ void dilattn_scalar(const Ctx& C, const Args& A) {
    const bf16_t* Q = (const bf16_t*)(C.ws + WS_Q); const bf16_t* K = (const bf16_t*)(C.ws + WS_K); const bf16_t* V = (const bf16_t*)(C.ws + WS_V);
    bf16_t* OG = (bf16_t*)(C.ws + WS_OG); float* LSE = (float*)(C.ws + WS_LSE);
    for (int it = C.gw; it < T * 12; it += C.NGW) {
        const int tok = it / 12, h = it % 12, g = h >> 2, dl = (g == 0) ? 1 : (g == 1 ? 4 : 16);
        const int t = tok % SEQ, i = t / dl;
        const float slope = exp2f(-(float)(h + 1) * (8.0f / 12.0f));
        float q[64];
        { const bf16_t* qp = Q + (size_t)tok * SGW + h * 64;
#pragma unroll
          for (int j = 0; j < 8; ++j) { const u32x4 w = *(const u32x4*)(qp + 8 * j);
              q[8 * j] = bflo(w.x); q[8 * j + 1] = bfhi(w.x); q[8 * j + 2] = bflo(w.y); q[8 * j + 3] = bfhi(w.y); q[8 * j + 4] = bflo(w.z); q[8 * j + 5] = bfhi(w.z); q[8 * j + 6] = bflo(w.w); q[8 * j + 7] = bfhi(w.w); } }
        float s[3];
#pragma unroll
        for (int jj = 0; jj < 3; ++jj) { const int j0 = jj * 64 + C.lane; const bool valid = (jj < 2 || C.lane == 0) && (j0 <= i);
            const int jc = valid ? j0 : 0;
            const bf16_t* kp = K + (size_t)(tok - jc * dl) * SGW + h * 64; float a = 0.f;
#pragma unroll
            for (int j = 0; j < 8; ++j) { const u32x4 w = *(const u32x4*)(kp + 8 * j);
                a += q[8 * j] * bflo(w.x) + q[8 * j + 1] * bfhi(w.x) + q[8 * j + 2] * bflo(w.y) + q[8 * j + 3] * bfhi(w.y) + q[8 * j + 4] * bflo(w.z) + q[8 * j + 5] * bfhi(w.z) + q[8 * j + 6] * bflo(w.w) + q[8 * j + 7] * bfhi(w.w); }
            s[jj] = valid ? (a - slope * (float)(dl * j0)) : -INFINITY; }
        const float mx = wave_max(fmaxf(fmaxf(s[0], s[1]), s[2]));
        float l = 0.f;
#pragma unroll
        for (int jj = 0; jj < 3; ++jj) { s[jj] = __expf(s[jj] - mx); l += s[jj]; }
        l = wave_sum(l);
        float acc = 0.f;
#pragma unroll
        for (int jj = 0; jj < 3; ++jj) { const int nm = (jj < 2) ? 64 : 1;
            for (int mm = 0; mm < nm; ++mm) { const int j0 = jj * 64 + mm; const int jc = (j0 <= i) ? j0 : 0;
                acc += __shfl(s[jj], mm) * bf1(V[(size_t)(tok - jc * dl) * SGW + h * 64 + C.lane]); } }
        OG[(size_t)tok * SGW + h * 64 + C.lane] = (bf16_t)f2bf(acc / l);
        if (C.lane == 0) LSE[tok * 12 + h] = mx + __logf(l);
    }
}
typedef short bf16x8 __attribute__((ext_vector_type(8)));
typedef short s16x4 __attribute__((ext_vector_type(4)));
constexpr int AT_KS = 144, AT_VS = 160, AT_ROWS = 272, AT_K_OFF = 0, AT_V_OFF = AT_ROWS * AT_KS;
static_assert(AT_V_OFF % 16 == 0 && AT_V_OFF + AT_ROWS * AT_VS <= 131072, "attention LDS map");

template <int NKB, bool DIL>
__device__ __forceinline__ void attn_compute(LAS unsigned char* lds, int lane, int krow0, bf16x8 qf0, bf16x8 qf1, float sdl, int ikw, f32x4 (&o)[4], float& mx, float& lsum) {
    const int n = lane & 15, g = lane >> 4;
    const LAS unsigned char* Kb = lds + AT_K_OFF + (krow0 + n) * AT_KS + g * 16;
    f32x4 sc[NKB];
#pragma unroll
    for (int kb = 0; kb < NKB; ++kb) {
        const bf16x8 k0 = *(const LAS bf16x8*)(Kb + kb * 16 * AT_KS), k1 = *(const LAS bf16x8*)(Kb + kb * 16 * AT_KS + 64);
        f32x4 a = (f32x4){0.f, 0.f, 0.f, 0.f};
        a = __builtin_amdgcn_mfma_f32_16x16x32_bf16(k0, qf0, a, 0, 0, 0);
        a = __builtin_amdgcn_mfma_f32_16x16x32_bf16(k1, qf1, a, 0, 0, 0);
        sc[kb] = a;
    }
    float m = -INFINITY;
#pragma unroll
    for (int kb = 0; kb < NKB; ++kb)
#pragma unroll
        for (int r = 0; r < 4; ++r) {
            if (DIL) { const int off = 16 * kb + 4 * g + r, rel = 144 + n - off; const bool valid = (rel >= 0) && (rel <= 128) && (ikw + off >= 0);
                sc[kb][r] = valid ? (sc[kb][r] - sdl * (float)rel) : -INFINITY; }
            m = fmaxf(m, sc[kb][r]); }
    m = fmaxf(m, __shfl_xor(m, 16)); m = fmaxf(m, __shfl_xor(m, 32));
    float l = 0.f;
#pragma unroll
    for (int kb = 0; kb < NKB; ++kb)
#pragma unroll
        for (int r = 0; r < 4; ++r) { sc[kb][r] = __expf(sc[kb][r] - m); l += sc[kb][r]; }
    l += __shfl_xor(l, 16); l += __shfl_xor(l, 32);
    mx = m; lsum = l;
    const LAS unsigned char* Vb = lds + AT_V_OFF + (krow0 + 4 * g + (n >> 2)) * AT_VS + (n & 3) * 8;
#pragma unroll
    for (int db = 0; db < 4; ++db) o[db] = (f32x4){0.f, 0.f, 0.f, 0.f};
#pragma unroll
    for (int kk = 0; kk < NKB / 2; ++kk) {
        union { bf16x8 v; unsigned u[4]; } pf;
        pf.u[0] = cvt_pk_bf16(sc[2 * kk][0], sc[2 * kk][1]); pf.u[1] = cvt_pk_bf16(sc[2 * kk][2], sc[2 * kk][3]);
        pf.u[2] = cvt_pk_bf16(sc[2 * kk + 1][0], sc[2 * kk + 1][1]); pf.u[3] = cvt_pk_bf16(sc[2 * kk + 1][2], sc[2 * kk + 1][3]);
#pragma unroll
        for (int db = 0; db < 4; ++db) {
            const s16x4 v0 = __builtin_amdgcn_ds_read_tr16_b64_v4i16((LAS s16x4*)(Vb + (2 * kk) * 16 * AT_VS + db * 32));
            const s16x4 v1 = __builtin_amdgcn_ds_read_tr16_b64_v4i16((LAS s16x4*)(Vb + (2 * kk + 1) * 16 * AT_VS + db * 32));
            const bf16x8 vf = __builtin_shufflevector(v0, v1, 0, 1, 2, 3, 4, 5, 6, 7);
            o[db] = __builtin_amdgcn_mfma_f32_16x16x32_bf16(vf, pf.v, o[db], 0, 0, 0);
        }
    }
}

__device__ __forceinline__ void memattn_mfma(const Ctx& C, const bf16_t* QM, const bf16_t* MKV, int ck, int cv, bf16_t* OUT, int ldo, int coff) {
    const int n = C.lane & 15, g = C.lane >> 4;
    for (int unit = C.bid; unit < NB * 4 * 8; unit += C.G) {
        const int b = unit >> 5, h = (unit >> 3) & 3, qp = unit & 7;
        __syncthreads();
#pragma unroll
        for (int it = 0; it < 4; ++it) { const int row = it * 64 + (C.tid >> 3), c = C.tid & 7;
            const bf16_t* src = MKV + (size_t)(b * NMEM + row) * 1024 + h * 64 + c * 8;
            const u32x4 kv = *(const u32x4*)(src + ck), vv = *(const u32x4*)(src + cv);
            *(LAS u32x4*)(C.lds + AT_K_OFF + row * AT_KS + c * 16) = kv; *(LAS u32x4*)(C.lds + AT_V_OFF + row * AT_VS + c * 16) = vv; }
        bf16x8 qf[2][2];
#pragma unroll
        for (int t = 0; t < 2; ++t) { const bf16_t* qp_ = QM + (size_t)(b * SEQ + (qp * 2 + t) * 128 + C.wave * 16 + n) * 256 + h * 64 + g * 8; qf[t][0] = *(const bf16x8*)qp_; qf[t][1] = *(const bf16x8*)(qp_ + 32); }
        __syncthreads();
#pragma unroll
        for (int t = 0; t < 2; ++t) {
            const int tok = b * SEQ + (qp * 2 + t) * 128 + C.wave * 16 + n;
            f32x4 o[4]; float mx, l;
            attn_compute<16, false>(C.lds, C.lane, 0, qf[t][0], qf[t][1], 0.f, 0, o, mx, l);
            const float inv = 1.0f / l;
#pragma unroll
            for (int db = 0; db < 4; ++db)
                *(u32x2*)(OUT + (size_t)tok * ldo + coff + h * 64 + 16 * db + 4 * g) = (u32x2){cvt_pk_bf16(o[db][0] * inv, o[db][1] * inv), cvt_pk_bf16(o[db][2] * inv, o[db][3] * inv)};
        }
    }
}
__device__ __forceinline__ void dilattn_mfma(const Ctx& C) {
    const bf16_t* Q = (const bf16_t*)(C.ws + WS_Q); const bf16_t* K = (const bf16_t*)(C.ws + WS_K); const bf16_t* V = (const bf16_t*)(C.ws + WS_V);
    bf16_t* OG = (bf16_t*)(C.ws + WS_OG); float* LSE = (float*)(C.ws + WS_LSE);
    const int n = C.lane & 15, g = C.lane >> 4;
    for (int unit = C.bid; unit < 12 * 128; unit += C.G) {
        const int h = unit >> 7, rem = unit & 127, b = rem >> 4, x = rem & 15, grp = h >> 2;
        const int dl = (grp == 0) ? 1 : (grp == 1 ? 4 : 16), ntile = 16 / dl, r = x / ntile, I0 = (x % ntile) * 128;
        const float sdl = exp2f(-(float)(h + 1) * (8.0f / 12.0f)) * (float)dl;
        __syncthreads();
        { u32x4 kv[5], vv[5];
#pragma unroll
          for (int it = 0; it < 5; ++it) { const int idx = it * NTHREADS + C.tid, row = idx >> 3, c = idx & 7, ik = I0 - 144 + row;
              kv[it] = (u32x4){0u, 0u, 0u, 0u}; vv[it] = (u32x4){0u, 0u, 0u, 0u};
              if (idx < AT_ROWS * 8 && ik >= 0) { const size_t off = (size_t)(b * SEQ + ik * dl + r) * SGW + h * 64 + c * 8; kv[it] = *(const u32x4*)(K + off); vv[it] = *(const u32x4*)(V + off); } }
#pragma unroll
          for (int it = 0; it < 5; ++it) { const int idx = it * NTHREADS + C.tid, row = idx >> 3, c = idx & 7;
              if (idx < AT_ROWS * 8) { *(LAS u32x4*)(C.lds + AT_K_OFF + row * AT_KS + c * 16) = kv[it]; *(LAS u32x4*)(C.lds + AT_V_OFF + row * AT_VS + c * 16) = vv[it]; } } }
        const int iq = I0 + C.wave * 16 + n, tok = b * SEQ + iq * dl + r;
        const bf16_t* qp = Q + (size_t)tok * SGW + h * 64 + g * 8;
        const bf16x8 qf0 = *(const bf16x8*)qp, qf1 = *(const bf16x8*)(qp + 32);
        __syncthreads();
        f32x4 o[4]; float mx, l;
        attn_compute<10, true>(C.lds, C.lane, C.wave * 16, qf0, qf1, sdl, I0 + C.wave * 16 - 144, o, mx, l);
        const float inv = 1.0f / l;
#pragma unroll
        for (int db = 0; db < 4; ++db)
            *(u32x2*)(OG + (size_t)tok * SGW + h * 64 + 16 * db + 4 * g) = (u32x2){cvt_pk_bf16(o[db][0] * inv, o[db][1] * inv), cvt_pk_bf16(o[db][2] * inv, o[db][3] * inv)};
        if (g == 0) LSE[tok * 12 + h] = mx + __logf(l);
    }
}
constexpr int SG_GVN_OFF = 1024, SG_VS = 160, SG_TILE = 128 * SG_VS, SG_GB_OFF = SG_GVN_OFF + 6 * SG_TILE;
static_assert(SG_GB_OFF + 2 * 384 * 4 <= 131072, "spatial-gating LDS map");
__device__ __forceinline__ void sg_mfma(const Ctx& C, const Args& A) {
    const bf16_t* U = (const bf16_t*)(C.ws + WS_U); const bf16_t* GV = (const bf16_t*)(C.ws + WS_GV); bf16_t* CAT = (bf16_t*)(C.ws + WS_CAT);
    const bf16_t* WB = (const bf16_t*)(C.ws + WS_SGWB); const float* RS = (const float*)(C.ws + WS_SGRS);
    const float* lng = A.in[4]; const float* lnb = A.in[5]; const float* sgb = A.in[7];
    LAS float* stat = (LAS float*)C.lds; LAS float* gbl = (LAS float*)(C.lds + SG_GB_OFF);
    const int n = C.lane & 15, gl = C.lane >> 4;
    for (int unit = C.bid; unit < NB * 16 * 2; unit += C.G) {
        const int tb = (unit >> 1) * 128, g0 = (unit & 1) * 6;
        __syncthreads();
        u32x4 wt[12];
#pragma unroll
        for (int k = 0; k < 12; ++k) { const int rg = k * 64 + (C.tid >> 3), gi = rg >> 7, row = rg & 127, c = C.tid & 7;
            wt[k] = *(const u32x4*)(GV + (size_t)(tb + row) * SGW + (g0 + gi) * 64 + c * 8); }
        if (C.tid < 192) { const int half = C.tid / 96, i4 = C.tid % 96; *(LAS f32x4*)(gbl + half * 384 + 4 * i4) = *(const f32x4*)((half ? lnb : lng) + g0 * 64 + 4 * i4); }
        for (int r8 = 0; r8 < 16; r8 += 8) {
            u32x2 w[8][3];
#pragma unroll
            for (int q = 0; q < 8; ++q)
#pragma unroll
                for (int j = 0; j < 3; ++j) w[q][j] = *(const u32x2*)(GV + (size_t)(tb + C.wave * 16 + r8 + q) * SGW + 4 * C.lane + 256 * j);
#pragma unroll
            for (int q = 0; q < 8; ++q) { float s = 0.f, ss = 0.f;
#pragma unroll
                for (int j = 0; j < 3; ++j) { const float a = bflo(w[q][j].x), b = bfhi(w[q][j].x), c = bflo(w[q][j].y), d = bfhi(w[q][j].y);
                    s += (a + b) + (c + d); ss += (a * a + b * b) + (c * c + d * d); }
                s = wave_sum_dpp(s); ss = wave_sum_dpp(ss);
                const float mean = s * (1.f / SGW), var = ss * (1.f / SGW) - mean * mean; const int row = C.wave * 16 + r8 + q;
                if (C.lane == 0) { stat[row * 2] = mean; stat[row * 2 + 1] = 1.0f / sqrtf(var + LN_EPS); } } }
        __syncthreads();
#pragma unroll
        for (int k = 0; k < 12; ++k) { const int rg = k * 64 + (C.tid >> 3), gi = rg >> 7, row = rg & 127, c = C.tid & 7;
            const float mean = stat[row * 2], rstd = stat[row * 2 + 1]; u32x4 o;
            o.x = cvt_pk_bf16((bflo(wt[k].x) - mean) * rstd, (bfhi(wt[k].x) - mean) * rstd); o.y = cvt_pk_bf16((bflo(wt[k].y) - mean) * rstd, (bfhi(wt[k].y) - mean) * rstd);
            o.z = cvt_pk_bf16((bflo(wt[k].z) - mean) * rstd, (bfhi(wt[k].z) - mean) * rstd); o.w = cvt_pk_bf16((bflo(wt[k].w) - mean) * rstd, (bfhi(wt[k].w) - mean) * rstd);
            *(LAS u32x4*)(C.lds + SG_GVN_OFF + gi * SG_TILE + row * SG_VS + c * 16) = o; }
        __syncthreads();
        const int p = C.wave * 16 + n;
#pragma unroll 3
        for (int gi = 0; gi < 6; ++gi) {
            const int g = g0 + gi;
            const bf16_t* wp = WB + (size_t)(g * 128 + p) * 128 + 8 * gl;
            bf16x8 wf[4];
#pragma unroll
            for (int ks = 0; ks < 4; ++ks) wf[ks] = *(const bf16x8*)(wp + 32 * ks);
            u32x2 uw[4];
#pragma unroll
            for (int db = 0; db < 4; ++db) uw[db] = *(const u32x2*)(U + (size_t)(tb + p) * SGW + (size_t)g * 64 + 16 * db + 4 * gl);
            const float bs = sgb[g * 128 + p], rsw = RS[g * 128 + p];
            f32x4 acc[4];
#pragma unroll
            for (int db = 0; db < 4; ++db) acc[db] = (f32x4){0.f, 0.f, 0.f, 0.f};
            const LAS unsigned char* vb = C.lds + SG_GVN_OFF + gi * SG_TILE + (8 * gl + (n >> 2)) * SG_VS + (n & 3) * 8;
#pragma unroll
            for (int ks = 0; ks < 4; ++ks)
#pragma unroll
                for (int db = 0; db < 4; ++db) {
                    const s16x4 v0 = __builtin_amdgcn_ds_read_tr16_b64_v4i16((LAS s16x4*)(vb + ks * 32 * SG_VS + db * 32));
                    const s16x4 v1 = __builtin_amdgcn_ds_read_tr16_b64_v4i16((LAS s16x4*)(vb + ks * 32 * SG_VS + 4 * SG_VS + db * 32));
                    const bf16x8 vf = __builtin_shufflevector(v0, v1, 0, 1, 2, 3, 4, 5, 6, 7);
                    acc[db] = __builtin_amdgcn_mfma_f32_16x16x32_bf16(vf, wf[ks], acc[db], 0, 0, 0);
                }
#pragma unroll
            for (int db = 0; db < 4; ++db) { const int cl = gi * 64 + 16 * db + 4 * gl; const size_t co = (size_t)g * 64 + 16 * db + 4 * gl;
                const f32x4 ga = *(const LAS f32x4*)(gbl + cl), be = *(const LAS f32x4*)(gbl + 384 + cl);
                const float s0 = ga[0] * acc[db][0] + (be[0] * rsw + bs), s1 = ga[1] * acc[db][1] + (be[1] * rsw + bs);
                const float s2 = ga[2] * acc[db][2] + (be[2] * rsw + bs), s3 = ga[3] * acc[db][3] + (be[3] * rsw + bs);
                *(u32x2*)(CAT + (size_t)(tb + p) * D + co) = (u32x2){cvt_pk_bf16(bflo(uw[db].x) * s0, bfhi(uw[db].x) * s1), cvt_pk_bf16(bflo(uw[db].y) * s2, bfhi(uw[db].y) * s3)}; }
        }
    }
}
__device__ __forceinline__ void dil_merge(const Ctx& C, const Args& A) {
    const bf16_t* OG = (const bf16_t*)(C.ws + WS_OG); const float* LSE = (const float*)(C.ws + WS_LSE); bf16_t* CAT2 = (bf16_t*)(C.ws + WS_CAT2);
    const int gt = C.bid * NTHREADS + C.tid, NT = C.G * NTHREADS;
    for (int it = gt; it < T * 32; it += NT) {
        const int tok = it >> 5, j = (it >> 3) & 3, c8 = it & 7;
        const float l0 = LSE[tok * 12 + j], l1 = LSE[tok * 12 + 4 + j], l2 = LSE[tok * 12 + 8 + j];
        const float mx = fmaxf(l0, fmaxf(l1, l2));
        float w0 = __expf(l0 - mx), w1 = __expf(l1 - mx), w2 = __expf(l2 - mx); const float inv = 1.0f / (w0 + w1 + w2); w0 *= inv; w1 *= inv; w2 *= inv;
        const u32x4 a = *(const u32x4*)(OG + (size_t)tok * SGW + j * 64 + c8 * 8), b = *(const u32x4*)(OG + (size_t)tok * SGW + (4 + j) * 64 + c8 * 8), c = *(const u32x4*)(OG + (size_t)tok * SGW + (8 + j) * 64 + c8 * 8);
        u32x4 o;
        o.x = pk2(w0 * bflo(a.x) + w1 * bflo(b.x) + w2 * bflo(c.x), w0 * bfhi(a.x) + w1 * bfhi(b.x) + w2 * bfhi(c.x));
        o.y = pk2(w0 * bflo(a.y) + w1 * bflo(b.y) + w2 * bflo(c.y), w0 * bfhi(a.y) + w1 * bfhi(b.y) + w2 * bfhi(c.y));
        o.z = pk2(w0 * bflo(a.z) + w1 * bflo(b.z) + w2 * bflo(c.z), w0 * bfhi(a.z) + w1 * bfhi(b.z) + w2 * bfhi(c.z));
        o.w = pk2(w0 * bflo(a.w) + w1 * bflo(b.w) + w2 * bflo(c.w), w0 * bfhi(a.w) + w1 * bfhi(b.w) + w2 * bfhi(c.w));
        *(u32x4*)(CAT2 + (size_t)tok * 512 + j * 64 + c8 * 8) = o;
    }
}

constexpr int LR_WS = 2064;
__device__ __forceinline__ void ln_route(const Ctx& C, const Args& A, int layer, int cset) {
    const bf16_t* Y = (const bf16_t*)(C.ws + WS_Y); bf16_t* X1B = (bf16_t*)(C.ws + WS_X1B); unsigned char* X1F8 = C.ws + WS_X1F8;
    const float* lg = A.in[14] + layer * D; const float* lb = A.in[15] + layer * D; const float* br = A.in[19];
    unsigned* cnt = (unsigned*)(C.ws + WS_CTL) + CW_CNT + cset * 16 * 64;
    int* tokE = (int*)(C.ws + WS_TOKE); int* tokP = (int*)(C.ws + WS_TOKP); float* tokG = (float*)(C.ws + WS_TOKG); int* list = (int*)(C.ws + WS_LIST);
    LAS unsigned char* wl = C.lds;
    LAS int* sE = (LAS int*)(C.lds + 65536); LAS float* sG = (LAS float*)(C.lds + 65536 + 512); LAS int* sPos = (LAS int*)(C.lds + 65536 + 1024);
    LAS int* lcnt = (LAS int*)(C.lds + 65536 + 1536); LAS int* lbase = (LAS int*)(C.lds + 65536 + 1600); LAS float* slog = (LAS float*)(C.lds + 65536 + 2048);
    __syncthreads();
#pragma unroll
    for (int it = 0; it < 4; ++it) { const int i = it * NTHREADS + C.tid, e = i >> 7, c = i & 127;
        *(LAS u32x4*)(wl + e * LR_WS + c * 16) = *(const u32x4*)((const bf16_t*)(C.ws + WS_WRT) + (size_t)e * 1024 + c * 8); }
    f32x4 g4[4], b4[4];
#pragma unroll
    for (int j = 0; j < 4; ++j) { g4[j] = *(const f32x4*)(lg + 4 * C.lane + 256 * j); b4[j] = *(const f32x4*)(lb + 4 * C.lane + 256 * j); }
    const int n = C.lane & 15, q = C.lane >> 4;
    for (int blk = C.bid; blk < T / 64; blk += C.G) {
        __syncthreads();
        if (C.tid < 16) lcnt[C.tid] = 0;
        u32x2 nv[4];
        { const u32x2* yb = (const u32x2*)(Y + (size_t)(blk * 64 + C.wave * 8) * D) + C.lane;
#pragma unroll
          for (int j = 0; j < 4; ++j) nv[j] = yb[64 * j]; }
#pragma unroll 1
        for (int tq = 0; tq < 8; ++tq) {
            const int tok = blk * 64 + C.wave * 8 + tq;
            f32x4 v[4]; float s = 0.f;
#pragma unroll
            for (int j = 0; j < 4; ++j) { v[j] = (f32x4){bflo(nv[j].x), bfhi(nv[j].x), bflo(nv[j].y), bfhi(nv[j].y)}; s += (v[j][0] + v[j][1]) + (v[j][2] + v[j][3]); }
            { const u32x2* yb = (const u32x2*)(Y + (size_t)(tok + (tq < 7 ? 1 : 0)) * D) + C.lane;
#pragma unroll
              for (int j = 0; j < 4; ++j) nv[j] = yb[64 * j]; }
            const float mean = wave_sum_dpp(s) * (1.f / D); float s2 = 0.f;
#pragma unroll
            for (int j = 0; j < 4; ++j) { v[j] = v[j] - mean; s2 += (v[j][0] * v[j][0] + v[j][1] * v[j][1]) + (v[j][2] * v[j][2] + v[j][3] * v[j][3]); }
            const float rstd = 1.0f / sqrtf(wave_sum_dpp(s2) * (1.f / D) + LN_EPS);
            u32x2* xb = (u32x2*)(X1B + (size_t)tok * D) + C.lane; unsigned* x8 = (unsigned*)(X1F8 + (size_t)tok * D) + C.lane;
#pragma unroll
            for (int j = 0; j < 4; ++j) { v[j] = v[j] * rstd * g4[j] + b4[j];
                xb[64 * j] = (u32x2){pk2(v[j][0], v[j][1]), pk2(v[j][2], v[j][3])};
                x8[64 * j] = pk4_fp8(v[j][0], v[j][1], v[j][2], v[j][3]); }
        }
        asm volatile("s_waitcnt vmcnt(0)" ::: "memory");
        __syncthreads();
        {
            const int tile = C.wave & 3, kh = C.wave >> 2;
            const bf16_t* ap = X1B + (size_t)(blk * 64 + tile * 16 + n) * D + kh * 512 + 8 * q;
            const LAS unsigned char* bp = wl + n * LR_WS + (kh * 512 + 8 * q) * 2;
            bf16x8 af[16];
#pragma unroll
            for (int ks = 0; ks < 16; ++ks) af[ks] = *(const bf16x8*)(ap + 32 * ks);
            f32x4 acc = (f32x4){0.f, 0.f, 0.f, 0.f};
#pragma unroll
            for (int ks = 0; ks < 16; ++ks) { const bf16x8 bf = *(const LAS bf16x8*)(bp + 64 * ks); acc = __builtin_amdgcn_mfma_f32_16x16x32_bf16(af[ks], bf, acc, 0, 0, 0); }
#pragma unroll
            for (int r = 0; r < 4; ++r) slog[(kh * 64 + tile * 16 + 4 * q + r) * 17 + n] = acc[r];
        }
        __syncthreads();
        if (C.tid < 64) {
            const int tl = C.tid;
            float pr[16]; float mx = -INFINITY;
#pragma unroll
            for (int e = 0; e < 16; ++e) { pr[e] = slog[tl * 17 + e] + slog[(64 + tl) * 17 + e]; mx = fmaxf(mx, pr[e]); }
            float sum = 0.f;
#pragma unroll
            for (int e = 0; e < 16; ++e) { pr[e] = __expf(pr[e] - mx); sum += pr[e]; }
            const float inv = 1.0f / sum; float sel[16];
#pragma unroll
            for (int e = 0; e < 16; ++e) { pr[e] *= inv; sel[e] = pr[e] + br[e]; }
            float gs[4];
#pragma unroll
            for (int g = 0; g < 4; ++g) { const float a = sel[4 * g], b = sel[4 * g + 1], c = sel[4 * g + 2], d = sel[4 * g + 3];
                gs[g] = fmaxf(fmaxf(fmaxf(a + b, a + c), fmaxf(a + d, b + c)), fmaxf(b + d, c + d)); }
            int gi = 0; float bsc = gs[0];
#pragma unroll
            for (int g = 1; g < 4; ++g) if (gs[g] > bsc) { bsc = gs[g]; gi = g; }
            float sg[4], pg[4];
#pragma unroll
            for (int k = 0; k < 4; ++k) { sg[k] = gi == 0 ? sel[k] : (gi == 1 ? sel[4 + k] : (gi == 2 ? sel[8 + k] : sel[12 + k])); pg[k] = gi == 0 ? pr[k] : (gi == 1 ? pr[4 + k] : (gi == 2 ? pr[8 + k] : pr[12 + k])); }
            int i1 = 0; float b1 = sg[0], p1 = pg[0];
#pragma unroll
            for (int k = 1; k < 4; ++k) if (sg[k] > b1) { b1 = sg[k]; i1 = k; p1 = pg[k]; }
            int i2 = -1; float b2 = -INFINITY, p2 = 0.f;
#pragma unroll
            for (int k = 0; k < 4; ++k) if (k != i1 && sg[k] > b2) { b2 = sg[k]; i2 = k; p2 = pg[k]; }
            const float gsum = p1 + p2; sE[tl * 2] = gi * 4 + i1; sE[tl * 2 + 1] = gi * 4 + i2; sG[tl * 2] = p1 / gsum; sG[tl * 2 + 1] = p2 / gsum;
        }
        __syncthreads();
        if (C.tid < 128) sPos[C.tid] = __hip_atomic_fetch_add(lcnt + sE[C.tid], 1, __ATOMIC_RELAXED, __HIP_MEMORY_SCOPE_WORKGROUP);
        __syncthreads();
        if (C.tid < 16) lbase[C.tid] = (int)__hip_atomic_fetch_add(cnt + C.tid * 64, (unsigned)lcnt[C.tid], __ATOMIC_RELAXED, __HIP_MEMORY_SCOPE_AGENT);
        __syncthreads();
        if (C.tid < 128) { const int e = sE[C.tid], pos = lbase[e] + sPos[C.tid], tok = blk * 64 + (C.tid >> 1);
            list[e * LISTCAP + pos] = tok; tokE[tok * 2 + (C.tid & 1)] = e; tokP[tok * 2 + (C.tid & 1)] = pos; tokG[tok * 2 + (C.tid & 1)] = sG[C.tid]; }
    }
}
__device__ __forceinline__ void moe_prefix(const Ctx& C, int layer) {
    LAS int* mi = (LAS int*)(C.lds + LDS_MISC);
    unsigned* cnt = (unsigned*)(C.ws + WS_CTL) + CW_CNT + layer * 16 * 64;
    __syncthreads();
    if (C.tid < 16) mi[17 + C.tid] = (int)__hip_atomic_load(cnt + C.tid * 64, __ATOMIC_RELAXED, __HIP_MEMORY_SCOPE_AGENT);
    __syncthreads();
    if (C.tid == 0) { int a = 0; for (int e = 0; e < 16; ++e) { mi[e] = a; a += (mi[17 + e] + 255) >> 8; } mi[16] = a; }
    __syncthreads();
}
__device__ __forceinline__ void moe_tokens(const Ctx& C, int ntn) {
    const LAS int* mi = (const LAS int*)(C.lds + LDS_MISC); LAS int* toks = (LAS int*)(C.lds + LDS_TOKS);
    const int* list = (const int*)(C.ws + WS_LIST);
    const int total = mi[16] * ntn;
    int tv[4]; bool ok[4];
#pragma unroll
    for (int k = 0; k < 4; ++k) {
        const int idx = k * NTHREADS + C.tid, u = idx >> 8, rr = idx & 255, L = u * C.G + C.bid; ok[k] = L < total;
        const int Lc = ok[k] ? L : 0; int e = 0;
#pragma unroll
        for (int j = 1; j < 16; ++j) e += (Lc >= mi[j] * ntn) ? 1 : 0;
        const int r = Lc - mi[e] * ntn, te = mi[e + 1] - mi[e], mt = r % (te > 0 ? te : 1), cn = mi[17 + e];
        int pos = mt * 256 + rr; pos = pos < cn ? pos : cn - 1; pos = pos < 0 ? 0 : pos;
        tv[k] = list[e * LISTCAP + pos];
    }
#pragma unroll
    for (int k = 0; k < 4; ++k) if (ok[k]) toks[k * NTHREADS + C.tid] = tv[k];
    __syncthreads();
}
__device__ __forceinline__ void combine_ln2(const Ctx& C, const Args& A, int layer) {
    const LAS int* mi = (const LAS int*)(C.lds + LDS_MISC);
    const bf16_t* X1B = (const bf16_t*)(C.ws + WS_X1B); const bf16_t* YD = (const bf16_t*)(C.ws + WS_YD); bf16_t* X2B = (bf16_t*)(C.ws + WS_XB);
    const int* tokE = (const int*)(C.ws + WS_TOKE); const int* tokP = (const int*)(C.ws + WS_TOKP); const float* tokG = (const float*)(C.ws + WS_TOKG);
    const float* lg = A.in[16] + layer * D; const float* lb = A.in[17] + layer * D;
    for (int tok0 = C.gw * 8; tok0 < T; tok0 += C.NGW * 8) {
        int rowv = 0; float gv = 0.f;
        if (C.lane < 16) { const int e = tokE[tok0 * 2 + C.lane]; rowv = mi[e] * 256 + tokP[tok0 * 2 + C.lane]; gv = tokG[tok0 * 2 + C.lane]; }
#pragma unroll 1
        for (int tq = 0; tq < 8; tq += 4) {
            u32x2 xa[4][4], y0[4][4], y1[4][4]; float g0[4], g1[4];
#pragma unroll
            for (int t = 0; t < 4; ++t) {
                const int ra = __shfl(rowv, 2 * (tq + t)), rb = __shfl(rowv, 2 * (tq + t) + 1);
                g0[t] = __shfl(gv, 2 * (tq + t)); g1[t] = __shfl(gv, 2 * (tq + t) + 1);
                const u32x2* xp = (const u32x2*)(X1B + (size_t)(tok0 + tq + t) * D) + C.lane; const u32x2* pa = (const u32x2*)(YD + (size_t)ra * D) + C.lane; const u32x2* pb = (const u32x2*)(YD + (size_t)rb * D) + C.lane;
#pragma unroll
                for (int j = 0; j < 4; ++j) { xa[t][j] = xp[64 * j]; y0[t][j] = pa[64 * j]; y1[t][j] = pb[64 * j]; }
            }
#pragma unroll
            for (int t = 0; t < 4; ++t) {
                f32x4 v[4]; float s = 0.f;
#pragma unroll
                for (int j = 0; j < 4; ++j) {
                    v[j][0] = ALPHA * bflo(xa[t][j].x) + (g0[t] * bflo(y0[t][j].x) + g1[t] * bflo(y1[t][j].x)); v[j][1] = ALPHA * bfhi(xa[t][j].x) + (g0[t] * bfhi(y0[t][j].x) + g1[t] * bfhi(y1[t][j].x));
                    v[j][2] = ALPHA * bflo(xa[t][j].y) + (g0[t] * bflo(y0[t][j].y) + g1[t] * bflo(y1[t][j].y)); v[j][3] = ALPHA * bfhi(xa[t][j].y) + (g0[t] * bfhi(y0[t][j].y) + g1[t] * bfhi(y1[t][j].y));
                    s += (v[j][0] + v[j][1]) + (v[j][2] + v[j][3]); }
                const float mean = wave_sum_dpp(s) * (1.f / D); float s2 = 0.f;
#pragma unroll
                for (int j = 0; j < 4; ++j) { v[j] = v[j] - mean; s2 += (v[j][0] * v[j][0] + v[j][1] * v[j][1]) + (v[j][2] * v[j][2] + v[j][3] * v[j][3]); }
                const float rstd = 1.0f / sqrtf(wave_sum_dpp(s2) * (1.f / D) + LN_EPS);
                const int tok = tok0 + tq + t;
#pragma unroll
                for (int j = 0; j < 4; ++j) { const int col = 4 * C.lane + 256 * j; const f32x4 g4 = *(const f32x4*)(lg + col), b4 = *(const f32x4*)(lb + col);
                    const f32x4 o = v[j] * rstd * g4 + b4;
                    if (layer == 0) *(u32x2*)(X2B + (size_t)tok * D + col) = (u32x2){pk2(o[0], o[1]), pk2(o[2], o[3])};
                    else *(f32x4*)(A.out + (size_t)tok * D + col) = o; }
            }
        }
    }
}

__global__ void __launch_bounds__(NTHREADS, 2) yoco_fwd(Args args) {
    extern __shared__ __attribute__((aligned(16))) unsigned char lds_raw[];
    Ctx C;
    C.ws = args.ws; C.lds = (LAS unsigned char*)lds_raw;
    C.tid = threadIdx.x; C.lane = C.tid & 63; C.wave = __builtin_amdgcn_readfirstlane(C.tid >> 6);
    C.G = gridDim.x; C.bid = blockIdx.x; C.gw = C.bid * NWAVES + C.wave; C.NGW = C.G * NWAVES;
    unsigned char* ws = args.ws;
#define PHASE_WS() do { ws = launder(args.ws); C.ws = ws; C.tid = launder_v((int)threadIdx.x); C.lane = C.tid & 63; } while (0)
    volatile LAS unsigned* misc = (volatile LAS unsigned*)(C.lds + LDS_MISC);
    for (int u = C.tid; u < 64; u += NTHREADS) misc[u] = 0u;
    __syncthreads();
    XcdBarrier bar; bar.bar = (unsigned*)(ws + WS_CTL) + CW_BAR; bar.x = 0; bar.st = misc + 60;
    const int lo = args.ph_lo, hi = args.ph_hi;
    if (hi - lo > 1) bar = xcd_barrier_post((unsigned*)(ws + WS_CTL) + CW_BAR, misc + 60);
#define IN(k) (lo <= (k) && (k) < hi)
#define SEAMF(k) do { if (IN(k) && IN((k) + 1)) { PHASE_WS(); fill_tail(C, args, (k), false); xcd_barrier(bar); } } while (0)
#if MK_DIAG == 9
#define SEAM(k) do { if (IN(k) && IN((k) + 1)) { const unsigned long long t0_ = __builtin_amdgcn_s_memrealtime(); xcd_barrier(bar); if (((MK_DIAGMASK >> (k)) & 1) && threadIdx.x == 0) diag_acc += (unsigned)(__builtin_amdgcn_s_memrealtime() - t0_); } } while (0)
#else
#define SEAM(k) do { if (IN(k) && IN((k) + 1)) xcd_barrier(bar); } while (0)
#endif
#ifndef MK_DUP
#define MK_DUP 0
#endif
    unsigned diag_acc = 0;
#if MK_DIAG == 10
#define TREG(id, ...) do { __syncthreads(); const unsigned long long t0_ = __builtin_amdgcn_s_memrealtime(); __VA_ARGS__; __syncthreads(); if ((id) == MK_DIAGSEL) diag_acc += (unsigned)(__builtin_amdgcn_s_memrealtime() - t0_); } while (0)
#else
#define TREG(id, ...) do { __VA_ARGS__; } while (0)
#endif
#define REP(k) for (int rep_ = 0; rep_ < 1 + ((MK_DUP >> (k)) & 1); ++rep_)

    if (IN(0)) { REP(0) { PHASE_WS(); TREG(10, p0_prologue(C, args)); } SEAM(0); }

    if (IN(1)) {
        REP(1) {
        PHASE_WS();
        { pg8::Gemm g{(const bf16_t*)(ws + WS_XB), (const bf16_t*)(ws + WS_BT_INA), T, 1792, D}; pg8::StaticOrder S; S.init(T, 1792, C.G, C.bid);
          EpiProjA E{(bf16_t*)(ws + WS_U), (bf16_t*)(ws + WS_GV), (bf16_t*)(ws + WS_QM0)};
          pg8::gemm_phase<EpiProjA, pg8::StaticOrder>(C.lds, g, S, E, nullptr, C.tid); }
        { pg8::Gemm g{(const bf16_t*)(ws + WS_MEMB), (const bf16_t*)(ws + WS_BT_MEM), NB * NMEM, 1024, D}; SmallOrder S{4, 32, C.bid - (C.G - 32)};
          EpiPlain E{(bf16_t*)(ws + WS_MKV), 1024, 4};
          pg8::gemm_phase<EpiPlain, SmallOrder>(C.lds, g, S, E, nullptr, C.tid); }
        }
        SEAMF(1);
    }
    if (IN(2)) {
        REP(2) { PHASE_WS();
        TREG(1, sg_mfma(C, args));
        TREG(2, memattn_mfma(C, (const bf16_t*)(ws + WS_QM0), (const bf16_t*)(ws + WS_MKV), 0, 256, (bf16_t*)(ws + WS_CAT), D, SGW)); }
        SEAM(2);
    }
    if (IN(3)) {
        REP(3) { PHASE_WS();
        pg8::Gemm g{(const bf16_t*)(ws + WS_CAT), (const bf16_t*)(ws + WS_BT_OUTA), T, D, D}; pg8::StaticOrder S; S.init(T, D, C.G, C.bid);
        EpiResid<true> E{(const void*)(ws + WS_XB), (bf16_t*)(ws + WS_Y)};
        pg8::gemm_phase<EpiResid<true>, pg8::StaticOrder>(C.lds, g, S, E, nullptr, C.tid); }
        SEAM(3);
    }
    { constexpr int layer = 0;
        const int pb = 4 + 8 * layer;
        if (IN(pb)) { if ((MK_DUP >> 4) & 1) { PHASE_WS(); ln_route(C, args, layer, 2 + layer); __syncthreads(); } PHASE_WS(); TREG(6 + layer, ln_route(C, args, layer, layer)); SEAM(pb); }
        if (IN(pb + 1)) {
            REP(5) { PHASE_WS();
            moe_prefix(C, layer); moe_tokens(C, 8);
            MoeGatherOrder S; S.tb = (const LAS int*)(C.lds + LDS_MISC); S.ntn = 8; S.G = C.G; S.c = C.bid; S.toks = (const LAS int*)(C.lds + LDS_TOKS);
            {
                pg8::Gemm g{(const bf16_t*)(ws + WS_X1F8), (const bf16_t*)(ws + WS_WGU + (size_t)layer * (64 * MiB)), 0, 0, D / 2, E8_ONE, E8_W};
                EpiSwiGLU8 E{ws + WS_ACT};
#if MK_DUPNULL
                if (rep_ > 0) { EpiNull EN; pg8::gemm_phase<EpiNull, MoeGatherOrder, false, true>(C.lds, g, S, EN, nullptr, C.tid); } else
#endif
                pg8::gemm_phase<EpiSwiGLU8, MoeGatherOrder, false, true>(C.lds, g, S, E, nullptr, C.tid);
            } }
            SEAMF(pb + 1);
        }
        if (IN(pb + 2)) {
            REP(6) { PHASE_WS();
            moe_prefix(C, layer);
            MoeOrder S{(const LAS int*)(C.lds + LDS_MISC), 4, C.G, C.bid};
            EpiPlain E{(bf16_t*)(ws + WS_YD), 1024, 4};
            {
                pg8::Gemm g{(const bf16_t*)(ws + WS_ACT), (const bf16_t*)(ws + WS_WD + (size_t)layer * (32 * MiB)), 0, 0, D / 2, E8_ACT, E8_W};
                pg8::gemm_phase<EpiPlain, MoeOrder, false, true>(C.lds, g, S, E, nullptr, C.tid);
            } }
            SEAMF(pb + 2);
        }
        if (IN(pb + 3)) { REP(7) { PHASE_WS(); moe_prefix(C, layer); TREG(8 + layer, combine_ln2(C, args, layer)); } if (layer == 0) SEAM(pb + 3); }
    }
    {
            if (IN(8)) {
                REP(8) { PHASE_WS();
                pg8::Gemm g{(const bf16_t*)(ws + WS_XB), (const bf16_t*)(ws + WS_BT_B), T, 2560, D}; pg8::StaticOrder S; S.init(T, 2560, C.G, C.bid);
                EpiProjB E{(bf16_t*)(ws + WS_K), (bf16_t*)(ws + WS_V), (bf16_t*)(ws + WS_Q), (bf16_t*)(ws + WS_QM1)};
                pg8::gemm_phase<EpiProjB, pg8::StaticOrder>(C.lds, g, S, E, nullptr, C.tid); }
                SEAMF(8);
            }
            if (IN(9)) {
                REP(9) { PHASE_WS();
                TREG(3, dilattn_mfma(C));
                TREG(4, memattn_mfma(C, (const bf16_t*)(ws + WS_QM1), (const bf16_t*)(ws + WS_MKV), 512, 768, (bf16_t*)(ws + WS_CAT2), 512, 256)); }
                SEAM(9);
            }
            if (IN(10)) { REP(10) { PHASE_WS(); TREG(5, dil_merge(C, args)); } SEAM(10); }
            if (IN(11)) {
                REP(11) { PHASE_WS();
                pg8::Gemm g{(const bf16_t*)(ws + WS_CAT2), (const bf16_t*)(ws + WS_BT_OUTB), T, D, 512}; pg8::StaticOrder S; S.init(T, D, C.G, C.bid);
                EpiResid<true> E{(const void*)(ws + WS_XB), (bf16_t*)(ws + WS_Y)};
                pg8::gemm_phase<EpiResid<true>, pg8::StaticOrder>(C.lds, g, S, E, nullptr, C.tid); }
                if (IN(11)) { PHASE_WS(); fill_tail(C, args, 11, true); }
                SEAM(11);
            }
    }
    { constexpr int layer = 1;
        const int pb = 4 + 8 * layer;
        if (IN(pb)) { if ((MK_DUP >> 4) & 1) { PHASE_WS(); ln_route(C, args, layer, 2 + layer); __syncthreads(); } PHASE_WS(); TREG(6 + layer, ln_route(C, args, layer, layer)); SEAM(pb); }
        if (IN(pb + 1)) {
            REP(5) { PHASE_WS();
            moe_prefix(C, layer); moe_tokens(C, 8);
            MoeGatherOrder S; S.tb = (const LAS int*)(C.lds + LDS_MISC); S.ntn = 8; S.G = C.G; S.c = C.bid; S.toks = (const LAS int*)(C.lds + LDS_TOKS);
            {
                pg8::Gemm g{(const bf16_t*)(ws + WS_X1F8), (const bf16_t*)(ws + WS_WGU + (size_t)layer * (64 * MiB)), 0, 0, D / 2, E8_ONE, E8_W};
                EpiSwiGLU8 E{ws + WS_ACT};
#if MK_DUPNULL
                if (rep_ > 0) { EpiNull EN; pg8::gemm_phase<EpiNull, MoeGatherOrder, false, true>(C.lds, g, S, EN, nullptr, C.tid); } else
#endif
                pg8::gemm_phase<EpiSwiGLU8, MoeGatherOrder, false, true>(C.lds, g, S, E, nullptr, C.tid);
            } }
            SEAM(pb + 1);
        }
        if (IN(pb + 2)) {
            REP(6) { PHASE_WS();
            moe_prefix(C, layer);
            MoeOrder S{(const LAS int*)(C.lds + LDS_MISC), 4, C.G, C.bid};
            EpiPlain E{(bf16_t*)(ws + WS_YD), 1024, 4};
            {
                pg8::Gemm g{(const bf16_t*)(ws + WS_ACT), (const bf16_t*)(ws + WS_WD + (size_t)layer * (32 * MiB)), 0, 0, D / 2, E8_ACT, E8_W};
                pg8::gemm_phase<EpiPlain, MoeOrder, false, true>(C.lds, g, S, E, nullptr, C.tid);
            } }
            SEAM(pb + 2);
        }
        if (IN(pb + 3)) { REP(7) { PHASE_WS(); moe_prefix(C, layer); TREG(8 + layer, combine_ln2(C, args, layer)); } if (layer == 0) SEAM(pb + 3); }
    }
#if MK_DIAG == 3
    xcd_barrier(bar);
    if (blockIdx.x == 0 && threadIdx.x == 0) { const unsigned got = __hip_atomic_fetch_add((unsigned*)(args.ws + WS_CTL) + 30000, 0u, __ATOMIC_RELAXED, __HIP_MEMORY_SCOPE_AGENT); const unsigned long long t0 = __builtin_amdgcn_s_memrealtime();
        const unsigned long long dur = (unsigned long long)got * 4ull;
        while (__builtin_amdgcn_s_memrealtime() - t0 < dur) __builtin_amdgcn_s_sleep(8); }
#endif
#if MK_DIAG == 11
    if (blockIdx.x == 0 && threadIdx.x == 0) { const unsigned long long t0 = __builtin_amdgcn_s_memrealtime(); const unsigned long long dur = (unsigned long long)misc[42] * 4ull;
        while (__builtin_amdgcn_s_memrealtime() - t0 < dur) __builtin_amdgcn_s_sleep(8); }
#endif
#if MK_DIAG == 10
    if (blockIdx.x == 0 && threadIdx.x == 0) { const unsigned long long t0 = __builtin_amdgcn_s_memrealtime(); const unsigned long long dur = (unsigned long long)diag_acc * 4ull;
        while (__builtin_amdgcn_s_memrealtime() - t0 < dur) __builtin_amdgcn_s_sleep(8); }
#endif
#if MK_DIAG == 9
    if (threadIdx.x == 0) __hip_atomic_fetch_add((unsigned*)(args.ws + WS_CTL) + 30000, diag_acc, __ATOMIC_RELAXED, __HIP_MEMORY_SCOPE_AGENT);
    xcd_barrier(bar);
    if (blockIdx.x == 0 && threadIdx.x == 0) { const unsigned got = __hip_atomic_fetch_add((unsigned*)(args.ws + WS_CTL) + 30000, 0u, __ATOMIC_RELAXED, __HIP_MEMORY_SCOPE_AGENT); const unsigned long long t0 = __builtin_amdgcn_s_memrealtime();
        const unsigned long long dur = (unsigned long long)got / 256ull;
        while (__builtin_amdgcn_s_memrealtime() - t0 < dur) __builtin_amdgcn_s_sleep(8); }
#endif
#undef IN
#undef SEAM
}
}

extern "C" void kernel_launch(void* const* d_in, const int* in_sizes, int n_in, void* d_out, int out_size, void* d_ws, size_t ws_size, hipStream_t stream) {
    using namespace mk;
    static int grid = 0;
    if (grid == 0) {
        if (n_in != 23 || out_size != T * D || ws_size < WS_END) { fprintf(stderr, "kernel_launch: unexpected shapes (n_in %d, out %d, ws %zu)\n", n_in, out_size, ws_size); grid = -1; return; }
        int dev = 0, cus = 0, per_cu = 0;
        if (hipGetDevice(&dev) != hipSuccess || hipDeviceGetAttribute(&cus, hipDeviceAttributeMultiprocessorCount, dev) != hipSuccess) { grid = -1; return; }
        if (hipFuncSetAttribute((const void*)yoco_fwd, hipFuncAttributeMaxDynamicSharedMemorySize, LDS_BYTES) != hipSuccess) { fprintf(stderr, "kernel_launch: hipFuncSetAttribute failed\n"); grid = -1; return; }
        if (hipOccupancyMaxActiveBlocksPerMultiprocessor(&per_cu, (const void*)yoco_fwd, NTHREADS, LDS_BYTES) != hipSuccess || per_cu < 1)
            fprintf(stderr, "kernel_launch: occupancy query reports %d workgroups per CU\n", per_cu);
        (void)hipGetLastError();
        grid = cus;
    }
    if (grid < 0) return;
    (void)hipMemsetAsync((char*)d_ws + WS_CTL, 0, CTL_ZERO_BYTES, stream);
    Args a{};
    for (int i = 0; i < 23; ++i) a.in[i] = (const float*)d_in[i];
    a.out = (float*)d_out; a.ws = (unsigned char*)d_ws;
    constexpr int NL = MK_N_LAUNCHES;
    for (int li = 0; li < NL; ++li) {
        a.ph_lo = (NL == NPHASE) ? li : (li * NPHASE) / NL; a.ph_hi = (NL == NPHASE) ? li + 1 : ((li + 1) * NPHASE) / NL;
        hipLaunchKernelGGL(yoco_fwd, dim3(grid), dim3(NTHREADS), LDS_BYTES, stream, a);
    }
}
```

```cpp
#include <hip/hip_runtime.h>
#include <cstdio>
#include <cstdint>
namespace pg8 {
#define PG8_LAS __attribute__((address_space(3)))
typedef unsigned short bf16_t;
typedef short bf16x8 __attribute__((ext_vector_type(8)));
typedef float f32x4 __attribute__((ext_vector_type(4)));
typedef unsigned u32x4 __attribute__((ext_vector_type(4)));
constexpr int BM = 256, BK = 64, HALF = 128, HTB = HALF * BK * 2  , STAGE_BYTES = 8 * HTB, NXCD = 8, WGM = 8;

__host__ __device__ __forceinline__ int lds_byte(int r, int c) { const int st = (r >> 4) * 2 + (c >> 5), rr = r & 15, cc = c & 31, ob = rr * 64 + cc * 2; return st * 1024 + (ob ^ (((ob >> 9) & 1) << 5)); }
__host__ __device__ __forceinline__ void stage_rc(int b, int& R, int& C) { const int st = b / 1024, sb = b % 1024, swz = sb ^ (((sb >> 9) & 1) << 5); R = (st >> 1) * 16 + swz / 64; C = (st & 1) * 32 + (swz % 64) / 2; }
__host__ __device__ __forceinline__ int perm32(int rho) { const int n = rho >> 4, i = rho & 15; return 8 * (i >> 2) + 4 * n + (i & 3); }

struct Unit { int pm, pn; };
struct Gemm { const bf16_t* A; const bf16_t* Bt; int M, N, K; int sA, sB; };

struct StaticOrder {
    int nM, nN, nwg, G, c;
    __host__ __device__ void init(int M, int N, int G_, int c_) { nM = M / BM; nN = N / BM; nwg = nM * nN; G = G_; c = c_; }
    __host__ __device__ bool next(int i, Unit& u) const {
        const long L = (long)i * G + c; if (L >= nwg) return false;
        int wgid = (int)L; { const int q = nwg / NXCD, r = nwg % NXCD, xcd = wgid % NXCD, off = wgid / NXCD; wgid = (xcd < r ? xcd * (q + 1) : r * (q + 1) + (xcd - r) * q) + off; }
        const int nig = WGM * nN, gid = wgid / nig, fm = gid * WGM, gsz = (nM - fm) < WGM ? (nM - fm) : WGM;
        u.pm = fm + ((wgid % nig) % gsz); u.pn = (wgid % nig) / gsz; return true;
    }
    __device__ __forceinline__ void a_ready(const Unit&) const {}
    __device__ __forceinline__ void done(const Unit&) const {}
    __device__ __forceinline__ int arow(int, const Unit& u, int r) const { return u.pm * BM + r; }
};
__device__ __forceinline__ unsigned cvt_pk_bf16(float lo, float hi) { unsigned r; asm volatile("v_cvt_pk_bf16_f32 %0, %1, %2" : "=v"(r) : "v"(lo), "v"(hi)); return r; }
typedef float f32x2 __attribute__((ext_vector_type(2)));
__device__ __forceinline__ f32x2 gelu_pk(f32x2 v) {
    const f32x2 av = __builtin_elementwise_abs(v), d = av * 0.2316418882f + 1.0f;
    f32x2 t; t.x = __builtin_amdgcn_rcpf(d.x); t.y = __builtin_amdgcn_rcpf(d.y);
    f32x2 q = t * 0.5307027145f + (-0.7265760135f); q = q * t + 0.7107068705f; q = q * t + (-0.142248368f); q = q * t + 0.127414796f; q = q * t;
    const f32x2 s = (v * v) * (-0.72134752044f);
    f32x2 e; e.x = __builtin_amdgcn_exp2f(s.x); e.y = __builtin_amdgcn_exp2f(s.y);
    const f32x2 m = v * (q * e), r = v - m;
    f32x2 o; o.x = v.x < 0.f ? m.x : r.x; o.y = v.y < 0.f ? m.y : r.y; return o;
}
template <class Epi, class Sched, bool STAMP = false, bool F8 = false>
__device__ __forceinline__ void gemm_phase(PG8_LAS unsigned char* lds, const Gemm g, const Sched& S, const Epi& E, unsigned long long* stamps, const int tid) {
    const int wid = __builtin_amdgcn_readfirstlane(tid >> 6), lane = tid & 63, wr = wid >> 2, wc = wid & 3, fr = lane & 15, fq = lane >> 4;
    const int K = g.K, nt = K / BK;
    int ts_lo = 0, ts_hi = 0, nts = 0; const unsigned long long rt_entry = STAMP ? (unsigned long long)wall_clock64() : 0ull;
#define PG8_STAMP() do { if (STAMP && wid == 0 && nts < 64) { const unsigned long long _c = (unsigned long long)clock64(); \
        ts_lo = (lane == nts) ? (int)(unsigned)_c : ts_lo; ts_hi = (lane == nts) ? (int)(unsigned)(_c >> 32) : ts_hi; ++nts; } } while (0)
    PG8_STAMP();
    unsigned colA[2], voffB[2]; int rowA[2];
#pragma unroll
    for (int i = 0; i < 2; ++i) { int R, C; stage_rc(tid * 16 + i * 8192, R, C); const int Rb = Epi::PERM ? ((R & ~31) + perm32(R & 31)) : R;
        rowA[i] = R; colA[i] = (unsigned)C * 2u; voffB[i] = (unsigned)(Rb * K + C) * 2u; }
#define PG8_AOFF(dst, uidx, un) do { _Pragma("unroll") for (int _h = 0; _h < 2; ++_h) _Pragma("unroll") for (int _i = 0; _i < 2; ++_i) \
        dst[_h][_i] = (unsigned)S.arow((uidx), (un), _h * HALF + rowA[_i]) * (unsigned)(K * 2) + colA[_i]; } while (0)
    const size_t kstep = (size_t)(BK * 2);
    const size_t hstep = (size_t)HALF * K * 2;
    const size_t tstep = 2 * hstep;
    const unsigned ldsw = (unsigned)wid * 1024u;
    const int aoff = lds_byte(wr * 64 + fr, fq * 8), boff = lds_byte(wc * 32 + fr, fq * 8);
    constexpr int KOFF = 1024;
#define PG8_SA(b, h) (((b) * 2 + (h)) * HTB)
#define PG8_SB(b, h) ((4 + (b) * 2 + (h)) * HTB)
#define PG8_STAGE(bufoff, gbase, voff) do { _Pragma("unroll") for (int _i = 0; _i < 2; ++_i) \
        __builtin_amdgcn_global_load_lds((const unsigned*)((const char*)(gbase) + (voff)[_i]), (PG8_LAS unsigned*)(lds + (bufoff) + ldsw + _i * 8192), 16, 0, 0); } while (0)
#define PG8_LDA(dst, b, h) do { _Pragma("unroll") for (int m = 0; m < 4; ++m) _Pragma("unroll") for (int k = 0; k < 2; ++k) dst[m][k] = *(const PG8_LAS bf16x8*)(lds + PG8_SA(b, h) + aoff + m * 2048 + k * KOFF); } while (0)
#define PG8_LDB(dst, b, h) do { _Pragma("unroll") for (int n = 0; n < 2; ++n) _Pragma("unroll") for (int k = 0; k < 2; ++k) dst[n][k] = *(const PG8_LAS bf16x8*)(lds + PG8_SB(b, h) + boff + n * 2048 + k * KOFF); } while (0)
#define PG8_MMA(ai, bj, At, Bt) do { __builtin_amdgcn_s_setprio(1); \
        if constexpr (F8) { _Pragma("unroll") for (int m = 0; m < 4; ++m) _Pragma("unroll") for (int n = 0; n < 2; ++n) { \
            typedef int i32x4_ __attribute__((ext_vector_type(4))); typedef int i32x8_ __attribute__((ext_vector_type(8))); \
            const i32x8_ b8_ = __builtin_shufflevector(__builtin_bit_cast(i32x4_, Bt[n][0]), __builtin_bit_cast(i32x4_, Bt[n][1]), 0, 1, 2, 3, 4, 5, 6, 7); \
            const i32x8_ a8_ = __builtin_shufflevector(__builtin_bit_cast(i32x4_, At[m][0]), __builtin_bit_cast(i32x4_, At[m][1]), 0, 1, 2, 3, 4, 5, 6, 7); \
            acc[ai][bj][m][n] = __builtin_amdgcn_mfma_scale_f32_16x16x128_f8f6f4(b8_, a8_, acc[ai][bj][m][n], 0, 0, 0, g.sB, 0, g.sA); } } \
        else { _Pragma("unroll") for (int m = 0; m < 4; ++m) _Pragma("unroll") for (int n = 0; n < 2; ++n) _Pragma("unroll") for (int k = 0; k < 2; ++k) \
            acc[ai][bj][m][n] = __builtin_amdgcn_mfma_f32_16x16x32_bf16(Bt[n][k], At[m][k], acc[ai][bj][m][n], 0, 0, 0); } \
        __builtin_amdgcn_s_setprio(0); } while (0)
#define PG8_WAIT_V(n) asm volatile("s_waitcnt vmcnt(" #n ")" ::: "memory")
#define PG8_WAIT_L(n) asm volatile("s_waitcnt lgkmcnt(" #n ")" ::: "memory")
#define PG8_BAR __builtin_amdgcn_s_barrier()
#define PG8_SCHED __builtin_amdgcn_sched_barrier(0)
    Unit cur, nxt; int ui = 0;
    if (!S.next(0, cur)) return;
    f32x4 acc[2][2][4][2];
#pragma unroll
    for (int a = 0; a < 2; ++a)
#pragma unroll
        for (int b = 0; b < 2; ++b)
#pragma unroll
            for (int m = 0; m < 4; ++m)
#pragma unroll
                for (int n = 0; n < 2; ++n) acc[a][b][m][n] = (f32x4){0.f, 0.f, 0.f, 0.f};
    bf16x8 At[4][2], B0[2][2], B1[2][2];
    const char* Ab = (const char*)g.A; const char* cB = (const char*)g.Bt + (size_t)cur.pn * tstep;
    unsigned cuA[2][2];
    S.a_ready(cur);
    PG8_AOFF(cuA, 0, cur);
    PG8_STAGE(PG8_SB(0, 0), cB, voffB); PG8_STAGE(PG8_SA(0, 0), Ab, cuA[0]); PG8_STAGE(PG8_SB(0, 1), cB + hstep, voffB); PG8_STAGE(PG8_SA(0, 1), Ab, cuA[1]);
    if (wr == 1) PG8_BAR;
    PG8_WAIT_V(4); PG8_BAR;
    PG8_STAGE(PG8_SB(1, 0), cB + kstep, voffB); PG8_STAGE(PG8_SA(1, 0), Ab + kstep, cuA[0]); PG8_STAGE(PG8_SB(1, 1), cB + hstep + kstep, voffB);
    PG8_WAIT_V(6); PG8_BAR;
    PG8_STAMP();
    for (;;) {
        const bool has_next = S.next(ui + 1, nxt);
        const char* nB = has_next ? (const char*)g.Bt + (size_t)nxt.pn * tstep : cB;
        for (int t = 0; t < nt; t += 2) {
            const bool last = (t == nt - 2);
            const char* a1 = Ab + (size_t)(t + 1) * kstep;
            const char* a2 = last ? Ab : Ab + (size_t)(t + 2) * kstep; const char* b2 = last ? nB : cB + (size_t)(t + 2) * kstep;
            const char* a3 = a2 + kstep; const char* b3 = b2 + kstep;

            if (last && has_next) S.a_ready(nxt);
            PG8_LDB(B0, 0, 0); PG8_SCHED; PG8_LDA(At, 0, 0); PG8_STAGE(PG8_SA(1, 1), a1, cuA[1]);
            PG8_WAIT_L(8); PG8_BAR; PG8_WAIT_L(0); PG8_MMA(0, 0, At, B0); PG8_BAR; PG8_SCHED;
            if (last && has_next) PG8_AOFF(cuA, ui + 1, nxt);
            PG8_LDB(B1, 0, 1); PG8_STAGE(PG8_SB(0, 0), b2, voffB);
            PG8_BAR; PG8_WAIT_L(0); PG8_MMA(0, 1, At, B1); PG8_BAR;
            PG8_LDA(At, 0, 1); PG8_STAGE(PG8_SA(0, 0), a2, cuA[0]);
            PG8_BAR; PG8_WAIT_L(0); PG8_MMA(1, 0, At, B0); PG8_BAR; PG8_SCHED;
            PG8_STAGE(PG8_SB(0, 1), b2 + hstep, voffB);
            PG8_WAIT_V(6); PG8_BAR; PG8_MMA(1, 1, At, B1); PG8_BAR;
            PG8_LDB(B0, 1, 0); PG8_SCHED; PG8_LDA(At, 1, 0); PG8_STAGE(PG8_SA(0, 1), a2, cuA[1]);
            PG8_WAIT_L(8); PG8_BAR; PG8_WAIT_L(0); PG8_MMA(0, 0, At, B0); PG8_BAR; PG8_SCHED;
            PG8_LDB(B1, 1, 1); PG8_STAGE(PG8_SB(1, 0), b3, voffB);
            PG8_BAR; PG8_WAIT_L(0); PG8_MMA(0, 1, At, B1); PG8_BAR;
            PG8_LDA(At, 1, 1); PG8_STAGE(PG8_SA(1, 0), a3, cuA[0]);
            PG8_BAR; PG8_WAIT_L(0); PG8_MMA(1, 0, At, B0); PG8_BAR; PG8_SCHED;
            PG8_STAGE(PG8_SB(1, 1), b3 + hstep, voffB);
            PG8_WAIT_V(6); PG8_BAR; PG8_MMA(1, 1, At, B1); PG8_BAR;
        }
        PG8_STAMP();
        if constexpr (!Epi::AFTER_DRAIN) { E(acc, cur, wr, wc, fr, fq); S.done(cur); }
        PG8_STAMP();
        if (!has_next) break;
#pragma unroll
        for (int a = 0; a < 2; ++a)
#pragma unroll
            for (int b = 0; b < 2; ++b)
#pragma unroll
                for (int m = 0; m < 4; ++m)
#pragma unroll
                    for (int n = 0; n < 2; ++n) acc[a][b][m][n] = (f32x4){0.f, 0.f, 0.f, 0.f};
        cur = nxt; cB = nB; ++ui;
    }
    PG8_WAIT_V(0);
    if (wr == 0) PG8_BAR;
    PG8_BAR;
    if constexpr (Epi::AFTER_DRAIN) { E.fused(acc, cur, wr, wc, fr, fq, lds, wid, lane); S.done(cur); }
    PG8_STAMP();
    if (STAMP && wid == 0) { stamps[lane] = lane < nts ? (((unsigned long long)(unsigned)ts_hi << 32) | (unsigned)ts_lo) : 0ull;
        if (lane == 62) stamps[62] = rt_entry; if (lane == 63) stamps[63] = (unsigned long long)wall_clock64(); }
#undef PG8_STAMP
#undef PG8_SA
#undef PG8_SB
#undef PG8_STAGE
#undef PG8_AOFF
#undef PG8_LDA
#undef PG8_LDB
#undef PG8_MMA
#undef PG8_WAIT_V
#undef PG8_WAIT_L
#undef PG8_BAR
#undef PG8_SCHED
}
}

namespace mk {
using pg8::bf16_t; using pg8::f32x4; using pg8::u32x4; using pg8::Unit; using pg8::cvt_pk_bf16;
#define LAS __attribute__((address_space(3)))
typedef float f32x2 __attribute__((ext_vector_type(2)));
typedef unsigned u32x2 __attribute__((ext_vector_type(2)));

#ifndef MK_DIAG
#define MK_DIAG 0
#endif
#ifndef MK_DUPNULL
#define MK_DUPNULL 0
#endif
#ifndef MK_DIAGSEL
#define MK_DIAGSEL 0
#endif
#ifndef MK_DIAGMASK
#define MK_DIAGMASK 0xFFFF
#endif
#ifndef MK_N_LAUNCHES
#define MK_N_LAUNCHES 1
#endif
constexpr int NPHASE = 16;
constexpr int NB = 8, SEQ = 2048, D = 1024, T = NB * SEQ, NMEM = 256, SGW = 768, NSG = 12, HD = 64, CH = 128;
constexpr int NEXP = 16, LISTCAP = 16384;
constexpr float ALPHA = 1.41421356237f;
constexpr float LN_EPS = 1e-5f, ATT_SCALE = 0.125f;
constexpr int NWAVES = 8, NTHREADS = 512;

constexpr size_t MiB = 1u << 20;
constexpr size_t WS_CTL = 0, CTL_ZERO_BYTES = 128 * 1024;
constexpr size_t WS_TOKE = 1 * MiB, WS_TOKP = WS_TOKE + 128 * 1024, WS_TOKG = WS_TOKP + 128 * 1024;
constexpr size_t WS_LIST = 2 * MiB, WS_LSE = 3 * MiB, WS_SGWB = 4 * MiB, WS_SGRS = 4 * MiB + 512 * 1024, WS_WRT = 4 * MiB + 768 * 1024;
constexpr size_t WS_MKV = 8 * MiB, WS_MEMB = 12 * MiB;
constexpr size_t WS_BT_INA = 18 * MiB, WS_BT_OUTA = 22 * MiB, WS_BT_B = 24 * MiB, WS_BT_OUTB = 29 * MiB, WS_BT_MEM = 30 * MiB;
constexpr size_t WS_WGU = 32 * MiB, WS_WD = 160 * MiB;
constexpr size_t WS_A = 224 * MiB;
constexpr size_t WS_U = WS_A, WS_GV = WS_A + 24 * MiB, WS_QM0 = WS_A + 48 * MiB;
constexpr size_t WS_K = WS_A, WS_V = WS_A + 24 * MiB, WS_Q = WS_A + 48 * MiB, WS_QM1 = WS_A + 72 * MiB;
constexpr size_t WS_ACT = WS_A;
constexpr size_t WS_XB = 304 * MiB;
constexpr size_t WS_C = 336 * MiB;
constexpr size_t WS_CAT = WS_C, WS_OG = WS_C, WS_CAT2 = WS_C + 24 * MiB;
constexpr size_t WS_Y = 376 * MiB;
constexpr size_t WS_YD = 336 * MiB;
constexpr size_t WS_X1B = 440 * MiB;
constexpr size_t WS_X1F8 = 472 * MiB;
constexpr size_t WS_END = 488 * MiB;
constexpr size_t WS_WGU8 = WS_WGU + 64 * MiB, WS_WD8 = WS_WD + 32 * MiB;
constexpr int CW_TMO = 0, CW_BAR = 4096, CW_CNT = 16384, CW_CONV = 24576, CW_DONE = 24640, CW_CONV0 = 26000;
constexpr int LDS_TOKS = 131072 + 1024, MAX_UNITS = 8;
constexpr int LDS_MISC = 131072;
constexpr int LDS_BYTES = 147456;
static_assert(LDS_TOKS + MAX_UNITS * 1024 <= LDS_BYTES, "LDS map");

#define LDS_WAIT() asm volatile("s_waitcnt lgkmcnt(0)" ::: "memory")
#define VM_WAIT() asm volatile("s_waitcnt vmcnt(0)" ::: "memory")
__device__ __forceinline__ unsigned f2bf(float f) { unsigned u = __builtin_bit_cast(unsigned, f); return (u + 0x7fffu + ((u >> 16) & 1u)) >> 16; }
__device__ __forceinline__ unsigned pk2(float lo, float hi) { return f2bf(lo) | (f2bf(hi) << 16); }
__device__ __forceinline__ float sat8(float x) { return __builtin_amdgcn_fmed3f(x, -448.0f, 448.0f); }
__device__ __forceinline__ unsigned pk4_fp8_e(float a, float b, float c, float d) { int r = 0; r = __builtin_amdgcn_cvt_pk_fp8_f32(sat8(a), sat8(b), r, false); r = __builtin_amdgcn_cvt_pk_fp8_f32(sat8(c), sat8(d), r, true); return (unsigned)r; }
__device__ __forceinline__ float bflo(unsigned w) { return __uint_as_float(w << 16); }
__device__ __forceinline__ float bfhi(unsigned w) { return __uint_as_float(w & 0xffff0000u); }
__device__ __forceinline__ float bf1(bf16_t v) { return __uint_as_float(((unsigned)v) << 16); }
__device__ __forceinline__ float wave_sum(float v) {
#pragma unroll
    for (int o = 1; o < 64; o <<= 1) v += __shfl_xor(v, o);
    return v;
}
template <int CTRL> __device__ __forceinline__ float dpp_f(float v) { return __builtin_bit_cast(float, __builtin_amdgcn_update_dpp(0, __builtin_bit_cast(int, v), CTRL, 0xf, 0xf, false)); }
__device__ __forceinline__ float row_sum(float v) { v += dpp_f<0xB1>(v); v += dpp_f<0x4E>(v); v += dpp_f<0x141>(v); v += dpp_f<0x140>(v); return v; }
__device__ __forceinline__ float wave_sum_dpp(float v) { v = row_sum(v); v += __shfl_xor(v, 16); v += __shfl_xor(v, 32); return v; }
__device__ __forceinline__ float wave_max(float v) {
#pragma unroll
    for (int o = 1; o < 64; o <<= 1) v = fmaxf(v, __shfl_xor(v, o));
    return v;
}

#define XB_TMO      128
#define XB_XCNT(j)  (256  + 64 * (j))
#define XB_XSUB(j)  (1280 + 64 * (j))
#define XB_XGEN(j)  (2304 + 64 * (j))
#define XB_TOP      3328
#define XB_TOPGEN   3392
#define XCD_BAR_WORDS 3456
#define XB_SPIN_CAP (1u << 18)
__device__ __forceinline__ unsigned xb_ld(unsigned* p)              { return __hip_atomic_load(p, __ATOMIC_RELAXED, __HIP_MEMORY_SCOPE_AGENT); }
__device__ __forceinline__ unsigned xb_add(unsigned* p, unsigned v) { return __hip_atomic_fetch_add(p, v, __ATOMIC_RELAXED, __HIP_MEMORY_SCOPE_AGENT); }
__device__ __forceinline__ unsigned xb_xcc_id() { return (unsigned)__builtin_amdgcn_s_getreg((3 << 11) | 20) & 0xFu; }
#define XB_SPIN(cond, bar) do { unsigned _sp = 0; while (cond) { __builtin_amdgcn_s_sleep(1); \
    if ((++_sp & 255u) == 0u) { if (xb_ld(&(bar)[XB_TMO])) break; if (_sp > XB_SPIN_CAP) { atomicAdd(&(bar)[XB_TMO], 1u); break; } } } } while (0)
struct XcdBarrier { unsigned* bar; unsigned x; volatile LAS unsigned* st; };
__device__ __forceinline__ XcdBarrier xcd_barrier_post(unsigned* bar, volatile LAS unsigned* st) {
    XcdBarrier b; b.bar = bar; b.x = xb_xcc_id(); b.st = st;
    if (threadIdx.x == 0) (void)xb_add(&bar[XB_XCNT(b.x)], 1u);
    return b;
}
__device__ __forceinline__ void xcd_barrier_complete(unsigned* bar, unsigned x, unsigned& nloc, unsigned& nx) {
    const unsigned G = gridDim.x * gridDim.y * gridDim.z;
    unsigned sum, cnt, mine, sp = 0u;
    for (;;) {
        sum = 0u; cnt = 0u; mine = 0u;
#pragma unroll
        for (unsigned j = 0; j < 16; ++j) { const unsigned c = xb_ld(&bar[XB_XCNT(j)]); sum += c; cnt += (c > 0u) ? 1u : 0u; mine = (j == x) ? c : mine; }
        if (sum == G) break;
        __builtin_amdgcn_s_sleep(1);
        if ((++sp & 255u) == 0u) { if (xb_ld(&bar[XB_TMO])) break; if (sp > XB_SPIN_CAP) { atomicAdd(&bar[XB_TMO], 1u); break; } }
    }
    nloc = mine > 0u ? mine : 1u; nx = cnt > 0u ? cnt : 1u;
}
__device__ __forceinline__ void xcd_barrier(const XcdBarrier& b) {
    asm volatile("s_waitcnt vmcnt(0)" ::: "memory");
    __syncthreads();
    if (threadIdx.x == 0) {
        unsigned* bar = b.bar;
        __builtin_amdgcn_s_waitcnt(0);
        unsigned nloc = b.st[0], nx = b.st[1];
        if (nloc == 0u) { xcd_barrier_complete(bar, b.x, nloc, nx); b.st[0] = nloc; b.st[1] = nx; }
        const unsigned old = xb_add(&bar[XB_XSUB(b.x)], 1u);
        const unsigned gen = old / nloc;
        if (old + 1u == (gen + 1u) * nloc) {
            __builtin_amdgcn_fence(__ATOMIC_RELEASE, "agent");
            asm volatile("s_waitcnt vmcnt(0)" ::: "memory");
            const unsigned og = xb_add(&bar[XB_TOP], 1u);
            const unsigned tg = og / nx;
            if (og + 1u == (tg + 1u) * nx) xb_add(&bar[XB_TOPGEN], 1u);
            else XB_SPIN(xb_ld(&bar[XB_TOPGEN]) == tg, bar);
            __builtin_amdgcn_fence(__ATOMIC_ACQUIRE, "agent");
            xb_add(&bar[XB_XGEN(b.x)], 1u);
            asm volatile("s_waitcnt vmcnt(0)" ::: "memory");
        } else {
            XB_SPIN(xb_ld(&bar[XB_XGEN(b.x)]) == gen, bar);
            __builtin_amdgcn_fence(__ATOMIC_ACQUIRE, "agent");
            asm volatile("s_waitcnt vmcnt(0)" ::: "memory");
        }
    }
    __syncthreads();
}


struct EpiProjA {
    static constexpr bool PERM = true, AFTER_DRAIN = false;
    bf16_t *u, *gv, *qm;
    __device__ __forceinline__ void operator()(const f32x4 (&acc)[2][2][4][2], const Unit& un, int wr, int wc, int fr, int fq) const {
        const int row0 = un.pm * 256 + wr * 64 + fr;
        bf16_t* base; int ldc, colt; bool act; float sc = 1.f;
        if (un.pn < 3) { base = u; ldc = SGW; colt = un.pn * 256; act = true; }
        else if (un.pn < 6) { base = gv; ldc = SGW; colt = (un.pn - 3) * 256; act = true; }
        else { base = qm; ldc = 256; colt = 0; act = false; sc = ATT_SCALE; }
        const int col0 = colt + wc * 32 + 8 * fq;
#pragma unroll
        for (int ai = 0; ai < 2; ++ai)
#pragma unroll
            for (int m = 0; m < 4; ++m) { bf16_t* rowp = base + (size_t)(row0 + ai * 128 + m * 16) * ldc + col0;
#pragma unroll
                for (int bj = 0; bj < 2; ++bj) { f32x4 v0 = acc[ai][bj][m][0], v1 = acc[ai][bj][m][1];
                    if (act) { pg8::f32x2 a = pg8::gelu_pk((pg8::f32x2){v0[0], v0[1]}), b = pg8::gelu_pk((pg8::f32x2){v0[2], v0[3]}), c = pg8::gelu_pk((pg8::f32x2){v1[0], v1[1]}), d = pg8::gelu_pk((pg8::f32x2){v1[2], v1[3]});
                        v0 = (f32x4){a.x, a.y, b.x, b.y}; v1 = (f32x4){c.x, c.y, d.x, d.y}; }
                    v0 = v0 * sc; v1 = v1 * sc;
                    u32x4 w; w.x = cvt_pk_bf16(v0[0], v0[1]); w.y = cvt_pk_bf16(v0[2], v0[3]); w.z = cvt_pk_bf16(v1[0], v1[1]); w.w = cvt_pk_bf16(v1[2], v1[3]);
                    *(u32x4*)(rowp + bj * 128) = w; } }
    }
};
struct EpiProjB {
    static constexpr bool PERM = true, AFTER_DRAIN = false;
    bf16_t *k, *v, *q, *qm;
    __device__ __forceinline__ void operator()(const f32x4 (&acc)[2][2][4][2], const Unit& un, int wr, int wc, int fr, int fq) const {
        const int row0 = un.pm * 256 + wr * 64 + fr;
        bf16_t* base; int ldc, colt; float sc = 1.f;
        if (un.pn < 3) { base = k; ldc = SGW; colt = un.pn * 256; }
        else if (un.pn < 6) { base = v; ldc = SGW; colt = (un.pn - 3) * 256; }
        else if (un.pn < 9) { base = q; ldc = SGW; colt = (un.pn - 6) * 256; sc = ATT_SCALE; }
        else { base = qm; ldc = 256; colt = 0; sc = ATT_SCALE; }
        const int col0 = colt + wc * 32 + 8 * fq;
#pragma unroll
        for (int ai = 0; ai < 2; ++ai)
#pragma unroll
            for (int m = 0; m < 4; ++m) { bf16_t* rowp = base + (size_t)(row0 + ai * 128 + m * 16) * ldc + col0;
#pragma unroll
                for (int bj = 0; bj < 2; ++bj) { f32x4 v0 = acc[ai][bj][m][0] * sc, v1 = acc[ai][bj][m][1] * sc;
                    u32x4 w; w.x = cvt_pk_bf16(v0[0], v0[1]); w.y = cvt_pk_bf16(v0[2], v0[3]); w.z = cvt_pk_bf16(v1[0], v1[1]); w.w = cvt_pk_bf16(v1[2], v1[3]);
                    *(u32x4*)(rowp + bj * 128) = w; } }
    }
};
struct EpiPlain {
    static constexpr bool PERM = true, AFTER_DRAIN = false;
    bf16_t* O; int ldc, ntn;
    __device__ __forceinline__ void operator()(const f32x4 (&acc)[2][2][4][2], const Unit& un, int wr, int wc, int fr, int fq) const {
        const int row0 = un.pm * 256 + wr * 64 + fr;
        const int col0 = (un.pn % ntn) * 256 + wc * 32 + 8 * fq;
#pragma unroll
        for (int ai = 0; ai < 2; ++ai)
#pragma unroll
            for (int m = 0; m < 4; ++m) { bf16_t* rowp = O + (size_t)(row0 + ai * 128 + m * 16) * ldc + col0;
#pragma unroll
                for (int bj = 0; bj < 2; ++bj) { const f32x4 v0 = acc[ai][bj][m][0], v1 = acc[ai][bj][m][1];
                    u32x4 w; w.x = cvt_pk_bf16(v0[0], v0[1]); w.y = cvt_pk_bf16(v0[2], v0[3]); w.z = cvt_pk_bf16(v1[0], v1[1]); w.w = cvt_pk_bf16(v1[2], v1[3]);
                    *(u32x4*)(rowp + bj * 128) = w; } }
    }
};
struct EpiSwiGLU {
    static constexpr bool PERM = true, AFTER_DRAIN = false;
    bf16_t* O;
    __device__ __forceinline__ void operator()(const f32x4 (&acc)[2][2][4][2], const Unit& un, int wr, int wc, int fr, int fq) const {
        const int row0 = un.pm * 256 + wr * 64 + fr;
        const int col0 = (un.pn & 7) * 128 + wc * 32 + 8 * fq;
#pragma unroll
        for (int ai = 0; ai < 2; ++ai)
#pragma unroll
            for (int m = 0; m < 4; ++m) { bf16_t* rowp = O + (size_t)(row0 + ai * 128 + m * 16) * 1024 + col0;
                float r[8];
#pragma unroll
                for (int n = 0; n < 2; ++n)
#pragma unroll
                    for (int j = 0; j < 4; ++j) { const float g = acc[ai][0][m][n][j], up = acc[ai][1][m][n][j];
                        r[n * 4 + j] = g * __builtin_amdgcn_rcpf(1.0f + __expf(-g)) * up; }
                u32x4 w; w.x = cvt_pk_bf16(r[0], r[1]); w.y = cvt_pk_bf16(r[2], r[3]); w.z = cvt_pk_bf16(r[4], r[5]); w.w = cvt_pk_bf16(r[6], r[7]);
                *(u32x4*)rowp = w; }
    }
};
struct EpiSwiGLU8 {
    static constexpr bool PERM = true, AFTER_DRAIN = false;
    unsigned char* O;
    __device__ __forceinline__ void operator()(const f32x4 (&acc)[2][2][4][2], const Unit& un, int wr, int wc, int fr, int fq) const {
        const int row0 = un.pm * 256 + wr * 64 + fr;
        const int col0 = (un.pn & 7) * 128 + wc * 32 + 8 * fq;
#pragma unroll
        for (int ai = 0; ai < 2; ++ai)
#pragma unroll
            for (int m = 0; m < 4; ++m) { unsigned char* rowp = O + (size_t)(row0 + ai * 128 + m * 16) * 1024 + col0;
                float r[8];
#pragma unroll
                for (int n = 0; n < 2; ++n)
#pragma unroll
                    for (int j = 0; j < 4; ++j) { const float g = acc[ai][0][m][n][j], up = acc[ai][1][m][n][j];
                        r[n * 4 + j] = g * __builtin_amdgcn_rcpf(1.0f + __expf(-g)) * up * 8.0f; }
                *(u32x2*)rowp = (u32x2){pk4_fp8_e(r[0], r[1], r[2], r[3]), pk4_fp8_e(r[4], r[5], r[6], r[7])}; }
    }
};
template <bool RB> struct EpiResid {
    static constexpr bool PERM = false, AFTER_DRAIN = false;
    const void* res; bf16_t* Y;
    __device__ __forceinline__ void operator()(const f32x4 (&acc)[2][2][4][2], const Unit& un, int wr, int wc, int fr, int fq) const {
        const int row0 = un.pm * 256 + wr * 64 + fr, col0 = un.pn * 256 + wc * 32 + 4 * fq;
#pragma unroll
        for (int ai = 0; ai < 2; ++ai)
#pragma unroll
            for (int m = 0; m < 4; ++m) { const size_t off = (size_t)(row0 + ai * 128 + m * 16) * D + col0;
#pragma unroll
                for (int bj = 0; bj < 2; ++bj)
#pragma unroll
                    for (int n = 0; n < 2; ++n) { const size_t o = off + bj * 128 + n * 16; f32x4 r;
                        if (RB) { const u32x2 w = *(const u32x2*)((const bf16_t*)res + o); r = (f32x4){bflo(w.x), bfhi(w.x), bflo(w.y), bfhi(w.y)}; }
                        else r = *(const f32x4*)((const float*)res + o);
                        const f32x4 yv = r * ALPHA + acc[ai][bj][m][n]; *(u32x2*)(Y + o) = (u32x2){cvt_pk_bf16(yv[0], yv[1]), cvt_pk_bf16(yv[2], yv[3])}; } }
    }
};
struct EpiNull {
    static constexpr bool PERM = true, AFTER_DRAIN = false;
    __device__ __forceinline__ void operator()(const f32x4 (&acc)[2][2][4][2], const Unit&, int, int, int, int) const {
#pragma unroll
        for (int a = 0; a < 2; ++a)
#pragma unroll
            for (int b = 0; b < 2; ++b)
#pragma unroll
                for (int m = 0; m < 4; ++m)
#pragma unroll
                    for (int n = 0; n < 2; ++n) asm volatile("" :: "v"(acc[a][b][m][n]));
    }
};
struct SmallOrder {
    int nN, nwg, c;
    __device__ bool next(int i, Unit& u) const { if (i != 0 || c < 0 || c >= nwg) return false; u.pm = c / nN; u.pn = c % nN; return true; }
    __device__ __forceinline__ void a_ready(const Unit&) const {}
    __device__ __forceinline__ void done(const Unit&) const {}
    __device__ __forceinline__ int arow(int, const Unit& u, int r) const { return u.pm * 256 + r; }
};
struct MoeOrder {
    const LAS int* tb;
    int ntn, G, c;
    __device__ bool next(int i, Unit& u) const {
        const int L = i * G + (((G & 7) == 0) ? (c & 7) * (G >> 3) + (c >> 3) : c); if (L >= tb[16] * ntn) return false;
        int e = 0;
#pragma unroll
        for (int j = 1; j < 16; ++j) e += (L >= tb[j] * ntn) ? 1 : 0;
        const int r = L - tb[e] * ntn, te = tb[e + 1] - tb[e];
        (void)te; u.pm = tb[e] + r / ntn; u.pn = e * ntn + r % ntn; return true;
    }
    __device__ __forceinline__ void a_ready(const Unit&) const {}
    __device__ __forceinline__ void done(const Unit&) const {}
    __device__ __forceinline__ int arow(int, const Unit& u, int r) const { return u.pm * 256 + r; }
};
struct MoeGatherOrder : MoeOrder {
    const LAS int* toks;
    __device__ __forceinline__ int arow(int ui, const Unit&, int r) const { return toks[ui * 256 + r]; }
};

struct Args { const float* in[23]; float* out; unsigned char* ws; int ph_lo, ph_hi; };
struct Ctx {
    unsigned char* ws; LAS unsigned char* lds;
    int tid, lane, wave, gw, NGW, G, bid;
};
__device__ __forceinline__ unsigned char* launder(unsigned char* p) { asm volatile("" : "+s"(p)); return p; }
__device__ __forceinline__ int launder_v(int v) { asm volatile("" : "+v"(v)); return v; }

__device__ __forceinline__ void tr_item(const float* W, int K, int N, bf16_t* WT, int grp, int gstride, int roff, LAS float* scr, int item, int lane) {
    const int nblk = N / 32, kb = item / nblk, nb = item % nblk, k0 = 64 * kb, n0 = 32 * nb;
    float ld[32];
    { const float* wp = W + (size_t)(k0 + (lane >> 5)) * N + n0 + (lane & 31);
#pragma unroll
      for (int i = 0; i < 32; ++i) ld[i] = __builtin_nontemporal_load(wp + (size_t)(2 * i) * N); }
#pragma unroll
    for (int i = 0; i < 32; ++i) scr[(2 * i + (lane >> 5)) * 33 + (lane & 31)] = ld[i];
    LDS_WAIT(); asm volatile("" ::: "memory");
    const int c = lane & 7;
#pragma unroll
    for (int j = 0; j < 4; ++j) { const int n = (lane >> 3) + 8 * j; const LAS float* s = scr + (8 * c) * 33 + n;
        const int nn = n0 + n, drow = (nn / grp) * gstride + (nn % grp) + roff;
        u32x4 o; o.x = pk2(s[0 * 33], s[1 * 33]); o.y = pk2(s[2 * 33], s[3 * 33]); o.z = pk2(s[4 * 33], s[5 * 33]); o.w = pk2(s[6 * 33], s[7 * 33]);
        *(u32x4*)(WT + (size_t)drow * K + k0 + 8 * c) = o; }
    LDS_WAIT(); asm volatile("" ::: "memory");
}
__device__ __forceinline__ unsigned pk4_fp8(float a, float b, float c, float d) { return pk4_fp8_e(a, b, c, d); }
__device__ __forceinline__ void tr_item8(const float* W, int K, int N, unsigned char* WT, int grp, int gstride, int roff, float sc, LAS float* scr, int item, int lane) {
    const int nblk = N / 32, kb = item / nblk, nb = item % nblk, k0 = 64 * kb, n0 = 32 * nb;
    float ld[32];
    { const float* wp = W + (size_t)(k0 + (lane >> 5)) * N + n0 + (lane & 31);
#pragma unroll
      for (int i = 0; i < 32; ++i) ld[i] = __builtin_nontemporal_load(wp + (size_t)(2 * i) * N); }
#pragma unroll
    for (int i = 0; i < 32; ++i) scr[(2 * i + (lane >> 5)) * 33 + (lane & 31)] = ld[i];
    LDS_WAIT(); asm volatile("" ::: "memory");
    const int c = lane & 7;
#pragma unroll
    for (int j = 0; j < 4; ++j) { const int n = (lane >> 3) + 8 * j; const LAS float* s = scr + (8 * c) * 33 + n;
        const int nn = n0 + n, drow = (nn / grp) * gstride + (nn % grp) + roff;
        u32x2 o; o.x = pk4_fp8(s[0 * 33] * sc, s[1 * 33] * sc, s[2 * 33] * sc, s[3 * 33] * sc); o.y = pk4_fp8(s[4 * 33] * sc, s[5 * 33] * sc, s[6 * 33] * sc, s[7 * 33] * sc);
        *(u32x2*)(WT + (size_t)drow * K + k0 + 8 * c) = o; }
    LDS_WAIT(); asm volatile("" ::: "memory");
}
constexpr float W8_SCALE = 32.0f, ACT8_SCALE = 8.0f;
constexpr int E8_ONE = 0x7f7f7f7f, E8_W = 0x7a7a7a7a, E8_ACT = 0x7c7c7c7c;
__device__ __forceinline__ void moe_conv_item(const Args& A, unsigned char* ws, LAS float* scr, int lane, int layer, int r) {
    const int t = r >> 13, e = (r & 8191) >> 9, m = layer * 16 + e, item = r & 511;
    if (t == 0) tr_item8(A.in[20] + (size_t)m * 1048576, 1024, 1024, ws + WS_WGU + (size_t)layer * (64 * MiB) + (size_t)e * 2097152, 128, 256, 0, W8_SCALE, scr, item, lane);
    else if (t == 1) tr_item8(A.in[21] + (size_t)m * 1048576, 1024, 1024, ws + WS_WGU + (size_t)layer * (64 * MiB) + (size_t)e * 2097152, 128, 256, 128, W8_SCALE, scr, item, lane);
    else tr_item8(A.in[22] + (size_t)m * 1048576, 1024, 1024, ws + WS_WD + (size_t)layer * (32 * MiB) + (size_t)e * 1048576, 1024, 1024, 0, W8_SCALE, scr, item, lane);
}
constexpr int N_CONV1 = 3 * 8192;
__device__ __forceinline__ void fill_tail(const Ctx& C, const Args& A, int ph, bool fin) {
    unsigned* ctl = (unsigned*)(C.ws + WS_CTL);
    volatile LAS int* flag = (volatile LAS int*)(C.lds + LDS_MISC) + 40;
    LAS float* scr = (LAS float*)(C.lds + C.wave * 16384);
    asm volatile("s_waitcnt vmcnt(0)" ::: "memory");
    __syncthreads();
    if (C.tid == 0 && !fin) __hip_atomic_fetch_add(ctl + CW_DONE + 64 * ph, 1u, __ATOMIC_RELAXED, __HIP_MEMORY_SCOPE_AGENT);
    for (;;) {
        if (C.tid == 0) { int v = -1;
            const unsigned d = fin ? 0u : __hip_atomic_fetch_add(ctl + CW_DONE + 64 * ph, 0u, __ATOMIC_RELAXED, __HIP_MEMORY_SCOPE_AGENT);
            if (d + 32u < (unsigned)C.G) { v = (int)__hip_atomic_fetch_add(ctl + CW_CONV, 8u, __ATOMIC_RELAXED, __HIP_MEMORY_SCOPE_AGENT); if (v >= N_CONV1) v = -1; }
#if MK_DIAG == 3
            if (!fin && v >= 0) __hip_atomic_fetch_add(ctl + 30000, 8u, __ATOMIC_RELAXED, __HIP_MEMORY_SCOPE_AGENT);
#endif
            *flag = v; }
        __syncthreads();
        const int v = *flag;
        __syncthreads();
        if (v < 0) break;
        if (v + C.wave < N_CONV1) moe_conv_item(A, C.ws, scr, C.lane, 1, v + C.wave);
    }
}
__device__ __forceinline__ void p0_prologue(const Ctx& C, const Args& A) {
    LAS float* scr = (LAS float*)(C.lds + C.wave * 16384);
    unsigned char* ws = C.ws;
    constexpr int I_MOE = 16 * 32;
    constexpr int N_MOE = 32 * I_MOE;
    constexpr int I_INA = 16 * 56, I_SQ = 512, I_KV = 16 * 24, I_OUTB = 8 * 32, I_MEM = 16 * 8;
    constexpr int N_MOE0 = 3 * 8192;
    constexpr int NITEMS = I_INA + I_SQ + I_SQ + 2 * I_KV + I_OUTB + 4 * I_MEM;
    for (int it = C.gw; it < NITEMS; it += C.NGW) {
        int r = it;
        if (r < I_INA) { tr_item(A.in[2], 1024, 1792, (bf16_t*)(ws + WS_BT_INA), 1792, 1792, 0, scr, r, C.lane); continue; } r -= I_INA;
        if (r < I_SQ) { tr_item(A.in[3], 1024, 1024, (bf16_t*)(ws + WS_BT_OUTA), 1024, 1024, 0, scr, r, C.lane); continue; } r -= I_SQ;
        if (r < I_SQ) { tr_item(A.in[8], 1024, 1024, (bf16_t*)(ws + WS_BT_B), 1024, 1024, 1536, scr, r, C.lane); continue; } r -= I_SQ;
        if (r < I_KV) { tr_item(A.in[10], 1024, 768, (bf16_t*)(ws + WS_BT_B), 768, 768, 0, scr, r, C.lane); continue; } r -= I_KV;
        if (r < I_KV) { tr_item(A.in[11], 1024, 768, (bf16_t*)(ws + WS_BT_B), 768, 768, 768, scr, r, C.lane); continue; } r -= I_KV;
        if (r < I_OUTB) { tr_item(A.in[9], 512, 1024, (bf16_t*)(ws + WS_BT_OUTB), 1024, 1024, 0, scr, r, C.lane); continue; } r -= I_OUTB;
        { const int m = r / I_MEM, layer = m & 1, isv = m >> 1;
          tr_item(A.in[isv ? 13 : 12] + (size_t)layer * 262144, 1024, 256, (bf16_t*)(ws + WS_BT_MEM), 256, 256, layer * 512 + isv * 256, scr, r % I_MEM, C.lane); }
    }
    const int gt = C.bid * NTHREADS + C.tid, NT = C.G * NTHREADS;
    for (int i = gt; i < NSG * 128 * 128 / 8; i += NT) { const int q0 = (i & 15) * 8, p = (i >> 4) & 127;
        const f32x4 a = *(const f32x4*)(A.in[6] + (size_t)i * 8), b = *(const f32x4*)(A.in[6] + (size_t)i * 8 + 4); float v[8] = {a[0], a[1], a[2], a[3], b[0], b[1], b[2], b[3]};
#pragma unroll
        for (int j = 0; j < 8; ++j) v[j] = (q0 + j <= p) ? v[j] : 0.f;
        u32x4 w; w.x = pk2(v[0], v[1]); w.y = pk2(v[2], v[3]); w.z = pk2(v[4], v[5]); w.w = pk2(v[6], v[7]); *(u32x4*)((bf16_t*)(ws + WS_SGWB) + (size_t)i * 8) = w; }
    for (int i = gt; i < 16 * 1024; i += NT) { const int e = i >> 10, k = i & 1023; ((bf16_t*)(ws + WS_WRT))[i] = (bf16_t)f2bf(A.in[18][(size_t)k * 16 + e]); }
    for (int i = C.gw; i < NSG * 128; i += C.NGW) { const int p = i & 127;
        const float w0 = A.in[6][(size_t)i * 128 + C.lane], w1 = A.in[6][(size_t)i * 128 + 64 + C.lane];
        const float acc = wave_sum_dpp((C.lane <= p ? bflo(f2bf(w0)) : 0.f) + (64 + C.lane <= p ? bflo(f2bf(w1)) : 0.f));
        if (C.lane == 0) ((float*)(ws + WS_SGRS))[i] = acc; }
    for (int i0 = gt; i0 < T * D / 8; i0 += 4 * NT) {
        f32x4 a[4], b[4];
#pragma unroll
        for (int k = 0; k < 4; ++k) { const int i = i0 + k * NT; const size_t o = (size_t)(i < T * D / 8 ? i : gt) * 8; a[k] = __builtin_nontemporal_load((const f32x4*)(A.in[0] + o)); b[k] = __builtin_nontemporal_load((const f32x4*)(A.in[0] + o + 4)); }
#pragma unroll
        for (int k = 0; k < 4; ++k) { const int i = i0 + k * NT; if (i < T * D / 8) { u32x4 w; w.x = cvt_pk_bf16(a[k][0], a[k][1]); w.y = cvt_pk_bf16(a[k][2], a[k][3]); w.z = cvt_pk_bf16(b[k][0], b[k][1]); w.w = cvt_pk_bf16(b[k][2], b[k][3]);
            *(u32x4*)((bf16_t*)(ws + WS_XB) + (size_t)i * 8) = w; } } }
    for (int i = gt; i < NB * NMEM * D / 8; i += NT) { const f32x4 a = *(const f32x4*)(A.in[1] + (size_t)i * 8), b = *(const f32x4*)(A.in[1] + (size_t)i * 8 + 4);
        u32x4 w; w.x = pk2(a[0], a[1]); w.y = pk2(a[2], a[3]); w.z = pk2(b[0], b[1]); w.w = pk2(b[2], b[3]); *(u32x4*)((bf16_t*)(ws + WS_MEMB) + (size_t)i * 8) = w; }
    { unsigned* ctr = (unsigned*)(ws + WS_CTL) + CW_CONV0; volatile LAS int* flag = (volatile LAS int*)(C.lds + LDS_MISC) + 40;
      if (C.tid == 0) *flag = (int)__hip_atomic_fetch_add(ctr, 8u, __ATOMIC_RELAXED, __HIP_MEMORY_SCOPE_AGENT);
      __syncthreads();
      int cur = *flag;
      __syncthreads();
      while (cur < N_MOE0) {
          int nxt = 0;
          if (C.tid == 0) nxt = (int)__hip_atomic_fetch_add(ctr, 8u, __ATOMIC_RELAXED, __HIP_MEMORY_SCOPE_AGENT);
          if (cur + C.wave < N_MOE0) moe_conv_item(A, ws, scr, C.lane, 0, cur + C.wave);
          if (C.tid == 0) *flag = nxt;
          __syncthreads();
          cur = *flag;
          __syncthreads();
      } }
}

__device__ __forceinline__ void sg_scalar(const Ctx& C, const Args& A) {
    const bf16_t* U = (const bf16_t*)(C.ws + WS_U); const bf16_t* GV = (const bf16_t*)(C.ws + WS_GV); bf16_t* CAT = (bf16_t*)(C.ws + WS_CAT);
    const float* lng = A.in[4]; const float* lnb = A.in[5]; const float* sgw = A.in[6]; const float* sgb = A.in[7];
    LAS float* stat = (LAS float*)C.lds;
    LAS float* gvn = (LAS float*)(C.lds + 1024);
    LAS float* Wl = (LAS float*)(C.lds + 1024 + 128 * 65 * 4);
    for (int unit = C.bid; unit < NB * 16; unit += C.G) {
        const int tb = unit * 128;
        for (int rr = 0; rr < 16; ++rr) { const int row = C.wave * 16 + rr; const bf16_t* p = GV + (size_t)(tb + row) * SGW + 4 * C.lane;
            float s = 0.f, ss = 0.f;
#pragma unroll
            for (int j = 0; j < 3; ++j) { const u32x2 w = *(const u32x2*)(p + 256 * j); const float a = bflo(w.x), b = bfhi(w.x), c = bflo(w.y), d = bfhi(w.y);
                s += (a + b) + (c + d); ss += (a * a + b * b) + (c * c + d * d); }
            s = wave_sum(s); ss = wave_sum(ss);
            const float mean = s * (1.f / SGW), var = ss * (1.f / SGW) - mean * mean;
            if (C.lane == 0) { stat[row * 2] = mean; stat[row * 2 + 1] = 1.0f / sqrtf(var + LN_EPS); } }
        __syncthreads();
        const int p = C.tid >> 2, d0 = (C.tid & 3) * 16;
        for (int g = 0; g < NSG; ++g) {
            { const bf16_t* src = GV + (size_t)(tb + p) * SGW + g * 64 + d0; const float mean = stat[p * 2], rstd = stat[p * 2 + 1];
#pragma unroll
              for (int h = 0; h < 2; ++h) { const u32x4 w = *(const u32x4*)(src + 8 * h); const unsigned ww[4] = {w.x, w.y, w.z, w.w};
#pragma unroll
                  for (int j = 0; j < 4; ++j) { const int d = d0 + 8 * h + 2 * j; const int cc = g * 64 + d;
                      gvn[p * 65 + d] = (bflo(ww[j]) - mean) * rstd * lng[cc] + lnb[cc];
                      gvn[p * 65 + d + 1] = (bfhi(ww[j]) - mean) * rstd * lng[cc + 1] + lnb[cc + 1]; } } }
            { const int q0 = (C.tid & 3) * 32; const float* src = sgw + ((size_t)g * 128 + p) * 128 + q0;
#pragma unroll
              for (int j = 0; j < 8; ++j) { const f32x4 w = *(const f32x4*)(src + 4 * j);
#pragma unroll
                  for (int t = 0; t < 4; ++t) { const int q = q0 + 4 * j + t; Wl[p * 129 + q] = (q <= p) ? w[t] : 0.f; } } }
            __syncthreads();
            float acc[16];
#pragma unroll
            for (int j = 0; j < 16; ++j) acc[j] = 0.f;
            for (int q = 0; q <= p; ++q) { const float w = Wl[p * 129 + q];
#pragma unroll
                for (int j = 0; j < 16; ++j) acc[j] += w * gvn[q * 65 + d0 + j]; }
            const float bs = sgb[g * 128 + p];
            const bf16_t* us = U + (size_t)(tb + p) * SGW + g * 64 + d0; bf16_t* dst = CAT + (size_t)(tb + p) * D + g * 64 + d0;
#pragma unroll
            for (int h = 0; h < 2; ++h) { const u32x4 w = *(const u32x4*)(us + 8 * h); const unsigned ww[4] = {w.x, w.y, w.z, w.w}; unsigned o[4];
#pragma unroll
                for (int j = 0; j < 4; ++j) o[j] = pk2(bflo(ww[j]) * (acc[8 * h + 2 * j] + bs), bfhi(ww[j]) * (acc[8 * h + 2 * j + 1] + bs));
                *(u32x4*)(dst + 8 * h) = (u32x4){o[0], o[1], o[2], o[3]}; }
            __syncthreads();
        }
    }
}

__device__ __forceinline__ void memattn_scalar(const Ctx& C, const bf16_t* QM, const bf16_t* MKV, int ck, int cv, bf16_t* OUT, int ldo, int coff) {
    for (int it = C.gw; it < T * 4; it += C.NGW) {
        const int tok = it >> 2, h = it & 3, b = tok / SEQ;
        float q[64];
        { const bf16_t* qp = QM + (size_t)tok * 256 + h * 64;
#pragma unroll
          for (int j = 0; j < 8; ++j) { const u32x4 w = *(const u32x4*)(qp + 8 * j);
              q[8 * j] = bflo(w.x); q[8 * j + 1] = bfhi(w.x); q[8 * j + 2] = bflo(w.y); q[8 * j + 3] = bfhi(w.y); q[8 * j + 4] = bflo(w.z); q[8 * j + 5] = bfhi(w.z); q[8 * j + 6] = bflo(w.w); q[8 * j + 7] = bfhi(w.w); } }
        float s[4];
#pragma unroll
        for (int jj = 0; jj < 4; ++jj) { const bf16_t* kp = MKV + (size_t)(b * NMEM + jj * 64 + C.lane) * 1024 + ck + h * 64; float a = 0.f;
#pragma unroll
            for (int j = 0; j < 8; ++j) { const u32x4 w = *(const u32x4*)(kp + 8 * j);
                a += q[8 * j] * bflo(w.x) + q[8 * j + 1] * bfhi(w.x) + q[8 * j + 2] * bflo(w.y) + q[8 * j + 3] * bfhi(w.y) + q[8 * j + 4] * bflo(w.z) + q[8 * j + 5] * bfhi(w.z) + q[8 * j + 6] * bflo(w.w) + q[8 * j + 7] * bfhi(w.w); }
            s[jj] = a; }
        const float mx = wave_max(fmaxf(fmaxf(s[0], s[1]), fmaxf(s[2], s[3])));
        float l = 0.f;
#pragma unroll
        for (int jj = 0; jj < 4; ++jj) { s[jj] = __expf(s[jj] - mx); l += s[jj]; }
        l = wave_sum(l);
        float acc = 0.f;
#pragma unroll
        for (int jj = 0; jj < 4; ++jj) { const bf16_t* vp = MKV + (size_t)(b * NMEM + jj * 64) * 1024 + cv + h * 64 + C.lane;
            for (int mm = 0; mm < 64; ++mm) acc += __shfl(s[jj], mm) * bf1(vp[(size_t)mm * 1024]); }
        OUT[(size_t)tok * ldo + coff + h * 64 + C.lane] = (bf16_t)f2bf(acc / l);
    }
}

__device__ __forceinline__ void dilattn_scalar(const Ctx& C, const Args& A) {
    const bf16_t* Q = (const bf16_t*)(C.ws + WS_Q); const bf16_t* K = (const bf16_t*)(C.ws + WS_K); const bf16_t* V = (const bf16_t*)(C.ws + WS_V);
    bf16_t* OG = (bf16_t*)(C.ws + WS_OG); float* LSE = (float*)(C.ws + WS_LSE);
    for (int it = C.gw; it < T * 12; it += C.NGW) {
        const int tok = it / 12, h = it % 12, g = h >> 2, dl = (g == 0) ? 1 : (g == 1 ? 4 : 16);
        const int t = tok % SEQ, i = t / dl;
        const float slope = exp2f(-(float)(h + 1) * (8.0f / 12.0f));
        float q[64];
        { const bf16_t* qp = Q + (size_t)tok * SGW + h * 64;
#pragma unroll
          for (int j = 0; j < 8; ++j) { const u32x4 w = *(const u32x4*)(qp + 8 * j);
              q[8 * j] = bflo(w.x); q[8 * j + 1] = bfhi(w.x); q[8 * j + 2] = bflo(w.y); q[8 * j + 3] = bfhi(w.y); q[8 * j + 4] = bflo(w.z); q[8 * j + 5] = bfhi(w.z); q[8 * j + 6] = bflo(w.w); q[8 * j + 7] = bfhi(w.w); } }
        float s[3];
#pragma unroll
        for (int jj = 0; jj < 3; ++jj) { const int j0 = jj * 64 + C.lane; const bool valid = (jj < 2 || C.lane == 0) && (j0 <= i);
            const int jc = valid ? j0 : 0;
            const bf16_t* kp = K + (size_t)(tok - jc * dl) * SGW + h * 64; float a = 0.f;
#pragma unroll
            for (int j = 0; j < 8; ++j) { const u32x4 w = *(const u32x4*)(kp + 8 * j);
                a += q[8 * j] * bflo(w.x) + q[8 * j + 1] * bfhi(w.x) + q[8 * j + 2] * bflo(w.y) + q[8 * j + 3] * bfhi(w.y) + q[8 * j + 4] * bflo(w.z) + q[8 * j + 5] * bfhi(w.z) + q[8 * j + 6] * bflo(w.w) + q[8 * j + 7] * bfhi(w.w); }
            s[jj] = valid ? (a - slope * (float)(dl * j0)) : -INFINITY; }
        const float mx = wave_max(fmaxf(fmaxf(s[0], s[1]), s[2]));
        float l = 0.f;
#pragma unroll
        for (int jj = 0; jj < 3; ++jj) { s[jj] = __expf(s[jj] - mx); l += s[jj]; }
        l = wave_sum(l);
        float acc = 0.f;
#pragma unroll
        for (int jj = 0; jj < 3; ++jj) { const int nm = (jj < 2) ? 64 : 1;
            for (int mm = 0; mm < nm; ++mm) { const int j0 = jj * 64 + mm; const int jc = (j0 <= i) ? j0 : 0;
                acc += __shfl(s[jj], mm) * bf1(V[(size_t)(tok - jc * dl) * SGW + h * 64 + C.lane]); } }
        OG[(size_t)tok * SGW + h * 64 + C.lane] = (bf16_t)f2bf(acc / l);
        if (C.lane == 0) LSE[tok * 12 + h] = mx + __logf(l);
    }
}
typedef short bf16x8 __attribute__((ext_vector_type(8)));
typedef short s16x4 __attribute__((ext_vector_type(4)));
constexpr int AT_KS = 144, AT_VS = 160, AT_ROWS = 272, AT_K_OFF = 0, AT_V_OFF = AT_ROWS * AT_KS;
static_assert(AT_V_OFF % 16 == 0 && AT_V_OFF + AT_ROWS * AT_VS <= 131072, "attention LDS map");

template <int NKB, bool DIL>
__device__ __forceinline__ void attn_compute(LAS unsigned char* lds, int lane, int krow0, bf16x8 qf0, bf16x8 qf1, float sdl, int ikw, f32x4 (&o)[4], float& mx, float& lsum) {
    const int n = lane & 15, g = lane >> 4;
    const LAS unsigned char* Kb = lds + AT_K_OFF + (krow0 + n) * AT_KS + g * 16;
    f32x4 sc[NKB];
#pragma unroll
    for (int kb = 0; kb < NKB; ++kb) {
        const bf16x8 k0 = *(const LAS bf16x8*)(Kb + kb * 16 * AT_KS), k1 = *(const LAS bf16x8*)(Kb + kb * 16 * AT_KS + 64);
        f32x4 a = (f32x4){0.f, 0.f, 0.f, 0.f};
        a = __builtin_amdgcn_mfma_f32_16x16x32_bf16(k0, qf0, a, 0, 0, 0);
        a = __builtin_amdgcn_mfma_f32_16x16x32_bf16(k1, qf1, a, 0, 0, 0);
        sc[kb] = a;
    }
    float m = -INFINITY;
#pragma unroll
    for (int kb = 0; kb < NKB; ++kb)
#pragma unroll
        for (int r = 0; r < 4; ++r) {
            if (DIL) { const int off = 16 * kb + 4 * g + r, rel = 144 + n - off; const bool valid = (rel >= 0) && (rel <= 128) && (ikw + off >= 0);
                sc[kb][r] = valid ? (sc[kb][r] - sdl * (float)rel) : -INFINITY; }
            m = fmaxf(m, sc[kb][r]); }
    m = fmaxf(m, __shfl_xor(m, 16)); m = fmaxf(m, __shfl_xor(m, 32));
    float l = 0.f;
#pragma unroll
    for (int kb = 0; kb < NKB; ++kb)
#pragma unroll
        for (int r = 0; r < 4; ++r) { sc[kb][r] = __expf(sc[kb][r] - m); l += sc[kb][r]; }
    l += __shfl_xor(l, 16); l += __shfl_xor(l, 32);
    mx = m; lsum = l;
    const LAS unsigned char* Vb = lds + AT_V_OFF + (krow0 + 4 * g + (n >> 2)) * AT_VS + (n & 3) * 8;
#pragma unroll
    for (int db = 0; db < 4; ++db) o[db] = (f32x4){0.f, 0.f, 0.f, 0.f};
#pragma unroll
    for (int kk = 0; kk < NKB / 2; ++kk) {
        union { bf16x8 v; unsigned u[4]; } pf;
        pf.u[0] = cvt_pk_bf16(sc[2 * kk][0], sc[2 * kk][1]); pf.u[1] = cvt_pk_bf16(sc[2 * kk][2], sc[2 * kk][3]);
        pf.u[2] = cvt_pk_bf16(sc[2 * kk + 1][0], sc[2 * kk + 1][1]); pf.u[3] = cvt_pk_bf16(sc[2 * kk + 1][2], sc[2 * kk + 1][3]);
#pragma unroll
        for (int db = 0; db < 4; ++db) {
            const s16x4 v0 = __builtin_amdgcn_ds_read_tr16_b64_v4i16((LAS s16x4*)(Vb + (2 * kk) * 16 * AT_VS + db * 32));
            const s16x4 v1 = __builtin_amdgcn_ds_read_tr16_b64_v4i16((LAS s16x4*)(Vb + (2 * kk + 1) * 16 * AT_VS + db * 32));
            const bf16x8 vf = __builtin_shufflevector(v0, v1, 0, 1, 2, 3, 4, 5, 6, 7);
            o[db] = __builtin_amdgcn_mfma_f32_16x16x32_bf16(vf, pf.v, o[db], 0, 0, 0);
        }
    }
}

__device__ __forceinline__ void memattn_mfma(const Ctx& C, const bf16_t* QM, const bf16_t* MKV, int ck, int cv, bf16_t* OUT, int ldo, int coff) {
    const int n = C.lane & 15, g = C.lane >> 4;
    for (int unit = C.bid; unit < NB * 4 * 8; unit += C.G) {
        const int b = unit >> 5, h = (unit >> 3) & 3, qp = unit & 7;
        __syncthreads();
#pragma unroll
        for (int it = 0; it < 4; ++it) { const int row = it * 64 + (C.tid >> 3), c = C.tid & 7;
            const bf16_t* src = MKV + (size_t)(b * NMEM + row) * 1024 + h * 64 + c * 8;
            const u32x4 kv = *(const u32x4*)(src + ck), vv = *(const u32x4*)(src + cv);
            *(LAS u32x4*)(C.lds + AT_K_OFF + row * AT_KS + c * 16) = kv; *(LAS u32x4*)(C.lds + AT_V_OFF + row * AT_VS + c * 16) = vv; }
        bf16x8 qf[2][2];
#pragma unroll
        for (int t = 0; t < 2; ++t) { const bf16_t* qp_ = QM + (size_t)(b * SEQ + (qp * 2 + t) * 128 + C.wave * 16 + n) * 256 + h * 64 + g * 8; qf[t][0] = *(const bf16x8*)qp_; qf[t][1] = *(const bf16x8*)(qp_ + 32); }
        __syncthreads();
#pragma unroll
        for (int t = 0; t < 2; ++t) {
            const int tok = b * SEQ + (qp * 2 + t) * 128 + C.wave * 16 + n;
            f32x4 o[4]; float mx, l;
            attn_compute<16, false>(C.lds, C.lane, 0, qf[t][0], qf[t][1], 0.f, 0, o, mx, l);
            const float inv = 1.0f / l;
#pragma unroll
            for (int db = 0; db < 4; ++db)
                *(u32x2*)(OUT + (size_t)tok * ldo + coff + h * 64 + 16 * db + 4 * g) = (u32x2){cvt_pk_bf16(o[db][0] * inv, o[db][1] * inv), cvt_pk_bf16(o[db][2] * inv, o[db][3] * inv)};
        }
    }
}
__device__ __forceinline__ void dilattn_mfma(const Ctx& C) {
    const bf16_t* Q = (const bf16_t*)(C.ws + WS_Q); const bf16_t* K = (const bf16_t*)(C.ws + WS_K); const bf16_t* V = (const bf16_t*)(C.ws + WS_V);
    bf16_t* OG = (bf16_t*)(C.ws + WS_OG); float* LSE = (float*)(C.ws + WS_LSE);
    const int n = C.lane & 15, g = C.lane >> 4;
    for (int unit = C.bid; unit < 12 * 128; unit += C.G) {
        const int h = unit >> 7, rem = unit & 127, b = rem >> 4, x = rem & 15, grp = h >> 2;
        const int dl = (grp == 0) ? 1 : (grp == 1 ? 4 : 16), ntile = 16 / dl, r = x / ntile, I0 = (x % ntile) * 128;
        const float sdl = exp2f(-(float)(h + 1) * (8.0f / 12.0f)) * (float)dl;
        __syncthreads();
        { u32x4 kv[5], vv[5];
#pragma unroll
          for (int it = 0; it < 5; ++it) { const int idx = it * NTHREADS + C.tid, row = idx >> 3, c = idx & 7, ik = I0 - 144 + row;
              kv[it] = (u32x4){0u, 0u, 0u, 0u}; vv[it] = (u32x4){0u, 0u, 0u, 0u};
              if (idx < AT_ROWS * 8 && ik >= 0) { const size_t off = (size_t)(b * SEQ + ik * dl + r) * SGW + h * 64 + c * 8; kv[it] = *(const u32x4*)(K + off); vv[it] = *(const u32x4*)(V + off); } }
#pragma unroll
          for (int it = 0; it < 5; ++it) { const int idx = it * NTHREADS + C.tid, row = idx >> 3, c = idx & 7;
              if (idx < AT_ROWS * 8) { *(LAS u32x4*)(C.lds + AT_K_OFF + row * AT_KS + c * 16) = kv[it]; *(LAS u32x4*)(C.lds + AT_V_OFF + row * AT_VS + c * 16) = vv[it]; } } }
        const int iq = I0 + C.wave * 16 + n, tok = b * SEQ + iq * dl + r;
        const bf16_t* qp = Q + (size_t)tok * SGW + h * 64 + g * 8;
        const bf16x8 qf0 = *(const bf16x8*)qp, qf1 = *(const bf16x8*)(qp + 32);
        __syncthreads();
        f32x4 o[4]; float mx, l;
        attn_compute<10, true>(C.lds, C.lane, C.wave * 16, qf0, qf1, sdl, I0 + C.wave * 16 - 144, o, mx, l);
        const float inv = 1.0f / l;
#pragma unroll
        for (int db = 0; db < 4; ++db)
            *(u32x2*)(OG + (size_t)tok * SGW + h * 64 + 16 * db + 4 * g) = (u32x2){cvt_pk_bf16(o[db][0] * inv, o[db][1] * inv), cvt_pk_bf16(o[db][2] * inv, o[db][3] * inv)};
        if (g == 0) LSE[tok * 12 + h] = mx + __logf(l);
    }
}
constexpr int SG_GVN_OFF = 1024, SG_VS = 160, SG_TILE = 128 * SG_VS, SG_GB_OFF = SG_GVN_OFF + 6 * SG_TILE;
static_assert(SG_GB_OFF + 2 * 384 * 4 <= 131072, "spatial-gating LDS map");
__device__ __forceinline__ void sg_mfma(const Ctx& C, const Args& A) {
    const bf16_t* U = (const bf16_t*)(C.ws + WS_U); const bf16_t* GV = (const bf16_t*)(C.ws + WS_GV); bf16_t* CAT = (bf16_t*)(C.ws + WS_CAT);
    const bf16_t* WB = (const bf16_t*)(C.ws + WS_SGWB); const float* RS = (const float*)(C.ws + WS_SGRS);
    const float* lng = A.in[4]; const float* lnb = A.in[5]; const float* sgb = A.in[7];
    LAS float* stat = (LAS float*)C.lds; LAS float* gbl = (LAS float*)(C.lds + SG_GB_OFF);
    const int n = C.lane & 15, gl = C.lane >> 4;
    for (int unit = C.bid; unit < NB * 16 * 2; unit += C.G) {
        const int tb = (unit >> 1) * 128, g0 = (unit & 1) * 6;
        __syncthreads();
        u32x4 wt[12];
#pragma unroll
        for (int k = 0; k < 12; ++k) { const int rg = k * 64 + (C.tid >> 3), gi = rg >> 7, row = rg & 127, c = C.tid & 7;
            wt[k] = *(const u32x4*)(GV + (size_t)(tb + row) * SGW + (g0 + gi) * 64 + c * 8); }
        if (C.tid < 192) { const int half = C.tid / 96, i4 = C.tid % 96; *(LAS f32x4*)(gbl + half * 384 + 4 * i4) = *(const f32x4*)((half ? lnb : lng) + g0 * 64 + 4 * i4); }
        for (int r8 = 0; r8 < 16; r8 += 8) {
            u32x2 w[8][3];
#pragma unroll
            for (int q = 0; q < 8; ++q)
#pragma unroll
                for (int j = 0; j < 3; ++j) w[q][j] = *(const u32x2*)(GV + (size_t)(tb + C.wave * 16 + r8 + q) * SGW + 4 * C.lane + 256 * j);
#pragma unroll
            for (int q = 0; q < 8; ++q) { float s = 0.f, ss = 0.f;
#pragma unroll
                for (int j = 0; j < 3; ++j) { const float a = bflo(w[q][j].x), b = bfhi(w[q][j].x), c = bflo(w[q][j].y), d = bfhi(w[q][j].y);
                    s += (a + b) + (c + d); ss += (a * a + b * b) + (c * c + d * d); }
                s = wave_sum_dpp(s); ss = wave_sum_dpp(ss);
                const float mean = s * (1.f / SGW), var = ss * (1.f / SGW) - mean * mean; const int row = C.wave * 16 + r8 + q;
                if (C.lane == 0) { stat[row * 2] = mean; stat[row * 2 + 1] = 1.0f / sqrtf(var + LN_EPS); } } }
        __syncthreads();
#pragma unroll
        for (int k = 0; k < 12; ++k) { const int rg = k * 64 + (C.tid >> 3), gi = rg >> 7, row = rg & 127, c = C.tid & 7;
            const float mean = stat[row * 2], rstd = stat[row * 2 + 1]; u32x4 o;
            o.x = cvt_pk_bf16((bflo(wt[k].x) - mean) * rstd, (bfhi(wt[k].x) - mean) * rstd); o.y = cvt_pk_bf16((bflo(wt[k].y) - mean) * rstd, (bfhi(wt[k].y) - mean) * rstd);
            o.z = cvt_pk_bf16((bflo(wt[k].z) - mean) * rstd, (bfhi(wt[k].z) - mean) * rstd); o.w = cvt_pk_bf16((bflo(wt[k].w) - mean) * rstd, (bfhi(wt[k].w) - mean) * rstd);
            *(LAS u32x4*)(C.lds + SG_GVN_OFF + gi * SG_TILE + row * SG_VS + c * 16) = o; }
        __syncthreads();
        const int p = C.wave * 16 + n;
#pragma unroll 3
        for (int gi = 0; gi < 6; ++gi) {
            const int g = g0 + gi;
            const bf16_t* wp = WB + (size_t)(g * 128 + p) * 128 + 8 * gl;
            bf16x8 wf[4];
#pragma unroll
            for (int ks = 0; ks < 4; ++ks) wf[ks] = *(const bf16x8*)(wp + 32 * ks);
            u32x2 uw[4];
#pragma unroll
            for (int db = 0; db < 4; ++db) uw[db] = *(const u32x2*)(U + (size_t)(tb + p) * SGW + (size_t)g * 64 + 16 * db + 4 * gl);
            const float bs = sgb[g * 128 + p], rsw = RS[g * 128 + p];
            f32x4 acc[4];
#pragma unroll
            for (int db = 0; db < 4; ++db) acc[db] = (f32x4){0.f, 0.f, 0.f, 0.f};
            const LAS unsigned char* vb = C.lds + SG_GVN_OFF + gi * SG_TILE + (8 * gl + (n >> 2)) * SG_VS + (n & 3) * 8;
#pragma unroll
            for (int ks = 0; ks < 4; ++ks)
#pragma unroll
                for (int db = 0; db < 4; ++db) {
                    const s16x4 v0 = __builtin_amdgcn_ds_read_tr16_b64_v4i16((LAS s16x4*)(vb + ks * 32 * SG_VS + db * 32));
                    const s16x4 v1 = __builtin_amdgcn_ds_read_tr16_b64_v4i16((LAS s16x4*)(vb + ks * 32 * SG_VS + 4 * SG_VS + db * 32));
                    const bf16x8 vf = __builtin_shufflevector(v0, v1, 0, 1, 2, 3, 4, 5, 6, 7);
                    acc[db] = __builtin_amdgcn_mfma_f32_16x16x32_bf16(vf, wf[ks], acc[db], 0, 0, 0);
                }
#pragma unroll
            for (int db = 0; db < 4; ++db) { const int cl = gi * 64 + 16 * db + 4 * gl; const size_t co = (size_t)g * 64 + 16 * db + 4 * gl;
                const f32x4 ga = *(const LAS f32x4*)(gbl + cl), be = *(const LAS f32x4*)(gbl + 384 + cl);
                const float s0 = ga[0] * acc[db][0] + (be[0] * rsw + bs), s1 = ga[1] * acc[db][1] + (be[1] * rsw + bs);
                const float s2 = ga[2] * acc[db][2] + (be[2] * rsw + bs), s3 = ga[3] * acc[db][3] + (be[3] * rsw + bs);
                *(u32x2*)(CAT + (size_t)(tb + p) * D + co) = (u32x2){cvt_pk_bf16(bflo(uw[db].x) * s0, bfhi(uw[db].x) * s1), cvt_pk_bf16(bflo(uw[db].y) * s2, bfhi(uw[db].y) * s3)}; }
        }
    }
}
__device__ __forceinline__ void dil_merge(const Ctx& C, const Args& A) {
    const bf16_t* OG = (const bf16_t*)(C.ws + WS_OG); const float* LSE = (const float*)(C.ws + WS_LSE); bf16_t* CAT2 = (bf16_t*)(C.ws + WS_CAT2);
    const int gt = C.bid * NTHREADS + C.tid, NT = C.G * NTHREADS;
    for (int it = gt; it < T * 32; it += NT) {
        const int tok = it >> 5, j = (it >> 3) & 3, c8 = it & 7;
        const float l0 = LSE[tok * 12 + j], l1 = LSE[tok * 12 + 4 + j], l2 = LSE[tok * 12 + 8 + j];
        const float mx = fmaxf(l0, fmaxf(l1, l2));
        float w0 = __expf(l0 - mx), w1 = __expf(l1 - mx), w2 = __expf(l2 - mx); const float inv = 1.0f / (w0 + w1 + w2); w0 *= inv; w1 *= inv; w2 *= inv;
        const u32x4 a = *(const u32x4*)(OG + (size_t)tok * SGW + j * 64 + c8 * 8), b = *(const u32x4*)(OG + (size_t)tok * SGW + (4 + j) * 64 + c8 * 8), c = *(const u32x4*)(OG + (size_t)tok * SGW + (8 + j) * 64 + c8 * 8);
        u32x4 o;
        o.x = pk2(w0 * bflo(a.x) + w1 * bflo(b.x) + w2 * bflo(c.x), w0 * bfhi(a.x) + w1 * bfhi(b.x) + w2 * bfhi(c.x));
        o.y = pk2(w0 * bflo(a.y) + w1 * bflo(b.y) + w2 * bflo(c.y), w0 * bfhi(a.y) + w1 * bfhi(b.y) + w2 * bfhi(c.y));
        o.z = pk2(w0 * bflo(a.z) + w1 * bflo(b.z) + w2 * bflo(c.z), w0 * bfhi(a.z) + w1 * bfhi(b.z) + w2 * bfhi(c.z));
        o.w = pk2(w0 * bflo(a.w) + w1 * bflo(b.w) + w2 * bflo(c.w), w0 * bfhi(a.w) + w1 * bfhi(b.w) + w2 * bfhi(c.w));
        *(u32x4*)(CAT2 + (size_t)tok * 512 + j * 64 + c8 * 8) = o;
    }
}

constexpr int LR_WS = 2064;
__device__ __forceinline__ void ln_route(const Ctx& C, const Args& A, int layer, int cset) {
    const bf16_t* Y = (const bf16_t*)(C.ws + WS_Y); bf16_t* X1B = (bf16_t*)(C.ws + WS_X1B); unsigned char* X1F8 = C.ws + WS_X1F8;
    const float* lg = A.in[14] + layer * D; const float* lb = A.in[15] + layer * D; const float* br = A.in[19];
    unsigned* cnt = (unsigned*)(C.ws + WS_CTL) + CW_CNT + cset * 16 * 64;
    int* tokE = (int*)(C.ws + WS_TOKE); int* tokP = (int*)(C.ws + WS_TOKP); float* tokG = (float*)(C.ws + WS_TOKG); int* list = (int*)(C.ws + WS_LIST);
    LAS unsigned char* wl = C.lds;
    LAS int* sE = (LAS int*)(C.lds + 65536); LAS float* sG = (LAS float*)(C.lds + 65536 + 512); LAS int* sPos = (LAS int*)(C.lds + 65536 + 1024);
    LAS int* lcnt = (LAS int*)(C.lds + 65536 + 1536); LAS int* lbase = (LAS int*)(C.lds + 65536 + 1600); LAS float* slog = (LAS float*)(C.lds + 65536 + 2048);
    __syncthreads();
#pragma unroll
    for (int it = 0; it < 4; ++it) { const int i = it * NTHREADS + C.tid, e = i >> 7, c = i & 127;
        *(LAS u32x4*)(wl + e * LR_WS + c * 16) = *(const u32x4*)((const bf16_t*)(C.ws + WS_WRT) + (size_t)e * 1024 + c * 8); }
    f32x4 g4[4], b4[4];
#pragma unroll
    for (int j = 0; j < 4; ++j) { g4[j] = *(const f32x4*)(lg + 4 * C.lane + 256 * j); b4[j] = *(const f32x4*)(lb + 4 * C.lane + 256 * j); }
    const int n = C.lane & 15, q = C.lane >> 4;
    for (int blk = C.bid; blk < T / 64; blk += C.G) {
        __syncthreads();
        if (C.tid < 16) lcnt[C.tid] = 0;
        u32x2 nv[4];
        { const u32x2* yb = (const u32x2*)(Y + (size_t)(blk * 64 + C.wave * 8) * D) + C.lane;
#pragma unroll
          for (int j = 0; j < 4; ++j) nv[j] = yb[64 * j]; }
#pragma unroll 1
        for (int tq = 0; tq < 8; ++tq) {
            const int tok = blk * 64 + C.wave * 8 + tq;
            f32x4 v[4]; float s = 0.f;
#pragma unroll
            for (int j = 0; j < 4; ++j) { v[j] = (f32x4){bflo(nv[j].x), bfhi(nv[j].x), bflo(nv[j].y), bfhi(nv[j].y)}; s += (v[j][0] + v[j][1]) + (v[j][2] + v[j][3]); }
            { const u32x2* yb = (const u32x2*)(Y + (size_t)(tok + (tq < 7 ? 1 : 0)) * D) + C.lane;
#pragma unroll
              for (int j = 0; j < 4; ++j) nv[j] = yb[64 * j]; }
            const float mean = wave_sum_dpp(s) * (1.f / D); float s2 = 0.f;
#pragma unroll
            for (int j = 0; j < 4; ++j) { v[j] = v[j] - mean; s2 += (v[j][0] * v[j][0] + v[j][1] * v[j][1]) + (v[j][2] * v[j][2] + v[j][3] * v[j][3]); }
            const float rstd = 1.0f / sqrtf(wave_sum_dpp(s2) * (1.f / D) + LN_EPS);
            u32x2* xb = (u32x2*)(X1B + (size_t)tok * D) + C.lane; unsigned* x8 = (unsigned*)(X1F8 + (size_t)tok * D) + C.lane;
#pragma unroll
            for (int j = 0; j < 4; ++j) { v[j] = v[j] * rstd * g4[j] + b4[j];
                xb[64 * j] = (u32x2){pk2(v[j][0], v[j][1]), pk2(v[j][2], v[j][3])};
                x8[64 * j] = pk4_fp8(v[j][0], v[j][1], v[j][2], v[j][3]); }
        }
        asm volatile("s_waitcnt vmcnt(0)" ::: "memory");
        __syncthreads();
        {
            const int tile = C.wave & 3, kh = C.wave >> 2;
            const bf16_t* ap = X1B + (size_t)(blk * 64 + tile * 16 + n) * D + kh * 512 + 8 * q;
            const LAS unsigned char* bp = wl + n * LR_WS + (kh * 512 + 8 * q) * 2;
            bf16x8 af[16];
#pragma unroll
            for (int ks = 0; ks < 16; ++ks) af[ks] = *(const bf16x8*)(ap + 32 * ks);
            f32x4 acc = (f32x4){0.f, 0.f, 0.f, 0.f};
#pragma unroll
            for (int ks = 0; ks < 16; ++ks) { const bf16x8 bf = *(const LAS bf16x8*)(bp + 64 * ks); acc = __builtin_amdgcn_mfma_f32_16x16x32_bf16(af[ks], bf, acc, 0, 0, 0); }
#pragma unroll
            for (int r = 0; r < 4; ++r) slog[(kh * 64 + tile * 16 + 4 * q + r) * 17 + n] = acc[r];
        }
        __syncthreads();
        if (C.tid < 64) {
            const int tl = C.tid;
            float pr[16]; float mx = -INFINITY;
#pragma unroll
            for (int e = 0; e < 16; ++e) { pr[e] = slog[tl * 17 + e] + slog[(64 + tl) * 17 + e]; mx = fmaxf(mx, pr[e]); }
            float sum = 0.f;
#pragma unroll
            for (int e = 0; e < 16; ++e) { pr[e] = __expf(pr[e] - mx); sum += pr[e]; }
            const float inv = 1.0f / sum; float sel[16];
#pragma unroll
            for (int e = 0; e < 16; ++e) { pr[e] *= inv; sel[e] = pr[e] + br[e]; }
            float gs[4];
#pragma unroll
            for (int g = 0; g < 4; ++g) { const float a = sel[4 * g], b = sel[4 * g + 1], c = sel[4 * g + 2], d = sel[4 * g + 3];
                gs[g] = fmaxf(fmaxf(fmaxf(a + b, a + c), fmaxf(a + d, b + c)), fmaxf(b + d, c + d)); }
            int gi = 0; float bsc = gs[0];
#pragma unroll
            for (int g = 1; g < 4; ++g) if (gs[g] > bsc) { bsc = gs[g]; gi = g; }
            float sg[4], pg[4];
#pragma unroll
            for (int k = 0; k < 4; ++k) { sg[k] = gi == 0 ? sel[k] : (gi == 1 ? sel[4 + k] : (gi == 2 ? sel[8 + k] : sel[12 + k])); pg[k] = gi == 0 ? pr[k] : (gi == 1 ? pr[4 + k] : (gi == 2 ? pr[8 + k] : pr[12 + k])); }
            int i1 = 0; float b1 = sg[0], p1 = pg[0];
#pragma unroll
            for (int k = 1; k < 4; ++k) if (sg[k] > b1) { b1 = sg[k]; i1 = k; p1 = pg[k]; }
            int i2 = -1; float b2 = -INFINITY, p2 = 0.f;
#pragma unroll
            for (int k = 0; k < 4; ++k) if (k != i1 && sg[k] > b2) { b2 = sg[k]; i2 = k; p2 = pg[k]; }
            const float gsum = p1 + p2; sE[tl * 2] = gi * 4 + i1; sE[tl * 2 + 1] = gi * 4 + i2; sG[tl * 2] = p1 / gsum; sG[tl * 2 + 1] = p2 / gsum;
        }
        __syncthreads();
        if (C.tid < 128) sPos[C.tid] = __hip_atomic_fetch_add(lcnt + sE[C.tid], 1, __ATOMIC_RELAXED, __HIP_MEMORY_SCOPE_WORKGROUP);
        __syncthreads();
        if (C.tid < 16) lbase[C.tid] = (int)__hip_atomic_fetch_add(cnt + C.tid * 64, (unsigned)lcnt[C.tid], __ATOMIC_RELAXED, __HIP_MEMORY_SCOPE_AGENT);
        __syncthreads();
        if (C.tid < 128) { const int e = sE[C.tid], pos = lbase[e] + sPos[C.tid], tok = blk * 64 + (C.tid >> 1);
            list[e * LISTCAP + pos] = tok; tokE[tok * 2 + (C.tid & 1)] = e; tokP[tok * 2 + (C.tid & 1)] = pos; tokG[tok * 2 + (C.tid & 1)] = sG[C.tid]; }
    }
}
__device__ __forceinline__ void moe_prefix(const Ctx& C, int layer) {
    LAS int* mi = (LAS int*)(C.lds + LDS_MISC);
    unsigned* cnt = (unsigned*)(C.ws + WS_CTL) + CW_CNT + layer * 16 * 64;
    __syncthreads();
    if (C.tid < 16) mi[17 + C.tid] = (int)__hip_atomic_load(cnt + C.tid * 64, __ATOMIC_RELAXED, __HIP_MEMORY_SCOPE_AGENT);
    __syncthreads();
    if (C.tid == 0) { int a = 0; for (int e = 0; e < 16; ++e) { mi[e] = a; a += (mi[17 + e] + 255) >> 8; } mi[16] = a; }
    __syncthreads();
}
__device__ __forceinline__ void moe_tokens(const Ctx& C, int ntn) {
    const LAS int* mi = (const LAS int*)(C.lds + LDS_MISC); LAS int* toks = (LAS int*)(C.lds + LDS_TOKS);
    const int* list = (const int*)(C.ws + WS_LIST);
    const int total = mi[16] * ntn;
    int tv[4]; bool ok[4];
#pragma unroll
    for (int k = 0; k < 4; ++k) {
        const int idx = k * NTHREADS + C.tid, u = idx >> 8, rr = idx & 255, L = u * C.G + (((C.G & 7) == 0) ? (C.bid & 7) * (C.G >> 3) + (C.bid >> 3) : C.bid); ok[k] = L < total;
        const int Lc = ok[k] ? L : 0; int e = 0;
#pragma unroll
        for (int j = 1; j < 16; ++j) e += (Lc >= mi[j] * ntn) ? 1 : 0;
        const int r = Lc - mi[e] * ntn, te = mi[e + 1] - mi[e], mt = r / ntn, cn = mi[17 + e]; (void)te;
        int pos = mt * 256 + rr; pos = pos < cn ? pos : cn - 1; pos = pos < 0 ? 0 : pos;
        tv[k] = list[e * LISTCAP + pos];
    }
#pragma unroll
    for (int k = 0; k < 4; ++k) if (ok[k]) toks[k * NTHREADS + C.tid] = tv[k];
    __syncthreads();
}
__device__ __forceinline__ void combine_ln2(const Ctx& C, const Args& A, int layer) {
    const LAS int* mi = (const LAS int*)(C.lds + LDS_MISC);
    const bf16_t* X1B = (const bf16_t*)(C.ws + WS_X1B); const bf16_t* YD = (const bf16_t*)(C.ws + WS_YD); bf16_t* X2B = (bf16_t*)(C.ws + WS_XB);
    const int* tokE = (const int*)(C.ws + WS_TOKE); const int* tokP = (const int*)(C.ws + WS_TOKP); const float* tokG = (const float*)(C.ws + WS_TOKG);
    const float* lg = A.in[16] + layer * D; const float* lb = A.in[17] + layer * D;
    for (int tok0 = C.gw * 8; tok0 < T; tok0 += C.NGW * 8) {
        int rowv = 0; float gv = 0.f;
        if (C.lane < 16) { const int e = tokE[tok0 * 2 + C.lane]; rowv = mi[e] * 256 + tokP[tok0 * 2 + C.lane]; gv = tokG[tok0 * 2 + C.lane]; }
#pragma unroll 1
        for (int tq = 0; tq < 8; tq += 4) {
            u32x2 xa[4][4], y0[4][4], y1[4][4]; float g0[4], g1[4];
#pragma unroll
            for (int t = 0; t < 4; ++t) {
                const int ra = __shfl(rowv, 2 * (tq + t)), rb = __shfl(rowv, 2 * (tq + t) + 1);
                g0[t] = __shfl(gv, 2 * (tq + t)); g1[t] = __shfl(gv, 2 * (tq + t) + 1);
                const u32x2* xp = (const u32x2*)(X1B + (size_t)(tok0 + tq + t) * D) + C.lane; const u32x2* pa = (const u32x2*)(YD + (size_t)ra * D) + C.lane; const u32x2* pb = (const u32x2*)(YD + (size_t)rb * D) + C.lane;
#pragma unroll
                for (int j = 0; j < 4; ++j) { xa[t][j] = xp[64 * j]; y0[t][j] = pa[64 * j]; y1[t][j] = pb[64 * j]; }
            }
#pragma unroll
            for (int t = 0; t < 4; ++t) {
                f32x4 v[4]; float s = 0.f;
#pragma unroll
                for (int j = 0; j < 4; ++j) {
                    v[j][0] = ALPHA * bflo(xa[t][j].x) + (g0[t] * bflo(y0[t][j].x) + g1[t] * bflo(y1[t][j].x)); v[j][1] = ALPHA * bfhi(xa[t][j].x) + (g0[t] * bfhi(y0[t][j].x) + g1[t] * bfhi(y1[t][j].x));
                    v[j][2] = ALPHA * bflo(xa[t][j].y) + (g0[t] * bflo(y0[t][j].y) + g1[t] * bflo(y1[t][j].y)); v[j][3] = ALPHA * bfhi(xa[t][j].y) + (g0[t] * bfhi(y0[t][j].y) + g1[t] * bfhi(y1[t][j].y));
                    s += (v[j][0] + v[j][1]) + (v[j][2] + v[j][3]); }
                const float mean = wave_sum_dpp(s) * (1.f / D); float s2 = 0.f;
#pragma unroll
                for (int j = 0; j < 4; ++j) { v[j] = v[j] - mean; s2 += (v[j][0] * v[j][0] + v[j][1] * v[j][1]) + (v[j][2] * v[j][2] + v[j][3] * v[j][3]); }
                const float rstd = 1.0f / sqrtf(wave_sum_dpp(s2) * (1.f / D) + LN_EPS);
                const int tok = tok0 + tq + t;
#pragma unroll
                for (int j = 0; j < 4; ++j) { const int col = 4 * C.lane + 256 * j; const f32x4 g4 = *(const f32x4*)(lg + col), b4 = *(const f32x4*)(lb + col);
                    const f32x4 o = v[j] * rstd * g4 + b4;
                    if (layer == 0) *(u32x2*)(X2B + (size_t)tok * D + col) = (u32x2){pk2(o[0], o[1]), pk2(o[2], o[3])};
                    else *(f32x4*)(A.out + (size_t)tok * D + col) = o; }
            }
        }
    }
}

__global__ void __launch_bounds__(NTHREADS, 2) yoco_fwd(Args args) {
    extern __shared__ __attribute__((aligned(16))) unsigned char lds_raw[];
    Ctx C;
    C.ws = args.ws; C.lds = (LAS unsigned char*)lds_raw;
    C.tid = threadIdx.x; C.lane = C.tid & 63; C.wave = __builtin_amdgcn_readfirstlane(C.tid >> 6);
    C.G = gridDim.x; C.bid = blockIdx.x; C.gw = C.bid * NWAVES + C.wave; C.NGW = C.G * NWAVES;
    unsigned char* ws = args.ws;
#define PHASE_WS() do { ws = launder(args.ws); C.ws = ws; C.tid = launder_v((int)threadIdx.x); C.lane = C.tid & 63; } while (0)
    volatile LAS unsigned* misc = (volatile LAS unsigned*)(C.lds + LDS_MISC);
    for (int u = C.tid; u < 64; u += NTHREADS) misc[u] = 0u;
    __syncthreads();
    XcdBarrier bar; bar.bar = (unsigned*)(ws + WS_CTL) + CW_BAR; bar.x = 0; bar.st = misc + 60;
    const int lo = args.ph_lo, hi = args.ph_hi;
    if (hi - lo > 1) bar = xcd_barrier_post((unsigned*)(ws + WS_CTL) + CW_BAR, misc + 60);
#define IN(k) (lo <= (k) && (k) < hi)
#define SEAMF(k) do { if (IN(k) && IN((k) + 1)) { PHASE_WS(); fill_tail(C, args, (k), false); xcd_barrier(bar); } } while (0)
#if MK_DIAG == 9
#define SEAM(k) do { if (IN(k) && IN((k) + 1)) { const unsigned long long t0_ = __builtin_amdgcn_s_memrealtime(); xcd_barrier(bar); if (((MK_DIAGMASK >> (k)) & 1) && threadIdx.x == 0) diag_acc += (unsigned)(__builtin_amdgcn_s_memrealtime() - t0_); } } while (0)
#else
#define SEAM(k) do { if (IN(k) && IN((k) + 1)) xcd_barrier(bar); } while (0)
#endif
#ifndef MK_DUP
#define MK_DUP 0
#endif
    unsigned diag_acc = 0;
#if MK_DIAG == 10
#define TREG(id, ...) do { __syncthreads(); const unsigned long long t0_ = __builtin_amdgcn_s_memrealtime(); __VA_ARGS__; __syncthreads(); if ((id) == MK_DIAGSEL) diag_acc += (unsigned)(__builtin_amdgcn_s_memrealtime() - t0_); } while (0)
#else
#define TREG(id, ...) do { __VA_ARGS__; } while (0)
#endif
#define REP(k) for (int rep_ = 0; rep_ < 1 + ((MK_DUP >> (k)) & 1); ++rep_)

    if (IN(0)) { REP(0) { PHASE_WS(); TREG(10, p0_prologue(C, args)); } SEAM(0); }

    if (IN(1)) {
        REP(1) {
        PHASE_WS();
        { pg8::Gemm g{(const bf16_t*)(ws + WS_XB), (const bf16_t*)(ws + WS_BT_INA), T, 1792, D}; pg8::StaticOrder S; S.init(T, 1792, C.G, C.bid);
          EpiProjA E{(bf16_t*)(ws + WS_U), (bf16_t*)(ws + WS_GV), (bf16_t*)(ws + WS_QM0)};
          pg8::gemm_phase<EpiProjA, pg8::StaticOrder>(C.lds, g, S, E, nullptr, C.tid); }
        { pg8::Gemm g{(const bf16_t*)(ws + WS_MEMB), (const bf16_t*)(ws + WS_BT_MEM), NB * NMEM, 1024, D}; SmallOrder S{4, 32, C.bid - (C.G - 32)};
          EpiPlain E{(bf16_t*)(ws + WS_MKV), 1024, 4};
          pg8::gemm_phase<EpiPlain, SmallOrder>(C.lds, g, S, E, nullptr, C.tid); }
        }
        SEAMF(1);
    }
    if (IN(2)) {
        REP(2) { PHASE_WS();
        TREG(1, sg_mfma(C, args));
        TREG(2, memattn_mfma(C, (const bf16_t*)(ws + WS_QM0), (const bf16_t*)(ws + WS_MKV), 0, 256, (bf16_t*)(ws + WS_CAT), D, SGW)); }
        SEAM(2);
    }
    if (IN(3)) {
        REP(3) { PHASE_WS();
        pg8::Gemm g{(const bf16_t*)(ws + WS_CAT), (const bf16_t*)(ws + WS_BT_OUTA), T, D, D}; pg8::StaticOrder S; S.init(T, D, C.G, C.bid);
        EpiResid<true> E{(const void*)(ws + WS_XB), (bf16_t*)(ws + WS_Y)};
        pg8::gemm_phase<EpiResid<true>, pg8::StaticOrder>(C.lds, g, S, E, nullptr, C.tid); }
        SEAM(3);
    }
    { constexpr int layer = 0;
        const int pb = 4 + 8 * layer;
        if (IN(pb)) { if ((MK_DUP >> 4) & 1) { PHASE_WS(); ln_route(C, args, layer, 2 + layer); __syncthreads(); } PHASE_WS(); TREG(6 + layer, ln_route(C, args, layer, layer)); SEAM(pb); }
        if (IN(pb + 1)) {
            REP(5) { PHASE_WS();
            moe_prefix(C, layer); moe_tokens(C, 8);
            MoeGatherOrder S; S.tb = (const LAS int*)(C.lds + LDS_MISC); S.ntn = 8; S.G = C.G; S.c = C.bid; S.toks = (const LAS int*)(C.lds + LDS_TOKS);
            {
                pg8::Gemm g{(const bf16_t*)(ws + WS_X1F8), (const bf16_t*)(ws + WS_WGU + (size_t)layer * (64 * MiB)), 0, 0, D / 2, E8_ONE, E8_W};
                EpiSwiGLU8 E{ws + WS_ACT};
#if MK_DUPNULL
                if (rep_ > 0) { EpiNull EN; pg8::gemm_phase<EpiNull, MoeGatherOrder, false, true>(C.lds, g, S, EN, nullptr, C.tid); } else
#endif
                pg8::gemm_phase<EpiSwiGLU8, MoeGatherOrder, false, true>(C.lds, g, S, E, nullptr, C.tid);
            } }
            SEAMF(pb + 1);
        }
        if (IN(pb + 2)) {
            REP(6) { PHASE_WS();
            moe_prefix(C, layer);
            MoeOrder S{(const LAS int*)(C.lds + LDS_MISC), 4, C.G, C.bid};
            EpiPlain E{(bf16_t*)(ws + WS_YD), 1024, 4};
            {
                pg8::Gemm g{(const bf16_t*)(ws + WS_ACT), (const bf16_t*)(ws + WS_WD + (size_t)layer * (32 * MiB)), 0, 0, D / 2, E8_ACT, E8_W};
                pg8::gemm_phase<EpiPlain, MoeOrder, false, true>(C.lds, g, S, E, nullptr, C.tid);
            } }
            SEAMF(pb + 2);
        }
        if (IN(pb + 3)) { REP(7) { PHASE_WS(); moe_prefix(C, layer); TREG(8 + layer, combine_ln2(C, args, layer)); } if (layer == 0) SEAM(pb + 3); }
    }
    {
            if (IN(8)) {
                REP(8) { PHASE_WS();
                pg8::Gemm g{(const bf16_t*)(ws + WS_XB), (const bf16_t*)(ws + WS_BT_B), T, 2560, D}; pg8::StaticOrder S; S.init(T, 2560, C.G, C.bid);
                EpiProjB E{(bf16_t*)(ws + WS_K), (bf16_t*)(ws + WS_V), (bf16_t*)(ws + WS_Q), (bf16_t*)(ws + WS_QM1)};
                pg8::gemm_phase<EpiProjB, pg8::StaticOrder>(C.lds, g, S, E, nullptr, C.tid); }
                SEAMF(8);
            }
            if (IN(9)) {
                REP(9) { PHASE_WS();
                TREG(3, dilattn_mfma(C));
                TREG(4, memattn_mfma(C, (const bf16_t*)(ws + WS_QM1), (const bf16_t*)(ws + WS_MKV), 512, 768, (bf16_t*)(ws + WS_CAT2), 512, 256)); }
                SEAM(9);
            }
            if (IN(10)) { REP(10) { PHASE_WS(); TREG(5, dil_merge(C, args)); } SEAM(10); }
            if (IN(11)) {
                REP(11) { PHASE_WS();
                pg8::Gemm g{(const bf16_t*)(ws + WS_CAT2), (const bf16_t*)(ws + WS_BT_OUTB), T, D, 512}; pg8::StaticOrder S; S.init(T, D, C.G, C.bid);
                EpiResid<true> E{(const void*)(ws + WS_XB), (bf16_t*)(ws + WS_Y)};
                pg8::gemm_phase<EpiResid<true>, pg8::StaticOrder>(C.lds, g, S, E, nullptr, C.tid); }
                if (IN(11)) { PHASE_WS(); fill_tail(C, args, 11, true); }
                SEAM(11);
            }
    }
    { constexpr int layer = 1;
        const int pb = 4 + 8 * layer;
        if (IN(pb)) { if ((MK_DUP >> 4) & 1) { PHASE_WS(); ln_route(C, args, layer, 2 + layer); __syncthreads(); } PHASE_WS(); TREG(6 + layer, ln_route(C, args, layer, layer)); SEAM(pb); }
        if (IN(pb + 1)) {
            REP(5) { PHASE_WS();
            moe_prefix(C, layer); moe_tokens(C, 8);
            MoeGatherOrder S; S.tb = (const LAS int*)(C.lds + LDS_MISC); S.ntn = 8; S.G = C.G; S.c = C.bid; S.toks = (const LAS int*)(C.lds + LDS_TOKS);
            {
                pg8::Gemm g{(const bf16_t*)(ws + WS_X1F8), (const bf16_t*)(ws + WS_WGU + (size_t)layer * (64 * MiB)), 0, 0, D / 2, E8_ONE, E8_W};
                EpiSwiGLU8 E{ws + WS_ACT};
#if MK_DUPNULL
                if (rep_ > 0) { EpiNull EN; pg8::gemm_phase<EpiNull, MoeGatherOrder, false, true>(C.lds, g, S, EN, nullptr, C.tid); } else
#endif
                pg8::gemm_phase<EpiSwiGLU8, MoeGatherOrder, false, true>(C.lds, g, S, E, nullptr, C.tid);
            } }
            SEAM(pb + 1);
        }
        if (IN(pb + 2)) {
            REP(6) { PHASE_WS();
            moe_prefix(C, layer);
            MoeOrder S{(const LAS int*)(C.lds + LDS_MISC), 4, C.G, C.bid};
            EpiPlain E{(bf16_t*)(ws + WS_YD), 1024, 4};
            {
                pg8::Gemm g{(const bf16_t*)(ws + WS_ACT), (const bf16_t*)(ws + WS_WD + (size_t)layer * (32 * MiB)), 0, 0, D / 2, E8_ACT, E8_W};
                pg8::gemm_phase<EpiPlain, MoeOrder, false, true>(C.lds, g, S, E, nullptr, C.tid);
            } }
            SEAM(pb + 2);
        }
        if (IN(pb + 3)) { REP(7) { PHASE_WS(); moe_prefix(C, layer); TREG(8 + layer, combine_ln2(C, args, layer)); } if (layer == 0) SEAM(pb + 3); }
    }
#if MK_DIAG == 3
    xcd_barrier(bar);
    if (blockIdx.x == 0 && threadIdx.x == 0) { const unsigned got = __hip_atomic_fetch_add((unsigned*)(args.ws + WS_CTL) + 30000, 0u, __ATOMIC_RELAXED, __HIP_MEMORY_SCOPE_AGENT); const unsigned long long t0 = __builtin_amdgcn_s_memrealtime();
        const unsigned long long dur = (unsigned long long)got * 4ull;
        while (__builtin_amdgcn_s_memrealtime() - t0 < dur) __builtin_amdgcn_s_sleep(8); }
#endif
#if MK_DIAG == 11
    if (blockIdx.x == 0 && threadIdx.x == 0) { const unsigned long long t0 = __builtin_amdgcn_s_memrealtime(); const unsigned long long dur = (unsigned long long)misc[42] * 4ull;
        while (__builtin_amdgcn_s_memrealtime() - t0 < dur) __builtin_amdgcn_s_sleep(8); }
#endif
#if MK_DIAG == 10
    if (blockIdx.x == 0 && threadIdx.x == 0) { const unsigned long long t0 = __builtin_amdgcn_s_memrealtime(); const unsigned long long dur = (unsigned long long)diag_acc * 4ull;
        while (__builtin_amdgcn_s_memrealtime() - t0 < dur) __builtin_amdgcn_s_sleep(8); }
#endif
#if MK_DIAG == 9
    if (threadIdx.x == 0) __hip_atomic_fetch_add((unsigned*)(args.ws + WS_CTL) + 30000, diag_acc, __ATOMIC_RELAXED, __HIP_MEMORY_SCOPE_AGENT);
    xcd_barrier(bar);
    if (blockIdx.x == 0 && threadIdx.x == 0) { const unsigned got = __hip_atomic_fetch_add((unsigned*)(args.ws + WS_CTL) + 30000, 0u, __ATOMIC_RELAXED, __HIP_MEMORY_SCOPE_AGENT); const unsigned long long t0 = __builtin_amdgcn_s_memrealtime();
        const unsigned long long dur = (unsigned long long)got / 256ull;
        while (__builtin_amdgcn_s_memrealtime() - t0 < dur) __builtin_amdgcn_s_sleep(8); }
#endif
#undef IN
#undef SEAM
}
}

extern "C" void kernel_launch(void* const* d_in, const int* in_sizes, int n_in, void* d_out, int out_size, void* d_ws, size_t ws_size, hipStream_t stream) {
    using namespace mk;
    static int grid = 0;
    if (grid == 0) {
        if (n_in != 23 || out_size != T * D || ws_size < WS_END) { fprintf(stderr, "kernel_launch: unexpected shapes (n_in %d, out %d, ws %zu)\n", n_in, out_size, ws_size); grid = -1; return; }
        int dev = 0, cus = 0, per_cu = 0;
        if (hipGetDevice(&dev) != hipSuccess || hipDeviceGetAttribute(&cus, hipDeviceAttributeMultiprocessorCount, dev) != hipSuccess) { grid = -1; return; }
        if (hipFuncSetAttribute((const void*)yoco_fwd, hipFuncAttributeMaxDynamicSharedMemorySize, LDS_BYTES) != hipSuccess) { fprintf(stderr, "kernel_launch: hipFuncSetAttribute failed\n"); grid = -1; return; }
        if (hipOccupancyMaxActiveBlocksPerMultiprocessor(&per_cu, (const void*)yoco_fwd, NTHREADS, LDS_BYTES) != hipSuccess || per_cu < 1)
            fprintf(stderr, "kernel_launch: occupancy query reports %d workgroups per CU\n", per_cu);
        (void)hipGetLastError();
        grid = cus;
    }
    if (grid < 0) return;
    (void)hipMemsetAsync((char*)d_ws + WS_CTL, 0, CTL_ZERO_BYTES, stream);
    Args a{};
    for (int i = 0; i < 23; ++i) a.in[i] = (const float*)d_in[i];
    a.out = (float*)d_out; a.ws = (unsigned char*)d_ws;
    constexpr int NL = MK_N_LAUNCHES;
    for (int li = 0; li < NL; ++li) {
        a.ph_lo = (NL == NPHASE) ? li : (li * NPHASE) / NL; a.ph_hi = (NL == NPHASE) ? li + 1 : ((li + 1) * NPHASE) / NL;
        hipLaunchKernelGGL(yoco_fwd, dim3(grid), dim3(NTHREADS), LDS_BYTES, stream, a);
    }
}
```

```cpp
#include <hip/hip_runtime.h>
#include <cstdio>
#include <cstdint>
namespace pg8 {
#define PG8_LAS __attribute__((address_space(3)))
typedef unsigned short bf16_t;
typedef short bf16x8 __attribute__((ext_vector_type(8)));
typedef float f32x4 __attribute__((ext_vector_type(4)));
typedef unsigned u32x4 __attribute__((ext_vector_type(4)));
constexpr int BM = 256, BK = 64, HALF = 128, HTB = HALF * BK * 2  , STAGE_BYTES = 8 * HTB, NXCD = 8, WGM = 4;

__host__ __device__ __forceinline__ int lds_byte(int r, int c) { const int st = (r >> 4) * 2 + (c >> 5), rr = r & 15, cc = c & 31, ob = rr * 64 + cc * 2; return st * 1024 + (ob ^ (((ob >> 9) & 1) << 5)); }
__host__ __device__ __forceinline__ void stage_rc(int b, int& R, int& C) { const int st = b / 1024, sb = b % 1024, swz = sb ^ (((sb >> 9) & 1) << 5); R = (st >> 1) * 16 + swz / 64; C = (st & 1) * 32 + (swz % 64) / 2; }
__host__ __device__ __forceinline__ int perm32(int rho) { const int n = rho >> 4, i = rho & 15; return 8 * (i >> 2) + 4 * n + (i & 3); }

struct Unit { int pm, pn; };
struct Gemm { const bf16_t* A; const bf16_t* Bt; int M, N, K; int sA, sB; };

struct StaticOrder {
    int nM, nN, nwg, G, c;
    __host__ __device__ void init(int M, int N, int G_, int c_) { nM = M / BM; nN = N / BM; nwg = nM * nN; G = G_; c = c_; }
    __host__ __device__ bool next(int i, Unit& u) const {
        const long L = (long)i * G + c; if (L >= nwg) return false;
        int wgid = (int)L; { const int q = nwg / NXCD, r = nwg % NXCD, xcd = wgid % NXCD, off = wgid / NXCD; wgid = (xcd < r ? xcd * (q + 1) : r * (q + 1) + (xcd - r) * q) + off; }
        const int nig = WGM * nN, gid = wgid / nig, fm = gid * WGM, gsz = (nM - fm) < WGM ? (nM - fm) : WGM;
        u.pm = fm + ((wgid % nig) % gsz); u.pn = (wgid % nig) / gsz; return true;
    }
    __device__ __forceinline__ void a_ready(const Unit&) const {}
    __device__ __forceinline__ void done(const Unit&) const {}
    __device__ __forceinline__ int arow(int, const Unit& u, int r) const { return u.pm * BM + r; }
};
__device__ __forceinline__ unsigned cvt_pk_bf16(float lo, float hi) { unsigned r; asm volatile("v_cvt_pk_bf16_f32 %0, %1, %2" : "=v"(r) : "v"(lo), "v"(hi)); return r; }
typedef float f32x2 __attribute__((ext_vector_type(2)));
__device__ __forceinline__ f32x2 gelu_pk(f32x2 v) {
    const f32x2 av = __builtin_elementwise_abs(v), d = av * 0.2316418882f + 1.0f;
    f32x2 t; t.x = __builtin_amdgcn_rcpf(d.x); t.y = __builtin_amdgcn_rcpf(d.y);
    f32x2 q = t * 0.5307027145f + (-0.7265760135f); q = q * t + 0.7107068705f; q = q * t + (-0.142248368f); q = q * t + 0.127414796f; q = q * t;
    const f32x2 s = (v * v) * (-0.72134752044f);
    f32x2 e; e.x = __builtin_amdgcn_exp2f(s.x); e.y = __builtin_amdgcn_exp2f(s.y);
    const f32x2 m = v * (q * e), r = v - m;
    f32x2 o; o.x = v.x < 0.f ? m.x : r.x; o.y = v.y < 0.f ? m.y : r.y; return o;
}
template <class Epi, class Sched, bool STAMP = false, bool F8 = false>
__device__ __forceinline__ void gemm_phase(PG8_LAS unsigned char* lds, const Gemm g, const Sched& S, const Epi& E, unsigned long long* stamps, const int tid) {
    const int wid = __builtin_amdgcn_readfirstlane(tid >> 6), lane = tid & 63, wr = wid >> 2, wc = wid & 3, fr = lane & 15, fq = lane >> 4;
    const int K = g.K, nt = K / BK;
    int ts_lo = 0, ts_hi = 0, nts = 0; const unsigned long long rt_entry = STAMP ? (unsigned long long)wall_clock64() : 0ull;
#define PG8_STAMP() do { if (STAMP && wid == 0 && nts < 64) { const unsigned long long _c = (unsigned long long)clock64(); \
        ts_lo = (lane == nts) ? (int)(unsigned)_c : ts_lo; ts_hi = (lane == nts) ? (int)(unsigned)(_c >> 32) : ts_hi; ++nts; } } while (0)
    PG8_STAMP();
    unsigned colA[2], voffB[2]; int rowA[2];
#pragma unroll
    for (int i = 0; i < 2; ++i) { int R, C; stage_rc(tid * 16 + i * 8192, R, C); const int Rb = Epi::PERM ? ((R & ~31) + perm32(R & 31)) : R;
        rowA[i] = R; colA[i] = (unsigned)C * 2u; voffB[i] = (unsigned)(Rb * K + C) * 2u; }
#define PG8_AOFF(dst, uidx, un) do { _Pragma("unroll") for (int _h = 0; _h < 2; ++_h) _Pragma("unroll") for (int _i = 0; _i < 2; ++_i) \
        dst[_h][_i] = (unsigned)S.arow((uidx), (un), _h * HALF + rowA[_i]) * (unsigned)(K * 2) + colA[_i]; } while (0)
    const size_t kstep = (size_t)(BK * 2);
    const size_t hstep = (size_t)HALF * K * 2;
    const size_t tstep = 2 * hstep;
    const unsigned ldsw = (unsigned)wid * 1024u;
    const int aoff = lds_byte(wr * 64 + fr, fq * 8), boff = lds_byte(wc * 32 + fr, fq * 8);
    constexpr int KOFF = 1024;
#define PG8_SA(b, h) (((b) * 2 + (h)) * HTB)
#define PG8_SB(b, h) ((4 + (b) * 2 + (h)) * HTB)
#define PG8_STAGE(bufoff, gbase, voff) do { _Pragma("unroll") for (int _i = 0; _i < 2; ++_i) \
        __builtin_amdgcn_global_load_lds((const unsigned*)((const char*)(gbase) + (voff)[_i]), (PG8_LAS unsigned*)(lds + (bufoff) + ldsw + _i * 8192), 16, 0, 0); } while (0)
#define PG8_LDA(dst, b, h) do { _Pragma("unroll") for (int m = 0; m < 4; ++m) _Pragma("unroll") for (int k = 0; k < 2; ++k) dst[m][k] = *(const PG8_LAS bf16x8*)(lds + PG8_SA(b, h) + aoff + m * 2048 + k * KOFF); } while (0)
#define PG8_LDB(dst, b, h) do { _Pragma("unroll") for (int n = 0; n < 2; ++n) _Pragma("unroll") for (int k = 0; k < 2; ++k) dst[n][k] = *(const PG8_LAS bf16x8*)(lds + PG8_SB(b, h) + boff + n * 2048 + k * KOFF); } while (0)
#define PG8_MMA(ai, bj, At, Bt) do { __builtin_amdgcn_s_setprio(1); \
        if constexpr (F8) { _Pragma("unroll") for (int m = 0; m < 4; ++m) _Pragma("unroll") for (int n = 0; n < 2; ++n) { \
            typedef int i32x4_ __attribute__((ext_vector_type(4))); typedef int i32x8_ __attribute__((ext_vector_type(8))); \
            const i32x8_ b8_ = __builtin_shufflevector(__builtin_bit_cast(i32x4_, Bt[n][0]), __builtin_bit_cast(i32x4_, Bt[n][1]), 0, 1, 2, 3, 4, 5, 6, 7); \
            const i32x8_ a8_ = __builtin_shufflevector(__builtin_bit_cast(i32x4_, At[m][0]), __builtin_bit_cast(i32x4_, At[m][1]), 0, 1, 2, 3, 4, 5, 6, 7); \
            acc[ai][bj][m][n] = __builtin_amdgcn_mfma_scale_f32_16x16x128_f8f6f4(b8_, a8_, acc[ai][bj][m][n], 0, 0, 0, g.sB, 0, g.sA); } } \
        else { _Pragma("unroll") for (int m = 0; m < 4; ++m) _Pragma("unroll") for (int n = 0; n < 2; ++n) _Pragma("unroll") for (int k = 0; k < 2; ++k) \
            acc[ai][bj][m][n] = __builtin_amdgcn_mfma_f32_16x16x32_bf16(Bt[n][k], At[m][k], acc[ai][bj][m][n], 0, 0, 0); } \
        __builtin_amdgcn_s_setprio(0); } while (0)
#define PG8_WAIT_V(n) asm volatile("s_waitcnt vmcnt(" #n ")" ::: "memory")
#define PG8_WAIT_L(n) asm volatile("s_waitcnt lgkmcnt(" #n ")" ::: "memory")
#define PG8_BAR __builtin_amdgcn_s_barrier()
#define PG8_SCHED __builtin_amdgcn_sched_barrier(0)
    Unit cur, nxt; int ui = 0;
    if (!S.next(0, cur)) return;
    f32x4 acc[2][2][4][2];
#pragma unroll
    for (int a = 0; a < 2; ++a)
#pragma unroll
        for (int b = 0; b < 2; ++b)
#pragma unroll
            for (int m = 0; m < 4; ++m)
#pragma unroll
                for (int n = 0; n < 2; ++n) acc[a][b][m][n] = (f32x4){0.f, 0.f, 0.f, 0.f};
    bf16x8 At[4][2], B0[2][2], B1[2][2];
    const char* Ab = (const char*)g.A; const char* cB = (const char*)g.Bt + (size_t)cur.pn * tstep;
    unsigned cuA[2][2];
    S.a_ready(cur);
    PG8_AOFF(cuA, 0, cur);
    PG8_STAGE(PG8_SB(0, 0), cB, voffB); PG8_STAGE(PG8_SA(0, 0), Ab, cuA[0]); PG8_STAGE(PG8_SB(0, 1), cB + hstep, voffB); PG8_STAGE(PG8_SA(0, 1), Ab, cuA[1]);
    if (wr == 1) PG8_BAR;
    PG8_WAIT_V(4); PG8_BAR;
    PG8_STAGE(PG8_SB(1, 0), cB + kstep, voffB); PG8_STAGE(PG8_SA(1, 0), Ab + kstep, cuA[0]); PG8_STAGE(PG8_SB(1, 1), cB + hstep + kstep, voffB);
    PG8_WAIT_V(6); PG8_BAR;
    PG8_STAMP();
    for (;;) {
        const bool has_next = S.next(ui + 1, nxt);
        const char* nB = has_next ? (const char*)g.Bt + (size_t)nxt.pn * tstep : cB;
        for (int t = 0; t < nt; t += 2) {
            const bool last = (t == nt - 2);
            const char* a1 = Ab + (size_t)(t + 1) * kstep;
            const char* a2 = last ? Ab : Ab + (size_t)(t + 2) * kstep; const char* b2 = last ? nB : cB + (size_t)(t + 2) * kstep;
            const char* a3 = a2 + kstep; const char* b3 = b2 + kstep;

            if (last && has_next) S.a_ready(nxt);
            PG8_LDB(B0, 0, 0); PG8_SCHED; PG8_LDA(At, 0, 0); PG8_STAGE(PG8_SA(1, 1), a1, cuA[1]);
            PG8_WAIT_L(8); PG8_BAR; PG8_WAIT_L(0); PG8_MMA(0, 0, At, B0); PG8_BAR; PG8_SCHED;
            if (last && has_next) PG8_AOFF(cuA, ui + 1, nxt);
            PG8_LDB(B1, 0, 1); PG8_STAGE(PG8_SB(0, 0), b2, voffB);
            PG8_BAR; PG8_WAIT_L(0); PG8_MMA(0, 1, At, B1); PG8_BAR;
            PG8_LDA(At, 0, 1); PG8_STAGE(PG8_SA(0, 0), a2, cuA[0]);
            PG8_BAR; PG8_WAIT_L(0); PG8_MMA(1, 0, At, B0); PG8_BAR; PG8_SCHED;
            PG8_STAGE(PG8_SB(0, 1), b2 + hstep, voffB);
            PG8_WAIT_V(6); PG8_BAR; PG8_MMA(1, 1, At, B1); PG8_BAR;
            PG8_LDB(B0, 1, 0); PG8_SCHED; PG8_LDA(At, 1, 0); PG8_STAGE(PG8_SA(0, 1), a2, cuA[1]);
            PG8_WAIT_L(8); PG8_BAR; PG8_WAIT_L(0); PG8_MMA(0, 0, At, B0); PG8_BAR; PG8_SCHED;
            PG8_LDB(B1, 1, 1); PG8_STAGE(PG8_SB(1, 0), b3, voffB);
            PG8_BAR; PG8_WAIT_L(0); PG8_MMA(0, 1, At, B1); PG8_BAR;
            PG8_LDA(At, 1, 1); PG8_STAGE(PG8_SA(1, 0), a3, cuA[0]);
            PG8_BAR; PG8_WAIT_L(0); PG8_MMA(1, 0, At, B0); PG8_BAR; PG8_SCHED;
            PG8_STAGE(PG8_SB(1, 1), b3 + hstep, voffB);
            PG8_WAIT_V(6); PG8_BAR; PG8_MMA(1, 1, At, B1); PG8_BAR;
        }
        PG8_STAMP();
        if constexpr (!Epi::AFTER_DRAIN) { E(acc, cur, wr, wc, fr, fq); S.done(cur); }
        PG8_STAMP();
        if (!has_next) break;
#pragma unroll
        for (int a = 0; a < 2; ++a)
#pragma unroll
            for (int b = 0; b < 2; ++b)
#pragma unroll
                for (int m = 0; m < 4; ++m)
#pragma unroll
                    for (int n = 0; n < 2; ++n) acc[a][b][m][n] = (f32x4){0.f, 0.f, 0.f, 0.f};
        cur = nxt; cB = nB; ++ui;
    }
    PG8_WAIT_V(0);
    if (wr == 0) PG8_BAR;
    PG8_BAR;
    if constexpr (Epi::AFTER_DRAIN) { E.fused(acc, cur, wr, wc, fr, fq, lds, wid, lane); S.done(cur); }
    PG8_STAMP();
    if (STAMP && wid == 0) { stamps[lane] = lane < nts ? (((unsigned long long)(unsigned)ts_hi << 32) | (unsigned)ts_lo) : 0ull;
        if (lane == 62) stamps[62] = rt_entry; if (lane == 63) stamps[63] = (unsigned long long)wall_clock64(); }
#undef PG8_STAMP
#undef PG8_SA
#undef PG8_SB
#undef PG8_STAGE
#undef PG8_AOFF
#undef PG8_LDA
#undef PG8_LDB
#undef PG8_MMA
#undef PG8_WAIT_V
#undef PG8_WAIT_L
#undef PG8_BAR
#undef PG8_SCHED
}
}

namespace mk {
using pg8::bf16_t; using pg8::f32x4; using pg8::u32x4; using pg8::Unit; using pg8::cvt_pk_bf16;
#define LAS __attribute__((address_space(3)))
typedef float f32x2 __attribute__((ext_vector_type(2)));
typedef unsigned u32x2 __attribute__((ext_vector_type(2)));

#ifndef MK_DIAG
#define MK_DIAG 0
#endif
#ifndef MK_DUPNULL
#define MK_DUPNULL 0
#endif
#ifndef MK_DIAGSEL
#define MK_DIAGSEL 0
#endif
#ifndef MK_DIAGMASK
#define MK_DIAGMASK 0xFFFF
#endif
#ifndef MK_N_LAUNCHES
#define MK_N_LAUNCHES 1
#endif
constexpr int NPHASE = 16;
constexpr int NB = 8, SEQ = 2048, D = 1024, T = NB * SEQ, NMEM = 256, SGW = 768, NSG = 12, HD = 64, CH = 128;
constexpr int NEXP = 16, LISTCAP = 16384;
constexpr float ALPHA = 1.41421356237f;
constexpr float LN_EPS = 1e-5f, ATT_SCALE = 0.125f;
constexpr int NWAVES = 8, NTHREADS = 512;

constexpr size_t MiB = 1u << 20;
constexpr size_t WS_CTL = 0, CTL_ZERO_BYTES = 128 * 1024;
constexpr size_t WS_TOKE = 1 * MiB, WS_TOKP = WS_TOKE + 128 * 1024, WS_TOKG = WS_TOKP + 128 * 1024;
constexpr size_t WS_LIST = 2 * MiB, WS_LSE = 3 * MiB, WS_SGWB = 4 * MiB, WS_SGRS = 4 * MiB + 512 * 1024, WS_WRT = 4 * MiB + 768 * 1024;
constexpr size_t WS_MKV = 8 * MiB, WS_MEMB = 12 * MiB;
constexpr size_t WS_BT_INA = 18 * MiB, WS_BT_OUTA = 22 * MiB, WS_BT_B = 24 * MiB, WS_BT_OUTB = 29 * MiB, WS_BT_MEM = 30 * MiB;
constexpr size_t WS_WGU = 32 * MiB, WS_WD = 160 * MiB;
constexpr size_t WS_A = 224 * MiB;
constexpr size_t WS_U = WS_A, WS_GV = WS_A + 24 * MiB, WS_QM0 = WS_A + 48 * MiB;
constexpr size_t WS_K = WS_A, WS_V = WS_A + 24 * MiB, WS_Q = WS_A + 48 * MiB, WS_QM1 = WS_A + 72 * MiB;
constexpr size_t WS_ACT = WS_A;
constexpr size_t WS_XB = 304 * MiB;
constexpr size_t WS_C = 336 * MiB;
constexpr size_t WS_CAT = WS_C, WS_OG = WS_C, WS_CAT2 = WS_C + 24 * MiB;
constexpr size_t WS_Y = 376 * MiB;
constexpr size_t WS_YD = 336 * MiB;
constexpr size_t WS_X1B = 440 * MiB;
constexpr size_t WS_X1F8 = 472 * MiB;
constexpr size_t WS_END = 488 * MiB;
constexpr size_t WS_WGU8 = WS_WGU + 64 * MiB, WS_WD8 = WS_WD + 32 * MiB;
constexpr int CW_TMO = 0, CW_BAR = 4096, CW_CNT = 16384, CW_CONV = 24576, CW_DONE = 24640, CW_CONV0 = 26000;
constexpr int LDS_TOKS = 131072 + 1024, MAX_UNITS = 8;
constexpr int LDS_MISC = 131072;
constexpr int LDS_BYTES = 147456;
static_assert(LDS_TOKS + MAX_UNITS * 1024 <= LDS_BYTES, "LDS map");

#define LDS_WAIT() asm volatile("s_waitcnt lgkmcnt(0)" ::: "memory")
#define VM_WAIT() asm volatile("s_waitcnt vmcnt(0)" ::: "memory")
__device__ __forceinline__ unsigned f2bf(float f) { unsigned u = __builtin_bit_cast(unsigned, f); return (u + 0x7fffu + ((u >> 16) & 1u)) >> 16; }
__device__ __forceinline__ unsigned pk2(float lo, float hi) { return f2bf(lo) | (f2bf(hi) << 16); }
__device__ __forceinline__ float sat8(float x) { return __builtin_amdgcn_fmed3f(x, -448.0f, 448.0f); }
__device__ __forceinline__ unsigned pk4_fp8_e(float a, float b, float c, float d) { int r = 0; r = __builtin_amdgcn_cvt_pk_fp8_f32(sat8(a), sat8(b), r, false); r = __builtin_amdgcn_cvt_pk_fp8_f32(sat8(c), sat8(d), r, true); return (unsigned)r; }
__device__ __forceinline__ float bflo(unsigned w) { return __uint_as_float(w << 16); }
__device__ __forceinline__ float bfhi(unsigned w) { return __uint_as_float(w & 0xffff0000u); }
__device__ __forceinline__ float bf1(bf16_t v) { return __uint_as_float(((unsigned)v) << 16); }
__device__ __forceinline__ float wave_sum(float v) {
#pragma unroll
    for (int o = 1; o < 64; o <<= 1) v += __shfl_xor(v, o);
    return v;
}
template <int CTRL> __device__ __forceinline__ float dpp_f(float v) { return __builtin_bit_cast(float, __builtin_amdgcn_update_dpp(0, __builtin_bit_cast(int, v), CTRL, 0xf, 0xf, false)); }
__device__ __forceinline__ float row_sum(float v) { v += dpp_f<0xB1>(v); v += dpp_f<0x4E>(v); v += dpp_f<0x141>(v); v += dpp_f<0x140>(v); return v; }
__device__ __forceinline__ float wave_sum_dpp(float v) { v = row_sum(v); v += __shfl_xor(v, 16); v += __shfl_xor(v, 32); return v; }
__device__ __forceinline__ float wave_max(float v) {
#pragma unroll
    for (int o = 1; o < 64; o <<= 1) v = fmaxf(v, __shfl_xor(v, o));
    return v;
}

#define XB_TMO      128
#define XB_XCNT(j)  (256  + 64 * (j))
#define XB_XSUB(j)  (1280 + 64 * (j))
#define XB_XGEN(j)  (2304 + 64 * (j))
#define XB_TOP      3328
#define XB_TOPGEN   3392
#define XCD_BAR_WORDS 3456
#define XB_SPIN_CAP (1u << 18)
__device__ __forceinline__ unsigned xb_ld(unsigned* p)              { return __hip_atomic_load(p, __ATOMIC_RELAXED, __HIP_MEMORY_SCOPE_AGENT); }
__device__ __forceinline__ unsigned xb_add(unsigned* p, unsigned v) { return __hip_atomic_fetch_add(p, v, __ATOMIC_RELAXED, __HIP_MEMORY_SCOPE_AGENT); }
__device__ __forceinline__ unsigned xb_xcc_id() { return (unsigned)__builtin_amdgcn_s_getreg((3 << 11) | 20) & 0xFu; }
#define XB_SPIN(cond, bar) do { unsigned _sp = 0; while (cond) { __builtin_amdgcn_s_sleep(1); \
    if ((++_sp & 255u) == 0u) { if (xb_ld(&(bar)[XB_TMO])) break; if (_sp > XB_SPIN_CAP) { atomicAdd(&(bar)[XB_TMO], 1u); break; } } } } while (0)
struct XcdBarrier { unsigned* bar; unsigned x; volatile LAS unsigned* st; };
__device__ __forceinline__ XcdBarrier xcd_barrier_post(unsigned* bar, volatile LAS unsigned* st) {
    XcdBarrier b; b.bar = bar; b.x = xb_xcc_id(); b.st = st;
    if (threadIdx.x == 0) (void)xb_add(&bar[XB_XCNT(b.x)], 1u);
    return b;
}
__device__ __forceinline__ void xcd_barrier_complete(unsigned* bar, unsigned x, unsigned& nloc, unsigned& nx) {
    const unsigned G = gridDim.x * gridDim.y * gridDim.z;
    unsigned sum, cnt, mine, sp = 0u;
    for (;;) {
        sum = 0u; cnt = 0u; mine = 0u;
#pragma unroll
        for (unsigned j = 0; j < 16; ++j) { const unsigned c = xb_ld(&bar[XB_XCNT(j)]); sum += c; cnt += (c > 0u) ? 1u : 0u; mine = (j == x) ? c : mine; }
        if (sum == G) break;
        __builtin_amdgcn_s_sleep(1);
        if ((++sp & 255u) == 0u) { if (xb_ld(&bar[XB_TMO])) break; if (sp > XB_SPIN_CAP) { atomicAdd(&bar[XB_TMO], 1u); break; } }
    }
    nloc = mine > 0u ? mine : 1u; nx = cnt > 0u ? cnt : 1u;
}
__device__ __forceinline__ void xcd_barrier(const XcdBarrier& b) {
    asm volatile("s_waitcnt vmcnt(0)" ::: "memory");
    __syncthreads();
    if (threadIdx.x == 0) {
        unsigned* bar = b.bar;
        __builtin_amdgcn_s_waitcnt(0);
        unsigned nloc = b.st[0], nx = b.st[1];
        if (nloc == 0u) { xcd_barrier_complete(bar, b.x, nloc, nx); b.st[0] = nloc; b.st[1] = nx; }
        const unsigned old = xb_add(&bar[XB_XSUB(b.x)], 1u);
        const unsigned gen = old / nloc;
        if (old + 1u == (gen + 1u) * nloc) {
            __builtin_amdgcn_fence(__ATOMIC_RELEASE, "agent");
            asm volatile("s_waitcnt vmcnt(0)" ::: "memory");
            const unsigned og = xb_add(&bar[XB_TOP], 1u);
            const unsigned tg = og / nx;
            if (og + 1u == (tg + 1u) * nx) xb_add(&bar[XB_TOPGEN], 1u);
            else XB_SPIN(xb_ld(&bar[XB_TOPGEN]) == tg, bar);
            __builtin_amdgcn_fence(__ATOMIC_ACQUIRE, "agent");
            xb_add(&bar[XB_XGEN(b.x)], 1u);
            asm volatile("s_waitcnt vmcnt(0)" ::: "memory");
        } else {
            XB_SPIN(xb_ld(&bar[XB_XGEN(b.x)]) == gen, bar);
            __builtin_amdgcn_fence(__ATOMIC_ACQUIRE, "agent");
            asm volatile("s_waitcnt vmcnt(0)" ::: "memory");
        }
    }
    __syncthreads();
}


struct EpiProjA {
    static constexpr bool PERM = true, AFTER_DRAIN = false;
    bf16_t *u, *gv, *qm;
    __device__ __forceinline__ void operator()(const f32x4 (&acc)[2][2][4][2], const Unit& un, int wr, int wc, int fr, int fq) const {
        const int row0 = un.pm * 256 + wr * 64 + fr;
        bf16_t* base; int ldc, colt; bool act; float sc = 1.f;
        if (un.pn < 3) { base = u; ldc = SGW; colt = un.pn * 256; act = true; }
        else if (un.pn < 6) { base = gv; ldc = SGW; colt = (un.pn - 3) * 256; act = true; }
        else { base = qm; ldc = 256; colt = 0; act = false; sc = ATT_SCALE; }
        const int col0 = colt + wc * 32 + 8 * fq;
#pragma unroll
        for (int ai = 0; ai < 2; ++ai)
#pragma unroll
            for (int m = 0; m < 4; ++m) { bf16_t* rowp = base + (size_t)(row0 + ai * 128 + m * 16) * ldc + col0;
#pragma unroll
                for (int bj = 0; bj < 2; ++bj) { f32x4 v0 = acc[ai][bj][m][0], v1 = acc[ai][bj][m][1];
                    if (act) { pg8::f32x2 a = pg8::gelu_pk((pg8::f32x2){v0[0], v0[1]}), b = pg8::gelu_pk((pg8::f32x2){v0[2], v0[3]}), c = pg8::gelu_pk((pg8::f32x2){v1[0], v1[1]}), d = pg8::gelu_pk((pg8::f32x2){v1[2], v1[3]});
                        v0 = (f32x4){a.x, a.y, b.x, b.y}; v1 = (f32x4){c.x, c.y, d.x, d.y}; }
                    v0 = v0 * sc; v1 = v1 * sc;
                    u32x4 w; w.x = cvt_pk_bf16(v0[0], v0[1]); w.y = cvt_pk_bf16(v0[2], v0[3]); w.z = cvt_pk_bf16(v1[0], v1[1]); w.w = cvt_pk_bf16(v1[2], v1[3]);
                    *(u32x4*)(rowp + bj * 128) = w; } }
    }
};
struct EpiProjB {
    static constexpr bool PERM = true, AFTER_DRAIN = false;
    bf16_t *k, *v, *q, *qm;
    __device__ __forceinline__ void operator()(const f32x4 (&acc)[2][2][4][2], const Unit& un, int wr, int wc, int fr, int fq) const {
        const int row0 = un.pm * 256 + wr * 64 + fr;
        bf16_t* base; int ldc, colt; float sc = 1.f;
        if (un.pn < 3) { base = k; ldc = SGW; colt = un.pn * 256; }
        else if (un.pn < 6) { base = v; ldc = SGW; colt = (un.pn - 3) * 256; }
        else if (un.pn < 9) { base = q; ldc = SGW; colt = (un.pn - 6) * 256; sc = ATT_SCALE; }
        else { base = qm; ldc = 256; colt = 0; sc = ATT_SCALE; }
        const int col0 = colt + wc * 32 + 8 * fq;
#pragma unroll
        for (int ai = 0; ai < 2; ++ai)
#pragma unroll
            for (int m = 0; m < 4; ++m) { bf16_t* rowp = base + (size_t)(row0 + ai * 128 + m * 16) * ldc + col0;
#pragma unroll
                for (int bj = 0; bj < 2; ++bj) { f32x4 v0 = acc[ai][bj][m][0] * sc, v1 = acc[ai][bj][m][1] * sc;
                    u32x4 w; w.x = cvt_pk_bf16(v0[0], v0[1]); w.y = cvt_pk_bf16(v0[2], v0[3]); w.z = cvt_pk_bf16(v1[0], v1[1]); w.w = cvt_pk_bf16(v1[2], v1[3]);
                    *(u32x4*)(rowp + bj * 128) = w; } }
    }
};
struct EpiPlain {
    static constexpr bool PERM = true, AFTER_DRAIN = false;
    bf16_t* O; int ldc, ntn;
    __device__ __forceinline__ void operator()(const f32x4 (&acc)[2][2][4][2], const Unit& un, int wr, int wc, int fr, int fq) const {
        const int row0 = un.pm * 256 + wr * 64 + fr;
        const int col0 = (un.pn % ntn) * 256 + wc * 32 + 8 * fq;
#pragma unroll
        for (int ai = 0; ai < 2; ++ai)
#pragma unroll
            for (int m = 0; m < 4; ++m) { bf16_t* rowp = O + (size_t)(row0 + ai * 128 + m * 16) * ldc + col0;
#pragma unroll
                for (int bj = 0; bj < 2; ++bj) { const f32x4 v0 = acc[ai][bj][m][0], v1 = acc[ai][bj][m][1];
                    u32x4 w; w.x = cvt_pk_bf16(v0[0], v0[1]); w.y = cvt_pk_bf16(v0[2], v0[3]); w.z = cvt_pk_bf16(v1[0], v1[1]); w.w = cvt_pk_bf16(v1[2], v1[3]);
                    *(u32x4*)(rowp + bj * 128) = w; } }
    }
};
struct EpiSwiGLU {
    static constexpr bool PERM = true, AFTER_DRAIN = false;
    bf16_t* O;
    __device__ __forceinline__ void operator()(const f32x4 (&acc)[2][2][4][2], const Unit& un, int wr, int wc, int fr, int fq) const {
        const int row0 = un.pm * 256 + wr * 64 + fr;
        const int col0 = (un.pn & 7) * 128 + wc * 32 + 8 * fq;
#pragma unroll
        for (int ai = 0; ai < 2; ++ai)
#pragma unroll
            for (int m = 0; m < 4; ++m) { bf16_t* rowp = O + (size_t)(row0 + ai * 128 + m * 16) * 1024 + col0;
                float r[8];
#pragma unroll
                for (int n = 0; n < 2; ++n)
#pragma unroll
                    for (int j = 0; j < 4; ++j) { const float g = acc[ai][0][m][n][j], up = acc[ai][1][m][n][j];
                        r[n * 4 + j] = g * __builtin_amdgcn_rcpf(1.0f + __expf(-g)) * up; }
                u32x4 w; w.x = cvt_pk_bf16(r[0], r[1]); w.y = cvt_pk_bf16(r[2], r[3]); w.z = cvt_pk_bf16(r[4], r[5]); w.w = cvt_pk_bf16(r[6], r[7]);
                *(u32x4*)rowp = w; }
    }
};
struct EpiSwiGLU8 {
    static constexpr bool PERM = true, AFTER_DRAIN = false;
    unsigned char* O;
    __device__ __forceinline__ void operator()(const f32x4 (&acc)[2][2][4][2], const Unit& un, int wr, int wc, int fr, int fq) const {
        const int row0 = un.pm * 256 + wr * 64 + fr;
        const int col0 = (un.pn & 7) * 128 + wc * 32 + 8 * fq;
#pragma unroll
        for (int ai = 0; ai < 2; ++ai)
#pragma unroll
            for (int m = 0; m < 4; ++m) { unsigned char* rowp = O + (size_t)(row0 + ai * 128 + m * 16) * 1024 + col0;
                float r[8];
#pragma unroll
                for (int n = 0; n < 2; ++n)
#pragma unroll
                    for (int j = 0; j < 4; ++j) { const float g = acc[ai][0][m][n][j], up = acc[ai][1][m][n][j];
                        r[n * 4 + j] = g * __builtin_amdgcn_rcpf(1.0f + __expf(-g)) * up * 8.0f; }
                *(u32x2*)rowp = (u32x2){pk4_fp8_e(r[0], r[1], r[2], r[3]), pk4_fp8_e(r[4], r[5], r[6], r[7])}; }
    }
};
template <bool RB> struct EpiResid {
    static constexpr bool PERM = false, AFTER_DRAIN = false;
    const void* res; bf16_t* Y;
    __device__ __forceinline__ void operator()(const f32x4 (&acc)[2][2][4][2], const Unit& un, int wr, int wc, int fr, int fq) const {
        const int row0 = un.pm * 256 + wr * 64 + fr, col0 = un.pn * 256 + wc * 32 + 4 * fq;
#pragma unroll
        for (int ai = 0; ai < 2; ++ai)
#pragma unroll
            for (int m = 0; m < 4; ++m) { const size_t off = (size_t)(row0 + ai * 128 + m * 16) * D + col0;
#pragma unroll
                for (int bj = 0; bj < 2; ++bj)
#pragma unroll
                    for (int n = 0; n < 2; ++n) { const size_t o = off + bj * 128 + n * 16; f32x4 r;
                        if (RB) { const u32x2 w = *(const u32x2*)((const bf16_t*)res + o); r = (f32x4){bflo(w.x), bfhi(w.x), bflo(w.y), bfhi(w.y)}; }
                        else r = *(const f32x4*)((const float*)res + o);
                        const f32x4 yv = r * ALPHA + acc[ai][bj][m][n]; *(u32x2*)(Y + o) = (u32x2){cvt_pk_bf16(yv[0], yv[1]), cvt_pk_bf16(yv[2], yv[3])}; } }
    }
};
struct EpiNull {
    static constexpr bool PERM = true, AFTER_DRAIN = false;
    __device__ __forceinline__ void operator()(const f32x4 (&acc)[2][2][4][2], const Unit&, int, int, int, int) const {
#pragma unroll
        for (int a = 0; a < 2; ++a)
#pragma unroll
            for (int b = 0; b < 2; ++b)
#pragma unroll
                for (int m = 0; m < 4; ++m)
#pragma unroll
                    for (int n = 0; n < 2; ++n) asm volatile("" :: "v"(acc[a][b][m][n]));
    }
};
struct SmallOrder {
    int nN, nwg, c;
    __device__ bool next(int i, Unit& u) const { if (i != 0 || c < 0 || c >= nwg) return false; u.pm = c / nN; u.pn = c % nN; return true; }
    __device__ __forceinline__ void a_ready(const Unit&) const {}
    __device__ __forceinline__ void done(const Unit&) const {}
    __device__ __forceinline__ int arow(int, const Unit& u, int r) const { return u.pm * 256 + r; }
};
struct MoeOrder {
    const LAS int* tb;
    int ntn, G, c;
    __device__ bool next(int i, Unit& u) const {
        const int L = i * G + (((G & 7) == 0) ? (c & 7) * (G >> 3) + (c >> 3) : c); if (L >= tb[16] * ntn) return false;
        int e = 0;
#pragma unroll
        for (int j = 1; j < 16; ++j) e += (L >= tb[j] * ntn) ? 1 : 0;
        const int r = L - tb[e] * ntn, te = tb[e + 1] - tb[e];
        (void)te; u.pm = tb[e] + r / ntn; u.pn = e * ntn + r % ntn; return true;
    }
    __device__ __forceinline__ void a_ready(const Unit&) const {}
    __device__ __forceinline__ void done(const Unit&) const {}
    __device__ __forceinline__ int arow(int, const Unit& u, int r) const { return u.pm * 256 + r; }
};
struct MoeGatherOrder : MoeOrder {
    const LAS int* toks;
    __device__ __forceinline__ int arow(int ui, const Unit&, int r) const { return toks[ui * 256 + r]; }
};

struct Args { const float* in[23]; float* out; unsigned char* ws; int ph_lo, ph_hi; };
struct Ctx {
    unsigned char* ws; LAS unsigned char* lds;
    int tid, lane, wave, gw, NGW, G, bid, vb;
};
__device__ __forceinline__ unsigned char* launder(unsigned char* p) { asm volatile("" : "+s"(p)); return p; }
__device__ __forceinline__ int launder_v(int v) { asm volatile("" : "+v"(v)); return v; }

__device__ __forceinline__ void tr_item(const float* W, int K, int N, bf16_t* WT, int grp, int gstride, int roff, LAS float* scr, int item, int lane) {
    const int nblk = N / 32, kb = item / nblk, nb = item % nblk, k0 = 64 * kb, n0 = 32 * nb;
    float ld[32];
    { const float* wp = W + (size_t)(k0 + (lane >> 5)) * N + n0 + (lane & 31);
#pragma unroll
      for (int i = 0; i < 32; ++i) ld[i] = __builtin_nontemporal_load(wp + (size_t)(2 * i) * N); }
#pragma unroll
    for (int i = 0; i < 32; ++i) scr[(2 * i + (lane >> 5)) * 33 + (lane & 31)] = ld[i];
    LDS_WAIT(); asm volatile("" ::: "memory");
    const int c = lane & 7;
#pragma unroll
    for (int j = 0; j < 4; ++j) { const int n = (lane >> 3) + 8 * j; const LAS float* s = scr + (8 * c) * 33 + n;
        const int nn = n0 + n, drow = (nn / grp) * gstride + (nn % grp) + roff;
        u32x4 o; o.x = pk2(s[0 * 33], s[1 * 33]); o.y = pk2(s[2 * 33], s[3 * 33]); o.z = pk2(s[4 * 33], s[5 * 33]); o.w = pk2(s[6 * 33], s[7 * 33]);
        *(u32x4*)(WT + (size_t)drow * K + k0 + 8 * c) = o; }
    LDS_WAIT(); asm volatile("" ::: "memory");
}
__device__ __forceinline__ unsigned pk4_fp8(float a, float b, float c, float d) { return pk4_fp8_e(a, b, c, d); }
__device__ __forceinline__ void tr_item8(const float* W, int K, int N, unsigned char* WT, int grp, int gstride, int roff, float sc, LAS float* scr, int item, int lane) {
    const int nblk = N / 32, kb = item / nblk, nb = item % nblk, k0 = 64 * kb, n0 = 32 * nb;
    float ld[32];
    { const float* wp = W + (size_t)(k0 + (lane >> 5)) * N + n0 + (lane & 31);
#pragma unroll
      for (int i = 0; i < 32; ++i) ld[i] = __builtin_nontemporal_load(wp + (size_t)(2 * i) * N); }
#pragma unroll
    for (int i = 0; i < 32; ++i) scr[(2 * i + (lane >> 5)) * 33 + (lane & 31)] = ld[i];
    LDS_WAIT(); asm volatile("" ::: "memory");
    const int c = lane & 7;
#pragma unroll
    for (int j = 0; j < 4; ++j) { const int n = (lane >> 3) + 8 * j; const LAS float* s = scr + (8 * c) * 33 + n;
        const int nn = n0 + n, drow = (nn / grp) * gstride + (nn % grp) + roff;
        u32x2 o; o.x = pk4_fp8(s[0 * 33] * sc, s[1 * 33] * sc, s[2 * 33] * sc, s[3 * 33] * sc); o.y = pk4_fp8(s[4 * 33] * sc, s[5 * 33] * sc, s[6 * 33] * sc, s[7 * 33] * sc);
        *(u32x2*)(WT + (size_t)drow * K + k0 + 8 * c) = o; }
    LDS_WAIT(); asm volatile("" ::: "memory");
}
constexpr float W8_SCALE = 32.0f, ACT8_SCALE = 8.0f;
constexpr int E8_ONE = 0x7f7f7f7f, E8_W = 0x7a7a7a7a, E8_ACT = 0x7c7c7c7c;
__device__ __forceinline__ void moe_conv_item(const Args& A, unsigned char* ws, LAS float* scr, int lane, int layer, int r) {
    const int t = r >> 13, e = (r & 8191) >> 9, m = layer * 16 + e, item = r & 511;
    if (t == 0) tr_item8(A.in[20] + (size_t)m * 1048576, 1024, 1024, ws + WS_WGU + (size_t)layer * (64 * MiB) + (size_t)e * 2097152, 128, 256, 0, W8_SCALE, scr, item, lane);
    else if (t == 1) tr_item8(A.in[21] + (size_t)m * 1048576, 1024, 1024, ws + WS_WGU + (size_t)layer * (64 * MiB) + (size_t)e * 2097152, 128, 256, 128, W8_SCALE, scr, item, lane);
    else tr_item8(A.in[22] + (size_t)m * 1048576, 1024, 1024, ws + WS_WD + (size_t)layer * (32 * MiB) + (size_t)e * 1048576, 1024, 1024, 0, W8_SCALE, scr, item, lane);
}
constexpr int N_CONV1 = 3 * 8192;
__device__ __forceinline__ void fill_tail(const Ctx& C, const Args& A, int ph, bool fin) {
    unsigned* ctl = (unsigned*)(C.ws + WS_CTL);
    volatile LAS int* flag = (volatile LAS int*)(C.lds + LDS_MISC) + 40;
    LAS float* scr = (LAS float*)(C.lds + C.wave * 16384);
    asm volatile("s_waitcnt vmcnt(0)" ::: "memory");
    __syncthreads();
    if (C.tid == 0 && !fin) __hip_atomic_fetch_add(ctl + CW_DONE + 64 * ph, 1u, __ATOMIC_RELAXED, __HIP_MEMORY_SCOPE_AGENT);
    for (;;) {
        if (C.tid == 0) { int v = -1;
            const unsigned d = fin ? 0u : __hip_atomic_fetch_add(ctl + CW_DONE + 64 * ph, 0u, __ATOMIC_RELAXED, __HIP_MEMORY_SCOPE_AGENT);
            if (d + 32u < (unsigned)C.G) { v = (int)__hip_atomic_fetch_add(ctl + CW_CONV, 8u, __ATOMIC_RELAXED, __HIP_MEMORY_SCOPE_AGENT); if (v >= N_CONV1) v = -1; }
#if MK_DIAG == 3
            if (!fin && v >= 0) __hip_atomic_fetch_add(ctl + 30000, 8u, __ATOMIC_RELAXED, __HIP_MEMORY_SCOPE_AGENT);
#endif
            *flag = v; }
        __syncthreads();
        const int v = *flag;
        __syncthreads();
        if (v < 0) break;
        if (v + C.wave < N_CONV1) moe_conv_item(A, C.ws, scr, C.lane, 1, v + C.wave);
    }
}
__device__ __forceinline__ void p0_prologue(const Ctx& C, const Args& A) {
    LAS float* scr = (LAS float*)(C.lds + C.wave * 16384);
    unsigned char* ws = C.ws;
    constexpr int I_MOE = 16 * 32;
    constexpr int N_MOE = 32 * I_MOE;
    constexpr int I_INA = 16 * 56, I_SQ = 512, I_KV = 16 * 24, I_OUTB = 8 * 32, I_MEM = 16 * 8;
    constexpr int N_MOE0 = 3 * 8192;
    constexpr int NITEMS = I_INA + I_SQ + I_SQ + 2 * I_KV + I_OUTB + 4 * I_MEM;
    for (int it = C.gw; it < NITEMS; it += C.NGW) {
        int r = it;
        if (r < I_INA) { tr_item(A.in[2], 1024, 1792, (bf16_t*)(ws + WS_BT_INA), 1792, 1792, 0, scr, r, C.lane); continue; } r -= I_INA;
        if (r < I_SQ) { tr_item(A.in[3], 1024, 1024, (bf16_t*)(ws + WS_BT_OUTA), 1024, 1024, 0, scr, r, C.lane); continue; } r -= I_SQ;
        if (r < I_SQ) { tr_item(A.in[8], 1024, 1024, (bf16_t*)(ws + WS_BT_B), 1024, 1024, 1536, scr, r, C.lane); continue; } r -= I_SQ;
        if (r < I_KV) { tr_item(A.in[10], 1024, 768, (bf16_t*)(ws + WS_BT_B), 768, 768, 0, scr, r, C.lane); continue; } r -= I_KV;
        if (r < I_KV) { tr_item(A.in[11], 1024, 768, (bf16_t*)(ws + WS_BT_B), 768, 768, 768, scr, r, C.lane); continue; } r -= I_KV;
        if (r < I_OUTB) { tr_item(A.in[9], 512, 1024, (bf16_t*)(ws + WS_BT_OUTB), 1024, 1024, 0, scr, r, C.lane); continue; } r -= I_OUTB;
        { const int m = r / I_MEM, layer = m & 1, isv = m >> 1;
          tr_item(A.in[isv ? 13 : 12] + (size_t)layer * 262144, 1024, 256, (bf16_t*)(ws + WS_BT_MEM), 256, 256, layer * 512 + isv * 256, scr, r % I_MEM, C.lane); }
    }
    const int gt = C.bid * NTHREADS + C.tid, NT = C.G * NTHREADS;
    for (int i = gt; i < NSG * 128 * 128 / 8; i += NT) { const int q0 = (i & 15) * 8, p = (i >> 4) & 127;
        const f32x4 a = *(const f32x4*)(A.in[6] + (size_t)i * 8), b = *(const f32x4*)(A.in[6] + (size_t)i * 8 + 4); float v[8] = {a[0], a[1], a[2], a[3], b[0], b[1], b[2], b[3]};
#pragma unroll
        for (int j = 0; j < 8; ++j) v[j] = (q0 + j <= p) ? v[j] : 0.f;
        u32x4 w; w.x = pk2(v[0], v[1]); w.y = pk2(v[2], v[3]); w.z = pk2(v[4], v[5]); w.w = pk2(v[6], v[7]); *(u32x4*)((bf16_t*)(ws + WS_SGWB) + (size_t)i * 8) = w; }
    for (int i = gt; i < 16 * 1024; i += NT) { const int e = i >> 10, k = i & 1023; ((bf16_t*)(ws + WS_WRT))[i] = (bf16_t)f2bf(A.in[18][(size_t)k * 16 + e]); }
    for (int i = C.gw; i < NSG * 128; i += C.NGW) { const int p = i & 127;
        const float w0 = A.in[6][(size_t)i * 128 + C.lane], w1 = A.in[6][(size_t)i * 128 + 64 + C.lane];
        const float acc = wave_sum_dpp((C.lane <= p ? bflo(f2bf(w0)) : 0.f) + (64 + C.lane <= p ? bflo(f2bf(w1)) : 0.f));
        if (C.lane == 0) ((float*)(ws + WS_SGRS))[i] = acc; }
    for (int i0 = gt; i0 < T * D / 8; i0 += 4 * NT) {
        f32x4 a[4], b[4];
#pragma unroll
        for (int k = 0; k < 4; ++k) { const int i = i0 + k * NT; const size_t o = (size_t)(i < T * D / 8 ? i : gt) * 8; a[k] = __builtin_nontemporal_load((const f32x4*)(A.in[0] + o)); b[k] = __builtin_nontemporal_load((const f32x4*)(A.in[0] + o + 4)); }
#pragma unroll
        for (int k = 0; k < 4; ++k) { const int i = i0 + k * NT; if (i < T * D / 8) { u32x4 w; w.x = cvt_pk_bf16(a[k][0], a[k][1]); w.y = cvt_pk_bf16(a[k][2], a[k][3]); w.z = cvt_pk_bf16(b[k][0], b[k][1]); w.w = cvt_pk_bf16(b[k][2], b[k][3]);
            *(u32x4*)((bf16_t*)(ws + WS_XB) + (size_t)i * 8) = w; } } }
    for (int i = gt; i < NB * NMEM * D / 8; i += NT) { const f32x4 a = *(const f32x4*)(A.in[1] + (size_t)i * 8), b = *(const f32x4*)(A.in[1] + (size_t)i * 8 + 4);
        u32x4 w; w.x = pk2(a[0], a[1]); w.y = pk2(a[2], a[3]); w.z = pk2(b[0], b[1]); w.w = pk2(b[2], b[3]); *(u32x4*)((bf16_t*)(ws + WS_MEMB) + (size_t)i * 8) = w; }
    { unsigned* ctr = (unsigned*)(ws + WS_CTL) + CW_CONV0; volatile LAS int* flag = (volatile LAS int*)(C.lds + LDS_MISC) + 40;
      if (C.tid == 0) *flag = (int)__hip_atomic_fetch_add(ctr, 8u, __ATOMIC_RELAXED, __HIP_MEMORY_SCOPE_AGENT);
      __syncthreads();
      int cur = *flag;
      __syncthreads();
      while (cur < N_MOE0) {
          int nxt = 0;
          if (C.tid == 0) nxt = (int)__hip_atomic_fetch_add(ctr, 8u, __ATOMIC_RELAXED, __HIP_MEMORY_SCOPE_AGENT);
          if (cur + C.wave < N_MOE0) moe_conv_item(A, ws, scr, C.lane, 0, cur + C.wave);
          if (C.tid == 0) *flag = nxt;
          __syncthreads();
          cur = *flag;
          __syncthreads();
      } }
}

__device__ __forceinline__ void sg_scalar(const Ctx& C, const Args& A) {
    const bf16_t* U = (const bf16_t*)(C.ws + WS_U); const bf16_t* GV = (const bf16_t*)(C.ws + WS_GV); bf16_t* CAT = (bf16_t*)(C.ws + WS_CAT);
    const float* lng = A.in[4]; const float* lnb = A.in[5]; const float* sgw = A.in[6]; const float* sgb = A.in[7];
    LAS float* stat = (LAS float*)C.lds;
    LAS float* gvn = (LAS float*)(C.lds + 1024);
    LAS float* Wl = (LAS float*)(C.lds + 1024 + 128 * 65 * 4);
    for (int unit = C.bid; unit < NB * 16; unit += C.G) {
        const int tb = unit * 128;
        for (int rr = 0; rr < 16; ++rr) { const int row = C.wave * 16 + rr; const bf16_t* p = GV + (size_t)(tb + row) * SGW + 4 * C.lane;
            float s = 0.f, ss = 0.f;
#pragma unroll
            for (int j = 0; j < 3; ++j) { const u32x2 w = *(const u32x2*)(p + 256 * j); const float a = bflo(w.x), b = bfhi(w.x), c = bflo(w.y), d = bfhi(w.y);
                s += (a + b) + (c + d); ss += (a * a + b * b) + (c * c + d * d); }
            s = wave_sum(s); ss = wave_sum(ss);
            const float mean = s * (1.f / SGW), var = ss * (1.f / SGW) - mean * mean;
            if (C.lane == 0) { stat[row * 2] = mean; stat[row * 2 + 1] = 1.0f / sqrtf(var + LN_EPS); } }
        __syncthreads();
        const int p = C.tid >> 2, d0 = (C.tid & 3) * 16;
        for (int g = 0; g < NSG; ++g) {
            { const bf16_t* src = GV + (size_t)(tb + p) * SGW + g * 64 + d0; const float mean = stat[p * 2], rstd = stat[p * 2 + 1];
#pragma unroll
              for (int h = 0; h < 2; ++h) { const u32x4 w = *(const u32x4*)(src + 8 * h); const unsigned ww[4] = {w.x, w.y, w.z, w.w};
#pragma unroll
                  for (int j = 0; j < 4; ++j) { const int d = d0 + 8 * h + 2 * j; const int cc = g * 64 + d;
                      gvn[p * 65 + d] = (bflo(ww[j]) - mean) * rstd * lng[cc] + lnb[cc];
                      gvn[p * 65 + d + 1] = (bfhi(ww[j]) - mean) * rstd * lng[cc + 1] + lnb[cc + 1]; } } }
            { const int q0 = (C.tid & 3) * 32; const float* src = sgw + ((size_t)g * 128 + p) * 128 + q0;
#pragma unroll
              for (int j = 0; j < 8; ++j) { const f32x4 w = *(const f32x4*)(src + 4 * j);
#pragma unroll
                  for (int t = 0; t < 4; ++t) { const int q = q0 + 4 * j + t; Wl[p * 129 + q] = (q <= p) ? w[t] : 0.f; } } }
            __syncthreads();
            float acc[16];
#pragma unroll
            for (int j = 0; j < 16; ++j) acc[j] = 0.f;
            for (int q = 0; q <= p; ++q) { const float w = Wl[p * 129 + q];
#pragma unroll
                for (int j = 0; j < 16; ++j) acc[j] += w * gvn[q * 65 + d0 + j]; }
            const float bs = sgb[g * 128 + p];
            const bf16_t* us = U + (size_t)(tb + p) * SGW + g * 64 + d0; bf16_t* dst = CAT + (size_t)(tb + p) * D + g * 64 + d0;
#pragma unroll
            for (int h = 0; h < 2; ++h) { const u32x4 w = *(const u32x4*)(us + 8 * h); const unsigned ww[4] = {w.x, w.y, w.z, w.w}; unsigned o[4];
#pragma unroll
                for (int j = 0; j < 4; ++j) o[j] = pk2(bflo(ww[j]) * (acc[8 * h + 2 * j] + bs), bfhi(ww[j]) * (acc[8 * h + 2 * j + 1] + bs));
                *(u32x4*)(dst + 8 * h) = (u32x4){o[0], o[1], o[2], o[3]}; }
            __syncthreads();
        }
    }
}

__device__ __forceinline__ void memattn_scalar(const Ctx& C, const bf16_t* QM, const bf16_t* MKV, int ck, int cv, bf16_t* OUT, int ldo, int coff) {
    for (int it = C.gw; it < T * 4; it += C.NGW) {
        const int tok = it >> 2, h = it & 3, b = tok / SEQ;
        float q[64];
        { const bf16_t* qp = QM + (size_t)tok * 256 + h * 64;
#pragma unroll
          for (int j = 0; j < 8; ++j) { const u32x4 w = *(const u32x4*)(qp + 8 * j);
              q[8 * j] = bflo(w.x); q[8 * j + 1] = bfhi(w.x); q[8 * j + 2] = bflo(w.y); q[8 * j + 3] = bfhi(w.y); q[8 * j + 4] = bflo(w.z); q[8 * j + 5] = bfhi(w.z); q[8 * j + 6] = bflo(w.w); q[8 * j + 7] = bfhi(w.w); } }
        float s[4];
#pragma unroll
        for (int jj = 0; jj < 4; ++jj) { const bf16_t* kp = MKV + (size_t)(b * NMEM + jj * 64 + C.lane) * 1024 + ck + h * 64; float a = 0.f;
#pragma unroll
            for (int j = 0; j < 8; ++j) { const u32x4 w = *(const u32x4*)(kp + 8 * j);
                a += q[8 * j] * bflo(w.x) + q[8 * j + 1] * bfhi(w.x) + q[8 * j + 2] * bflo(w.y) + q[8 * j + 3] * bfhi(w.y) + q[8 * j + 4] * bflo(w.z) + q[8 * j + 5] * bfhi(w.z) + q[8 * j + 6] * bflo(w.w) + q[8 * j + 7] * bfhi(w.w); }
            s[jj] = a; }
        const float mx = wave_max(fmaxf(fmaxf(s[0], s[1]), fmaxf(s[2], s[3])));
        float l = 0.f;
#pragma unroll
        for (int jj = 0; jj < 4; ++jj) { s[jj] = __expf(s[jj] - mx); l += s[jj]; }
        l = wave_sum(l);
        float acc = 0.f;
#pragma unroll
        for (int jj = 0; jj < 4; ++jj) { const bf16_t* vp = MKV + (size_t)(b * NMEM + jj * 64) * 1024 + cv + h * 64 + C.lane;
            for (int mm = 0; mm < 64; ++mm) acc += __shfl(s[jj], mm) * bf1(vp[(size_t)mm * 1024]); }
        OUT[(size_t)tok * ldo + coff + h * 64 + C.lane] = (bf16_t)f2bf(acc / l);
    }
}

__device__ __forceinline__ void dilattn_scalar(const Ctx& C, const Args& A) {
    const bf16_t* Q = (const bf16_t*)(C.ws + WS_Q); const bf16_t* K = (const bf16_t*)(C.ws + WS_K); const bf16_t* V = (const bf16_t*)(C.ws + WS_V);
    bf16_t* OG = (bf16_t*)(C.ws + WS_OG); float* LSE = (float*)(C.ws + WS_LSE);
    for (int it = C.gw; it < T * 12; it += C.NGW) {
        const int tok = it / 12, h = it % 12, g = h >> 2, dl = (g == 0) ? 1 : (g == 1 ? 4 : 16);
        const int t = tok % SEQ, i = t / dl;
        const float slope = exp2f(-(float)(h + 1) * (8.0f / 12.0f));
        float q[64];
        { const bf16_t* qp = Q + (size_t)tok * SGW + h * 64;
#pragma unroll
          for (int j = 0; j < 8; ++j) { const u32x4 w = *(const u32x4*)(qp + 8 * j);
              q[8 * j] = bflo(w.x); q[8 * j + 1] = bfhi(w.x); q[8 * j + 2] = bflo(w.y); q[8 * j + 3] = bfhi(w.y); q[8 * j + 4] = bflo(w.z); q[8 * j + 5] = bfhi(w.z); q[8 * j + 6] = bflo(w.w); q[8 * j + 7] = bfhi(w.w); } }
        float s[3];
#pragma unroll
        for (int jj = 0; jj < 3; ++jj) { const int j0 = jj * 64 + C.lane; const bool valid = (jj < 2 || C.lane == 0) && (j0 <= i);
            const int jc = valid ? j0 : 0;
            const bf16_t* kp = K + (size_t)(tok - jc * dl) * SGW + h * 64; float a = 0.f;
#pragma unroll
            for (int j = 0; j < 8; ++j) { const u32x4 w = *(const u32x4*)(kp + 8 * j);
                a += q[8 * j] * bflo(w.x) + q[8 * j + 1] * bfhi(w.x) + q[8 * j + 2] * bflo(w.y) + q[8 * j + 3] * bfhi(w.y) + q[8 * j + 4] * bflo(w.z) + q[8 * j + 5] * bfhi(w.z) + q[8 * j + 6] * bflo(w.w) + q[8 * j + 7] * bfhi(w.w); }
            s[jj] = valid ? (a - slope * (float)(dl * j0)) : -INFINITY; }
        const float mx = wave_max(fmaxf(fmaxf(s[0], s[1]), s[2]));
        float l = 0.f;
#pragma unroll
        for (int jj = 0; jj < 3; ++jj) { s[jj] = __expf(s[jj] - mx); l += s[jj]; }
        l = wave_sum(l);
        float acc = 0.f;
#pragma unroll
        for (int jj = 0; jj < 3; ++jj) { const int nm = (jj < 2) ? 64 : 1;
            for (int mm = 0; mm < nm; ++mm) { const int j0 = jj * 64 + mm; const int jc = (j0 <= i) ? j0 : 0;
                acc += __shfl(s[jj], mm) * bf1(V[(size_t)(tok - jc * dl) * SGW + h * 64 + C.lane]); } }
        OG[(size_t)tok * SGW + h * 64 + C.lane] = (bf16_t)f2bf(acc / l);
        if (C.lane == 0) LSE[tok * 12 + h] = mx + __logf(l);
    }
}
typedef short bf16x8 __attribute__((ext_vector_type(8)));
typedef short s16x4 __attribute__((ext_vector_type(4)));
constexpr int AT_KS = 144, AT_VS = 160, AT_ROWS = 272, AT_K_OFF = 0, AT_V_OFF = AT_ROWS * AT_KS;
static_assert(AT_V_OFF % 16 == 0 && AT_V_OFF + AT_ROWS * AT_VS <= 131072, "attention LDS map");

template <int NKB, bool DIL>
__device__ __forceinline__ void attn_compute(LAS unsigned char* lds, int lane, int krow0, bf16x8 qf0, bf16x8 qf1, float sdl, int ikw, f32x4 (&o)[4], float& mx, float& lsum) {
    const int n = lane & 15, g = lane >> 4;
    const LAS unsigned char* Kb = lds + AT_K_OFF + (krow0 + n) * AT_KS + g * 16;
    f32x4 sc[NKB];
#pragma unroll
    for (int kb = 0; kb < NKB; ++kb) {
        const bf16x8 k0 = *(const LAS bf16x8*)(Kb + kb * 16 * AT_KS), k1 = *(const LAS bf16x8*)(Kb + kb * 16 * AT_KS + 64);
        f32x4 a = (f32x4){0.f, 0.f, 0.f, 0.f};
        a = __builtin_amdgcn_mfma_f32_16x16x32_bf16(k0, qf0, a, 0, 0, 0);
        a = __builtin_amdgcn_mfma_f32_16x16x32_bf16(k1, qf1, a, 0, 0, 0);
        sc[kb] = a;
    }
    float m = -INFINITY;
#pragma unroll
    for (int kb = 0; kb < NKB; ++kb)
#pragma unroll
        for (int r = 0; r < 4; ++r) {
            if (DIL) { const int off = 16 * kb + 4 * g + r, rel = 144 + n - off; const bool valid = (rel >= 0) && (rel <= 128) && (ikw + off >= 0);
                sc[kb][r] = valid ? (sc[kb][r] - sdl * (float)rel) : -INFINITY; }
            m = fmaxf(m, sc[kb][r]); }
    m = fmaxf(m, __shfl_xor(m, 16)); m = fmaxf(m, __shfl_xor(m, 32));
    float l = 0.f;
#pragma unroll
    for (int kb = 0; kb < NKB; ++kb)
#pragma unroll
        for (int r = 0; r < 4; ++r) { sc[kb][r] = __expf(sc[kb][r] - m); l += sc[kb][r]; }
    l += __shfl_xor(l, 16); l += __shfl_xor(l, 32);
    mx = m; lsum = l;
    const LAS unsigned char* Vb = lds + AT_V_OFF + (krow0 + 4 * g + (n >> 2)) * AT_VS + (n & 3) * 8;
#pragma unroll
    for (int db = 0; db < 4; ++db) o[db] = (f32x4){0.f, 0.f, 0.f, 0.f};
#pragma unroll
    for (int kk = 0; kk < NKB / 2; ++kk) {
        union { bf16x8 v; unsigned u[4]; } pf;
        pf.u[0] = cvt_pk_bf16(sc[2 * kk][0], sc[2 * kk][1]); pf.u[1] = cvt_pk_bf16(sc[2 * kk][2], sc[2 * kk][3]);
        pf.u[2] = cvt_pk_bf16(sc[2 * kk + 1][0], sc[2 * kk + 1][1]); pf.u[3] = cvt_pk_bf16(sc[2 * kk + 1][2], sc[2 * kk + 1][3]);
#pragma unroll
        for (int db = 0; db < 4; ++db) {
            const s16x4 v0 = __builtin_amdgcn_ds_read_tr16_b64_v4i16((LAS s16x4*)(Vb + (2 * kk) * 16 * AT_VS + db * 32));
            const s16x4 v1 = __builtin_amdgcn_ds_read_tr16_b64_v4i16((LAS s16x4*)(Vb + (2 * kk + 1) * 16 * AT_VS + db * 32));
            const bf16x8 vf = __builtin_shufflevector(v0, v1, 0, 1, 2, 3, 4, 5, 6, 7);
            o[db] = __builtin_amdgcn_mfma_f32_16x16x32_bf16(vf, pf.v, o[db], 0, 0, 0);
        }
    }
}

__device__ __forceinline__ void memattn_mfma(const Ctx& C, const bf16_t* QM, const bf16_t* MKV, int ck, int cv, bf16_t* OUT, int ldo, int coff) {
    const int n = C.lane & 15, g = C.lane >> 4;
    for (int unit = C.vb; unit < NB * 4 * 8; unit += C.G) {
        const int b = unit >> 5, h = (unit >> 3) & 3, qp = unit & 7;
        __syncthreads();
#pragma unroll
        for (int it = 0; it < 4; ++it) { const int row = it * 64 + (C.tid >> 3), c = C.tid & 7;
            const bf16_t* src = MKV + (size_t)(b * NMEM + row) * 1024 + h * 64 + c * 8;
            const u32x4 kv = *(const u32x4*)(src + ck), vv = *(const u32x4*)(src + cv);
            *(LAS u32x4*)(C.lds + AT_K_OFF + row * AT_KS + c * 16) = kv; *(LAS u32x4*)(C.lds + AT_V_OFF + row * AT_VS + c * 16) = vv; }
        bf16x8 qf[2][2];
#pragma unroll
        for (int t = 0; t < 2; ++t) { const bf16_t* qp_ = QM + (size_t)(b * SEQ + (qp * 2 + t) * 128 + C.wave * 16 + n) * 256 + h * 64 + g * 8; qf[t][0] = *(const bf16x8*)qp_; qf[t][1] = *(const bf16x8*)(qp_ + 32); }
        __syncthreads();
#pragma unroll
        for (int t = 0; t < 2; ++t) {
            const int tok = b * SEQ + (qp * 2 + t) * 128 + C.wave * 16 + n;
            f32x4 o[4]; float mx, l;
            attn_compute<16, false>(C.lds, C.lane, 0, qf[t][0], qf[t][1], 0.f, 0, o, mx, l);
            const float inv = 1.0f / l;
#pragma unroll
            for (int db = 0; db < 4; ++db)
                *(u32x2*)(OUT + (size_t)tok * ldo + coff + h * 64 + 16 * db + 4 * g) = (u32x2){cvt_pk_bf16(o[db][0] * inv, o[db][1] * inv), cvt_pk_bf16(o[db][2] * inv, o[db][3] * inv)};
        }
    }
}
__device__ __forceinline__ void dilattn_mfma(const Ctx& C) {
    const bf16_t* Q = (const bf16_t*)(C.ws + WS_Q); const bf16_t* K = (const bf16_t*)(C.ws + WS_K); const bf16_t* V = (const bf16_t*)(C.ws + WS_V);
    bf16_t* OG = (bf16_t*)(C.ws + WS_OG); float* LSE = (float*)(C.ws + WS_LSE);
    const int n = C.lane & 15, g = C.lane >> 4;
    for (int unit = C.vb; unit < 12 * 128; unit += C.G) {
        const int h = unit >> 7, rem = unit & 127, b = rem >> 4, x = rem & 15, grp = h >> 2;
        const int dl = (grp == 0) ? 1 : (grp == 1 ? 4 : 16), ntile = 16 / dl, r = x / ntile, I0 = (x % ntile) * 128;
        const float sdl = exp2f(-(float)(h + 1) * (8.0f / 12.0f)) * (float)dl;
        __syncthreads();
        { u32x4 kv[5], vv[5];
#pragma unroll
          for (int it = 0; it < 5; ++it) { const int idx = it * NTHREADS + C.tid, row = idx >> 3, c = idx & 7, ik = I0 - 144 + row;
              kv[it] = (u32x4){0u, 0u, 0u, 0u}; vv[it] = (u32x4){0u, 0u, 0u, 0u};
              if (idx < AT_ROWS * 8 && ik >= 0) { const size_t off = (size_t)(b * SEQ + ik * dl + r) * SGW + h * 64 + c * 8; kv[it] = *(const u32x4*)(K + off); vv[it] = *(const u32x4*)(V + off); } }
#pragma unroll
          for (int it = 0; it < 5; ++it) { const int idx = it * NTHREADS + C.tid, row = idx >> 3, c = idx & 7;
              if (idx < AT_ROWS * 8) { *(LAS u32x4*)(C.lds + AT_K_OFF + row * AT_KS + c * 16) = kv[it]; *(LAS u32x4*)(C.lds + AT_V_OFF + row * AT_VS + c * 16) = vv[it]; } } }
        const int iq = I0 + C.wave * 16 + n, tok = b * SEQ + iq * dl + r;
        const bf16_t* qp = Q + (size_t)tok * SGW + h * 64 + g * 8;
        const bf16x8 qf0 = *(const bf16x8*)qp, qf1 = *(const bf16x8*)(qp + 32);
        __syncthreads();
        f32x4 o[4]; float mx, l;
        attn_compute<10, true>(C.lds, C.lane, C.wave * 16, qf0, qf1, sdl, I0 + C.wave * 16 - 144, o, mx, l);
        const float inv = 1.0f / l;
#pragma unroll
        for (int db = 0; db < 4; ++db)
            *(u32x2*)(OG + (size_t)tok * SGW + h * 64 + 16 * db + 4 * g) = (u32x2){cvt_pk_bf16(o[db][0] * inv, o[db][1] * inv), cvt_pk_bf16(o[db][2] * inv, o[db][3] * inv)};
        if (g == 0) LSE[tok * 12 + h] = mx + __logf(l);
    }
}
constexpr int SG_GVN_OFF = 1024, SG_VS = 160, SG_TILE = 128 * SG_VS, SG_GB_OFF = SG_GVN_OFF + 6 * SG_TILE;
static_assert(SG_GB_OFF + 2 * 384 * 4 <= 131072, "spatial-gating LDS map");
__device__ __forceinline__ void sg_mfma(const Ctx& C, const Args& A) {
    const bf16_t* U = (const bf16_t*)(C.ws + WS_U); const bf16_t* GV = (const bf16_t*)(C.ws + WS_GV); bf16_t* CAT = (bf16_t*)(C.ws + WS_CAT);
    const bf16_t* WB = (const bf16_t*)(C.ws + WS_SGWB); const float* RS = (const float*)(C.ws + WS_SGRS);
    const float* lng = A.in[4]; const float* lnb = A.in[5]; const float* sgb = A.in[7];
    LAS float* stat = (LAS float*)C.lds; LAS float* gbl = (LAS float*)(C.lds + SG_GB_OFF);
    const int n = C.lane & 15, gl = C.lane >> 4;
    for (int unit = C.vb; unit < NB * 16 * 2; unit += C.G) {
        const int tb = (unit >> 1) * 128, g0 = (unit & 1) * 6;
        __syncthreads();
        u32x4 wt[12];
#pragma unroll
        for (int k = 0; k < 12; ++k) { const int rg = k * 64 + (C.tid >> 3), gi = rg >> 7, row = rg & 127, c = C.tid & 7;
            wt[k] = *(const u32x4*)(GV + (size_t)(tb + row) * SGW + (g0 + gi) * 64 + c * 8); }
        if (C.tid < 192) { const int half = C.tid / 96, i4 = C.tid % 96; *(LAS f32x4*)(gbl + half * 384 + 4 * i4) = *(const f32x4*)((half ? lnb : lng) + g0 * 64 + 4 * i4); }
        for (int r8 = 0; r8 < 16; r8 += 8) {
            u32x2 w[8][3];
#pragma unroll
            for (int q = 0; q < 8; ++q)
#pragma unroll
                for (int j = 0; j < 3; ++j) w[q][j] = *(const u32x2*)(GV + (size_t)(tb + C.wave * 16 + r8 + q) * SGW + 4 * C.lane + 256 * j);
#pragma unroll
            for (int q = 0; q < 8; ++q) { float s = 0.f, ss = 0.f;
#pragma unroll
                for (int j = 0; j < 3; ++j) { const float a = bflo(w[q][j].x), b = bfhi(w[q][j].x), c = bflo(w[q][j].y), d = bfhi(w[q][j].y);
                    s += (a + b) + (c + d); ss += (a * a + b * b) + (c * c + d * d); }
                s = wave_sum_dpp(s); ss = wave_sum_dpp(ss);
                const float mean = s * (1.f / SGW), var = ss * (1.f / SGW) - mean * mean; const int row = C.wave * 16 + r8 + q;
                if (C.lane == 0) { stat[row * 2] = mean; stat[row * 2 + 1] = 1.0f / sqrtf(var + LN_EPS); } } }
        __syncthreads();
#pragma unroll
        for (int k = 0; k < 12; ++k) { const int rg = k * 64 + (C.tid >> 3), gi = rg >> 7, row = rg & 127, c = C.tid & 7;
            const float mean = stat[row * 2], rstd = stat[row * 2 + 1]; u32x4 o;
            o.x = cvt_pk_bf16((bflo(wt[k].x) - mean) * rstd, (bfhi(wt[k].x) - mean) * rstd); o.y = cvt_pk_bf16((bflo(wt[k].y) - mean) * rstd, (bfhi(wt[k].y) - mean) * rstd);
            o.z = cvt_pk_bf16((bflo(wt[k].z) - mean) * rstd, (bfhi(wt[k].z) - mean) * rstd); o.w = cvt_pk_bf16((bflo(wt[k].w) - mean) * rstd, (bfhi(wt[k].w) - mean) * rstd);
            *(LAS u32x4*)(C.lds + SG_GVN_OFF + gi * SG_TILE + row * SG_VS + c * 16) = o; }
        __syncthreads();
        const int p = C.wave * 16 + n;
#pragma unroll 3
        for (int gi = 0; gi < 6; ++gi) {
            const int g = g0 + gi;
            const bf16_t* wp = WB + (size_t)(g * 128 + p) * 128 + 8 * gl;
            bf16x8 wf[4];
#pragma unroll
            for (int ks = 0; ks < 4; ++ks) wf[ks] = *(const bf16x8*)(wp + 32 * ks);
            u32x2 uw[4];
#pragma unroll
            for (int db = 0; db < 4; ++db) uw[db] = *(const u32x2*)(U + (size_t)(tb + p) * SGW + (size_t)g * 64 + 16 * db + 4 * gl);
            const float bs = sgb[g * 128 + p], rsw = RS[g * 128 + p];
            f32x4 acc[4];
#pragma unroll
            for (int db = 0; db < 4; ++db) acc[db] = (f32x4){0.f, 0.f, 0.f, 0.f};
            const LAS unsigned char* vb = C.lds + SG_GVN_OFF + gi * SG_TILE + (8 * gl + (n >> 2)) * SG_VS + (n & 3) * 8;
#pragma unroll
            for (int ks = 0; ks < 4; ++ks)
#pragma unroll
                for (int db = 0; db < 4; ++db) {
                    const s16x4 v0 = __builtin_amdgcn_ds_read_tr16_b64_v4i16((LAS s16x4*)(vb + ks * 32 * SG_VS + db * 32));
                    const s16x4 v1 = __builtin_amdgcn_ds_read_tr16_b64_v4i16((LAS s16x4*)(vb + ks * 32 * SG_VS + 4 * SG_VS + db * 32));
                    const bf16x8 vf = __builtin_shufflevector(v0, v1, 0, 1, 2, 3, 4, 5, 6, 7);
                    acc[db] = __builtin_amdgcn_mfma_f32_16x16x32_bf16(vf, wf[ks], acc[db], 0, 0, 0);
                }
#pragma unroll
            for (int db = 0; db < 4; ++db) { const int cl = gi * 64 + 16 * db + 4 * gl; const size_t co = (size_t)g * 64 + 16 * db + 4 * gl;
                const f32x4 ga = *(const LAS f32x4*)(gbl + cl), be = *(const LAS f32x4*)(gbl + 384 + cl);
                const float s0 = ga[0] * acc[db][0] + (be[0] * rsw + bs), s1 = ga[1] * acc[db][1] + (be[1] * rsw + bs);
                const float s2 = ga[2] * acc[db][2] + (be[2] * rsw + bs), s3 = ga[3] * acc[db][3] + (be[3] * rsw + bs);
                *(u32x2*)(CAT + (size_t)(tb + p) * D + co) = (u32x2){cvt_pk_bf16(bflo(uw[db].x) * s0, bfhi(uw[db].x) * s1), cvt_pk_bf16(bflo(uw[db].y) * s2, bfhi(uw[db].y) * s3)}; }
        }
    }
}
__device__ __forceinline__ void dil_merge(const Ctx& C, const Args& A) {
    const bf16_t* OG = (const bf16_t*)(C.ws + WS_OG); const float* LSE = (const float*)(C.ws + WS_LSE); bf16_t* CAT2 = (bf16_t*)(C.ws + WS_CAT2);
    const int gt = C.bid * NTHREADS + C.tid, NT = C.G * NTHREADS;
    for (int it = gt; it < T * 32; it += NT) {
        const int tok = it >> 5, j = (it >> 3) & 3, c8 = it & 7;
        const float l0 = LSE[tok * 12 + j], l1 = LSE[tok * 12 + 4 + j], l2 = LSE[tok * 12 + 8 + j];
        const float mx = fmaxf(l0, fmaxf(l1, l2));
        float w0 = __expf(l0 - mx), w1 = __expf(l1 - mx), w2 = __expf(l2 - mx); const float inv = 1.0f / (w0 + w1 + w2); w0 *= inv; w1 *= inv; w2 *= inv;
        const u32x4 a = *(const u32x4*)(OG + (size_t)tok * SGW + j * 64 + c8 * 8), b = *(const u32x4*)(OG + (size_t)tok * SGW + (4 + j) * 64 + c8 * 8), c = *(const u32x4*)(OG + (size_t)tok * SGW + (8 + j) * 64 + c8 * 8);
        u32x4 o;
        o.x = pk2(w0 * bflo(a.x) + w1 * bflo(b.x) + w2 * bflo(c.x), w0 * bfhi(a.x) + w1 * bfhi(b.x) + w2 * bfhi(c.x));
        o.y = pk2(w0 * bflo(a.y) + w1 * bflo(b.y) + w2 * bflo(c.y), w0 * bfhi(a.y) + w1 * bfhi(b.y) + w2 * bfhi(c.y));
        o.z = pk2(w0 * bflo(a.z) + w1 * bflo(b.z) + w2 * bflo(c.z), w0 * bfhi(a.z) + w1 * bfhi(b.z) + w2 * bfhi(c.z));
        o.w = pk2(w0 * bflo(a.w) + w1 * bflo(b.w) + w2 * bflo(c.w), w0 * bfhi(a.w) + w1 * bfhi(b.w) + w2 * bfhi(c.w));
        *(u32x4*)(CAT2 + (size_t)tok * 512 + j * 64 + c8 * 8) = o;
    }
}

constexpr int LR_WS = 2064;
__device__ __forceinline__ void ln_route(const Ctx& C, const Args& A, int layer, int cset) {
    const bf16_t* Y = (const bf16_t*)(C.ws + WS_Y); bf16_t* X1B = (bf16_t*)(C.ws + WS_X1B); unsigned char* X1F8 = C.ws + WS_X1F8;
    const float* lg = A.in[14] + layer * D; const float* lb = A.in[15] + layer * D; const float* br = A.in[19];
    unsigned* cnt = (unsigned*)(C.ws + WS_CTL) + CW_CNT + cset * 16 * 64;
    int* tokE = (int*)(C.ws + WS_TOKE); int* tokP = (int*)(C.ws + WS_TOKP); float* tokG = (float*)(C.ws + WS_TOKG); int* list = (int*)(C.ws + WS_LIST);
    LAS unsigned char* wl = C.lds;
    LAS int* sE = (LAS int*)(C.lds + 65536); LAS float* sG = (LAS float*)(C.lds + 65536 + 512); LAS int* sPos = (LAS int*)(C.lds + 65536 + 1024);
    LAS int* lcnt = (LAS int*)(C.lds + 65536 + 1536); LAS int* lbase = (LAS int*)(C.lds + 65536 + 1600); LAS float* slog = (LAS float*)(C.lds + 65536 + 2048);
    __syncthreads();
#pragma unroll
    for (int it = 0; it < 4; ++it) { const int i = it * NTHREADS + C.tid, e = i >> 7, c = i & 127;
        *(LAS u32x4*)(wl + e * LR_WS + c * 16) = *(const u32x4*)((const bf16_t*)(C.ws + WS_WRT) + (size_t)e * 1024 + c * 8); }
    f32x4 g4[4], b4[4];
#pragma unroll
    for (int j = 0; j < 4; ++j) { g4[j] = *(const f32x4*)(lg + 4 * C.lane + 256 * j); b4[j] = *(const f32x4*)(lb + 4 * C.lane + 256 * j); }
    const int n = C.lane & 15, q = C.lane >> 4;
    for (int blk = C.bid; blk < T / 64; blk += C.G) {
        __syncthreads();
        if (C.tid < 16) lcnt[C.tid] = 0;
        u32x2 nv[4];
        { const u32x2* yb = (const u32x2*)(Y + (size_t)(blk * 64 + C.wave * 8) * D) + C.lane;
#pragma unroll
          for (int j = 0; j < 4; ++j) nv[j] = yb[64 * j]; }
#pragma unroll 1
        for (int tq = 0; tq < 8; ++tq) {
            const int tok = blk * 64 + C.wave * 8 + tq;
            f32x4 v[4]; float s = 0.f;
#pragma unroll
            for (int j = 0; j < 4; ++j) { v[j] = (f32x4){bflo(nv[j].x), bfhi(nv[j].x), bflo(nv[j].y), bfhi(nv[j].y)}; s += (v[j][0] + v[j][1]) + (v[j][2] + v[j][3]); }
            { const u32x2* yb = (const u32x2*)(Y + (size_t)(tok + (tq < 7 ? 1 : 0)) * D) + C.lane;
#pragma unroll
              for (int j = 0; j < 4; ++j) nv[j] = yb[64 * j]; }
            const float mean = wave_sum_dpp(s) * (1.f / D); float s2 = 0.f;
#pragma unroll
            for (int j = 0; j < 4; ++j) { v[j] = v[j] - mean; s2 += (v[j][0] * v[j][0] + v[j][1] * v[j][1]) + (v[j][2] * v[j][2] + v[j][3] * v[j][3]); }
            const float rstd = 1.0f / sqrtf(wave_sum_dpp(s2) * (1.f / D) + LN_EPS);
            u32x2* xb = (u32x2*)(X1B + (size_t)tok * D) + C.lane; unsigned* x8 = (unsigned*)(X1F8 + (size_t)tok * D) + C.lane;
#pragma unroll
            for (int j = 0; j < 4; ++j) { v[j] = v[j] * rstd * g4[j] + b4[j];
                xb[64 * j] = (u32x2){pk2(v[j][0], v[j][1]), pk2(v[j][2], v[j][3])};
                x8[64 * j] = pk4_fp8(v[j][0], v[j][1], v[j][2], v[j][3]); }
        }
        asm volatile("s_waitcnt vmcnt(0)" ::: "memory");
        __syncthreads();
        {
            const int tile = C.wave & 3, kh = C.wave >> 2;
            const bf16_t* ap = X1B + (size_t)(blk * 64 + tile * 16 + n) * D + kh * 512 + 8 * q;
            const LAS unsigned char* bp = wl + n * LR_WS + (kh * 512 + 8 * q) * 2;
            bf16x8 af[16];
#pragma unroll
            for (int ks = 0; ks < 16; ++ks) af[ks] = *(const bf16x8*)(ap + 32 * ks);
            f32x4 acc = (f32x4){0.f, 0.f, 0.f, 0.f};
#pragma unroll
            for (int ks = 0; ks < 16; ++ks) { const bf16x8 bf = *(const LAS bf16x8*)(bp + 64 * ks); acc = __builtin_amdgcn_mfma_f32_16x16x32_bf16(af[ks], bf, acc, 0, 0, 0); }
#pragma unroll
            for (int r = 0; r < 4; ++r) slog[(kh * 64 + tile * 16 + 4 * q + r) * 17 + n] = acc[r];
        }
        __syncthreads();
        if (C.tid < 64) {
            const int tl = C.tid;
            float pr[16]; float mx = -INFINITY;
#pragma unroll
            for (int e = 0; e < 16; ++e) { pr[e] = slog[tl * 17 + e] + slog[(64 + tl) * 17 + e]; mx = fmaxf(mx, pr[e]); }
            float sum = 0.f;
#pragma unroll
            for (int e = 0; e < 16; ++e) { pr[e] = __expf(pr[e] - mx); sum += pr[e]; }
            const float inv = 1.0f / sum; float sel[16];
#pragma unroll
            for (int e = 0; e < 16; ++e) { pr[e] *= inv; sel[e] = pr[e] + br[e]; }
            float gs[4];
#pragma unroll
            for (int g = 0; g < 4; ++g) { const float a = sel[4 * g], b = sel[4 * g + 1], c = sel[4 * g + 2], d = sel[4 * g + 3];
                gs[g] = fmaxf(fmaxf(fmaxf(a + b, a + c), fmaxf(a + d, b + c)), fmaxf(b + d, c + d)); }
            int gi = 0; float bsc = gs[0];
#pragma unroll
            for (int g = 1; g < 4; ++g) if (gs[g] > bsc) { bsc = gs[g]; gi = g; }
            float sg[4], pg[4];
#pragma unroll
            for (int k = 0; k < 4; ++k) { sg[k] = gi == 0 ? sel[k] : (gi == 1 ? sel[4 + k] : (gi == 2 ? sel[8 + k] : sel[12 + k])); pg[k] = gi == 0 ? pr[k] : (gi == 1 ? pr[4 + k] : (gi == 2 ? pr[8 + k] : pr[12 + k])); }
            int i1 = 0; float b1 = sg[0], p1 = pg[0];
#pragma unroll
            for (int k = 1; k < 4; ++k) if (sg[k] > b1) { b1 = sg[k]; i1 = k; p1 = pg[k]; }
            int i2 = -1; float b2 = -INFINITY, p2 = 0.f;
#pragma unroll
            for (int k = 0; k < 4; ++k) if (k != i1 && sg[k] > b2) { b2 = sg[k]; i2 = k; p2 = pg[k]; }
            const float gsum = p1 + p2; sE[tl * 2] = gi * 4 + i1; sE[tl * 2 + 1] = gi * 4 + i2; sG[tl * 2] = p1 / gsum; sG[tl * 2 + 1] = p2 / gsum;
        }
        __syncthreads();
        if (C.tid < 128) sPos[C.tid] = __hip_atomic_fetch_add(lcnt + sE[C.tid], 1, __ATOMIC_RELAXED, __HIP_MEMORY_SCOPE_WORKGROUP);
        __syncthreads();
        if (C.tid < 16) lbase[C.tid] = (int)__hip_atomic_fetch_add(cnt + C.tid * 64, (unsigned)lcnt[C.tid], __ATOMIC_RELAXED, __HIP_MEMORY_SCOPE_AGENT);
        __syncthreads();
        if (C.tid < 128) { const int e = sE[C.tid], pos = lbase[e] + sPos[C.tid], tok = blk * 64 + (C.tid >> 1);
            list[e * LISTCAP + pos] = tok; tokE[tok * 2 + (C.tid & 1)] = e; tokP[tok * 2 + (C.tid & 1)] = pos; tokG[tok * 2 + (C.tid & 1)] = sG[C.tid]; }
    }
}
__device__ __forceinline__ void moe_prefix(const Ctx& C, int layer) {
    LAS int* mi = (LAS int*)(C.lds + LDS_MISC);
    unsigned* cnt = (unsigned*)(C.ws + WS_CTL) + CW_CNT + layer * 16 * 64;
    __syncthreads();
    if (C.tid < 16) mi[17 + C.tid] = (int)__hip_atomic_load(cnt + C.tid * 64, __ATOMIC_RELAXED, __HIP_MEMORY_SCOPE_AGENT);
    __syncthreads();
    if (C.tid == 0) { int a = 0; for (int e = 0; e < 16; ++e) { mi[e] = a; a += (mi[17 + e] + 255) >> 8; } mi[16] = a; }
    __syncthreads();
}
__device__ __forceinline__ void moe_tokens(const Ctx& C, int ntn) {
    const LAS int* mi = (const LAS int*)(C.lds + LDS_MISC); LAS int* toks = (LAS int*)(C.lds + LDS_TOKS);
    const int* list = (const int*)(C.ws + WS_LIST);
    const int total = mi[16] * ntn;
    int tv[4]; bool ok[4];
#pragma unroll
    for (int k = 0; k < 4; ++k) {
        const int idx = k * NTHREADS + C.tid, u = idx >> 8, rr = idx & 255, L = u * C.G + (((C.G & 7) == 0) ? (C.bid & 7) * (C.G >> 3) + (C.bid >> 3) : C.bid); ok[k] = L < total;
        const int Lc = ok[k] ? L : 0; int e = 0;
#pragma unroll
        for (int j = 1; j < 16; ++j) e += (Lc >= mi[j] * ntn) ? 1 : 0;
        const int r = Lc - mi[e] * ntn, te = mi[e + 1] - mi[e], mt = r / ntn, cn = mi[17 + e]; (void)te;
        int pos = mt * 256 + rr; pos = pos < cn ? pos : cn - 1; pos = pos < 0 ? 0 : pos;
        tv[k] = list[e * LISTCAP + pos];
    }
#pragma unroll
    for (int k = 0; k < 4; ++k) if (ok[k]) toks[k * NTHREADS + C.tid] = tv[k];
    __syncthreads();
}
__device__ __forceinline__ void combine_ln2(const Ctx& C, const Args& A, int layer) {
    const LAS int* mi = (const LAS int*)(C.lds + LDS_MISC);
    const bf16_t* X1B = (const bf16_t*)(C.ws + WS_X1B); const bf16_t* YD = (const bf16_t*)(C.ws + WS_YD); bf16_t* X2B = (bf16_t*)(C.ws + WS_XB);
    const int* tokE = (const int*)(C.ws + WS_TOKE); const int* tokP = (const int*)(C.ws + WS_TOKP); const float* tokG = (const float*)(C.ws + WS_TOKG);
    const float* lg = A.in[16] + layer * D; const float* lb = A.in[17] + layer * D;
    for (int tok0 = C.gw * 8; tok0 < T; tok0 += C.NGW * 8) {
        int rowv = 0; float gv = 0.f;
        if (C.lane < 16) { const int e = tokE[tok0 * 2 + C.lane]; rowv = mi[e] * 256 + tokP[tok0 * 2 + C.lane]; gv = tokG[tok0 * 2 + C.lane]; }
#pragma unroll 1
        for (int tq = 0; tq < 8; tq += 4) {
            u32x2 xa[4][4], y0[4][4], y1[4][4]; float g0[4], g1[4];
#pragma unroll
            for (int t = 0; t < 4; ++t) {
                const int ra = __shfl(rowv, 2 * (tq + t)), rb = __shfl(rowv, 2 * (tq + t) + 1);
                g0[t] = __shfl(gv, 2 * (tq + t)); g1[t] = __shfl(gv, 2 * (tq + t) + 1);
                const u32x2* xp = (const u32x2*)(X1B + (size_t)(tok0 + tq + t) * D) + C.lane; const u32x2* pa = (const u32x2*)(YD + (size_t)ra * D) + C.lane; const u32x2* pb = (const u32x2*)(YD + (size_t)rb * D) + C.lane;
#pragma unroll
                for (int j = 0; j < 4; ++j) { xa[t][j] = xp[64 * j]; y0[t][j] = pa[64 * j]; y1[t][j] = pb[64 * j]; }
            }
#pragma unroll
            for (int t = 0; t < 4; ++t) {
                f32x4 v[4]; float s = 0.f;
#pragma unroll
                for (int j = 0; j < 4; ++j) {
                    v[j][0] = ALPHA * bflo(xa[t][j].x) + (g0[t] * bflo(y0[t][j].x) + g1[t] * bflo(y1[t][j].x)); v[j][1] = ALPHA * bfhi(xa[t][j].x) + (g0[t] * bfhi(y0[t][j].x) + g1[t] * bfhi(y1[t][j].x));
                    v[j][2] = ALPHA * bflo(xa[t][j].y) + (g0[t] * bflo(y0[t][j].y) + g1[t] * bflo(y1[t][j].y)); v[j][3] = ALPHA * bfhi(xa[t][j].y) + (g0[t] * bfhi(y0[t][j].y) + g1[t] * bfhi(y1[t][j].y));
                    s += (v[j][0] + v[j][1]) + (v[j][2] + v[j][3]); }
                const float mean = wave_sum_dpp(s) * (1.f / D); float s2 = 0.f;
#pragma unroll
                for (int j = 0; j < 4; ++j) { v[j] = v[j] - mean; s2 += (v[j][0] * v[j][0] + v[j][1] * v[j][1]) + (v[j][2] * v[j][2] + v[j][3] * v[j][3]); }
                const float rstd = 1.0f / sqrtf(wave_sum_dpp(s2) * (1.f / D) + LN_EPS);
                const int tok = tok0 + tq + t;
#pragma unroll
                for (int j = 0; j < 4; ++j) { const int col = 4 * C.lane + 256 * j; const f32x4 g4 = *(const f32x4*)(lg + col), b4 = *(const f32x4*)(lb + col);
                    const f32x4 o = v[j] * rstd * g4 + b4;
                    if (layer == 0) *(u32x2*)(X2B + (size_t)tok * D + col) = (u32x2){pk2(o[0], o[1]), pk2(o[2], o[3])};
                    else *(f32x4*)(A.out + (size_t)tok * D + col) = o; }
            }
        }
    }
}

__global__ void __launch_bounds__(NTHREADS, 2) yoco_fwd(Args args) {
    extern __shared__ __attribute__((aligned(16))) unsigned char lds_raw[];
    Ctx C;
    C.ws = args.ws; C.lds = (LAS unsigned char*)lds_raw;
    C.tid = threadIdx.x; C.lane = C.tid & 63; C.wave = __builtin_amdgcn_readfirstlane(C.tid >> 6);
    C.G = gridDim.x; C.bid = blockIdx.x; C.gw = C.bid * NWAVES + C.wave; C.NGW = C.G * NWAVES;
    C.vb = ((C.G & 7) == 0) ? (C.bid & 7) * (C.G >> 3) + (C.bid >> 3) : C.bid;
    unsigned char* ws = args.ws;
#define PHASE_WS() do { ws = launder(args.ws); C.ws = ws; C.tid = launder_v((int)threadIdx.x); C.lane = C.tid & 63; } while (0)
    volatile LAS unsigned* misc = (volatile LAS unsigned*)(C.lds + LDS_MISC);
    for (int u = C.tid; u < 64; u += NTHREADS) misc[u] = 0u;
    __syncthreads();
    XcdBarrier bar; bar.bar = (unsigned*)(ws + WS_CTL) + CW_BAR; bar.x = 0; bar.st = misc + 60;
    const int lo = args.ph_lo, hi = args.ph_hi;
    if (hi - lo > 1) bar = xcd_barrier_post((unsigned*)(ws + WS_CTL) + CW_BAR, misc + 60);
#define IN(k) (lo <= (k) && (k) < hi)
#define SEAMF(k) do { if (IN(k) && IN((k) + 1)) { PHASE_WS(); fill_tail(C, args, (k), false); xcd_barrier(bar); } } while (0)
#if MK_DIAG == 9
#define SEAM(k) do { if (IN(k) && IN((k) + 1)) { const unsigned long long t0_ = __builtin_amdgcn_s_memrealtime(); xcd_barrier(bar); if (((MK_DIAGMASK >> (k)) & 1) && threadIdx.x == 0) diag_acc += (unsigned)(__builtin_amdgcn_s_memrealtime() - t0_); } } while (0)
#else
#define SEAM(k) do { if (IN(k) && IN((k) + 1)) xcd_barrier(bar); } while (0)
#endif
#ifndef MK_DUP
#define MK_DUP 0
#endif
    unsigned diag_acc = 0;
#if MK_DIAG == 10
#define TREG(id, ...) do { __syncthreads(); const unsigned long long t0_ = __builtin_amdgcn_s_memrealtime(); __VA_ARGS__; __syncthreads(); if ((id) == MK_DIAGSEL) diag_acc += (unsigned)(__builtin_amdgcn_s_memrealtime() - t0_); } while (0)
#else
#define TREG(id, ...) do { __VA_ARGS__; } while (0)
#endif
#define REP(k) for (int rep_ = 0; rep_ < 1 + ((MK_DUP >> (k)) & 1); ++rep_)

    if (IN(0)) { REP(0) { PHASE_WS(); TREG(10, p0_prologue(C, args)); } SEAM(0); }

    if (IN(1)) {
        REP(1) {
        PHASE_WS();
        { pg8::Gemm g{(const bf16_t*)(ws + WS_XB), (const bf16_t*)(ws + WS_BT_INA), T, 1792, D}; pg8::StaticOrder S; S.init(T, 1792, C.G, C.bid);
          EpiProjA E{(bf16_t*)(ws + WS_U), (bf16_t*)(ws + WS_GV), (bf16_t*)(ws + WS_QM0)};
          pg8::gemm_phase<EpiProjA, pg8::StaticOrder>(C.lds, g, S, E, nullptr, C.tid); }
        { pg8::Gemm g{(const bf16_t*)(ws + WS_MEMB), (const bf16_t*)(ws + WS_BT_MEM), NB * NMEM, 1024, D}; SmallOrder S{4, 32, C.bid - (C.G - 32)};
          EpiPlain E{(bf16_t*)(ws + WS_MKV), 1024, 4};
          pg8::gemm_phase<EpiPlain, SmallOrder>(C.lds, g, S, E, nullptr, C.tid); }
        }
        SEAMF(1);
    }
    if (IN(2)) {
        REP(2) { PHASE_WS();
        TREG(1, sg_mfma(C, args));
        TREG(2, memattn_mfma(C, (const bf16_t*)(ws + WS_QM0), (const bf16_t*)(ws + WS_MKV), 0, 256, (bf16_t*)(ws + WS_CAT), D, SGW)); }
        SEAM(2);
    }
    if (IN(3)) {
        REP(3) { PHASE_WS();
        pg8::Gemm g{(const bf16_t*)(ws + WS_CAT), (const bf16_t*)(ws + WS_BT_OUTA), T, D, D}; pg8::StaticOrder S; S.init(T, D, C.G, C.bid);
        EpiResid<true> E{(const void*)(ws + WS_XB), (bf16_t*)(ws + WS_Y)};
        pg8::gemm_phase<EpiResid<true>, pg8::StaticOrder>(C.lds, g, S, E, nullptr, C.tid); }
        SEAM(3);
    }
    { constexpr int layer = 0;
        const int pb = 4 + 8 * layer;
        if (IN(pb)) { if ((MK_DUP >> 4) & 1) { PHASE_WS(); ln_route(C, args, layer, 2 + layer); __syncthreads(); } PHASE_WS(); TREG(6 + layer, ln_route(C, args, layer, layer)); SEAM(pb); }
        if (IN(pb + 1)) {
            REP(5) { PHASE_WS();
            moe_prefix(C, layer); moe_tokens(C, 8);
            MoeGatherOrder S; S.tb = (const LAS int*)(C.lds + LDS_MISC); S.ntn = 8; S.G = C.G; S.c = C.bid; S.toks = (const LAS int*)(C.lds + LDS_TOKS);
            {
                pg8::Gemm g{(const bf16_t*)(ws + WS_X1F8), (const bf16_t*)(ws + WS_WGU + (size_t)layer * (64 * MiB)), 0, 0, D / 2, E8_ONE, E8_W};
                EpiSwiGLU8 E{ws + WS_ACT};
#if MK_DUPNULL
                if (rep_ > 0) { EpiNull EN; pg8::gemm_phase<EpiNull, MoeGatherOrder, false, true>(C.lds, g, S, EN, nullptr, C.tid); } else
#endif
                pg8::gemm_phase<EpiSwiGLU8, MoeGatherOrder, false, true>(C.lds, g, S, E, nullptr, C.tid);
            } }
            SEAMF(pb + 1);
        }
        if (IN(pb + 2)) {
            REP(6) { PHASE_WS();
            moe_prefix(C, layer);
            MoeOrder S{(const LAS int*)(C.lds + LDS_MISC), 4, C.G, C.bid};
            EpiPlain E{(bf16_t*)(ws + WS_YD), 1024, 4};
            {
                pg8::Gemm g{(const bf16_t*)(ws + WS_ACT), (const bf16_t*)(ws + WS_WD + (size_t)layer * (32 * MiB)), 0, 0, D / 2, E8_ACT, E8_W};
                pg8::gemm_phase<EpiPlain, MoeOrder, false, true>(C.lds, g, S, E, nullptr, C.tid);
            } }
            SEAMF(pb + 2);
        }
        if (IN(pb + 3)) { REP(7) { PHASE_WS(); moe_prefix(C, layer); TREG(8 + layer, combine_ln2(C, args, layer)); } if (layer == 0) SEAM(pb + 3); }
    }
    {
            if (IN(8)) {
                REP(8) { PHASE_WS();
                pg8::Gemm g{(const bf16_t*)(ws + WS_XB), (const bf16_t*)(ws + WS_BT_B), T, 2560, D}; pg8::StaticOrder S; S.init(T, 2560, C.G, C.bid);
                EpiProjB E{(bf16_t*)(ws + WS_K), (bf16_t*)(ws + WS_V), (bf16_t*)(ws + WS_Q), (bf16_t*)(ws + WS_QM1)};
                pg8::gemm_phase<EpiProjB, pg8::StaticOrder>(C.lds, g, S, E, nullptr, C.tid); }
                SEAMF(8);
            }
            if (IN(9)) {
                REP(9) { PHASE_WS();
                TREG(3, dilattn_mfma(C));
                TREG(4, memattn_mfma(C, (const bf16_t*)(ws + WS_QM1), (const bf16_t*)(ws + WS_MKV), 512, 768, (bf16_t*)(ws + WS_CAT2), 512, 256)); }
                SEAM(9);
            }
            if (IN(10)) { REP(10) { PHASE_WS(); TREG(5, dil_merge(C, args)); } SEAM(10); }
            if (IN(11)) {
                REP(11) { PHASE_WS();
                pg8::Gemm g{(const bf16_t*)(ws + WS_CAT2), (const bf16_t*)(ws + WS_BT_OUTB), T, D, 512}; pg8::StaticOrder S; S.init(T, D, C.G, C.bid);
                EpiResid<true> E{(const void*)(ws + WS_XB), (bf16_t*)(ws + WS_Y)};
                pg8::gemm_phase<EpiResid<true>, pg8::StaticOrder>(C.lds, g, S, E, nullptr, C.tid); }
                if (IN(11)) { PHASE_WS(); fill_tail(C, args, 11, true); }
                SEAM(11);
            }
    }
    { constexpr int layer = 1;
        const int pb = 4 + 8 * layer;
        if (IN(pb)) { if ((MK_DUP >> 4) & 1) { PHASE_WS(); ln_route(C, args, layer, 2 + layer); __syncthreads(); } PHASE_WS(); TREG(6 + layer, ln_route(C, args, layer, layer)); SEAM(pb); }
        if (IN(pb + 1)) {
            REP(5) { PHASE_WS();
            moe_prefix(C, layer); moe_tokens(C, 8);
            MoeGatherOrder S; S.tb = (const LAS int*)(C.lds + LDS_MISC); S.ntn = 8; S.G = C.G; S.c = C.bid; S.toks = (const LAS int*)(C.lds + LDS_TOKS);
            {
                pg8::Gemm g{(const bf16_t*)(ws + WS_X1F8), (const bf16_t*)(ws + WS_WGU + (size_t)layer * (64 * MiB)), 0, 0, D / 2, E8_ONE, E8_W};
                EpiSwiGLU8 E{ws + WS_ACT};
#if MK_DUPNULL
                if (rep_ > 0) { EpiNull EN; pg8::gemm_phase<EpiNull, MoeGatherOrder, false, true>(C.lds, g, S, EN, nullptr, C.tid); } else
#endif
                pg8::gemm_phase<EpiSwiGLU8, MoeGatherOrder, false, true>(C.lds, g, S, E, nullptr, C.tid);
            } }
            SEAM(pb + 1);
        }
        if (IN(pb + 2)) {
            REP(6) { PHASE_WS();
            moe_prefix(C, layer);
            MoeOrder S{(const LAS int*)(C.lds + LDS_MISC), 4, C.G, C.bid};
            EpiPlain E{(bf16_t*)(ws + WS_YD), 1024, 4};
            {
                pg8::Gemm g{(const bf16_t*)(ws + WS_ACT), (const bf16_t*)(ws + WS_WD + (size_t)layer * (32 * MiB)), 0, 0, D / 2, E8_ACT, E8_W};
                pg8::gemm_phase<EpiPlain, MoeOrder, false, true>(C.lds, g, S, E, nullptr, C.tid);
            } }
            SEAM(pb + 2);
        }
        if (IN(pb + 3)) { REP(7) { PHASE_WS(); moe_prefix(C, layer); TREG(8 + layer, combine_ln2(C, args, layer)); } if (layer == 0) SEAM(pb + 3); }
    }
#if MK_DIAG == 3
    xcd_barrier(bar);
    if (blockIdx.x == 0 && threadIdx.x == 0) { const unsigned got = __hip_atomic_fetch_add((unsigned*)(args.ws + WS_CTL) + 30000, 0u, __ATOMIC_RELAXED, __HIP_MEMORY_SCOPE_AGENT); const unsigned long long t0 = __builtin_amdgcn_s_memrealtime();
        const unsigned long long dur = (unsigned long long)got * 4ull;
        while (__builtin_amdgcn_s_memrealtime() - t0 < dur) __builtin_amdgcn_s_sleep(8); }
#endif
#if MK_DIAG == 11
    if (blockIdx.x == 0 && threadIdx.x == 0) { const unsigned long long t0 = __builtin_amdgcn_s_memrealtime(); const unsigned long long dur = (unsigned long long)misc[42] * 4ull;
        while (__builtin_amdgcn_s_memrealtime() - t0 < dur) __builtin_amdgcn_s_sleep(8); }
#endif
#if MK_DIAG == 10
    if (blockIdx.x == 0 && threadIdx.x == 0) { const unsigned long long t0 = __builtin_amdgcn_s_memrealtime(); const unsigned long long dur = (unsigned long long)diag_acc * 4ull;
        while (__builtin_amdgcn_s_memrealtime() - t0 < dur) __builtin_amdgcn_s_sleep(8); }
#endif
#if MK_DIAG == 9
    if (threadIdx.x == 0) __hip_atomic_fetch_add((unsigned*)(args.ws + WS_CTL) + 30000, diag_acc, __ATOMIC_RELAXED, __HIP_MEMORY_SCOPE_AGENT);
    xcd_barrier(bar);
    if (blockIdx.x == 0 && threadIdx.x == 0) { const unsigned got = __hip_atomic_fetch_add((unsigned*)(args.ws + WS_CTL) + 30000, 0u, __ATOMIC_RELAXED, __HIP_MEMORY_SCOPE_AGENT); const unsigned long long t0 = __builtin_amdgcn_s_memrealtime();
        const unsigned long long dur = (unsigned long long)got / 256ull;
        while (__builtin_amdgcn_s_memrealtime() - t0 < dur) __builtin_amdgcn_s_sleep(8); }
#endif
#undef IN
#undef SEAM
}
}

extern "C" void kernel_launch(void* const* d_in, const int* in_sizes, int n_in, void* d_out, int out_size, void* d_ws, size_t ws_size, hipStream_t stream) {
    using namespace mk;
    static int grid = 0;
    if (grid == 0) {
        if (n_in != 23 || out_size != T * D || ws_size < WS_END) { fprintf(stderr, "kernel_launch: unexpected shapes (n_in %d, out %d, ws %zu)\n", n_in, out_size, ws_size); grid = -1; return; }
        int dev = 0, cus = 0, per_cu = 0;
        if (hipGetDevice(&dev) != hipSuccess || hipDeviceGetAttribute(&cus, hipDeviceAttributeMultiprocessorCount, dev) != hipSuccess) { grid = -1; return; }
        if (hipFuncSetAttribute((const void*)yoco_fwd, hipFuncAttributeMaxDynamicSharedMemorySize, LDS_BYTES) != hipSuccess) { fprintf(stderr, "kernel_launch: hipFuncSetAttribute failed\n"); grid = -1; return; }
        if (hipOccupancyMaxActiveBlocksPerMultiprocessor(&per_cu, (const void*)yoco_fwd, NTHREADS, LDS_BYTES) != hipSuccess || per_cu < 1)
            fprintf(stderr, "kernel_launch: occupancy query reports %d workgroups per CU\n", per_cu);
        (void)hipGetLastError();
        grid = cus;
    }
    if (grid < 0) return;
    (void)hipMemsetAsync((char*)d_ws + WS_CTL, 0, CTL_ZERO_BYTES, stream);
    Args a{};
    for (int i = 0; i < 23; ++i) a.in[i] = (const float*)d_in[i];
    a.out = (float*)d_out; a.ws = (unsigned char*)d_ws;
    constexpr int NL = MK_N_LAUNCHES;
    for (int li = 0; li < NL; ++li) {
        a.ph_lo = (NL == NPHASE) ? li : (li * NPHASE) / NL; a.ph_hi = (NL == NPHASE) ? li + 1 : ((li + 1) * NPHASE) / NL;
        hipLaunchKernelGGL(yoco_fwd, dim3(grid), dim3(NTHREADS), LDS_BYTES, stream, a);
    }
}
```

```cpp
#include <hip/hip_runtime.h>
#include <cstdio>
#include <cstdint>
namespace pg8 {
#define PG8_LAS __attribute__((address_space(3)))
typedef unsigned short bf16_t;
typedef short bf16x8 __attribute__((ext_vector_type(8)));
typedef float f32x4 __attribute__((ext_vector_type(4)));
typedef unsigned u32x4 __attribute__((ext_vector_type(4)));
constexpr int BM = 256, BK = 64, HALF = 128, HTB = HALF * BK * 2  , STAGE_BYTES = 8 * HTB, NXCD = 8, WGM = 4;

__host__ __device__ __forceinline__ int lds_byte(int r, int c) { const int st = (r >> 4) * 2 + (c >> 5), rr = r & 15, cc = c & 31, ob = rr * 64 + cc * 2; return st * 1024 + (ob ^ (((ob >> 9) & 1) << 5)); }
__host__ __device__ __forceinline__ void stage_rc(int b, int& R, int& C) { const int st = b / 1024, sb = b % 1024, swz = sb ^ (((sb >> 9) & 1) << 5); R = (st >> 1) * 16 + swz / 64; C = (st & 1) * 32 + (swz % 64) / 2; }
__host__ __device__ __forceinline__ int perm32(int rho) { const int n = rho >> 4, i = rho & 15; return 8 * (i >> 2) + 4 * n + (i & 3); }

struct Unit { int pm, pn; };
struct Gemm { const bf16_t* A; const bf16_t* Bt; int M, N, K; int sA, sB; };

struct StaticOrder {
    int nM, nN, nwg, G, c;
    __host__ __device__ void init(int M, int N, int G_, int c_) { nM = M / BM; nN = N / BM; nwg = nM * nN; G = G_; c = c_; }
    __host__ __device__ bool next(int i, Unit& u) const {
        const long L = (long)i * G + c; if (L >= nwg) return false;
        int wgid = (int)L; { const int q = nwg / NXCD, r = nwg % NXCD, xcd = wgid % NXCD, off = wgid / NXCD; wgid = (xcd < r ? xcd * (q + 1) : r * (q + 1) + (xcd - r) * q) + off; }
        const int nig = WGM * nN, gid = wgid / nig, fm = gid * WGM, gsz = (nM - fm) < WGM ? (nM - fm) : WGM;
        u.pm = fm + ((wgid % nig) % gsz); u.pn = (wgid % nig) / gsz; return true;
    }
    __device__ __forceinline__ void a_ready(const Unit&) const {}
    __device__ __forceinline__ void done(const Unit&) const {}
    __device__ __forceinline__ int arow(int, const Unit& u, int r) const { return u.pm * BM + r; }
};
__device__ __forceinline__ unsigned cvt_pk_bf16(float lo, float hi) { unsigned r; asm volatile("v_cvt_pk_bf16_f32 %0, %1, %2" : "=v"(r) : "v"(lo), "v"(hi)); return r; }
typedef float f32x2 __attribute__((ext_vector_type(2)));
__device__ __forceinline__ f32x2 gelu_pk(f32x2 v) {
    const f32x2 av = __builtin_elementwise_abs(v), d = av * 0.2316418882f + 1.0f;
    f32x2 t; t.x = __builtin_amdgcn_rcpf(d.x); t.y = __builtin_amdgcn_rcpf(d.y);
    f32x2 q = t * 0.5307027145f + (-0.7265760135f); q = q * t + 0.7107068705f; q = q * t + (-0.142248368f); q = q * t + 0.127414796f; q = q * t;
    const f32x2 s = (v * v) * (-0.72134752044f);
    f32x2 e; e.x = __builtin_amdgcn_exp2f(s.x); e.y = __builtin_amdgcn_exp2f(s.y);
    const f32x2 m = v * (q * e), r = v - m;
    f32x2 o; o.x = v.x < 0.f ? m.x : r.x; o.y = v.y < 0.f ? m.y : r.y; return o;
}
template <class Epi, class Sched, bool STAMP = false, bool F8 = false>
__device__ __forceinline__ void gemm_phase(PG8_LAS unsigned char* lds, const Gemm g, const Sched& S, const Epi& E, unsigned long long* stamps, const int tid) {
    const int wid = __builtin_amdgcn_readfirstlane(tid >> 6), lane = tid & 63, wr = wid >> 2, wc = wid & 3, fr = lane & 15, fq = lane >> 4;
    const int K = g.K, nt = K / BK;
    int ts_lo = 0, ts_hi = 0, nts = 0; const unsigned long long rt_entry = STAMP ? (unsigned long long)wall_clock64() : 0ull;
#define PG8_STAMP() do { if (STAMP && wid == 0 && nts < 64) { const unsigned long long _c = (unsigned long long)clock64(); \
        ts_lo = (lane == nts) ? (int)(unsigned)_c : ts_lo; ts_hi = (lane == nts) ? (int)(unsigned)(_c >> 32) : ts_hi; ++nts; } } while (0)
    PG8_STAMP();
    unsigned colA[2], voffB[2]; int rowA[2];
#pragma unroll
    for (int i = 0; i < 2; ++i) { int R, C; stage_rc(tid * 16 + i * 8192, R, C); const int Rb = Epi::PERM ? ((R & ~31) + perm32(R & 31)) : R;
        rowA[i] = R; colA[i] = (unsigned)C * 2u; voffB[i] = (unsigned)(Rb * K + C) * 2u; }
#define PG8_AOFF(dst, uidx, un) do { _Pragma("unroll") for (int _h = 0; _h < 2; ++_h) _Pragma("unroll") for (int _i = 0; _i < 2; ++_i) \
        dst[_h][_i] = (unsigned)S.arow((uidx), (un), _h * HALF + rowA[_i]) * (unsigned)(K * 2) + colA[_i]; } while (0)
    const size_t kstep = (size_t)(BK * 2);
    const size_t hstep = (size_t)HALF * K * 2;
    const size_t tstep = 2 * hstep;
    const unsigned ldsw = (unsigned)wid * 1024u;
    const int aoff = lds_byte(wr * 64 + fr, fq * 8), boff = lds_byte(wc * 32 + fr, fq * 8);
    constexpr int KOFF = 1024;
#define PG8_SA(b, h) (((b) * 2 + (h)) * HTB)
#define PG8_SB(b, h) ((4 + (b) * 2 + (h)) * HTB)
#define PG8_STAGE(bufoff, gbase, voff) do { _Pragma("unroll") for (int _i = 0; _i < 2; ++_i) \
        __builtin_amdgcn_global_load_lds((const unsigned*)((const char*)(gbase) + (voff)[_i]), (PG8_LAS unsigned*)(lds + (bufoff) + ldsw + _i * 8192), 16, 0, 0); } while (0)
#define PG8_LDA(dst, b, h) do { _Pragma("unroll") for (int m = 0; m < 4; ++m) _Pragma("unroll") for (int k = 0; k < 2; ++k) dst[m][k] = *(const PG8_LAS bf16x8*)(lds + PG8_SA(b, h) + aoff + m * 2048 + k * KOFF); } while (0)
#define PG8_LDB(dst, b, h) do { _Pragma("unroll") for (int n = 0; n < 2; ++n) _Pragma("unroll") for (int k = 0; k < 2; ++k) dst[n][k] = *(const PG8_LAS bf16x8*)(lds + PG8_SB(b, h) + boff + n * 2048 + k * KOFF); } while (0)
#define PG8_MMA(ai, bj, At, Bt) do { __builtin_amdgcn_s_setprio(1); \
        if constexpr (F8) { _Pragma("unroll") for (int m = 0; m < 4; ++m) _Pragma("unroll") for (int n = 0; n < 2; ++n) { \
            typedef int i32x4_ __attribute__((ext_vector_type(4))); typedef int i32x8_ __attribute__((ext_vector_type(8))); \
            const i32x8_ b8_ = __builtin_shufflevector(__builtin_bit_cast(i32x4_, Bt[n][0]), __builtin_bit_cast(i32x4_, Bt[n][1]), 0, 1, 2, 3, 4, 5, 6, 7); \
            const i32x8_ a8_ = __builtin_shufflevector(__builtin_bit_cast(i32x4_, At[m][0]), __builtin_bit_cast(i32x4_, At[m][1]), 0, 1, 2, 3, 4, 5, 6, 7); \
            acc[ai][bj][m][n] = __builtin_amdgcn_mfma_scale_f32_16x16x128_f8f6f4(b8_, a8_, acc[ai][bj][m][n], 0, 0, 0, g.sB, 0, g.sA); } } \
        else { _Pragma("unroll") for (int m = 0; m < 4; ++m) _Pragma("unroll") for (int n = 0; n < 2; ++n) _Pragma("unroll") for (int k = 0; k < 2; ++k) \
            acc[ai][bj][m][n] = __builtin_amdgcn_mfma_f32_16x16x32_bf16(Bt[n][k], At[m][k], acc[ai][bj][m][n], 0, 0, 0); } \
        __builtin_amdgcn_s_setprio(0); } while (0)
#define PG8_WAIT_V(n) asm volatile("s_waitcnt vmcnt(" #n ")" ::: "memory")
#define PG8_WAIT_L(n) asm volatile("s_waitcnt lgkmcnt(" #n ")" ::: "memory")
#define PG8_BAR __builtin_amdgcn_s_barrier()
#define PG8_SCHED __builtin_amdgcn_sched_barrier(0)
    Unit cur, nxt; int ui = 0;
    if (!S.next(0, cur)) return;
    f32x4 acc[2][2][4][2];
#pragma unroll
    for (int a = 0; a < 2; ++a)
#pragma unroll
        for (int b = 0; b < 2; ++b)
#pragma unroll
            for (int m = 0; m < 4; ++m)
#pragma unroll
                for (int n = 0; n < 2; ++n) acc[a][b][m][n] = (f32x4){0.f, 0.f, 0.f, 0.f};
    bf16x8 At[4][2], B0[2][2], B1[2][2];
    const char* Ab = (const char*)g.A; const char* cB = (const char*)g.Bt + (size_t)cur.pn * tstep;
    unsigned cuA[2][2];
    S.a_ready(cur);
    PG8_AOFF(cuA, 0, cur);
    PG8_STAGE(PG8_SB(0, 0), cB, voffB); PG8_STAGE(PG8_SA(0, 0), Ab, cuA[0]); PG8_STAGE(PG8_SB(0, 1), cB + hstep, voffB); PG8_STAGE(PG8_SA(0, 1), Ab, cuA[1]);
    if (wr == 1) PG8_BAR;
    PG8_WAIT_V(4); PG8_BAR;
    PG8_STAGE(PG8_SB(1, 0), cB + kstep, voffB); PG8_STAGE(PG8_SA(1, 0), Ab + kstep, cuA[0]); PG8_STAGE(PG8_SB(1, 1), cB + hstep + kstep, voffB);
    PG8_WAIT_V(6); PG8_BAR;
    PG8_STAMP();
    for (;;) {
        const bool has_next = S.next(ui + 1, nxt);
        const char* nB = has_next ? (const char*)g.Bt + (size_t)nxt.pn * tstep : cB;
        for (int t = 0; t < nt; t += 2) {
            const bool last = (t == nt - 2);
            const char* a1 = Ab + (size_t)(t + 1) * kstep;
            const char* a2 = last ? Ab : Ab + (size_t)(t + 2) * kstep; const char* b2 = last ? nB : cB + (size_t)(t + 2) * kstep;
            const char* a3 = a2 + kstep; const char* b3 = b2 + kstep;

            if (last && has_next) S.a_ready(nxt);
            PG8_LDB(B0, 0, 0); PG8_SCHED; PG8_LDA(At, 0, 0); PG8_STAGE(PG8_SA(1, 1), a1, cuA[1]);
            PG8_WAIT_L(8); PG8_BAR; PG8_WAIT_L(0); PG8_MMA(0, 0, At, B0); PG8_BAR; PG8_SCHED;
            if (last && has_next) PG8_AOFF(cuA, ui + 1, nxt);
            PG8_LDB(B1, 0, 1); PG8_STAGE(PG8_SB(0, 0), b2, voffB);
            PG8_BAR; PG8_WAIT_L(0); PG8_MMA(0, 1, At, B1); PG8_BAR;
            PG8_LDA(At, 0, 1); PG8_STAGE(PG8_SA(0, 0), a2, cuA[0]);
            PG8_BAR; PG8_WAIT_L(0); PG8_MMA(1, 0, At, B0); PG8_BAR; PG8_SCHED;
            PG8_STAGE(PG8_SB(0, 1), b2 + hstep, voffB);
            PG8_WAIT_V(6); PG8_BAR; PG8_MMA(1, 1, At, B1); PG8_BAR;
            PG8_LDB(B0, 1, 0); PG8_SCHED; PG8_LDA(At, 1, 0); PG8_STAGE(PG8_SA(0, 1), a2, cuA[1]);
            PG8_WAIT_L(8); PG8_BAR; PG8_WAIT_L(0); PG8_MMA(0, 0, At, B0); PG8_BAR; PG8_SCHED;
            PG8_LDB(B1, 1, 1); PG8_STAGE(PG8_SB(1, 0), b3, voffB);
            PG8_BAR; PG8_WAIT_L(0); PG8_MMA(0, 1, At, B1); PG8_BAR;
            PG8_LDA(At, 1, 1); PG8_STAGE(PG8_SA(1, 0), a3, cuA[0]);
            PG8_BAR; PG8_WAIT_L(0); PG8_MMA(1, 0, At, B0); PG8_BAR; PG8_SCHED;
            PG8_STAGE(PG8_SB(1, 1), b3 + hstep, voffB);
            PG8_WAIT_V(6); PG8_BAR; PG8_MMA(1, 1, At, B1); PG8_BAR;
        }
        PG8_STAMP();
        if constexpr (!Epi::AFTER_DRAIN) { E(acc, cur, wr, wc, fr, fq); S.done(cur); }
        PG8_STAMP();
        if (!has_next) break;
#pragma unroll
        for (int a = 0; a < 2; ++a)
#pragma unroll
            for (int b = 0; b < 2; ++b)
#pragma unroll
                for (int m = 0; m < 4; ++m)
#pragma unroll
                    for (int n = 0; n < 2; ++n) acc[a][b][m][n] = (f32x4){0.f, 0.f, 0.f, 0.f};
        cur = nxt; cB = nB; ++ui;
    }
    PG8_WAIT_V(0);
    if (wr == 0) PG8_BAR;
    PG8_BAR;
    if constexpr (Epi::AFTER_DRAIN) { E.fused(acc, cur, wr, wc, fr, fq, lds, wid, lane); S.done(cur); }
    PG8_STAMP();
    if (STAMP && wid == 0) { stamps[lane] = lane < nts ? (((unsigned long long)(unsigned)ts_hi << 32) | (unsigned)ts_lo) : 0ull;
        if (lane == 62) stamps[62] = rt_entry; if (lane == 63) stamps[63] = (unsigned long long)wall_clock64(); }
#undef PG8_STAMP
#undef PG8_SA
#undef PG8_SB
#undef PG8_STAGE
#undef PG8_AOFF
#undef PG8_LDA
#undef PG8_LDB
#undef PG8_MMA
#undef PG8_WAIT_V
#undef PG8_WAIT_L
#undef PG8_BAR
#undef PG8_SCHED
}
}

namespace mk {
using pg8::bf16_t; using pg8::f32x4; using pg8::u32x4; using pg8::Unit; using pg8::cvt_pk_bf16;
#define LAS __attribute__((address_space(3)))
typedef float f32x2 __attribute__((ext_vector_type(2)));
typedef unsigned u32x2 __attribute__((ext_vector_type(2)));

#ifndef MK_DIAG
#define MK_DIAG 0
#endif
#ifndef MK_DUPNULL
#define MK_DUPNULL 0
#endif
#ifndef MK_DIAGSEL
#define MK_DIAGSEL 0
#endif
#ifndef MK_DIAGMASK
#define MK_DIAGMASK 0xFFFF
#endif
#ifndef MK_N_LAUNCHES
#define MK_N_LAUNCHES 1
#endif
constexpr int NPHASE = 16;
constexpr int NB = 8, SEQ = 2048, D = 1024, T = NB * SEQ, NMEM = 256, SGW = 768, NSG = 12, HD = 64, CH = 128;
constexpr int NEXP = 16, LISTCAP = 16384;
constexpr float ALPHA = 1.41421356237f;
constexpr float LN_EPS = 1e-5f, ATT_SCALE = 0.125f;
constexpr int NWAVES = 8, NTHREADS = 512;

constexpr size_t MiB = 1u << 20;
constexpr size_t WS_CTL = 0, CTL_ZERO_BYTES = 128 * 1024;
constexpr size_t WS_TOKE = 1 * MiB, WS_TOKP = WS_TOKE + 128 * 1024, WS_TOKG = WS_TOKP + 128 * 1024;
constexpr size_t WS_LIST = 2 * MiB, WS_LSE = 3 * MiB, WS_SGWB = 4 * MiB, WS_SGRS = 4 * MiB + 512 * 1024, WS_WRT = 4 * MiB + 768 * 1024;
constexpr size_t WS_MKV = 8 * MiB, WS_MEMB = 12 * MiB;
constexpr size_t WS_BT_INA = 18 * MiB, WS_BT_OUTA = 22 * MiB, WS_BT_B = 24 * MiB, WS_BT_OUTB = 29 * MiB, WS_BT_MEM = 30 * MiB;
constexpr size_t WS_WGU = 32 * MiB, WS_WD = 160 * MiB;
constexpr size_t WS_A = 224 * MiB;
constexpr size_t WS_U = WS_A, WS_GV = WS_A + 24 * MiB, WS_QM0 = WS_A + 48 * MiB;
constexpr size_t WS_K = WS_A, WS_V = WS_A + 24 * MiB, WS_Q = WS_A + 48 * MiB, WS_QM1 = WS_A + 72 * MiB;
constexpr size_t WS_ACT = WS_A;
constexpr size_t WS_XB = 304 * MiB;
constexpr size_t WS_C = 336 * MiB;
constexpr size_t WS_CAT = WS_C, WS_OG = WS_C, WS_CAT2 = WS_C + 24 * MiB;
constexpr size_t WS_Y = 376 * MiB;
constexpr size_t WS_YD = 336 * MiB;
constexpr size_t WS_X1B = 440 * MiB;
constexpr size_t WS_X1F8 = 472 * MiB;
constexpr size_t WS_END = 488 * MiB;
constexpr size_t WS_WGU8 = WS_WGU + 64 * MiB, WS_WD8 = WS_WD + 32 * MiB;
constexpr int CW_TMO = 0, CW_BAR = 4096, CW_CNT = 16384, CW_CONV = 24576, CW_DONE = 24640, CW_CONV0 = 26000;
constexpr int LDS_TOKS = 131072 + 1024, MAX_UNITS = 8;
constexpr int LDS_MISC = 131072;
constexpr int LDS_BYTES = 147456;
static_assert(LDS_TOKS + MAX_UNITS * 1024 <= LDS_BYTES, "LDS map");

#define LDS_WAIT() asm volatile("s_waitcnt lgkmcnt(0)" ::: "memory")
#define VM_WAIT() asm volatile("s_waitcnt vmcnt(0)" ::: "memory")
__device__ __forceinline__ unsigned f2bf(float f) { unsigned u = __builtin_bit_cast(unsigned, f); return (u + 0x7fffu + ((u >> 16) & 1u)) >> 16; }
__device__ __forceinline__ unsigned pk2(float lo, float hi) { return f2bf(lo) | (f2bf(hi) << 16); }
__device__ __forceinline__ float sat8(float x) { return __builtin_amdgcn_fmed3f(x, -448.0f, 448.0f); }
__device__ __forceinline__ unsigned pk4_fp8_e(float a, float b, float c, float d) { int r = 0; r = __builtin_amdgcn_cvt_pk_fp8_f32(sat8(a), sat8(b), r, false); r = __builtin_amdgcn_cvt_pk_fp8_f32(sat8(c), sat8(d), r, true); return (unsigned)r; }
__device__ __forceinline__ float bflo(unsigned w) { return __uint_as_float(w << 16); }
__device__ __forceinline__ float bfhi(unsigned w) { return __uint_as_float(w & 0xffff0000u); }
__device__ __forceinline__ float bf1(bf16_t v) { return __uint_as_float(((unsigned)v) << 16); }
__device__ __forceinline__ float wave_sum(float v) {
#pragma unroll
    for (int o = 1; o < 64; o <<= 1) v += __shfl_xor(v, o);
    return v;
}
template <int CTRL> __device__ __forceinline__ float dpp_f(float v) { return __builtin_bit_cast(float, __builtin_amdgcn_update_dpp(0, __builtin_bit_cast(int, v), CTRL, 0xf, 0xf, false)); }
__device__ __forceinline__ float row_sum(float v) { v += dpp_f<0xB1>(v); v += dpp_f<0x4E>(v); v += dpp_f<0x141>(v); v += dpp_f<0x140>(v); return v; }
__device__ __forceinline__ float wave_sum_dpp(float v) { v = row_sum(v); v += __shfl_xor(v, 16); v += __shfl_xor(v, 32); return v; }
__device__ __forceinline__ float wave_max(float v) {
#pragma unroll
    for (int o = 1; o < 64; o <<= 1) v = fmaxf(v, __shfl_xor(v, o));
    return v;
}

#define XB_TMO      128
#define XB_XCNT(j)  (256  + 64 * (j))
#define XB_XSUB(j)  (1280 + 64 * (j))
#define XB_XGEN(j)  (2304 + 64 * (j))
#define XB_TOP      3328
#define XB_TOPGEN   3392
#define XCD_BAR_WORDS 3456
#define XB_SPIN_CAP (1u << 18)
__device__ __forceinline__ unsigned xb_ld(unsigned* p)              { return __hip_atomic_load(p, __ATOMIC_RELAXED, __HIP_MEMORY_SCOPE_AGENT); }
__device__ __forceinline__ unsigned xb_add(unsigned* p, unsigned v) { return __hip_atomic_fetch_add(p, v, __ATOMIC_RELAXED, __HIP_MEMORY_SCOPE_AGENT); }
__device__ __forceinline__ unsigned xb_xcc_id() { return (unsigned)__builtin_amdgcn_s_getreg((3 << 11) | 20) & 0xFu; }
#define XB_SPIN(cond, bar) do { unsigned _sp = 0; while (cond) { __builtin_amdgcn_s_sleep(1); \
    if ((++_sp & 255u) == 0u) { if (xb_ld(&(bar)[XB_TMO])) break; if (_sp > XB_SPIN_CAP) { atomicAdd(&(bar)[XB_TMO], 1u); break; } } } } while (0)
struct XcdBarrier { unsigned* bar; unsigned x; volatile LAS unsigned* st; };
__device__ __forceinline__ XcdBarrier xcd_barrier_post(unsigned* bar, volatile LAS unsigned* st) {
    XcdBarrier b; b.bar = bar; b.x = xb_xcc_id(); b.st = st;
    if (threadIdx.x == 0) (void)xb_add(&bar[XB_XCNT(b.x)], 1u);
    return b;
}
__device__ __forceinline__ void xcd_barrier_complete(unsigned* bar, unsigned x, unsigned& nloc, unsigned& nx) {
    const unsigned G = gridDim.x * gridDim.y * gridDim.z;
    unsigned sum, cnt, mine, sp = 0u;
    for (;;) {
        sum = 0u; cnt = 0u; mine = 0u;
#pragma unroll
        for (unsigned j = 0; j < 16; ++j) { const unsigned c = xb_ld(&bar[XB_XCNT(j)]); sum += c; cnt += (c > 0u) ? 1u : 0u; mine = (j == x) ? c : mine; }
        if (sum == G) break;
        __builtin_amdgcn_s_sleep(1);
        if ((++sp & 255u) == 0u) { if (xb_ld(&bar[XB_TMO])) break; if (sp > XB_SPIN_CAP) { atomicAdd(&bar[XB_TMO], 1u); break; } }
    }
    nloc = mine > 0u ? mine : 1u; nx = cnt > 0u ? cnt : 1u;
}
__device__ __forceinline__ void xcd_barrier(const XcdBarrier& b) {
    asm volatile("s_waitcnt vmcnt(0)" ::: "memory");
    __syncthreads();
    if (threadIdx.x == 0) {
        unsigned* bar = b.bar;
        __builtin_amdgcn_s_waitcnt(0);
        unsigned nloc = b.st[0], nx = b.st[1];
        if (nloc == 0u) { xcd_barrier_complete(bar, b.x, nloc, nx); b.st[0] = nloc; b.st[1] = nx; }
        const unsigned old = xb_add(&bar[XB_XSUB(b.x)], 1u);
        const unsigned gen = old / nloc;
        if (old + 1u == (gen + 1u) * nloc) {
            __builtin_amdgcn_fence(__ATOMIC_RELEASE, "agent");
            asm volatile("s_waitcnt vmcnt(0)" ::: "memory");
            const unsigned og = xb_add(&bar[XB_TOP], 1u);
            const unsigned tg = og / nx;
            if (og + 1u == (tg + 1u) * nx) xb_add(&bar[XB_TOPGEN], 1u);
            else XB_SPIN(xb_ld(&bar[XB_TOPGEN]) == tg, bar);
            __builtin_amdgcn_fence(__ATOMIC_ACQUIRE, "agent");
            xb_add(&bar[XB_XGEN(b.x)], 1u);
            asm volatile("s_waitcnt vmcnt(0)" ::: "memory");
        } else {
            XB_SPIN(xb_ld(&bar[XB_XGEN(b.x)]) == gen, bar);
            __builtin_amdgcn_fence(__ATOMIC_ACQUIRE, "agent");
            asm volatile("s_waitcnt vmcnt(0)" ::: "memory");
        }
    }
    __syncthreads();
}


struct EpiProjA {
    static constexpr bool PERM = true, AFTER_DRAIN = false;
    bf16_t *u, *gv, *qm;
    __device__ __forceinline__ void operator()(const f32x4 (&acc)[2][2][4][2], const Unit& un, int wr, int wc, int fr, int fq) const {
        const int row0 = un.pm * 256 + wr * 64 + fr;
        bf16_t* base; int ldc, colt; bool act; float sc = 1.f;
        if (un.pn < 3) { base = u; ldc = SGW; colt = un.pn * 256; act = true; }
        else if (un.pn < 6) { base = gv; ldc = SGW; colt = (un.pn - 3) * 256; act = true; }
        else { base = qm; ldc = 256; colt = 0; act = false; sc = ATT_SCALE; }
        const int col0 = colt + wc * 32 + 8 * fq;
#pragma unroll
        for (int ai = 0; ai < 2; ++ai)
#pragma unroll
            for (int m = 0; m < 4; ++m) { bf16_t* rowp = base + (size_t)(row0 + ai * 128 + m * 16) * ldc + col0;
#pragma unroll
                for (int bj = 0; bj < 2; ++bj) { f32x4 v0 = acc[ai][bj][m][0], v1 = acc[ai][bj][m][1];
                    if (act) { pg8::f32x2 a = pg8::gelu_pk((pg8::f32x2){v0[0], v0[1]}), b = pg8::gelu_pk((pg8::f32x2){v0[2], v0[3]}), c = pg8::gelu_pk((pg8::f32x2){v1[0], v1[1]}), d = pg8::gelu_pk((pg8::f32x2){v1[2], v1[3]});
                        v0 = (f32x4){a.x, a.y, b.x, b.y}; v1 = (f32x4){c.x, c.y, d.x, d.y}; }
                    v0 = v0 * sc; v1 = v1 * sc;
                    u32x4 w; w.x = cvt_pk_bf16(v0[0], v0[1]); w.y = cvt_pk_bf16(v0[2], v0[3]); w.z = cvt_pk_bf16(v1[0], v1[1]); w.w = cvt_pk_bf16(v1[2], v1[3]);
                    *(u32x4*)(rowp + bj * 128) = w; } }
    }
};
struct EpiProjB {
    static constexpr bool PERM = true, AFTER_DRAIN = false;
    bf16_t *k, *v, *q, *qm;
    __device__ __forceinline__ void operator()(const f32x4 (&acc)[2][2][4][2], const Unit& un, int wr, int wc, int fr, int fq) const {
        const int row0 = un.pm * 256 + wr * 64 + fr;
        bf16_t* base; int ldc, colt; float sc = 1.f;
        if (un.pn < 3) { base = k; ldc = SGW; colt = un.pn * 256; }
        else if (un.pn < 6) { base = v; ldc = SGW; colt = (un.pn - 3) * 256; }
        else if (un.pn < 9) { base = q; ldc = SGW; colt = (un.pn - 6) * 256; sc = ATT_SCALE; }
        else { base = qm; ldc = 256; colt = 0; sc = ATT_SCALE; }
        const int col0 = colt + wc * 32 + 8 * fq;
#pragma unroll
        for (int ai = 0; ai < 2; ++ai)
#pragma unroll
            for (int m = 0; m < 4; ++m) { bf16_t* rowp = base + (size_t)(row0 + ai * 128 + m * 16) * ldc + col0;
#pragma unroll
                for (int bj = 0; bj < 2; ++bj) { f32x4 v0 = acc[ai][bj][m][0] * sc, v1 = acc[ai][bj][m][1] * sc;
                    u32x4 w; w.x = cvt_pk_bf16(v0[0], v0[1]); w.y = cvt_pk_bf16(v0[2], v0[3]); w.z = cvt_pk_bf16(v1[0], v1[1]); w.w = cvt_pk_bf16(v1[2], v1[3]);
                    *(u32x4*)(rowp + bj * 128) = w; } }
    }
};
struct EpiPlain {
    static constexpr bool PERM = true, AFTER_DRAIN = false;
    bf16_t* O; int ldc, ntn;
    __device__ __forceinline__ void operator()(const f32x4 (&acc)[2][2][4][2], const Unit& un, int wr, int wc, int fr, int fq) const {
        const int row0 = un.pm * 256 + wr * 64 + fr;
        const int col0 = (un.pn % ntn) * 256 + wc * 32 + 8 * fq;
#pragma unroll
        for (int ai = 0; ai < 2; ++ai)
#pragma unroll
            for (int m = 0; m < 4; ++m) { bf16_t* rowp = O + (size_t)(row0 + ai * 128 + m * 16) * ldc + col0;
#pragma unroll
                for (int bj = 0; bj < 2; ++bj) { const f32x4 v0 = acc[ai][bj][m][0], v1 = acc[ai][bj][m][1];
                    u32x4 w; w.x = cvt_pk_bf16(v0[0], v0[1]); w.y = cvt_pk_bf16(v0[2], v0[3]); w.z = cvt_pk_bf16(v1[0], v1[1]); w.w = cvt_pk_bf16(v1[2], v1[3]);
                    *(u32x4*)(rowp + bj * 128) = w; } }
    }
};
struct EpiPlain8 {
    static constexpr bool PERM = true, AFTER_DRAIN = false;
    unsigned char* O; int ldc, ntn; float sc;
    __device__ __forceinline__ void operator()(const f32x4 (&acc)[2][2][4][2], const Unit& un, int wr, int wc, int fr, int fq) const {
        const int row0 = un.pm * 256 + wr * 64 + fr;
        const int col0 = (un.pn % ntn) * 256 + wc * 32 + 8 * fq;
#pragma unroll
        for (int ai = 0; ai < 2; ++ai)
#pragma unroll
            for (int m = 0; m < 4; ++m) { unsigned char* rowp = O + (size_t)(row0 + ai * 128 + m * 16) * ldc + col0;
#pragma unroll
                for (int bj = 0; bj < 2; ++bj) { const f32x4 v0 = acc[ai][bj][m][0] * sc, v1 = acc[ai][bj][m][1] * sc;
                    *(u32x2*)(rowp + bj * 128) = (u32x2){pk4_fp8_e(v0[0], v0[1], v0[2], v0[3]), pk4_fp8_e(v1[0], v1[1], v1[2], v1[3])}; } }
    }
};
struct EpiSwiGLU {
    static constexpr bool PERM = true, AFTER_DRAIN = false;
    bf16_t* O;
    __device__ __forceinline__ void operator()(const f32x4 (&acc)[2][2][4][2], const Unit& un, int wr, int wc, int fr, int fq) const {
        const int row0 = un.pm * 256 + wr * 64 + fr;
        const int col0 = (un.pn & 7) * 128 + wc * 32 + 8 * fq;
#pragma unroll
        for (int ai = 0; ai < 2; ++ai)
#pragma unroll
            for (int m = 0; m < 4; ++m) { bf16_t* rowp = O + (size_t)(row0 + ai * 128 + m * 16) * 1024 + col0;
                float r[8];
#pragma unroll
                for (int n = 0; n < 2; ++n)
#pragma unroll
                    for (int j = 0; j < 4; ++j) { const float g = acc[ai][0][m][n][j], up = acc[ai][1][m][n][j];
                        r[n * 4 + j] = g * __builtin_amdgcn_rcpf(1.0f + __expf(-g)) * up; }
                u32x4 w; w.x = cvt_pk_bf16(r[0], r[1]); w.y = cvt_pk_bf16(r[2], r[3]); w.z = cvt_pk_bf16(r[4], r[5]); w.w = cvt_pk_bf16(r[6], r[7]);
                *(u32x4*)rowp = w; }
    }
};
struct EpiSwiGLU8 {
    static constexpr bool PERM = true, AFTER_DRAIN = false;
    unsigned char* O;
    __device__ __forceinline__ void operator()(const f32x4 (&acc)[2][2][4][2], const Unit& un, int wr, int wc, int fr, int fq) const {
        const int row0 = un.pm * 256 + wr * 64 + fr;
        const int col0 = (un.pn & 7) * 128 + wc * 32 + 8 * fq;
#pragma unroll
        for (int ai = 0; ai < 2; ++ai)
#pragma unroll
            for (int m = 0; m < 4; ++m) { unsigned char* rowp = O + (size_t)(row0 + ai * 128 + m * 16) * 1024 + col0;
                float r[8];
#pragma unroll
                for (int n = 0; n < 2; ++n)
#pragma unroll
                    for (int j = 0; j < 4; ++j) { const float g = acc[ai][0][m][n][j], up = acc[ai][1][m][n][j];
                        r[n * 4 + j] = g * __builtin_amdgcn_rcpf(1.0f + __expf(-g)) * up * 8.0f; }
                *(u32x2*)rowp = (u32x2){pk4_fp8_e(r[0], r[1], r[2], r[3]), pk4_fp8_e(r[4], r[5], r[6], r[7])}; }
    }
};
template <bool RB> struct EpiResid {
    static constexpr bool PERM = false, AFTER_DRAIN = false;
    const void* res; bf16_t* Y;
    __device__ __forceinline__ void operator()(const f32x4 (&acc)[2][2][4][2], const Unit& un, int wr, int wc, int fr, int fq) const {
        const int row0 = un.pm * 256 + wr * 64 + fr, col0 = un.pn * 256 + wc * 32 + 4 * fq;
#pragma unroll
        for (int ai = 0; ai < 2; ++ai)
#pragma unroll
            for (int m = 0; m < 4; ++m) { const size_t off = (size_t)(row0 + ai * 128 + m * 16) * D + col0;
#pragma unroll
                for (int bj = 0; bj < 2; ++bj)
#pragma unroll
                    for (int n = 0; n < 2; ++n) { const size_t o = off + bj * 128 + n * 16; f32x4 r;
                        if (RB) { const u32x2 w = *(const u32x2*)((const bf16_t*)res + o); r = (f32x4){bflo(w.x), bfhi(w.x), bflo(w.y), bfhi(w.y)}; }
                        else r = *(const f32x4*)((const float*)res + o);
                        const f32x4 yv = r * ALPHA + acc[ai][bj][m][n]; *(u32x2*)(Y + o) = (u32x2){cvt_pk_bf16(yv[0], yv[1]), cvt_pk_bf16(yv[2], yv[3])}; } }
    }
};
struct EpiNull {
    static constexpr bool PERM = true, AFTER_DRAIN = false;
    __device__ __forceinline__ void operator()(const f32x4 (&acc)[2][2][4][2], const Unit&, int, int, int, int) const {
#pragma unroll
        for (int a = 0; a < 2; ++a)
#pragma unroll
            for (int b = 0; b < 2; ++b)
#pragma unroll
                for (int m = 0; m < 4; ++m)
#pragma unroll
                    for (int n = 0; n < 2; ++n) asm volatile("" :: "v"(acc[a][b][m][n]));
    }
};
struct SmallOrder {
    int nN, nwg, c;
    __device__ bool next(int i, Unit& u) const { if (i != 0 || c < 0 || c >= nwg) return false; u.pm = c / nN; u.pn = c % nN; return true; }
    __device__ __forceinline__ void a_ready(const Unit&) const {}
    __device__ __forceinline__ void done(const Unit&) const {}
    __device__ __forceinline__ int arow(int, const Unit& u, int r) const { return u.pm * 256 + r; }
};
__device__ __forceinline__ int moe_unit_index(int i, int c, int G, int U) {
    if ((G & 7) != 0) { const int L = i * G + c; return L < U ? L : -1; }
    const int per = (U + 7) >> 3, n = i * (G >> 3) + (c >> 3); if (n >= per) return -1;
    const int L = (c & 7) * per + n; return L < U ? L : -1;
}
struct MoeOrder {
    const LAS int* tb;
    int ntn, G, c;
    __device__ bool next(int i, Unit& u) const {
        const int L = moe_unit_index(i, c, G, tb[16] * ntn); if (L < 0) return false;
        int e = 0;
#pragma unroll
        for (int j = 1; j < 16; ++j) e += (L >= tb[j] * ntn) ? 1 : 0;
        const int r = L - tb[e] * ntn, te = tb[e + 1] - tb[e];
        (void)te; u.pm = tb[e] + r / ntn; u.pn = e * ntn + r % ntn; return true;
    }
    __device__ __forceinline__ void a_ready(const Unit&) const {}
    __device__ __forceinline__ void done(const Unit&) const {}
    __device__ __forceinline__ int arow(int, const Unit& u, int r) const { return u.pm * 256 + r; }
};
struct MoeGatherOrder : MoeOrder {
    const LAS int* toks;
    __device__ __forceinline__ int arow(int ui, const Unit&, int r) const { return toks[ui * 256 + r]; }
};

struct Args { const float* in[23]; float* out; unsigned char* ws; int ph_lo, ph_hi; };
struct Ctx {
    unsigned char* ws; LAS unsigned char* lds;
    int tid, lane, wave, gw, NGW, G, bid, vb;
};
__device__ __forceinline__ unsigned char* launder(unsigned char* p) { asm volatile("" : "+s"(p)); return p; }
__device__ __forceinline__ int launder_v(int v) { asm volatile("" : "+v"(v)); return v; }

__device__ __forceinline__ void tr_item(const float* W, int K, int N, bf16_t* WT, int grp, int gstride, int roff, LAS float* scr, int item, int lane) {
    const int nblk = N / 32, kb = item / nblk, nb = item % nblk, k0 = 64 * kb, n0 = 32 * nb;
    float ld[32];
    { const float* wp = W + (size_t)(k0 + (lane >> 5)) * N + n0 + (lane & 31);
#pragma unroll
      for (int i = 0; i < 32; ++i) ld[i] = __builtin_nontemporal_load(wp + (size_t)(2 * i) * N); }
#pragma unroll
    for (int i = 0; i < 32; ++i) scr[(2 * i + (lane >> 5)) * 33 + (lane & 31)] = ld[i];
    LDS_WAIT(); asm volatile("" ::: "memory");
    const int c = lane & 7;
#pragma unroll
    for (int j = 0; j < 4; ++j) { const int n = (lane >> 3) + 8 * j; const LAS float* s = scr + (8 * c) * 33 + n;
        const int nn = n0 + n, drow = (nn / grp) * gstride + (nn % grp) + roff;
        u32x4 o; o.x = pk2(s[0 * 33], s[1 * 33]); o.y = pk2(s[2 * 33], s[3 * 33]); o.z = pk2(s[4 * 33], s[5 * 33]); o.w = pk2(s[6 * 33], s[7 * 33]);
        *(u32x4*)(WT + (size_t)drow * K + k0 + 8 * c) = o; }
    LDS_WAIT(); asm volatile("" ::: "memory");
}
__device__ __forceinline__ unsigned pk4_fp8(float a, float b, float c, float d) { return pk4_fp8_e(a, b, c, d); }
__device__ __forceinline__ void tr_item8(const float* W, int K, int N, unsigned char* WT, int grp, int gstride, int roff, float sc, LAS float* scr, int item, int lane) {
    const int nblk = N / 32, kb = item / nblk, nb = item % nblk, k0 = 64 * kb, n0 = 32 * nb;
    float ld[32];
    { const float* wp = W + (size_t)(k0 + (lane >> 5)) * N + n0 + (lane & 31);
#pragma unroll
      for (int i = 0; i < 32; ++i) ld[i] = __builtin_nontemporal_load(wp + (size_t)(2 * i) * N); }
#pragma unroll
    for (int i = 0; i < 32; ++i) scr[(2 * i + (lane >> 5)) * 33 + (lane & 31)] = ld[i];
    LDS_WAIT(); asm volatile("" ::: "memory");
    const int c = lane & 7;
#pragma unroll
    for (int j = 0; j < 4; ++j) { const int n = (lane >> 3) + 8 * j; const LAS float* s = scr + (8 * c) * 33 + n;
        const int nn = n0 + n, drow = (nn / grp) * gstride + (nn % grp) + roff;
        u32x2 o; o.x = pk4_fp8(s[0 * 33] * sc, s[1 * 33] * sc, s[2 * 33] * sc, s[3 * 33] * sc); o.y = pk4_fp8(s[4 * 33] * sc, s[5 * 33] * sc, s[6 * 33] * sc, s[7 * 33] * sc);
        *(u32x2*)(WT + (size_t)drow * K + k0 + 8 * c) = o; }
    LDS_WAIT(); asm volatile("" ::: "memory");
}
constexpr float W8_SCALE = 32.0f, ACT8_SCALE = 8.0f, YD8_SCALE = 16.0f;
constexpr int E8_ONE = 0x7f7f7f7f, E8_W = 0x7a7a7a7a, E8_ACT = 0x7c7c7c7c;
__device__ __forceinline__ void moe_conv_item(const Args& A, unsigned char* ws, LAS float* scr, int lane, int layer, int r) {
    const int t = r >> 13, e = (r & 8191) >> 9, m = layer * 16 + e, item = r & 511;
    if (t == 0) tr_item8(A.in[20] + (size_t)m * 1048576, 1024, 1024, ws + WS_WGU + (size_t)layer * (64 * MiB) + (size_t)e * 2097152, 128, 256, 0, W8_SCALE, scr, item, lane);
    else if (t == 1) tr_item8(A.in[21] + (size_t)m * 1048576, 1024, 1024, ws + WS_WGU + (size_t)layer * (64 * MiB) + (size_t)e * 2097152, 128, 256, 128, W8_SCALE, scr, item, lane);
    else tr_item8(A.in[22] + (size_t)m * 1048576, 1024, 1024, ws + WS_WD + (size_t)layer * (32 * MiB) + (size_t)e * 1048576, 1024, 1024, 0, W8_SCALE, scr, item, lane);
}
constexpr int N_CONV1 = 3 * 8192;
__device__ __forceinline__ void fill_tail(const Ctx& C, const Args& A, int ph, bool fin) {
    unsigned* ctl = (unsigned*)(C.ws + WS_CTL);
    volatile LAS int* flag = (volatile LAS int*)(C.lds + LDS_MISC) + 40;
    LAS float* scr = (LAS float*)(C.lds + C.wave * 16384);
    asm volatile("s_waitcnt vmcnt(0)" ::: "memory");
    __syncthreads();
    if (C.tid == 0 && !fin) __hip_atomic_fetch_add(ctl + CW_DONE + 64 * ph, 1u, __ATOMIC_RELAXED, __HIP_MEMORY_SCOPE_AGENT);
    for (;;) {
        if (C.tid == 0) { int v = -1;
            const unsigned d = fin ? 0u : __hip_atomic_fetch_add(ctl + CW_DONE + 64 * ph, 0u, __ATOMIC_RELAXED, __HIP_MEMORY_SCOPE_AGENT);
            if (d + 32u < (unsigned)C.G) { v = (int)__hip_atomic_fetch_add(ctl + CW_CONV, 8u, __ATOMIC_RELAXED, __HIP_MEMORY_SCOPE_AGENT); if (v >= N_CONV1) v = -1; }
#if MK_DIAG == 3
            if (!fin && v >= 0) __hip_atomic_fetch_add(ctl + 30000, 8u, __ATOMIC_RELAXED, __HIP_MEMORY_SCOPE_AGENT);
#endif
            *flag = v; }
        __syncthreads();
        const int v = *flag;
        __syncthreads();
        if (v < 0) break;
        if (v + C.wave < N_CONV1) moe_conv_item(A, C.ws, scr, C.lane, 1, v + C.wave);
    }
}
__device__ __forceinline__ void p0_prologue(const Ctx& C, const Args& A) {
    LAS float* scr = (LAS float*)(C.lds + C.wave * 16384);
    unsigned char* ws = C.ws;
    constexpr int I_MOE = 16 * 32;
    constexpr int N_MOE = 32 * I_MOE;
    constexpr int I_INA = 16 * 56, I_SQ = 512, I_KV = 16 * 24, I_OUTB = 8 * 32, I_MEM = 16 * 8;
    constexpr int N_MOE0 = 3 * 8192;
    constexpr int NITEMS = I_INA + I_SQ + I_SQ + 2 * I_KV + I_OUTB + 4 * I_MEM;
    for (int it = C.gw; it < NITEMS; it += C.NGW) {
        int r = it;
        if (r < I_INA) { tr_item(A.in[2], 1024, 1792, (bf16_t*)(ws + WS_BT_INA), 1792, 1792, 0, scr, r, C.lane); continue; } r -= I_INA;
        if (r < I_SQ) { tr_item(A.in[3], 1024, 1024, (bf16_t*)(ws + WS_BT_OUTA), 1024, 1024, 0, scr, r, C.lane); continue; } r -= I_SQ;
        if (r < I_SQ) { tr_item(A.in[8], 1024, 1024, (bf16_t*)(ws + WS_BT_B), 1024, 1024, 1536, scr, r, C.lane); continue; } r -= I_SQ;
        if (r < I_KV) { tr_item(A.in[10], 1024, 768, (bf16_t*)(ws + WS_BT_B), 768, 768, 0, scr, r, C.lane); continue; } r -= I_KV;
        if (r < I_KV) { tr_item(A.in[11], 1024, 768, (bf16_t*)(ws + WS_BT_B), 768, 768, 768, scr, r, C.lane); continue; } r -= I_KV;
        if (r < I_OUTB) { tr_item(A.in[9], 512, 1024, (bf16_t*)(ws + WS_BT_OUTB), 1024, 1024, 0, scr, r, C.lane); continue; } r -= I_OUTB;
        { const int m = r / I_MEM, layer = m & 1, isv = m >> 1;
          tr_item(A.in[isv ? 13 : 12] + (size_t)layer * 262144, 1024, 256, (bf16_t*)(ws + WS_BT_MEM), 256, 256, layer * 512 + isv * 256, scr, r % I_MEM, C.lane); }
    }
    const int gt = C.bid * NTHREADS + C.tid, NT = C.G * NTHREADS;
    for (int i = gt; i < NSG * 128 * 128 / 8; i += NT) { const int q0 = (i & 15) * 8, p = (i >> 4) & 127;
        const f32x4 a = *(const f32x4*)(A.in[6] + (size_t)i * 8), b = *(const f32x4*)(A.in[6] + (size_t)i * 8 + 4); float v[8] = {a[0], a[1], a[2], a[3], b[0], b[1], b[2], b[3]};
#pragma unroll
        for (int j = 0; j < 8; ++j) v[j] = (q0 + j <= p) ? v[j] : 0.f;
        u32x4 w; w.x = pk2(v[0], v[1]); w.y = pk2(v[2], v[3]); w.z = pk2(v[4], v[5]); w.w = pk2(v[6], v[7]); *(u32x4*)((bf16_t*)(ws + WS_SGWB) + (size_t)i * 8) = w; }
    for (int i = gt; i < 16 * 1024; i += NT) { const int e = i >> 10, k = i & 1023; ((bf16_t*)(ws + WS_WRT))[i] = (bf16_t)f2bf(A.in[18][(size_t)k * 16 + e]); }
    for (int i = C.gw; i < NSG * 128; i += C.NGW) { const int p = i & 127;
        const float w0 = A.in[6][(size_t)i * 128 + C.lane], w1 = A.in[6][(size_t)i * 128 + 64 + C.lane];
        const float acc = wave_sum_dpp((C.lane <= p ? bflo(f2bf(w0)) : 0.f) + (64 + C.lane <= p ? bflo(f2bf(w1)) : 0.f));
        if (C.lane == 0) ((float*)(ws + WS_SGRS))[i] = acc; }
    for (int i0 = gt; i0 < T * D / 8; i0 += 4 * NT) {
        f32x4 a[4], b[4];
#pragma unroll
        for (int k = 0; k < 4; ++k) { const int i = i0 + k * NT; const size_t o = (size_t)(i < T * D / 8 ? i : gt) * 8; a[k] = __builtin_nontemporal_load((const f32x4*)(A.in[0] + o)); b[k] = __builtin_nontemporal_load((const f32x4*)(A.in[0] + o + 4)); }
#pragma unroll
        for (int k = 0; k < 4; ++k) { const int i = i0 + k * NT; if (i < T * D / 8) { u32x4 w; w.x = cvt_pk_bf16(a[k][0], a[k][1]); w.y = cvt_pk_bf16(a[k][2], a[k][3]); w.z = cvt_pk_bf16(b[k][0], b[k][1]); w.w = cvt_pk_bf16(b[k][2], b[k][3]);
            *(u32x4*)((bf16_t*)(ws + WS_XB) + (size_t)i * 8) = w; } } }
    for (int i = gt; i < NB * NMEM * D / 8; i += NT) { const f32x4 a = *(const f32x4*)(A.in[1] + (size_t)i * 8), b = *(const f32x4*)(A.in[1] + (size_t)i * 8 + 4);
        u32x4 w; w.x = pk2(a[0], a[1]); w.y = pk2(a[2], a[3]); w.z = pk2(b[0], b[1]); w.w = pk2(b[2], b[3]); *(u32x4*)((bf16_t*)(ws + WS_MEMB) + (size_t)i * 8) = w; }
    { unsigned* ctr = (unsigned*)(ws + WS_CTL) + CW_CONV0; volatile LAS int* flag = (volatile LAS int*)(C.lds + LDS_MISC) + 40;
      if (C.tid == 0) *flag = (int)__hip_atomic_fetch_add(ctr, 8u, __ATOMIC_RELAXED, __HIP_MEMORY_SCOPE_AGENT);
      __syncthreads();
      int cur = *flag;
      __syncthreads();
      while (cur < N_MOE0) {
          int nxt = 0;
          if (C.tid == 0) nxt = (int)__hip_atomic_fetch_add(ctr, 8u, __ATOMIC_RELAXED, __HIP_MEMORY_SCOPE_AGENT);
          if (cur + C.wave < N_MOE0) moe_conv_item(A, ws, scr, C.lane, 0, cur + C.wave);
          if (C.tid == 0) *flag = nxt;
          __syncthreads();
          cur = *flag;
          __syncthreads();
      } }
}

__device__ __forceinline__ void sg_scalar(const Ctx& C, const Args& A) {
    const bf16_t* U = (const bf16_t*)(C.ws + WS_U); const bf16_t* GV = (const bf16_t*)(C.ws + WS_GV); bf16_t* CAT = (bf16_t*)(C.ws + WS_CAT);
    const float* lng = A.in[4]; const float* lnb = A.in[5]; const float* sgw = A.in[6]; const float* sgb = A.in[7];
    LAS float* stat = (LAS float*)C.lds;
    LAS float* gvn = (LAS float*)(C.lds + 1024);
    LAS float* Wl = (LAS float*)(C.lds + 1024 + 128 * 65 * 4);
    for (int unit = C.bid; unit < NB * 16; unit += C.G) {
        const int tb = unit * 128;
        for (int rr = 0; rr < 16; ++rr) { const int row = C.wave * 16 + rr; const bf16_t* p = GV + (size_t)(tb + row) * SGW + 4 * C.lane;
            float s = 0.f, ss = 0.f;
#pragma unroll
            for (int j = 0; j < 3; ++j) { const u32x2 w = *(const u32x2*)(p + 256 * j); const float a = bflo(w.x), b = bfhi(w.x), c = bflo(w.y), d = bfhi(w.y);
                s += (a + b) + (c + d); ss += (a * a + b * b) + (c * c + d * d); }
            s = wave_sum(s); ss = wave_sum(ss);
            const float mean = s * (1.f / SGW), var = ss * (1.f / SGW) - mean * mean;
            if (C.lane == 0) { stat[row * 2] = mean; stat[row * 2 + 1] = 1.0f / sqrtf(var + LN_EPS); } }
        __syncthreads();
        const int p = C.tid >> 2, d0 = (C.tid & 3) * 16;
        for (int g = 0; g < NSG; ++g) {
            { const bf16_t* src = GV + (size_t)(tb + p) * SGW + g * 64 + d0; const float mean = stat[p * 2], rstd = stat[p * 2 + 1];
#pragma unroll
              for (int h = 0; h < 2; ++h) { const u32x4 w = *(const u32x4*)(src + 8 * h); const unsigned ww[4] = {w.x, w.y, w.z, w.w};
#pragma unroll
                  for (int j = 0; j < 4; ++j) { const int d = d0 + 8 * h + 2 * j; const int cc = g * 64 + d;
                      gvn[p * 65 + d] = (bflo(ww[j]) - mean) * rstd * lng[cc] + lnb[cc];
                      gvn[p * 65 + d + 1] = (bfhi(ww[j]) - mean) * rstd * lng[cc + 1] + lnb[cc + 1]; } } }
            { const int q0 = (C.tid & 3) * 32; const float* src = sgw + ((size_t)g * 128 + p) * 128 + q0;
#pragma unroll
              for (int j = 0; j < 8; ++j) { const f32x4 w = *(const f32x4*)(src + 4 * j);
#pragma unroll
                  for (int t = 0; t < 4; ++t) { const int q = q0 + 4 * j + t; Wl[p * 129 + q] = (q <= p) ? w[t] : 0.f; } } }
            __syncthreads();
            float acc[16];
#pragma unroll
            for (int j = 0; j < 16; ++j) acc[j] = 0.f;
            for (int q = 0; q <= p; ++q) { const float w = Wl[p * 129 + q];
#pragma unroll
                for (int j = 0; j < 16; ++j) acc[j] += w * gvn[q * 65 + d0 + j]; }
            const float bs = sgb[g * 128 + p];
            const bf16_t* us = U + (size_t)(tb + p) * SGW + g * 64 + d0; bf16_t* dst = CAT + (size_t)(tb + p) * D + g * 64 + d0;
#pragma unroll
            for (int h = 0; h < 2; ++h) { const u32x4 w = *(const u32x4*)(us + 8 * h); const unsigned ww[4] = {w.x, w.y, w.z, w.w}; unsigned o[4];
#pragma unroll
                for (int j = 0; j < 4; ++j) o[j] = pk2(bflo(ww[j]) * (acc[8 * h + 2 * j] + bs), bfhi(ww[j]) * (acc[8 * h + 2 * j + 1] + bs));
                *(u32x4*)(dst + 8 * h) = (u32x4){o[0], o[1], o[2], o[3]}; }
            __syncthreads();
        }
    }
}

__device__ __forceinline__ void memattn_scalar(const Ctx& C, const bf16_t* QM, const bf16_t* MKV, int ck, int cv, bf16_t* OUT, int ldo, int coff) {
    for (int it = C.gw; it < T * 4; it += C.NGW) {
        const int tok = it >> 2, h = it & 3, b = tok / SEQ;
        float q[64];
        { const bf16_t* qp = QM + (size_t)tok * 256 + h * 64;
#pragma unroll
          for (int j = 0; j < 8; ++j) { const u32x4 w = *(const u32x4*)(qp + 8 * j);
              q[8 * j] = bflo(w.x); q[8 * j + 1] = bfhi(w.x); q[8 * j + 2] = bflo(w.y); q[8 * j + 3] = bfhi(w.y); q[8 * j + 4] = bflo(w.z); q[8 * j + 5] = bfhi(w.z); q[8 * j + 6] = bflo(w.w); q[8 * j + 7] = bfhi(w.w); } }
        float s[4];
#pragma unroll
        for (int jj = 0; jj < 4; ++jj) { const bf16_t* kp = MKV + (size_t)(b * NMEM + jj * 64 + C.lane) * 1024 + ck + h * 64; float a = 0.f;
#pragma unroll
            for (int j = 0; j < 8; ++j) { const u32x4 w = *(const u32x4*)(kp + 8 * j);
                a += q[8 * j] * bflo(w.x) + q[8 * j + 1] * bfhi(w.x) + q[8 * j + 2] * bflo(w.y) + q[8 * j + 3] * bfhi(w.y) + q[8 * j + 4] * bflo(w.z) + q[8 * j + 5] * bfhi(w.z) + q[8 * j + 6] * bflo(w.w) + q[8 * j + 7] * bfhi(w.w); }
            s[jj] = a; }
        const float mx = wave_max(fmaxf(fmaxf(s[0], s[1]), fmaxf(s[2], s[3])));
        float l = 0.f;
#pragma unroll
        for (int jj = 0; jj < 4; ++jj) { s[jj] = __expf(s[jj] - mx); l += s[jj]; }
        l = wave_sum(l);
        float acc = 0.f;
#pragma unroll
        for (int jj = 0; jj < 4; ++jj) { const bf16_t* vp = MKV + (size_t)(b * NMEM + jj * 64) * 1024 + cv + h * 64 + C.lane;
            for (int mm = 0; mm < 64; ++mm) acc += __shfl(s[jj], mm) * bf1(vp[(size_t)mm * 1024]); }
        OUT[(size_t)tok * ldo + coff + h * 64 + C.lane] = (bf16_t)f2bf(acc / l);
    }
}

__device__ __forceinline__ void dilattn_scalar(const Ctx& C, const Args& A) {
    const bf16_t* Q = (const bf16_t*)(C.ws + WS_Q); const bf16_t* K = (const bf16_t*)(C.ws + WS_K); const bf16_t* V = (const bf16_t*)(C.ws + WS_V);
    bf16_t* OG = (bf16_t*)(C.ws + WS_OG); float* LSE = (float*)(C.ws + WS_LSE);
    for (int it = C.gw; it < T * 12; it += C.NGW) {
        const int tok = it / 12, h = it % 12, g = h >> 2, dl = (g == 0) ? 1 : (g == 1 ? 4 : 16);
        const int t = tok % SEQ, i = t / dl;
        const float slope = exp2f(-(float)(h + 1) * (8.0f / 12.0f));
        float q[64];
        { const bf16_t* qp = Q + (size_t)tok * SGW + h * 64;
#pragma unroll
          for (int j = 0; j < 8; ++j) { const u32x4 w = *(const u32x4*)(qp + 8 * j);
              q[8 * j] = bflo(w.x); q[8 * j + 1] = bfhi(w.x); q[8 * j + 2] = bflo(w.y); q[8 * j + 3] = bfhi(w.y); q[8 * j + 4] = bflo(w.z); q[8 * j + 5] = bfhi(w.z); q[8 * j + 6] = bflo(w.w); q[8 * j + 7] = bfhi(w.w); } }
        float s[3];
#pragma unroll
        for (int jj = 0; jj < 3; ++jj) { const int j0 = jj * 64 + C.lane; const bool valid = (jj < 2 || C.lane == 0) && (j0 <= i);
            const int jc = valid ? j0 : 0;
            const bf16_t* kp = K + (size_t)(tok - jc * dl) * SGW + h * 64; float a = 0.f;
#pragma unroll
            for (int j = 0; j < 8; ++j) { const u32x4 w = *(const u32x4*)(kp + 8 * j);
                a += q[8 * j] * bflo(w.x) + q[8 * j + 1] * bfhi(w.x) + q[8 * j + 2] * bflo(w.y) + q[8 * j + 3] * bfhi(w.y) + q[8 * j + 4] * bflo(w.z) + q[8 * j + 5] * bfhi(w.z) + q[8 * j + 6] * bflo(w.w) + q[8 * j + 7] * bfhi(w.w); }
            s[jj] = valid ? (a - slope * (float)(dl * j0)) : -INFINITY; }
        const float mx = wave_max(fmaxf(fmaxf(s[0], s[1]), s[2]));
        float l = 0.f;
#pragma unroll
        for (int jj = 0; jj < 3; ++jj) { s[jj] = __expf(s[jj] - mx); l += s[jj]; }
        l = wave_sum(l);
        float acc = 0.f;
#pragma unroll
        for (int jj = 0; jj < 3; ++jj) { const int nm = (jj < 2) ? 64 : 1;
            for (int mm = 0; mm < nm; ++mm) { const int j0 = jj * 64 + mm; const int jc = (j0 <= i) ? j0 : 0;
                acc += __shfl(s[jj], mm) * bf1(V[(size_t)(tok - jc * dl) * SGW + h * 64 + C.lane]); } }
        OG[(size_t)tok * SGW + h * 64 + C.lane] = (bf16_t)f2bf(acc / l);
        if (C.lane == 0) LSE[tok * 12 + h] = mx + __logf(l);
    }
}
typedef short bf16x8 __attribute__((ext_vector_type(8)));
typedef short s16x4 __attribute__((ext_vector_type(4)));
constexpr int AT_KS = 144, AT_VS = 160, AT_ROWS = 272, AT_K_OFF = 0, AT_V_OFF = AT_ROWS * AT_KS;
static_assert(AT_V_OFF % 16 == 0 && AT_V_OFF + AT_ROWS * AT_VS <= 131072, "attention LDS map");

template <int NKB, bool DIL>
__device__ __forceinline__ void attn_compute(LAS unsigned char* lds, int lane, int krow0, bf16x8 qf0, bf16x8 qf1, float sdl, int ikw, f32x4 (&o)[4], float& mx, float& lsum) {
    const int n = lane & 15, g = lane >> 4;
    const LAS unsigned char* Kb = lds + AT_K_OFF + (krow0 + n) * AT_KS + g * 16;
    f32x4 sc[NKB];
#pragma unroll
    for (int kb = 0; kb < NKB; ++kb) {
        const bf16x8 k0 = *(const LAS bf16x8*)(Kb + kb * 16 * AT_KS), k1 = *(const LAS bf16x8*)(Kb + kb * 16 * AT_KS + 64);
        f32x4 a = (f32x4){0.f, 0.f, 0.f, 0.f};
        a = __builtin_amdgcn_mfma_f32_16x16x32_bf16(k0, qf0, a, 0, 0, 0);
        a = __builtin_amdgcn_mfma_f32_16x16x32_bf16(k1, qf1, a, 0, 0, 0);
        sc[kb] = a;
    }
    float m = -INFINITY;
#pragma unroll
    for (int kb = 0; kb < NKB; ++kb)
#pragma unroll
        for (int r = 0; r < 4; ++r) {
            if (DIL) { const int off = 16 * kb + 4 * g + r, rel = 144 + n - off; const bool valid = (rel >= 0) && (rel <= 128) && (ikw + off >= 0);
                sc[kb][r] = valid ? (sc[kb][r] - sdl * (float)rel) : -INFINITY; }
            m = fmaxf(m, sc[kb][r]); }
    m = fmaxf(m, __shfl_xor(m, 16)); m = fmaxf(m, __shfl_xor(m, 32));
    float l = 0.f;
#pragma unroll
    for (int kb = 0; kb < NKB; ++kb)
#pragma unroll
        for (int r = 0; r < 4; ++r) { sc[kb][r] = __expf(sc[kb][r] - m); l += sc[kb][r]; }
    l += __shfl_xor(l, 16); l += __shfl_xor(l, 32);
    mx = m; lsum = l;
    const LAS unsigned char* Vb = lds + AT_V_OFF + (krow0 + 4 * g + (n >> 2)) * AT_VS + (n & 3) * 8;
#pragma unroll
    for (int db = 0; db < 4; ++db) o[db] = (f32x4){0.f, 0.f, 0.f, 0.f};
#pragma unroll
    for (int kk = 0; kk < NKB / 2; ++kk) {
        union { bf16x8 v; unsigned u[4]; } pf;
        pf.u[0] = cvt_pk_bf16(sc[2 * kk][0], sc[2 * kk][1]); pf.u[1] = cvt_pk_bf16(sc[2 * kk][2], sc[2 * kk][3]);
        pf.u[2] = cvt_pk_bf16(sc[2 * kk + 1][0], sc[2 * kk + 1][1]); pf.u[3] = cvt_pk_bf16(sc[2 * kk + 1][2], sc[2 * kk + 1][3]);
#pragma unroll
        for (int db = 0; db < 4; ++db) {
            const s16x4 v0 = __builtin_amdgcn_ds_read_tr16_b64_v4i16((LAS s16x4*)(Vb + (2 * kk) * 16 * AT_VS + db * 32));
            const s16x4 v1 = __builtin_amdgcn_ds_read_tr16_b64_v4i16((LAS s16x4*)(Vb + (2 * kk + 1) * 16 * AT_VS + db * 32));
            const bf16x8 vf = __builtin_shufflevector(v0, v1, 0, 1, 2, 3, 4, 5, 6, 7);
            o[db] = __builtin_amdgcn_mfma_f32_16x16x32_bf16(vf, pf.v, o[db], 0, 0, 0);
        }
    }
}

__device__ __forceinline__ void memattn_mfma(const Ctx& C, const bf16_t* QM, const bf16_t* MKV, int ck, int cv, bf16_t* OUT, int ldo, int coff) {
    const int n = C.lane & 15, g = C.lane >> 4;
    for (int unit = C.vb; unit < NB * 4 * 8; unit += C.G) {
        const int b = unit >> 5, h = (unit >> 3) & 3, qp = unit & 7;
        __syncthreads();
#pragma unroll
        for (int it = 0; it < 4; ++it) { const int row = it * 64 + (C.tid >> 3), c = C.tid & 7;
            const bf16_t* src = MKV + (size_t)(b * NMEM + row) * 1024 + h * 64 + c * 8;
            const u32x4 kv = *(const u32x4*)(src + ck), vv = *(const u32x4*)(src + cv);
            *(LAS u32x4*)(C.lds + AT_K_OFF + row * AT_KS + c * 16) = kv; *(LAS u32x4*)(C.lds + AT_V_OFF + row * AT_VS + c * 16) = vv; }
        bf16x8 qf[2][2];
#pragma unroll
        for (int t = 0; t < 2; ++t) { const bf16_t* qp_ = QM + (size_t)(b * SEQ + (qp * 2 + t) * 128 + C.wave * 16 + n) * 256 + h * 64 + g * 8; qf[t][0] = *(const bf16x8*)qp_; qf[t][1] = *(const bf16x8*)(qp_ + 32); }
        __syncthreads();
#pragma unroll
        for (int t = 0; t < 2; ++t) {
            const int tok = b * SEQ + (qp * 2 + t) * 128 + C.wave * 16 + n;
            f32x4 o[4]; float mx, l;
            attn_compute<16, false>(C.lds, C.lane, 0, qf[t][0], qf[t][1], 0.f, 0, o, mx, l);
            const float inv = 1.0f / l;
#pragma unroll
            for (int db = 0; db < 4; ++db)
                *(u32x2*)(OUT + (size_t)tok * ldo + coff + h * 64 + 16 * db + 4 * g) = (u32x2){cvt_pk_bf16(o[db][0] * inv, o[db][1] * inv), cvt_pk_bf16(o[db][2] * inv, o[db][3] * inv)};
        }
    }
}
__device__ __forceinline__ void dilattn_mfma(const Ctx& C) {
    const bf16_t* Q = (const bf16_t*)(C.ws + WS_Q); const bf16_t* K = (const bf16_t*)(C.ws + WS_K); const bf16_t* V = (const bf16_t*)(C.ws + WS_V);
    bf16_t* OG = (bf16_t*)(C.ws + WS_OG); float* LSE = (float*)(C.ws + WS_LSE);
    const int n = C.lane & 15, g = C.lane >> 4;
    for (int unit = C.vb; unit < 12 * 128; unit += C.G) {
        const int h = unit >> 7, rem = unit & 127, b = rem >> 4, x = rem & 15, grp = h >> 2;
        const int dl = (grp == 0) ? 1 : (grp == 1 ? 4 : 16), ntile = 16 / dl, r = x / ntile, I0 = (x % ntile) * 128;
        const float sdl = exp2f(-(float)(h + 1) * (8.0f / 12.0f)) * (float)dl;
        __syncthreads();
        { u32x4 kv[5], vv[5];
#pragma unroll
          for (int it = 0; it < 5; ++it) { const int idx = it * NTHREADS + C.tid, row = idx >> 3, c = idx & 7, ik = I0 - 144 + row;
              kv[it] = (u32x4){0u, 0u, 0u, 0u}; vv[it] = (u32x4){0u, 0u, 0u, 0u};
              if (idx < AT_ROWS * 8 && ik >= 0) { const size_t off = (size_t)(b * SEQ + ik * dl + r) * SGW + h * 64 + c * 8; kv[it] = *(const u32x4*)(K + off); vv[it] = *(const u32x4*)(V + off); } }
#pragma unroll
          for (int it = 0; it < 5; ++it) { const int idx = it * NTHREADS + C.tid, row = idx >> 3, c = idx & 7;
              if (idx < AT_ROWS * 8) { *(LAS u32x4*)(C.lds + AT_K_OFF + row * AT_KS + c * 16) = kv[it]; *(LAS u32x4*)(C.lds + AT_V_OFF + row * AT_VS + c * 16) = vv[it]; } } }
        const int iq = I0 + C.wave * 16 + n, tok = b * SEQ + iq * dl + r;
        const bf16_t* qp = Q + (size_t)tok * SGW + h * 64 + g * 8;
        const bf16x8 qf0 = *(const bf16x8*)qp, qf1 = *(const bf16x8*)(qp + 32);
        __syncthreads();
        f32x4 o[4]; float mx, l;
        attn_compute<10, true>(C.lds, C.lane, C.wave * 16, qf0, qf1, sdl, I0 + C.wave * 16 - 144, o, mx, l);
        const float inv = 1.0f / l;
#pragma unroll
        for (int db = 0; db < 4; ++db)
            *(u32x2*)(OG + (size_t)tok * SGW + h * 64 + 16 * db + 4 * g) = (u32x2){cvt_pk_bf16(o[db][0] * inv, o[db][1] * inv), cvt_pk_bf16(o[db][2] * inv, o[db][3] * inv)};
        if (g == 0) LSE[tok * 12 + h] = mx + __logf(l);
    }
}
constexpr int SG_GVN_OFF = 1024, SG_VS = 160, SG_TILE = 128 * SG_VS, SG_GB_OFF = SG_GVN_OFF + 6 * SG_TILE;
static_assert(SG_GB_OFF + 2 * 384 * 4 <= 131072, "spatial-gating LDS map");
__device__ __forceinline__ void sg_mfma(const Ctx& C, const Args& A) {
    const bf16_t* U = (const bf16_t*)(C.ws + WS_U); const bf16_t* GV = (const bf16_t*)(C.ws + WS_GV); bf16_t* CAT = (bf16_t*)(C.ws + WS_CAT);
    const bf16_t* WB = (const bf16_t*)(C.ws + WS_SGWB); const float* RS = (const float*)(C.ws + WS_SGRS);
    const float* lng = A.in[4]; const float* lnb = A.in[5]; const float* sgb = A.in[7];
    LAS float* stat = (LAS float*)C.lds; LAS float* gbl = (LAS float*)(C.lds + SG_GB_OFF);
    const int n = C.lane & 15, gl = C.lane >> 4;
    for (int unit = C.vb; unit < NB * 16 * 2; unit += C.G) {
        const int tb = (unit >> 1) * 128, g0 = (unit & 1) * 6;
        __syncthreads();
        u32x4 wt[12];
#pragma unroll
        for (int k = 0; k < 12; ++k) { const int rg = k * 64 + (C.tid >> 3), gi = rg >> 7, row = rg & 127, c = C.tid & 7;
            wt[k] = *(const u32x4*)(GV + (size_t)(tb + row) * SGW + (g0 + gi) * 64 + c * 8); }
        if (C.tid < 192) { const int half = C.tid / 96, i4 = C.tid % 96; *(LAS f32x4*)(gbl + half * 384 + 4 * i4) = *(const f32x4*)((half ? lnb : lng) + g0 * 64 + 4 * i4); }
        for (int r8 = 0; r8 < 16; r8 += 8) {
            u32x2 w[8][3];
#pragma unroll
            for (int q = 0; q < 8; ++q)
#pragma unroll
                for (int j = 0; j < 3; ++j) w[q][j] = *(const u32x2*)(GV + (size_t)(tb + C.wave * 16 + r8 + q) * SGW + 4 * C.lane + 256 * j);
#pragma unroll
            for (int q = 0; q < 8; ++q) { float s = 0.f, ss = 0.f;
#pragma unroll
                for (int j = 0; j < 3; ++j) { const float a = bflo(w[q][j].x), b = bfhi(w[q][j].x), c = bflo(w[q][j].y), d = bfhi(w[q][j].y);
                    s += (a + b) + (c + d); ss += (a * a + b * b) + (c * c + d * d); }
                s = wave_sum_dpp(s); ss = wave_sum_dpp(ss);
                const float mean = s * (1.f / SGW), var = ss * (1.f / SGW) - mean * mean; const int row = C.wave * 16 + r8 + q;
                if (C.lane == 0) { stat[row * 2] = mean; stat[row * 2 + 1] = 1.0f / sqrtf(var + LN_EPS); } } }
        __syncthreads();
#pragma unroll
        for (int k = 0; k < 12; ++k) { const int rg = k * 64 + (C.tid >> 3), gi = rg >> 7, row = rg & 127, c = C.tid & 7;
            const float mean = stat[row * 2], rstd = stat[row * 2 + 1]; u32x4 o;
            o.x = cvt_pk_bf16((bflo(wt[k].x) - mean) * rstd, (bfhi(wt[k].x) - mean) * rstd); o.y = cvt_pk_bf16((bflo(wt[k].y) - mean) * rstd, (bfhi(wt[k].y) - mean) * rstd);
            o.z = cvt_pk_bf16((bflo(wt[k].z) - mean) * rstd, (bfhi(wt[k].z) - mean) * rstd); o.w = cvt_pk_bf16((bflo(wt[k].w) - mean) * rstd, (bfhi(wt[k].w) - mean) * rstd);
            *(LAS u32x4*)(C.lds + SG_GVN_OFF + gi * SG_TILE + row * SG_VS + c * 16) = o; }
        __syncthreads();
        const int p = C.wave * 16 + n;
#pragma unroll 3
        for (int gi = 0; gi < 6; ++gi) {
            const int g = g0 + gi;
            const bf16_t* wp = WB + (size_t)(g * 128 + p) * 128 + 8 * gl;
            bf16x8 wf[4];
#pragma unroll
            for (int ks = 0; ks < 4; ++ks) wf[ks] = *(const bf16x8*)(wp + 32 * ks);
            u32x2 uw[4];
#pragma unroll
            for (int db = 0; db < 4; ++db) uw[db] = *(const u32x2*)(U + (size_t)(tb + p) * SGW + (size_t)g * 64 + 16 * db + 4 * gl);
            const float bs = sgb[g * 128 + p], rsw = RS[g * 128 + p];
            f32x4 acc[4];
#pragma unroll
            for (int db = 0; db < 4; ++db) acc[db] = (f32x4){0.f, 0.f, 0.f, 0.f};
            const LAS unsigned char* vb = C.lds + SG_GVN_OFF + gi * SG_TILE + (8 * gl + (n >> 2)) * SG_VS + (n & 3) * 8;
#pragma unroll
            for (int ks = 0; ks < 4; ++ks)
#pragma unroll
                for (int db = 0; db < 4; ++db) {
                    const s16x4 v0 = __builtin_amdgcn_ds_read_tr16_b64_v4i16((LAS s16x4*)(vb + ks * 32 * SG_VS + db * 32));
                    const s16x4 v1 = __builtin_amdgcn_ds_read_tr16_b64_v4i16((LAS s16x4*)(vb + ks * 32 * SG_VS + 4 * SG_VS + db * 32));
                    const bf16x8 vf = __builtin_shufflevector(v0, v1, 0, 1, 2, 3, 4, 5, 6, 7);
                    acc[db] = __builtin_amdgcn_mfma_f32_16x16x32_bf16(vf, wf[ks], acc[db], 0, 0, 0);
                }
#pragma unroll
            for (int db = 0; db < 4; ++db) { const int cl = gi * 64 + 16 * db + 4 * gl; const size_t co = (size_t)g * 64 + 16 * db + 4 * gl;
                const f32x4 ga = *(const LAS f32x4*)(gbl + cl), be = *(const LAS f32x4*)(gbl + 384 + cl);
                const float s0 = ga[0] * acc[db][0] + (be[0] * rsw + bs), s1 = ga[1] * acc[db][1] + (be[1] * rsw + bs);
                const float s2 = ga[2] * acc[db][2] + (be[2] * rsw + bs), s3 = ga[3] * acc[db][3] + (be[3] * rsw + bs);
                *(u32x2*)(CAT + (size_t)(tb + p) * D + co) = (u32x2){cvt_pk_bf16(bflo(uw[db].x) * s0, bfhi(uw[db].x) * s1), cvt_pk_bf16(bflo(uw[db].y) * s2, bfhi(uw[db].y) * s3)}; }
        }
    }
}
__device__ __forceinline__ void dil_merge(const Ctx& C, const Args& A) {
    const bf16_t* OG = (const bf16_t*)(C.ws + WS_OG); const float* LSE = (const float*)(C.ws + WS_LSE); bf16_t* CAT2 = (bf16_t*)(C.ws + WS_CAT2);
    const int gt = C.bid * NTHREADS + C.tid, NT = C.G * NTHREADS;
    for (int it = gt; it < T * 32; it += NT) {
        const int tok = it >> 5, j = (it >> 3) & 3, c8 = it & 7;
        const float l0 = LSE[tok * 12 + j], l1 = LSE[tok * 12 + 4 + j], l2 = LSE[tok * 12 + 8 + j];
        const float mx = fmaxf(l0, fmaxf(l1, l2));
        float w0 = __expf(l0 - mx), w1 = __expf(l1 - mx), w2 = __expf(l2 - mx); const float inv = 1.0f / (w0 + w1 + w2); w0 *= inv; w1 *= inv; w2 *= inv;
        const u32x4 a = *(const u32x4*)(OG + (size_t)tok * SGW + j * 64 + c8 * 8), b = *(const u32x4*)(OG + (size_t)tok * SGW + (4 + j) * 64 + c8 * 8), c = *(const u32x4*)(OG + (size_t)tok * SGW + (8 + j) * 64 + c8 * 8);
        u32x4 o;
        o.x = pk2(w0 * bflo(a.x) + w1 * bflo(b.x) + w2 * bflo(c.x), w0 * bfhi(a.x) + w1 * bfhi(b.x) + w2 * bfhi(c.x));
        o.y = pk2(w0 * bflo(a.y) + w1 * bflo(b.y) + w2 * bflo(c.y), w0 * bfhi(a.y) + w1 * bfhi(b.y) + w2 * bfhi(c.y));
        o.z = pk2(w0 * bflo(a.z) + w1 * bflo(b.z) + w2 * bflo(c.z), w0 * bfhi(a.z) + w1 * bfhi(b.z) + w2 * bfhi(c.z));
        o.w = pk2(w0 * bflo(a.w) + w1 * bflo(b.w) + w2 * bflo(c.w), w0 * bfhi(a.w) + w1 * bfhi(b.w) + w2 * bfhi(c.w));
        *(u32x4*)(CAT2 + (size_t)tok * 512 + j * 64 + c8 * 8) = o;
    }
}

constexpr int LR_WS = 2064;
__device__ __forceinline__ void ln_route(const Ctx& C, const Args& A, int layer, int cset) {
    const bf16_t* Y = (const bf16_t*)(C.ws + WS_Y); bf16_t* X1B = (bf16_t*)(C.ws + WS_X1B); unsigned char* X1F8 = C.ws + WS_X1F8;
    const float* lg = A.in[14] + layer * D; const float* lb = A.in[15] + layer * D; const float* br = A.in[19];
    unsigned* cnt = (unsigned*)(C.ws + WS_CTL) + CW_CNT + cset * 16 * 64;
    int* tokE = (int*)(C.ws + WS_TOKE); int* tokP = (int*)(C.ws + WS_TOKP); float* tokG = (float*)(C.ws + WS_TOKG); int* list = (int*)(C.ws + WS_LIST);
    LAS unsigned char* wl = C.lds;
    LAS int* sE = (LAS int*)(C.lds + 65536); LAS float* sG = (LAS float*)(C.lds + 65536 + 512); LAS int* sPos = (LAS int*)(C.lds + 65536 + 1024);
    LAS int* lcnt = (LAS int*)(C.lds + 65536 + 1536); LAS int* lbase = (LAS int*)(C.lds + 65536 + 1600); LAS float* slog = (LAS float*)(C.lds + 65536 + 2048);
    __syncthreads();
#pragma unroll
    for (int it = 0; it < 4; ++it) { const int i = it * NTHREADS + C.tid, e = i >> 7, c = i & 127;
        *(LAS u32x4*)(wl + e * LR_WS + c * 16) = *(const u32x4*)((const bf16_t*)(C.ws + WS_WRT) + (size_t)e * 1024 + c * 8); }
    f32x4 g4[4], b4[4];
#pragma unroll
    for (int j = 0; j < 4; ++j) { g4[j] = *(const f32x4*)(lg + 4 * C.lane + 256 * j); b4[j] = *(const f32x4*)(lb + 4 * C.lane + 256 * j); }
    const int n = C.lane & 15, q = C.lane >> 4;
    for (int blk = C.bid; blk < T / 64; blk += C.G) {
        __syncthreads();
        if (C.tid < 16) lcnt[C.tid] = 0;
        u32x2 nv[4];
        { const u32x2* yb = (const u32x2*)(Y + (size_t)(blk * 64 + C.wave * 8) * D) + C.lane;
#pragma unroll
          for (int j = 0; j < 4; ++j) nv[j] = yb[64 * j]; }
#pragma unroll 1
        for (int tq = 0; tq < 8; ++tq) {
            const int tok = blk * 64 + C.wave * 8 + tq;
            f32x4 v[4]; float s = 0.f;
#pragma unroll
            for (int j = 0; j < 4; ++j) { v[j] = (f32x4){bflo(nv[j].x), bfhi(nv[j].x), bflo(nv[j].y), bfhi(nv[j].y)}; s += (v[j][0] + v[j][1]) + (v[j][2] + v[j][3]); }
            { const u32x2* yb = (const u32x2*)(Y + (size_t)(tok + (tq < 7 ? 1 : 0)) * D) + C.lane;
#pragma unroll
              for (int j = 0; j < 4; ++j) nv[j] = yb[64 * j]; }
            const float mean = wave_sum_dpp(s) * (1.f / D); float s2 = 0.f;
#pragma unroll
            for (int j = 0; j < 4; ++j) { v[j] = v[j] - mean; s2 += (v[j][0] * v[j][0] + v[j][1] * v[j][1]) + (v[j][2] * v[j][2] + v[j][3] * v[j][3]); }
            const float rstd = 1.0f / sqrtf(wave_sum_dpp(s2) * (1.f / D) + LN_EPS);
            u32x2* xb = (u32x2*)(X1B + (size_t)tok * D) + C.lane; unsigned* x8 = (unsigned*)(X1F8 + (size_t)tok * D) + C.lane;
#pragma unroll
            for (int j = 0; j < 4; ++j) { v[j] = v[j] * rstd * g4[j] + b4[j];
                xb[64 * j] = (u32x2){pk2(v[j][0], v[j][1]), pk2(v[j][2], v[j][3])};
                x8[64 * j] = pk4_fp8(v[j][0], v[j][1], v[j][2], v[j][3]); }
        }
        asm volatile("s_waitcnt vmcnt(0)" ::: "memory");
        __syncthreads();
        {
            const int tile = C.wave & 3, kh = C.wave >> 2;
            const bf16_t* ap = X1B + (size_t)(blk * 64 + tile * 16 + n) * D + kh * 512 + 8 * q;
            const LAS unsigned char* bp = wl + n * LR_WS + (kh * 512 + 8 * q) * 2;
            bf16x8 af[16];
#pragma unroll
            for (int ks = 0; ks < 16; ++ks) af[ks] = *(const bf16x8*)(ap + 32 * ks);
            f32x4 acc = (f32x4){0.f, 0.f, 0.f, 0.f};
#pragma unroll
            for (int ks = 0; ks < 16; ++ks) { const bf16x8 bf = *(const LAS bf16x8*)(bp + 64 * ks); acc = __builtin_amdgcn_mfma_f32_16x16x32_bf16(af[ks], bf, acc, 0, 0, 0); }
#pragma unroll
            for (int r = 0; r < 4; ++r) slog[(kh * 64 + tile * 16 + 4 * q + r) * 17 + n] = acc[r];
        }
        __syncthreads();
        if (C.tid < 64) {
            const int tl = C.tid;
            float pr[16]; float mx = -INFINITY;
#pragma unroll
            for (int e = 0; e < 16; ++e) { pr[e] = slog[tl * 17 + e] + slog[(64 + tl) * 17 + e]; mx = fmaxf(mx, pr[e]); }
            float sum = 0.f;
#pragma unroll
            for (int e = 0; e < 16; ++e) { pr[e] = __expf(pr[e] - mx); sum += pr[e]; }
            const float inv = 1.0f / sum; float sel[16];
#pragma unroll
            for (int e = 0; e < 16; ++e) { pr[e] *= inv; sel[e] = pr[e] + br[e]; }
            float gs[4];
#pragma unroll
            for (int g = 0; g < 4; ++g) { const float a = sel[4 * g], b = sel[4 * g + 1], c = sel[4 * g + 2], d = sel[4 * g + 3];
                gs[g] = fmaxf(fmaxf(fmaxf(a + b, a + c), fmaxf(a + d, b + c)), fmaxf(b + d, c + d)); }
            int gi = 0; float bsc = gs[0];
#pragma unroll
            for (int g = 1; g < 4; ++g) if (gs[g] > bsc) { bsc = gs[g]; gi = g; }
            float sg[4], pg[4];
#pragma unroll
            for (int k = 0; k < 4; ++k) { sg[k] = gi == 0 ? sel[k] : (gi == 1 ? sel[4 + k] : (gi == 2 ? sel[8 + k] : sel[12 + k])); pg[k] = gi == 0 ? pr[k] : (gi == 1 ? pr[4 + k] : (gi == 2 ? pr[8 + k] : pr[12 + k])); }
            int i1 = 0; float b1 = sg[0], p1 = pg[0];
#pragma unroll
            for (int k = 1; k < 4; ++k) if (sg[k] > b1) { b1 = sg[k]; i1 = k; p1 = pg[k]; }
            int i2 = -1; float b2 = -INFINITY, p2 = 0.f;
#pragma unroll
            for (int k = 0; k < 4; ++k) if (k != i1 && sg[k] > b2) { b2 = sg[k]; i2 = k; p2 = pg[k]; }
            const float gsum = p1 + p2; sE[tl * 2] = gi * 4 + i1; sE[tl * 2 + 1] = gi * 4 + i2; sG[tl * 2] = p1 / gsum; sG[tl * 2 + 1] = p2 / gsum;
        }
        __syncthreads();
        if (C.tid < 128) sPos[C.tid] = __hip_atomic_fetch_add(lcnt + sE[C.tid], 1, __ATOMIC_RELAXED, __HIP_MEMORY_SCOPE_WORKGROUP);
        __syncthreads();
        if (C.tid < 16) lbase[C.tid] = (int)__hip_atomic_fetch_add(cnt + C.tid * 64, (unsigned)lcnt[C.tid], __ATOMIC_RELAXED, __HIP_MEMORY_SCOPE_AGENT);
        __syncthreads();
        if (C.tid < 128) { const int e = sE[C.tid], pos = lbase[e] + sPos[C.tid], tok = blk * 64 + (C.tid >> 1);
            list[e * LISTCAP + pos] = tok; tokE[tok * 2 + (C.tid & 1)] = e; tokP[tok * 2 + (C.tid & 1)] = pos; tokG[tok * 2 + (C.tid & 1)] = sG[C.tid]; }
    }
}
__device__ __forceinline__ void moe_prefix(const Ctx& C, int layer) {
    LAS int* mi = (LAS int*)(C.lds + LDS_MISC);
    unsigned* cnt = (unsigned*)(C.ws + WS_CTL) + CW_CNT + layer * 16 * 64;
    __syncthreads();
    if (C.tid < 16) mi[17 + C.tid] = (int)__hip_atomic_load(cnt + C.tid * 64, __ATOMIC_RELAXED, __HIP_MEMORY_SCOPE_AGENT);
    __syncthreads();
    if (C.tid == 0) { int a = 0; for (int e = 0; e < 16; ++e) { mi[e] = a; a += (mi[17 + e] + 255) >> 8; } mi[16] = a; }
    __syncthreads();
}
__device__ __forceinline__ void moe_tokens(const Ctx& C, int ntn) {
    const LAS int* mi = (const LAS int*)(C.lds + LDS_MISC); LAS int* toks = (LAS int*)(C.lds + LDS_TOKS);
    const int* list = (const int*)(C.ws + WS_LIST);
    const int total = mi[16] * ntn;
    int tv[4]; bool ok[4];
#pragma unroll
    for (int k = 0; k < 4; ++k) {
        const int idx = k * NTHREADS + C.tid, u = idx >> 8, rr = idx & 255, L = moe_unit_index(u, C.bid, C.G, total); ok[k] = L >= 0;
        const int Lc = ok[k] ? L : 0; int e = 0;
#pragma unroll
        for (int j = 1; j < 16; ++j) e += (Lc >= mi[j] * ntn) ? 1 : 0;
        const int r = Lc - mi[e] * ntn, te = mi[e + 1] - mi[e], mt = r / ntn, cn = mi[17 + e]; (void)te;
        int pos = mt * 256 + rr; pos = pos < cn ? pos : cn - 1; pos = pos < 0 ? 0 : pos;
        tv[k] = list[e * LISTCAP + pos];
    }
#pragma unroll
    for (int k = 0; k < 4; ++k) if (ok[k]) toks[k * NTHREADS + C.tid] = tv[k];
    __syncthreads();
}
__device__ __forceinline__ void combine_ln2(const Ctx& C, const Args& A, int layer) {
    const LAS int* mi = (const LAS int*)(C.lds + LDS_MISC);
    const bf16_t* X1B = (const bf16_t*)(C.ws + WS_X1B); const unsigned char* YD = C.ws + WS_YD; bf16_t* X2B = (bf16_t*)(C.ws + WS_XB);
    const int* tokE = (const int*)(C.ws + WS_TOKE); const int* tokP = (const int*)(C.ws + WS_TOKP); const float* tokG = (const float*)(C.ws + WS_TOKG);
    const float* lg = A.in[16] + layer * D; const float* lb = A.in[17] + layer * D;
    for (int tok0 = C.gw * 8; tok0 < T; tok0 += C.NGW * 8) {
        int rowv = 0; float gv = 0.f;
        if (C.lane < 16) { const int e = tokE[tok0 * 2 + C.lane]; rowv = mi[e] * 256 + tokP[tok0 * 2 + C.lane]; gv = tokG[tok0 * 2 + C.lane]; }
#pragma unroll 1
        for (int tq = 0; tq < 8; tq += 4) {
            u32x2 xa[4][4]; unsigned y0[4][4], y1[4][4]; float g0[4], g1[4];
#pragma unroll
            for (int t = 0; t < 4; ++t) {
                const int ra = __shfl(rowv, 2 * (tq + t)), rb = __shfl(rowv, 2 * (tq + t) + 1);
                g0[t] = __shfl(gv, 2 * (tq + t)) * (1.0f / YD8_SCALE); g1[t] = __shfl(gv, 2 * (tq + t) + 1) * (1.0f / YD8_SCALE);
                const u32x2* xp = (const u32x2*)(X1B + (size_t)(tok0 + tq + t) * D) + C.lane; const unsigned* pa = (const unsigned*)(YD + (size_t)ra * D) + C.lane; const unsigned* pb = (const unsigned*)(YD + (size_t)rb * D) + C.lane;
#pragma unroll
                for (int j = 0; j < 4; ++j) { xa[t][j] = xp[64 * j]; y0[t][j] = pa[64 * j]; y1[t][j] = pb[64 * j]; }
            }
#pragma unroll
            for (int t = 0; t < 4; ++t) {
                f32x4 v[4]; float s = 0.f;
#pragma unroll
                for (int j = 0; j < 4; ++j) {
                    const f32x2 a01 = __builtin_amdgcn_cvt_pk_f32_fp8((int)y0[t][j], false), a23 = __builtin_amdgcn_cvt_pk_f32_fp8((int)y0[t][j], true);
                    const f32x2 b01 = __builtin_amdgcn_cvt_pk_f32_fp8((int)y1[t][j], false), b23 = __builtin_amdgcn_cvt_pk_f32_fp8((int)y1[t][j], true);
                    v[j][0] = ALPHA * bflo(xa[t][j].x) + (g0[t] * a01.x + g1[t] * b01.x); v[j][1] = ALPHA * bfhi(xa[t][j].x) + (g0[t] * a01.y + g1[t] * b01.y);
                    v[j][2] = ALPHA * bflo(xa[t][j].y) + (g0[t] * a23.x + g1[t] * b23.x); v[j][3] = ALPHA * bfhi(xa[t][j].y) + (g0[t] * a23.y + g1[t] * b23.y);
                    s += (v[j][0] + v[j][1]) + (v[j][2] + v[j][3]); }
                const float mean = wave_sum_dpp(s) * (1.f / D); float s2 = 0.f;
#pragma unroll
                for (int j = 0; j < 4; ++j) { v[j] = v[j] - mean; s2 += (v[j][0] * v[j][0] + v[j][1] * v[j][1]) + (v[j][2] * v[j][2] + v[j][3] * v[j][3]); }
                const float rstd = 1.0f / sqrtf(wave_sum_dpp(s2) * (1.f / D) + LN_EPS);
                const int tok = tok0 + tq + t;
#pragma unroll
                for (int j = 0; j < 4; ++j) { const int col = 4 * C.lane + 256 * j; const f32x4 g4 = *(const f32x4*)(lg + col), b4 = *(const f32x4*)(lb + col);
                    const f32x4 o = v[j] * rstd * g4 + b4;
                    if (layer == 0) *(u32x2*)(X2B + (size_t)tok * D + col) = (u32x2){pk2(o[0], o[1]), pk2(o[2], o[3])};
                    else *(f32x4*)(A.out + (size_t)tok * D + col) = o; }
            }
        }
    }
}

__global__ void __launch_bounds__(NTHREADS, 2) yoco_fwd(Args args) {
    extern __shared__ __attribute__((aligned(16))) unsigned char lds_raw[];
    Ctx C;
    C.ws = args.ws; C.lds = (LAS unsigned char*)lds_raw;
    C.tid = threadIdx.x; C.lane = C.tid & 63; C.wave = __builtin_amdgcn_readfirstlane(C.tid >> 6);
    C.G = gridDim.x; C.bid = blockIdx.x; C.gw = C.bid * NWAVES + C.wave; C.NGW = C.G * NWAVES;
    C.vb = ((C.G & 7) == 0) ? (C.bid & 7) * (C.G >> 3) + (C.bid >> 3) : C.bid;
    unsigned char* ws = args.ws;
#define PHASE_WS() do { ws = launder(args.ws); C.ws = ws; C.tid = launder_v((int)threadIdx.x); C.lane = C.tid & 63; } while (0)
    volatile LAS unsigned* misc = (volatile LAS unsigned*)(C.lds + LDS_MISC);
    for (int u = C.tid; u < 64; u += NTHREADS) misc[u] = 0u;
    __syncthreads();
    XcdBarrier bar; bar.bar = (unsigned*)(ws + WS_CTL) + CW_BAR; bar.x = 0; bar.st = misc + 60;
    const int lo = args.ph_lo, hi = args.ph_hi;
    if (hi - lo > 1) bar = xcd_barrier_post((unsigned*)(ws + WS_CTL) + CW_BAR, misc + 60);
#define IN(k) (lo <= (k) && (k) < hi)
#define SEAMF(k) do { if (IN(k) && IN((k) + 1)) { PHASE_WS(); fill_tail(C, args, (k), false); xcd_barrier(bar); } } while (0)
#if MK_DIAG == 9
#define SEAM(k) do { if (IN(k) && IN((k) + 1)) { const unsigned long long t0_ = __builtin_amdgcn_s_memrealtime(); xcd_barrier(bar); if (((MK_DIAGMASK >> (k)) & 1) && threadIdx.x == 0) diag_acc += (unsigned)(__builtin_amdgcn_s_memrealtime() - t0_); } } while (0)
#else
#define SEAM(k) do { if (IN(k) && IN((k) + 1)) xcd_barrier(bar); } while (0)
#endif
#ifndef MK_DUP
#define MK_DUP 0
#endif
    unsigned diag_acc = 0;
#if MK_DIAG == 10
#define TREG(id, ...) do { __syncthreads(); const unsigned long long t0_ = __builtin_amdgcn_s_memrealtime(); __VA_ARGS__; __syncthreads(); if ((id) == MK_DIAGSEL) diag_acc += (unsigned)(__builtin_amdgcn_s_memrealtime() - t0_); } while (0)
#else
#define TREG(id, ...) do { __VA_ARGS__; } while (0)
#endif
#define REP(k) for (int rep_ = 0; rep_ < 1 + ((MK_DUP >> (k)) & 1); ++rep_)

    if (IN(0)) { REP(0) { PHASE_WS(); TREG(10, p0_prologue(C, args)); } SEAM(0); }

    if (IN(1)) {
        REP(1) {
        PHASE_WS();
        { pg8::Gemm g{(const bf16_t*)(ws + WS_XB), (const bf16_t*)(ws + WS_BT_INA), T, 1792, D}; pg8::StaticOrder S; S.init(T, 1792, C.G, C.bid);
          EpiProjA E{(bf16_t*)(ws + WS_U), (bf16_t*)(ws + WS_GV), (bf16_t*)(ws + WS_QM0)};
          pg8::gemm_phase<EpiProjA, pg8::StaticOrder>(C.lds, g, S, E, nullptr, C.tid); }
        { pg8::Gemm g{(const bf16_t*)(ws + WS_MEMB), (const bf16_t*)(ws + WS_BT_MEM), NB * NMEM, 1024, D}; SmallOrder S{4, 32, C.bid - (C.G - 32)};
          EpiPlain E{(bf16_t*)(ws + WS_MKV), 1024, 4};
          pg8::gemm_phase<EpiPlain, SmallOrder>(C.lds, g, S, E, nullptr, C.tid); }
        }
        SEAMF(1);
    }
    if (IN(2)) {
        REP(2) { PHASE_WS();
        TREG(1, sg_mfma(C, args));
        TREG(2, memattn_mfma(C, (const bf16_t*)(ws + WS_QM0), (const bf16_t*)(ws + WS_MKV), 0, 256, (bf16_t*)(ws + WS_CAT), D, SGW)); }
        SEAM(2);
    }
    if (IN(3)) {
        REP(3) { PHASE_WS();
        pg8::Gemm g{(const bf16_t*)(ws + WS_CAT), (const bf16_t*)(ws + WS_BT_OUTA), T, D, D}; pg8::StaticOrder S; S.init(T, D, C.G, C.bid);
        EpiResid<true> E{(const void*)(ws + WS_XB), (bf16_t*)(ws + WS_Y)};
        pg8::gemm_phase<EpiResid<true>, pg8::StaticOrder>(C.lds, g, S, E, nullptr, C.tid); }
        SEAM(3);
    }
    { constexpr int layer = 0;
        const int pb = 4 + 8 * layer;
        if (IN(pb)) { if ((MK_DUP >> 4) & 1) { PHASE_WS(); ln_route(C, args, layer, 2 + layer); __syncthreads(); } PHASE_WS(); TREG(6 + layer, ln_route(C, args, layer, layer)); SEAM(pb); }
        if (IN(pb + 1)) {
            REP(5) { PHASE_WS();
            moe_prefix(C, layer); moe_tokens(C, 8);
            MoeGatherOrder S; S.tb = (const LAS int*)(C.lds + LDS_MISC); S.ntn = 8; S.G = C.G; S.c = C.bid; S.toks = (const LAS int*)(C.lds + LDS_TOKS);
            {
                pg8::Gemm g{(const bf16_t*)(ws + WS_X1F8), (const bf16_t*)(ws + WS_WGU + (size_t)layer * (64 * MiB)), 0, 0, D / 2, E8_ONE, E8_W};
                EpiSwiGLU8 E{ws + WS_ACT};
#if MK_DUPNULL
                if (rep_ > 0) { EpiNull EN; pg8::gemm_phase<EpiNull, MoeGatherOrder, false, true>(C.lds, g, S, EN, nullptr, C.tid); } else
#endif
                pg8::gemm_phase<EpiSwiGLU8, MoeGatherOrder, false, true>(C.lds, g, S, E, nullptr, C.tid);
            } }
            SEAMF(pb + 1);
        }
        if (IN(pb + 2)) {
            REP(6) { PHASE_WS();
            moe_prefix(C, layer);
            MoeOrder S{(const LAS int*)(C.lds + LDS_MISC), 4, C.G, C.bid};
            EpiPlain8 E{ws + WS_YD, 1024, 4, YD8_SCALE};
            {
                pg8::Gemm g{(const bf16_t*)(ws + WS_ACT), (const bf16_t*)(ws + WS_WD + (size_t)layer * (32 * MiB)), 0, 0, D / 2, E8_ACT, E8_W};
                pg8::gemm_phase<EpiPlain8, MoeOrder, false, true>(C.lds, g, S, E, nullptr, C.tid);
            } }
            SEAMF(pb + 2);
        }
        if (IN(pb + 3)) { REP(7) { PHASE_WS(); moe_prefix(C, layer); TREG(8 + layer, combine_ln2(C, args, layer)); } if (layer == 0) SEAM(pb + 3); }
    }
    {
            if (IN(8)) {
                REP(8) { PHASE_WS();
                pg8::Gemm g{(const bf16_t*)(ws + WS_XB), (const bf16_t*)(ws + WS_BT_B), T, 2560, D}; pg8::StaticOrder S; S.init(T, 2560, C.G, C.bid);
                EpiProjB E{(bf16_t*)(ws + WS_K), (bf16_t*)(ws + WS_V), (bf16_t*)(ws + WS_Q), (bf16_t*)(ws + WS_QM1)};
                pg8::gemm_phase<EpiProjB, pg8::StaticOrder>(C.lds, g, S, E, nullptr, C.tid); }
                SEAMF(8);
            }
            if (IN(9)) {
                REP(9) { PHASE_WS();
                TREG(3, dilattn_mfma(C));
                TREG(4, memattn_mfma(C, (const bf16_t*)(ws + WS_QM1), (const bf16_t*)(ws + WS_MKV), 512, 768, (bf16_t*)(ws + WS_CAT2), 512, 256)); }
                SEAM(9);
            }
            if (IN(10)) { REP(10) { PHASE_WS(); TREG(5, dil_merge(C, args)); } SEAM(10); }
            if (IN(11)) {
                REP(11) { PHASE_WS();
                pg8::Gemm g{(const bf16_t*)(ws + WS_CAT2), (const bf16_t*)(ws + WS_BT_OUTB), T, D, 512}; pg8::StaticOrder S; S.init(T, D, C.G, C.bid);
                EpiResid<true> E{(const void*)(ws + WS_XB), (bf16_t*)(ws + WS_Y)};
                pg8::gemm_phase<EpiResid<true>, pg8::StaticOrder>(C.lds, g, S, E, nullptr, C.tid); }
                if (IN(11)) { PHASE_WS(); fill_tail(C, args, 11, true); }
                SEAM(11);
            }
    }
    { constexpr int layer = 1;
        const int pb = 4 + 8 * layer;
        if (IN(pb)) { if ((MK_DUP >> 4) & 1) { PHASE_WS(); ln_route(C, args, layer, 2 + layer); __syncthreads(); } PHASE_WS(); TREG(6 + layer, ln_route(C, args, layer, layer)); SEAM(pb); }
        if (IN(pb + 1)) {
            REP(5) { PHASE_WS();
            moe_prefix(C, layer); moe_tokens(C, 8);
            MoeGatherOrder S; S.tb = (const LAS int*)(C.lds + LDS_MISC); S.ntn = 8; S.G = C.G; S.c = C.bid; S.toks = (const LAS int*)(C.lds + LDS_TOKS);
            {
                pg8::Gemm g{(const bf16_t*)(ws + WS_X1F8), (const bf16_t*)(ws + WS_WGU + (size_t)layer * (64 * MiB)), 0, 0, D / 2, E8_ONE, E8_W};
                EpiSwiGLU8 E{ws + WS_ACT};
#if MK_DUPNULL
                if (rep_ > 0) { EpiNull EN; pg8::gemm_phase<EpiNull, MoeGatherOrder, false, true>(C.lds, g, S, EN, nullptr, C.tid); } else
#endif
                pg8::gemm_phase<EpiSwiGLU8, MoeGatherOrder, false, true>(C.lds, g, S, E, nullptr, C.tid);
            } }
            SEAM(pb + 1);
        }
        if (IN(pb + 2)) {
            REP(6) { PHASE_WS();
            moe_prefix(C, layer);
            MoeOrder S{(const LAS int*)(C.lds + LDS_MISC), 4, C.G, C.bid};
            EpiPlain8 E{ws + WS_YD, 1024, 4, YD8_SCALE};
            {
                pg8::Gemm g{(const bf16_t*)(ws + WS_ACT), (const bf16_t*)(ws + WS_WD + (size_t)layer * (32 * MiB)), 0, 0, D / 2, E8_ACT, E8_W};
                pg8::gemm_phase<EpiPlain8, MoeOrder, false, true>(C.lds, g, S, E, nullptr, C.tid);
            } }
            SEAM(pb + 2);
        }
        if (IN(pb + 3)) { REP(7) { PHASE_WS(); moe_prefix(C, layer); TREG(8 + layer, combine_ln2(C, args, layer)); } if (layer == 0) SEAM(pb + 3); }
    }
#if MK_DIAG == 3
    xcd_barrier(bar);
    if (blockIdx.x == 0 && threadIdx.x == 0) { const unsigned got = __hip_atomic_fetch_add((unsigned*)(args.ws + WS_CTL) + 30000, 0u, __ATOMIC_RELAXED, __HIP_MEMORY_SCOPE_AGENT); const unsigned long long t0 = __builtin_amdgcn_s_memrealtime();
        const unsigned long long dur = (unsigned long long)got * 4ull;
        while (__builtin_amdgcn_s_memrealtime() - t0 < dur) __builtin_amdgcn_s_sleep(8); }
#endif
#if MK_DIAG == 11
    if (blockIdx.x == 0 && threadIdx.x == 0) { const unsigned long long t0 = __builtin_amdgcn_s_memrealtime(); const unsigned long long dur = (unsigned long long)misc[42] * 4ull;
        while (__builtin_amdgcn_s_memrealtime() - t0 < dur) __builtin_amdgcn_s_sleep(8); }
#endif
#if MK_DIAG == 10
    if (blockIdx.x == 0 && threadIdx.x == 0) { const unsigned long long t0 = __builtin_amdgcn_s_memrealtime(); const unsigned long long dur = (unsigned long long)diag_acc * 4ull;
        while (__builtin_amdgcn_s_memrealtime() - t0 < dur) __builtin_amdgcn_s_sleep(8); }
#endif
#if MK_DIAG == 9
    if (threadIdx.x == 0) __hip_atomic_fetch_add((unsigned*)(args.ws + WS_CTL) + 30000, diag_acc, __ATOMIC_RELAXED, __HIP_MEMORY_SCOPE_AGENT);
    xcd_barrier(bar);
    if (blockIdx.x == 0 && threadIdx.x == 0) { const unsigned got = __hip_atomic_fetch_add((unsigned*)(args.ws + WS_CTL) + 30000, 0u, __ATOMIC_RELAXED, __HIP_MEMORY_SCOPE_AGENT); const unsigned long long t0 = __builtin_amdgcn_s_memrealtime();
        const unsigned long long dur = (unsigned long long)got / 256ull;
        while (__builtin_amdgcn_s_memrealtime() - t0 < dur) __builtin_amdgcn_s_sleep(8); }
#endif
#undef IN
#undef SEAM
}
}

extern "C" void kernel_launch(void* const* d_in, const int* in_sizes, int n_in, void* d_out, int out_size, void* d_ws, size_t ws_size, hipStream_t stream) {
    using namespace mk;
    static int grid = 0;
    if (grid == 0) {
        if (n_in != 23 || out_size != T * D || ws_size < WS_END) { fprintf(stderr, "kernel_launch: unexpected shapes (n_in %d, out %d, ws %zu)\n", n_in, out_size, ws_size); grid = -1; return; }
        int dev = 0, cus = 0, per_cu = 0;
        if (hipGetDevice(&dev) != hipSuccess || hipDeviceGetAttribute(&cus, hipDeviceAttributeMultiprocessorCount, dev) != hipSuccess) { grid = -1; return; }
        if (hipFuncSetAttribute((const void*)yoco_fwd, hipFuncAttributeMaxDynamicSharedMemorySize, LDS_BYTES) != hipSuccess) { fprintf(stderr, "kernel_launch: hipFuncSetAttribute failed\n"); grid = -1; return; }
        if (hipOccupancyMaxActiveBlocksPerMultiprocessor(&per_cu, (const void*)yoco_fwd, NTHREADS, LDS_BYTES) != hipSuccess || per_cu < 1)
            fprintf(stderr, "kernel_launch: occupancy query reports %d workgroups per CU\n", per_cu);
        (void)hipGetLastError();
        grid = cus;
    }
    if (grid < 0) return;
    (void)hipMemsetAsync((char*)d_ws + WS_CTL, 0, CTL_ZERO_BYTES, stream);
    Args a{};
    for (int i = 0; i < 23; ++i) a.in[i] = (const float*)d_in[i];
    a.out = (float*)d_out; a.ws = (unsigned char*)d_ws;
    constexpr int NL = MK_N_LAUNCHES;
    for (int li = 0; li < NL; ++li) {
        a.ph_lo = (NL == NPHASE) ? li : (li * NPHASE) / NL; a.ph_hi = (NL == NPHASE) ? li + 1 : ((li + 1) * NPHASE) / NL;
        hipLaunchKernelGGL(yoco_fwd, dim3(grid), dim3(NTHREADS), LDS_BYTES, stream, a);
    }
}
```
